# Optimizing an MI355X kernel written in HIP

```python
import jax, jax.numpy as jnp
from jax import lax
import numpy as np

D_MODEL = 2048
BATCH = 1
SEQ = 16384
DEPTH = 2

HEAD_DIM = 128
ATTN_WIDTH = D_MODEL // 2
N_ATTN_HEADS = ATTN_WIDTH // HEAD_DIM
CONV_WIDTH = D_MODEL - ATTN_WIDTH
MIX_WIDTH = ATTN_WIDTH + CONV_WIDTH
IN_PROJ_WIDTH = 3 * ATTN_WIDTH + 2 * CONV_WIDTH
CONV_KERNEL = 31
MOBA_BLOCK = 256
MOBA_TOP_K = 3
Q_CHUNK = 128
ROPE_THETA = 10000.0
D_FF = 5632
N_EXPERTS = 8
TOP_K_EXPERTS = 2
N_DENSE = (DEPTH + 1) // 2
N_MOE = DEPTH // 2
LN_EPS = 1e-5
DEEPNORM_ALPHA = (2.0 * DEPTH) ** 0.25
DEEPNORM_BETA = (8.0 * DEPTH) ** -0.25

kernel_name = "hymba_conformer_moba_moe_deepnorm"


def layer_norm(x, g, b):
    xf = x.astype(jnp.float32)
    mu = jnp.mean(xf, axis=-1, keepdims=True)
    var = jnp.mean(jnp.square(xf - mu), axis=-1, keepdims=True)
    return ((xf - mu) * lax.rsqrt(var + LN_EPS) * g + b).astype(x.dtype)


def rotary(x, pos):
    half = HEAD_DIM // 2
    inv_freq = jnp.power(ROPE_THETA, -jnp.arange(half, dtype=jnp.float32) / half)
    ang = pos.astype(jnp.float32)[:, None] * inv_freq[None, :]
    cos = jnp.cos(ang)[None, :, None, :]
    sin = jnp.sin(ang)[None, :, None, :]
    x1 = x[..., :half].astype(jnp.float32)
    x2 = x[..., half:].astype(jnp.float32)
    return jnp.concatenate([x1 * cos - x2 * sin, x2 * cos + x1 * sin], axis=-1).astype(x.dtype)


def moba_attention(q, k, v):
    B, S, H, D = q.shape
    nb = -(-S // MOBA_BLOCK)
    pad = nb * MOBA_BLOCK - S
    if pad:
        k = jnp.pad(k, ((0, 0), (0, pad), (0, 0), (0, 0)))
        v = jnp.pad(v, ((0, 0), (0, pad), (0, 0), (0, 0)))
    kk = min(MOBA_TOP_K, nb)
    scale = D ** -0.5
    kb = k.reshape(B, nb, MOBA_BLOCK, H, D).transpose(0, 3, 1, 2, 4)
    vb = v.reshape(B, nb, MOBA_BLOCK, H, D).transpose(0, 3, 1, 2, 4)
    k_mean = jnp.mean(kb.astype(jnp.float32), axis=3)
    n_chunks = S // Q_CHUNK
    qc = q.reshape(B, n_chunks, Q_CHUNK, H, D).transpose(1, 0, 3, 2, 4)
    b_idx = jnp.arange(B)[:, None, None, None]
    h_idx = jnp.arange(H)[None, :, None, None]
    blk_ids = jnp.arange(nb)

    def one_chunk(args):
        c, q_c = args
        q_start = c * Q_CHUNK
        own = q_start // MOBA_BLOCK
        q_pos = q_start + jnp.arange(Q_CHUNK)
        gate = jnp.einsum('bhqd,bhnd->bhqn', q_c.astype(jnp.float32), k_mean)
        gate = jnp.where(blk_ids[None, None, None, :] < own, gate, -jnp.inf)
        _, sel = lax.top_k(gate, kk)
        valid = sel < own
        k_sel = kb[b_idx, h_idx, sel]
        v_sel = vb[b_idx, h_idx, sel]
        s_sel = jnp.einsum('bhqd,bhqkld->bhqkl', q_c, k_sel).astype(jnp.float32) * scale
        s_sel = jnp.where(valid[..., None], s_sel, -jnp.inf)
        k_own = lax.dynamic_index_in_dim(kb, own, axis=2, keepdims=False)
        v_own = lax.dynamic_index_in_dim(vb, own, axis=2, keepdims=False)
        s_own = jnp.einsum('bhqd,bhld->bhql', q_c, k_own).astype(jnp.float32) * scale
        k_pos = own * MOBA_BLOCK + jnp.arange(MOBA_BLOCK)
        s_own = jnp.where(k_pos[None, :] <= q_pos[:, None], s_own, -jnp.inf)
        scores = jnp.concatenate(
            [s_sel.reshape(B, H, Q_CHUNK, kk * MOBA_BLOCK), s_own], axis=-1)
        p = jax.nn.softmax(scores, axis=-1)
        p_sel = p[..., :kk * MOBA_BLOCK].reshape(B, H, Q_CHUNK, kk, MOBA_BLOCK).astype(q.dtype)
        p_own = p[..., kk * MOBA_BLOCK:].astype(q.dtype)
        return (jnp.einsum('bhqkl,bhqkld->bhqd', p_sel, v_sel)
                + jnp.einsum('bhql,bhld->bhqd', p_own, v_own))

    out = lax.map(one_chunk, (jnp.arange(n_chunks), qc))
    return out.transpose(1, 0, 3, 2, 4).reshape(B, S, H * D)


def causal_depthwise_conv(u, w, b):
    C = u.shape[-1]
    y = lax.conv_general_dilated(
        u, w[:, None, :], window_strides=(1,), padding=[(CONV_KERNEL - 1, 0)],
        dimension_numbers=('NWC', 'WIO', 'NWC'), feature_group_count=C)
    return y + b


def hybrid_mixer(x, w_in, conv_dw_w, conv_dw_b, conv_ln_g, conv_ln_b, w_out, pos):
    B, S, _ = x.shape
    proj = x @ w_in
    q, k, v, glu_a, glu_g = jnp.split(
        proj, [ATTN_WIDTH, 2 * ATTN_WIDTH, 3 * ATTN_WIDTH, 3 * ATTN_WIDTH + CONV_WIDTH], axis=-1)
    q = rotary(q.reshape(B, S, N_ATTN_HEADS, HEAD_DIM), pos)
    k = rotary(k.reshape(B, S, N_ATTN_HEADS, HEAD_DIM), pos)
    v = v.reshape(B, S, N_ATTN_HEADS, HEAD_DIM)
    attn = moba_attention(q, k, v)
    u = glu_a * jax.nn.sigmoid(glu_g)
    u = causal_depthwise_conv(u, conv_dw_w, conv_dw_b)
    u = jax.nn.silu(layer_norm(u, conv_ln_g, conv_ln_b))
    return jnp.concatenate([attn, u], axis=-1) @ w_out


def swiglu(x, w_gate, w_up, w_down):
    return (jax.nn.silu(x @ w_gate) * (x @ w_up)) @ w_down


def moe_swiglu(x, router_w, e_gate, e_up, e_down):
    logits = (x @ router_w).astype(jnp.float32)
    top_vals, top_idx = lax.top_k(logits, TOP_K_EXPERTS)
    gates = jax.nn.softmax(top_vals, axis=-1)
    combine = jnp.sum(jax.nn.one_hot(top_idx, N_EXPERTS, dtype=jnp.float32)
                      * gates[..., None], axis=-2).astype(x.dtype)
    y = jnp.zeros_like(x)
    for e in range(N_EXPERTS):
        y = y + combine[..., e:e + 1] * swiglu(x, e_gate[e], e_up[e], e_down[e])
    return y


def setup_inputs(seed: int = 0) -> dict:
    key = jax.random.key(seed)
    ks = jax.random.split(key, 20)
    f32 = jnp.float32
    nrm = lambda k, shape, s: jax.random.normal(k, shape, f32) * s
    d_scale = D_MODEL ** -0.5
    col_scale = jnp.concatenate([
        jnp.ones((2 * ATTN_WIDTH,), f32),
        jnp.full((ATTN_WIDTH,), DEEPNORM_BETA, f32),
        jnp.ones((2 * CONV_WIDTH,), f32)])
    w_in = nrm(ks[1], (DEPTH, D_MODEL, IN_PROJ_WIDTH), d_scale) * col_scale
    return {
        "x": jax.random.normal(ks[0], (BATCH, SEQ, D_MODEL), f32),
        "w_in": w_in,
        "conv_dw_w": nrm(ks[2], (DEPTH, CONV_KERNEL, CONV_WIDTH), CONV_KERNEL ** -0.5),
        "conv_dw_b": nrm(ks[3], (DEPTH, CONV_WIDTH), 0.02),
        "conv_ln_g": 1.0 + nrm(ks[4], (DEPTH, CONV_WIDTH), 0.02),
        "conv_ln_b": nrm(ks[5], (DEPTH, CONV_WIDTH), 0.02),
        "w_out": nrm(ks[6], (DEPTH, MIX_WIDTH, D_MODEL), MIX_WIDTH ** -0.5 * DEEPNORM_BETA),
        "ln_mix_g": 1.0 + nrm(ks[7], (DEPTH, D_MODEL), 0.02),
        "ln_mix_b": nrm(ks[8], (DEPTH, D_MODEL), 0.02),
        "ln_ffn_g": 1.0 + nrm(ks[9], (DEPTH, D_MODEL), 0.02),
        "ln_ffn_b": nrm(ks[10], (DEPTH, D_MODEL), 0.02),
        "ffn_w_gate": nrm(ks[11], (N_DENSE, D_MODEL, D_FF), d_scale),
        "ffn_w_up": nrm(ks[12], (N_DENSE, D_MODEL, D_FF), d_scale),
        "ffn_w_down": nrm(ks[13], (N_DENSE, D_FF, D_MODEL), D_FF ** -0.5 * DEEPNORM_BETA),
        "router_w": nrm(ks[14], (N_MOE, D_MODEL, N_EXPERTS), d_scale),
        "expert_w_gate": nrm(ks[15], (N_MOE, N_EXPERTS, D_MODEL, D_FF), d_scale),
        "expert_w_up": nrm(ks[16], (N_MOE, N_EXPERTS, D_MODEL, D_FF), d_scale),
        "expert_w_down": nrm(ks[17], (N_MOE, N_EXPERTS, D_FF, D_MODEL), D_FF ** -0.5 * DEEPNORM_BETA),
    }


def reference(x, w_in, conv_dw_w, conv_dw_b, conv_ln_g, conv_ln_b, w_out,
              ln_mix_g, ln_mix_b, ln_ffn_g, ln_ffn_b,
              ffn_w_gate, ffn_w_up, ffn_w_down,
              router_w, expert_w_gate, expert_w_up, expert_w_down):
    S = x.shape[1]
    pos = jnp.arange(S, dtype=jnp.int32)
    h = x
    for l in range(DEPTH):
        mix = hybrid_mixer(h, w_in[l], conv_dw_w[l], conv_dw_b[l], conv_ln_g[l], conv_ln_b[l],
                           w_out[l], pos)
        h = layer_norm(DEEPNORM_ALPHA * h + mix, ln_mix_g[l], ln_mix_b[l])
        if l % 2 == 0:
            f = swiglu(h, ffn_w_gate[l // 2], ffn_w_up[l // 2], ffn_w_down[l // 2])
        else:
            f = moe_swiglu(h, router_w[l // 2], expert_w_gate[l // 2],
                           expert_w_up[l // 2], expert_w_down[l // 2])
        h = layer_norm(DEEPNORM_ALPHA * h + f, ln_ffn_g[l], ln_ffn_b[l])
    return h
```

```cpp
#include <hip/hip_runtime.h>
#include <cstdio>
#include <cstdint>
#include <cmath>
namespace pg8 {
#define PG8_LAS __attribute__((address_space(3)))
typedef unsigned short bf16_t;
typedef short bf16x8 __attribute__((ext_vector_type(8)));
typedef float f32x4 __attribute__((ext_vector_type(4)));
typedef unsigned u32x4 __attribute__((ext_vector_type(4)));
typedef unsigned u32x2 __attribute__((ext_vector_type(2)));
constexpr int BM = 256, BK = 64, HALF = 128, HTB = HALF * BK * 2  , STAGE_BYTES = 8 * HTB, NXCD = 8, WGM = 8;

__host__ __device__ __forceinline__ int lds_byte(int r, int c) { const int st = (r >> 4) * 2 + (c >> 5), rr = r & 15, cc = c & 31, ob = rr * 64 + cc * 2; return st * 1024 + (ob ^ (((ob >> 9) & 1) << 5)); }
__host__ __device__ __forceinline__ void stage_rc(int b, int& R, int& C) { const int st = b / 1024, sb = b % 1024, swz = sb ^ (((sb >> 9) & 1) << 5); R = (st >> 1) * 16 + swz / 64; C = (st & 1) * 32 + (swz % 64) / 2; }
__host__ __device__ __forceinline__ int perm32(int rho) { const int n = rho >> 4, i = rho & 15; return 8 * (i >> 2) + 4 * n + (i & 3); }

struct Unit { int pm, pn, e; };
struct Gemm { const bf16_t* A; const bf16_t* Bt; int M, N, K; size_t bstride; };

struct StaticOrder {
    int nM, nN, nwg, G, c;
    __host__ __device__ void init(int M, int N, int G_, int c_) { nM = M / BM; nN = N / BM; nwg = nM * nN; G = G_; c = c_; }
    __host__ __device__ bool next(int i, Unit& u) const {
        const long L = (long)i * G + c; if (L >= nwg) return false;
        int wgid = (int)L; { const int q = nwg / NXCD, r = nwg % NXCD, xcd = wgid % NXCD, off = wgid / NXCD; wgid = (xcd < r ? xcd * (q + 1) : r * (q + 1) + (xcd - r) * q) + off; }
        const int nig = WGM * nN, gid = wgid / nig, fm = gid * WGM, gsz = (nM - fm) < WGM ? (nM - fm) : WGM;
        u.pm = fm + ((wgid % nig) % gsz); u.pn = (wgid % nig) / gsz; u.e = 0; return true;
    }
    __device__ __forceinline__ void a_ready(const Unit&) const {}
    __device__ __forceinline__ void done(const Unit&) const {}
};
struct GroupedOrder : StaticOrder {
    int cum[8];
    __device__ bool next(int i, Unit& u) const {
        if (!StaticOrder::next(i, u)) return false;
        int e = 0;
#pragma unroll
        for (int j = 1; j < 8; ++j) e += (u.pm >= cum[j]) ? 1 : 0;
        u.e = e; return true;
    }
};

__device__ __forceinline__ unsigned cvt_pk_bf16(float lo, float hi) { unsigned r; asm volatile("v_cvt_pk_bf16_f32 %0, %1, %2" : "=v"(r) : "v"(lo), "v"(hi)); return r; }
__device__ __forceinline__ float sigmoidf_fast(float g) { return __builtin_amdgcn_rcpf(1.0f + __builtin_amdgcn_exp2f(-1.44269504089f * g)); }

struct EpiF32 {
    static constexpr bool PERM = false, AFTER_DRAIN = false;
    float* C; int ldc;
    __device__ __forceinline__ void operator()(const f32x4 (&acc)[2][2][4][2], const Unit& u, int wr, int wc, int fr, int fq) const {
        const int row0 = u.pm * BM + wr * 64 + fr, col0 = u.pn * BM + wc * 32 + 4 * fq;
#pragma unroll
        for (int ai = 0; ai < 2; ++ai)
#pragma unroll
            for (int m = 0; m < 4; ++m) { float* rowp = C + (size_t)(row0 + ai * HALF + m * 16) * ldc + col0;
#pragma unroll
                for (int bj = 0; bj < 2; ++bj)
#pragma unroll
                    for (int n = 0; n < 2; ++n) *(f32x4*)(rowp + bj * HALF + n * 16) = acc[ai][bj][m][n]; }
    }
};
struct EpiBf16 {
    static constexpr bool PERM = true, AFTER_DRAIN = false;
    bf16_t* O; int ldc;
    __device__ __forceinline__ void operator()(const f32x4 (&acc)[2][2][4][2], const Unit& u, int wr, int wc, int fr, int fq) const {
        const int row0 = u.pm * BM + wr * 64 + fr, col0 = u.pn * BM + wc * 32 + 8 * fq;
#pragma unroll
        for (int ai = 0; ai < 2; ++ai)
#pragma unroll
            for (int m = 0; m < 4; ++m) { bf16_t* rowp = O + (size_t)(row0 + ai * HALF + m * 16) * ldc + col0;
#pragma unroll
                for (int bj = 0; bj < 2; ++bj) { const f32x4 v0 = acc[ai][bj][m][0], v1 = acc[ai][bj][m][1];
                    u32x4 w; w.x = cvt_pk_bf16(v0[0], v0[1]); w.y = cvt_pk_bf16(v0[2], v0[3]); w.z = cvt_pk_bf16(v1[0], v1[1]); w.w = cvt_pk_bf16(v1[2], v1[3]);
                    *(u32x4*)(rowp + bj * HALF) = w; } }
    }
};
struct EpiSwiGLU {
    static constexpr bool PERM = true, AFTER_DRAIN = false;
    bf16_t* O; int ldc;
    __device__ __forceinline__ void operator()(const f32x4 (&acc)[2][2][4][2], const Unit& u, int wr, int wc, int fr, int fq) const {
        const int row0 = u.pm * BM + wr * 64 + fr, col0 = u.pn * HALF + wc * 32 + 8 * fq;
#pragma unroll
        for (int ai = 0; ai < 2; ++ai)
#pragma unroll
            for (int m = 0; m < 4; ++m) { bf16_t* rowp = O + (size_t)(row0 + ai * HALF + m * 16) * ldc + col0;
                float o[8];
#pragma unroll
                for (int n = 0; n < 2; ++n)
#pragma unroll
                    for (int j = 0; j < 4; ++j) { const float g = acc[ai][0][m][n][j], up = acc[ai][1][m][n][j]; o[n * 4 + j] = g * sigmoidf_fast(g) * up; }
                u32x4 w; w.x = cvt_pk_bf16(o[0], o[1]); w.y = cvt_pk_bf16(o[2], o[3]); w.z = cvt_pk_bf16(o[4], o[5]); w.w = cvt_pk_bf16(o[6], o[7]);
                *(u32x4*)rowp = w; }
    }
};
struct EpiInProj {
    static constexpr bool PERM = true, AFTER_DRAIN = false;
    bf16_t *Q, *Kb, *V, *U; const float *ropeC, *ropeS;
    __device__ __forceinline__ void operator()(const f32x4 (&acc)[2][2][4][2], const Unit& u, int wr, int wc, int fr, int fq) const {
        const int row0 = u.pm * BM + wr * 64 + fr;
        if (u.pn < 8) {
            bf16_t* base = (u.pn < 4) ? Q : Kb; const int col0 = (u.pn & 3) * BM + wc * 32 + 8 * fq, idx0 = 16 * wc + 4 * fq;
#pragma unroll
            for (int ai = 0; ai < 2; ++ai)
#pragma unroll
                for (int m = 0; m < 4; ++m) { const int row = row0 + ai * HALF + m * 16;
                    const f32x4 cs = *(const f32x4*)(ropeC + (size_t)row * 64 + idx0), sn = *(const f32x4*)(ropeS + (size_t)row * 64 + idx0);
#pragma unroll
                    for (int bj = 0; bj < 2; ++bj) { const f32x4 x1 = acc[ai][bj][m][0], x2 = acc[ai][bj][m][1];
                        const f32x4 o1 = x1 * cs - x2 * sn, o2 = x2 * cs + x1 * sn;
                        u32x4 w; w.x = cvt_pk_bf16(o1[0], o1[1]); w.y = cvt_pk_bf16(o1[2], o1[3]); w.z = cvt_pk_bf16(o2[0], o2[1]); w.w = cvt_pk_bf16(o2[2], o2[3]);
                        *(u32x4*)(base + (size_t)row * 1024 + col0 + bj * HALF) = w; } }
        } else if (u.pn < 12) {
            const int col0 = (u.pn - 8) * BM + wc * 32 + 8 * fq;
#pragma unroll
            for (int ai = 0; ai < 2; ++ai)
#pragma unroll
                for (int m = 0; m < 4; ++m) { bf16_t* rowp = V + (size_t)(row0 + ai * HALF + m * 16) * 1024 + col0;
#pragma unroll
                    for (int bj = 0; bj < 2; ++bj) { const f32x4 v0 = acc[ai][bj][m][0], v1 = acc[ai][bj][m][1];
                        u32x4 w; w.x = cvt_pk_bf16(v0[0], v0[1]); w.y = cvt_pk_bf16(v0[2], v0[3]); w.z = cvt_pk_bf16(v1[0], v1[1]); w.w = cvt_pk_bf16(v1[2], v1[3]);
                        *(u32x4*)(rowp + bj * HALF) = w; } }
        } else {
            const int col0 = (u.pn - 12) * HALF + wc * 32 + 8 * fq;
#pragma unroll
            for (int ai = 0; ai < 2; ++ai)
#pragma unroll
                for (int m = 0; m < 4; ++m) { bf16_t* rowp = U + (size_t)(row0 + ai * HALF + m * 16) * 1024 + col0;
                    float o[8];
#pragma unroll
                    for (int n = 0; n < 2; ++n)
#pragma unroll
                        for (int j = 0; j < 4; ++j) o[n * 4 + j] = acc[ai][0][m][n][j] * sigmoidf_fast(acc[ai][1][m][n][j]);
                    u32x4 w; w.x = cvt_pk_bf16(o[0], o[1]); w.y = cvt_pk_bf16(o[2], o[3]); w.z = cvt_pk_bf16(o[4], o[5]); w.w = cvt_pk_bf16(o[6], o[7]);
                    *(u32x4*)rowp = w; }
        }
    }
};

template <class Epi, class Sched, bool ALIGN_EPI = false, bool SP2 = false>
__device__ __forceinline__ void gemm_phase(PG8_LAS unsigned char* lds, const Gemm g, const Sched& S, const Epi& E, const int wave_in) {
    int lane; asm volatile("v_mbcnt_lo_u32_b32 %0, -1, 0\n\tv_mbcnt_hi_u32_b32 %0, -1, %0" : "=v"(lane));
    const int wid = wave_in, tid = wid * 64 + lane, wr = wid >> 2, wc = wid & 3, fr = lane & 15, fq = lane >> 4;
    const int K = g.K, nt = K / BK;
    unsigned voffA[2], voffB[2];
#pragma unroll
    for (int i = 0; i < 2; ++i) { int R, C; stage_rc(tid * 16 + i * 8192, R, C); const int Rb = Epi::PERM ? ((R & ~31) + perm32(R & 31)) : R;
        voffA[i] = (unsigned)(R * K + C) * 2u; voffB[i] = (unsigned)(Rb * K + C) * 2u; }
    const size_t kstep = (size_t)(BK * 2);
    const size_t hstep = (size_t)HALF * K * 2;
    const size_t tstep = 2 * hstep;
    const unsigned ldsw = (unsigned)wid * 1024u;
    const int aoff = lds_byte(wr * 64 + fr, fq * 8), boff = lds_byte(wc * 32 + fr, fq * 8);
#define PG8_SA(b, h) (((b) * 2 + (h)) * HTB)
#define PG8_SB(b, h) ((4 + (b) * 2 + (h)) * HTB)
#define PG8_STAGE(bufoff, gbase, voff) do { _Pragma("unroll") for (int _i = 0; _i < 2; ++_i) \
        __builtin_amdgcn_global_load_lds((const unsigned*)((const char*)(gbase) + (voff)[_i]), (PG8_LAS unsigned*)(lds + (bufoff) + ldsw + _i * 8192), 16, 0, 0); } while (0)
#define PG8_LDA(dst, b, h) do { _Pragma("unroll") for (int m = 0; m < 4; ++m) _Pragma("unroll") for (int k = 0; k < 2; ++k) dst[m][k] = *(const PG8_LAS bf16x8*)(lds + PG8_SA(b, h) + aoff + m * 2048 + k * 1024); } while (0)
#define PG8_LDB(dst, b, h) do { _Pragma("unroll") for (int n = 0; n < 2; ++n) _Pragma("unroll") for (int k = 0; k < 2; ++k) dst[n][k] = *(const PG8_LAS bf16x8*)(lds + PG8_SB(b, h) + boff + n * 2048 + k * 1024); } while (0)
#define PG8_MMA(ai, bj, At, Bt) do { __builtin_amdgcn_s_setprio(1); _Pragma("unroll") for (int m = 0; m < 4; ++m) _Pragma("unroll") for (int n = 0; n < 2; ++n) _Pragma("unroll") for (int k = 0; k < 2; ++k) \
        acc[ai][bj][m][n] = __builtin_amdgcn_mfma_f32_16x16x32_bf16(Bt[n][k], At[m][k], acc[ai][bj][m][n], 0, 0, 0); __builtin_amdgcn_s_setprio(0); } while (0)
#define PG8_WAIT_V(n) asm volatile("s_waitcnt vmcnt(" #n ")" ::: "memory")
#define PG8_WAIT_L(n) asm volatile("s_waitcnt lgkmcnt(" #n ")" ::: "memory")
#define PG8_BAR __builtin_amdgcn_s_barrier()
#define PG8_SCHED __builtin_amdgcn_sched_barrier(0)
    Unit cur, nxt; int ui = 0;
    if (!S.next(0, cur)) return;
    f32x4 acc[2][2][4][2];
#pragma unroll
    for (int a = 0; a < 2; ++a)
#pragma unroll
        for (int b = 0; b < 2; ++b)
#pragma unroll
            for (int m = 0; m < 4; ++m)
#pragma unroll
                for (int n = 0; n < 2; ++n) acc[a][b][m][n] = (f32x4){0.f, 0.f, 0.f, 0.f};
    bf16x8 At[4][2], B0[2][2], B1[2][2];
    const char* cA = (const char*)g.A + (size_t)cur.pm * tstep; const char* cB = (const char*)g.Bt + (size_t)cur.e * g.bstride + (size_t)cur.pn * tstep;
    S.a_ready(cur);
    if constexpr (SP2) {
        PG8_STAGE(PG8_SB(0, 0), cB, voffB); PG8_STAGE(PG8_SB(0, 1), cB + hstep, voffB); PG8_STAGE(PG8_SA(0, 0), cA, voffA); PG8_STAGE(PG8_SA(0, 1), cA + hstep, voffA);
        if (wr == 1) PG8_BAR;
        PG8_WAIT_V(2); PG8_BAR;
        PG8_STAGE(PG8_SB(1, 0), cB + kstep, voffB); PG8_STAGE(PG8_SA(1, 0), cA + kstep, voffA); PG8_STAGE(PG8_SB(1, 1), cB + hstep + kstep, voffB);
        PG8_WAIT_V(6); PG8_BAR;
    } else {
        PG8_STAGE(PG8_SB(0, 0), cB, voffB); PG8_STAGE(PG8_SA(0, 0), cA, voffA); PG8_STAGE(PG8_SB(0, 1), cB + hstep, voffB); PG8_STAGE(PG8_SA(0, 1), cA + hstep, voffA);
        if (wr == 1) PG8_BAR;
        PG8_WAIT_V(4); PG8_BAR;
        PG8_STAGE(PG8_SB(1, 0), cB + kstep, voffB); PG8_STAGE(PG8_SA(1, 0), cA + kstep, voffA); PG8_STAGE(PG8_SB(1, 1), cB + hstep + kstep, voffB);
        PG8_WAIT_V(6); PG8_BAR;
    }
    for (;;) {
        const bool has_next = S.next(ui + 1, nxt);
        const char* nA = has_next ? (const char*)g.A + (size_t)nxt.pm * tstep : cA; const char* nB = has_next ? (const char*)g.Bt + (size_t)nxt.e * g.bstride + (size_t)nxt.pn * tstep : cB;
        for (int t = 0; t < nt; t += 2) {
            const bool last = (t == nt - 2);
            const char* a1 = cA + (size_t)(t + 1) * kstep;
            const char* a2 = last ? nA : cA + (size_t)(t + 2) * kstep; const char* b2 = last ? nB : cB + (size_t)(t + 2) * kstep;
            const char* a3 = a2 + kstep; const char* b3 = b2 + kstep;
            if (last && has_next) S.a_ready(nxt);
            if constexpr (SP2) {
            PG8_LDB(B0, 0, 0); PG8_LDB(B1, 0, 1); PG8_SCHED; PG8_LDA(At, 0, 0); PG8_STAGE(PG8_SA(1, 1), a1 + hstep, voffA);
            PG8_WAIT_V(8); PG8_WAIT_L(0); PG8_BAR; PG8_MMA(0, 0, At, B0); PG8_MMA(0, 1, At, B1); PG8_BAR; PG8_SCHED;
            PG8_LDA(At, 0, 1); PG8_STAGE(PG8_SB(0, 0), b2, voffB); PG8_STAGE(PG8_SB(0, 1), b2 + hstep, voffB); PG8_STAGE(PG8_SA(0, 0), a2, voffA);
            PG8_WAIT_V(8); PG8_WAIT_L(0); PG8_BAR; PG8_MMA(1, 0, At, B0); PG8_MMA(1, 1, At, B1); PG8_BAR; PG8_SCHED;
            PG8_LDB(B0, 1, 0); PG8_LDB(B1, 1, 1); PG8_SCHED; PG8_LDA(At, 1, 0); PG8_STAGE(PG8_SA(0, 1), a2 + hstep, voffA);
            PG8_WAIT_V(8); PG8_WAIT_L(0); PG8_BAR; PG8_MMA(0, 0, At, B0); PG8_MMA(0, 1, At, B1); PG8_BAR; PG8_SCHED;
            PG8_LDA(At, 1, 1); PG8_STAGE(PG8_SB(1, 0), b3, voffB); PG8_STAGE(PG8_SB(1, 1), b3 + hstep, voffB); PG8_STAGE(PG8_SA(1, 0), a3, voffA);
            PG8_WAIT_V(8); PG8_WAIT_L(0); PG8_BAR; PG8_MMA(1, 0, At, B0); PG8_MMA(1, 1, At, B1); PG8_BAR; PG8_SCHED;
            } else {
            PG8_LDB(B0, 0, 0); PG8_SCHED; PG8_LDA(At, 0, 0); PG8_STAGE(PG8_SA(1, 1), a1 + hstep, voffA);
            PG8_WAIT_L(8); PG8_BAR; PG8_WAIT_L(0); PG8_MMA(0, 0, At, B0); PG8_BAR; PG8_SCHED;
            PG8_LDB(B1, 0, 1); PG8_STAGE(PG8_SB(0, 0), b2, voffB);
            PG8_BAR; PG8_WAIT_L(0); PG8_MMA(0, 1, At, B1); PG8_BAR;
            PG8_LDA(At, 0, 1); PG8_STAGE(PG8_SA(0, 0), a2, voffA);
            PG8_BAR; PG8_WAIT_L(0); PG8_MMA(1, 0, At, B0); PG8_BAR; PG8_SCHED;
            PG8_STAGE(PG8_SB(0, 1), b2 + hstep, voffB);
            PG8_WAIT_V(6); PG8_BAR; PG8_MMA(1, 1, At, B1); PG8_BAR;
            PG8_LDB(B0, 1, 0); PG8_SCHED; PG8_LDA(At, 1, 0); PG8_STAGE(PG8_SA(0, 1), a2 + hstep, voffA);
            PG8_WAIT_L(8); PG8_BAR; PG8_WAIT_L(0); PG8_MMA(0, 0, At, B0); PG8_BAR; PG8_SCHED;
            PG8_LDB(B1, 1, 1); PG8_STAGE(PG8_SB(1, 0), b3, voffB);
            PG8_BAR; PG8_WAIT_L(0); PG8_MMA(0, 1, At, B1); PG8_BAR;
            PG8_LDA(At, 1, 1); PG8_STAGE(PG8_SA(1, 0), a3, voffA);
            PG8_BAR; PG8_WAIT_L(0); PG8_MMA(1, 0, At, B0); PG8_BAR; PG8_SCHED;
            PG8_STAGE(PG8_SB(1, 1), b3 + hstep, voffB);
            PG8_WAIT_V(6); PG8_BAR; PG8_MMA(1, 1, At, B1); PG8_BAR;
            }
        }
        if constexpr (ALIGN_EPI) { if (wr == 0) PG8_BAR; }
        if constexpr (!Epi::AFTER_DRAIN) { E(acc, cur, wr, wc, fr, fq); S.done(cur); }
        if (!has_next) break;
#pragma unroll
        for (int a = 0; a < 2; ++a)
#pragma unroll
            for (int b = 0; b < 2; ++b)
#pragma unroll
                for (int m = 0; m < 4; ++m)
#pragma unroll
                    for (int n = 0; n < 2; ++n) acc[a][b][m][n] = (f32x4){0.f, 0.f, 0.f, 0.f};
        cur = nxt; cA = nA; cB = nB; ++ui;
        if constexpr (ALIGN_EPI) { if (wr == 1) PG8_BAR; }
    }
    PG8_WAIT_V(0);
    if constexpr (!ALIGN_EPI) { if (wr == 0) PG8_BAR; }
    PG8_BAR;
    if constexpr (Epi::AFTER_DRAIN) { E.fused(acc, cur, wr, wc, fr, fq, lds, wid, lane); S.done(cur); }
#undef PG8_SA
#undef PG8_SB
#undef PG8_STAGE
#undef PG8_LDA
#undef PG8_LDB
#undef PG8_MMA
#undef PG8_WAIT_V
#undef PG8_WAIT_L
#undef PG8_BAR
#undef PG8_SCHED
}
}

constexpr int NWAVES = 8;
constexpr int S = 16384, DM = 2048, NPROJ = 5120, AW = 1024, HD = 128, NH = 8, DFF = 5632, NE = 8, CKW = 31, NBLK = 64;
constexpr float LN_EPS = 1e-5f, ALPHA = 1.41421356237309515f;
constexpr int MOE_ROWS = 2 * S + NE * 256;

constexpr size_t MiB = 1u << 20;
constexpr size_t WS_CTL = 0, CTL_ZERO_BYTES = 1 * MiB;
constexpr size_t WS_ROPEC = 1 * MiB, WS_ROPES = 5 * MiB;
constexpr size_t WS_KMEAN = 9 * MiB;
constexpr size_t WS_EIDX = 9 * MiB + 512 * 1024, WS_GATEW = WS_EIDX + 128 * 1024, WS_ROWPOS = WS_GATEW + 128 * 1024;
constexpr size_t WS_WIN = 10 * MiB, WS_WOUT = 50 * MiB, WS_WGU0 = 66 * MiB, WS_WD0 = 110 * MiB, WS_WGUE = 132 * MiB, WS_WDE = 484 * MiB;
constexpr size_t WS_HB = 660 * MiB;
constexpr size_t WS_R2 = 724 * MiB;
constexpr size_t WS_HBP = 860 * MiB;
constexpr size_t WS_R1 = 996 * MiB;
constexpr size_t WS_Q = WS_R1, WS_K = WS_R1 + 32 * MiB, WS_V = WS_R1 + 64 * MiB, WS_U = WS_R1 + 96 * MiB, WS_CAT = WS_R1 + 128 * MiB, WS_ACT = WS_R1;
constexpr size_t WS_END = 1370 * MiB;
static_assert(WS_R1 + (size_t)MOE_ROWS * DFF * 2 <= WS_END && WS_HBP + (size_t)MOE_ROWS * DM * 2 <= WS_R1 && WS_R2 + (size_t)MOE_ROWS * DM * 2 <= WS_HBP, "d_ws map");
static_assert(WS_WDE + (size_t)NE * DM * DFF * 2 <= WS_HB && WS_WGUE + (size_t)NE * 2 * DFF * DM * 2 <= WS_WDE, "d_ws weights map");
constexpr int CW_TMO = 0, CW_CODE = 1, CW_BAR = 4096, CW_ECNT = 8192, CW_ECUR = 8192 + 64 * 8;
constexpr int RING_OFF = 0, RING_BYTES = 131072;
constexpr int LDSCTL_OFF = RING_BYTES, MISC_OFF = LDSCTL_OFF + 320;
constexpr int LDS_BYTES = 147456;

__device__ const float INV_FREQ[64] = {
1.000000000e+00f, 8.659643531e-01f, 7.498942018e-01f, 6.493816376e-01f, 5.623413324e-01f, 4.869675338e-01f, 4.216965139e-01f, 3.651741147e-01f, 3.162277639e-01f, 2.738419771e-01f, 2.371373773e-01f, 2.053525001e-01f, 1.778279394e-01f, 1.539926529e-01f, 1.333521456e-01f, 1.154781953e-01f, 1.000000015e-01f, 8.659642935e-02f, 7.498942316e-02f, 6.493816525e-02f, 5.623413250e-02f, 4.869675264e-02f, 4.216964915e-02f, 3.651741147e-02f, 3.162277490e-02f, 2.738419548e-02f, 2.371373773e-02f, 2.053525113e-02f, 1.778279431e-02f, 1.539926510e-02f, 1.333521400e-02f, 1.154781971e-02f, 9.999999776e-03f, 8.659643121e-03f, 7.498942316e-03f, 6.493816152e-03f, 5.623413250e-03f, 4.869675264e-03f, 4.216964822e-03f, 3.651741194e-03f, 3.162277630e-03f, 2.738419687e-03f, 2.371373819e-03f, 2.053525066e-03f, 1.778279431e-03f, 1.539926510e-03f, 1.333521446e-03f, 1.154782018e-03f, 1.000000047e-03f, 8.659643354e-04f, 7.498941850e-04f, 6.493816036e-04f, 5.623413017e-04f, 4.869675322e-04f, 4.216965172e-04f, 3.651741135e-04f, 3.162277571e-04f, 2.738419571e-04f, 2.371373703e-04f, 2.053525095e-04f, 1.778279402e-04f, 1.539926598e-04f, 1.333521504e-04f, 1.154782003e-04f
};

#define GAS __attribute__((address_space(1)))
#define LAS __attribute__((address_space(3)))
typedef unsigned short bf16;
typedef unsigned v4u __attribute__((ext_vector_type(4)));
typedef unsigned v2u __attribute__((ext_vector_type(2)));
typedef float f32x4 __attribute__((ext_vector_type(4)));
typedef float f32x2 __attribute__((ext_vector_type(2)));
typedef short bf16x8 __attribute__((ext_vector_type(8)));
typedef GAS unsigned gu32;
typedef GAS unsigned long long gu64;
#define RLX_AGENT __ATOMIC_RELAXED, __HIP_MEMORY_SCOPE_AGENT
#define LDS_WAIT() asm volatile("s_waitcnt lgkmcnt(0)" ::: "memory")
#define VM_WAIT() asm volatile("s_waitcnt vmcnt(0)" ::: "memory")
__device__ __forceinline__ unsigned f2bf(float f) { unsigned u = __builtin_bit_cast(unsigned, f); return (u + 0x7fffu + ((u >> 16) & 1u)) >> 16; }
__device__ __forceinline__ unsigned pk2(float lo, float hi) { return f2bf(lo) | (f2bf(hi) << 16); }
__device__ __forceinline__ float bflo(unsigned w) { return __builtin_bit_cast(float, w << 16); }
__device__ __forceinline__ float bfhi(unsigned w) { return __builtin_bit_cast(float, w & 0xffff0000u); }

#define XB_TMO      128
#define XB_XCNT(j)  (256  + 64 * (j))
#define XB_XSUB(j)  (1280 + 64 * (j))
#define XB_XGEN(j)  (2304 + 64 * (j))
#define XB_TOP      3328
#define XB_TOPGEN   3392
#define XCD_BAR_WORDS 3456
#define XB_SPIN_CAP (1u << 22)

__device__ __forceinline__ unsigned xb_ld(unsigned* p)              { return __hip_atomic_load(p, __ATOMIC_RELAXED, __HIP_MEMORY_SCOPE_AGENT); }
__device__ __forceinline__ unsigned xb_add(unsigned* p, unsigned v) { return __hip_atomic_fetch_add(p, v, __ATOMIC_RELAXED, __HIP_MEMORY_SCOPE_AGENT); }
__device__ __forceinline__ unsigned xb_xcc_id() { return (unsigned)__builtin_amdgcn_s_getreg((3 << 11) | 20) & 0xFu; }
#define XB_SPIN(cond, bar) do { unsigned _sp = 0; while (cond) { __builtin_amdgcn_s_sleep(1); \
    if ((++_sp & 255u) == 0u) { if (xb_ld(&(bar)[XB_TMO])) break; if (_sp > XB_SPIN_CAP) { atomicAdd(&(bar)[XB_TMO], 1u); break; } } } } while (0)

__device__ __forceinline__ int lane_now() { int l; asm volatile("v_mbcnt_lo_u32_b32 %0, -1, 0\n\tv_mbcnt_hi_u32_b32 %0, -1, %0" : "=v"(l)); return l; }
#define XB_T0() (b.w0 == 0 && lane_now() == 0)
struct XcdBarrier {
    unsigned* bar; unsigned x; int w0;
    volatile LAS unsigned* st;
};

__device__ __forceinline__ XcdBarrier xcd_barrier_post(unsigned* bar, volatile LAS unsigned* st, int w0) {
    XcdBarrier b; b.bar = bar; b.x = xb_xcc_id(); b.st = st; b.w0 = w0;
    if (XB_T0()) (void)xb_add(&bar[XB_XCNT(b.x)], 1u);
    return b;
}
__device__ __forceinline__ void xcd_barrier_complete(unsigned* bar, unsigned x, unsigned& nloc, unsigned& nx) {
    const unsigned G = gridDim.x * gridDim.y * gridDim.z;
    unsigned sum, cnt, mine, sp = 0u;
    for (;;) {
        sum = 0u; cnt = 0u; mine = 0u;
#pragma unroll
        for (unsigned j = 0; j < 16; ++j) { const unsigned c = xb_ld(&bar[XB_XCNT(j)]); sum += c; cnt += (c > 0u) ? 1u : 0u; mine = (j == x) ? c : mine; }
        if (sum == G) break;
        __builtin_amdgcn_s_sleep(1);
        if ((++sp & 255u) == 0u) { if (xb_ld(&bar[XB_TMO])) break; if (sp > XB_SPIN_CAP) { atomicAdd(&bar[XB_TMO], 1u); break; } }
    }
    nloc = mine > 0u ? mine : 1u; nx = cnt > 0u ? cnt : 1u;
}

__device__ __forceinline__ void xcd_barrier(const XcdBarrier& b) {
    asm volatile("s_waitcnt vmcnt(0)" ::: "memory");
    __syncthreads();
    if (XB_T0()) {
        unsigned* bar = b.bar;
        __builtin_amdgcn_s_waitcnt(0);
        unsigned nloc = b.st[0], nx = b.st[1];
        if (nloc == 0u) { xcd_barrier_complete(bar, b.x, nloc, nx); b.st[0] = nloc; b.st[1] = nx; }
        const unsigned old = xb_add(&bar[XB_XSUB(b.x)], 1u);
        const unsigned gen = old / nloc;
        if (old + 1u == (gen + 1u) * nloc) {
            __builtin_amdgcn_fence(__ATOMIC_RELEASE, "agent");
            asm volatile("s_waitcnt vmcnt(0)" ::: "memory");
            const unsigned og = xb_add(&bar[XB_TOP], 1u);
            const unsigned tg = og / nx;
            if (og + 1u == (tg + 1u) * nx) xb_add(&bar[XB_TOPGEN], 1u);
            else XB_SPIN(xb_ld(&bar[XB_TOPGEN]) == tg, bar);
            __builtin_amdgcn_fence(__ATOMIC_ACQUIRE, "agent");
            xb_add(&bar[XB_XGEN(b.x)], 1u);
            asm volatile("s_waitcnt vmcnt(0)" ::: "memory");
        } else {
            XB_SPIN(xb_ld(&bar[XB_XGEN(b.x)]) == gen, bar);
            __builtin_amdgcn_fence(__ATOMIC_ACQUIRE, "agent");
            asm volatile("s_waitcnt vmcnt(0)" ::: "memory");
        }
    }
    __syncthreads();
}


struct Frame {
    LAS unsigned char* lds;
    volatile LAS unsigned* MISC;
    gu32* ctl;
    int wave;
    int vcu, G;
    const float* x; float* out;
    const float *w_in, *conv_w, *conv_b, *conv_g, *conv_be, *w_out, *lnm_g, *lnm_b, *lnf_g, *lnf_b, *fg, *fu, *fd, *router, *eg, *eu, *ed;
    unsigned char* ws;
};
__device__ __forceinline__ float wave_sum(float v) {
#pragma unroll
    for (int o = 1; o < 64; o <<= 1) v += __shfl_xor(v, o);
    return v;
}
__device__ __forceinline__ float wave_max(float v) {
#pragma unroll
    for (int o = 1; o < 64; o <<= 1) v = fmaxf(v, __shfl_xor(v, o));
    return v;
}
__device__ __forceinline__ int wmap(int kind, int c) {
    if (kind == 0) return c;
    if (kind == 1) {
        if (c < 2048) { const int hh = c >> 7, w = c & 127, n = w >> 6, idx = w & 63; return hh * 128 + 32 * (idx >> 4) + 8 * ((idx >> 2) & 3) + 4 * n + (idx & 3); }
        if (c < 3072) return c;
        if (c < 4096) { const int j = c - 3072; return 3072 + 256 * (j >> 7) + (j & 127); }
        const int j = c - 4096; return 3072 + 256 * (j >> 7) + 128 + (j & 127);
    }
    return 256 * (c >> 7) + (kind == 3 ? 128 : 0) + (c & 127);
}
__device__ __forceinline__ void p0_transpose_item(const float* Wg, int K, int N, bf16* WT, int kind, LAS float* scr, int item, int lane) {
    const GAS float* W = (const GAS float*)Wg;
    const int nblk = N / 32, kb = item / nblk, nb = item % nblk, k0 = 64 * kb, n0 = 32 * nb;
#pragma unroll 8
    for (int i = 0; i < 32; ++i) { const int kk = 2 * i + (lane >> 5); scr[kk * 33 + (lane & 31)] = W[(size_t)(k0 + kk) * N + n0 + (lane & 31)]; }
    LDS_WAIT(); asm volatile("" ::: "memory");
    const int c = lane & 7;
#pragma unroll
    for (int j = 0; j < 4; ++j) { const int n = (lane >> 3) + 8 * j; const LAS float* s = scr + (8 * c) * 33 + n;
        v4u o; o.x = pk2(s[0 * 33], s[1 * 33]); o.y = pk2(s[2 * 33], s[3 * 33]); o.z = pk2(s[4 * 33], s[5 * 33]); o.w = pk2(s[6 * 33], s[7 * 33]);
        *(GAS v4u*)(WT + (size_t)wmap(kind, n0 + n) * K + k0 + 8 * c) = o; }
    LDS_WAIT(); asm volatile("" ::: "memory");
}
__device__ __forceinline__ void sincos_acc(float ang, float& sn, float& cs) {
    const double x = (double)ang, k = __builtin_rint(x * 0.63661977236758134308);
    double r = __builtin_fma(-k, 1.57079632679489655800e+00, x); r = __builtin_fma(-k, 6.12323399573676603587e-17, r);
    const int q = ((int)k) & 3; const double r2 = r * r;
    double sp = 1.0 / 6227020800.0; sp = sp * r2 - 1.0 / 39916800.0; sp = sp * r2 + 1.0 / 362880.0; sp = sp * r2 - 1.0 / 5040.0; sp = sp * r2 + 1.0 / 120.0; sp = sp * r2 - 1.0 / 6.0;
    const double s = r + r * r2 * sp;
    double cp = -1.0 / 87178291200.0; cp = cp * r2 + 1.0 / 479001600.0; cp = cp * r2 - 1.0 / 3628800.0; cp = cp * r2 + 1.0 / 40320.0; cp = cp * r2 - 1.0 / 720.0; cp = cp * r2 + 1.0 / 24.0; cp = cp * r2 - 0.5;
    const double c = 1.0 + r2 * cp;
    const double ss = (q & 1) ? c : s, cc = (q & 1) ? s : c;
    sn = (float)((q & 2) ? -ss : ss); cs = (float)(((q + 1) & 2) ? -cc : cc);
}
__device__ __forceinline__ void p0_transpose_stack(Frame& F, const float* src, int K, int N, int nmat, bf16* dst, size_t dst_stride, int kind) {
    LAS float* scr = (LAS float*)(F.lds + RING_OFF + F.wave * 16384);
    const int gw = F.vcu * NWAVES + F.wave, NGW = F.G * NWAVES, per = (K / 64) * (N / 32), total = per * nmat, lane = lane_now();
#pragma clang loop unroll(disable)
    for (int it = gw; it < total; it += NGW) { const int m = it / per, r = it - m * per;
        p0_transpose_item(src + (size_t)m * K * N, K, N, dst + (size_t)m * dst_stride, kind, scr, r, lane); }
}
__device__ __forceinline__ void p0_prologue(Frame& F) {
    p0_transpose_stack(F, F.w_in, DM, NPROJ, 2, (bf16*)(F.ws + WS_WIN), (size_t)NPROJ * DM, 1);
    p0_transpose_stack(F, F.w_out, DM, DM, 2, (bf16*)(F.ws + WS_WOUT), (size_t)DM * DM, 0);
    p0_transpose_stack(F, F.fg, DM, DFF, 1, (bf16*)(F.ws + WS_WGU0), 0, 2);
    p0_transpose_stack(F, F.fu, DM, DFF, 1, (bf16*)(F.ws + WS_WGU0), 0, 3);
    p0_transpose_stack(F, F.fd, DFF, DM, 1, (bf16*)(F.ws + WS_WD0), 0, 0);
    p0_transpose_stack(F, F.eg, DM, DFF, NE, (bf16*)(F.ws + WS_WGUE), (size_t)2 * DFF * DM, 2);
    p0_transpose_stack(F, F.eu, DM, DFF, NE, (bf16*)(F.ws + WS_WGUE), (size_t)2 * DFF * DM, 3);
    p0_transpose_stack(F, F.ed, DFF, DM, NE, (bf16*)(F.ws + WS_WDE), (size_t)DM * DFF, 0);
    { GAS float* rc = (GAS float*)(F.ws + WS_ROPEC); GAS float* rs = (GAS float*)(F.ws + WS_ROPES);
#pragma clang loop unroll(disable)
      for (int i = (F.vcu * NWAVES + F.wave) * 64 + lane_now(); i < S * 64; i += F.G * NWAVES * 64) { const int t = i >> 6, f = i & 63; const float ang = (float)t * INV_FREQ[f]; float sn, cs; sincos_acc(ang, sn, cs); rc[i] = cs; rs[i] = sn; } }
    { const GAS f32x4* xs = (const GAS f32x4*)F.x; GAS v4u* hb = (GAS v4u*)(F.ws + WS_HB);
#pragma clang loop unroll(disable)
      for (int i = (F.vcu * NWAVES + F.wave) * 64 + lane_now(); i < S * DM / 8; i += F.G * NWAVES * 64) { const f32x4 a = xs[2 * i], b = xs[2 * i + 1]; v4u o; o.x = pk2(a[0], a[1]); o.y = pk2(a[2], a[3]); o.z = pk2(b[0], b[1]); o.w = pk2(b[2], b[3]); hb[i] = o; } }
}

__device__ __forceinline__ void kmean_phase(Frame& F) {
    const int gw = F.vcu * NWAVES + F.wave, NGW = F.G * NWAVES, lane = lane_now();
#pragma clang loop unroll(disable)
    for (int unit = gw; unit < NH * NBLK; unit += NGW) { const int j = unit & 63, h = unit >> 6;
        const GAS unsigned* kp = (const GAS unsigned*)(F.ws + WS_K) + ((size_t)(j * 256) * 1024 + h * 128) / 2 + lane;
        float a0 = 0.f, a1 = 0.f;
#pragma unroll 8
        for (int r = 0; r < 256; ++r) { const unsigned w = kp[(size_t)r * 512]; a0 += bflo(w); a1 += bfhi(w); }
        GAS f32x2* km = (GAS f32x2*)(F.ws + WS_KMEAN) + ((size_t)(h * 64 + j) * 128) / 2 + lane;
        *km = (f32x2){a0 * (1.f / 256.f), a1 * (1.f / 256.f)}; }
}

constexpr int CT = 16, CROWS = CT + 30;
__device__ __forceinline__ void conv_phase(Frame& F, int l) {
    LAS unsigned* ub = (LAS unsigned*)(F.lds + RING_OFF);
    LAS f32x2* part = (LAS f32x2*)(F.lds + RING_OFF + CROWS * 2048);
    const int lane = lane_now(), tid = F.wave * 64 + lane;
    const GAS f32x2* cw = (const GAS f32x2*)(F.conv_w + (size_t)l * CKW * 1024) + tid;
    float w0[CKW], w1[CKW];
#pragma unroll
    for (int k = 0; k < CKW; ++k) { const f32x2 w = cw[k * 512]; w0[k] = w.x; w1[k] = w.y; }
    const f32x2 cb = ((const GAS f32x2*)(F.conv_b + l * 1024))[tid], lg = ((const GAS f32x2*)(F.conv_g + l * 1024))[tid], lb = ((const GAS f32x2*)(F.conv_be + l * 1024))[tid];
    const GAS v4u* U = (const GAS v4u*)(F.ws + WS_U);
    GAS unsigned* CAT = (GAS unsigned*)(F.ws + WS_CAT);
#pragma clang loop unroll(disable)
    for (int unit = blockIdx.x; unit < S / CT; unit += F.G) { const int t0 = unit * CT;
#pragma clang loop unroll(disable)
        for (int i = tid; i < CROWS * 128; i += NWAVES * 64) { const int r = i >> 7, c16 = i & 127, tok = t0 - 30 + r;
            v4u v = (v4u){0u, 0u, 0u, 0u}; if (tok >= 0) v = U[(size_t)tok * 128 + c16];
            *(LAS v4u*)(ub + r * 512 + c16 * 4) = v; }
        __syncthreads();
        float a0[CT], a1[CT];
#pragma unroll
        for (int t = 0; t < CT; ++t) { a0[t] = cb.x; a1[t] = cb.y; }
#pragma unroll
        for (int r = 0; r < CROWS; ++r) { const unsigned w = ub[r * 512 + tid]; const float x0 = bflo(w), x1 = bfhi(w);
#pragma unroll
            for (int t = 0; t < CT; ++t) { if (r - t >= 0 && r - t <= 30) { a0[t] += w0[r - t] * x0; a1[t] += w1[r - t] * x1; } } }
#pragma unroll
        for (int t = 0; t < CT; ++t) { float s = a0[t] + a1[t], q = a0[t] * a0[t] + a1[t] * a1[t]; s = wave_sum(s); q = wave_sum(q); if (lane == 0) part[F.wave * CT + t] = (f32x2){s, q}; }
        __syncthreads();
#pragma unroll
        for (int t = 0; t < CT; ++t) { float s = 0.f, q = 0.f;
#pragma unroll
            for (int w = 0; w < 8; ++w) { const f32x2 p = part[w * CT + t]; s += p.x; q += p.y; }
            const float mean = s * (1.f / 1024.f), var = fmaxf(q * (1.f / 1024.f) - mean * mean, 0.f), rstd = 1.0f / sqrtf(var + LN_EPS);
            const float y0 = (a0[t] - mean) * rstd * lg.x + lb.x, y1 = (a1[t] - mean) * rstd * lg.y + lb.y;
            CAT[((size_t)(t0 + t) * DM + 1024) / 2 + tid] = pk2(y0 * pg8::sigmoidf_fast(y0), y1 * pg8::sigmoidf_fast(y1)); }
        __syncthreads();
    }
}

__device__ __forceinline__ void attn_naive_phase(Frame& F) {
    LAS float* qs = (LAS float*)(F.lds + RING_OFF + F.wave * 4608);
    LAS float* ps = qs + 128;
    const int gw = F.vcu * NWAVES + F.wave, NGW = F.G * NWAVES, lane = lane_now();
    const float scale = 0.08838834764831845f, NEG = -__builtin_inff();
    const bf16* Q = (const bf16*)(F.ws + WS_Q); const bf16* Kb = (const bf16*)(F.ws + WS_K); const bf16* V = (const bf16*)(F.ws + WS_V);
#pragma clang loop unroll(disable)
    for (int unit = gw; unit < S * NH; unit += NGW) { const int h = unit & 7, t = unit >> 3, own = t >> 8;
        { const unsigned w = ((const GAS unsigned*)(Q + (size_t)t * 1024 + h * 128))[lane]; qs[2 * lane] = bflo(w); qs[2 * lane + 1] = bfhi(w); }
        LDS_WAIT(); asm volatile("" ::: "memory");
        float g = NEG;
        if (lane < own) { const GAS f32x4* km = (const GAS f32x4*)(F.ws + WS_KMEAN) + (size_t)(h * 64 + lane) * 32; float a = 0.f;
#pragma unroll 8
            for (int d = 0; d < 32; ++d) { const f32x4 kv = km[d]; const f32x4 qv = *(const LAS f32x4*)(qs + 4 * d); a += kv[0] * qv[0] + kv[1] * qv[1] + kv[2] * qv[2] + kv[3] * qv[3]; }
            g = a; }
        int blk[4]; bool val[4];
#pragma unroll
        for (int r = 0; r < 3; ++r) { float v = g; int idx = lane;
#pragma unroll
            for (int o = 1; o < 64; o <<= 1) { const float ov = __shfl_xor(v, o); const int oi = __shfl_xor(idx, o); if (ov > v || (ov == v && oi < idx)) { v = ov; idx = oi; } }
            blk[r] = __builtin_amdgcn_readfirstlane(idx); val[r] = __builtin_amdgcn_readfirstlane(v > NEG ? 1 : 0) != 0; if (lane == blk[r]) g = NEG; }
        blk[3] = own; val[3] = true;
        float sc[4][4]; float mx = NEG;
#pragma unroll
        for (int b = 0; b < 4; ++b) {
#pragma unroll
            for (int c = 0; c < 4; ++c) { const int key = blk[b] * 256 + c * 64 + lane; float s = NEG;
                if (val[b] && (b < 3 || key <= t)) { const GAS v4u* kr = (const GAS v4u*)(Kb + (size_t)key * 1024 + h * 128); float a = 0.f;
#pragma unroll 4
                    for (int d = 0; d < 16; ++d) { const v4u kv = kr[d]; const f32x4 q0 = *(const LAS f32x4*)(qs + 8 * d), q1 = *(const LAS f32x4*)(qs + 8 * d + 4);
                        a += bflo(kv.x) * q0[0] + bfhi(kv.x) * q0[1] + bflo(kv.y) * q0[2] + bfhi(kv.y) * q0[3] + bflo(kv.z) * q1[0] + bfhi(kv.z) * q1[1] + bflo(kv.w) * q1[2] + bfhi(kv.w) * q1[3]; }
                    s = a * scale; }
                sc[b][c] = s; mx = fmaxf(mx, s); } }
        mx = wave_max(mx);
        float lsum = 0.f;
#pragma unroll
        for (int b = 0; b < 4; ++b)
#pragma unroll
            for (int c = 0; c < 4; ++c) { const float p = (sc[b][c] > NEG) ? __expf(sc[b][c] - mx) : 0.f; lsum += p; ps[b * 256 + c * 64 + lane] = p; }
        lsum = wave_sum(lsum);
        LDS_WAIT(); asm volatile("" ::: "memory");
        float o0 = 0.f, o1 = 0.f;
#pragma unroll
        for (int b = 0; b < 4; ++b) { if (!val[b]) continue;
            const GAS unsigned* vp = (const GAS unsigned*)(V + (size_t)(blk[b] * 256) * 1024 + h * 128) + lane;
            const int nk = (b == 3) ? (t - own * 256 + 1) : 256;
#pragma unroll 8
            for (int j = 0; j < nk; ++j) { const float p = ps[b * 256 + j]; const unsigned w = vp[(size_t)j * 512]; o0 += p * bflo(w); o1 += p * bfhi(w); } }
        const float inv = 1.0f / lsum;
        ((GAS unsigned*)(F.ws + WS_CAT))[((size_t)t * DM + h * 128) / 2 + lane] = pk2(o0 * inv, o1 * inv);
        LDS_WAIT(); asm volatile("" ::: "memory");
    }
}

__device__ __forceinline__ void ln_phase(Frame& F, const float* hres_, const float* y_, const float* g_, const float* b_, const float* router, bool write_hb) {
    const int gw = F.vcu * NWAVES + F.wave, lane = lane_now();
    const GAS f32x4* gp = (const GAS f32x4*)g_ + lane; const GAS f32x4* bp = (const GAS f32x4*)b_ + lane;
    int ecl[8];
#pragma unroll
    for (int e = 0; e < 8; ++e) ecl[e] = 0;
#pragma clang loop unroll(disable)
    for (int i = 0; i < S / (256 * NWAVES); ++i) { const int row = gw * (S / (256 * NWAVES)) + i;
        const GAS f32x4* hp = (const GAS f32x4*)(hres_ + (size_t)row * DM) + lane; const GAS f32x4* yp = (const GAS f32x4*)(y_ + (size_t)row * DM) + lane;
        f32x4 v[8]; float s = 0.f;
#pragma unroll
        for (int j = 0; j < 8; ++j) { v[j] = hp[64 * j] * ALPHA + yp[64 * j]; s += (v[j][0] + v[j][1]) + (v[j][2] + v[j][3]); }
        const float mean = wave_sum(s) * (1.f / DM); float s2 = 0.f;
#pragma unroll
        for (int j = 0; j < 8; ++j) { v[j] = v[j] - mean; s2 += (v[j][0] * v[j][0] + v[j][1] * v[j][1]) + (v[j][2] * v[j][2] + v[j][3] * v[j][3]); }
        const float rstd = 1.f / sqrtf(wave_sum(s2) * (1.f / DM) + LN_EPS);
        GAS f32x4* op = (GAS f32x4*)(F.out + (size_t)row * DM) + lane; GAS v2u* hb = (GAS v2u*)(F.ws + WS_HB + (size_t)row * DM * 2) + lane;
#pragma unroll
        for (int j = 0; j < 8; ++j) { v[j] = v[j] * rstd * gp[64 * j] + bp[64 * j]; op[64 * j] = v[j]; if (write_hb) hb[64 * j] = (v2u){pk2(v[j][0], v[j][1]), pk2(v[j][2], v[j][3])}; }
        if (router) {
            float lg[8];
#pragma unroll
            for (int e = 0; e < 8; ++e) lg[e] = 0.f;
#pragma unroll
            for (int j = 0; j < 8; ++j)
#pragma unroll
                for (int c = 0; c < 4; ++c) { const GAS f32x4* rw = (const GAS f32x4*)(router + (size_t)(256 * j + 4 * lane + c) * 8); const f32x4 r0 = rw[0], r1 = rw[1]; const float xv = v[j][c];
                    lg[0] += xv * r0[0]; lg[1] += xv * r0[1]; lg[2] += xv * r0[2]; lg[3] += xv * r0[3]; lg[4] += xv * r1[0]; lg[5] += xv * r1[1]; lg[6] += xv * r1[2]; lg[7] += xv * r1[3]; }
#pragma unroll
            for (int e = 0; e < 8; ++e) lg[e] = wave_sum(lg[e]);
            int i1 = 0; float v1 = lg[0];
#pragma unroll
            for (int e = 1; e < 8; ++e) if (lg[e] > v1) { v1 = lg[e]; i1 = e; }
            int i2 = -1; float v2 = -__builtin_inff();
#pragma unroll
            for (int e = 0; e < 8; ++e) if (e != i1 && lg[e] > v2) { v2 = lg[e]; i2 = e; }
            const float g1 = 1.0f / (1.0f + __expf(v2 - v1)), g2 = 1.0f - g1;
            if (lane == 0) { ((GAS int*)(F.ws + WS_EIDX))[row * 2] = i1; ((GAS int*)(F.ws + WS_EIDX))[row * 2 + 1] = i2; ((GAS float*)(F.ws + WS_GATEW))[row * 2] = g1; ((GAS float*)(F.ws + WS_GATEW))[row * 2 + 1] = g2; }
#pragma unroll
            for (int e = 0; e < 8; ++e) ecl[e] += (i1 == e ? 1 : 0) + (i2 == e ? 1 : 0);
        }
    }
    if (router) { int mine = 0;
#pragma unroll
        for (int e = 0; e < 8; ++e) mine = (lane == e) ? ecl[e] : mine;
        if (lane < 8 && mine) __hip_atomic_fetch_add(F.ctl + CW_ECNT + 64 * lane, (unsigned)mine, RLX_AGENT); }
}
__device__ __forceinline__ void load_expert_layout(Frame& F, int (&off)[8], int (&cum)[8], int& npanels) {
    int o = 0;
#pragma unroll
    for (int e = 0; e < 8; ++e) { const int c = (int)__builtin_amdgcn_readfirstlane(__hip_atomic_load(F.ctl + CW_ECNT + 64 * e, RLX_AGENT)); off[e] = o; cum[e] = o >> 8; o += (c + 255) & ~255; }
    npanels = o >> 8;
}
__device__ __forceinline__ void route_phase(Frame& F) {
    const int gw = F.vcu * NWAVES + F.wave, lane = lane_now();
    int off[8], cum[8], np; load_expert_layout(F, off, cum, np);
    const int row = gw * 8 + (lane >> 1), slot = lane & 1; const bool act = lane < 16;
    const int mye = act ? ((const GAS int*)(F.ws + WS_EIDX))[row * 2 + slot] : -1;
    int pos = 0;
#pragma unroll
    for (int e = 0; e < 8; ++e) { const unsigned long long mask = __ballot(mye == e);
        if (mask) { const int leader = __builtin_ctzll(mask), n = __builtin_popcountll(mask); unsigned b = 0u;
            if (lane == leader) b = __hip_atomic_fetch_add(F.ctl + CW_ECUR + 64 * e, (unsigned)n, RLX_AGENT);
            b = __shfl(b, leader);
            if (mye == e) pos = off[e] + (int)b + __builtin_popcountll(mask & ((1ull << lane) - 1ull)); } }
    if (act) ((GAS int*)(F.ws + WS_ROWPOS))[row * 2 + slot] = pos;
#pragma clang loop unroll(disable)
    for (int k = 0; k < 16; ++k) { const int p = __shfl(pos, k), r = gw * 8 + (k >> 1);
        const GAS v4u* src = (const GAS v4u*)(F.ws + WS_HB + (size_t)r * DM * 2) + lane; GAS v4u* dst = (GAS v4u*)(F.ws + WS_HBP + (size_t)p * DM * 2) + lane;
#pragma unroll
        for (int j = 0; j < 4; ++j) dst[64 * j] = src[64 * j]; }
}
__device__ __forceinline__ void ln_moe_phase(Frame& F, const float* g_, const float* b_) {
    const int gw = F.vcu * NWAVES + F.wave, lane = lane_now();
    const GAS f32x4* gp = (const GAS f32x4*)g_ + lane; const GAS f32x4* bp = (const GAS f32x4*)b_ + lane;
#pragma clang loop unroll(disable)
    for (int i = 0; i < 8; ++i) { const int row = gw * 8 + i;
        const int p1 = ((const GAS int*)(F.ws + WS_ROWPOS))[row * 2], p2 = ((const GAS int*)(F.ws + WS_ROWPOS))[row * 2 + 1];
        const float g1 = ((const GAS float*)(F.ws + WS_GATEW))[row * 2], g2 = ((const GAS float*)(F.ws + WS_GATEW))[row * 2 + 1];
        const GAS f32x4* hp = (const GAS f32x4*)(F.out + (size_t)row * DM) + lane;
        const GAS v2u* y1 = (const GAS v2u*)(F.ws + WS_R2 + (size_t)p1 * DM * 2) + lane; const GAS v2u* y2 = (const GAS v2u*)(F.ws + WS_R2 + (size_t)p2 * DM * 2) + lane;
        f32x4 v[8]; float s = 0.f;
#pragma unroll
        for (int j = 0; j < 8; ++j) { const v2u a = y1[64 * j], b = y2[64 * j];
            const f32x4 fa = (f32x4){bflo(a.x), bfhi(a.x), bflo(a.y), bfhi(a.y)}, fb = (f32x4){bflo(b.x), bfhi(b.x), bflo(b.y), bfhi(b.y)};
            v[j] = hp[64 * j] * ALPHA + fa * g1 + fb * g2; s += (v[j][0] + v[j][1]) + (v[j][2] + v[j][3]); }
        const float mean = wave_sum(s) * (1.f / DM); float s2 = 0.f;
#pragma unroll
        for (int j = 0; j < 8; ++j) { v[j] = v[j] - mean; s2 += (v[j][0] * v[j][0] + v[j][1] * v[j][1]) + (v[j][2] * v[j][2] + v[j][3] * v[j][3]); }
        const float rstd = 1.f / sqrtf(wave_sum(s2) * (1.f / DM) + LN_EPS);
        GAS f32x4* op = (GAS f32x4*)(F.out + (size_t)row * DM) + lane;
#pragma unroll
        for (int j = 0; j < 8; ++j) op[64 * j] = v[j] * rstd * gp[64 * j] + bp[64 * j];
    }
}

struct Args { const float* in[18]; float* out; unsigned char* ws; };
__global__ void __launch_bounds__(NWAVES * 64, 2) hymba_fwd(Args args) {
    extern __shared__ __attribute__((aligned(16))) unsigned char lds[];
    Frame F;
    F.lds = (LAS unsigned char*)lds;
    F.MISC = (volatile LAS unsigned*)(F.lds + MISC_OFF);
    F.wave = __builtin_amdgcn_readfirstlane((int)threadIdx.x >> 6);
    F.G = gridDim.x; { const int bx = blockIdx.x; F.vcu = (F.G % 8 == 0) ? (bx % 8) * (F.G / 8) + bx / 8 : bx; }
    F.ws = args.ws; F.ctl = (gu32*)(args.ws + WS_CTL);
    F.x = args.in[0]; F.w_in = args.in[1]; F.conv_w = args.in[2]; F.conv_b = args.in[3]; F.conv_g = args.in[4]; F.conv_be = args.in[5]; F.w_out = args.in[6];
    F.lnm_g = args.in[7]; F.lnm_b = args.in[8]; F.lnf_g = args.in[9]; F.lnf_b = args.in[10]; F.fg = args.in[11]; F.fu = args.in[12]; F.fd = args.in[13];
    F.router = args.in[14]; F.eg = args.in[15]; F.eu = args.in[16]; F.ed = args.in[17]; F.out = args.out;
    for (int u = threadIdx.x; u < (LDS_BYTES - LDSCTL_OFF) / 4; u += NWAVES * 64) ((LAS unsigned*)(F.lds + LDSCTL_OFF))[u] = 0u;
    __syncthreads();
    XcdBarrier bar = xcd_barrier_post((unsigned*)(F.ctl + CW_BAR), F.MISC + 8, F.wave);
#define LAUNDER() asm volatile("" : "+s"(F.ws), "+s"(F.ctl), "+s"(F.out), "+s"(F.x), "+s"(bar.bar), "+s"(F.wave))
#define GRID_BAR() do { LAUNDER(); xcd_barrier(bar); LAUNDER(); } while (0)
#define HB ((bf16*)(F.ws + WS_HB))
#define Y ((float*)(F.ws + WS_R2))

    p0_prologue(F);
    GRID_BAR();

#pragma clang loop unroll(disable)
    for (int l = 0; l < 2; ++l) {
#ifndef NO_G_INPROJ
        { pg8::Gemm g{HB, (const bf16*)(F.ws + WS_WIN) + (size_t)l * NPROJ * DM, S, NPROJ, DM, 0}; pg8::StaticOrder So; So.init(S, NPROJ, F.G, (int)blockIdx.x);
          pg8::EpiInProj E{(bf16*)(F.ws + WS_Q), (bf16*)(F.ws + WS_K), (bf16*)(F.ws + WS_V), (bf16*)(F.ws + WS_U), (const float*)(F.ws + WS_ROPEC), (const float*)(F.ws + WS_ROPES)};
          pg8::gemm_phase<pg8::EpiInProj, pg8::StaticOrder, true, true>(F.lds + RING_OFF, g, So, E, F.wave); }
#endif
        GRID_BAR();
        kmean_phase(F);
        conv_phase(F, l);
        GRID_BAR();
        attn_naive_phase(F);
        GRID_BAR();
#ifndef NO_G_OUTPROJ
        { pg8::Gemm g{(const bf16*)(F.ws + WS_CAT), (const bf16*)(F.ws + WS_WOUT) + (size_t)l * DM * DM, S, DM, DM, 0}; pg8::StaticOrder So; So.init(S, DM, F.G, (int)blockIdx.x);
          pg8::EpiF32 E{Y, DM};
          pg8::gemm_phase<pg8::EpiF32, pg8::StaticOrder, true, true>(F.lds + RING_OFF, g, So, E, F.wave); }
#endif
        GRID_BAR();
        ln_phase(F, l == 0 ? F.x : F.out, Y, F.lnm_g + l * DM, F.lnm_b + l * DM, l == 1 ? F.router : nullptr, true);
        GRID_BAR();
        if (l == 0) {
#ifndef NO_G_FFNGU
            { pg8::Gemm g{HB, (const bf16*)(F.ws + WS_WGU0), S, 2 * DFF, DM, 0}; pg8::StaticOrder So; So.init(S, 2 * DFF, F.G, (int)blockIdx.x);
              pg8::EpiSwiGLU E{(bf16*)(F.ws + WS_ACT), DFF};
              pg8::gemm_phase<pg8::EpiSwiGLU, pg8::StaticOrder, true, true>(F.lds + RING_OFF, g, So, E, F.wave); }
#endif
            GRID_BAR();
#ifndef NO_G_FFND
            { pg8::Gemm g{(const bf16*)(F.ws + WS_ACT), (const bf16*)(F.ws + WS_WD0), S, DM, DFF, 0}; pg8::StaticOrder So; So.init(S, DM, F.G, (int)blockIdx.x);
              pg8::EpiF32 E{Y, DM};
              pg8::gemm_phase<pg8::EpiF32, pg8::StaticOrder, true, true>(F.lds + RING_OFF, g, So, E, F.wave); }
#endif
            GRID_BAR();
            ln_phase(F, F.out, Y, F.lnf_g, F.lnf_b, nullptr, true);
            GRID_BAR();
        } else {
            route_phase(F);
            GRID_BAR();
            int off[8], cum[8], np; load_expert_layout(F, off, cum, np);
#ifndef NO_G_MOEGU
            { pg8::Gemm g{(const bf16*)(F.ws + WS_HBP), (const bf16*)(F.ws + WS_WGUE), np * 256, 2 * DFF, DM, (size_t)2 * DFF * DM * 2}; pg8::GroupedOrder So; So.init(np * 256, 2 * DFF, F.G, (int)blockIdx.x);
#pragma unroll
              for (int e = 0; e < 8; ++e) So.cum[e] = cum[e];
              pg8::EpiSwiGLU E{(bf16*)(F.ws + WS_ACT), DFF};
              pg8::gemm_phase<pg8::EpiSwiGLU, pg8::GroupedOrder, true, true>(F.lds + RING_OFF, g, So, E, F.wave); }
#endif
            GRID_BAR();
#ifndef NO_G_MOED
            { pg8::Gemm g{(const bf16*)(F.ws + WS_ACT), (const bf16*)(F.ws + WS_WDE), np * 256, DM, DFF, (size_t)DM * DFF * 2}; pg8::GroupedOrder So; So.init(np * 256, DM, F.G, (int)blockIdx.x);
#pragma unroll
              for (int e = 0; e < 8; ++e) So.cum[e] = cum[e];
              pg8::EpiBf16 E{(bf16*)(F.ws + WS_R2), DM};
              pg8::gemm_phase<pg8::EpiBf16, pg8::GroupedOrder, true, true>(F.lds + RING_OFF, g, So, E, F.wave); }
#endif
            GRID_BAR();
            ln_moe_phase(F, F.lnf_g + DM, F.lnf_b + DM);
        }
    }
#undef GRID_BAR
#undef LAUNDER
#undef HB
#undef Y
}

extern "C" void kernel_launch(void* const* d_in, const int* in_sizes, int n_in, void* d_out, int out_size, void* d_ws, size_t ws_size, hipStream_t stream) {
    static int grid = 0;
    if (grid == 0) {
        if (n_in != 18 || in_sizes[0] != S * DM || out_size != S * DM || ws_size < WS_END) { fprintf(stderr, "kernel_launch: unexpected shapes (n_in %d, in0 %d, out %d, ws %zu < %zu); nothing launched\n", n_in, n_in > 0 ? in_sizes[0] : -1, out_size, ws_size, (size_t)WS_END); grid = -1; return; }
        int dev = 0, cus = 0, per_cu = 0;
        if (hipGetDevice(&dev) != hipSuccess || hipDeviceGetAttribute(&cus, hipDeviceAttributeMultiprocessorCount, dev) != hipSuccess) { grid = -1; return; }
        if (hipFuncSetAttribute((const void*)hymba_fwd, hipFuncAttributeMaxDynamicSharedMemorySize, LDS_BYTES) != hipSuccess) { fprintf(stderr, "kernel_launch: hipFuncSetAttribute failed\n"); grid = -1; return; }
        if (hipOccupancyMaxActiveBlocksPerMultiprocessor(&per_cu, (const void*)hymba_fwd, NWAVES * 64, LDS_BYTES) != hipSuccess || per_cu < 1)
            fprintf(stderr, "kernel_launch: note: occupancy query reports %d workgroups per CU\n", per_cu);
        (void)hipGetLastError();
        grid = cus;
        if (grid != 256) { fprintf(stderr, "kernel_launch: built for 256 CUs, device has %d; nothing launched\n", cus); grid = -1; return; }
    }
    if (grid < 0) return;
    if (hipMemsetAsync((char*)d_ws + WS_CTL, 0, CTL_ZERO_BYTES, stream) != hipSuccess) return;
    Args a{};
    for (int i = 0; i < 18; ++i) a.in[i] = (const float*)d_in[i];
    a.out = (float*)d_out; a.ws = (unsigned char*)d_ws;
    hipLaunchKernelGGL(hymba_fwd, dim3(grid), dim3(NWAVES * 64), LDS_BYTES, stream, a);
}
```

```cpp
#include <hip/hip_runtime.h>
#include <cstdio>
#include <cstdint>
#include <cmath>
namespace pg8 {
#define PG8_LAS __attribute__((address_space(3)))
typedef unsigned short bf16_t;
typedef short bf16x8 __attribute__((ext_vector_type(8)));
typedef float f32x4 __attribute__((ext_vector_type(4)));
typedef unsigned u32x4 __attribute__((ext_vector_type(4)));
typedef unsigned u32x2 __attribute__((ext_vector_type(2)));
constexpr int BM = 256, BK = 64, HALF = 128, HTB = HALF * BK * 2  , STAGE_BYTES = 8 * HTB, NXCD = 8, WGM = 8;

__host__ __device__ __forceinline__ int lds_byte(int r, int c) { const int st = (r >> 4) * 2 + (c >> 5), rr = r & 15, cc = c & 31, ob = rr * 64 + cc * 2; return st * 1024 + (ob ^ (((ob >> 9) & 1) << 5)); }
__host__ __device__ __forceinline__ void stage_rc(int b, int& R, int& C) { const int st = b / 1024, sb = b % 1024, swz = sb ^ (((sb >> 9) & 1) << 5); R = (st >> 1) * 16 + swz / 64; C = (st & 1) * 32 + (swz % 64) / 2; }
__host__ __device__ __forceinline__ int perm32(int rho) { const int n = rho >> 4, i = rho & 15; return 8 * (i >> 2) + 4 * n + (i & 3); }

struct Unit { int pm, pn, e; };
struct Gemm { const bf16_t* A; const bf16_t* Bt; int M, N, K; size_t bstride; };

struct StaticOrder {
    int nM, nN, nwg, G, c;
    __host__ __device__ void init(int M, int N, int G_, int c_) { nM = M / BM; nN = N / BM; nwg = nM * nN; G = G_; c = c_; }
    __host__ __device__ bool next(int i, Unit& u) const {
        const long L = (long)i * G + c; if (L >= nwg) return false;
        int wgid = (int)L; { const int q = nwg / NXCD, r = nwg % NXCD, xcd = wgid % NXCD, off = wgid / NXCD; wgid = (xcd < r ? xcd * (q + 1) : r * (q + 1) + (xcd - r) * q) + off; }
        const int nig = WGM * nN, gid = wgid / nig, fm = gid * WGM, gsz = (nM - fm) < WGM ? (nM - fm) : WGM;
        u.pm = fm + ((wgid % nig) % gsz); u.pn = (wgid % nig) / gsz; u.e = 0; return true;
    }
    __device__ __forceinline__ void a_ready(const Unit&) const {}
    __device__ __forceinline__ void done(const Unit&) const {}
};
struct GroupedOrder : StaticOrder {
    int cum[8];
    __device__ bool next(int i, Unit& u) const {
        if (!StaticOrder::next(i, u)) return false;
        int e = 0;
#pragma unroll
        for (int j = 1; j < 8; ++j) e += (u.pm >= cum[j]) ? 1 : 0;
        u.e = e; return true;
    }
};

__device__ __forceinline__ unsigned cvt_pk_bf16(float lo, float hi) { unsigned r; asm volatile("v_cvt_pk_bf16_f32 %0, %1, %2" : "=v"(r) : "v"(lo), "v"(hi)); return r; }
__device__ __forceinline__ float sigmoidf_fast(float g) { return __builtin_amdgcn_rcpf(1.0f + __builtin_amdgcn_exp2f(-1.44269504089f * g)); }

struct EpiF32 {
    static constexpr bool PERM = false, AFTER_DRAIN = false;
    float* C; int ldc;
    __device__ __forceinline__ void operator()(const f32x4 (&acc)[2][2][4][2], const Unit& u, int wr, int wc, int fr, int fq) const {
        const int row0 = u.pm * BM + wr * 64 + fr, col0 = u.pn * BM + wc * 32 + 4 * fq;
#pragma unroll
        for (int ai = 0; ai < 2; ++ai)
#pragma unroll
            for (int m = 0; m < 4; ++m) { float* rowp = C + (size_t)(row0 + ai * HALF + m * 16) * ldc + col0;
#pragma unroll
                for (int bj = 0; bj < 2; ++bj)
#pragma unroll
                    for (int n = 0; n < 2; ++n) *(f32x4*)(rowp + bj * HALF + n * 16) = acc[ai][bj][m][n]; }
    }
};
struct EpiBf16 {
    static constexpr bool PERM = true, AFTER_DRAIN = false;
    bf16_t* O; int ldc;
    __device__ __forceinline__ void operator()(const f32x4 (&acc)[2][2][4][2], const Unit& u, int wr, int wc, int fr, int fq) const {
        const int row0 = u.pm * BM + wr * 64 + fr, col0 = u.pn * BM + wc * 32 + 8 * fq;
#pragma unroll
        for (int ai = 0; ai < 2; ++ai)
#pragma unroll
            for (int m = 0; m < 4; ++m) { bf16_t* rowp = O + (size_t)(row0 + ai * HALF + m * 16) * ldc + col0;
#pragma unroll
                for (int bj = 0; bj < 2; ++bj) { const f32x4 v0 = acc[ai][bj][m][0], v1 = acc[ai][bj][m][1];
                    u32x4 w; w.x = cvt_pk_bf16(v0[0], v0[1]); w.y = cvt_pk_bf16(v0[2], v0[3]); w.z = cvt_pk_bf16(v1[0], v1[1]); w.w = cvt_pk_bf16(v1[2], v1[3]);
                    *(u32x4*)(rowp + bj * HALF) = w; } }
    }
};
struct EpiSwiGLU {
    static constexpr bool PERM = true, AFTER_DRAIN = false;
    bf16_t* O; int ldc;
    __device__ __forceinline__ void operator()(const f32x4 (&acc)[2][2][4][2], const Unit& u, int wr, int wc, int fr, int fq) const {
        const int row0 = u.pm * BM + wr * 64 + fr, col0 = u.pn * HALF + wc * 32 + 8 * fq;
#pragma unroll
        for (int ai = 0; ai < 2; ++ai)
#pragma unroll
            for (int m = 0; m < 4; ++m) { bf16_t* rowp = O + (size_t)(row0 + ai * HALF + m * 16) * ldc + col0;
                float o[8];
#pragma unroll
                for (int n = 0; n < 2; ++n)
#pragma unroll
                    for (int j = 0; j < 4; ++j) { const float g = acc[ai][0][m][n][j], up = acc[ai][1][m][n][j]; o[n * 4 + j] = g * sigmoidf_fast(g) * up; }
                u32x4 w; w.x = cvt_pk_bf16(o[0], o[1]); w.y = cvt_pk_bf16(o[2], o[3]); w.z = cvt_pk_bf16(o[4], o[5]); w.w = cvt_pk_bf16(o[6], o[7]);
                *(u32x4*)rowp = w; }
    }
};
struct EpiInProj {
    static constexpr bool PERM = true, AFTER_DRAIN = false;
    bf16_t *Q, *Kb, *V, *U; const float *ropeC, *ropeS;
    __device__ __forceinline__ void operator()(const f32x4 (&acc)[2][2][4][2], const Unit& u, int wr, int wc, int fr, int fq) const {
        const int row0 = u.pm * BM + wr * 64 + fr;
        if (u.pn < 8) {
            bf16_t* base = (u.pn < 4) ? Q : Kb; const int col0 = (u.pn & 3) * BM + wc * 32 + 8 * fq, idx0 = 16 * wc + 4 * fq;
#pragma unroll
            for (int ai = 0; ai < 2; ++ai)
#pragma unroll
                for (int m = 0; m < 4; ++m) { const int row = row0 + ai * HALF + m * 16;
                    const f32x4 cs = *(const f32x4*)(ropeC + (size_t)row * 64 + idx0), sn = *(const f32x4*)(ropeS + (size_t)row * 64 + idx0);
#pragma unroll
                    for (int bj = 0; bj < 2; ++bj) { const f32x4 x1 = acc[ai][bj][m][0], x2 = acc[ai][bj][m][1];
                        const f32x4 o1 = x1 * cs - x2 * sn, o2 = x2 * cs + x1 * sn;
                        u32x4 w; w.x = cvt_pk_bf16(o1[0], o1[1]); w.y = cvt_pk_bf16(o1[2], o1[3]); w.z = cvt_pk_bf16(o2[0], o2[1]); w.w = cvt_pk_bf16(o2[2], o2[3]);
                        *(u32x4*)(base + (size_t)row * 1024 + col0 + bj * HALF) = w; } }
        } else if (u.pn < 12) {
            const int col0 = (u.pn - 8) * BM + wc * 32 + 8 * fq;
#pragma unroll
            for (int ai = 0; ai < 2; ++ai)
#pragma unroll
                for (int m = 0; m < 4; ++m) { bf16_t* rowp = V + (size_t)(row0 + ai * HALF + m * 16) * 1024 + col0;
#pragma unroll
                    for (int bj = 0; bj < 2; ++bj) { const f32x4 v0 = acc[ai][bj][m][0], v1 = acc[ai][bj][m][1];
                        u32x4 w; w.x = cvt_pk_bf16(v0[0], v0[1]); w.y = cvt_pk_bf16(v0[2], v0[3]); w.z = cvt_pk_bf16(v1[0], v1[1]); w.w = cvt_pk_bf16(v1[2], v1[3]);
                        *(u32x4*)(rowp + bj * HALF) = w; } }
        } else {
            const int col0 = (u.pn - 12) * HALF + wc * 32 + 8 * fq;
#pragma unroll
            for (int ai = 0; ai < 2; ++ai)
#pragma unroll
                for (int m = 0; m < 4; ++m) { bf16_t* rowp = U + (size_t)(row0 + ai * HALF + m * 16) * 1024 + col0;
                    float o[8];
#pragma unroll
                    for (int n = 0; n < 2; ++n)
#pragma unroll
                        for (int j = 0; j < 4; ++j) o[n * 4 + j] = acc[ai][0][m][n][j] * sigmoidf_fast(acc[ai][1][m][n][j]);
                    u32x4 w; w.x = cvt_pk_bf16(o[0], o[1]); w.y = cvt_pk_bf16(o[2], o[3]); w.z = cvt_pk_bf16(o[4], o[5]); w.w = cvt_pk_bf16(o[6], o[7]);
                    *(u32x4*)rowp = w; }
        }
    }
};

template <class Epi, class Sched, bool ALIGN_EPI = false, bool SP2 = false>
__device__ __forceinline__ void gemm_phase(PG8_LAS unsigned char* lds, const Gemm g, const Sched& S, const Epi& E, const int wave_in) {
    int lane; asm volatile("v_mbcnt_lo_u32_b32 %0, -1, 0\n\tv_mbcnt_hi_u32_b32 %0, -1, %0" : "=v"(lane));
    const int wid = wave_in, tid = wid * 64 + lane, wr = wid >> 2, wc = wid & 3, fr = lane & 15, fq = lane >> 4;
    const int K = g.K, nt = K / BK;
    unsigned voffA[2], voffB[2];
#pragma unroll
    for (int i = 0; i < 2; ++i) { int R, C; stage_rc(tid * 16 + i * 8192, R, C); const int Rb = Epi::PERM ? ((R & ~31) + perm32(R & 31)) : R;
        voffA[i] = (unsigned)(R * K + C) * 2u; voffB[i] = (unsigned)(Rb * K + C) * 2u; }
    const size_t kstep = (size_t)(BK * 2);
    const size_t hstep = (size_t)HALF * K * 2;
    const size_t tstep = 2 * hstep;
    const unsigned ldsw = (unsigned)wid * 1024u;
    const int aoff = lds_byte(wr * 64 + fr, fq * 8), boff = lds_byte(wc * 32 + fr, fq * 8);
#define PG8_SA(b, h) (((b) * 2 + (h)) * HTB)
#define PG8_SB(b, h) ((4 + (b) * 2 + (h)) * HTB)
#define PG8_STAGE(bufoff, gbase, voff) do { _Pragma("unroll") for (int _i = 0; _i < 2; ++_i) \
        __builtin_amdgcn_global_load_lds((const unsigned*)((const char*)(gbase) + (voff)[_i]), (PG8_LAS unsigned*)(lds + (bufoff) + ldsw + _i * 8192), 16, 0, 0); } while (0)
#define PG8_LDA(dst, b, h) do { _Pragma("unroll") for (int m = 0; m < 4; ++m) _Pragma("unroll") for (int k = 0; k < 2; ++k) dst[m][k] = *(const PG8_LAS bf16x8*)(lds + PG8_SA(b, h) + aoff + m * 2048 + k * 1024); } while (0)
#define PG8_LDB(dst, b, h) do { _Pragma("unroll") for (int n = 0; n < 2; ++n) _Pragma("unroll") for (int k = 0; k < 2; ++k) dst[n][k] = *(const PG8_LAS bf16x8*)(lds + PG8_SB(b, h) + boff + n * 2048 + k * 1024); } while (0)
#define PG8_MMA(ai, bj, At, Bt) do { __builtin_amdgcn_s_setprio(1); _Pragma("unroll") for (int m = 0; m < 4; ++m) _Pragma("unroll") for (int n = 0; n < 2; ++n) _Pragma("unroll") for (int k = 0; k < 2; ++k) \
        acc[ai][bj][m][n] = __builtin_amdgcn_mfma_f32_16x16x32_bf16(Bt[n][k], At[m][k], acc[ai][bj][m][n], 0, 0, 0); __builtin_amdgcn_s_setprio(0); } while (0)
#define PG8_WAIT_V(n) asm volatile("s_waitcnt vmcnt(" #n ")" ::: "memory")
#define PG8_WAIT_L(n) asm volatile("s_waitcnt lgkmcnt(" #n ")" ::: "memory")
#define PG8_BAR __builtin_amdgcn_s_barrier()
#define PG8_SCHED __builtin_amdgcn_sched_barrier(0)
    Unit cur, nxt; int ui = 0;
    if (!S.next(0, cur)) return;
    f32x4 acc[2][2][4][2];
#pragma unroll
    for (int a = 0; a < 2; ++a)
#pragma unroll
        for (int b = 0; b < 2; ++b)
#pragma unroll
            for (int m = 0; m < 4; ++m)
#pragma unroll
                for (int n = 0; n < 2; ++n) acc[a][b][m][n] = (f32x4){0.f, 0.f, 0.f, 0.f};
    bf16x8 At[4][2], B0[2][2], B1[2][2];
    const char* cA = (const char*)g.A + (size_t)cur.pm * tstep; const char* cB = (const char*)g.Bt + (size_t)cur.e * g.bstride + (size_t)cur.pn * tstep;
    S.a_ready(cur);
    if constexpr (SP2) {
        PG8_STAGE(PG8_SB(0, 0), cB, voffB); PG8_STAGE(PG8_SB(0, 1), cB + hstep, voffB); PG8_STAGE(PG8_SA(0, 0), cA, voffA); PG8_STAGE(PG8_SA(0, 1), cA + hstep, voffA);
        if (wr == 1) PG8_BAR;
        PG8_WAIT_V(2); PG8_BAR;
        PG8_STAGE(PG8_SB(1, 0), cB + kstep, voffB); PG8_STAGE(PG8_SA(1, 0), cA + kstep, voffA); PG8_STAGE(PG8_SB(1, 1), cB + hstep + kstep, voffB);
        PG8_WAIT_V(6); PG8_BAR;
    } else {
        PG8_STAGE(PG8_SB(0, 0), cB, voffB); PG8_STAGE(PG8_SA(0, 0), cA, voffA); PG8_STAGE(PG8_SB(0, 1), cB + hstep, voffB); PG8_STAGE(PG8_SA(0, 1), cA + hstep, voffA);
        if (wr == 1) PG8_BAR;
        PG8_WAIT_V(4); PG8_BAR;
        PG8_STAGE(PG8_SB(1, 0), cB + kstep, voffB); PG8_STAGE(PG8_SA(1, 0), cA + kstep, voffA); PG8_STAGE(PG8_SB(1, 1), cB + hstep + kstep, voffB);
        PG8_WAIT_V(6); PG8_BAR;
    }
    for (;;) {
        const bool has_next = S.next(ui + 1, nxt);
        const char* nA = has_next ? (const char*)g.A + (size_t)nxt.pm * tstep : cA; const char* nB = has_next ? (const char*)g.Bt + (size_t)nxt.e * g.bstride + (size_t)nxt.pn * tstep : cB;
        for (int t = 0; t < nt; t += 2) {
            const bool last = (t == nt - 2);
            const char* a1 = cA + (size_t)(t + 1) * kstep;
            const char* a2 = last ? nA : cA + (size_t)(t + 2) * kstep; const char* b2 = last ? nB : cB + (size_t)(t + 2) * kstep;
            const char* a3 = a2 + kstep; const char* b3 = b2 + kstep;
            if (last && has_next) S.a_ready(nxt);
            if constexpr (SP2) {
            PG8_LDB(B0, 0, 0); PG8_LDB(B1, 0, 1); PG8_SCHED; PG8_LDA(At, 0, 0); PG8_STAGE(PG8_SA(1, 1), a1 + hstep, voffA);
            PG8_WAIT_V(8); PG8_WAIT_L(0); PG8_BAR; PG8_MMA(0, 0, At, B0); PG8_MMA(0, 1, At, B1); PG8_BAR; PG8_SCHED;
            PG8_LDA(At, 0, 1); PG8_STAGE(PG8_SB(0, 0), b2, voffB); PG8_STAGE(PG8_SB(0, 1), b2 + hstep, voffB); PG8_STAGE(PG8_SA(0, 0), a2, voffA);
            PG8_WAIT_V(8); PG8_WAIT_L(0); PG8_BAR; PG8_MMA(1, 0, At, B0); PG8_MMA(1, 1, At, B1); PG8_BAR; PG8_SCHED;
            PG8_LDB(B0, 1, 0); PG8_LDB(B1, 1, 1); PG8_SCHED; PG8_LDA(At, 1, 0); PG8_STAGE(PG8_SA(0, 1), a2 + hstep, voffA);
            PG8_WAIT_V(8); PG8_WAIT_L(0); PG8_BAR; PG8_MMA(0, 0, At, B0); PG8_MMA(0, 1, At, B1); PG8_BAR; PG8_SCHED;
            PG8_LDA(At, 1, 1); PG8_STAGE(PG8_SB(1, 0), b3, voffB); PG8_STAGE(PG8_SB(1, 1), b3 + hstep, voffB); PG8_STAGE(PG8_SA(1, 0), a3, voffA);
            PG8_WAIT_V(8); PG8_WAIT_L(0); PG8_BAR; PG8_MMA(1, 0, At, B0); PG8_MMA(1, 1, At, B1); PG8_BAR; PG8_SCHED;
            } else {
            PG8_LDB(B0, 0, 0); PG8_SCHED; PG8_LDA(At, 0, 0); PG8_STAGE(PG8_SA(1, 1), a1 + hstep, voffA);
            PG8_WAIT_L(8); PG8_BAR; PG8_WAIT_L(0); PG8_MMA(0, 0, At, B0); PG8_BAR; PG8_SCHED;
            PG8_LDB(B1, 0, 1); PG8_STAGE(PG8_SB(0, 0), b2, voffB);
            PG8_BAR; PG8_WAIT_L(0); PG8_MMA(0, 1, At, B1); PG8_BAR;
            PG8_LDA(At, 0, 1); PG8_STAGE(PG8_SA(0, 0), a2, voffA);
            PG8_BAR; PG8_WAIT_L(0); PG8_MMA(1, 0, At, B0); PG8_BAR; PG8_SCHED;
            PG8_STAGE(PG8_SB(0, 1), b2 + hstep, voffB);
            PG8_WAIT_V(6); PG8_BAR; PG8_MMA(1, 1, At, B1); PG8_BAR;
            PG8_LDB(B0, 1, 0); PG8_SCHED; PG8_LDA(At, 1, 0); PG8_STAGE(PG8_SA(0, 1), a2 + hstep, voffA);
            PG8_WAIT_L(8); PG8_BAR; PG8_WAIT_L(0); PG8_MMA(0, 0, At, B0); PG8_BAR; PG8_SCHED;
            PG8_LDB(B1, 1, 1); PG8_STAGE(PG8_SB(1, 0), b3, voffB);
            PG8_BAR; PG8_WAIT_L(0); PG8_MMA(0, 1, At, B1); PG8_BAR;
            PG8_LDA(At, 1, 1); PG8_STAGE(PG8_SA(1, 0), a3, voffA);
            PG8_BAR; PG8_WAIT_L(0); PG8_MMA(1, 0, At, B0); PG8_BAR; PG8_SCHED;
            PG8_STAGE(PG8_SB(1, 1), b3 + hstep, voffB);
            PG8_WAIT_V(6); PG8_BAR; PG8_MMA(1, 1, At, B1); PG8_BAR;
            }
        }
        if constexpr (ALIGN_EPI) { if (wr == 0) PG8_BAR; }
        if constexpr (!Epi::AFTER_DRAIN) { E(acc, cur, wr, wc, fr, fq); S.done(cur); }
        if (!has_next) break;
#pragma unroll
        for (int a = 0; a < 2; ++a)
#pragma unroll
            for (int b = 0; b < 2; ++b)
#pragma unroll
                for (int m = 0; m < 4; ++m)
#pragma unroll
                    for (int n = 0; n < 2; ++n) acc[a][b][m][n] = (f32x4){0.f, 0.f, 0.f, 0.f};
        cur = nxt; cA = nA; cB = nB; ++ui;
        if constexpr (ALIGN_EPI) { if (wr == 1) PG8_BAR; }
    }
    PG8_WAIT_V(0);
    if constexpr (!ALIGN_EPI) { if (wr == 0) PG8_BAR; }
    PG8_BAR;
    if constexpr (Epi::AFTER_DRAIN) { E.fused(acc, cur, wr, wc, fr, fq, lds, wid, lane); S.done(cur); }
#undef PG8_SA
#undef PG8_SB
#undef PG8_STAGE
#undef PG8_LDA
#undef PG8_LDB
#undef PG8_MMA
#undef PG8_WAIT_V
#undef PG8_WAIT_L
#undef PG8_BAR
#undef PG8_SCHED
}
}

constexpr int NWAVES = 8;
constexpr int S = 16384, DM = 2048, NPROJ = 5120, AW = 1024, HD = 128, NH = 8, DFF = 5632, NE = 8, CKW = 31, NBLK = 64;
constexpr float LN_EPS = 1e-5f, ALPHA = 1.41421356237309515f;
constexpr int MOE_ROWS = 2 * S + NE * 256;

constexpr size_t MiB = 1u << 20;
constexpr size_t WS_CTL = 0, CTL_ZERO_BYTES = 1 * MiB;
constexpr size_t WS_ROPEC = 1 * MiB, WS_ROPES = 5 * MiB;
constexpr size_t WS_KMEAN = 9 * MiB;
constexpr size_t WS_EIDX = 9 * MiB + 512 * 1024, WS_GATEW = WS_EIDX + 128 * 1024, WS_ROWPOS = WS_GATEW + 128 * 1024;
constexpr size_t WS_WIN = 10 * MiB, WS_WOUT = 50 * MiB, WS_WGU0 = 66 * MiB, WS_WD0 = 110 * MiB, WS_WGUE = 132 * MiB, WS_WDE = 484 * MiB;
constexpr size_t WS_HB = 660 * MiB;
constexpr size_t WS_R2 = 724 * MiB;
constexpr size_t WS_HBP = 860 * MiB;
constexpr size_t WS_R1 = 996 * MiB;
constexpr size_t WS_Q = WS_R1, WS_K = WS_R1 + 32 * MiB, WS_V = WS_R1 + 64 * MiB, WS_U = WS_R1 + 96 * MiB, WS_CAT = WS_R1 + 128 * MiB, WS_ACT = WS_R1;
constexpr size_t WS_VT = WS_R1 + 192 * MiB, WS_PO = WS_R1 + 224 * MiB, WS_PML = WS_R1 + 320 * MiB, WS_LIST = WS_R1 + 324 * MiB;
constexpr size_t WS_END = 1370 * MiB;
static_assert(WS_R1 + (size_t)MOE_ROWS * DFF * 2 <= WS_END && WS_HBP + (size_t)MOE_ROWS * DM * 2 <= WS_R1 && WS_R2 + (size_t)MOE_ROWS * DM * 2 <= WS_HBP, "d_ws map");
static_assert(WS_WDE + (size_t)NE * DM * DFF * 2 <= WS_HB && WS_WGUE + (size_t)NE * 2 * DFF * DM * 2 <= WS_WDE, "d_ws weights map");
constexpr int CW_TMO = 0, CW_CODE = 1, CW_BAR = 4096, CW_ECNT = 8192, CW_ECUR = 8192 + 64 * 8, CW_LCNT = 12288;
constexpr int RING_OFF = 0, RING_BYTES = 131072;
constexpr int LDSCTL_OFF = RING_BYTES, MISC_OFF = LDSCTL_OFF + 320;
constexpr int LDS_BYTES = 147456;

__device__ const float INV_FREQ[64] = {
1.000000000e+00f, 8.659643531e-01f, 7.498942018e-01f, 6.493816376e-01f, 5.623413324e-01f, 4.869675338e-01f, 4.216965139e-01f, 3.651741147e-01f, 3.162277639e-01f, 2.738419771e-01f, 2.371373773e-01f, 2.053525001e-01f, 1.778279394e-01f, 1.539926529e-01f, 1.333521456e-01f, 1.154781953e-01f, 1.000000015e-01f, 8.659642935e-02f, 7.498942316e-02f, 6.493816525e-02f, 5.623413250e-02f, 4.869675264e-02f, 4.216964915e-02f, 3.651741147e-02f, 3.162277490e-02f, 2.738419548e-02f, 2.371373773e-02f, 2.053525113e-02f, 1.778279431e-02f, 1.539926510e-02f, 1.333521400e-02f, 1.154781971e-02f, 9.999999776e-03f, 8.659643121e-03f, 7.498942316e-03f, 6.493816152e-03f, 5.623413250e-03f, 4.869675264e-03f, 4.216964822e-03f, 3.651741194e-03f, 3.162277630e-03f, 2.738419687e-03f, 2.371373819e-03f, 2.053525066e-03f, 1.778279431e-03f, 1.539926510e-03f, 1.333521446e-03f, 1.154782018e-03f, 1.000000047e-03f, 8.659643354e-04f, 7.498941850e-04f, 6.493816036e-04f, 5.623413017e-04f, 4.869675322e-04f, 4.216965172e-04f, 3.651741135e-04f, 3.162277571e-04f, 2.738419571e-04f, 2.371373703e-04f, 2.053525095e-04f, 1.778279402e-04f, 1.539926598e-04f, 1.333521504e-04f, 1.154782003e-04f
};

#define GAS __attribute__((address_space(1)))
#define LAS __attribute__((address_space(3)))
typedef unsigned short bf16;
typedef unsigned v4u __attribute__((ext_vector_type(4)));
typedef unsigned v2u __attribute__((ext_vector_type(2)));
typedef float f32x4 __attribute__((ext_vector_type(4)));
typedef float f32x2 __attribute__((ext_vector_type(2)));
typedef short bf16x8 __attribute__((ext_vector_type(8)));
typedef GAS unsigned gu32;
typedef GAS unsigned long long gu64;
#define RLX_AGENT __ATOMIC_RELAXED, __HIP_MEMORY_SCOPE_AGENT
#define LDS_WAIT() asm volatile("s_waitcnt lgkmcnt(0)" ::: "memory")
#define VM_WAIT() asm volatile("s_waitcnt vmcnt(0)" ::: "memory")
__device__ __forceinline__ unsigned f2bf(float f) { unsigned u = __builtin_bit_cast(unsigned, f); return (u + 0x7fffu + ((u >> 16) & 1u)) >> 16; }
__device__ __forceinline__ unsigned pk2(float lo, float hi) { return f2bf(lo) | (f2bf(hi) << 16); }
__device__ __forceinline__ float bflo(unsigned w) { return __builtin_bit_cast(float, w << 16); }
__device__ __forceinline__ float bfhi(unsigned w) { return __builtin_bit_cast(float, w & 0xffff0000u); }

#define XB_TMO      128
#define XB_XCNT(j)  (256  + 64 * (j))
#define XB_XSUB(j)  (1280 + 64 * (j))
#define XB_XGEN(j)  (2304 + 64 * (j))
#define XB_TOP      3328
#define XB_TOPGEN   3392
#define XCD_BAR_WORDS 3456
#define XB_SPIN_CAP (1u << 22)

__device__ __forceinline__ unsigned xb_ld(unsigned* p)              { return __hip_atomic_load(p, __ATOMIC_RELAXED, __HIP_MEMORY_SCOPE_AGENT); }
__device__ __forceinline__ unsigned xb_add(unsigned* p, unsigned v) { return __hip_atomic_fetch_add(p, v, __ATOMIC_RELAXED, __HIP_MEMORY_SCOPE_AGENT); }
__device__ __forceinline__ unsigned xb_xcc_id() { return (unsigned)__builtin_amdgcn_s_getreg((3 << 11) | 20) & 0xFu; }
#define XB_SPIN(cond, bar) do { unsigned _sp = 0; while (cond) { __builtin_amdgcn_s_sleep(1); \
    if ((++_sp & 255u) == 0u) { if (xb_ld(&(bar)[XB_TMO])) break; if (_sp > XB_SPIN_CAP) { atomicAdd(&(bar)[XB_TMO], 1u); break; } } } } while (0)

__device__ __forceinline__ int lane_now() { int l; asm volatile("v_mbcnt_lo_u32_b32 %0, -1, 0\n\tv_mbcnt_hi_u32_b32 %0, -1, %0" : "=v"(l)); return l; }
#define XB_T0() (b.w0 == 0 && lane_now() == 0)
struct XcdBarrier {
    unsigned* bar; unsigned x; int w0;
    volatile LAS unsigned* st;
};

__device__ __forceinline__ XcdBarrier xcd_barrier_post(unsigned* bar, volatile LAS unsigned* st, int w0) {
    XcdBarrier b; b.bar = bar; b.x = xb_xcc_id(); b.st = st; b.w0 = w0;
    if (XB_T0()) (void)xb_add(&bar[XB_XCNT(b.x)], 1u);
    return b;
}
__device__ __forceinline__ void xcd_barrier_complete(unsigned* bar, unsigned x, unsigned& nloc, unsigned& nx) {
    const unsigned G = gridDim.x * gridDim.y * gridDim.z;
    unsigned sum, cnt, mine, sp = 0u;
    for (;;) {
        sum = 0u; cnt = 0u; mine = 0u;
#pragma unroll
        for (unsigned j = 0; j < 16; ++j) { const unsigned c = xb_ld(&bar[XB_XCNT(j)]); sum += c; cnt += (c > 0u) ? 1u : 0u; mine = (j == x) ? c : mine; }
        if (sum == G) break;
        __builtin_amdgcn_s_sleep(1);
        if ((++sp & 255u) == 0u) { if (xb_ld(&bar[XB_TMO])) break; if (sp > XB_SPIN_CAP) { atomicAdd(&bar[XB_TMO], 1u); break; } }
    }
    nloc = mine > 0u ? mine : 1u; nx = cnt > 0u ? cnt : 1u;
}

__device__ __forceinline__ void xcd_barrier(const XcdBarrier& b) {
    asm volatile("s_waitcnt vmcnt(0)" ::: "memory");
    __syncthreads();
    if (XB_T0()) {
        unsigned* bar = b.bar;
        __builtin_amdgcn_s_waitcnt(0);
        unsigned nloc = b.st[0], nx = b.st[1];
        if (nloc == 0u) { xcd_barrier_complete(bar, b.x, nloc, nx); b.st[0] = nloc; b.st[1] = nx; }
        const unsigned old = xb_add(&bar[XB_XSUB(b.x)], 1u);
        const unsigned gen = old / nloc;
        if (old + 1u == (gen + 1u) * nloc) {
            __builtin_amdgcn_fence(__ATOMIC_RELEASE, "agent");
            asm volatile("s_waitcnt vmcnt(0)" ::: "memory");
            const unsigned og = xb_add(&bar[XB_TOP], 1u);
            const unsigned tg = og / nx;
            if (og + 1u == (tg + 1u) * nx) xb_add(&bar[XB_TOPGEN], 1u);
            else XB_SPIN(xb_ld(&bar[XB_TOPGEN]) == tg, bar);
            __builtin_amdgcn_fence(__ATOMIC_ACQUIRE, "agent");
            xb_add(&bar[XB_XGEN(b.x)], 1u);
            asm volatile("s_waitcnt vmcnt(0)" ::: "memory");
        } else {
            XB_SPIN(xb_ld(&bar[XB_XGEN(b.x)]) == gen, bar);
            __builtin_amdgcn_fence(__ATOMIC_ACQUIRE, "agent");
            asm volatile("s_waitcnt vmcnt(0)" ::: "memory");
        }
    }
    __syncthreads();
}


struct Frame {
    LAS unsigned char* lds;
    volatile LAS unsigned* MISC;
    gu32* ctl;
    int wave;
    int vcu, G;
    const float* x; float* out;
    const float *w_in, *conv_w, *conv_b, *conv_g, *conv_be, *w_out, *lnm_g, *lnm_b, *lnf_g, *lnf_b, *fg, *fu, *fd, *router, *eg, *eu, *ed;
    unsigned char* ws;
};
__device__ __forceinline__ float wave_sum(float v) {
#pragma unroll
    for (int o = 1; o < 64; o <<= 1) v += __shfl_xor(v, o);
    return v;
}
__device__ __forceinline__ float wave_max(float v) {
#pragma unroll
    for (int o = 1; o < 64; o <<= 1) v = fmaxf(v, __shfl_xor(v, o));
    return v;
}
__device__ __forceinline__ int wmap(int kind, int c) {
    if (kind == 0) return c;
    if (kind == 1) {
        if (c < 2048) { const int hh = c >> 7, w = c & 127, n = w >> 6, idx = w & 63; return hh * 128 + 32 * (idx >> 4) + 8 * ((idx >> 2) & 3) + 4 * n + (idx & 3); }
        if (c < 3072) return c;
        if (c < 4096) { const int j = c - 3072; return 3072 + 256 * (j >> 7) + (j & 127); }
        const int j = c - 4096; return 3072 + 256 * (j >> 7) + 128 + (j & 127);
    }
    return 256 * (c >> 7) + (kind == 3 ? 128 : 0) + (c & 127);
}
__device__ __forceinline__ void p0_transpose_item(const float* Wg, int K, int N, bf16* WT, int kind, LAS float* scr, int item, int lane) {
    const GAS float* W = (const GAS float*)Wg;
    const int nblk = N / 32, kb = item / nblk, nb = item % nblk, k0 = 64 * kb, n0 = 32 * nb;
#pragma unroll 8
    for (int i = 0; i < 32; ++i) { const int kk = 2 * i + (lane >> 5); scr[kk * 33 + (lane & 31)] = W[(size_t)(k0 + kk) * N + n0 + (lane & 31)]; }
    LDS_WAIT(); asm volatile("" ::: "memory");
    const int c = lane & 7;
#pragma unroll
    for (int j = 0; j < 4; ++j) { const int n = (lane >> 3) + 8 * j; const LAS float* s = scr + (8 * c) * 33 + n;
        v4u o; o.x = pk2(s[0 * 33], s[1 * 33]); o.y = pk2(s[2 * 33], s[3 * 33]); o.z = pk2(s[4 * 33], s[5 * 33]); o.w = pk2(s[6 * 33], s[7 * 33]);
        *(GAS v4u*)(WT + (size_t)wmap(kind, n0 + n) * K + k0 + 8 * c) = o; }
    LDS_WAIT(); asm volatile("" ::: "memory");
}
__device__ __forceinline__ void sincos_acc(float ang, float& sn, float& cs) {
    const double x = (double)ang, k = __builtin_rint(x * 0.63661977236758134308);
    double r = __builtin_fma(-k, 1.57079632679489655800e+00, x); r = __builtin_fma(-k, 6.12323399573676603587e-17, r);
    const int q = ((int)k) & 3; const double r2 = r * r;
    double sp = 1.0 / 6227020800.0; sp = sp * r2 - 1.0 / 39916800.0; sp = sp * r2 + 1.0 / 362880.0; sp = sp * r2 - 1.0 / 5040.0; sp = sp * r2 + 1.0 / 120.0; sp = sp * r2 - 1.0 / 6.0;
    const double s = r + r * r2 * sp;
    double cp = -1.0 / 87178291200.0; cp = cp * r2 + 1.0 / 479001600.0; cp = cp * r2 - 1.0 / 3628800.0; cp = cp * r2 + 1.0 / 40320.0; cp = cp * r2 - 1.0 / 720.0; cp = cp * r2 + 1.0 / 24.0; cp = cp * r2 - 0.5;
    const double c = 1.0 + r2 * cp;
    const double ss = (q & 1) ? c : s, cc = (q & 1) ? s : c;
    sn = (float)((q & 2) ? -ss : ss); cs = (float)(((q + 1) & 2) ? -cc : cc);
}
__device__ __forceinline__ void p0_transpose_stack(Frame& F, const float* src, int K, int N, int nmat, bf16* dst, size_t dst_stride, int kind) {
    LAS float* scr = (LAS float*)(F.lds + RING_OFF + F.wave * 16384);
    const int gw = F.vcu * NWAVES + F.wave, NGW = F.G * NWAVES, per = (K / 64) * (N / 32), total = per * nmat, lane = lane_now();
#pragma clang loop unroll(disable)
    for (int it = gw; it < total; it += NGW) { const int m = it / per, r = it - m * per;
        p0_transpose_item(src + (size_t)m * K * N, K, N, dst + (size_t)m * dst_stride, kind, scr, r, lane); }
}
__device__ __forceinline__ void p0_prologue(Frame& F) {
    p0_transpose_stack(F, F.w_in, DM, NPROJ, 2, (bf16*)(F.ws + WS_WIN), (size_t)NPROJ * DM, 1);
    p0_transpose_stack(F, F.w_out, DM, DM, 2, (bf16*)(F.ws + WS_WOUT), (size_t)DM * DM, 0);
    p0_transpose_stack(F, F.fg, DM, DFF, 1, (bf16*)(F.ws + WS_WGU0), 0, 2);
    p0_transpose_stack(F, F.fu, DM, DFF, 1, (bf16*)(F.ws + WS_WGU0), 0, 3);
    p0_transpose_stack(F, F.fd, DFF, DM, 1, (bf16*)(F.ws + WS_WD0), 0, 0);
    p0_transpose_stack(F, F.eg, DM, DFF, NE, (bf16*)(F.ws + WS_WGUE), (size_t)2 * DFF * DM, 2);
    p0_transpose_stack(F, F.eu, DM, DFF, NE, (bf16*)(F.ws + WS_WGUE), (size_t)2 * DFF * DM, 3);
    p0_transpose_stack(F, F.ed, DFF, DM, NE, (bf16*)(F.ws + WS_WDE), (size_t)DM * DFF, 0);
    { GAS float* rc = (GAS float*)(F.ws + WS_ROPEC); GAS float* rs = (GAS float*)(F.ws + WS_ROPES);
#pragma clang loop unroll(disable)
      for (int i = (F.vcu * NWAVES + F.wave) * 64 + lane_now(); i < S * 64; i += F.G * NWAVES * 64) { const int t = i >> 6, f = i & 63; const float ang = (float)t * INV_FREQ[f]; float sn, cs; sincos_acc(ang, sn, cs); rc[i] = cs; rs[i] = sn; } }
    { const GAS f32x4* xs = (const GAS f32x4*)F.x; GAS v4u* hb = (GAS v4u*)(F.ws + WS_HB);
#pragma clang loop unroll(disable)
      for (int i = (F.vcu * NWAVES + F.wave) * 64 + lane_now(); i < S * DM / 8; i += F.G * NWAVES * 64) { const f32x4 a = xs[2 * i], b = xs[2 * i + 1]; v4u o; o.x = pk2(a[0], a[1]); o.y = pk2(a[2], a[3]); o.z = pk2(b[0], b[1]); o.w = pk2(b[2], b[3]); hb[i] = o; } }
}

__device__ __forceinline__ void kmean_phase(Frame& F) {
    const int gw = F.vcu * NWAVES + F.wave, NGW = F.G * NWAVES, lane = lane_now();
#pragma clang loop unroll(disable)
    for (int unit = gw; unit < NH * NBLK; unit += NGW) { const int j = unit & 63, h = unit >> 6;
        const GAS unsigned* kp = (const GAS unsigned*)(F.ws + WS_K) + ((size_t)(j * 256) * 1024 + h * 128) / 2 + lane;
        float a0 = 0.f, a1 = 0.f;
#pragma unroll 8
        for (int r = 0; r < 256; ++r) { const unsigned w = kp[(size_t)r * 512]; a0 += bflo(w); a1 += bfhi(w); }
        a0 *= (1.f / 256.f); a1 *= (1.f / 256.f);
        const unsigned hi = pk2(a0, a1), lo = pk2(a0 - bflo(hi), a1 - bfhi(hi));
        GAS unsigned* kh = (GAS unsigned*)(F.ws + WS_KMEAN) + ((size_t)(h * 64 + j) * 128) / 2 + lane;
        kh[0] = hi; kh[NH * NBLK * HD / 2] = lo; }
}
__device__ __forceinline__ void vt_phase(Frame& F) {
    const int gw = F.vcu * NWAVES + F.wave, NGW = F.G * NWAVES, lane = lane_now();
    LAS unsigned char* tile = F.lds + RING_OFF + F.wave * 8704;
#pragma clang loop unroll(disable)
    for (int unit = gw; unit < (S / 32) * NH; unit += NGW) { const int h = unit & 7, kb = (unit >> 3) * 32;
        const GAS v4u* src = (const GAS v4u*)(F.ws + WS_V) + ((size_t)kb * 1024 + h * 128) / 8;
#pragma unroll
        for (int i = 0; i < 8; ++i) { const int row = i * 4 + (lane >> 4), c16 = lane & 15; *(LAS v4u*)(tile + row * 272 + c16 * 16) = src[(size_t)row * 128 + c16]; }
        LDS_WAIT(); asm volatile("" ::: "memory");
        const int ch = lane & 3, G = ch >> 1, g = ch & 1;
#pragma unroll
        for (int i = 0; i < 8; ++i) { const int d = i * 16 + (lane >> 2);
            unsigned short e[8];
#pragma unroll
            for (int p = 0; p < 8; ++p) { const int key = 16 * G + 8 * (p >> 2) + 4 * g + (p & 3); e[p] = *(const LAS unsigned short*)(tile + key * 272 + d * 2); }
            v4u o; o.x = (unsigned)e[0] | ((unsigned)e[1] << 16); o.y = (unsigned)e[2] | ((unsigned)e[3] << 16); o.z = (unsigned)e[4] | ((unsigned)e[5] << 16); o.w = (unsigned)e[6] | ((unsigned)e[7] << 16);
            *((GAS v4u*)(F.ws + WS_VT) + ((size_t)(h * 128 + d) * S + kb + 8 * ch) / 8) = o; }
        LDS_WAIT(); asm volatile("" ::: "memory");
    }
}

constexpr int CT = 16, CROWS = CT + 30;
__device__ __forceinline__ void conv_phase(Frame& F, int l) {
    LAS unsigned* ub = (LAS unsigned*)(F.lds + RING_OFF);
    LAS f32x2* part = (LAS f32x2*)(F.lds + RING_OFF + CROWS * 2048);
    const int lane = lane_now(), tid = F.wave * 64 + lane;
    const GAS f32x2* cw = (const GAS f32x2*)(F.conv_w + (size_t)l * CKW * 1024) + tid;
    float w0[CKW], w1[CKW];
#pragma unroll
    for (int k = 0; k < CKW; ++k) { const f32x2 w = cw[k * 512]; w0[k] = w.x; w1[k] = w.y; }
    const f32x2 cb = ((const GAS f32x2*)(F.conv_b + l * 1024))[tid], lg = ((const GAS f32x2*)(F.conv_g + l * 1024))[tid], lb = ((const GAS f32x2*)(F.conv_be + l * 1024))[tid];
    const GAS v4u* U = (const GAS v4u*)(F.ws + WS_U);
    GAS unsigned* CAT = (GAS unsigned*)(F.ws + WS_CAT);
#pragma clang loop unroll(disable)
    for (int unit = blockIdx.x; unit < S / CT; unit += F.G) { const int t0 = unit * CT;
#pragma clang loop unroll(disable)
        for (int i = tid; i < CROWS * 128; i += NWAVES * 64) { const int r = i >> 7, c16 = i & 127, tok = t0 - 30 + r;
            v4u v = (v4u){0u, 0u, 0u, 0u}; if (tok >= 0) v = U[(size_t)tok * 128 + c16];
            *(LAS v4u*)(ub + r * 512 + c16 * 4) = v; }
        __syncthreads();
        float a0[CT], a1[CT];
#pragma unroll
        for (int t = 0; t < CT; ++t) { a0[t] = cb.x; a1[t] = cb.y; }
#pragma unroll
        for (int r = 0; r < CROWS; ++r) { const unsigned w = ub[r * 512 + tid]; const float x0 = bflo(w), x1 = bfhi(w);
#pragma unroll
            for (int t = 0; t < CT; ++t) { if (r - t >= 0 && r - t <= 30) { a0[t] += w0[r - t] * x0; a1[t] += w1[r - t] * x1; } } }
#pragma unroll
        for (int t = 0; t < CT; ++t) { float s = a0[t] + a1[t], q = a0[t] * a0[t] + a1[t] * a1[t]; s = wave_sum(s); q = wave_sum(q); if (lane == 0) part[F.wave * CT + t] = (f32x2){s, q}; }
        __syncthreads();
#pragma unroll
        for (int t = 0; t < CT; ++t) { float s = 0.f, q = 0.f;
#pragma unroll
            for (int w = 0; w < 8; ++w) { const f32x2 p = part[w * CT + t]; s += p.x; q += p.y; }
            const float mean = s * (1.f / 1024.f), var = fmaxf(q * (1.f / 1024.f) - mean * mean, 0.f), rstd = 1.0f / sqrtf(var + LN_EPS);
            const float y0 = (a0[t] - mean) * rstd * lg.x + lb.x, y1 = (a1[t] - mean) * rstd * lg.y + lb.y;
            CAT[((size_t)(t0 + t) * DM + 1024) / 2 + tid] = pk2(y0 * pg8::sigmoidf_fast(y0), y1 * pg8::sigmoidf_fast(y1)); }
        __syncthreads();
    }
}

typedef float f32x16 __attribute__((ext_vector_type(16)));
typedef __bf16 bf16x2_t __attribute__((ext_vector_type(2)));
__device__ __forceinline__ unsigned cvtpk(float lo, float hi) { const f32x2 v = {lo, hi}; const bf16x2_t b = __builtin_convertvector(v, bf16x2_t); return __builtin_bit_cast(unsigned, b); }
#define MFMA32(a, b, c) __builtin_amdgcn_mfma_f32_32x32x16_bf16((a), (b), (c), 0, 0, 0)
constexpr int LIST_PER_HEAD = 256 * 2016;
__device__ __forceinline__ int binoff(int j) { return 256 * (63 * j - (j * (j - 1)) / 2); }
#define TOP3_INSERT(v, j) do { const float v_ = (v); const int j_ = (j); \
    if (v_ > tv2) { if (v_ > tv1) { tv2 = tv1; ti2 = ti1; if (v_ > tv0) { tv1 = tv0; ti1 = ti0; tv0 = v_; ti0 = j_; } else { tv1 = v_; ti1 = j_; } } else { tv2 = v_; ti2 = j_; } } } while (0)
__device__ __forceinline__ void sel_phase(Frame& F, int l) {
    LAS int* cntL = (LAS int*)(F.lds + RING_OFF); LAS int* baseL = cntL + 64;
    const int lane = lane_now(), r = lane & 31, hg = lane >> 5, tid = F.wave * 64 + lane;
    const float NEG = -__builtin_inff();
#pragma clang loop unroll(disable)
    for (int unit = blockIdx.x; unit < 63 * NH; unit += F.G) { const int b = 1 + (unit >> 3), h = unit & 7;
        if (tid < 64) cntL[tid] = 0;
        __syncthreads();
        const int t = b * 256 + F.wave * 32 + r;
        const GAS bf16x8* qp = (const GAS bf16x8*)(F.ws + WS_Q) + ((size_t)t * 1024 + h * 128) / 8 + hg;
        bf16x8 qf[8];
#pragma unroll
        for (int kk = 0; kk < 8; ++kk) qf[kk] = qp[2 * kk];
        const GAS bf16x8* kh = (const GAS bf16x8*)(F.ws + WS_KMEAN) + ((size_t)(h * 64 + r) * 128) / 8 + hg;
        f32x16 G0, G1;
#pragma unroll
        for (int i = 0; i < 16; ++i) { G0[i] = 0.f; G1[i] = 0.f; }
#pragma unroll
        for (int kk = 0; kk < 8; ++kk) { G0 = MFMA32(kh[2 * kk], qf[kk], G0); G0 = MFMA32(kh[2 * kk + NH * NBLK * HD / 8], qf[kk], G0); }
        if (b > 32) {
#pragma unroll
            for (int kk = 0; kk < 8; ++kk) { G1 = MFMA32(kh[2 * kk + 32 * 16], qf[kk], G1); G1 = MFMA32(kh[2 * kk + 32 * 16 + NH * NBLK * HD / 8], qf[kk], G1); } }
        float tv0 = NEG, tv1 = NEG, tv2 = NEG; int ti0 = 0, ti1 = 0, ti2 = 0;
#pragma unroll
        for (int i = 0; i < 16; ++i) { const int j = (i & 3) + 8 * (i >> 2) + 4 * hg; TOP3_INSERT(j < b ? G0[i] : NEG, j); }
        if (b > 32) {
#pragma unroll
            for (int i = 0; i < 16; ++i) { const int j = 32 + (i & 3) + 8 * (i >> 2) + 4 * hg; TOP3_INSERT(j < b ? G1[i] : NEG, j); } }
        { const float p0 = __shfl_xor(tv0, 32), p1 = __shfl_xor(tv1, 32), p2 = __shfl_xor(tv2, 32); const int q0 = __shfl_xor(ti0, 32), q1 = __shfl_xor(ti1, 32), q2 = __shfl_xor(ti2, 32);
          TOP3_INSERT(p0, q0); TOP3_INSERT(p1, q1); TOP3_INSERT(p2, q2); }
        int rk0 = 0, rk1 = 0, rk2 = 0;
        if (hg == 0) {
            if (tv0 > NEG) rk0 = __hip_atomic_fetch_add(cntL + ti0, 1, __ATOMIC_RELAXED, __HIP_MEMORY_SCOPE_WORKGROUP);
            if (tv1 > NEG) rk1 = __hip_atomic_fetch_add(cntL + ti1, 1, __ATOMIC_RELAXED, __HIP_MEMORY_SCOPE_WORKGROUP);
            if (tv2 > NEG) rk2 = __hip_atomic_fetch_add(cntL + ti2, 1, __ATOMIC_RELAXED, __HIP_MEMORY_SCOPE_WORKGROUP); }
        __syncthreads();
        if (tid < 64) { const int c = cntL[tid]; if (c > 0) baseL[tid] = (int)__hip_atomic_fetch_add(F.ctl + CW_LCNT + l * 512 + h * 64 + tid, (unsigned)c, RLX_AGENT); }
        __syncthreads();
        if (hg == 0) { GAS int* L = (GAS int*)(F.ws + WS_LIST) + (size_t)h * LIST_PER_HEAD;
            if (tv0 > NEG) L[binoff(ti0) + baseL[ti0] + rk0] = t * 4 + 0;
            if (tv1 > NEG) L[binoff(ti1) + baseL[ti1] + rk1] = t * 4 + 1;
            if (tv2 > NEG) L[binoff(ti2) + baseL[ti2] + rk2] = t * 4 + 2; }
        __syncthreads();
    }
}
template <bool CAUSAL>
__device__ __forceinline__ void moba_tile(const GAS bf16x8* qp, const GAS bf16x8* kp, const GAS bf16x8* vp, const int nkt, const int r, const int hg, f32x16 (&O)[4], float& ms, float& lsum) {
    const float NEG = -__builtin_inff(), SC = 0.08838834764831845f * 1.44269504088896341f;
    bf16x8 qf[8];
#pragma unroll
    for (int kk = 0; kk < 8; ++kk) qf[kk] = qp[2 * kk];
    f32x16 Sx[8];
#pragma unroll
    for (int kt = 0; kt < 8; ++kt) {
        if (kt < nkt) { f32x16 a;
#pragma unroll
            for (int i = 0; i < 16; ++i) a[i] = 0.f;
#pragma unroll
            for (int kk = 0; kk < 8; ++kk) a = MFMA32(kp[kt * 4096 + 2 * kk], qf[kk], a);
            if (CAUSAL && kt == nkt - 1) {
#pragma unroll
                for (int i = 0; i < 16; ++i) a[i] = ((i & 3) + 8 * (i >> 2) + 4 * hg > r) ? NEG : a[i]; }
            Sx[kt] = a;
        } else {
#pragma unroll
            for (int i = 0; i < 16; ++i) Sx[kt][i] = NEG; }
    }
    float mx = NEG;
#pragma unroll
    for (int kt = 0; kt < 8; ++kt)
#pragma unroll
        for (int i = 0; i < 16; ++i) mx = fmaxf(mx, Sx[kt][i]);
    mx = fmaxf(mx, __shfl_xor(mx, 32));
    ms = mx * SC;
    float ls = 0.f;
#pragma unroll
    for (int kt = 0; kt < 8; ++kt)
#pragma unroll
        for (int i = 0; i < 16; ++i) { const float p = __builtin_amdgcn_exp2f(Sx[kt][i] * SC - ms); ls += p; Sx[kt][i] = p; }
    lsum = ls + __shfl_xor(ls, 32);
#pragma unroll
    for (int dt = 0; dt < 4; ++dt)
#pragma unroll
        for (int i = 0; i < 16; ++i) O[dt][i] = 0.f;
#pragma unroll
    for (int kt = 0; kt < 8; ++kt) {
        if (kt < nkt) {
#pragma unroll
            for (int s2 = 0; s2 < 2; ++s2) { v4u pw; pw.x = cvtpk(Sx[kt][8 * s2], Sx[kt][8 * s2 + 1]); pw.y = cvtpk(Sx[kt][8 * s2 + 2], Sx[kt][8 * s2 + 3]); pw.z = cvtpk(Sx[kt][8 * s2 + 4], Sx[kt][8 * s2 + 5]); pw.w = cvtpk(Sx[kt][8 * s2 + 6], Sx[kt][8 * s2 + 7]);
                const bf16x8 pb = __builtin_bit_cast(bf16x8, pw);
#pragma unroll
                for (int dt = 0; dt < 4; ++dt) O[dt] = MFMA32(vp[(size_t)dt * (32 * S / 8) + kt * 4 + 2 * s2], pb, O[dt]); } }
    }
}
__device__ __forceinline__ void partial_phase(Frame& F, int l) {
    const int gw = F.vcu * NWAVES + F.wave, NGW = F.G * NWAVES, lane = lane_now(), r = lane & 31, hg = lane >> 5;
    gu32* lcnt = F.ctl + CW_LCNT + l * 512;
    int tl[8], sum = 0;
#pragma unroll
    for (int i = 0; i < 8; ++i) { const int c = (int)__hip_atomic_load(lcnt + lane * 8 + i, RLX_AGENT); tl[i] = (c + 31) >> 5; sum += tl[i]; }
    int inc = sum;
#pragma unroll
    for (int o = 1; o < 64; o <<= 1) { const int v = __shfl_up(inc, o); if (lane >= o) inc += v; }
    const int excl = inc - sum, total = __builtin_amdgcn_readlane(inc, 63);
#pragma clang loop unroll(disable)
    for (int u = gw; u < total; u += NGW) {
        const bool mine = (u >= excl) && (u < inc);
        int bin = 0, chunk = 0;
        { int rem = mine ? (u - excl) : -1;
#pragma unroll
          for (int i = 0; i < 8; ++i) { if (rem >= 0) { if (rem < tl[i]) { bin = lane * 8 + i; chunk = rem; rem = -1; } else rem -= tl[i]; } } }
        const int src = __builtin_ctzll(__ballot(mine)); bin = __builtin_amdgcn_readfirstlane(__shfl(bin, src)); chunk = __builtin_amdgcn_readfirstlane(__shfl(chunk, src));
        const int h = bin >> 6, j = bin & 63, n = (int)__builtin_amdgcn_readfirstlane(__hip_atomic_load(lcnt + bin, RLX_AGENT));
        const bool valid = chunk * 32 + r < n;
        const int e = ((const GAS int*)(F.ws + WS_LIST))[(size_t)h * LIST_PER_HEAD + binoff(j) + chunk * 32 + (valid ? r : 0)];
        const int t = e >> 2, sl = e & 3;
        const GAS bf16x8* qp = (const GAS bf16x8*)(F.ws + WS_Q) + ((size_t)t * 1024 + h * 128) / 8 + hg;
        const GAS bf16x8* kp = (const GAS bf16x8*)(F.ws + WS_K) + ((size_t)(j * 256 + r) * 1024 + h * 128) / 8 + hg;
        const GAS bf16x8* vp = (const GAS bf16x8*)(F.ws + WS_VT) + ((size_t)(h * 128 + r) * S + j * 256) / 8 + hg;
        f32x16 O[4]; float ms, ls;
        moba_tile<false>(qp, kp, vp, 8, r, hg, O, ms, ls);
        if (valid) { const size_t idx = ((size_t)t * NH + h) * 3 + sl; const float inv = 1.0f / ls;
            GAS v2u* po = (GAS v2u*)(F.ws + WS_PO) + idx * 32 + hg;
#pragma unroll
            for (int dt = 0; dt < 4; ++dt)
#pragma unroll
                for (int g4 = 0; g4 < 4; ++g4) po[dt * 8 + 2 * g4] = (v2u){cvtpk(O[dt][4 * g4] * inv, O[dt][4 * g4 + 1] * inv), cvtpk(O[dt][4 * g4 + 2] * inv, O[dt][4 * g4 + 3] * inv)};
            if (hg == 0) ((GAS f32x2*)(F.ws + WS_PML))[idx] = (f32x2){ms, ls}; }
    }
}
__device__ __forceinline__ void own_phase(Frame& F) {
    const int gw = F.vcu * NWAVES + F.wave, NGW = F.G * NWAVES, lane = lane_now(), r = lane & 31, hg = lane >> 5;
#pragma clang loop unroll(disable)
    for (int u = gw; u < (S / 32) * NH; u += NGW) { const int h = u & 7, T = u >> 3, b = T >> 3, qt = (T < 256) ? (7 - (T & 7)) : (T & 7);
        const int t = b * 256 + qt * 32 + r;
        const GAS bf16x8* qp = (const GAS bf16x8*)(F.ws + WS_Q) + ((size_t)t * 1024 + h * 128) / 8 + hg;
        const GAS bf16x8* kp = (const GAS bf16x8*)(F.ws + WS_K) + ((size_t)(b * 256 + r) * 1024 + h * 128) / 8 + hg;
        const GAS bf16x8* vp = (const GAS bf16x8*)(F.ws + WS_VT) + ((size_t)(h * 128 + r) * S + b * 256) / 8 + hg;
        f32x16 O[4]; float ms, ls;
        moba_tile<true>(qp, kp, vp, qt + 1, r, hg, O, ms, ls);
        const int nv = b < 3 ? b : 3; const size_t idx0 = ((size_t)t * NH + h) * 3;
        float pm[3], pl[3], M = ms;
#pragma unroll
        for (int s2 = 0; s2 < 3; ++s2) { pm[s2] = -__builtin_inff(); pl[s2] = 0.f; if (s2 < nv) { const f32x2 v = ((const GAS f32x2*)(F.ws + WS_PML))[idx0 + s2]; pm[s2] = v.x; pl[s2] = v.y; M = fmaxf(M, v.x); } }
        const float wo = __builtin_amdgcn_exp2f(ms - M); float W = ls * wo, w[3];
#pragma unroll
        for (int s2 = 0; s2 < 3; ++s2) { w[s2] = pl[s2] * __builtin_amdgcn_exp2f(pm[s2] - M); W += w[s2]; }
        const float invW = 1.0f / W;
#pragma unroll
        for (int dt = 0; dt < 4; ++dt)
#pragma unroll
            for (int i = 0; i < 16; ++i) O[dt][i] *= wo;
#pragma unroll
        for (int s2 = 0; s2 < 3; ++s2) { if (s2 < nv) { const GAS v2u* po = (const GAS v2u*)(F.ws + WS_PO) + (idx0 + s2) * 32 + hg;
#pragma unroll
                for (int dt = 0; dt < 4; ++dt)
#pragma unroll
                    for (int g4 = 0; g4 < 4; ++g4) { const v2u v = po[dt * 8 + 2 * g4]; O[dt][4 * g4] += w[s2] * bflo(v.x); O[dt][4 * g4 + 1] += w[s2] * bfhi(v.x); O[dt][4 * g4 + 2] += w[s2] * bflo(v.y); O[dt][4 * g4 + 3] += w[s2] * bfhi(v.y); } } }
        GAS v2u* co = (GAS v2u*)(F.ws + WS_CAT) + ((size_t)t * DM + h * 128) / 4 + hg;
#pragma unroll
        for (int dt = 0; dt < 4; ++dt)
#pragma unroll
            for (int g4 = 0; g4 < 4; ++g4) co[dt * 8 + 2 * g4] = (v2u){cvtpk(O[dt][4 * g4] * invW, O[dt][4 * g4 + 1] * invW), cvtpk(O[dt][4 * g4 + 2] * invW, O[dt][4 * g4 + 3] * invW)};
    }
}

__device__ __forceinline__ void ln_phase(Frame& F, const float* hres_, const float* y_, const float* g_, const float* b_, const float* router, bool write_hb) {
    const int gw = F.vcu * NWAVES + F.wave, lane = lane_now();
    const GAS f32x4* gp = (const GAS f32x4*)g_ + lane; const GAS f32x4* bp = (const GAS f32x4*)b_ + lane;
    int ecl[8];
#pragma unroll
    for (int e = 0; e < 8; ++e) ecl[e] = 0;
#pragma clang loop unroll(disable)
    for (int i = 0; i < S / (256 * NWAVES); ++i) { const int row = gw * (S / (256 * NWAVES)) + i;
        const GAS f32x4* hp = (const GAS f32x4*)(hres_ + (size_t)row * DM) + lane; const GAS f32x4* yp = (const GAS f32x4*)(y_ + (size_t)row * DM) + lane;
        f32x4 v[8]; float s = 0.f;
#pragma unroll
        for (int j = 0; j < 8; ++j) { v[j] = hp[64 * j] * ALPHA + yp[64 * j]; s += (v[j][0] + v[j][1]) + (v[j][2] + v[j][3]); }
        const float mean = wave_sum(s) * (1.f / DM); float s2 = 0.f;
#pragma unroll
        for (int j = 0; j < 8; ++j) { v[j] = v[j] - mean; s2 += (v[j][0] * v[j][0] + v[j][1] * v[j][1]) + (v[j][2] * v[j][2] + v[j][3] * v[j][3]); }
        const float rstd = 1.f / sqrtf(wave_sum(s2) * (1.f / DM) + LN_EPS);
        GAS f32x4* op = (GAS f32x4*)(F.out + (size_t)row * DM) + lane; GAS v2u* hb = (GAS v2u*)(F.ws + WS_HB + (size_t)row * DM * 2) + lane;
#pragma unroll
        for (int j = 0; j < 8; ++j) { v[j] = v[j] * rstd * gp[64 * j] + bp[64 * j]; op[64 * j] = v[j]; if (write_hb) hb[64 * j] = (v2u){pk2(v[j][0], v[j][1]), pk2(v[j][2], v[j][3])}; }
        if (router) {
            float lg[8];
#pragma unroll
            for (int e = 0; e < 8; ++e) lg[e] = 0.f;
#pragma unroll
            for (int j = 0; j < 8; ++j)
#pragma unroll
                for (int c = 0; c < 4; ++c) { const GAS f32x4* rw = (const GAS f32x4*)(router + (size_t)(256 * j + 4 * lane + c) * 8); const f32x4 r0 = rw[0], r1 = rw[1]; const float xv = v[j][c];
                    lg[0] += xv * r0[0]; lg[1] += xv * r0[1]; lg[2] += xv * r0[2]; lg[3] += xv * r0[3]; lg[4] += xv * r1[0]; lg[5] += xv * r1[1]; lg[6] += xv * r1[2]; lg[7] += xv * r1[3]; }
#pragma unroll
            for (int e = 0; e < 8; ++e) lg[e] = wave_sum(lg[e]);
            int i1 = 0; float v1 = lg[0];
#pragma unroll
            for (int e = 1; e < 8; ++e) if (lg[e] > v1) { v1 = lg[e]; i1 = e; }
            int i2 = -1; float v2 = -__builtin_inff();
#pragma unroll
            for (int e = 0; e < 8; ++e) if (e != i1 && lg[e] > v2) { v2 = lg[e]; i2 = e; }
            const float g1 = 1.0f / (1.0f + __expf(v2 - v1)), g2 = 1.0f - g1;
            if (lane == 0) { ((GAS int*)(F.ws + WS_EIDX))[row * 2] = i1; ((GAS int*)(F.ws + WS_EIDX))[row * 2 + 1] = i2; ((GAS float*)(F.ws + WS_GATEW))[row * 2] = g1; ((GAS float*)(F.ws + WS_GATEW))[row * 2 + 1] = g2; }
#pragma unroll
            for (int e = 0; e < 8; ++e) ecl[e] += (i1 == e ? 1 : 0) + (i2 == e ? 1 : 0);
        }
    }
    if (router) { int mine = 0;
#pragma unroll
        for (int e = 0; e < 8; ++e) mine = (lane == e) ? ecl[e] : mine;
        if (lane < 8 && mine) __hip_atomic_fetch_add(F.ctl + CW_ECNT + 64 * lane, (unsigned)mine, RLX_AGENT); }
}
__device__ __forceinline__ void load_expert_layout(Frame& F, int (&off)[8], int (&cum)[8], int& npanels) {
    int o = 0;
#pragma unroll
    for (int e = 0; e < 8; ++e) { const int c = (int)__builtin_amdgcn_readfirstlane(__hip_atomic_load(F.ctl + CW_ECNT + 64 * e, RLX_AGENT)); off[e] = o; cum[e] = o >> 8; o += (c + 255) & ~255; }
    npanels = o >> 8;
}
__device__ __forceinline__ void route_phase(Frame& F) {
    const int gw = F.vcu * NWAVES + F.wave, lane = lane_now();
    int off[8], cum[8], np; load_expert_layout(F, off, cum, np);
    const int row = gw * 8 + (lane >> 1), slot = lane & 1; const bool act = lane < 16;
    const int mye = act ? ((const GAS int*)(F.ws + WS_EIDX))[row * 2 + slot] : -1;
    int pos = 0;
#pragma unroll
    for (int e = 0; e < 8; ++e) { const unsigned long long mask = __ballot(mye == e);
        if (mask) { const int leader = __builtin_ctzll(mask), n = __builtin_popcountll(mask); unsigned b = 0u;
            if (lane == leader) b = __hip_atomic_fetch_add(F.ctl + CW_ECUR + 64 * e, (unsigned)n, RLX_AGENT);
            b = __shfl(b, leader);
            if (mye == e) pos = off[e] + (int)b + __builtin_popcountll(mask & ((1ull << lane) - 1ull)); } }
    if (act) ((GAS int*)(F.ws + WS_ROWPOS))[row * 2 + slot] = pos;
#pragma clang loop unroll(disable)
    for (int k = 0; k < 16; ++k) { const int p = __shfl(pos, k), r = gw * 8 + (k >> 1);
        const GAS v4u* src = (const GAS v4u*)(F.ws + WS_HB + (size_t)r * DM * 2) + lane; GAS v4u* dst = (GAS v4u*)(F.ws + WS_HBP + (size_t)p * DM * 2) + lane;
#pragma unroll
        for (int j = 0; j < 4; ++j) dst[64 * j] = src[64 * j]; }
}
__device__ __forceinline__ void ln_moe_phase(Frame& F, const float* g_, const float* b_) {
    const int gw = F.vcu * NWAVES + F.wave, lane = lane_now();
    const GAS f32x4* gp = (const GAS f32x4*)g_ + lane; const GAS f32x4* bp = (const GAS f32x4*)b_ + lane;
#pragma clang loop unroll(disable)
    for (int i = 0; i < 8; ++i) { const int row = gw * 8 + i;
        const int p1 = ((const GAS int*)(F.ws + WS_ROWPOS))[row * 2], p2 = ((const GAS int*)(F.ws + WS_ROWPOS))[row * 2 + 1];
        const float g1 = ((const GAS float*)(F.ws + WS_GATEW))[row * 2], g2 = ((const GAS float*)(F.ws + WS_GATEW))[row * 2 + 1];
        const GAS f32x4* hp = (const GAS f32x4*)(F.out + (size_t)row * DM) + lane;
        const GAS v2u* y1 = (const GAS v2u*)(F.ws + WS_R2 + (size_t)p1 * DM * 2) + lane; const GAS v2u* y2 = (const GAS v2u*)(F.ws + WS_R2 + (size_t)p2 * DM * 2) + lane;
        f32x4 v[8]; float s = 0.f;
#pragma unroll
        for (int j = 0; j < 8; ++j) { const v2u a = y1[64 * j], b = y2[64 * j];
            const f32x4 fa = (f32x4){bflo(a.x), bfhi(a.x), bflo(a.y), bfhi(a.y)}, fb = (f32x4){bflo(b.x), bfhi(b.x), bflo(b.y), bfhi(b.y)};
            v[j] = hp[64 * j] * ALPHA + fa * g1 + fb * g2; s += (v[j][0] + v[j][1]) + (v[j][2] + v[j][3]); }
        const float mean = wave_sum(s) * (1.f / DM); float s2 = 0.f;
#pragma unroll
        for (int j = 0; j < 8; ++j) { v[j] = v[j] - mean; s2 += (v[j][0] * v[j][0] + v[j][1] * v[j][1]) + (v[j][2] * v[j][2] + v[j][3] * v[j][3]); }
        const float rstd = 1.f / sqrtf(wave_sum(s2) * (1.f / DM) + LN_EPS);
        GAS f32x4* op = (GAS f32x4*)(F.out + (size_t)row * DM) + lane;
#pragma unroll
        for (int j = 0; j < 8; ++j) op[64 * j] = v[j] * rstd * gp[64 * j] + bp[64 * j];
    }
}

struct Args { const float* in[18]; float* out; unsigned char* ws; };
__global__ void __launch_bounds__(NWAVES * 64, 2) hymba_fwd(Args args) {
    extern __shared__ __attribute__((aligned(16))) unsigned char lds[];
    Frame F;
    F.lds = (LAS unsigned char*)lds;
    F.MISC = (volatile LAS unsigned*)(F.lds + MISC_OFF);
    F.wave = __builtin_amdgcn_readfirstlane((int)threadIdx.x >> 6);
    F.G = gridDim.x; { const int bx = blockIdx.x; F.vcu = (F.G % 8 == 0) ? (bx % 8) * (F.G / 8) + bx / 8 : bx; }
    F.ws = args.ws; F.ctl = (gu32*)(args.ws + WS_CTL);
    F.x = args.in[0]; F.w_in = args.in[1]; F.conv_w = args.in[2]; F.conv_b = args.in[3]; F.conv_g = args.in[4]; F.conv_be = args.in[5]; F.w_out = args.in[6];
    F.lnm_g = args.in[7]; F.lnm_b = args.in[8]; F.lnf_g = args.in[9]; F.lnf_b = args.in[10]; F.fg = args.in[11]; F.fu = args.in[12]; F.fd = args.in[13];
    F.router = args.in[14]; F.eg = args.in[15]; F.eu = args.in[16]; F.ed = args.in[17]; F.out = args.out;
    for (int u = threadIdx.x; u < (LDS_BYTES - LDSCTL_OFF) / 4; u += NWAVES * 64) ((LAS unsigned*)(F.lds + LDSCTL_OFF))[u] = 0u;
    __syncthreads();
    XcdBarrier bar = xcd_barrier_post((unsigned*)(F.ctl + CW_BAR), F.MISC + 8, F.wave);
#define LAUNDER() asm volatile("" : "+s"(F.ws), "+s"(F.ctl), "+s"(F.out), "+s"(F.x), "+s"(bar.bar), "+s"(F.wave))
#define GRID_BAR() do { LAUNDER(); xcd_barrier(bar); LAUNDER(); } while (0)
#define HB ((bf16*)(F.ws + WS_HB))
#define Y ((float*)(F.ws + WS_R2))

    p0_prologue(F);
    GRID_BAR();

#pragma clang loop unroll(disable)
    for (int l = 0; l < 2; ++l) {
#ifndef NO_G_INPROJ
        { pg8::Gemm g{HB, (const bf16*)(F.ws + WS_WIN) + (size_t)l * NPROJ * DM, S, NPROJ, DM, 0}; pg8::StaticOrder So; So.init(S, NPROJ, F.G, (int)blockIdx.x);
          pg8::EpiInProj E{(bf16*)(F.ws + WS_Q), (bf16*)(F.ws + WS_K), (bf16*)(F.ws + WS_V), (bf16*)(F.ws + WS_U), (const float*)(F.ws + WS_ROPEC), (const float*)(F.ws + WS_ROPES)};
          pg8::gemm_phase<pg8::EpiInProj, pg8::StaticOrder, true, true>(F.lds + RING_OFF, g, So, E, F.wave); }
#endif
        GRID_BAR();
        kmean_phase(F);
        vt_phase(F);
        __syncthreads();
        conv_phase(F, l);
        GRID_BAR();
        sel_phase(F, l);
        GRID_BAR();
        partial_phase(F, l);
        GRID_BAR();
        own_phase(F);
        GRID_BAR();
#ifndef NO_G_OUTPROJ
        { pg8::Gemm g{(const bf16*)(F.ws + WS_CAT), (const bf16*)(F.ws + WS_WOUT) + (size_t)l * DM * DM, S, DM, DM, 0}; pg8::StaticOrder So; So.init(S, DM, F.G, (int)blockIdx.x);
          pg8::EpiF32 E{Y, DM};
          pg8::gemm_phase<pg8::EpiF32, pg8::StaticOrder, true, true>(F.lds + RING_OFF, g, So, E, F.wave); }
#endif
        GRID_BAR();
        ln_phase(F, l == 0 ? F.x : F.out, Y, F.lnm_g + l * DM, F.lnm_b + l * DM, l == 1 ? F.router : nullptr, true);
        GRID_BAR();
        if (l == 0) {
#ifndef NO_G_FFNGU
            { pg8::Gemm g{HB, (const bf16*)(F.ws + WS_WGU0), S, 2 * DFF, DM, 0}; pg8::StaticOrder So; So.init(S, 2 * DFF, F.G, (int)blockIdx.x);
              pg8::EpiSwiGLU E{(bf16*)(F.ws + WS_ACT), DFF};
              pg8::gemm_phase<pg8::EpiSwiGLU, pg8::StaticOrder, true, true>(F.lds + RING_OFF, g, So, E, F.wave); }
#endif
            GRID_BAR();
#ifndef NO_G_FFND
            { pg8::Gemm g{(const bf16*)(F.ws + WS_ACT), (const bf16*)(F.ws + WS_WD0), S, DM, DFF, 0}; pg8::StaticOrder So; So.init(S, DM, F.G, (int)blockIdx.x);
              pg8::EpiF32 E{Y, DM};
              pg8::gemm_phase<pg8::EpiF32, pg8::StaticOrder, true, true>(F.lds + RING_OFF, g, So, E, F.wave); }
#endif
            GRID_BAR();
            ln_phase(F, F.out, Y, F.lnf_g, F.lnf_b, nullptr, true);
            GRID_BAR();
        } else {
            route_phase(F);
            GRID_BAR();
            int off[8], cum[8], np; load_expert_layout(F, off, cum, np);
#ifndef NO_G_MOEGU
            { pg8::Gemm g{(const bf16*)(F.ws + WS_HBP), (const bf16*)(F.ws + WS_WGUE), np * 256, 2 * DFF, DM, (size_t)2 * DFF * DM * 2}; pg8::GroupedOrder So; So.init(np * 256, 2 * DFF, F.G, (int)blockIdx.x);
#pragma unroll
              for (int e = 0; e < 8; ++e) So.cum[e] = cum[e];
              pg8::EpiSwiGLU E{(bf16*)(F.ws + WS_ACT), DFF};
              pg8::gemm_phase<pg8::EpiSwiGLU, pg8::GroupedOrder, true, true>(F.lds + RING_OFF, g, So, E, F.wave); }
#endif
            GRID_BAR();
#ifndef NO_G_MOED
            { pg8::Gemm g{(const bf16*)(F.ws + WS_ACT), (const bf16*)(F.ws + WS_WDE), np * 256, DM, DFF, (size_t)DM * DFF * 2}; pg8::GroupedOrder So; So.init(np * 256, DM, F.G, (int)blockIdx.x);
#pragma unroll
              for (int e = 0; e < 8; ++e) So.cum[e] = cum[e];
              pg8::EpiBf16 E{(bf16*)(F.ws + WS_R2), DM};
              pg8::gemm_phase<pg8::EpiBf16, pg8::GroupedOrder, true, true>(F.lds + RING_OFF, g, So, E, F.wave); }
#endif
            GRID_BAR();
            ln_moe_phase(F, F.lnf_g + DM, F.lnf_b + DM);
        }
    }
#undef GRID_BAR
#undef LAUNDER
#undef HB
#undef Y
}

extern "C" void kernel_launch(void* const* d_in, const int* in_sizes, int n_in, void* d_out, int out_size, void* d_ws, size_t ws_size, hipStream_t stream) {
    static int grid = 0;
    if (grid == 0) {
        if (n_in != 18 || in_sizes[0] != S * DM || out_size != S * DM || ws_size < WS_END) { fprintf(stderr, "kernel_launch: unexpected shapes (n_in %d, in0 %d, out %d, ws %zu < %zu); nothing launched\n", n_in, n_in > 0 ? in_sizes[0] : -1, out_size, ws_size, (size_t)WS_END); grid = -1; return; }
        int dev = 0, cus = 0, per_cu = 0;
        if (hipGetDevice(&dev) != hipSuccess || hipDeviceGetAttribute(&cus, hipDeviceAttributeMultiprocessorCount, dev) != hipSuccess) { grid = -1; return; }
        if (hipFuncSetAttribute((const void*)hymba_fwd, hipFuncAttributeMaxDynamicSharedMemorySize, LDS_BYTES) != hipSuccess) { fprintf(stderr, "kernel_launch: hipFuncSetAttribute failed\n"); grid = -1; return; }
        if (hipOccupancyMaxActiveBlocksPerMultiprocessor(&per_cu, (const void*)hymba_fwd, NWAVES * 64, LDS_BYTES) != hipSuccess || per_cu < 1)
            fprintf(stderr, "kernel_launch: note: occupancy query reports %d workgroups per CU\n", per_cu);
        (void)hipGetLastError();
        grid = cus;
        if (grid != 256) { fprintf(stderr, "kernel_launch: built for 256 CUs, device has %d; nothing launched\n", cus); grid = -1; return; }
    }
    if (grid < 0) return;
    if (hipMemsetAsync((char*)d_ws + WS_CTL, 0, CTL_ZERO_BYTES, stream) != hipSuccess) return;
    Args a{};
    for (int i = 0; i < 18; ++i) a.in[i] = (const float*)d_in[i];
    a.out = (float*)d_out; a.ws = (unsigned char*)d_ws;
    hipLaunchKernelGGL(hymba_fwd, dim3(grid), dim3(NWAVES * 64), LDS_BYTES, stream, a);
}
```

```cpp
#include <hip/hip_runtime.h>
#include <cstdio>
#include <cstdint>
#include <cmath>
namespace pg8 {
#define PG8_LAS __attribute__((address_space(3)))
typedef unsigned short bf16_t;
typedef short bf16x8 __attribute__((ext_vector_type(8)));
typedef float f32x4 __attribute__((ext_vector_type(4)));
typedef unsigned u32x4 __attribute__((ext_vector_type(4)));
typedef unsigned u32x2 __attribute__((ext_vector_type(2)));
typedef int v8i __attribute__((ext_vector_type(8)));
typedef int v4i __attribute__((ext_vector_type(4)));
constexpr int BM = 256, BK = 64, HALF = 128, HTB = HALF * BK * 2  , STAGE_BYTES = 8 * HTB, NXCD = 8, WGM = 8;

__host__ __device__ __forceinline__ int lds_byte(int r, int c) { const int st = (r >> 4) * 2 + (c >> 5), rr = r & 15, cc = c & 31, ob = rr * 64 + cc * 2; return st * 1024 + (ob ^ (((ob >> 9) & 1) << 5)); }
__host__ __device__ __forceinline__ void stage_rc(int b, int& R, int& C) { const int st = b / 1024, sb = b % 1024, swz = sb ^ (((sb >> 9) & 1) << 5); R = (st >> 1) * 16 + swz / 64; C = (st & 1) * 32 + (swz % 64) / 2; }
__host__ __device__ __forceinline__ int perm32(int rho) { const int n = rho >> 4, i = rho & 15; return 8 * (i >> 2) + 4 * n + (i & 3); }

struct Unit { int pm, pn, e; };
struct Gemm { const bf16_t* A; const bf16_t* Bt; int M, N, K; size_t bstride; };

struct StaticOrder {
    int nM, nN, nwg, G, c;
    __host__ __device__ void init(int M, int N, int G_, int c_) { nM = M / BM; nN = N / BM; nwg = nM * nN; G = G_; c = c_; }
    __host__ __device__ bool next(int i, Unit& u) const {
        const long L = (long)i * G + c; if (L >= nwg) return false;
        int wgid = (int)L; { const int q = nwg / NXCD, r = nwg % NXCD, xcd = wgid % NXCD, off = wgid / NXCD; wgid = (xcd < r ? xcd * (q + 1) : r * (q + 1) + (xcd - r) * q) + off; }
        const int nig = WGM * nN, gid = wgid / nig, fm = gid * WGM, gsz = (nM - fm) < WGM ? (nM - fm) : WGM;
        u.pm = fm + ((wgid % nig) % gsz); u.pn = (wgid % nig) / gsz; u.e = 0; return true;
    }
    __device__ __forceinline__ void a_ready(const Unit&) const {}
    __device__ __forceinline__ void done(const Unit&) const {}
};
struct GroupedOrder : StaticOrder {
    int cum[8];
    __device__ bool next(int i, Unit& u) const {
        if (!StaticOrder::next(i, u)) return false;
        int e = 0;
#pragma unroll
        for (int j = 1; j < 8; ++j) e += (u.pm >= cum[j]) ? 1 : 0;
        u.e = e; return true;
    }
};

__device__ __forceinline__ unsigned cvt_pk_bf16(float lo, float hi) { unsigned r; asm volatile("v_cvt_pk_bf16_f32 %0, %1, %2" : "=v"(r) : "v"(lo), "v"(hi)); return r; }
__device__ __forceinline__ float sigmoidf_fast(float g) { return __builtin_amdgcn_rcpf(1.0f + __builtin_amdgcn_exp2f(-1.44269504089f * g)); }

__device__ __forceinline__ unsigned pk4_fp8(float a, float b, float c, float d) {
    unsigned w = 0u; w = __builtin_amdgcn_cvt_pk_fp8_f32(__builtin_amdgcn_fmed3f(a, -448.f, 448.f), __builtin_amdgcn_fmed3f(b, -448.f, 448.f), w, false);
    return __builtin_amdgcn_cvt_pk_fp8_f32(__builtin_amdgcn_fmed3f(c, -448.f, 448.f), __builtin_amdgcn_fmed3f(d, -448.f, 448.f), w, true); }
struct EpiF32 {
    static constexpr bool PERM = false, AFTER_DRAIN = false;
    float* C; int ldc;
    __device__ __forceinline__ void operator()(const f32x4 (&acc)[2][2][4][2], const Unit& u, int wr, int wc, int fr, int fq) const {
        const int row0 = u.pm * BM + wr * 64 + fr, col0 = u.pn * BM + wc * 32 + 4 * fq;
#pragma unroll
        for (int ai = 0; ai < 2; ++ai)
#pragma unroll
            for (int m = 0; m < 4; ++m) { float* rowp = C + (size_t)(row0 + ai * HALF + m * 16) * ldc + col0;
#pragma unroll
                for (int bj = 0; bj < 2; ++bj)
#pragma unroll
                    for (int n = 0; n < 2; ++n) *(f32x4*)(rowp + bj * HALF + n * 16) = acc[ai][bj][m][n]; }
    }
};
struct EpiBf16 {
    static constexpr bool PERM = true, AFTER_DRAIN = false;
    bf16_t* O; int ldc; float sc;
    __device__ __forceinline__ void operator()(const f32x4 (&acc)[2][2][4][2], const Unit& u, int wr, int wc, int fr, int fq) const {
        const int row0 = u.pm * BM + wr * 64 + fr, col0 = u.pn * BM + wc * 32 + 8 * fq;
#pragma unroll
        for (int ai = 0; ai < 2; ++ai)
#pragma unroll
            for (int m = 0; m < 4; ++m) { bf16_t* rowp = O + (size_t)(row0 + ai * HALF + m * 16) * ldc + col0;
#pragma unroll
                for (int bj = 0; bj < 2; ++bj) { const f32x4 v0 = acc[ai][bj][m][0] * sc, v1 = acc[ai][bj][m][1] * sc;
                    u32x4 w; w.x = cvt_pk_bf16(v0[0], v0[1]); w.y = cvt_pk_bf16(v0[2], v0[3]); w.z = cvt_pk_bf16(v1[0], v1[1]); w.w = cvt_pk_bf16(v1[2], v1[3]);
                    *(u32x4*)(rowp + bj * HALF) = w; } }
    }
};
struct EpiSwiGLU {
    static constexpr bool PERM = true, AFTER_DRAIN = false;
    bf16_t* O; int ldc;
    __device__ __forceinline__ void operator()(const f32x4 (&acc)[2][2][4][2], const Unit& u, int wr, int wc, int fr, int fq) const {
        const int row0 = u.pm * BM + wr * 64 + fr, col0 = u.pn * HALF + wc * 32 + 8 * fq;
#pragma unroll
        for (int ai = 0; ai < 2; ++ai)
#pragma unroll
            for (int m = 0; m < 4; ++m) { bf16_t* rowp = O + (size_t)(row0 + ai * HALF + m * 16) * ldc + col0;
                float o[8];
#pragma unroll
                for (int n = 0; n < 2; ++n)
#pragma unroll
                    for (int j = 0; j < 4; ++j) { const float g = acc[ai][0][m][n][j], up = acc[ai][1][m][n][j]; o[n * 4 + j] = g * sigmoidf_fast(g) * up; }
                u32x4 w; w.x = cvt_pk_bf16(o[0], o[1]); w.y = cvt_pk_bf16(o[2], o[3]); w.z = cvt_pk_bf16(o[4], o[5]); w.w = cvt_pk_bf16(o[6], o[7]);
                *(u32x4*)rowp = w; }
    }
};
struct EpiSwiGLU8 {
    static constexpr bool PERM = true, AFTER_DRAIN = false;
    unsigned char* O; int ldc; float sin, sout;
    __device__ __forceinline__ void operator()(const f32x4 (&acc)[2][2][4][2], const Unit& u, int wr, int wc, int fr, int fq) const {
        const int row0 = u.pm * BM + wr * 64 + fr, col0 = u.pn * HALF + wc * 32 + 8 * fq;
#pragma unroll
        for (int ai = 0; ai < 2; ++ai)
#pragma unroll
            for (int m = 0; m < 4; ++m) { unsigned char* rowp = O + (size_t)(row0 + ai * HALF + m * 16) * ldc + col0;
                float o[8];
#pragma unroll
                for (int n = 0; n < 2; ++n)
#pragma unroll
                    for (int j = 0; j < 4; ++j) { const float g = acc[ai][0][m][n][j] * sin, up = acc[ai][1][m][n][j] * sin; o[n * 4 + j] = g * sigmoidf_fast(g) * up * sout; }
                u32x2 w; w.x = pk4_fp8(o[0], o[1], o[2], o[3]); w.y = pk4_fp8(o[4], o[5], o[6], o[7]);
                *(u32x2*)rowp = w; }
    }
};
struct EpiInProj {
    static constexpr bool PERM = true, AFTER_DRAIN = false;
    bf16_t *Q, *Kb, *V, *U; const float *ropeC, *ropeS;
    __device__ __forceinline__ void operator()(const f32x4 (&acc)[2][2][4][2], const Unit& u, int wr, int wc, int fr, int fq) const {
        const int row0 = u.pm * BM + wr * 64 + fr;
        if (u.pn < 8) {
            bf16_t* base = (u.pn < 4) ? Q : Kb; const int col0 = (u.pn & 3) * BM + wc * 32 + 8 * fq, idx0 = 16 * wc + 4 * fq;
#pragma unroll
            for (int ai = 0; ai < 2; ++ai)
#pragma unroll
                for (int m = 0; m < 4; ++m) { const int row = row0 + ai * HALF + m * 16;
                    const f32x4 cs = *(const f32x4*)(ropeC + (size_t)row * 64 + idx0), sn = *(const f32x4*)(ropeS + (size_t)row * 64 + idx0);
#pragma unroll
                    for (int bj = 0; bj < 2; ++bj) { const f32x4 x1 = acc[ai][bj][m][0], x2 = acc[ai][bj][m][1];
                        const f32x4 o1 = x1 * cs - x2 * sn, o2 = x2 * cs + x1 * sn;
                        u32x4 w; w.x = cvt_pk_bf16(o1[0], o1[1]); w.y = cvt_pk_bf16(o1[2], o1[3]); w.z = cvt_pk_bf16(o2[0], o2[1]); w.w = cvt_pk_bf16(o2[2], o2[3]);
                        *(u32x4*)(base + (size_t)row * 1024 + col0 + bj * HALF) = w; } }
        } else if (u.pn < 12) {
            const int col0 = (u.pn - 8) * BM + wc * 32 + 8 * fq;
#pragma unroll
            for (int ai = 0; ai < 2; ++ai)
#pragma unroll
                for (int m = 0; m < 4; ++m) { bf16_t* rowp = V + (size_t)(row0 + ai * HALF + m * 16) * 1024 + col0;
#pragma unroll
                    for (int bj = 0; bj < 2; ++bj) { const f32x4 v0 = acc[ai][bj][m][0], v1 = acc[ai][bj][m][1];
                        u32x4 w; w.x = cvt_pk_bf16(v0[0], v0[1]); w.y = cvt_pk_bf16(v0[2], v0[3]); w.z = cvt_pk_bf16(v1[0], v1[1]); w.w = cvt_pk_bf16(v1[2], v1[3]);
                        *(u32x4*)(rowp + bj * HALF) = w; } }
        } else {
            const int col0 = (u.pn - 12) * HALF + wc * 32 + 8 * fq;
#pragma unroll
            for (int ai = 0; ai < 2; ++ai)
#pragma unroll
                for (int m = 0; m < 4; ++m) { bf16_t* rowp = U + (size_t)(row0 + ai * HALF + m * 16) * 1024 + col0;
                    float o[8];
#pragma unroll
                    for (int n = 0; n < 2; ++n)
#pragma unroll
                        for (int j = 0; j < 4; ++j) o[n * 4 + j] = acc[ai][0][m][n][j] * sigmoidf_fast(acc[ai][1][m][n][j]);
                    u32x4 w; w.x = cvt_pk_bf16(o[0], o[1]); w.y = cvt_pk_bf16(o[2], o[3]); w.z = cvt_pk_bf16(o[4], o[5]); w.w = cvt_pk_bf16(o[6], o[7]);
                    *(u32x4*)rowp = w; }
        }
    }
};

template <class Epi, class Sched, bool ALIGN_EPI = false, bool SP2 = false, bool FP8 = false>
__device__ __forceinline__ void gemm_phase(PG8_LAS unsigned char* lds, const Gemm g, const Sched& S, const Epi& E, const int wave_in) {
    int lane; asm volatile("v_mbcnt_lo_u32_b32 %0, -1, 0\n\tv_mbcnt_hi_u32_b32 %0, -1, %0" : "=v"(lane));
    const int wid = wave_in, tid = wid * 64 + lane, wr = wid >> 2, wc = wid & 3, fr = lane & 15, fq = lane >> 4;
    const int K = g.K, nt = K / BK;
    unsigned voffA[2], voffB[2];
#pragma unroll
    for (int i = 0; i < 2; ++i) { int R, C; stage_rc(tid * 16 + i * 8192, R, C); const int Rb = Epi::PERM ? ((R & ~31) + perm32(R & 31)) : R;
        voffA[i] = (unsigned)(R * K + C) * 2u; voffB[i] = (unsigned)(Rb * K + C) * 2u; }
    const size_t kstep = (size_t)(BK * 2);
    const size_t hstep = (size_t)HALF * K * 2;
    const size_t tstep = 2 * hstep;
    const unsigned ldsw = (unsigned)wid * 1024u;
    const int aoff = lds_byte(wr * 64 + fr, fq * 8), boff = lds_byte(wc * 32 + fr, fq * 8);
#define PG8_SA(b, h) (((b) * 2 + (h)) * HTB)
#define PG8_SB(b, h) ((4 + (b) * 2 + (h)) * HTB)
#define PG8_STAGE(bufoff, gbase, voff) do { _Pragma("unroll") for (int _i = 0; _i < 2; ++_i) \
        __builtin_amdgcn_global_load_lds((const unsigned*)((const char*)(gbase) + (voff)[_i]), (PG8_LAS unsigned*)(lds + (bufoff) + ldsw + _i * 8192), 16, 0, 0); } while (0)
#define PG8_LDA(dst, b, h) do { if constexpr (FP8) { _Pragma("unroll") for (int m = 0; m < 4; ++m) { const v4i lo_ = *(const PG8_LAS v4i*)(lds + PG8_SA(b, h) + aoff + m * 2048), hi_ = *(const PG8_LAS v4i*)(lds + PG8_SA(b, h) + aoff + m * 2048 + 1024); \
            dst##8[m] = __builtin_shufflevector(lo_, hi_, 0, 1, 2, 3, 4, 5, 6, 7); } } \
        else { _Pragma("unroll") for (int m = 0; m < 4; ++m) _Pragma("unroll") for (int k = 0; k < 2; ++k) dst[m][k] = *(const PG8_LAS bf16x8*)(lds + PG8_SA(b, h) + aoff + m * 2048 + k * 1024); } } while (0)
#define PG8_LDB(dst, b, h) do { if constexpr (FP8) { _Pragma("unroll") for (int n = 0; n < 2; ++n) { const v4i lo_ = *(const PG8_LAS v4i*)(lds + PG8_SB(b, h) + boff + n * 2048), hi_ = *(const PG8_LAS v4i*)(lds + PG8_SB(b, h) + boff + n * 2048 + 1024); \
            dst##8[n] = __builtin_shufflevector(lo_, hi_, 0, 1, 2, 3, 4, 5, 6, 7); } } \
        else { _Pragma("unroll") for (int n = 0; n < 2; ++n) _Pragma("unroll") for (int k = 0; k < 2; ++k) dst[n][k] = *(const PG8_LAS bf16x8*)(lds + PG8_SB(b, h) + boff + n * 2048 + k * 1024); } } while (0)
#define PG8_MMA(ai, bj, At, Bt) do { __builtin_amdgcn_s_setprio(1); \
        if constexpr (FP8) {   \
            _Pragma("unroll") for (int m = 0; m < 4; ++m) _Pragma("unroll") for (int n = 0; n < 2; ++n) \
                asm volatile("v_mfma_f32_16x16x128_f8f6f4 %0, %1, %2, %0" : "+v"(acc[ai][bj][m][n]) : "v"(Bt##8[n]), "v"(At##8[m]));   \
        } else { _Pragma("unroll") for (int m = 0; m < 4; ++m) _Pragma("unroll") for (int n = 0; n < 2; ++n) _Pragma("unroll") for (int k = 0; k < 2; ++k) \
            acc[ai][bj][m][n] = __builtin_amdgcn_mfma_f32_16x16x32_bf16(Bt[n][k], At[m][k], acc[ai][bj][m][n], 0, 0, 0); } \
        __builtin_amdgcn_s_setprio(0); } while (0)
#define PG8_WAIT_V(n) asm volatile("s_waitcnt vmcnt(" #n ")" ::: "memory")
#define PG8_WAIT_L(n) asm volatile("s_waitcnt lgkmcnt(" #n ")" ::: "memory")
#define PG8_BAR __builtin_amdgcn_s_barrier()
#define PG8_SCHED __builtin_amdgcn_sched_barrier(0)
    Unit cur, nxt; int ui = 0;
    if (!S.next(0, cur)) return;
    f32x4 acc[2][2][4][2];
#pragma unroll
    for (int a = 0; a < 2; ++a)
#pragma unroll
        for (int b = 0; b < 2; ++b)
#pragma unroll
            for (int m = 0; m < 4; ++m)
#pragma unroll
                for (int n = 0; n < 2; ++n) acc[a][b][m][n] = (f32x4){0.f, 0.f, 0.f, 0.f};
    bf16x8 At[4][2], B0[2][2], B1[2][2]; v8i At8[4], B08[2], B18[2];
    const char* cA = (const char*)g.A + (size_t)cur.pm * tstep; const char* cB = (const char*)g.Bt + (size_t)cur.e * g.bstride + (size_t)cur.pn * tstep;
    S.a_ready(cur);
    if constexpr (SP2) {
        PG8_STAGE(PG8_SB(0, 0), cB, voffB); PG8_STAGE(PG8_SB(0, 1), cB + hstep, voffB); PG8_STAGE(PG8_SA(0, 0), cA, voffA); PG8_STAGE(PG8_SA(0, 1), cA + hstep, voffA);
        if (wr == 1) PG8_BAR;
        PG8_WAIT_V(2); PG8_BAR;
        PG8_STAGE(PG8_SB(1, 0), cB + kstep, voffB); PG8_STAGE(PG8_SA(1, 0), cA + kstep, voffA); PG8_STAGE(PG8_SB(1, 1), cB + hstep + kstep, voffB);
        PG8_WAIT_V(6); PG8_BAR;
    } else {
        PG8_STAGE(PG8_SB(0, 0), cB, voffB); PG8_STAGE(PG8_SA(0, 0), cA, voffA); PG8_STAGE(PG8_SB(0, 1), cB + hstep, voffB); PG8_STAGE(PG8_SA(0, 1), cA + hstep, voffA);
        if (wr == 1) PG8_BAR;
        PG8_WAIT_V(4); PG8_BAR;
        PG8_STAGE(PG8_SB(1, 0), cB + kstep, voffB); PG8_STAGE(PG8_SA(1, 0), cA + kstep, voffA); PG8_STAGE(PG8_SB(1, 1), cB + hstep + kstep, voffB);
        PG8_WAIT_V(6); PG8_BAR;
    }
    for (;;) {
        const bool has_next = S.next(ui + 1, nxt);
        const char* nA = has_next ? (const char*)g.A + (size_t)nxt.pm * tstep : cA; const char* nB = has_next ? (const char*)g.Bt + (size_t)nxt.e * g.bstride + (size_t)nxt.pn * tstep : cB;
        for (int t = 0; t < nt; t += 2) {
            const bool last = (t == nt - 2);
            const char* a1 = cA + (size_t)(t + 1) * kstep;
            const char* a2 = last ? nA : cA + (size_t)(t + 2) * kstep; const char* b2 = last ? nB : cB + (size_t)(t + 2) * kstep;
            const char* a3 = a2 + kstep; const char* b3 = b2 + kstep;
            if (last && has_next) S.a_ready(nxt);
            if constexpr (SP2) {
            PG8_LDB(B0, 0, 0); PG8_LDB(B1, 0, 1); PG8_SCHED; PG8_LDA(At, 0, 0); PG8_STAGE(PG8_SA(1, 1), a1 + hstep, voffA);
            PG8_WAIT_V(8); PG8_WAIT_L(0); PG8_BAR; PG8_MMA(0, 0, At, B0); PG8_MMA(0, 1, At, B1); PG8_BAR; PG8_SCHED;
            PG8_LDA(At, 0, 1); PG8_STAGE(PG8_SB(0, 0), b2, voffB); PG8_STAGE(PG8_SB(0, 1), b2 + hstep, voffB); PG8_STAGE(PG8_SA(0, 0), a2, voffA);
            PG8_WAIT_V(8); PG8_WAIT_L(0); PG8_BAR; PG8_MMA(1, 0, At, B0); PG8_MMA(1, 1, At, B1); PG8_BAR; PG8_SCHED;
            PG8_LDB(B0, 1, 0); PG8_LDB(B1, 1, 1); PG8_SCHED; PG8_LDA(At, 1, 0); PG8_STAGE(PG8_SA(0, 1), a2 + hstep, voffA);
            PG8_WAIT_V(8); PG8_WAIT_L(0); PG8_BAR; PG8_MMA(0, 0, At, B0); PG8_MMA(0, 1, At, B1); PG8_BAR; PG8_SCHED;
            PG8_LDA(At, 1, 1); PG8_STAGE(PG8_SB(1, 0), b3, voffB); PG8_STAGE(PG8_SB(1, 1), b3 + hstep, voffB); PG8_STAGE(PG8_SA(1, 0), a3, voffA);
            PG8_WAIT_V(8); PG8_WAIT_L(0); PG8_BAR; PG8_MMA(1, 0, At, B0); PG8_MMA(1, 1, At, B1); PG8_BAR; PG8_SCHED;
            } else {
            PG8_LDB(B0, 0, 0); PG8_SCHED; PG8_LDA(At, 0, 0); PG8_STAGE(PG8_SA(1, 1), a1 + hstep, voffA);
            PG8_WAIT_L(8); PG8_BAR; PG8_WAIT_L(0); PG8_MMA(0, 0, At, B0); PG8_BAR; PG8_SCHED;
            PG8_LDB(B1, 0, 1); PG8_STAGE(PG8_SB(0, 0), b2, voffB);
            PG8_BAR; PG8_WAIT_L(0); PG8_MMA(0, 1, At, B1); PG8_BAR;
            PG8_LDA(At, 0, 1); PG8_STAGE(PG8_SA(0, 0), a2, voffA);
            PG8_BAR; PG8_WAIT_L(0); PG8_MMA(1, 0, At, B0); PG8_BAR; PG8_SCHED;
            PG8_STAGE(PG8_SB(0, 1), b2 + hstep, voffB);
            PG8_WAIT_V(6); PG8_BAR; PG8_MMA(1, 1, At, B1); PG8_BAR;
            PG8_LDB(B0, 1, 0); PG8_SCHED; PG8_LDA(At, 1, 0); PG8_STAGE(PG8_SA(0, 1), a2 + hstep, voffA);
            PG8_WAIT_L(8); PG8_BAR; PG8_WAIT_L(0); PG8_MMA(0, 0, At, B0); PG8_BAR; PG8_SCHED;
            PG8_LDB(B1, 1, 1); PG8_STAGE(PG8_SB(1, 0), b3, voffB);
            PG8_BAR; PG8_WAIT_L(0); PG8_MMA(0, 1, At, B1); PG8_BAR;
            PG8_LDA(At, 1, 1); PG8_STAGE(PG8_SA(1, 0), a3, voffA);
            PG8_BAR; PG8_WAIT_L(0); PG8_MMA(1, 0, At, B0); PG8_BAR; PG8_SCHED;
            PG8_STAGE(PG8_SB(1, 1), b3 + hstep, voffB);
            PG8_WAIT_V(6); PG8_BAR; PG8_MMA(1, 1, At, B1); PG8_BAR;
            }
        }
        if constexpr (FP8) asm volatile("s_nop 15\n\ts_nop 15" ::: "memory");
        if constexpr (ALIGN_EPI) { if (wr == 0) PG8_BAR; }
        if constexpr (!Epi::AFTER_DRAIN) { E(acc, cur, wr, wc, fr, fq); S.done(cur); }
        if (!has_next) break;
#pragma unroll
        for (int a = 0; a < 2; ++a)
#pragma unroll
            for (int b = 0; b < 2; ++b)
#pragma unroll
                for (int m = 0; m < 4; ++m)
#pragma unroll
                    for (int n = 0; n < 2; ++n) acc[a][b][m][n] = (f32x4){0.f, 0.f, 0.f, 0.f};
        cur = nxt; cA = nA; cB = nB; ++ui;
        if constexpr (ALIGN_EPI) { if (wr == 1) PG8_BAR; }
    }
    PG8_WAIT_V(0);
    if constexpr (!ALIGN_EPI) { if (wr == 0) PG8_BAR; }
    PG8_BAR;
    if constexpr (Epi::AFTER_DRAIN) { E.fused(acc, cur, wr, wc, fr, fq, lds, wid, lane); S.done(cur); }
#undef PG8_SA
#undef PG8_SB
#undef PG8_STAGE
#undef PG8_LDA
#undef PG8_LDB
#undef PG8_MMA
#undef PG8_WAIT_V
#undef PG8_WAIT_L
#undef PG8_BAR
#undef PG8_SCHED
}
}

constexpr int NWAVES = 8;
constexpr int S = 16384, DM = 2048, NPROJ = 5120, AW = 1024, HD = 128, NH = 8, DFF = 5632, NE = 8, CKW = 31, NBLK = 64;
constexpr float LN_EPS = 1e-5f, ALPHA = 1.41421356237309515f;
constexpr int MOE_ROWS = 2 * S + NE * 256;
constexpr float WSC_GU = 32.f, WSC_D = 128.f, ASC_H = 4.f, ASC_ACT = 8.f;

constexpr size_t MiB = 1u << 20;
constexpr size_t WS_CTL = 0, CTL_ZERO_BYTES = 1 * MiB;
constexpr size_t WS_ROPEC = 1 * MiB, WS_ROPES = 5 * MiB;
constexpr size_t WS_KMEAN = 9 * MiB;
constexpr size_t WS_EIDX = 9 * MiB + 512 * 1024, WS_GATEW = WS_EIDX + 128 * 1024, WS_ROWPOS = WS_GATEW + 128 * 1024;
constexpr size_t WS_WIN = 10 * MiB, WS_WOUT = 50 * MiB, WS_WGU0 = 66 * MiB, WS_WD0 = 110 * MiB, WS_WGUE = 132 * MiB, WS_WDE = 484 * MiB;
constexpr size_t WS_HB = 660 * MiB;
constexpr size_t WS_R2 = 724 * MiB;
constexpr size_t WS_HBP = 860 * MiB;
constexpr size_t WS_R1 = 996 * MiB;
constexpr size_t WS_Q = WS_R1, WS_K = WS_R1 + 32 * MiB, WS_V = WS_R1 + 64 * MiB, WS_U = WS_R1 + 96 * MiB, WS_CAT = WS_R1 + 128 * MiB, WS_ACT = WS_R1;
constexpr size_t WS_VT = WS_R1 + 192 * MiB, WS_PO = WS_R1 + 224 * MiB, WS_PML = WS_R1 + 320 * MiB, WS_LIST = WS_R1 + 324 * MiB;
constexpr size_t WS_END = 1370 * MiB;
static_assert(WS_R1 + (size_t)MOE_ROWS * DFF * 2 <= WS_END && WS_HBP + (size_t)MOE_ROWS * DM * 2 <= WS_R1 && WS_R2 + (size_t)MOE_ROWS * DM * 2 <= WS_HBP, "d_ws map");
static_assert(WS_WDE + (size_t)NE * DM * DFF * 2 <= WS_HB && WS_WGUE + (size_t)NE * 2 * DFF * DM * 2 <= WS_WDE, "d_ws weights map");
constexpr int CW_TMO = 0, CW_CODE = 1, CW_BAR = 4096, CW_ECNT = 8192, CW_ECUR = 8192 + 64 * 8, CW_LCNT = 12288;
constexpr int RING_OFF = 0, RING_BYTES = 131072;
constexpr int LDSCTL_OFF = 139264, MISC_OFF = LDSCTL_OFF + 320;
constexpr int LDS_BYTES = 147456;

__device__ const float INV_FREQ[64] = {
1.000000000e+00f, 8.659643531e-01f, 7.498942018e-01f, 6.493816376e-01f, 5.623413324e-01f, 4.869675338e-01f, 4.216965139e-01f, 3.651741147e-01f, 3.162277639e-01f, 2.738419771e-01f, 2.371373773e-01f, 2.053525001e-01f, 1.778279394e-01f, 1.539926529e-01f, 1.333521456e-01f, 1.154781953e-01f, 1.000000015e-01f, 8.659642935e-02f, 7.498942316e-02f, 6.493816525e-02f, 5.623413250e-02f, 4.869675264e-02f, 4.216964915e-02f, 3.651741147e-02f, 3.162277490e-02f, 2.738419548e-02f, 2.371373773e-02f, 2.053525113e-02f, 1.778279431e-02f, 1.539926510e-02f, 1.333521400e-02f, 1.154781971e-02f, 9.999999776e-03f, 8.659643121e-03f, 7.498942316e-03f, 6.493816152e-03f, 5.623413250e-03f, 4.869675264e-03f, 4.216964822e-03f, 3.651741194e-03f, 3.162277630e-03f, 2.738419687e-03f, 2.371373819e-03f, 2.053525066e-03f, 1.778279431e-03f, 1.539926510e-03f, 1.333521446e-03f, 1.154782018e-03f, 1.000000047e-03f, 8.659643354e-04f, 7.498941850e-04f, 6.493816036e-04f, 5.623413017e-04f, 4.869675322e-04f, 4.216965172e-04f, 3.651741135e-04f, 3.162277571e-04f, 2.738419571e-04f, 2.371373703e-04f, 2.053525095e-04f, 1.778279402e-04f, 1.539926598e-04f, 1.333521504e-04f, 1.154782003e-04f
};

#define GAS __attribute__((address_space(1)))
#define LAS __attribute__((address_space(3)))
typedef unsigned short bf16;
typedef unsigned v4u __attribute__((ext_vector_type(4)));
typedef unsigned v2u __attribute__((ext_vector_type(2)));
typedef float f32x4 __attribute__((ext_vector_type(4)));
typedef float f32x2 __attribute__((ext_vector_type(2)));
typedef short bf16x8 __attribute__((ext_vector_type(8)));
typedef GAS unsigned gu32;
typedef GAS unsigned long long gu64;
#define RLX_AGENT __ATOMIC_RELAXED, __HIP_MEMORY_SCOPE_AGENT
#define LDS_WAIT() asm volatile("s_waitcnt lgkmcnt(0)" ::: "memory")
#define VM_WAIT() asm volatile("s_waitcnt vmcnt(0)" ::: "memory")
__device__ __forceinline__ unsigned f2bf(float f) { unsigned u = __builtin_bit_cast(unsigned, f); return (u + 0x7fffu + ((u >> 16) & 1u)) >> 16; }
__device__ __forceinline__ unsigned pk2(float lo, float hi) { return f2bf(lo) | (f2bf(hi) << 16); }
__device__ __forceinline__ float bflo(unsigned w) { return __builtin_bit_cast(float, w << 16); }
__device__ __forceinline__ float bfhi(unsigned w) { return __builtin_bit_cast(float, w & 0xffff0000u); }

#define XB_TMO      128
#define XB_XCNT(j)  (256  + 64 * (j))
#define XB_XSUB(j)  (1280 + 64 * (j))
#define XB_XGEN(j)  (2304 + 64 * (j))
#define XB_TOP      3328
#define XB_TOPGEN   3392
#define XCD_BAR_WORDS 3456
#define XB_SPIN_CAP (1u << 22)

__device__ __forceinline__ unsigned xb_ld(unsigned* p)              { return __hip_atomic_load(p, __ATOMIC_RELAXED, __HIP_MEMORY_SCOPE_AGENT); }
__device__ __forceinline__ unsigned xb_add(unsigned* p, unsigned v) { return __hip_atomic_fetch_add(p, v, __ATOMIC_RELAXED, __HIP_MEMORY_SCOPE_AGENT); }
__device__ __forceinline__ unsigned xb_xcc_id() { return (unsigned)__builtin_amdgcn_s_getreg((3 << 11) | 20) & 0xFu; }
#define XB_SPIN(cond, bar) do { unsigned _sp = 0; while (cond) { __builtin_amdgcn_s_sleep(1); \
    if ((++_sp & 255u) == 0u) { if (xb_ld(&(bar)[XB_TMO])) break; if (_sp > XB_SPIN_CAP) { atomicAdd(&(bar)[XB_TMO], 1u); break; } } } } while (0)

__device__ __forceinline__ int lane_now() { int l; asm volatile("v_mbcnt_lo_u32_b32 %0, -1, 0\n\tv_mbcnt_hi_u32_b32 %0, -1, %0" : "=v"(l)); return l; }
#define XB_T0() (b.w0 == 0 && lane_now() == 0)
struct XcdBarrier {
    unsigned* bar; unsigned x; int w0;
    volatile LAS unsigned* st;
};

__device__ __forceinline__ XcdBarrier xcd_barrier_post(unsigned* bar, volatile LAS unsigned* st, int w0) {
    XcdBarrier b; b.bar = bar; b.x = xb_xcc_id(); b.st = st; b.w0 = w0;
    if (XB_T0()) (void)xb_add(&bar[XB_XCNT(b.x)], 1u);
    return b;
}
__device__ __forceinline__ void xcd_barrier_complete(unsigned* bar, unsigned x, unsigned& nloc, unsigned& nx) {
    const unsigned G = gridDim.x * gridDim.y * gridDim.z;
    unsigned sum, cnt, mine, sp = 0u;
    for (;;) {
        sum = 0u; cnt = 0u; mine = 0u;
#pragma unroll
        for (unsigned j = 0; j < 16; ++j) { const unsigned c = xb_ld(&bar[XB_XCNT(j)]); sum += c; cnt += (c > 0u) ? 1u : 0u; mine = (j == x) ? c : mine; }
        if (sum == G) break;
        __builtin_amdgcn_s_sleep(1);
        if ((++sp & 255u) == 0u) { if (xb_ld(&bar[XB_TMO])) break; if (sp > XB_SPIN_CAP) { atomicAdd(&bar[XB_TMO], 1u); break; } }
    }
    nloc = mine > 0u ? mine : 1u; nx = cnt > 0u ? cnt : 1u;
}

__device__ __forceinline__ void xcd_barrier(const XcdBarrier& b) {
    asm volatile("s_waitcnt vmcnt(0)" ::: "memory");
    __syncthreads();
    if (XB_T0()) {
        unsigned* bar = b.bar;
        __builtin_amdgcn_s_waitcnt(0);
        unsigned nloc = b.st[0], nx = b.st[1];
        if (nloc == 0u) { xcd_barrier_complete(bar, b.x, nloc, nx); b.st[0] = nloc; b.st[1] = nx; }
        const unsigned old = xb_add(&bar[XB_XSUB(b.x)], 1u);
        const unsigned gen = old / nloc;
        if (old + 1u == (gen + 1u) * nloc) {
            __builtin_amdgcn_fence(__ATOMIC_RELEASE, "agent");
            asm volatile("s_waitcnt vmcnt(0)" ::: "memory");
            const unsigned og = xb_add(&bar[XB_TOP], 1u);
            const unsigned tg = og / nx;
            if (og + 1u == (tg + 1u) * nx) xb_add(&bar[XB_TOPGEN], 1u);
            else XB_SPIN(xb_ld(&bar[XB_TOPGEN]) == tg, bar);
            __builtin_amdgcn_fence(__ATOMIC_ACQUIRE, "agent");
            xb_add(&bar[XB_XGEN(b.x)], 1u);
            asm volatile("s_waitcnt vmcnt(0)" ::: "memory");
        } else {
            XB_SPIN(xb_ld(&bar[XB_XGEN(b.x)]) == gen, bar);
            __builtin_amdgcn_fence(__ATOMIC_ACQUIRE, "agent");
            asm volatile("s_waitcnt vmcnt(0)" ::: "memory");
        }
    }
    __syncthreads();
}


struct Frame {
    LAS unsigned char* lds;
    volatile LAS unsigned* MISC;
    gu32* ctl;
    int wave;
    int vcu, G;
    const float* x; float* out;
    const float *w_in, *conv_w, *conv_b, *conv_g, *conv_be, *w_out, *lnm_g, *lnm_b, *lnf_g, *lnf_b, *fg, *fu, *fd, *router, *eg, *eu, *ed;
    unsigned char* ws;
};
__device__ __forceinline__ int shx_i(int v, int m, int lane) { return __builtin_amdgcn_ds_bpermute((lane ^ m) << 2, v); }
__device__ __forceinline__ float shx(float v, int m, int lane) { return __builtin_bit_cast(float, __builtin_amdgcn_ds_bpermute((lane ^ m) << 2, __builtin_bit_cast(int, v))); }
__device__ __forceinline__ int shl_i(int v, int src) { return __builtin_amdgcn_ds_bpermute(src << 2, v); }
__device__ __forceinline__ float wave_sum(float v, int lane) {
#pragma unroll
    for (int o = 1; o < 64; o <<= 1) v += shx(v, o, lane);
    return v;
}
__device__ __forceinline__ int wmap(int kind, int c) {
    if (kind == 0) return c;
    if (kind == 1) {
        if (c < 2048) { const int hh = c >> 7, w = c & 127, n = w >> 6, idx = w & 63; return hh * 128 + 32 * (idx >> 4) + 8 * ((idx >> 2) & 3) + 4 * n + (idx & 3); }
        if (c < 3072) return c;
        if (c < 4096) { const int j = c - 3072; return 3072 + 256 * (j >> 7) + (j & 127); }
        const int j = c - 4096; return 3072 + 256 * (j >> 7) + 128 + (j & 127);
    }
    return 256 * (c >> 7) + (kind == 3 ? 128 : 0) + (c & 127);
}
__device__ __forceinline__ void p0_transpose_item(const float* Wg, int K, int N, bf16* WT, int kind, LAS float* scr, int item, int lane) {
    const GAS float* W = (const GAS float*)Wg;
    const int nblk = N / 32, kb = item / nblk, nb = item % nblk, k0 = 64 * kb, n0 = 32 * nb;
    float wv[32];
#pragma unroll
    for (int i = 0; i < 32; ++i) wv[i] = W[(size_t)(k0 + 2 * i + (lane >> 5)) * N + n0 + (lane & 31)];
#pragma unroll
    for (int i = 0; i < 32; ++i) scr[(2 * i + (lane >> 5)) * 33 + (lane & 31)] = wv[i];
    LDS_WAIT(); asm volatile("" ::: "memory");
    const int c = lane & 7;
#pragma unroll
    for (int j = 0; j < 4; ++j) { const int n = (lane >> 3) + 8 * j; const LAS float* s = scr + (8 * c) * 33 + n;
        v4u o; o.x = pk2(s[0 * 33], s[1 * 33]); o.y = pk2(s[2 * 33], s[3 * 33]); o.z = pk2(s[4 * 33], s[5 * 33]); o.w = pk2(s[6 * 33], s[7 * 33]);
        *(GAS v4u*)(WT + (size_t)wmap(kind, n0 + n) * K + k0 + 8 * c) = o; }
    LDS_WAIT(); asm volatile("" ::: "memory");
}
__device__ __forceinline__ void sincos_acc(float ang, float& sn, float& cs) {
    const double x = (double)ang, k = __builtin_rint(x * 0.63661977236758134308);
    double r = __builtin_fma(-k, 1.57079632679489655800e+00, x); r = __builtin_fma(-k, 6.12323399573676603587e-17, r);
    const int q = ((int)k) & 3; const double r2 = r * r;
    double sp = 1.0 / 6227020800.0; sp = sp * r2 - 1.0 / 39916800.0; sp = sp * r2 + 1.0 / 362880.0; sp = sp * r2 - 1.0 / 5040.0; sp = sp * r2 + 1.0 / 120.0; sp = sp * r2 - 1.0 / 6.0;
    const double s = r + r * r2 * sp;
    double cp = -1.0 / 87178291200.0; cp = cp * r2 + 1.0 / 479001600.0; cp = cp * r2 - 1.0 / 3628800.0; cp = cp * r2 + 1.0 / 40320.0; cp = cp * r2 - 1.0 / 720.0; cp = cp * r2 + 1.0 / 24.0; cp = cp * r2 - 0.5;
    const double c = 1.0 + r2 * cp;
    const double ss = (q & 1) ? c : s, cc = (q & 1) ? s : c;
    sn = (float)((q & 2) ? -ss : ss); cs = (float)(((q + 1) & 2) ? -cc : cc);
}
__device__ __forceinline__ void p0_transpose_item8(const float* Wg, int K, int N, unsigned char* WT, int kind, float wscale, LAS float* scr, int item, int lane) {
    const GAS float* W = (const GAS float*)Wg;
    const int nblk = N / 32, kb = item / nblk, nb = item % nblk, k0 = 64 * kb, n0 = 32 * nb;
    float wv[32];
#pragma unroll
    for (int i = 0; i < 32; ++i) wv[i] = W[(size_t)(k0 + 2 * i + (lane >> 5)) * N + n0 + (lane & 31)];
#pragma unroll
    for (int i = 0; i < 32; ++i) scr[(2 * i + (lane >> 5)) * 33 + (lane & 31)] = wv[i] * wscale;
    LDS_WAIT(); asm volatile("" ::: "memory");
    const int c = lane & 7;
#pragma unroll
    for (int j = 0; j < 4; ++j) { const int n = (lane >> 3) + 8 * j; const LAS float* sp = scr + (8 * c) * 33 + n;
        v2u o; o.x = pg8::pk4_fp8(sp[0 * 33], sp[1 * 33], sp[2 * 33], sp[3 * 33]); o.y = pg8::pk4_fp8(sp[4 * 33], sp[5 * 33], sp[6 * 33], sp[7 * 33]);
        *(GAS v2u*)(WT + (size_t)wmap(kind, n0 + n) * K + k0 + 8 * c) = o; }
    LDS_WAIT(); asm volatile("" ::: "memory");
}
__device__ __forceinline__ void p0_transpose_stack8(Frame& F, const float* src, int K, int N, int nmat, unsigned char* dst, size_t dst_stride, int kind, float wscale) {
    LAS float* scr = (LAS float*)(F.lds + RING_OFF + F.wave * 16384);
    const int gw = F.vcu * NWAVES + F.wave, NGW = F.G * NWAVES, per = (K / 64) * (N / 32), total = per * nmat, lane = lane_now();
#pragma clang loop unroll(disable)
    for (int it = gw; it < total; it += NGW) { const int m = it / per, r = it - m * per;
        p0_transpose_item8(src + (size_t)m * K * N, K, N, dst + (size_t)m * dst_stride, kind, wscale, scr, r, lane); }
}
__device__ __forceinline__ void p0_transpose_stack(Frame& F, const float* src, int K, int N, int nmat, bf16* dst, size_t dst_stride, int kind) {
    LAS float* scr = (LAS float*)(F.lds + RING_OFF + F.wave * 16384);
    const int gw = F.vcu * NWAVES + F.wave, NGW = F.G * NWAVES, per = (K / 64) * (N / 32), total = per * nmat, lane = lane_now();
#pragma clang loop unroll(disable)
    for (int it = gw; it < total; it += NGW) { const int m = it / per, r = it - m * per;
        p0_transpose_item(src + (size_t)m * K * N, K, N, dst + (size_t)m * dst_stride, kind, scr, r, lane); }
}
__device__ __forceinline__ void p0_prologue(Frame& F) {
    p0_transpose_stack(F, F.w_in, DM, NPROJ, 2, (bf16*)(F.ws + WS_WIN), (size_t)NPROJ * DM, 1);
    p0_transpose_stack(F, F.w_out, DM, DM, 2, (bf16*)(F.ws + WS_WOUT), (size_t)DM * DM, 0);
    p0_transpose_stack(F, F.fg, DM, DFF, 1, (bf16*)(F.ws + WS_WGU0), 0, 2);
    p0_transpose_stack(F, F.fu, DM, DFF, 1, (bf16*)(F.ws + WS_WGU0), 0, 3);
    p0_transpose_stack(F, F.fd, DFF, DM, 1, (bf16*)(F.ws + WS_WD0), 0, 0);
    p0_transpose_stack8(F, F.eg, DM, DFF, NE, F.ws + WS_WGUE, (size_t)2 * DFF * DM, 2, WSC_GU);
    p0_transpose_stack8(F, F.eu, DM, DFF, NE, F.ws + WS_WGUE, (size_t)2 * DFF * DM, 3, WSC_GU);
    p0_transpose_stack8(F, F.ed, DFF, DM, NE, F.ws + WS_WDE, (size_t)DM * DFF, 0, WSC_D);
    { GAS float* rc = (GAS float*)(F.ws + WS_ROPEC); GAS float* rs = (GAS float*)(F.ws + WS_ROPES);
#pragma clang loop unroll(disable)
      for (int i = (F.vcu * NWAVES + F.wave) * 64 + lane_now(); i < S * 64; i += F.G * NWAVES * 64) { const int t = i >> 6, f = i & 63; const float ang = (float)t * INV_FREQ[f]; float sn, cs; sincos_acc(ang, sn, cs); rc[i] = cs; rs[i] = sn; } }
    { const GAS f32x4* xs = (const GAS f32x4*)F.x; GAS v4u* hb = (GAS v4u*)(F.ws + WS_HB);
#pragma clang loop unroll(disable)
      for (int i = (F.vcu * NWAVES + F.wave) * 64 + lane_now(); i < S * DM / 8; i += F.G * NWAVES * 64) { const f32x4 a = xs[2 * i], b = xs[2 * i + 1]; v4u o; o.x = pk2(a[0], a[1]); o.y = pk2(a[2], a[3]); o.z = pk2(b[0], b[1]); o.w = pk2(b[2], b[3]); hb[i] = o; } }
}

__device__ __forceinline__ void kmean_phase(Frame& F) {
    const int lane = lane_now(), c8 = lane & 15, rg = lane >> 4;
    const int unit = F.wave * F.G + (int)blockIdx.x;
    if (unit < NH * NBLK) { const int j = unit & 63, h = unit >> 6;
        const GAS v4u* kp = (const GAS v4u*)(F.ws + WS_K) + ((size_t)(j * 256 + rg) * 1024 + h * 128) / 8 + c8;
        float a[8];
#pragma unroll
        for (int i = 0; i < 8; ++i) a[i] = 0.f;
#pragma unroll 16
        for (int it = 0; it < 64; ++it) { const v4u w = kp[(size_t)it * 4 * 128];
            a[0] += bflo(w.x); a[1] += bfhi(w.x); a[2] += bflo(w.y); a[3] += bfhi(w.y); a[4] += bflo(w.z); a[5] += bfhi(w.z); a[6] += bflo(w.w); a[7] += bfhi(w.w); }
#pragma unroll
        for (int i = 0; i < 8; ++i) { a[i] += shx(a[i], 16, lane); a[i] += shx(a[i], 32, lane); a[i] *= (1.f / 256.f); }
        if (rg == 0) { v4u hi, lo;
            hi.x = pk2(a[0], a[1]); hi.y = pk2(a[2], a[3]); hi.z = pk2(a[4], a[5]); hi.w = pk2(a[6], a[7]);
            lo.x = pk2(a[0] - bflo(hi.x), a[1] - bfhi(hi.x)); lo.y = pk2(a[2] - bflo(hi.y), a[3] - bfhi(hi.y)); lo.z = pk2(a[4] - bflo(hi.z), a[5] - bfhi(hi.z)); lo.w = pk2(a[6] - bflo(hi.w), a[7] - bfhi(hi.w));
            GAS v4u* kh = (GAS v4u*)(F.ws + WS_KMEAN) + ((size_t)(h * 64 + j) * 128) / 8 + c8;
            kh[0] = hi; kh[NH * NBLK * HD / 8] = lo; } }
}
__device__ __forceinline__ void vt_phase(Frame& F) {
    const int gw = F.vcu * NWAVES + F.wave, NGW = F.G * NWAVES, lane = lane_now();
    LAS unsigned char* tile = F.lds + RING_OFF + F.wave * 8704;
#pragma clang loop unroll(disable)
    for (int unit = gw; unit < (S / 32) * NH; unit += NGW) { const int h = unit & 7, kb = (unit >> 3) * 32;
        const GAS v4u* src = (const GAS v4u*)(F.ws + WS_V) + ((size_t)kb * 1024 + h * 128) / 8;
#pragma unroll
        for (int i = 0; i < 8; ++i) { const int row = i * 4 + (lane >> 4), c16 = lane & 15; *(LAS v4u*)(tile + row * 272 + c16 * 16) = src[(size_t)row * 128 + c16]; }
        LDS_WAIT(); asm volatile("" ::: "memory");
        const int ch = lane & 3, G = ch >> 1, g = ch & 1;
#pragma unroll
        for (int i = 0; i < 8; ++i) { const int d = i * 16 + (lane >> 2);
            unsigned short e[8];
#pragma unroll
            for (int p = 0; p < 8; ++p) { const int key = 16 * G + 8 * (p >> 2) + 4 * g + (p & 3); e[p] = *(const LAS unsigned short*)(tile + key * 272 + d * 2); }
            v4u o; o.x = (unsigned)e[0] | ((unsigned)e[1] << 16); o.y = (unsigned)e[2] | ((unsigned)e[3] << 16); o.z = (unsigned)e[4] | ((unsigned)e[5] << 16); o.w = (unsigned)e[6] | ((unsigned)e[7] << 16);
            *((GAS v4u*)(F.ws + WS_VT) + ((size_t)(h * 128 + d) * S + kb + 8 * ch) / 8) = o; }
        LDS_WAIT(); asm volatile("" ::: "memory");
    }
}

constexpr int CT = 16, CROWS = CT + 30;
__device__ __forceinline__ void conv_phase(Frame& F, int l) {
    LAS unsigned* ub = (LAS unsigned*)(F.lds + RING_OFF);
    LAS f32x2* part = (LAS f32x2*)(F.lds + RING_OFF + CROWS * 2048);
    const int lane = lane_now(), tid = F.wave * 64 + lane;
    const GAS f32x2* cw = (const GAS f32x2*)(F.conv_w + (size_t)l * CKW * 1024) + tid;
    float w0[CKW], w1[CKW];
#pragma unroll
    for (int k = 0; k < CKW; ++k) { const f32x2 w = cw[k * 512]; w0[k] = w.x; w1[k] = w.y; }
    const f32x2 cb = ((const GAS f32x2*)(F.conv_b + l * 1024))[tid], lg = ((const GAS f32x2*)(F.conv_g + l * 1024))[tid], lb = ((const GAS f32x2*)(F.conv_be + l * 1024))[tid];
    const GAS v4u* U = (const GAS v4u*)(F.ws + WS_U);
    GAS unsigned* CAT = (GAS unsigned*)(F.ws + WS_CAT);
    constexpr int NP = (CROWS * 128 + NWAVES * 64 - 1) / (NWAVES * 64);
    const int tb = (int)blockIdx.x * 64;
#pragma clang loop unroll(disable)
    for (int st = 0; st < 4; ++st) { const int t0 = tb + st * CT;
        { const int lane2 = lane_now(), tid2 = F.wave * 64 + lane2;
          v4u nx[NP];
#pragma unroll
          for (int i = 0; i < NP; ++i) { const int p = tid2 + NWAVES * 64 * i, tok = t0 - 30 + (p >> 7); nx[i] = (v4u){0u, 0u, 0u, 0u}; if (p < CROWS * 128 && tok >= 0) nx[i] = U[(size_t)tok * 128 + (p & 127)]; }
#pragma unroll
          for (int i = 0; i < NP; ++i) { const int p = tid2 + NWAVES * 64 * i; if (p < CROWS * 128) *(LAS v4u*)(ub + (p >> 7) * 512 + (p & 127) * 4) = nx[i]; } }
        __syncthreads();
        float a0[CT], a1[CT];
#pragma unroll
        for (int t = 0; t < CT; ++t) { a0[t] = cb.x; a1[t] = cb.y; }
#pragma unroll
        for (int r = 0; r < CROWS; ++r) { const unsigned w = ub[r * 512 + tid]; const float x0 = bflo(w), x1 = bfhi(w);
#pragma unroll
            for (int t = 0; t < CT; ++t) { if (r - t >= 0 && r - t <= 30) { a0[t] += w0[r - t] * x0; a1[t] += w1[r - t] * x1; } } }
#pragma unroll
        for (int t = 0; t < CT; ++t) { float s1 = a0[t] + a1[t], q = a0[t] * a0[t] + a1[t] * a1[t]; s1 = wave_sum(s1, lane); q = wave_sum(q, lane); if (lane == 0) part[F.wave * CT + t] = (f32x2){s1, q}; }
        __syncthreads();
#pragma unroll
        for (int t = 0; t < CT; ++t) { float s1 = 0.f, q = 0.f;
#pragma unroll
            for (int w = 0; w < 8; ++w) { const f32x2 pp = part[w * CT + t]; s1 += pp.x; q += pp.y; }
            const float mean = s1 * (1.f / 1024.f), var = fmaxf(q * (1.f / 1024.f) - mean * mean, 0.f), rstd = 1.0f / sqrtf(var + LN_EPS);
            const float y0 = (a0[t] - mean) * rstd * lg.x + lb.x, y1 = (a1[t] - mean) * rstd * lg.y + lb.y;
            CAT[((size_t)(t0 + t) * DM + 1024) / 2 + tid] = pk2(y0 * pg8::sigmoidf_fast(y0), y1 * pg8::sigmoidf_fast(y1)); }
        __syncthreads();
    }
}

typedef float f32x16 __attribute__((ext_vector_type(16)));
typedef __bf16 bf16x2_t __attribute__((ext_vector_type(2)));
__device__ __forceinline__ unsigned cvtpk(float lo, float hi) { const f32x2 v = {lo, hi}; const bf16x2_t b = __builtin_convertvector(v, bf16x2_t); return __builtin_bit_cast(unsigned, b); }
#define MFMA32(a, b, c) __builtin_amdgcn_mfma_f32_32x32x16_bf16((a), (b), (c), 0, 0, 0)
constexpr int LIST_PER_HEAD = 256 * 2016;
__device__ __forceinline__ int binoff(int j) { return 256 * (63 * j - (j * (j - 1)) / 2); }
#define TOP3_INSERT(v, j) do { const float v_ = (v); const int j_ = (j); \
    if (v_ > tv2) { if (v_ > tv1) { tv2 = tv1; ti2 = ti1; if (v_ > tv0) { tv1 = tv0; ti1 = ti0; tv0 = v_; ti0 = j_; } else { tv1 = v_; ti1 = j_; } } else { tv2 = v_; ti2 = j_; } } } while (0)
__device__ __forceinline__ void sel_phase(Frame& F, int l) {
    LAS int* cntL = (LAS int*)(F.lds + RING_OFF); LAS int* baseL = cntL + 64;
    const int lane = lane_now(), r = lane & 31, hg = lane >> 5, tid = F.wave * 64 + lane;
    const float NEG = -__builtin_inff();
#pragma clang loop unroll(disable)
    for (int unit = blockIdx.x; unit < 63 * NH; unit += F.G) { const int b = 1 + (unit >> 3), h = unit & 7;
        if (tid < 64) cntL[tid] = 0;
        __syncthreads();
        const int t = b * 256 + F.wave * 32 + r;
        const GAS bf16x8* qp = (const GAS bf16x8*)(F.ws + WS_Q) + ((size_t)t * 1024 + h * 128) / 8 + hg;
        bf16x8 qf[8];
#pragma unroll
        for (int kk = 0; kk < 8; ++kk) qf[kk] = qp[2 * kk];
        const GAS bf16x8* kh = (const GAS bf16x8*)(F.ws + WS_KMEAN) + ((size_t)(h * 64 + r) * 128) / 8 + hg;
        f32x16 G0, G1;
#pragma unroll
        for (int i = 0; i < 16; ++i) { G0[i] = 0.f; G1[i] = 0.f; }
#pragma unroll
        for (int kk = 0; kk < 8; ++kk) { G0 = MFMA32(kh[2 * kk], qf[kk], G0); G0 = MFMA32(kh[2 * kk + NH * NBLK * HD / 8], qf[kk], G0); }
        if (b > 32) {
#pragma unroll
            for (int kk = 0; kk < 8; ++kk) { G1 = MFMA32(kh[2 * kk + 32 * 16], qf[kk], G1); G1 = MFMA32(kh[2 * kk + 32 * 16 + NH * NBLK * HD / 8], qf[kk], G1); } }
        float tv0 = NEG, tv1 = NEG, tv2 = NEG; int ti0 = 0, ti1 = 0, ti2 = 0;
#pragma unroll
        for (int i = 0; i < 16; ++i) { const int j = (i & 3) + 8 * (i >> 2) + 4 * hg; TOP3_INSERT(j < b ? G0[i] : NEG, j); }
        if (b > 32) {
#pragma unroll
            for (int i = 0; i < 16; ++i) { const int j = 32 + (i & 3) + 8 * (i >> 2) + 4 * hg; TOP3_INSERT(j < b ? G1[i] : NEG, j); } }
        { const float p0 = shx(tv0, 32, lane), p1 = shx(tv1, 32, lane), p2 = shx(tv2, 32, lane); const int q0 = shx_i(ti0, 32, lane), q1 = shx_i(ti1, 32, lane), q2 = shx_i(ti2, 32, lane);
          TOP3_INSERT(p0, q0); TOP3_INSERT(p1, q1); TOP3_INSERT(p2, q2); }
        int rk0 = 0, rk1 = 0, rk2 = 0;
        if (hg == 0) {
            if (tv0 > NEG) rk0 = __hip_atomic_fetch_add(cntL + ti0, 1, __ATOMIC_RELAXED, __HIP_MEMORY_SCOPE_WORKGROUP);
            if (tv1 > NEG) rk1 = __hip_atomic_fetch_add(cntL + ti1, 1, __ATOMIC_RELAXED, __HIP_MEMORY_SCOPE_WORKGROUP);
            if (tv2 > NEG) rk2 = __hip_atomic_fetch_add(cntL + ti2, 1, __ATOMIC_RELAXED, __HIP_MEMORY_SCOPE_WORKGROUP); }
        __syncthreads();
        if (tid < 64) { const int c = cntL[tid]; if (c > 0) baseL[tid] = (int)__hip_atomic_fetch_add(F.ctl + CW_LCNT + l * 512 + h * 64 + tid, (unsigned)c, RLX_AGENT); }
        __syncthreads();
        if (hg == 0) { GAS int* L = (GAS int*)(F.ws + WS_LIST) + (size_t)h * LIST_PER_HEAD;
            if (tv0 > NEG) L[binoff(ti0) + baseL[ti0] + rk0] = t * 4 + 0;
            if (tv1 > NEG) L[binoff(ti1) + baseL[ti1] + rk1] = t * 4 + 1;
            if (tv2 > NEG) L[binoff(ti2) + baseL[ti2] + rk2] = t * 4 + 2; }
        __syncthreads();
    }
}
constexpr int KROW = 272, VROW = 528, KBUF_BYTES = 256 * KROW, VBUF_BYTES = 128 * VROW;
#define SCHED_FENCE() __builtin_amdgcn_sched_barrier(0)
template <bool CAUSAL>
__device__ __forceinline__ void moba_tile(const bf16x8 (&qf)[8], const LAS unsigned char* kb, const LAS unsigned char* vb, const int nkt, const int r, const int hg, f32x16 (&O)[4], float& ms, float& lsum) {
    const float NEG = -__builtin_inff(), SC = 0.08838834764831845f * 1.44269504088896341f;
    f32x16 Sx[8];
    bf16x8 kfA[8], kfB[8];
#pragma unroll
    for (int kk = 0; kk < 8; ++kk) kfA[kk] = *(const LAS bf16x8*)(kb + kk * 32);
#pragma unroll
    for (int kt = 0; kt < 8; ++kt) {
        if (kt < nkt) { f32x16 a;
#pragma unroll
            for (int i = 0; i < 16; ++i) a[i] = 0.f;
            if (kt + 1 < 8 && kt + 1 < nkt) {
#pragma unroll
                for (int kk = 0; kk < 8; ++kk) { if (kt & 1) kfA[kk] = *(const LAS bf16x8*)(kb + (kt + 1) * 32 * KROW + kk * 32); else kfB[kk] = *(const LAS bf16x8*)(kb + (kt + 1) * 32 * KROW + kk * 32); } }
            SCHED_FENCE();
#pragma unroll
            for (int kk = 0; kk < 8; ++kk) a = MFMA32((kt & 1) ? kfB[kk] : kfA[kk], qf[kk], a);
            SCHED_FENCE();
            if (CAUSAL && kt == nkt - 1) {
#pragma unroll
                for (int i = 0; i < 16; ++i) a[i] = ((i & 3) + 8 * (i >> 2) + 4 * hg > r) ? NEG : a[i]; }
            Sx[kt] = a;
        } else {
#pragma unroll
            for (int i = 0; i < 16; ++i) Sx[kt][i] = NEG; }
    }
    float mx = NEG;
#pragma unroll
    for (int kt = 0; kt < 8; ++kt)
#pragma unroll
        for (int i = 0; i < 16; ++i) mx = fmaxf(mx, Sx[kt][i]);
    mx = fmaxf(mx, shx(mx, 32, r + 32 * hg));
    ms = mx * SC;
    float ls = 0.f;
    bf16x8 pb[8][2];
#pragma unroll
    for (int kt = 0; kt < 8; ++kt)
#pragma unroll
        for (int s2 = 0; s2 < 2; ++s2) { float p[8];
#pragma unroll
            for (int i = 0; i < 8; ++i) { p[i] = __builtin_amdgcn_exp2f(Sx[kt][8 * s2 + i] * SC - ms); ls += p[i]; }
            v4u pw; pw.x = cvtpk(p[0], p[1]); pw.y = cvtpk(p[2], p[3]); pw.z = cvtpk(p[4], p[5]); pw.w = cvtpk(p[6], p[7]);
            pb[kt][s2] = __builtin_bit_cast(bf16x8, pw); }
    lsum = ls + shx(ls, 32, r + 32 * hg);
#pragma unroll
    for (int dt = 0; dt < 4; ++dt)
#pragma unroll
        for (int i = 0; i < 16; ++i) O[dt][i] = 0.f;
    bf16x8 vfA[4], vfB[4];
#pragma unroll
    for (int dt = 0; dt < 4; ++dt) vfA[dt] = *(const LAS bf16x8*)(vb + dt * 32 * VROW);
#pragma unroll
    for (int st = 0; st < 16; ++st) { const int kt = st >> 1, s2 = st & 1;
        if (kt < nkt) {
            if (st + 1 < 16 && ((st + 1) >> 1) < nkt) {
#pragma unroll
                for (int dt = 0; dt < 4; ++dt) { if (st & 1) vfA[dt] = *(const LAS bf16x8*)(vb + dt * 32 * VROW + (st + 1) * 32); else vfB[dt] = *(const LAS bf16x8*)(vb + dt * 32 * VROW + (st + 1) * 32); } }
            SCHED_FENCE();
#pragma unroll
            for (int dt = 0; dt < 4; ++dt) O[dt] = MFMA32((st & 1) ? vfB[dt] : vfA[dt], pb[kt][s2], O[dt]);
            SCHED_FENCE();
        }
    }
}
__device__ __forceinline__ void stage_kv(Frame& F, int h, int j, int tid) {
    LAS unsigned char* kbuf = F.lds + RING_OFF; LAS unsigned char* vbuf = kbuf + KBUF_BYTES;
    const GAS v4u* kg = (const GAS v4u*)(F.ws + WS_K) + ((size_t)(j * 256) * 1024 + h * 128) / 8;
    const GAS v4u* vg = (const GAS v4u*)(F.ws + WS_VT) + ((size_t)(h * 128) * S + j * 256) / 8;
    v4u kr[8], vr[8];
#pragma unroll
    for (int i = 0; i < 8; ++i) { const int p = tid + 512 * i; kr[i] = kg[(size_t)(p >> 4) * 128 + (p & 15)]; vr[i] = vg[(size_t)(p >> 5) * (S / 8) + (p & 31)]; }
#pragma unroll
    for (int i = 0; i < 8; ++i) { const int p = tid + 512 * i; *(LAS v4u*)(kbuf + (p >> 4) * KROW + (p & 15) * 16) = kr[i]; *(LAS v4u*)(vbuf + (p >> 5) * VROW + (p & 31) * 16) = vr[i]; }
}
__device__ __forceinline__ void partial_phase(Frame& F, int l) {
    gu32* lcnt = F.ctl + CW_LCNT + l * 512;
    LAS int* tab = (LAS int*)(F.lds + RING_OFF + KBUF_BYTES + VBUF_BYTES);
    { const int lane = lane_now(); int tl[8], sum = 0;
#pragma unroll
      for (int i = 0; i < 8; ++i) { const int c = (int)__hip_atomic_load(lcnt + lane * 8 + i, RLX_AGENT); tl[i] = (c + 255) >> 8; sum += tl[i]; }
      int inc = sum;
#pragma unroll
      for (int o = 1; o < 64; o <<= 1) { const int v = __builtin_amdgcn_ds_bpermute((lane - o) << 2, inc); if (lane >= o) inc += v; }
      int run = inc - sum;
      if (F.wave == 0) {
#pragma unroll
          for (int i = 0; i < 8; ++i) { run += tl[i]; tab[lane * 8 + i] = run; } } }
    __syncthreads();
    const int total = __builtin_amdgcn_readfirstlane(tab[511]);
#pragma clang loop unroll(disable)
    for (int u = blockIdx.x; u < total; u += F.G) {
        const int lane = lane_now(), r = lane & 31, hg = lane >> 5, tid = F.wave * 64 + lane;
        const LAS unsigned char* kb = F.lds + RING_OFF + r * KROW + hg * 16; const LAS unsigned char* vb = F.lds + RING_OFF + KBUF_BYTES + r * VROW + hg * 16;
        int bin = 0, chunk = 0; bool mine = false;
        { const int prev = lane ? tab[lane * 8 - 1] : 0; int lo = prev;
#pragma unroll
          for (int i = 0; i < 8; ++i) { const int hi = tab[lane * 8 + i]; if (u >= lo && u < hi) { mine = true; bin = lane * 8 + i; chunk = u - lo; } lo = hi; } }
        const int src = __builtin_ctzll(__ballot(mine)); bin = __builtin_amdgcn_readlane(bin, src); chunk = __builtin_amdgcn_readlane(chunk, src);
        const int h = bin >> 6, j = bin & 63, n = (int)__builtin_amdgcn_readfirstlane(__hip_atomic_load(lcnt + bin, RLX_AGENT));
        const int base = chunk * 256 + F.wave * 32; const bool active = base < n, valid = base + r < n;
        const int e = ((const GAS int*)(F.ws + WS_LIST))[(size_t)h * LIST_PER_HEAD + binoff(j) + (active ? base + (valid ? r : 0) : 0)];
        const int t = e >> 2, sl = e & 3;
        const GAS bf16x8* qp = (const GAS bf16x8*)(F.ws + WS_Q) + ((size_t)t * 1024 + h * 128) / 8 + hg;
        bf16x8 qf[8];
#pragma unroll
        for (int kk = 0; kk < 8; ++kk) qf[kk] = qp[2 * kk];
        __syncthreads();
        stage_kv(F, h, j, tid);
        __syncthreads();
        if (active) {
            f32x16 O[4]; float ms, ls;
            moba_tile<false>(qf, kb, vb, 8, r, hg, O, ms, ls);
            if (valid) { const size_t idx = ((size_t)t * NH + h) * 3 + sl; const float inv = 1.0f / ls;
                GAS v2u* po = (GAS v2u*)(F.ws + WS_PO) + idx * 32 + hg;
#pragma unroll
                for (int dt = 0; dt < 4; ++dt)
#pragma unroll
                    for (int g4 = 0; g4 < 4; ++g4) po[dt * 8 + 2 * g4] = (v2u){cvtpk(O[dt][4 * g4] * inv, O[dt][4 * g4 + 1] * inv), cvtpk(O[dt][4 * g4 + 2] * inv, O[dt][4 * g4 + 3] * inv)};
                if (hg == 0) ((GAS f32x2*)(F.ws + WS_PML))[idx] = (f32x2){ms, ls}; }
        }
    }
}
__device__ __forceinline__ void own_phase(Frame& F) {
#pragma clang loop unroll(disable)
    for (int u = blockIdx.x; u < NBLK * NH; u += F.G) { const int h = u & 7, b = u >> 3, qt = F.wave;
        const int lane = lane_now(), r = lane & 31, hg = lane >> 5, tid = F.wave * 64 + lane;
        const LAS unsigned char* kb = F.lds + RING_OFF + r * KROW + hg * 16; const LAS unsigned char* vb = F.lds + RING_OFF + KBUF_BYTES + r * VROW + hg * 16;
        const int t = b * 256 + qt * 32 + r;
        const GAS bf16x8* qp = (const GAS bf16x8*)(F.ws + WS_Q) + ((size_t)t * 1024 + h * 128) / 8 + hg;
        bf16x8 qf[8];
#pragma unroll
        for (int kk = 0; kk < 8; ++kk) qf[kk] = qp[2 * kk];
        __syncthreads();
        stage_kv(F, h, b, tid);
        __syncthreads();
        f32x16 O[4]; float ms, ls;
        moba_tile<true>(qf, kb, vb, qt + 1, r, hg, O, ms, ls);
        const int nv = b < 3 ? b : 3; const size_t idx0 = ((size_t)t * NH + h) * 3;
        float pm[3], pl[3], M = ms;
#pragma unroll
        for (int s2 = 0; s2 < 3; ++s2) { pm[s2] = -__builtin_inff(); pl[s2] = 0.f; if (s2 < nv) { const f32x2 v = ((const GAS f32x2*)(F.ws + WS_PML))[idx0 + s2]; pm[s2] = v.x; pl[s2] = v.y; M = fmaxf(M, v.x); } }
        const float wo = __builtin_amdgcn_exp2f(ms - M); float W = ls * wo, w[3];
#pragma unroll
        for (int s2 = 0; s2 < 3; ++s2) { w[s2] = pl[s2] * __builtin_amdgcn_exp2f(pm[s2] - M); W += w[s2]; }
        const float invW = 1.0f / W;
#pragma unroll
        for (int dt = 0; dt < 4; ++dt)
#pragma unroll
            for (int i = 0; i < 16; ++i) O[dt][i] *= wo;
#pragma unroll
        for (int s2 = 0; s2 < 3; ++s2) { if (s2 < nv) { const GAS v2u* po = (const GAS v2u*)(F.ws + WS_PO) + (idx0 + s2) * 32 + hg;
#pragma unroll
                for (int dt = 0; dt < 4; ++dt)
#pragma unroll
                    for (int g4 = 0; g4 < 4; ++g4) { const v2u v = po[dt * 8 + 2 * g4]; O[dt][4 * g4] += w[s2] * bflo(v.x); O[dt][4 * g4 + 1] += w[s2] * bfhi(v.x); O[dt][4 * g4 + 2] += w[s2] * bflo(v.y); O[dt][4 * g4 + 3] += w[s2] * bfhi(v.y); } } }
        GAS v2u* co = (GAS v2u*)(F.ws + WS_CAT) + ((size_t)t * DM + h * 128) / 4 + hg;
#pragma unroll
        for (int dt = 0; dt < 4; ++dt)
#pragma unroll
            for (int g4 = 0; g4 < 4; ++g4) co[dt * 8 + 2 * g4] = (v2u){cvtpk(O[dt][4 * g4] * invW, O[dt][4 * g4 + 1] * invW), cvtpk(O[dt][4 * g4 + 2] * invW, O[dt][4 * g4 + 3] * invW)};
    }
}

__device__ __forceinline__ void ln_phase(Frame& F, const float* hres_, const float* y_, const float* g_, const float* b_, const float* router, bool write_hb) {
    const int gw = F.vcu * NWAVES + F.wave, lane = lane_now();
    const GAS f32x4* gp = (const GAS f32x4*)g_ + lane; const GAS f32x4* bp = (const GAS f32x4*)b_ + lane;
    int ecl[8];
#pragma unroll
    for (int e = 0; e < 8; ++e) ecl[e] = 0;
#pragma clang loop unroll(disable)
    for (int i = 0; i < S / (256 * NWAVES); ++i) { const int row = gw * (S / (256 * NWAVES)) + i;
        const GAS f32x4* hp = (const GAS f32x4*)(hres_ + (size_t)row * DM) + lane; const GAS f32x4* yp = (const GAS f32x4*)(y_ + (size_t)row * DM) + lane;
        f32x4 v[8]; float s = 0.f;
#pragma unroll
        for (int j = 0; j < 8; ++j) { v[j] = hp[64 * j] * ALPHA + yp[64 * j]; s += (v[j][0] + v[j][1]) + (v[j][2] + v[j][3]); }
        const float mean = wave_sum(s, lane) * (1.f / DM); float s2 = 0.f;
#pragma unroll
        for (int j = 0; j < 8; ++j) { v[j] = v[j] - mean; s2 += (v[j][0] * v[j][0] + v[j][1] * v[j][1]) + (v[j][2] * v[j][2] + v[j][3] * v[j][3]); }
        const float rstd = 1.f / sqrtf(wave_sum(s2, lane) * (1.f / DM) + LN_EPS);
        GAS f32x4* op = (GAS f32x4*)(F.out + (size_t)row * DM) + lane; GAS v2u* hb = (GAS v2u*)(F.ws + WS_HB + (size_t)row * DM * 2) + lane;
#pragma unroll
        for (int j = 0; j < 8; ++j) { v[j] = v[j] * rstd * gp[64 * j] + bp[64 * j]; op[64 * j] = v[j];
            if (router) ((GAS unsigned*)(F.ws + WS_HB + (size_t)row * DM))[64 * j + lane] = pg8::pk4_fp8(v[j][0] * ASC_H, v[j][1] * ASC_H, v[j][2] * ASC_H, v[j][3] * ASC_H);
            else if (write_hb) hb[64 * j] = (v2u){pk2(v[j][0], v[j][1]), pk2(v[j][2], v[j][3])}; }
        if (router) {
            float lg[8];
#pragma unroll
            for (int e = 0; e < 8; ++e) lg[e] = 0.f;
#pragma unroll
            for (int j = 0; j < 8; ++j)
#pragma unroll
                for (int c = 0; c < 4; ++c) { const GAS f32x4* rw = (const GAS f32x4*)(router + (size_t)(256 * j + 4 * lane + c) * 8); const f32x4 r0 = rw[0], r1 = rw[1]; const float xv = v[j][c];
                    lg[0] += xv * r0[0]; lg[1] += xv * r0[1]; lg[2] += xv * r0[2]; lg[3] += xv * r0[3]; lg[4] += xv * r1[0]; lg[5] += xv * r1[1]; lg[6] += xv * r1[2]; lg[7] += xv * r1[3]; }
#pragma unroll
            for (int e = 0; e < 8; ++e) lg[e] = wave_sum(lg[e], lane);
            int i1 = 0; float v1 = lg[0];
#pragma unroll
            for (int e = 1; e < 8; ++e) if (lg[e] > v1) { v1 = lg[e]; i1 = e; }
            int i2 = -1; float v2 = -__builtin_inff();
#pragma unroll
            for (int e = 0; e < 8; ++e) if (e != i1 && lg[e] > v2) { v2 = lg[e]; i2 = e; }
            const float g1 = 1.0f / (1.0f + __expf(v2 - v1)), g2 = 1.0f - g1;
            if (lane == 0) { ((GAS int*)(F.ws + WS_EIDX))[row * 2] = i1; ((GAS int*)(F.ws + WS_EIDX))[row * 2 + 1] = i2; ((GAS float*)(F.ws + WS_GATEW))[row * 2] = g1; ((GAS float*)(F.ws + WS_GATEW))[row * 2 + 1] = g2; }
#pragma unroll
            for (int e = 0; e < 8; ++e) ecl[e] += (i1 == e ? 1 : 0) + (i2 == e ? 1 : 0);
        }
    }
    if (router) { int mine = 0;
#pragma unroll
        for (int e = 0; e < 8; ++e) mine = (lane == e) ? ecl[e] : mine;
        if (lane < 8 && mine) __hip_atomic_fetch_add(F.ctl + CW_ECNT + 64 * lane, (unsigned)mine, RLX_AGENT); }
}
__device__ __forceinline__ void load_expert_layout(Frame& F, int (&off)[8], int (&cum)[8], int& npanels) {
    int o = 0;
#pragma unroll
    for (int e = 0; e < 8; ++e) { const int c = (int)__builtin_amdgcn_readfirstlane(__hip_atomic_load(F.ctl + CW_ECNT + 64 * e, RLX_AGENT)); off[e] = o; cum[e] = o >> 8; o += (c + 255) & ~255; }
    npanels = o >> 8;
}
__device__ __forceinline__ void route_phase(Frame& F) {
    const int gw = F.vcu * NWAVES + F.wave, lane = lane_now();
    int off[8], cum[8], np; load_expert_layout(F, off, cum, np);
    const int row = gw * 8 + (lane >> 1), slot = lane & 1; const bool act = lane < 16;
    const int mye = act ? ((const GAS int*)(F.ws + WS_EIDX))[row * 2 + slot] : -1;
    int pos = 0;
#pragma unroll
    for (int e = 0; e < 8; ++e) { const unsigned long long mask = __ballot(mye == e);
        if (mask) { const int leader = __builtin_ctzll(mask), n = __builtin_popcountll(mask); unsigned b = 0u;
            if (lane == leader) b = __hip_atomic_fetch_add(F.ctl + CW_ECUR + 64 * e, (unsigned)n, RLX_AGENT);
            b = (unsigned)shl_i((int)b, leader);
            if (mye == e) pos = off[e] + (int)b + __builtin_popcountll(mask & ((1ull << lane) - 1ull)); } }
    if (act) ((GAS int*)(F.ws + WS_ROWPOS))[row * 2 + slot] = pos;
#pragma clang loop unroll(disable)
    for (int k = 0; k < 16; ++k) { const int p = shl_i(pos, k), r = gw * 8 + (k >> 1);
        const GAS v4u* src = (const GAS v4u*)(F.ws + WS_HB + (size_t)r * DM) + lane; GAS v4u* dst = (GAS v4u*)(F.ws + WS_HBP + (size_t)p * DM) + lane;
#pragma unroll
        for (int j = 0; j < 2; ++j) dst[64 * j] = src[64 * j]; }
}
__device__ __forceinline__ void ln_moe_phase(Frame& F, const float* g_, const float* b_) {
    const int gw = F.vcu * NWAVES + F.wave, lane = lane_now();
    const GAS f32x4* gp = (const GAS f32x4*)g_ + lane; const GAS f32x4* bp = (const GAS f32x4*)b_ + lane;
#pragma clang loop unroll(disable)
    for (int i = 0; i < 8; ++i) { const int row = gw * 8 + i;
        const int p1 = ((const GAS int*)(F.ws + WS_ROWPOS))[row * 2], p2 = ((const GAS int*)(F.ws + WS_ROWPOS))[row * 2 + 1];
        const float g1 = ((const GAS float*)(F.ws + WS_GATEW))[row * 2], g2 = ((const GAS float*)(F.ws + WS_GATEW))[row * 2 + 1];
        const GAS f32x4* hp = (const GAS f32x4*)(F.out + (size_t)row * DM) + lane;
        const GAS v2u* y1 = (const GAS v2u*)(F.ws + WS_R2 + (size_t)p1 * DM * 2) + lane; const GAS v2u* y2 = (const GAS v2u*)(F.ws + WS_R2 + (size_t)p2 * DM * 2) + lane;
        f32x4 v[8]; float s = 0.f;
#pragma unroll
        for (int j = 0; j < 8; ++j) { const v2u a = y1[64 * j], b = y2[64 * j];
            const f32x4 fa = (f32x4){bflo(a.x), bfhi(a.x), bflo(a.y), bfhi(a.y)}, fb = (f32x4){bflo(b.x), bfhi(b.x), bflo(b.y), bfhi(b.y)};
            v[j] = hp[64 * j] * ALPHA + fa * g1 + fb * g2; s += (v[j][0] + v[j][1]) + (v[j][2] + v[j][3]); }
        const float mean = wave_sum(s, lane) * (1.f / DM); float s2 = 0.f;
#pragma unroll
        for (int j = 0; j < 8; ++j) { v[j] = v[j] - mean; s2 += (v[j][0] * v[j][0] + v[j][1] * v[j][1]) + (v[j][2] * v[j][2] + v[j][3] * v[j][3]); }
        const float rstd = 1.f / sqrtf(wave_sum(s2, lane) * (1.f / DM) + LN_EPS);
        GAS f32x4* op = (GAS f32x4*)(F.out + (size_t)row * DM) + lane;
#pragma unroll
        for (int j = 0; j < 8; ++j) op[64 * j] = v[j] * rstd * gp[64 * j] + bp[64 * j];
    }
}

struct Args { const float* in[18]; float* out; unsigned char* ws; };
__global__ void __launch_bounds__(NWAVES * 64, 2) hymba_fwd(Args args) {
    extern __shared__ __attribute__((aligned(16))) unsigned char lds[];
    Frame F;
    F.lds = (LAS unsigned char*)lds;
    F.MISC = (volatile LAS unsigned*)(F.lds + MISC_OFF);
    F.wave = __builtin_amdgcn_readfirstlane((int)threadIdx.x >> 6);
    F.G = gridDim.x; { const int bx = blockIdx.x; F.vcu = (F.G % 8 == 0) ? (bx % 8) * (F.G / 8) + bx / 8 : bx; }
    F.ws = args.ws; F.ctl = (gu32*)(args.ws + WS_CTL);
    F.x = args.in[0]; F.w_in = args.in[1]; F.conv_w = args.in[2]; F.conv_b = args.in[3]; F.conv_g = args.in[4]; F.conv_be = args.in[5]; F.w_out = args.in[6];
    F.lnm_g = args.in[7]; F.lnm_b = args.in[8]; F.lnf_g = args.in[9]; F.lnf_b = args.in[10]; F.fg = args.in[11]; F.fu = args.in[12]; F.fd = args.in[13];
    F.router = args.in[14]; F.eg = args.in[15]; F.eu = args.in[16]; F.ed = args.in[17]; F.out = args.out;
    for (int u = threadIdx.x; u < (LDS_BYTES - LDSCTL_OFF) / 4; u += NWAVES * 64) ((LAS unsigned*)(F.lds + LDSCTL_OFF))[u] = 0u;
    __syncthreads();
    XcdBarrier bar = xcd_barrier_post((unsigned*)(F.ctl + CW_BAR), F.MISC + 8, F.wave);
#define LAUNDER() asm volatile("" : "+s"(F.ws), "+s"(F.ctl), "+s"(F.out), "+s"(F.x), "+s"(bar.bar), "+s"(F.wave))
#define GRID_BAR() do { LAUNDER(); xcd_barrier(bar); LAUNDER(); } while (0)
#define HB ((bf16*)(F.ws + WS_HB))
#define Y ((float*)(F.ws + WS_R2))

    p0_prologue(F);
    GRID_BAR();

#pragma clang loop unroll(disable)
    for (int l = 0; l < 2; ++l) {
#ifndef NO_G_INPROJ
        { pg8::Gemm g{HB, (const bf16*)(F.ws + WS_WIN) + (size_t)l * NPROJ * DM, S, NPROJ, DM, 0}; pg8::StaticOrder So; So.init(S, NPROJ, F.G, (int)blockIdx.x);
          pg8::EpiInProj E{(bf16*)(F.ws + WS_Q), (bf16*)(F.ws + WS_K), (bf16*)(F.ws + WS_V), (bf16*)(F.ws + WS_U), (const float*)(F.ws + WS_ROPEC), (const float*)(F.ws + WS_ROPES)};
          pg8::gemm_phase<pg8::EpiInProj, pg8::StaticOrder, true, true>(F.lds + RING_OFF, g, So, E, F.wave); }
#endif
        GRID_BAR();
        kmean_phase(F);
        vt_phase(F);
        __syncthreads();
        conv_phase(F, l);
        GRID_BAR();
        sel_phase(F, l);
        GRID_BAR();
        partial_phase(F, l);
        GRID_BAR();
        own_phase(F);
        GRID_BAR();
#ifndef NO_G_OUTPROJ
        { pg8::Gemm g{(const bf16*)(F.ws + WS_CAT), (const bf16*)(F.ws + WS_WOUT) + (size_t)l * DM * DM, S, DM, DM, 0}; pg8::StaticOrder So; So.init(S, DM, F.G, (int)blockIdx.x);
          pg8::EpiF32 E{Y, DM};
          pg8::gemm_phase<pg8::EpiF32, pg8::StaticOrder, true, true>(F.lds + RING_OFF, g, So, E, F.wave); }
#endif
        GRID_BAR();
        ln_phase(F, l == 0 ? F.x : F.out, Y, F.lnm_g + l * DM, F.lnm_b + l * DM, l == 1 ? F.router : nullptr, true);
        GRID_BAR();
        if (l == 0) {
#ifndef NO_G_FFNGU
            { pg8::Gemm g{HB, (const bf16*)(F.ws + WS_WGU0), S, 2 * DFF, DM, 0}; pg8::StaticOrder So; So.init(S, 2 * DFF, F.G, (int)blockIdx.x);
              pg8::EpiSwiGLU E{(bf16*)(F.ws + WS_ACT), DFF};
              pg8::gemm_phase<pg8::EpiSwiGLU, pg8::StaticOrder, true, true>(F.lds + RING_OFF, g, So, E, F.wave); }
#endif
            GRID_BAR();
#ifndef NO_G_FFND
            { pg8::Gemm g{(const bf16*)(F.ws + WS_ACT), (const bf16*)(F.ws + WS_WD0), S, DM, DFF, 0}; pg8::StaticOrder So; So.init(S, DM, F.G, (int)blockIdx.x);
              pg8::EpiF32 E{Y, DM};
              pg8::gemm_phase<pg8::EpiF32, pg8::StaticOrder, true, true>(F.lds + RING_OFF, g, So, E, F.wave); }
#endif
            GRID_BAR();
            ln_phase(F, F.out, Y, F.lnf_g, F.lnf_b, nullptr, true);
            GRID_BAR();
        } else {
            route_phase(F);
            GRID_BAR();
            int off[8], cum[8], np; load_expert_layout(F, off, cum, np);
#ifndef NO_G_MOEGU
            { pg8::Gemm g{(const bf16*)(F.ws + WS_HBP), (const bf16*)(F.ws + WS_WGUE), np * 256, 2 * DFF, DM / 2, (size_t)2 * DFF * DM}; pg8::GroupedOrder So; So.init(np * 256, 2 * DFF, F.G, (int)blockIdx.x);
#pragma unroll
              for (int e = 0; e < 8; ++e) So.cum[e] = cum[e];
              pg8::EpiSwiGLU8 E{F.ws + WS_ACT, DFF, 1.0f / (WSC_GU * ASC_H), ASC_ACT};
              pg8::gemm_phase<pg8::EpiSwiGLU8, pg8::GroupedOrder, true, true, true>(F.lds + RING_OFF, g, So, E, F.wave); }
#endif
            GRID_BAR();
#ifndef NO_G_MOED
            { pg8::Gemm g{(const bf16*)(F.ws + WS_ACT), (const bf16*)(F.ws + WS_WDE), np * 256, DM, DFF / 2, (size_t)DM * DFF}; pg8::GroupedOrder So; So.init(np * 256, DM, F.G, (int)blockIdx.x);
#pragma unroll
              for (int e = 0; e < 8; ++e) So.cum[e] = cum[e];
              pg8::EpiBf16 E{(bf16*)(F.ws + WS_R2), DM, 1.0f / (WSC_D * ASC_ACT)};
              pg8::gemm_phase<pg8::EpiBf16, pg8::GroupedOrder, true, true, true>(F.lds + RING_OFF, g, So, E, F.wave); }
#endif
            GRID_BAR();
            ln_moe_phase(F, F.lnf_g + DM, F.lnf_b + DM);
        }
    }
#undef GRID_BAR
#undef LAUNDER
#undef HB
#undef Y
}

extern "C" void kernel_launch(void* const* d_in, const int* in_sizes, int n_in, void* d_out, int out_size, void* d_ws, size_t ws_size, hipStream_t stream) {
    static int grid = 0;
    if (grid == 0) {
        if (n_in != 18 || in_sizes[0] != S * DM || out_size != S * DM || ws_size < WS_END) { fprintf(stderr, "kernel_launch: unexpected shapes (n_in %d, in0 %d, out %d, ws %zu < %zu); nothing launched\n", n_in, n_in > 0 ? in_sizes[0] : -1, out_size, ws_size, (size_t)WS_END); grid = -1; return; }
        int dev = 0, cus = 0, per_cu = 0;
        if (hipGetDevice(&dev) != hipSuccess || hipDeviceGetAttribute(&cus, hipDeviceAttributeMultiprocessorCount, dev) != hipSuccess) { grid = -1; return; }
        if (hipFuncSetAttribute((const void*)hymba_fwd, hipFuncAttributeMaxDynamicSharedMemorySize, LDS_BYTES) != hipSuccess) { fprintf(stderr, "kernel_launch: hipFuncSetAttribute failed\n"); grid = -1; return; }
        if (hipOccupancyMaxActiveBlocksPerMultiprocessor(&per_cu, (const void*)hymba_fwd, NWAVES * 64, LDS_BYTES) != hipSuccess || per_cu < 1)
            fprintf(stderr, "kernel_launch: note: occupancy query reports %d workgroups per CU\n", per_cu);
        (void)hipGetLastError();
        grid = cus;
        if (grid != 256) { fprintf(stderr, "kernel_launch: built for 256 CUs, device has %d; nothing launched\n", cus); grid = -1; return; }
    }
    if (grid < 0) return;
    if (hipMemsetAsync((char*)d_ws + WS_CTL, 0, CTL_ZERO_BYTES, stream) != hipSuccess) return;
    Args a{};
    for (int i = 0; i < 18; ++i) a.in[i] = (const float*)d_in[i];
    a.out = (float*)d_out; a.ws = (unsigned char*)d_ws;
    hipLaunchKernelGGL(hymba_fwd, dim3(grid), dim3(NWAVES * 64), LDS_BYTES, stream, a);
}
```

```cpp
#include <hip/hip_runtime.h>
#include <cstdio>
#include <cstdint>
#include <cmath>
namespace pg8 {
#define PG8_LAS __attribute__((address_space(3)))
typedef unsigned short bf16_t;
typedef short bf16x8 __attribute__((ext_vector_type(8)));
typedef float f32x4 __attribute__((ext_vector_type(4)));
typedef unsigned u32x4 __attribute__((ext_vector_type(4)));
typedef unsigned u32x2 __attribute__((ext_vector_type(2)));
typedef int v8i __attribute__((ext_vector_type(8)));
typedef int v4i __attribute__((ext_vector_type(4)));
constexpr int BM = 256, BK = 64, HALF = 128, HTB = HALF * BK * 2  , STAGE_BYTES = 8 * HTB, NXCD = 8, WGM = 8;

__host__ __device__ __forceinline__ int lds_byte(int r, int c) { const int st = (r >> 4) * 2 + (c >> 5), rr = r & 15, cc = c & 31, ob = rr * 64 + cc * 2; return st * 1024 + (ob ^ (((ob >> 9) & 1) << 5)); }
__host__ __device__ __forceinline__ void stage_rc(int b, int& R, int& C) { const int st = b / 1024, sb = b % 1024, swz = sb ^ (((sb >> 9) & 1) << 5); R = (st >> 1) * 16 + swz / 64; C = (st & 1) * 32 + (swz % 64) / 2; }
__host__ __device__ __forceinline__ int perm32(int rho) { const int n = rho >> 4, i = rho & 15; return 8 * (i >> 2) + 4 * n + (i & 3); }

struct Unit { int pm, pn, e; };
struct Gemm { const bf16_t* A; const bf16_t* Bt; int M, N, K; size_t bstride; };

struct StaticOrder {
    int nM, nN, nwg, G, c;
    __host__ __device__ void init(int M, int N, int G_, int c_) { nM = M / BM; nN = N / BM; nwg = nM * nN; G = G_; c = c_; }
    __host__ __device__ bool next(int i, Unit& u) const {
        const long L = (long)i * G + c; if (L >= nwg) return false;
        int wgid = (int)L; { const int q = nwg / NXCD, r = nwg % NXCD, xcd = wgid % NXCD, off = wgid / NXCD; wgid = (xcd < r ? xcd * (q + 1) : r * (q + 1) + (xcd - r) * q) + off; }
        const int nig = WGM * nN, gid = wgid / nig, fm = gid * WGM, gsz = (nM - fm) < WGM ? (nM - fm) : WGM;
        u.pm = fm + ((wgid % nig) % gsz); u.pn = (wgid % nig) / gsz; u.e = 0; return true;
    }
    __device__ __forceinline__ void a_ready(const Unit&) const {}
    __device__ __forceinline__ void done(const Unit&) const {}
};
struct GroupedOrder : StaticOrder {
    int cum[8];
    __device__ bool next(int i, Unit& u) const {
        if (!StaticOrder::next(i, u)) return false;
        int e = 0;
#pragma unroll
        for (int j = 1; j < 8; ++j) e += (u.pm >= cum[j]) ? 1 : 0;
        u.e = e; return true;
    }
};

__device__ __forceinline__ unsigned cvt_pk_bf16(float lo, float hi) { unsigned r; asm volatile("v_cvt_pk_bf16_f32 %0, %1, %2" : "=v"(r) : "v"(lo), "v"(hi)); return r; }
__device__ __forceinline__ float sigmoidf_fast(float g) { return __builtin_amdgcn_rcpf(1.0f + __builtin_amdgcn_exp2f(-1.44269504089f * g)); }

__device__ __forceinline__ unsigned pk4_fp8(float a, float b, float c, float d) {
    unsigned w = 0u; w = __builtin_amdgcn_cvt_pk_fp8_f32(__builtin_amdgcn_fmed3f(a, -448.f, 448.f), __builtin_amdgcn_fmed3f(b, -448.f, 448.f), w, false);
    return __builtin_amdgcn_cvt_pk_fp8_f32(__builtin_amdgcn_fmed3f(c, -448.f, 448.f), __builtin_amdgcn_fmed3f(d, -448.f, 448.f), w, true); }
struct EpiF32 {
    static constexpr bool PERM = false, AFTER_DRAIN = false;
    float* C; int ldc;
    __device__ __forceinline__ void operator()(const f32x4 (&acc)[2][2][4][2], const Unit& u, int wr, int wc, int fr, int fq) const {
        const int row0 = u.pm * BM + wr * 64 + fr, col0 = u.pn * BM + wc * 32 + 4 * fq;
#pragma unroll
        for (int ai = 0; ai < 2; ++ai)
#pragma unroll
            for (int m = 0; m < 4; ++m) { float* rowp = C + (size_t)(row0 + ai * HALF + m * 16) * ldc + col0;
#pragma unroll
                for (int bj = 0; bj < 2; ++bj)
#pragma unroll
                    for (int n = 0; n < 2; ++n) *(f32x4*)(rowp + bj * HALF + n * 16) = acc[ai][bj][m][n]; }
    }
};
struct EpiBf16 {
    static constexpr bool PERM = true, AFTER_DRAIN = false;
    bf16_t* O; int ldc; float sc;
    __device__ __forceinline__ void operator()(const f32x4 (&acc)[2][2][4][2], const Unit& u, int wr, int wc, int fr, int fq) const {
        const int row0 = u.pm * BM + wr * 64 + fr, col0 = u.pn * BM + wc * 32 + 8 * fq;
#pragma unroll
        for (int ai = 0; ai < 2; ++ai)
#pragma unroll
            for (int m = 0; m < 4; ++m) { bf16_t* rowp = O + (size_t)(row0 + ai * HALF + m * 16) * ldc + col0;
#pragma unroll
                for (int bj = 0; bj < 2; ++bj) { const f32x4 v0 = acc[ai][bj][m][0] * sc, v1 = acc[ai][bj][m][1] * sc;
                    u32x4 w; w.x = cvt_pk_bf16(v0[0], v0[1]); w.y = cvt_pk_bf16(v0[2], v0[3]); w.z = cvt_pk_bf16(v1[0], v1[1]); w.w = cvt_pk_bf16(v1[2], v1[3]);
                    *(u32x4*)(rowp + bj * HALF) = w; } }
    }
};
struct EpiSwiGLU {
    static constexpr bool PERM = true, AFTER_DRAIN = false;
    bf16_t* O; int ldc;
    __device__ __forceinline__ void operator()(const f32x4 (&acc)[2][2][4][2], const Unit& u, int wr, int wc, int fr, int fq) const {
        const int row0 = u.pm * BM + wr * 64 + fr, col0 = u.pn * HALF + wc * 32 + 8 * fq;
#pragma unroll
        for (int ai = 0; ai < 2; ++ai)
#pragma unroll
            for (int m = 0; m < 4; ++m) { bf16_t* rowp = O + (size_t)(row0 + ai * HALF + m * 16) * ldc + col0;
                float o[8];
#pragma unroll
                for (int n = 0; n < 2; ++n)
#pragma unroll
                    for (int j = 0; j < 4; ++j) { const float g = acc[ai][0][m][n][j], up = acc[ai][1][m][n][j]; o[n * 4 + j] = g * sigmoidf_fast(g) * up; }
                u32x4 w; w.x = cvt_pk_bf16(o[0], o[1]); w.y = cvt_pk_bf16(o[2], o[3]); w.z = cvt_pk_bf16(o[4], o[5]); w.w = cvt_pk_bf16(o[6], o[7]);
                *(u32x4*)rowp = w; }
    }
};
struct EpiSwiGLU8 {
    static constexpr bool PERM = true, AFTER_DRAIN = false;
    unsigned char* O; int ldc; float sin, sout;
    __device__ __forceinline__ void operator()(const f32x4 (&acc)[2][2][4][2], const Unit& u, int wr, int wc, int fr, int fq) const {
        const int row0 = u.pm * BM + wr * 64 + fr, col0 = u.pn * HALF + wc * 32 + 8 * fq;
#pragma unroll
        for (int ai = 0; ai < 2; ++ai)
#pragma unroll
            for (int m = 0; m < 4; ++m) { unsigned char* rowp = O + (size_t)(row0 + ai * HALF + m * 16) * ldc + col0;
                float o[8];
#pragma unroll
                for (int n = 0; n < 2; ++n)
#pragma unroll
                    for (int j = 0; j < 4; ++j) { const float g = acc[ai][0][m][n][j] * sin, up = acc[ai][1][m][n][j] * sin; o[n * 4 + j] = g * sigmoidf_fast(g) * up * sout; }
                u32x2 w; w.x = pk4_fp8(o[0], o[1], o[2], o[3]); w.y = pk4_fp8(o[4], o[5], o[6], o[7]);
                *(u32x2*)rowp = w; }
    }
};
struct EpiInProj {
    static constexpr bool PERM = true, AFTER_DRAIN = false;
    bf16_t *Q, *Kb, *V, *U; const float *ropeC, *ropeS;
    __device__ __forceinline__ void operator()(const f32x4 (&acc)[2][2][4][2], const Unit& u, int wr, int wc, int fr, int fq) const {
        const int row0 = u.pm * BM + wr * 64 + fr;
        if (u.pn < 8) {
            bf16_t* base = (u.pn < 4) ? Q : Kb; const int col0 = (u.pn & 3) * BM + wc * 32 + 8 * fq, idx0 = 16 * wc + 4 * fq;
#pragma unroll
            for (int ai = 0; ai < 2; ++ai)
#pragma unroll
                for (int m = 0; m < 4; ++m) { const int row = row0 + ai * HALF + m * 16;
                    const f32x4 cs = *(const f32x4*)(ropeC + (size_t)row * 64 + idx0), sn = *(const f32x4*)(ropeS + (size_t)row * 64 + idx0);
#pragma unroll
                    for (int bj = 0; bj < 2; ++bj) { const f32x4 x1 = acc[ai][bj][m][0], x2 = acc[ai][bj][m][1];
                        const f32x4 o1 = x1 * cs - x2 * sn, o2 = x2 * cs + x1 * sn;
                        u32x4 w; w.x = cvt_pk_bf16(o1[0], o1[1]); w.y = cvt_pk_bf16(o1[2], o1[3]); w.z = cvt_pk_bf16(o2[0], o2[1]); w.w = cvt_pk_bf16(o2[2], o2[3]);
                        *(u32x4*)(base + (size_t)row * 1024 + col0 + bj * HALF) = w; } }
        } else if (u.pn < 12) {
            const int col0 = (u.pn - 8) * BM + wc * 32 + 8 * fq;
#pragma unroll
            for (int ai = 0; ai < 2; ++ai)
#pragma unroll
                for (int m = 0; m < 4; ++m) { bf16_t* rowp = V + (size_t)(row0 + ai * HALF + m * 16) * 1024 + col0;
#pragma unroll
                    for (int bj = 0; bj < 2; ++bj) { const f32x4 v0 = acc[ai][bj][m][0], v1 = acc[ai][bj][m][1];
                        u32x4 w; w.x = cvt_pk_bf16(v0[0], v0[1]); w.y = cvt_pk_bf16(v0[2], v0[3]); w.z = cvt_pk_bf16(v1[0], v1[1]); w.w = cvt_pk_bf16(v1[2], v1[3]);
                        *(u32x4*)(rowp + bj * HALF) = w; } }
        } else {
            const int col0 = (u.pn - 12) * HALF + wc * 32 + 8 * fq;
#pragma unroll
            for (int ai = 0; ai < 2; ++ai)
#pragma unroll
                for (int m = 0; m < 4; ++m) { bf16_t* rowp = U + (size_t)(row0 + ai * HALF + m * 16) * 1024 + col0;
                    float o[8];
#pragma unroll
                    for (int n = 0; n < 2; ++n)
#pragma unroll
                        for (int j = 0; j < 4; ++j) o[n * 4 + j] = acc[ai][0][m][n][j] * sigmoidf_fast(acc[ai][1][m][n][j]);
                    u32x4 w; w.x = cvt_pk_bf16(o[0], o[1]); w.y = cvt_pk_bf16(o[2], o[3]); w.z = cvt_pk_bf16(o[4], o[5]); w.w = cvt_pk_bf16(o[6], o[7]);
                    *(u32x4*)rowp = w; }
        }
    }
};

template <class Epi, class Sched, bool ALIGN_EPI = false, bool SP2 = false, bool FP8 = false>
__device__ __forceinline__ void gemm_phase(PG8_LAS unsigned char* lds, const Gemm g, const Sched& S, const Epi& E, const int wave_in) {
    int lane; asm volatile("v_mbcnt_lo_u32_b32 %0, -1, 0\n\tv_mbcnt_hi_u32_b32 %0, -1, %0" : "=v"(lane));
    const int wid = wave_in, tid = wid * 64 + lane, wr = wid >> 2, wc = wid & 3, fr = lane & 15, fq = lane >> 4;
    const int K = g.K, nt = K / BK;
    unsigned voffA[2], voffB[2];
#pragma unroll
    for (int i = 0; i < 2; ++i) { int R, C; stage_rc(tid * 16 + i * 8192, R, C); const int Rb = Epi::PERM ? ((R & ~31) + perm32(R & 31)) : R;
        voffA[i] = (unsigned)(R * K + C) * 2u; voffB[i] = (unsigned)(Rb * K + C) * 2u; }
    const size_t kstep = (size_t)(BK * 2);
    const size_t hstep = (size_t)HALF * K * 2;
    const size_t tstep = 2 * hstep;
    const unsigned ldsw = (unsigned)wid * 1024u;
    const int aoff = lds_byte(wr * 64 + fr, fq * 8), boff = lds_byte(wc * 32 + fr, fq * 8);
#define PG8_SA(b, h) (((b) * 2 + (h)) * HTB)
#define PG8_SB(b, h) ((4 + (b) * 2 + (h)) * HTB)
#define PG8_STAGE(bufoff, gbase, voff) do { _Pragma("unroll") for (int _i = 0; _i < 2; ++_i) \
        __builtin_amdgcn_global_load_lds((const unsigned*)((const char*)(gbase) + (voff)[_i]), (PG8_LAS unsigned*)(lds + (bufoff) + ldsw + _i * 8192), 16, 0, 0); } while (0)
#define PG8_LDA(dst, b, h) do { if constexpr (FP8) { _Pragma("unroll") for (int m = 0; m < 4; ++m) { const v4i lo_ = *(const PG8_LAS v4i*)(lds + PG8_SA(b, h) + aoff + m * 2048), hi_ = *(const PG8_LAS v4i*)(lds + PG8_SA(b, h) + aoff + m * 2048 + 1024); \
            dst##8[m] = __builtin_shufflevector(lo_, hi_, 0, 1, 2, 3, 4, 5, 6, 7); } } \
        else { _Pragma("unroll") for (int m = 0; m < 4; ++m) _Pragma("unroll") for (int k = 0; k < 2; ++k) dst[m][k] = *(const PG8_LAS bf16x8*)(lds + PG8_SA(b, h) + aoff + m * 2048 + k * 1024); } } while (0)
#define PG8_LDB(dst, b, h) do { if constexpr (FP8) { _Pragma("unroll") for (int n = 0; n < 2; ++n) { const v4i lo_ = *(const PG8_LAS v4i*)(lds + PG8_SB(b, h) + boff + n * 2048), hi_ = *(const PG8_LAS v4i*)(lds + PG8_SB(b, h) + boff + n * 2048 + 1024); \
            dst##8[n] = __builtin_shufflevector(lo_, hi_, 0, 1, 2, 3, 4, 5, 6, 7); } } \
        else { _Pragma("unroll") for (int n = 0; n < 2; ++n) _Pragma("unroll") for (int k = 0; k < 2; ++k) dst[n][k] = *(const PG8_LAS bf16x8*)(lds + PG8_SB(b, h) + boff + n * 2048 + k * 1024); } } while (0)
#define PG8_MMA(ai, bj, At, Bt) do { __builtin_amdgcn_s_setprio(1); \
        if constexpr (FP8) {   \
            _Pragma("unroll") for (int m = 0; m < 4; ++m) _Pragma("unroll") for (int n = 0; n < 2; ++n) \
                asm volatile("v_mfma_f32_16x16x128_f8f6f4 %0, %1, %2, %0" : "+v"(acc[ai][bj][m][n]) : "v"(Bt##8[n]), "v"(At##8[m]));   \
        } else { _Pragma("unroll") for (int m = 0; m < 4; ++m) _Pragma("unroll") for (int n = 0; n < 2; ++n) _Pragma("unroll") for (int k = 0; k < 2; ++k) \
            acc[ai][bj][m][n] = __builtin_amdgcn_mfma_f32_16x16x32_bf16(Bt[n][k], At[m][k], acc[ai][bj][m][n], 0, 0, 0); } \
        __builtin_amdgcn_s_setprio(0); } while (0)
#define PG8_WAIT_V(n) asm volatile("s_waitcnt vmcnt(" #n ")" ::: "memory")
#define PG8_WAIT_L(n) asm volatile("s_waitcnt lgkmcnt(" #n ")" ::: "memory")
#define PG8_BAR __builtin_amdgcn_s_barrier()
#define PG8_SCHED __builtin_amdgcn_sched_barrier(0)
    Unit cur, nxt; int ui = 0;
    if (!S.next(0, cur)) return;
    f32x4 acc[2][2][4][2];
#pragma unroll
    for (int a = 0; a < 2; ++a)
#pragma unroll
        for (int b = 0; b < 2; ++b)
#pragma unroll
            for (int m = 0; m < 4; ++m)
#pragma unroll
                for (int n = 0; n < 2; ++n) acc[a][b][m][n] = (f32x4){0.f, 0.f, 0.f, 0.f};
    bf16x8 At[4][2], B0[2][2], B1[2][2]; v8i At8[4], B08[2], B18[2];
    const char* cA = (const char*)g.A + (size_t)cur.pm * tstep; const char* cB = (const char*)g.Bt + (size_t)cur.e * g.bstride + (size_t)cur.pn * tstep;
    S.a_ready(cur);
    if constexpr (SP2) {
        PG8_STAGE(PG8_SB(0, 0), cB, voffB); PG8_STAGE(PG8_SB(0, 1), cB + hstep, voffB); PG8_STAGE(PG8_SA(0, 0), cA, voffA); PG8_STAGE(PG8_SA(0, 1), cA + hstep, voffA);
        if (wr == 1) PG8_BAR;
        PG8_WAIT_V(2); PG8_BAR;
        PG8_STAGE(PG8_SB(1, 0), cB + kstep, voffB); PG8_STAGE(PG8_SA(1, 0), cA + kstep, voffA); PG8_STAGE(PG8_SB(1, 1), cB + hstep + kstep, voffB);
        PG8_WAIT_V(6); PG8_BAR;
    } else {
        PG8_STAGE(PG8_SB(0, 0), cB, voffB); PG8_STAGE(PG8_SA(0, 0), cA, voffA); PG8_STAGE(PG8_SB(0, 1), cB + hstep, voffB); PG8_STAGE(PG8_SA(0, 1), cA + hstep, voffA);
        if (wr == 1) PG8_BAR;
        PG8_WAIT_V(4); PG8_BAR;
        PG8_STAGE(PG8_SB(1, 0), cB + kstep, voffB); PG8_STAGE(PG8_SA(1, 0), cA + kstep, voffA); PG8_STAGE(PG8_SB(1, 1), cB + hstep + kstep, voffB);
        PG8_WAIT_V(6); PG8_BAR;
    }
    for (;;) {
        const bool has_next = S.next(ui + 1, nxt);
        const char* nA = has_next ? (const char*)g.A + (size_t)nxt.pm * tstep : cA; const char* nB = has_next ? (const char*)g.Bt + (size_t)nxt.e * g.bstride + (size_t)nxt.pn * tstep : cB;
        for (int t = 0; t < nt; t += 2) {
            const bool last = (t == nt - 2);
            const char* a1 = cA + (size_t)(t + 1) * kstep;
            const char* a2 = last ? nA : cA + (size_t)(t + 2) * kstep; const char* b2 = last ? nB : cB + (size_t)(t + 2) * kstep;
            const char* a3 = a2 + kstep; const char* b3 = b2 + kstep;
            if (last && has_next) S.a_ready(nxt);
            if constexpr (SP2) {
            PG8_LDB(B0, 0, 0); PG8_LDB(B1, 0, 1); PG8_SCHED; PG8_LDA(At, 0, 0); PG8_STAGE(PG8_SA(1, 1), a1 + hstep, voffA);
            PG8_WAIT_V(8); PG8_WAIT_L(0); PG8_BAR; PG8_MMA(0, 0, At, B0); PG8_MMA(0, 1, At, B1); PG8_BAR; PG8_SCHED;
            PG8_LDA(At, 0, 1); PG8_STAGE(PG8_SB(0, 0), b2, voffB); PG8_STAGE(PG8_SB(0, 1), b2 + hstep, voffB); PG8_STAGE(PG8_SA(0, 0), a2, voffA);
            PG8_WAIT_V(8); PG8_WAIT_L(0); PG8_BAR; PG8_MMA(1, 0, At, B0); PG8_MMA(1, 1, At, B1); PG8_BAR; PG8_SCHED;
            PG8_LDB(B0, 1, 0); PG8_LDB(B1, 1, 1); PG8_SCHED; PG8_LDA(At, 1, 0); PG8_STAGE(PG8_SA(0, 1), a2 + hstep, voffA);
            PG8_WAIT_V(8); PG8_WAIT_L(0); PG8_BAR; PG8_MMA(0, 0, At, B0); PG8_MMA(0, 1, At, B1); PG8_BAR; PG8_SCHED;
            PG8_LDA(At, 1, 1); PG8_STAGE(PG8_SB(1, 0), b3, voffB); PG8_STAGE(PG8_SB(1, 1), b3 + hstep, voffB); PG8_STAGE(PG8_SA(1, 0), a3, voffA);
            PG8_WAIT_V(8); PG8_WAIT_L(0); PG8_BAR; PG8_MMA(1, 0, At, B0); PG8_MMA(1, 1, At, B1); PG8_BAR; PG8_SCHED;
            } else {
            PG8_LDB(B0, 0, 0); PG8_SCHED; PG8_LDA(At, 0, 0); PG8_STAGE(PG8_SA(1, 1), a1 + hstep, voffA);
            PG8_WAIT_L(8); PG8_BAR; PG8_WAIT_L(0); PG8_MMA(0, 0, At, B0); PG8_BAR; PG8_SCHED;
            PG8_LDB(B1, 0, 1); PG8_STAGE(PG8_SB(0, 0), b2, voffB);
            PG8_BAR; PG8_WAIT_L(0); PG8_MMA(0, 1, At, B1); PG8_BAR;
            PG8_LDA(At, 0, 1); PG8_STAGE(PG8_SA(0, 0), a2, voffA);
            PG8_BAR; PG8_WAIT_L(0); PG8_MMA(1, 0, At, B0); PG8_BAR; PG8_SCHED;
            PG8_STAGE(PG8_SB(0, 1), b2 + hstep, voffB);
            PG8_WAIT_V(6); PG8_BAR; PG8_MMA(1, 1, At, B1); PG8_BAR;
            PG8_LDB(B0, 1, 0); PG8_SCHED; PG8_LDA(At, 1, 0); PG8_STAGE(PG8_SA(0, 1), a2 + hstep, voffA);
            PG8_WAIT_L(8); PG8_BAR; PG8_WAIT_L(0); PG8_MMA(0, 0, At, B0); PG8_BAR; PG8_SCHED;
            PG8_LDB(B1, 1, 1); PG8_STAGE(PG8_SB(1, 0), b3, voffB);
            PG8_BAR; PG8_WAIT_L(0); PG8_MMA(0, 1, At, B1); PG8_BAR;
            PG8_LDA(At, 1, 1); PG8_STAGE(PG8_SA(1, 0), a3, voffA);
            PG8_BAR; PG8_WAIT_L(0); PG8_MMA(1, 0, At, B0); PG8_BAR; PG8_SCHED;
            PG8_STAGE(PG8_SB(1, 1), b3 + hstep, voffB);
            PG8_WAIT_V(6); PG8_BAR; PG8_MMA(1, 1, At, B1); PG8_BAR;
            }
        }
        if constexpr (FP8) asm volatile("s_nop 15\n\ts_nop 15" ::: "memory");
        if constexpr (ALIGN_EPI) { if (wr == 0) PG8_BAR; }
        if constexpr (!Epi::AFTER_DRAIN) { E(acc, cur, wr, wc, fr, fq); S.done(cur); }
        if (!has_next) break;
#pragma unroll
        for (int a = 0; a < 2; ++a)
#pragma unroll
            for (int b = 0; b < 2; ++b)
#pragma unroll
                for (int m = 0; m < 4; ++m)
#pragma unroll
                    for (int n = 0; n < 2; ++n) acc[a][b][m][n] = (f32x4){0.f, 0.f, 0.f, 0.f};
        cur = nxt; cA = nA; cB = nB; ++ui;
        if constexpr (ALIGN_EPI) { if (wr == 1) PG8_BAR; }
    }
    PG8_WAIT_V(0);
    if constexpr (!ALIGN_EPI) { if (wr == 0) PG8_BAR; }
    PG8_BAR;
    if constexpr (Epi::AFTER_DRAIN) { E.fused(acc, cur, wr, wc, fr, fq, lds, wid, lane); S.done(cur); }
#undef PG8_SA
#undef PG8_SB
#undef PG8_STAGE
#undef PG8_LDA
#undef PG8_LDB
#undef PG8_MMA
#undef PG8_WAIT_V
#undef PG8_WAIT_L
#undef PG8_BAR
#undef PG8_SCHED
}
}

constexpr int NWAVES = 8;
constexpr int S = 16384, DM = 2048, NPROJ = 5120, AW = 1024, HD = 128, NH = 8, DFF = 5632, NE = 8, CKW = 31, NBLK = 64;
constexpr float LN_EPS = 1e-5f, ALPHA = 1.41421356237309515f;
constexpr int MOE_ROWS = 2 * S + NE * 256;
constexpr float WSC_GU = 32.f, WSC_D = 128.f, ASC_H = 4.f, ASC_ACT = 8.f;

constexpr size_t MiB = 1u << 20;
constexpr size_t WS_CTL = 0, CTL_ZERO_BYTES = 1 * MiB;
constexpr size_t WS_ROPEC = 1 * MiB, WS_ROPES = 5 * MiB;
constexpr size_t WS_KMEAN = 9 * MiB;
constexpr size_t WS_EIDX = 9 * MiB + 512 * 1024, WS_GATEW = WS_EIDX + 128 * 1024, WS_ROWPOS = WS_GATEW + 128 * 1024;
constexpr size_t WS_WIN = 10 * MiB, WS_WOUT = 50 * MiB, WS_WGU0 = 66 * MiB, WS_WD0 = 110 * MiB, WS_WGUE = 132 * MiB, WS_WDE = 484 * MiB;
constexpr size_t WS_HB = 660 * MiB;
constexpr size_t WS_R2 = 724 * MiB;
constexpr size_t WS_HBP = 860 * MiB;
constexpr size_t WS_R1 = 996 * MiB;
constexpr size_t WS_Q = WS_R1, WS_K = WS_R1 + 32 * MiB, WS_V = WS_R1 + 64 * MiB, WS_U = WS_R1 + 96 * MiB, WS_CAT = WS_R1 + 128 * MiB, WS_ACT = WS_R1;
constexpr size_t WS_VT = WS_R1 + 192 * MiB, WS_PO = WS_R1 + 224 * MiB, WS_PML = WS_R1 + 320 * MiB, WS_LIST = WS_R1 + 324 * MiB;
constexpr size_t WS_END = 1370 * MiB;
static_assert(WS_R1 + (size_t)MOE_ROWS * DFF * 2 <= WS_END && WS_HBP + (size_t)MOE_ROWS * DM * 2 <= WS_R1 && WS_R2 + (size_t)MOE_ROWS * DM * 2 <= WS_HBP, "d_ws map");
static_assert(WS_WDE + (size_t)NE * DM * DFF * 2 <= WS_HB && WS_WGUE + (size_t)NE * 2 * DFF * DM * 2 <= WS_WDE, "d_ws weights map");
constexpr int CW_TMO = 0, CW_CODE = 1, CW_BAR = 4096, CW_ECNT = 8192, CW_ECUR = 8192 + 64 * 8, CW_LCNT = 12288;
constexpr int RING_OFF = 0, RING_BYTES = 131072;
constexpr int LDSCTL_OFF = 139264, MISC_OFF = LDSCTL_OFF + 320;
constexpr int LDS_BYTES = 147456;

__device__ const float INV_FREQ[64] = {
1.000000000e+00f, 8.659643531e-01f, 7.498942018e-01f, 6.493816376e-01f, 5.623413324e-01f, 4.869675338e-01f, 4.216965139e-01f, 3.651741147e-01f, 3.162277639e-01f, 2.738419771e-01f, 2.371373773e-01f, 2.053525001e-01f, 1.778279394e-01f, 1.539926529e-01f, 1.333521456e-01f, 1.154781953e-01f, 1.000000015e-01f, 8.659642935e-02f, 7.498942316e-02f, 6.493816525e-02f, 5.623413250e-02f, 4.869675264e-02f, 4.216964915e-02f, 3.651741147e-02f, 3.162277490e-02f, 2.738419548e-02f, 2.371373773e-02f, 2.053525113e-02f, 1.778279431e-02f, 1.539926510e-02f, 1.333521400e-02f, 1.154781971e-02f, 9.999999776e-03f, 8.659643121e-03f, 7.498942316e-03f, 6.493816152e-03f, 5.623413250e-03f, 4.869675264e-03f, 4.216964822e-03f, 3.651741194e-03f, 3.162277630e-03f, 2.738419687e-03f, 2.371373819e-03f, 2.053525066e-03f, 1.778279431e-03f, 1.539926510e-03f, 1.333521446e-03f, 1.154782018e-03f, 1.000000047e-03f, 8.659643354e-04f, 7.498941850e-04f, 6.493816036e-04f, 5.623413017e-04f, 4.869675322e-04f, 4.216965172e-04f, 3.651741135e-04f, 3.162277571e-04f, 2.738419571e-04f, 2.371373703e-04f, 2.053525095e-04f, 1.778279402e-04f, 1.539926598e-04f, 1.333521504e-04f, 1.154782003e-04f
};

#define GAS __attribute__((address_space(1)))
#define LAS __attribute__((address_space(3)))
typedef unsigned short bf16;
typedef unsigned v4u __attribute__((ext_vector_type(4)));
typedef unsigned v2u __attribute__((ext_vector_type(2)));
typedef float f32x4 __attribute__((ext_vector_type(4)));
typedef float f32x2 __attribute__((ext_vector_type(2)));
typedef short bf16x8 __attribute__((ext_vector_type(8)));
typedef GAS unsigned gu32;
typedef GAS unsigned long long gu64;
#define RLX_AGENT __ATOMIC_RELAXED, __HIP_MEMORY_SCOPE_AGENT
#define LDS_WAIT() asm volatile("s_waitcnt lgkmcnt(0)" ::: "memory")
#define VM_WAIT() asm volatile("s_waitcnt vmcnt(0)" ::: "memory")
__device__ __forceinline__ unsigned f2bf(float f) { unsigned u = __builtin_bit_cast(unsigned, f); return (u + 0x7fffu + ((u >> 16) & 1u)) >> 16; }
__device__ __forceinline__ unsigned pk2(float lo, float hi) { return f2bf(lo) | (f2bf(hi) << 16); }
__device__ __forceinline__ float bflo(unsigned w) { return __builtin_bit_cast(float, w << 16); }
__device__ __forceinline__ float bfhi(unsigned w) { return __builtin_bit_cast(float, w & 0xffff0000u); }

#define XB_TMO      128
#define XB_XCNT(j)  (256  + 64 * (j))
#define XB_XSUB(j)  (1280 + 64 * (j))
#define XB_XGEN(j)  (2304 + 64 * (j))
#define XB_TOP      3328
#define XB_TOPGEN   3392
#define XCD_BAR_WORDS 3456
#define XB_SPIN_CAP (1u << 22)

__device__ __forceinline__ unsigned xb_ld(unsigned* p)              { return __hip_atomic_load(p, __ATOMIC_RELAXED, __HIP_MEMORY_SCOPE_AGENT); }
__device__ __forceinline__ unsigned xb_add(unsigned* p, unsigned v) { return __hip_atomic_fetch_add(p, v, __ATOMIC_RELAXED, __HIP_MEMORY_SCOPE_AGENT); }
__device__ __forceinline__ unsigned xb_xcc_id() { return (unsigned)__builtin_amdgcn_s_getreg((3 << 11) | 20) & 0xFu; }
#define XB_SPIN(cond, bar) do { unsigned _sp = 0; while (cond) { __builtin_amdgcn_s_sleep(1); \
    if ((++_sp & 255u) == 0u) { if (xb_ld(&(bar)[XB_TMO])) break; if (_sp > XB_SPIN_CAP) { atomicAdd(&(bar)[XB_TMO], 1u); break; } } } } while (0)

__device__ __forceinline__ int lane_now() { int l; asm volatile("v_mbcnt_lo_u32_b32 %0, -1, 0\n\tv_mbcnt_hi_u32_b32 %0, -1, %0" : "=v"(l)); return l; }
#define XB_T0() (b.w0 == 0 && lane_now() == 0)
struct XcdBarrier {
    unsigned* bar; unsigned x; int w0;
    volatile LAS unsigned* st;
};

__device__ __forceinline__ XcdBarrier xcd_barrier_post(unsigned* bar, volatile LAS unsigned* st, int w0) {
    XcdBarrier b; b.bar = bar; b.x = xb_xcc_id(); b.st = st; b.w0 = w0;
    if (XB_T0()) (void)xb_add(&bar[XB_XCNT(b.x)], 1u);
    return b;
}
__device__ __forceinline__ void xcd_barrier_complete(unsigned* bar, unsigned x, unsigned& nloc, unsigned& nx) {
    const unsigned G = gridDim.x * gridDim.y * gridDim.z;
    unsigned sum, cnt, mine, sp = 0u;
    for (;;) {
        sum = 0u; cnt = 0u; mine = 0u;
#pragma unroll
        for (unsigned j = 0; j < 16; ++j) { const unsigned c = xb_ld(&bar[XB_XCNT(j)]); sum += c; cnt += (c > 0u) ? 1u : 0u; mine = (j == x) ? c : mine; }
        if (sum == G) break;
        __builtin_amdgcn_s_sleep(1);
        if ((++sp & 255u) == 0u) { if (xb_ld(&bar[XB_TMO])) break; if (sp > XB_SPIN_CAP) { atomicAdd(&bar[XB_TMO], 1u); break; } }
    }
    nloc = mine > 0u ? mine : 1u; nx = cnt > 0u ? cnt : 1u;
}

__device__ __forceinline__ void xcd_barrier(const XcdBarrier& b) {
    asm volatile("s_waitcnt vmcnt(0)" ::: "memory");
    __syncthreads();
    if (XB_T0()) {
        unsigned* bar = b.bar;
        __builtin_amdgcn_s_waitcnt(0);
        unsigned nloc = b.st[0], nx = b.st[1];
        if (nloc == 0u) { xcd_barrier_complete(bar, b.x, nloc, nx); b.st[0] = nloc; b.st[1] = nx; }
        const unsigned old = xb_add(&bar[XB_XSUB(b.x)], 1u);
        const unsigned gen = old / nloc;
        if (old + 1u == (gen + 1u) * nloc) {
            __builtin_amdgcn_fence(__ATOMIC_RELEASE, "agent");
            asm volatile("s_waitcnt vmcnt(0)" ::: "memory");
            const unsigned og = xb_add(&bar[XB_TOP], 1u);
            const unsigned tg = og / nx;
            if (og + 1u == (tg + 1u) * nx) xb_add(&bar[XB_TOPGEN], 1u);
            else XB_SPIN(xb_ld(&bar[XB_TOPGEN]) == tg, bar);
            __builtin_amdgcn_fence(__ATOMIC_ACQUIRE, "agent");
            xb_add(&bar[XB_XGEN(b.x)], 1u);
            asm volatile("s_waitcnt vmcnt(0)" ::: "memory");
        } else {
            XB_SPIN(xb_ld(&bar[XB_XGEN(b.x)]) == gen, bar);
            __builtin_amdgcn_fence(__ATOMIC_ACQUIRE, "agent");
            asm volatile("s_waitcnt vmcnt(0)" ::: "memory");
        }
    }
    __syncthreads();
}


struct Frame {
    LAS unsigned char* lds;
    volatile LAS unsigned* MISC;
    gu32* ctl;
    int wave;
    int vcu, G;
    const float* x; float* out;
    const float *w_in, *conv_w, *conv_b, *conv_g, *conv_be, *w_out, *lnm_g, *lnm_b, *lnf_g, *lnf_b, *fg, *fu, *fd, *router, *eg, *eu, *ed;
    unsigned char* ws;
};
__device__ __forceinline__ int shx_i(int v, int m, int lane) { return __builtin_amdgcn_ds_bpermute((lane ^ m) << 2, v); }
__device__ __forceinline__ float shx(float v, int m, int lane) { return __builtin_bit_cast(float, __builtin_amdgcn_ds_bpermute((lane ^ m) << 2, __builtin_bit_cast(int, v))); }
__device__ __forceinline__ int shl_i(int v, int src) { return __builtin_amdgcn_ds_bpermute(src << 2, v); }
__device__ __forceinline__ float wave_sum(float v, int lane) {
#pragma unroll
    for (int o = 1; o < 64; o <<= 1) v += shx(v, o, lane);
    return v;
}
__device__ __forceinline__ int wmap(int kind, int c) {
    if (kind == 0) return c;
    if (kind == 1) {
        if (c < 2048) { const int hh = c >> 7, w = c & 127, n = w >> 6, idx = w & 63; return hh * 128 + 32 * (idx >> 4) + 8 * ((idx >> 2) & 3) + 4 * n + (idx & 3); }
        if (c < 3072) return c;
        if (c < 4096) { const int j = c - 3072; return 3072 + 256 * (j >> 7) + (j & 127); }
        const int j = c - 4096; return 3072 + 256 * (j >> 7) + 128 + (j & 127);
    }
    return 256 * (c >> 7) + (kind == 3 ? 128 : 0) + (c & 127);
}
__device__ __forceinline__ void p0_transpose_item(const float* Wg, int K, int N, bf16* WT, int kind, LAS float* scr, int item, int lane) {
    const GAS float* W = (const GAS float*)Wg;
    const int nblk = N / 32, kb = item / nblk, nb = item % nblk, k0 = 64 * kb, n0 = 32 * nb;
    float wv[32];
#pragma unroll
    for (int i = 0; i < 32; ++i) wv[i] = W[(size_t)(k0 + 2 * i + (lane >> 5)) * N + n0 + (lane & 31)];
#pragma unroll
    for (int i = 0; i < 32; ++i) scr[(2 * i + (lane >> 5)) * 33 + (lane & 31)] = wv[i];
    LDS_WAIT(); asm volatile("" ::: "memory");
    const int c = lane & 7;
#pragma unroll
    for (int j = 0; j < 4; ++j) { const int n = (lane >> 3) + 8 * j; const LAS float* s = scr + (8 * c) * 33 + n;
        v4u o; o.x = pk2(s[0 * 33], s[1 * 33]); o.y = pk2(s[2 * 33], s[3 * 33]); o.z = pk2(s[4 * 33], s[5 * 33]); o.w = pk2(s[6 * 33], s[7 * 33]);
        *(GAS v4u*)(WT + (size_t)wmap(kind, n0 + n) * K + k0 + 8 * c) = o; }
    LDS_WAIT(); asm volatile("" ::: "memory");
}
__device__ __forceinline__ void sincos_acc(float ang, float& sn, float& cs) {
    const double x = (double)ang, k = __builtin_rint(x * 0.63661977236758134308);
    double r = __builtin_fma(-k, 1.57079632679489655800e+00, x); r = __builtin_fma(-k, 6.12323399573676603587e-17, r);
    const int q = ((int)k) & 3; const double r2 = r * r;
    double sp = 1.0 / 6227020800.0; sp = sp * r2 - 1.0 / 39916800.0; sp = sp * r2 + 1.0 / 362880.0; sp = sp * r2 - 1.0 / 5040.0; sp = sp * r2 + 1.0 / 120.0; sp = sp * r2 - 1.0 / 6.0;
    const double s = r + r * r2 * sp;
    double cp = -1.0 / 87178291200.0; cp = cp * r2 + 1.0 / 479001600.0; cp = cp * r2 - 1.0 / 3628800.0; cp = cp * r2 + 1.0 / 40320.0; cp = cp * r2 - 1.0 / 720.0; cp = cp * r2 + 1.0 / 24.0; cp = cp * r2 - 0.5;
    const double c = 1.0 + r2 * cp;
    const double ss = (q & 1) ? c : s, cc = (q & 1) ? s : c;
    sn = (float)((q & 2) ? -ss : ss); cs = (float)(((q + 1) & 2) ? -cc : cc);
}
__device__ __forceinline__ void p0_transpose_item8(const float* Wg, int K, int N, unsigned char* WT, int kind, float wscale, LAS float* scr, int item, int lane) {
    const GAS float* W = (const GAS float*)Wg;
    const int nblk = N / 32, kb = item / nblk, nb = item % nblk, k0 = 64 * kb, n0 = 32 * nb;
    float wv[32];
#pragma unroll
    for (int i = 0; i < 32; ++i) wv[i] = W[(size_t)(k0 + 2 * i + (lane >> 5)) * N + n0 + (lane & 31)];
#pragma unroll
    for (int i = 0; i < 32; ++i) scr[(2 * i + (lane >> 5)) * 33 + (lane & 31)] = wv[i] * wscale;
    LDS_WAIT(); asm volatile("" ::: "memory");
    const int c = lane & 7;
#pragma unroll
    for (int j = 0; j < 4; ++j) { const int n = (lane >> 3) + 8 * j; const LAS float* sp = scr + (8 * c) * 33 + n;
        v2u o; o.x = pg8::pk4_fp8(sp[0 * 33], sp[1 * 33], sp[2 * 33], sp[3 * 33]); o.y = pg8::pk4_fp8(sp[4 * 33], sp[5 * 33], sp[6 * 33], sp[7 * 33]);
        *(GAS v2u*)(WT + (size_t)wmap(kind, n0 + n) * K + k0 + 8 * c) = o; }
    LDS_WAIT(); asm volatile("" ::: "memory");
}
__device__ __forceinline__ void p0_transpose_stack8(Frame& F, const float* src, int K, int N, int nmat, unsigned char* dst, size_t dst_stride, int kind, float wscale) {
    LAS float* scr = (LAS float*)(F.lds + RING_OFF + F.wave * 16384);
    const int gw = F.vcu * NWAVES + F.wave, NGW = F.G * NWAVES, per = (K / 64) * (N / 32), total = per * nmat, lane = lane_now();
#pragma clang loop unroll(disable)
    for (int it = gw; it < total; it += NGW) { const int m = it / per, r = it - m * per;
        p0_transpose_item8(src + (size_t)m * K * N, K, N, dst + (size_t)m * dst_stride, kind, wscale, scr, r, lane); }
}
__device__ __forceinline__ void p0_transpose_stack(Frame& F, const float* src, int K, int N, int nmat, bf16* dst, size_t dst_stride, int kind) {
    LAS float* scr = (LAS float*)(F.lds + RING_OFF + F.wave * 16384);
    const int gw = F.vcu * NWAVES + F.wave, NGW = F.G * NWAVES, per = (K / 64) * (N / 32), total = per * nmat, lane = lane_now();
#pragma clang loop unroll(disable)
    for (int it = gw; it < total; it += NGW) { const int m = it / per, r = it - m * per;
        p0_transpose_item(src + (size_t)m * K * N, K, N, dst + (size_t)m * dst_stride, kind, scr, r, lane); }
}
__device__ __forceinline__ void p0_prologue(Frame& F) {
    p0_transpose_stack(F, F.w_in, DM, NPROJ, 2, (bf16*)(F.ws + WS_WIN), (size_t)NPROJ * DM, 1);
    p0_transpose_stack(F, F.w_out, DM, DM, 2, (bf16*)(F.ws + WS_WOUT), (size_t)DM * DM, 0);
    p0_transpose_stack(F, F.fg, DM, DFF, 1, (bf16*)(F.ws + WS_WGU0), 0, 2);
    p0_transpose_stack(F, F.fu, DM, DFF, 1, (bf16*)(F.ws + WS_WGU0), 0, 3);
    p0_transpose_stack(F, F.fd, DFF, DM, 1, (bf16*)(F.ws + WS_WD0), 0, 0);
    p0_transpose_stack8(F, F.eg, DM, DFF, NE, F.ws + WS_WGUE, (size_t)2 * DFF * DM, 2, WSC_GU);
    p0_transpose_stack8(F, F.eu, DM, DFF, NE, F.ws + WS_WGUE, (size_t)2 * DFF * DM, 3, WSC_GU);
    p0_transpose_stack8(F, F.ed, DFF, DM, NE, F.ws + WS_WDE, (size_t)DM * DFF, 0, WSC_D);
    { GAS float* rc = (GAS float*)(F.ws + WS_ROPEC); GAS float* rs = (GAS float*)(F.ws + WS_ROPES);
#pragma clang loop unroll(disable)
      for (int i = (F.vcu * NWAVES + F.wave) * 64 + lane_now(); i < S * 64; i += F.G * NWAVES * 64) { const int t = i >> 6, f = i & 63; const float ang = (float)t * INV_FREQ[f]; float sn, cs; sincos_acc(ang, sn, cs); rc[i] = cs; rs[i] = sn; } }
    { const GAS f32x4* xs = (const GAS f32x4*)F.x; GAS v4u* hb = (GAS v4u*)(F.ws + WS_HB);
#pragma clang loop unroll(disable)
      for (int i = (F.vcu * NWAVES + F.wave) * 64 + lane_now(); i < S * DM / 8; i += F.G * NWAVES * 64) { const f32x4 a = xs[2 * i], b = xs[2 * i + 1]; v4u o; o.x = pk2(a[0], a[1]); o.y = pk2(a[2], a[3]); o.z = pk2(b[0], b[1]); o.w = pk2(b[2], b[3]); hb[i] = o; } }
}

__device__ __forceinline__ void kmean_phase(Frame& F) {
    const int lane = lane_now(), c8 = lane & 15, rg = lane >> 4;
    const int unit = F.wave * F.G + (int)blockIdx.x;
    if (unit < NH * NBLK) { const int j = unit & 63, h = unit >> 6;
        const GAS v4u* kp = (const GAS v4u*)(F.ws + WS_K) + ((size_t)(j * 256 + rg) * 1024 + h * 128) / 8 + c8;
        float a[8];
#pragma unroll
        for (int i = 0; i < 8; ++i) a[i] = 0.f;
#pragma unroll 16
        for (int it = 0; it < 64; ++it) { const v4u w = kp[(size_t)it * 4 * 128];
            a[0] += bflo(w.x); a[1] += bfhi(w.x); a[2] += bflo(w.y); a[3] += bfhi(w.y); a[4] += bflo(w.z); a[5] += bfhi(w.z); a[6] += bflo(w.w); a[7] += bfhi(w.w); }
#pragma unroll
        for (int i = 0; i < 8; ++i) { a[i] += shx(a[i], 16, lane); a[i] += shx(a[i], 32, lane); a[i] *= (1.f / 256.f); }
        if (rg == 0) { v4u hi, lo;
            hi.x = pk2(a[0], a[1]); hi.y = pk2(a[2], a[3]); hi.z = pk2(a[4], a[5]); hi.w = pk2(a[6], a[7]);
            lo.x = pk2(a[0] - bflo(hi.x), a[1] - bfhi(hi.x)); lo.y = pk2(a[2] - bflo(hi.y), a[3] - bfhi(hi.y)); lo.z = pk2(a[4] - bflo(hi.z), a[5] - bfhi(hi.z)); lo.w = pk2(a[6] - bflo(hi.w), a[7] - bfhi(hi.w));
            GAS v4u* kh = (GAS v4u*)(F.ws + WS_KMEAN) + ((size_t)(h * 64 + j) * 128) / 8 + c8;
            kh[0] = hi; kh[NH * NBLK * HD / 8] = lo; } }
}
__device__ __forceinline__ void vt_phase(Frame& F) {
    const int gw = F.vcu * NWAVES + F.wave, NGW = F.G * NWAVES, lane = lane_now();
    LAS unsigned char* tile = F.lds + RING_OFF + F.wave * 8704;
#pragma clang loop unroll(disable)
    for (int unit = gw; unit < (S / 32) * NH; unit += NGW) { const int h = unit & 7, kb = (unit >> 3) * 32;
        const GAS v4u* src = (const GAS v4u*)(F.ws + WS_V) + ((size_t)kb * 1024 + h * 128) / 8;
#pragma unroll
        for (int i = 0; i < 8; ++i) { const int row = i * 4 + (lane >> 4), c16 = lane & 15; *(LAS v4u*)(tile + row * 272 + c16 * 16) = src[(size_t)row * 128 + c16]; }
        LDS_WAIT(); asm volatile("" ::: "memory");
        const int ch = lane & 3, G = ch >> 1, g = ch & 1;
#pragma unroll
        for (int i = 0; i < 8; ++i) { const int d = i * 16 + (lane >> 2);
            unsigned short e[8];
#pragma unroll
            for (int p = 0; p < 8; ++p) { const int key = 16 * G + 8 * (p >> 2) + 4 * g + (p & 3); e[p] = *(const LAS unsigned short*)(tile + key * 272 + d * 2); }
            v4u o; o.x = (unsigned)e[0] | ((unsigned)e[1] << 16); o.y = (unsigned)e[2] | ((unsigned)e[3] << 16); o.z = (unsigned)e[4] | ((unsigned)e[5] << 16); o.w = (unsigned)e[6] | ((unsigned)e[7] << 16);
            *((GAS v4u*)(F.ws + WS_VT) + ((size_t)(h * 128 + d) * S + kb + 8 * ch) / 8) = o; }
        LDS_WAIT(); asm volatile("" ::: "memory");
    }
}

constexpr int CT = 16, CROWS = CT + 30;
__device__ __forceinline__ void conv_phase(Frame& F, int l) {
    LAS unsigned* ub = (LAS unsigned*)(F.lds + RING_OFF);
    LAS f32x2* part = (LAS f32x2*)(F.lds + RING_OFF + CROWS * 2048);
    const int lane = lane_now(), tid = F.wave * 64 + lane;
    const GAS f32x2* cw = (const GAS f32x2*)(F.conv_w + (size_t)l * CKW * 1024) + tid;
    float w0[CKW], w1[CKW];
#pragma unroll
    for (int k = 0; k < CKW; ++k) { const f32x2 w = cw[k * 512]; w0[k] = w.x; w1[k] = w.y; }
    const f32x2 cb = ((const GAS f32x2*)(F.conv_b + l * 1024))[tid], lg = ((const GAS f32x2*)(F.conv_g + l * 1024))[tid], lb = ((const GAS f32x2*)(F.conv_be + l * 1024))[tid];
    const GAS v4u* U = (const GAS v4u*)(F.ws + WS_U);
    GAS unsigned* CAT = (GAS unsigned*)(F.ws + WS_CAT);
    constexpr int NP = (CROWS * 128 + NWAVES * 64 - 1) / (NWAVES * 64);
    const int tb = (int)blockIdx.x * 64;
#pragma clang loop unroll(disable)
    for (int st = 0; st < 4; ++st) { const int t0 = tb + st * CT;
        { const int lane2 = lane_now(), tid2 = F.wave * 64 + lane2;
          v4u nx[NP];
#pragma unroll
          for (int i = 0; i < NP; ++i) { const int p = tid2 + NWAVES * 64 * i, tok = t0 - 30 + (p >> 7); nx[i] = (v4u){0u, 0u, 0u, 0u}; if (p < CROWS * 128 && tok >= 0) nx[i] = U[(size_t)tok * 128 + (p & 127)]; }
#pragma unroll
          for (int i = 0; i < NP; ++i) { const int p = tid2 + NWAVES * 64 * i; if (p < CROWS * 128) *(LAS v4u*)(ub + (p >> 7) * 512 + (p & 127) * 4) = nx[i]; } }
        __syncthreads();
        float a0[CT], a1[CT];
#pragma unroll
        for (int t = 0; t < CT; ++t) { a0[t] = cb.x; a1[t] = cb.y; }
#pragma unroll
        for (int r = 0; r < CROWS; ++r) { const unsigned w = ub[r * 512 + tid]; const float x0 = bflo(w), x1 = bfhi(w);
#pragma unroll
            for (int t = 0; t < CT; ++t) { if (r - t >= 0 && r - t <= 30) { a0[t] += w0[r - t] * x0; a1[t] += w1[r - t] * x1; } } }
#pragma unroll
        for (int t = 0; t < CT; ++t) { float s1 = a0[t] + a1[t], q = a0[t] * a0[t] + a1[t] * a1[t]; s1 = wave_sum(s1, lane); q = wave_sum(q, lane); if (lane == 0) part[F.wave * CT + t] = (f32x2){s1, q}; }
        __syncthreads();
#pragma unroll
        for (int t = 0; t < CT; ++t) { float s1 = 0.f, q = 0.f;
#pragma unroll
            for (int w = 0; w < 8; ++w) { const f32x2 pp = part[w * CT + t]; s1 += pp.x; q += pp.y; }
            const float mean = s1 * (1.f / 1024.f), var = fmaxf(q * (1.f / 1024.f) - mean * mean, 0.f), rstd = 1.0f / sqrtf(var + LN_EPS);
            const float y0 = (a0[t] - mean) * rstd * lg.x + lb.x, y1 = (a1[t] - mean) * rstd * lg.y + lb.y;
            CAT[((size_t)(t0 + t) * DM + 1024) / 2 + tid] = pk2(y0 * pg8::sigmoidf_fast(y0), y1 * pg8::sigmoidf_fast(y1)); }
        __syncthreads();
    }
}

typedef float f32x16 __attribute__((ext_vector_type(16)));
typedef __bf16 bf16x2_t __attribute__((ext_vector_type(2)));
__device__ __forceinline__ unsigned cvtpk(float lo, float hi) { const f32x2 v = {lo, hi}; const bf16x2_t b = __builtin_convertvector(v, bf16x2_t); return __builtin_bit_cast(unsigned, b); }
#define MFMA32(a, b, c) __builtin_amdgcn_mfma_f32_32x32x16_bf16((a), (b), (c), 0, 0, 0)
constexpr int LIST_PER_HEAD = 256 * 2016;
__device__ __forceinline__ int binoff(int j) { return 256 * (63 * j - (j * (j - 1)) / 2); }
#define TOP3_INSERT(v, j) do { const float v_ = (v); const int j_ = (j); \
    if (v_ > tv2) { if (v_ > tv1) { tv2 = tv1; ti2 = ti1; if (v_ > tv0) { tv1 = tv0; ti1 = ti0; tv0 = v_; ti0 = j_; } else { tv1 = v_; ti1 = j_; } } else { tv2 = v_; ti2 = j_; } } } while (0)
__device__ __forceinline__ void sel_phase(Frame& F, int l) {
    LAS int* cntL = (LAS int*)(F.lds + RING_OFF); LAS int* baseL = cntL + 64;
    const int lane = lane_now(), r = lane & 31, hg = lane >> 5, tid = F.wave * 64 + lane;
    const float NEG = -__builtin_inff();
#pragma clang loop unroll(disable)
    for (int unit = blockIdx.x; unit < 63 * NH; unit += F.G) { const int b = 1 + (unit >> 3), h = unit & 7;
        if (tid < 64) cntL[tid] = 0;
        __syncthreads();
        const int t = b * 256 + F.wave * 32 + r;
        const GAS bf16x8* qp = (const GAS bf16x8*)(F.ws + WS_Q) + ((size_t)t * 1024 + h * 128) / 8 + hg;
        bf16x8 qf[8];
#pragma unroll
        for (int kk = 0; kk < 8; ++kk) qf[kk] = qp[2 * kk];
        const GAS bf16x8* kh = (const GAS bf16x8*)(F.ws + WS_KMEAN) + ((size_t)(h * 64 + r) * 128) / 8 + hg;
        f32x16 G0, G1;
#pragma unroll
        for (int i = 0; i < 16; ++i) { G0[i] = 0.f; G1[i] = 0.f; }
#pragma unroll
        for (int kk = 0; kk < 8; ++kk) { G0 = MFMA32(kh[2 * kk], qf[kk], G0); G0 = MFMA32(kh[2 * kk + NH * NBLK * HD / 8], qf[kk], G0); }
        if (b > 32) {
#pragma unroll
            for (int kk = 0; kk < 8; ++kk) { G1 = MFMA32(kh[2 * kk + 32 * 16], qf[kk], G1); G1 = MFMA32(kh[2 * kk + 32 * 16 + NH * NBLK * HD / 8], qf[kk], G1); } }
        float tv0 = NEG, tv1 = NEG, tv2 = NEG; int ti0 = 0, ti1 = 0, ti2 = 0;
#pragma unroll
        for (int i = 0; i < 16; ++i) { const int j = (i & 3) + 8 * (i >> 2) + 4 * hg; TOP3_INSERT(j < b ? G0[i] : NEG, j); }
        if (b > 32) {
#pragma unroll
            for (int i = 0; i < 16; ++i) { const int j = 32 + (i & 3) + 8 * (i >> 2) + 4 * hg; TOP3_INSERT(j < b ? G1[i] : NEG, j); } }
        { const float p0 = shx(tv0, 32, lane), p1 = shx(tv1, 32, lane), p2 = shx(tv2, 32, lane); const int q0 = shx_i(ti0, 32, lane), q1 = shx_i(ti1, 32, lane), q2 = shx_i(ti2, 32, lane);
          TOP3_INSERT(p0, q0); TOP3_INSERT(p1, q1); TOP3_INSERT(p2, q2); }
        int rk0 = 0, rk1 = 0, rk2 = 0;
        if (hg == 0) {
            if (tv0 > NEG) rk0 = __hip_atomic_fetch_add(cntL + ti0, 1, __ATOMIC_RELAXED, __HIP_MEMORY_SCOPE_WORKGROUP);
            if (tv1 > NEG) rk1 = __hip_atomic_fetch_add(cntL + ti1, 1, __ATOMIC_RELAXED, __HIP_MEMORY_SCOPE_WORKGROUP);
            if (tv2 > NEG) rk2 = __hip_atomic_fetch_add(cntL + ti2, 1, __ATOMIC_RELAXED, __HIP_MEMORY_SCOPE_WORKGROUP); }
        __syncthreads();
        if (tid < 64) { const int c = cntL[tid]; if (c > 0) baseL[tid] = (int)__hip_atomic_fetch_add(F.ctl + CW_LCNT + l * 512 + h * 64 + tid, (unsigned)c, RLX_AGENT); }
        __syncthreads();
        if (hg == 0) { GAS int* L = (GAS int*)(F.ws + WS_LIST) + (size_t)h * LIST_PER_HEAD;
            if (tv0 > NEG) L[binoff(ti0) + baseL[ti0] + rk0] = t * 4 + 0;
            if (tv1 > NEG) L[binoff(ti1) + baseL[ti1] + rk1] = t * 4 + 1;
            if (tv2 > NEG) L[binoff(ti2) + baseL[ti2] + rk2] = t * 4 + 2; }
        __syncthreads();
    }
}
constexpr int KROW = 272, VROW = 528, KBUF_BYTES = 256 * KROW, VBUF_BYTES = 128 * VROW;
#define SCHED_FENCE() __builtin_amdgcn_sched_barrier(0)
template <bool CAUSAL>
__device__ __forceinline__ void moba_tile(const bf16x8 (&qf)[8], const LAS unsigned char* kb, const LAS unsigned char* vb, const int nkt, const int r, const int hg, f32x16 (&O)[4], float& ms, float& lsum) {
    const float NEG = -__builtin_inff(), SC = 0.08838834764831845f * 1.44269504088896341f;
    f32x16 Sx[8];
    bf16x8 kfA[8], kfB[8];
#pragma unroll
    for (int kk = 0; kk < 8; ++kk) kfA[kk] = *(const LAS bf16x8*)(kb + kk * 32);
#pragma unroll
    for (int kt = 0; kt < 8; ++kt) {
        if (kt < nkt) { f32x16 a;
#pragma unroll
            for (int i = 0; i < 16; ++i) a[i] = 0.f;
            if (kt + 1 < 8 && kt + 1 < nkt) {
#pragma unroll
                for (int kk = 0; kk < 8; ++kk) { if (kt & 1) kfA[kk] = *(const LAS bf16x8*)(kb + (kt + 1) * 32 * KROW + kk * 32); else kfB[kk] = *(const LAS bf16x8*)(kb + (kt + 1) * 32 * KROW + kk * 32); } }
            SCHED_FENCE();
#pragma unroll
            for (int kk = 0; kk < 8; ++kk) a = MFMA32((kt & 1) ? kfB[kk] : kfA[kk], qf[kk], a);
            SCHED_FENCE();
            if (CAUSAL && kt == nkt - 1) {
#pragma unroll
                for (int i = 0; i < 16; ++i) a[i] = ((i & 3) + 8 * (i >> 2) + 4 * hg > r) ? NEG : a[i]; }
            Sx[kt] = a;
        } else {
#pragma unroll
            for (int i = 0; i < 16; ++i) Sx[kt][i] = NEG; }
    }
    float mx = NEG;
#pragma unroll
    for (int kt = 0; kt < 8; ++kt)
#pragma unroll
        for (int i = 0; i < 16; ++i) mx = fmaxf(mx, Sx[kt][i]);
    mx = fmaxf(mx, shx(mx, 32, r + 32 * hg));
    ms = mx * SC;
    float ls = 0.f;
    bf16x8 pb[8][2];
#pragma unroll
    for (int kt = 0; kt < 8; ++kt)
#pragma unroll
        for (int s2 = 0; s2 < 2; ++s2) { float p[8];
#pragma unroll
            for (int i = 0; i < 8; ++i) { p[i] = __builtin_amdgcn_exp2f(Sx[kt][8 * s2 + i] * SC - ms); ls += p[i]; }
            v4u pw; pw.x = cvtpk(p[0], p[1]); pw.y = cvtpk(p[2], p[3]); pw.z = cvtpk(p[4], p[5]); pw.w = cvtpk(p[6], p[7]);
            pb[kt][s2] = __builtin_bit_cast(bf16x8, pw); }
    lsum = ls + shx(ls, 32, r + 32 * hg);
#pragma unroll
    for (int dt = 0; dt < 4; ++dt)
#pragma unroll
        for (int i = 0; i < 16; ++i) O[dt][i] = 0.f;
    bf16x8 vfA[4], vfB[4];
#pragma unroll
    for (int dt = 0; dt < 4; ++dt) vfA[dt] = *(const LAS bf16x8*)(vb + dt * 32 * VROW);
#pragma unroll
    for (int st = 0; st < 16; ++st) { const int kt = st >> 1, s2 = st & 1;
        if (kt < nkt) {
            if (st + 1 < 16 && ((st + 1) >> 1) < nkt) {
#pragma unroll
                for (int dt = 0; dt < 4; ++dt) { if (st & 1) vfA[dt] = *(const LAS bf16x8*)(vb + dt * 32 * VROW + (st + 1) * 32); else vfB[dt] = *(const LAS bf16x8*)(vb + dt * 32 * VROW + (st + 1) * 32); } }
            SCHED_FENCE();
#pragma unroll
            for (int dt = 0; dt < 4; ++dt) O[dt] = MFMA32((st & 1) ? vfB[dt] : vfA[dt], pb[kt][s2], O[dt]);
            SCHED_FENCE();
        }
    }
}
__device__ __forceinline__ void stage_kv(Frame& F, int h, int j, int tid) {
    LAS unsigned char* kbuf = F.lds + RING_OFF; LAS unsigned char* vbuf = kbuf + KBUF_BYTES;
    const GAS v4u* kg = (const GAS v4u*)(F.ws + WS_K) + ((size_t)(j * 256) * 1024 + h * 128) / 8;
    const GAS v4u* vg = (const GAS v4u*)(F.ws + WS_VT) + ((size_t)(h * 128) * S + j * 256) / 8;
    v4u kr[8], vr[8];
#pragma unroll
    for (int i = 0; i < 8; ++i) { const int p = tid + 512 * i; kr[i] = kg[(size_t)(p >> 4) * 128 + (p & 15)]; vr[i] = vg[(size_t)(p >> 5) * (S / 8) + (p & 31)]; }
#pragma unroll
    for (int i = 0; i < 8; ++i) { const int p = tid + 512 * i; *(LAS v4u*)(kbuf + (p >> 4) * KROW + (p & 15) * 16) = kr[i]; *(LAS v4u*)(vbuf + (p >> 5) * VROW + (p & 31) * 16) = vr[i]; }
}
__device__ __forceinline__ void partial_phase(Frame& F, int l) {
    gu32* lcnt = F.ctl + CW_LCNT + l * 512;
    LAS int* tab = (LAS int*)(F.lds + RING_OFF + KBUF_BYTES + VBUF_BYTES);
    { const int lane = lane_now(); int tl[8], sum = 0;
#pragma unroll
      for (int i = 0; i < 8; ++i) { const int c = (int)__hip_atomic_load(lcnt + lane * 8 + i, RLX_AGENT); tl[i] = (c + 255) >> 8; sum += tl[i]; }
      int inc = sum;
#pragma unroll
      for (int o = 1; o < 64; o <<= 1) { const int v = __builtin_amdgcn_ds_bpermute((lane - o) << 2, inc); if (lane >= o) inc += v; }
      int run = inc - sum;
      if (F.wave == 0) {
#pragma unroll
          for (int i = 0; i < 8; ++i) { run += tl[i]; tab[lane * 8 + i] = run; } } }
    __syncthreads();
    const int total = __builtin_amdgcn_readfirstlane(tab[511]);
#pragma clang loop unroll(disable)
    for (int u = blockIdx.x; u < total; u += F.G) {
        const int lane = lane_now(), r = lane & 31, hg = lane >> 5, tid = F.wave * 64 + lane;
        const LAS unsigned char* kb = F.lds + RING_OFF + r * KROW + hg * 16; const LAS unsigned char* vb = F.lds + RING_OFF + KBUF_BYTES + r * VROW + hg * 16;
        int bin = 0, chunk = 0; bool mine = false;
        { const int prev = lane ? tab[lane * 8 - 1] : 0; int lo = prev;
#pragma unroll
          for (int i = 0; i < 8; ++i) { const int hi = tab[lane * 8 + i]; if (u >= lo && u < hi) { mine = true; bin = lane * 8 + i; chunk = u - lo; } lo = hi; } }
        const int src = __builtin_ctzll(__ballot(mine)); bin = __builtin_amdgcn_readlane(bin, src); chunk = __builtin_amdgcn_readlane(chunk, src);
        const int h = bin >> 6, j = bin & 63, n = (int)__builtin_amdgcn_readfirstlane(__hip_atomic_load(lcnt + bin, RLX_AGENT));
        const int base = chunk * 256 + F.wave * 32; const bool active = base < n, valid = base + r < n;
        const int e = ((const GAS int*)(F.ws + WS_LIST))[(size_t)h * LIST_PER_HEAD + binoff(j) + (active ? base + (valid ? r : 0) : 0)];
        const int t = e >> 2, sl = e & 3;
        const GAS bf16x8* qp = (const GAS bf16x8*)(F.ws + WS_Q) + ((size_t)t * 1024 + h * 128) / 8 + hg;
        bf16x8 qf[8];
#pragma unroll
        for (int kk = 0; kk < 8; ++kk) qf[kk] = qp[2 * kk];
        __syncthreads();
        stage_kv(F, h, j, tid);
        __syncthreads();
        if (active) {
            f32x16 O[4]; float ms, ls;
            moba_tile<false>(qf, kb, vb, 8, r, hg, O, ms, ls);
            if (valid) { const size_t idx = ((size_t)t * NH + h) * 3 + sl; const float inv = 1.0f / ls;
                GAS v2u* po = (GAS v2u*)(F.ws + WS_PO) + idx * 32 + hg;
#pragma unroll
                for (int dt = 0; dt < 4; ++dt)
#pragma unroll
                    for (int g4 = 0; g4 < 4; ++g4) po[dt * 8 + 2 * g4] = (v2u){cvtpk(O[dt][4 * g4] * inv, O[dt][4 * g4 + 1] * inv), cvtpk(O[dt][4 * g4 + 2] * inv, O[dt][4 * g4 + 3] * inv)};
                if (hg == 0) ((GAS f32x2*)(F.ws + WS_PML))[idx] = (f32x2){ms, ls}; }
        }
    }
}
__device__ __forceinline__ void own_phase(Frame& F) {
#pragma clang loop unroll(disable)
    for (int u = blockIdx.x; u < NBLK * NH; u += F.G) { const int h = u & 7, b = u >> 3, qt = F.wave;
        const int lane = lane_now(), r = lane & 31, hg = lane >> 5, tid = F.wave * 64 + lane;
        const LAS unsigned char* kb = F.lds + RING_OFF + r * KROW + hg * 16; const LAS unsigned char* vb = F.lds + RING_OFF + KBUF_BYTES + r * VROW + hg * 16;
        const int t = b * 256 + qt * 32 + r;
        const GAS bf16x8* qp = (const GAS bf16x8*)(F.ws + WS_Q) + ((size_t)t * 1024 + h * 128) / 8 + hg;
        bf16x8 qf[8];
#pragma unroll
        for (int kk = 0; kk < 8; ++kk) qf[kk] = qp[2 * kk];
        __syncthreads();
        stage_kv(F, h, b, tid);
        __syncthreads();
        f32x16 O[4]; float ms, ls;
        moba_tile<true>(qf, kb, vb, qt + 1, r, hg, O, ms, ls);
        const int nv = b < 3 ? b : 3; const size_t idx0 = ((size_t)t * NH + h) * 3;
        float pm[3], pl[3], M = ms;
#pragma unroll
        for (int s2 = 0; s2 < 3; ++s2) { pm[s2] = -__builtin_inff(); pl[s2] = 0.f; if (s2 < nv) { const f32x2 v = ((const GAS f32x2*)(F.ws + WS_PML))[idx0 + s2]; pm[s2] = v.x; pl[s2] = v.y; M = fmaxf(M, v.x); } }
        const float wo = __builtin_amdgcn_exp2f(ms - M); float W = ls * wo, w[3];
#pragma unroll
        for (int s2 = 0; s2 < 3; ++s2) { w[s2] = pl[s2] * __builtin_amdgcn_exp2f(pm[s2] - M); W += w[s2]; }
        const float invW = 1.0f / W;
#pragma unroll
        for (int dt = 0; dt < 4; ++dt)
#pragma unroll
            for (int i = 0; i < 16; ++i) O[dt][i] *= wo;
#pragma unroll
        for (int s2 = 0; s2 < 3; ++s2) { if (s2 < nv) { const GAS v2u* po = (const GAS v2u*)(F.ws + WS_PO) + (idx0 + s2) * 32 + hg;
#pragma unroll
                for (int dt = 0; dt < 4; ++dt)
#pragma unroll
                    for (int g4 = 0; g4 < 4; ++g4) { const v2u v = po[dt * 8 + 2 * g4]; O[dt][4 * g4] += w[s2] * bflo(v.x); O[dt][4 * g4 + 1] += w[s2] * bfhi(v.x); O[dt][4 * g4 + 2] += w[s2] * bflo(v.y); O[dt][4 * g4 + 3] += w[s2] * bfhi(v.y); } } }
        GAS v2u* co = (GAS v2u*)(F.ws + WS_CAT) + ((size_t)t * DM + h * 128) / 4 + hg;
#pragma unroll
        for (int dt = 0; dt < 4; ++dt)
#pragma unroll
            for (int g4 = 0; g4 < 4; ++g4) co[dt * 8 + 2 * g4] = (v2u){cvtpk(O[dt][4 * g4] * invW, O[dt][4 * g4 + 1] * invW), cvtpk(O[dt][4 * g4 + 2] * invW, O[dt][4 * g4 + 3] * invW)};
    }
}

__device__ __forceinline__ void ln_phase(Frame& F, const float* hres_, const bf16* y_, const float* g_, const float* b_, const float* router, bool write_hb) {
    const int gw = F.vcu * NWAVES + F.wave, lane = lane_now();
    const GAS f32x4* gp = (const GAS f32x4*)g_ + lane; const GAS f32x4* bp = (const GAS f32x4*)b_ + lane;
    int ecl[8];
#pragma unroll
    for (int e = 0; e < 8; ++e) ecl[e] = 0;
    f32x4 hraw[8]; v2u yraw[8];
    { const GAS f32x4* hp = (const GAS f32x4*)(hres_ + (size_t)(gw * 8) * DM) + lane; const GAS v2u* yp = (const GAS v2u*)(y_ + (size_t)(gw * 8) * DM) + lane;
#pragma unroll
      for (int j = 0; j < 8; ++j) { hraw[j] = hp[64 * j]; yraw[j] = yp[64 * j]; } }
#pragma clang loop unroll(disable)
    for (int i = 0; i < S / (256 * NWAVES); ++i) { const int row = gw * (S / (256 * NWAVES)) + i;
        f32x4 v[8]; float s = 0.f;
#pragma unroll
        for (int j = 0; j < 8; ++j) { const v2u yv = yraw[j]; v[j] = hraw[j] * ALPHA + (f32x4){bflo(yv.x), bfhi(yv.x), bflo(yv.y), bfhi(yv.y)}; s += (v[j][0] + v[j][1]) + (v[j][2] + v[j][3]); }
        if (i + 1 < S / (256 * NWAVES)) { const GAS f32x4* hp = (const GAS f32x4*)(hres_ + (size_t)(row + 1) * DM) + lane; const GAS v2u* yp = (const GAS v2u*)(y_ + (size_t)(row + 1) * DM) + lane;
#pragma unroll
            for (int j = 0; j < 8; ++j) { hraw[j] = hp[64 * j]; yraw[j] = yp[64 * j]; } }
        const float mean = wave_sum(s, lane) * (1.f / DM); float s2 = 0.f;
#pragma unroll
        for (int j = 0; j < 8; ++j) { v[j] = v[j] - mean; s2 += (v[j][0] * v[j][0] + v[j][1] * v[j][1]) + (v[j][2] * v[j][2] + v[j][3] * v[j][3]); }
        const float rstd = 1.f / sqrtf(wave_sum(s2, lane) * (1.f / DM) + LN_EPS);
        GAS f32x4* op = (GAS f32x4*)(F.out + (size_t)row * DM) + lane; GAS v2u* hb = (GAS v2u*)(F.ws + WS_HB + (size_t)row * DM * 2) + lane;
#pragma unroll
        for (int j = 0; j < 8; ++j) { v[j] = v[j] * rstd * gp[64 * j] + bp[64 * j]; op[64 * j] = v[j];
            if (router) ((GAS unsigned*)(F.ws + WS_HB + (size_t)row * DM))[64 * j + lane] = pg8::pk4_fp8(v[j][0] * ASC_H, v[j][1] * ASC_H, v[j][2] * ASC_H, v[j][3] * ASC_H);
            else if (write_hb) hb[64 * j] = (v2u){pk2(v[j][0], v[j][1]), pk2(v[j][2], v[j][3])}; }
        if (router) {
            float lg[8];
#pragma unroll
            for (int e = 0; e < 8; ++e) lg[e] = 0.f;
#pragma unroll
            for (int j = 0; j < 8; ++j)
#pragma unroll
                for (int c = 0; c < 4; ++c) { const GAS f32x4* rw = (const GAS f32x4*)(router + (size_t)(256 * j + 4 * lane + c) * 8); const f32x4 r0 = rw[0], r1 = rw[1]; const float xv = v[j][c];
                    lg[0] += xv * r0[0]; lg[1] += xv * r0[1]; lg[2] += xv * r0[2]; lg[3] += xv * r0[3]; lg[4] += xv * r1[0]; lg[5] += xv * r1[1]; lg[6] += xv * r1[2]; lg[7] += xv * r1[3]; }
#pragma unroll
            for (int e = 0; e < 8; ++e) lg[e] = wave_sum(lg[e], lane);
            int i1 = 0; float v1 = lg[0];
#pragma unroll
            for (int e = 1; e < 8; ++e) if (lg[e] > v1) { v1 = lg[e]; i1 = e; }
            int i2 = -1; float v2 = -__builtin_inff();
#pragma unroll
            for (int e = 0; e < 8; ++e) if (e != i1 && lg[e] > v2) { v2 = lg[e]; i2 = e; }
            const float g1 = 1.0f / (1.0f + __expf(v2 - v1)), g2 = 1.0f - g1;
            if (lane == 0) { ((GAS int*)(F.ws + WS_EIDX))[row * 2] = i1; ((GAS int*)(F.ws + WS_EIDX))[row * 2 + 1] = i2; ((GAS float*)(F.ws + WS_GATEW))[row * 2] = g1; ((GAS float*)(F.ws + WS_GATEW))[row * 2 + 1] = g2; }
#pragma unroll
            for (int e = 0; e < 8; ++e) ecl[e] += (i1 == e ? 1 : 0) + (i2 == e ? 1 : 0);
        }
    }
    if (router) { int mine = 0;
#pragma unroll
        for (int e = 0; e < 8; ++e) mine = (lane == e) ? ecl[e] : mine;
        if (lane < 8 && mine) __hip_atomic_fetch_add(F.ctl + CW_ECNT + 64 * lane, (unsigned)mine, RLX_AGENT); }
}
__device__ __forceinline__ void load_expert_layout(Frame& F, int (&off)[8], int (&cum)[8], int& npanels) {
    int o = 0;
#pragma unroll
    for (int e = 0; e < 8; ++e) { const int c = (int)__builtin_amdgcn_readfirstlane(__hip_atomic_load(F.ctl + CW_ECNT + 64 * e, RLX_AGENT)); off[e] = o; cum[e] = o >> 8; o += (c + 255) & ~255; }
    npanels = o >> 8;
}
__device__ __forceinline__ void route_phase(Frame& F) {
    const int gw = F.vcu * NWAVES + F.wave, lane = lane_now();
    int off[8], cum[8], np; load_expert_layout(F, off, cum, np);
    const int row = gw * 8 + (lane >> 1), slot = lane & 1; const bool act = lane < 16;
    const int mye = act ? ((const GAS int*)(F.ws + WS_EIDX))[row * 2 + slot] : -1;
    int pos = 0;
#pragma unroll
    for (int e = 0; e < 8; ++e) { const unsigned long long mask = __ballot(mye == e);
        if (mask) { const int leader = __builtin_ctzll(mask), n = __builtin_popcountll(mask); unsigned b = 0u;
            if (lane == leader) b = __hip_atomic_fetch_add(F.ctl + CW_ECUR + 64 * e, (unsigned)n, RLX_AGENT);
            b = (unsigned)shl_i((int)b, leader);
            if (mye == e) pos = off[e] + (int)b + __builtin_popcountll(mask & ((1ull << lane) - 1ull)); } }
    if (act) ((GAS int*)(F.ws + WS_ROWPOS))[row * 2 + slot] = pos;
#pragma clang loop unroll(disable)
    for (int k = 0; k < 16; ++k) { const int p = shl_i(pos, k), r = gw * 8 + (k >> 1);
        const GAS v4u* src = (const GAS v4u*)(F.ws + WS_HB + (size_t)r * DM) + lane; GAS v4u* dst = (GAS v4u*)(F.ws + WS_HBP + (size_t)p * DM) + lane;
#pragma unroll
        for (int j = 0; j < 2; ++j) dst[64 * j] = src[64 * j]; }
}
__device__ __forceinline__ void ln_moe_phase(Frame& F, const float* g_, const float* b_) {
    const int gw = F.vcu * NWAVES + F.wave, lane = lane_now();
    const GAS f32x4* gp = (const GAS f32x4*)g_ + lane; const GAS f32x4* bp = (const GAS f32x4*)b_ + lane;
    int mp1 = 0, mp2 = 0; float mg1 = 0.f, mg2 = 0.f;
    if (lane < 8) { const int rr = gw * 8 + lane; mp1 = ((const GAS int*)(F.ws + WS_ROWPOS))[rr * 2]; mp2 = ((const GAS int*)(F.ws + WS_ROWPOS))[rr * 2 + 1]; mg1 = ((const GAS float*)(F.ws + WS_GATEW))[rr * 2]; mg2 = ((const GAS float*)(F.ws + WS_GATEW))[rr * 2 + 1]; }
    f32x4 hraw[8]; v2u araw[8], braw[8];
    { const int p1 = __builtin_amdgcn_readlane(mp1, 0), p2 = __builtin_amdgcn_readlane(mp2, 0);
      const GAS f32x4* hp = (const GAS f32x4*)(F.out + (size_t)(gw * 8) * DM) + lane;
      const GAS v2u* y1 = (const GAS v2u*)(F.ws + WS_R2 + (size_t)p1 * DM * 2) + lane; const GAS v2u* y2 = (const GAS v2u*)(F.ws + WS_R2 + (size_t)p2 * DM * 2) + lane;
#pragma unroll
      for (int j = 0; j < 8; ++j) { hraw[j] = hp[64 * j]; araw[j] = y1[64 * j]; braw[j] = y2[64 * j]; } }
#pragma clang loop unroll(disable)
    for (int i = 0; i < 8; ++i) { const int row = gw * 8 + i;
        const float g1 = __builtin_bit_cast(float, shl_i(__builtin_bit_cast(int, mg1), i)), g2 = __builtin_bit_cast(float, shl_i(__builtin_bit_cast(int, mg2), i));
        f32x4 v[8]; float s = 0.f;
#pragma unroll
        for (int j = 0; j < 8; ++j) { const v2u a = araw[j], b = braw[j];
            const f32x4 fa = (f32x4){bflo(a.x), bfhi(a.x), bflo(a.y), bfhi(a.y)}, fb = (f32x4){bflo(b.x), bfhi(b.x), bflo(b.y), bfhi(b.y)};
            v[j] = hraw[j] * ALPHA + fa * g1 + fb * g2; s += (v[j][0] + v[j][1]) + (v[j][2] + v[j][3]); }
        if (i + 1 < 8) { const int p1 = __builtin_amdgcn_readfirstlane(shl_i(mp1, i + 1)), p2 = __builtin_amdgcn_readfirstlane(shl_i(mp2, i + 1));
            const GAS f32x4* hp = (const GAS f32x4*)(F.out + (size_t)(row + 1) * DM) + lane;
            const GAS v2u* y1 = (const GAS v2u*)(F.ws + WS_R2 + (size_t)p1 * DM * 2) + lane; const GAS v2u* y2 = (const GAS v2u*)(F.ws + WS_R2 + (size_t)p2 * DM * 2) + lane;
#pragma unroll
            for (int j = 0; j < 8; ++j) { hraw[j] = hp[64 * j]; araw[j] = y1[64 * j]; braw[j] = y2[64 * j]; } }
        const float mean = wave_sum(s, lane) * (1.f / DM); float s2 = 0.f;
#pragma unroll
        for (int j = 0; j < 8; ++j) { v[j] = v[j] - mean; s2 += (v[j][0] * v[j][0] + v[j][1] * v[j][1]) + (v[j][2] * v[j][2] + v[j][3] * v[j][3]); }
        const float rstd = 1.f / sqrtf(wave_sum(s2, lane) * (1.f / DM) + LN_EPS);
        GAS f32x4* op = (GAS f32x4*)(F.out + (size_t)row * DM) + lane;
#pragma unroll
        for (int j = 0; j < 8; ++j) op[64 * j] = v[j] * rstd * gp[64 * j] + bp[64 * j];
    }
}

struct Args { const float* in[18]; float* out; unsigned char* ws; };
__global__ void __launch_bounds__(NWAVES * 64, 2) hymba_fwd(Args args) {
    extern __shared__ __attribute__((aligned(16))) unsigned char lds[];
    Frame F;
    F.lds = (LAS unsigned char*)lds;
    F.MISC = (volatile LAS unsigned*)(F.lds + MISC_OFF);
    F.wave = __builtin_amdgcn_readfirstlane((int)threadIdx.x >> 6);
    F.G = gridDim.x; { const int bx = blockIdx.x; F.vcu = (F.G % 8 == 0) ? (bx % 8) * (F.G / 8) + bx / 8 : bx; }
    F.ws = args.ws; F.ctl = (gu32*)(args.ws + WS_CTL);
    F.x = args.in[0]; F.w_in = args.in[1]; F.conv_w = args.in[2]; F.conv_b = args.in[3]; F.conv_g = args.in[4]; F.conv_be = args.in[5]; F.w_out = args.in[6];
    F.lnm_g = args.in[7]; F.lnm_b = args.in[8]; F.lnf_g = args.in[9]; F.lnf_b = args.in[10]; F.fg = args.in[11]; F.fu = args.in[12]; F.fd = args.in[13];
    F.router = args.in[14]; F.eg = args.in[15]; F.eu = args.in[16]; F.ed = args.in[17]; F.out = args.out;
    for (int u = threadIdx.x; u < (LDS_BYTES - LDSCTL_OFF) / 4; u += NWAVES * 64) ((LAS unsigned*)(F.lds + LDSCTL_OFF))[u] = 0u;
    __syncthreads();
    XcdBarrier bar = xcd_barrier_post((unsigned*)(F.ctl + CW_BAR), F.MISC + 8, F.wave);
#define LAUNDER() asm volatile("" : "+s"(F.ws), "+s"(F.ctl), "+s"(F.out), "+s"(F.x), "+s"(bar.bar), "+s"(F.wave))
#define GRID_BAR() do { LAUNDER(); xcd_barrier(bar); LAUNDER(); } while (0)
#define HB ((bf16*)(F.ws + WS_HB))
#define Y ((bf16*)(F.ws + WS_R2))

    p0_prologue(F);
    GRID_BAR();

#pragma clang loop unroll(disable)
    for (int l = 0; l < 2; ++l) {
#ifndef NO_G_INPROJ
        { pg8::Gemm g{HB, (const bf16*)(F.ws + WS_WIN) + (size_t)l * NPROJ * DM, S, NPROJ, DM, 0}; pg8::StaticOrder So; So.init(S, NPROJ, F.G, (int)blockIdx.x);
          pg8::EpiInProj E{(bf16*)(F.ws + WS_Q), (bf16*)(F.ws + WS_K), (bf16*)(F.ws + WS_V), (bf16*)(F.ws + WS_U), (const float*)(F.ws + WS_ROPEC), (const float*)(F.ws + WS_ROPES)};
          pg8::gemm_phase<pg8::EpiInProj, pg8::StaticOrder, true, true>(F.lds + RING_OFF, g, So, E, F.wave); }
#endif
        GRID_BAR();
        kmean_phase(F);
        vt_phase(F);
        __syncthreads();
        conv_phase(F, l);
        GRID_BAR();
        sel_phase(F, l);
        GRID_BAR();
        partial_phase(F, l);
        GRID_BAR();
        own_phase(F);
        GRID_BAR();
#ifndef NO_G_OUTPROJ
        { pg8::Gemm g{(const bf16*)(F.ws + WS_CAT), (const bf16*)(F.ws + WS_WOUT) + (size_t)l * DM * DM, S, DM, DM, 0}; pg8::StaticOrder So; So.init(S, DM, F.G, (int)blockIdx.x);
          pg8::EpiBf16 E{Y, DM, 1.0f};
          pg8::gemm_phase<pg8::EpiBf16, pg8::StaticOrder, true, true>(F.lds + RING_OFF, g, So, E, F.wave); }
#endif
        GRID_BAR();
        ln_phase(F, l == 0 ? F.x : F.out, Y, F.lnm_g + l * DM, F.lnm_b + l * DM, l == 1 ? F.router : nullptr, true);
        GRID_BAR();
        if (l == 0) {
#ifndef NO_G_FFNGU
            { pg8::Gemm g{HB, (const bf16*)(F.ws + WS_WGU0), S, 2 * DFF, DM, 0}; pg8::StaticOrder So; So.init(S, 2 * DFF, F.G, (int)blockIdx.x);
              pg8::EpiSwiGLU E{(bf16*)(F.ws + WS_ACT), DFF};
              pg8::gemm_phase<pg8::EpiSwiGLU, pg8::StaticOrder, true, true>(F.lds + RING_OFF, g, So, E, F.wave); }
#endif
            GRID_BAR();
#ifndef NO_G_FFND
            { pg8::Gemm g{(const bf16*)(F.ws + WS_ACT), (const bf16*)(F.ws + WS_WD0), S, DM, DFF, 0}; pg8::StaticOrder So; So.init(S, DM, F.G, (int)blockIdx.x);
              pg8::EpiBf16 E{Y, DM, 1.0f};
              pg8::gemm_phase<pg8::EpiBf16, pg8::StaticOrder, true, true>(F.lds + RING_OFF, g, So, E, F.wave); }
#endif
            GRID_BAR();
            ln_phase(F, F.out, Y, F.lnf_g, F.lnf_b, nullptr, true);
            GRID_BAR();
        } else {
            route_phase(F);
            GRID_BAR();
            int off[8], cum[8], np; load_expert_layout(F, off, cum, np);
#ifndef NO_G_MOEGU
            { pg8::Gemm g{(const bf16*)(F.ws + WS_HBP), (const bf16*)(F.ws + WS_WGUE), np * 256, 2 * DFF, DM / 2, (size_t)2 * DFF * DM}; pg8::GroupedOrder So; So.init(np * 256, 2 * DFF, F.G, (int)blockIdx.x);
#pragma unroll
              for (int e = 0; e < 8; ++e) So.cum[e] = cum[e];
              pg8::EpiSwiGLU8 E{F.ws + WS_ACT, DFF, 1.0f / (WSC_GU * ASC_H), ASC_ACT};
              pg8::gemm_phase<pg8::EpiSwiGLU8, pg8::GroupedOrder, true, true, true>(F.lds + RING_OFF, g, So, E, F.wave); }
#endif
            GRID_BAR();
#ifndef NO_G_MOED
            { pg8::Gemm g{(const bf16*)(F.ws + WS_ACT), (const bf16*)(F.ws + WS_WDE), np * 256, DM, DFF / 2, (size_t)DM * DFF}; pg8::GroupedOrder So; So.init(np * 256, DM, F.G, (int)blockIdx.x);
#pragma unroll
              for (int e = 0; e < 8; ++e) So.cum[e] = cum[e];
              pg8::EpiBf16 E{(bf16*)(F.ws + WS_R2), DM, 1.0f / (WSC_D * ASC_ACT)};
              pg8::gemm_phase<pg8::EpiBf16, pg8::GroupedOrder, true, true, true>(F.lds + RING_OFF, g, So, E, F.wave); }
#endif
            GRID_BAR();
            ln_moe_phase(F, F.lnf_g + DM, F.lnf_b + DM);
        }
    }
#undef GRID_BAR
#undef LAUNDER
#undef HB
#undef Y
}

extern "C" void kernel_launch(void* const* d_in, const int* in_sizes, int n_in, void* d_out, int out_size, void* d_ws, size_t ws_size, hipStream_t stream) {
    static int grid = 0;
    if (grid == 0) {
        if (n_in != 18 || in_sizes[0] != S * DM || out_size != S * DM || ws_size < WS_END) { fprintf(stderr, "kernel_launch: unexpected shapes (n_in %d, in0 %d, out %d, ws %zu < %zu); nothing launched\n", n_in, n_in > 0 ? in_sizes[0] : -1, out_size, ws_size, (size_t)WS_END); grid = -1; return; }
        int dev = 0, cus = 0, per_cu = 0;
        if (hipGetDevice(&dev) != hipSuccess || hipDeviceGetAttribute(&cus, hipDeviceAttributeMultiprocessorCount, dev) != hipSuccess) { grid = -1; return; }
        if (hipFuncSetAttribute((const void*)hymba_fwd, hipFuncAttributeMaxDynamicSharedMemorySize, LDS_BYTES) != hipSuccess) { fprintf(stderr, "kernel_launch: hipFuncSetAttribute failed\n"); grid = -1; return; }
        if (hipOccupancyMaxActiveBlocksPerMultiprocessor(&per_cu, (const void*)hymba_fwd, NWAVES * 64, LDS_BYTES) != hipSuccess || per_cu < 1)
            fprintf(stderr, "kernel_launch: note: occupancy query reports %d workgroups per CU\n", per_cu);
        (void)hipGetLastError();
        grid = cus;
        if (grid != 256) { fprintf(stderr, "kernel_launch: built for 256 CUs, device has %d; nothing launched\n", cus); grid = -1; return; }
    }
    if (grid < 0) return;
    if (hipMemsetAsync((char*)d_ws + WS_CTL, 0, CTL_ZERO_BYTES, stream) != hipSuccess) return;
    Args a{};
    for (int i = 0; i < 18; ++i) a.in[i] = (const float*)d_in[i];
    a.out = (float*)d_out; a.ws = (unsigned char*)d_ws;
    hipLaunchKernelGGL(hymba_fwd, dim3(grid), dim3(NWAVES * 64), LDS_BYTES, stream, a);
}
```

```cpp
#include <hip/hip_runtime.h>
#include <cstdio>
#include <cstdint>
#include <cmath>
namespace pg8 {
#define PG8_LAS __attribute__((address_space(3)))
typedef unsigned short bf16_t;
typedef short bf16x8 __attribute__((ext_vector_type(8)));
typedef float f32x4 __attribute__((ext_vector_type(4)));
typedef unsigned u32x4 __attribute__((ext_vector_type(4)));
typedef unsigned u32x2 __attribute__((ext_vector_type(2)));
typedef int v8i __attribute__((ext_vector_type(8)));
typedef int v4i __attribute__((ext_vector_type(4)));
constexpr int BM = 256, BK = 64, HALF = 128, HTB = HALF * BK * 2  , STAGE_BYTES = 8 * HTB, NXCD = 8, WGM = 8;

__host__ __device__ __forceinline__ int lds_byte(int r, int c) { const int st = (r >> 4) * 2 + (c >> 5), rr = r & 15, cc = c & 31, ob = rr * 64 + cc * 2; return st * 1024 + (ob ^ (((ob >> 9) & 1) << 5)); }
__host__ __device__ __forceinline__ void stage_rc(int b, int& R, int& C) { const int st = b / 1024, sb = b % 1024, swz = sb ^ (((sb >> 9) & 1) << 5); R = (st >> 1) * 16 + swz / 64; C = (st & 1) * 32 + (swz % 64) / 2; }
__host__ __device__ __forceinline__ int perm32(int rho) { const int n = rho >> 4, i = rho & 15; return 8 * (i >> 2) + 4 * n + (i & 3); }

struct Unit { int pm, pn, e; };
struct Gemm { const bf16_t* A; const bf16_t* Bt; int M, N, K; size_t bstride; };

struct StaticOrder {
    int nM, nN, nwg, G, c;
    __host__ __device__ void init(int M, int N, int G_, int c_) { nM = M / BM; nN = N / BM; nwg = nM * nN; G = G_; c = c_; }
    __host__ __device__ bool next(int i, Unit& u) const {
        const long L = (long)i * G + c; if (L >= nwg) return false;
        int wgid = (int)L; { const int q = nwg / NXCD, r = nwg % NXCD, xcd = wgid % NXCD, off = wgid / NXCD; wgid = (xcd < r ? xcd * (q + 1) : r * (q + 1) + (xcd - r) * q) + off; }
        const int nig = WGM * nN, gid = wgid / nig, fm = gid * WGM, gsz = (nM - fm) < WGM ? (nM - fm) : WGM;
        u.pm = fm + ((wgid % nig) % gsz); u.pn = (wgid % nig) / gsz; u.e = 0; return true;
    }
    __device__ __forceinline__ void a_ready(const Unit&) const {}
    __device__ __forceinline__ void done(const Unit&) const {}
};
struct GroupedOrder : StaticOrder {
    int cum[8];
    __device__ bool next(int i, Unit& u) const {
        if (!StaticOrder::next(i, u)) return false;
        int e = 0;
#pragma unroll
        for (int j = 1; j < 8; ++j) e += (u.pm >= cum[j]) ? 1 : 0;
        u.e = e; return true;
    }
};

__device__ __forceinline__ unsigned cvt_pk_bf16(float lo, float hi) { unsigned r; asm volatile("v_cvt_pk_bf16_f32 %0, %1, %2" : "=v"(r) : "v"(lo), "v"(hi)); return r; }
__device__ __forceinline__ float sigmoidf_fast(float g) { return __builtin_amdgcn_rcpf(1.0f + __builtin_amdgcn_exp2f(-1.44269504089f * g)); }

__device__ __forceinline__ unsigned pk4_fp8(float a, float b, float c, float d) {
    unsigned w = 0u; w = __builtin_amdgcn_cvt_pk_fp8_f32(__builtin_amdgcn_fmed3f(a, -448.f, 448.f), __builtin_amdgcn_fmed3f(b, -448.f, 448.f), w, false);
    return __builtin_amdgcn_cvt_pk_fp8_f32(__builtin_amdgcn_fmed3f(c, -448.f, 448.f), __builtin_amdgcn_fmed3f(d, -448.f, 448.f), w, true); }
struct EpiF32 {
    static constexpr bool PERM = false, AFTER_DRAIN = false;
    float* C; int ldc;
    __device__ __forceinline__ void operator()(const f32x4 (&acc)[2][2][4][2], const Unit& u, int wr, int wc, int fr, int fq) const {
        const int row0 = u.pm * BM + wr * 64 + fr, col0 = u.pn * BM + wc * 32 + 4 * fq;
#pragma unroll
        for (int ai = 0; ai < 2; ++ai)
#pragma unroll
            for (int m = 0; m < 4; ++m) { float* rowp = C + (size_t)(row0 + ai * HALF + m * 16) * ldc + col0;
#pragma unroll
                for (int bj = 0; bj < 2; ++bj)
#pragma unroll
                    for (int n = 0; n < 2; ++n) *(f32x4*)(rowp + bj * HALF + n * 16) = acc[ai][bj][m][n]; }
    }
};
struct EpiBf16 {
    static constexpr bool PERM = true, AFTER_DRAIN = false;
    bf16_t* O; int ldc; float sc;
    __device__ __forceinline__ void operator()(const f32x4 (&acc)[2][2][4][2], const Unit& u, int wr, int wc, int fr, int fq) const {
        const int row0 = u.pm * BM + wr * 64 + fr, col0 = u.pn * BM + wc * 32 + 8 * fq;
#pragma unroll
        for (int ai = 0; ai < 2; ++ai)
#pragma unroll
            for (int m = 0; m < 4; ++m) { bf16_t* rowp = O + (size_t)(row0 + ai * HALF + m * 16) * ldc + col0;
#pragma unroll
                for (int bj = 0; bj < 2; ++bj) { const f32x4 v0 = acc[ai][bj][m][0] * sc, v1 = acc[ai][bj][m][1] * sc;
                    u32x4 w; w.x = cvt_pk_bf16(v0[0], v0[1]); w.y = cvt_pk_bf16(v0[2], v0[3]); w.z = cvt_pk_bf16(v1[0], v1[1]); w.w = cvt_pk_bf16(v1[2], v1[3]);
                    *(u32x4*)(rowp + bj * HALF) = w; } }
    }
};
struct EpiSwiGLU {
    static constexpr bool PERM = true, AFTER_DRAIN = false;
    bf16_t* O; int ldc;
    __device__ __forceinline__ void operator()(const f32x4 (&acc)[2][2][4][2], const Unit& u, int wr, int wc, int fr, int fq) const {
        const int row0 = u.pm * BM + wr * 64 + fr, col0 = u.pn * HALF + wc * 32 + 8 * fq;
#pragma unroll
        for (int ai = 0; ai < 2; ++ai)
#pragma unroll
            for (int m = 0; m < 4; ++m) { bf16_t* rowp = O + (size_t)(row0 + ai * HALF + m * 16) * ldc + col0;
                float o[8];
#pragma unroll
                for (int n = 0; n < 2; ++n)
#pragma unroll
                    for (int j = 0; j < 4; ++j) { const float g = acc[ai][0][m][n][j], up = acc[ai][1][m][n][j]; o[n * 4 + j] = g * sigmoidf_fast(g) * up; }
                u32x4 w; w.x = cvt_pk_bf16(o[0], o[1]); w.y = cvt_pk_bf16(o[2], o[3]); w.z = cvt_pk_bf16(o[4], o[5]); w.w = cvt_pk_bf16(o[6], o[7]);
                *(u32x4*)rowp = w; }
    }
};
struct EpiSwiGLU8 {
    static constexpr bool PERM = true, AFTER_DRAIN = false;
    unsigned char* O; int ldc; float sin, sout;
    __device__ __forceinline__ void operator()(const f32x4 (&acc)[2][2][4][2], const Unit& u, int wr, int wc, int fr, int fq) const {
        const int row0 = u.pm * BM + wr * 64 + fr, col0 = u.pn * HALF + wc * 32 + 8 * fq;
#pragma unroll
        for (int ai = 0; ai < 2; ++ai)
#pragma unroll
            for (int m = 0; m < 4; ++m) { unsigned char* rowp = O + (size_t)(row0 + ai * HALF + m * 16) * ldc + col0;
                float o[8];
#pragma unroll
                for (int n = 0; n < 2; ++n)
#pragma unroll
                    for (int j = 0; j < 4; ++j) { const float g = acc[ai][0][m][n][j] * sin, up = acc[ai][1][m][n][j] * sin; o[n * 4 + j] = g * sigmoidf_fast(g) * up * sout; }
                u32x2 w; w.x = pk4_fp8(o[0], o[1], o[2], o[3]); w.y = pk4_fp8(o[4], o[5], o[6], o[7]);
                *(u32x2*)rowp = w; }
    }
};
struct EpiInProj {
    static constexpr bool PERM = true, AFTER_DRAIN = false;
    bf16_t *Q, *Kb, *V, *U; const float *ropeC, *ropeS;
    __device__ __forceinline__ void operator()(const f32x4 (&acc)[2][2][4][2], const Unit& u, int wr, int wc, int fr, int fq) const {
        const int row0 = u.pm * BM + wr * 64 + fr;
        if (u.pn < 8) {
            bf16_t* base = (u.pn < 4) ? Q : Kb; const int col0 = (u.pn & 3) * BM + wc * 32 + 8 * fq, idx0 = 16 * wc + 4 * fq;
#pragma unroll
            for (int ai = 0; ai < 2; ++ai)
#pragma unroll
                for (int m = 0; m < 4; ++m) { const int row = row0 + ai * HALF + m * 16;
                    const f32x4 cs = *(const f32x4*)(ropeC + (size_t)row * 64 + idx0), sn = *(const f32x4*)(ropeS + (size_t)row * 64 + idx0);
#pragma unroll
                    for (int bj = 0; bj < 2; ++bj) { const f32x4 x1 = acc[ai][bj][m][0], x2 = acc[ai][bj][m][1];
                        const f32x4 o1 = x1 * cs - x2 * sn, o2 = x2 * cs + x1 * sn;
                        u32x4 w; w.x = cvt_pk_bf16(o1[0], o1[1]); w.y = cvt_pk_bf16(o1[2], o1[3]); w.z = cvt_pk_bf16(o2[0], o2[1]); w.w = cvt_pk_bf16(o2[2], o2[3]);
                        *(u32x4*)(base + (size_t)row * 1024 + col0 + bj * HALF) = w; } }
        } else if (u.pn < 12) {
            const int col0 = (u.pn - 8) * BM + wc * 32 + 8 * fq;
#pragma unroll
            for (int ai = 0; ai < 2; ++ai)
#pragma unroll
                for (int m = 0; m < 4; ++m) { bf16_t* rowp = V + (size_t)(row0 + ai * HALF + m * 16) * 1024 + col0;
#pragma unroll
                    for (int bj = 0; bj < 2; ++bj) { const f32x4 v0 = acc[ai][bj][m][0], v1 = acc[ai][bj][m][1];
                        u32x4 w; w.x = cvt_pk_bf16(v0[0], v0[1]); w.y = cvt_pk_bf16(v0[2], v0[3]); w.z = cvt_pk_bf16(v1[0], v1[1]); w.w = cvt_pk_bf16(v1[2], v1[3]);
                        *(u32x4*)(rowp + bj * HALF) = w; } }
        } else {
            const int col0 = (u.pn - 12) * HALF + wc * 32 + 8 * fq;
#pragma unroll
            for (int ai = 0; ai < 2; ++ai)
#pragma unroll
                for (int m = 0; m < 4; ++m) { bf16_t* rowp = U + (size_t)(row0 + ai * HALF + m * 16) * 1024 + col0;
                    float o[8];
#pragma unroll
                    for (int n = 0; n < 2; ++n)
#pragma unroll
                        for (int j = 0; j < 4; ++j) o[n * 4 + j] = acc[ai][0][m][n][j] * sigmoidf_fast(acc[ai][1][m][n][j]);
                    u32x4 w; w.x = cvt_pk_bf16(o[0], o[1]); w.y = cvt_pk_bf16(o[2], o[3]); w.z = cvt_pk_bf16(o[4], o[5]); w.w = cvt_pk_bf16(o[6], o[7]);
                    *(u32x4*)rowp = w; }
        }
    }
};

template <class Epi, class Sched, bool ALIGN_EPI = false, bool SP2 = false, bool FP8 = false>
__device__ __forceinline__ void gemm_phase(PG8_LAS unsigned char* lds, const Gemm g, const Sched& S, const Epi& E, const int wave_in) {
    int lane; asm volatile("v_mbcnt_lo_u32_b32 %0, -1, 0\n\tv_mbcnt_hi_u32_b32 %0, -1, %0" : "=v"(lane));
    const int wid = wave_in, tid = wid * 64 + lane, wr = wid >> 2, wc = wid & 3, fr = lane & 15, fq = lane >> 4;
    const int K = g.K, nt = K / BK;
    unsigned voffA[2], voffB[2];
#pragma unroll
    for (int i = 0; i < 2; ++i) { int R, C; stage_rc(tid * 16 + i * 8192, R, C); const int Rb = Epi::PERM ? ((R & ~31) + perm32(R & 31)) : R;
        voffA[i] = (unsigned)(R * K + C) * 2u; voffB[i] = (unsigned)(Rb * K + C) * 2u; }
    const size_t kstep = (size_t)(BK * 2);
    const size_t hstep = (size_t)HALF * K * 2;
    const size_t tstep = 2 * hstep;
    const unsigned ldsw = (unsigned)wid * 1024u;
    const int aoff = lds_byte(wr * 64 + fr, fq * 8), boff = lds_byte(wc * 32 + fr, fq * 8);
#define PG8_SA(b, h) (((b) * 2 + (h)) * HTB)
#define PG8_SB(b, h) ((4 + (b) * 2 + (h)) * HTB)
#define PG8_STAGE(bufoff, gbase, voff) do { _Pragma("unroll") for (int _i = 0; _i < 2; ++_i) \
        __builtin_amdgcn_global_load_lds((const unsigned*)((const char*)(gbase) + (voff)[_i]), (PG8_LAS unsigned*)(lds + (bufoff) + ldsw + _i * 8192), 16, 0, 0); } while (0)
#define PG8_LDA(dst, b, h) do { if constexpr (FP8) { _Pragma("unroll") for (int m = 0; m < 4; ++m) { const v4i lo_ = *(const PG8_LAS v4i*)(lds + PG8_SA(b, h) + aoff + m * 2048), hi_ = *(const PG8_LAS v4i*)(lds + PG8_SA(b, h) + aoff + m * 2048 + 1024); \
            dst##8[m] = __builtin_shufflevector(lo_, hi_, 0, 1, 2, 3, 4, 5, 6, 7); } } \
        else { _Pragma("unroll") for (int m = 0; m < 4; ++m) _Pragma("unroll") for (int k = 0; k < 2; ++k) dst[m][k] = *(const PG8_LAS bf16x8*)(lds + PG8_SA(b, h) + aoff + m * 2048 + k * 1024); } } while (0)
#define PG8_LDB(dst, b, h) do { if constexpr (FP8) { _Pragma("unroll") for (int n = 0; n < 2; ++n) { const v4i lo_ = *(const PG8_LAS v4i*)(lds + PG8_SB(b, h) + boff + n * 2048), hi_ = *(const PG8_LAS v4i*)(lds + PG8_SB(b, h) + boff + n * 2048 + 1024); \
            dst##8[n] = __builtin_shufflevector(lo_, hi_, 0, 1, 2, 3, 4, 5, 6, 7); } } \
        else { _Pragma("unroll") for (int n = 0; n < 2; ++n) _Pragma("unroll") for (int k = 0; k < 2; ++k) dst[n][k] = *(const PG8_LAS bf16x8*)(lds + PG8_SB(b, h) + boff + n * 2048 + k * 1024); } } while (0)
#define PG8_MMA(ai, bj, At, Bt) do { __builtin_amdgcn_s_setprio(1); \
        if constexpr (FP8) {   \
            _Pragma("unroll") for (int m = 0; m < 4; ++m) _Pragma("unroll") for (int n = 0; n < 2; ++n) \
                asm volatile("v_mfma_f32_16x16x128_f8f6f4 %0, %1, %2, %0" : "+v"(acc[ai][bj][m][n]) : "v"(Bt##8[n]), "v"(At##8[m]));   \
        } else { _Pragma("unroll") for (int m = 0; m < 4; ++m) _Pragma("unroll") for (int n = 0; n < 2; ++n) _Pragma("unroll") for (int k = 0; k < 2; ++k) \
            acc[ai][bj][m][n] = __builtin_amdgcn_mfma_f32_16x16x32_bf16(Bt[n][k], At[m][k], acc[ai][bj][m][n], 0, 0, 0); } \
        __builtin_amdgcn_s_setprio(0); } while (0)
#define PG8_WAIT_V(n) asm volatile("s_waitcnt vmcnt(" #n ")" ::: "memory")
#define PG8_WAIT_L(n) asm volatile("s_waitcnt lgkmcnt(" #n ")" ::: "memory")
#define PG8_BAR __builtin_amdgcn_s_barrier()
#define PG8_SCHED __builtin_amdgcn_sched_barrier(0)
    Unit cur, nxt; int ui = 0;
    if (!S.next(0, cur)) return;
    f32x4 acc[2][2][4][2];
#pragma unroll
    for (int a = 0; a < 2; ++a)
#pragma unroll
        for (int b = 0; b < 2; ++b)
#pragma unroll
            for (int m = 0; m < 4; ++m)
#pragma unroll
                for (int n = 0; n < 2; ++n) acc[a][b][m][n] = (f32x4){0.f, 0.f, 0.f, 0.f};
    bf16x8 At[4][2], B0[2][2], B1[2][2]; v8i At8[4], B08[2], B18[2];
    const char* cA = (const char*)g.A + (size_t)cur.pm * tstep; const char* cB = (const char*)g.Bt + (size_t)cur.e * g.bstride + (size_t)cur.pn * tstep;
    S.a_ready(cur);
    if constexpr (SP2) {
        PG8_STAGE(PG8_SB(0, 0), cB, voffB); PG8_STAGE(PG8_SB(0, 1), cB + hstep, voffB); PG8_STAGE(PG8_SA(0, 0), cA, voffA); PG8_STAGE(PG8_SA(0, 1), cA + hstep, voffA);
        if (wr == 1) PG8_BAR;
        PG8_WAIT_V(2); PG8_BAR;
        PG8_STAGE(PG8_SB(1, 0), cB + kstep, voffB); PG8_STAGE(PG8_SA(1, 0), cA + kstep, voffA); PG8_STAGE(PG8_SB(1, 1), cB + hstep + kstep, voffB);
        PG8_WAIT_V(6); PG8_BAR;
    } else {
        PG8_STAGE(PG8_SB(0, 0), cB, voffB); PG8_STAGE(PG8_SA(0, 0), cA, voffA); PG8_STAGE(PG8_SB(0, 1), cB + hstep, voffB); PG8_STAGE(PG8_SA(0, 1), cA + hstep, voffA);
        if (wr == 1) PG8_BAR;
        PG8_WAIT_V(4); PG8_BAR;
        PG8_STAGE(PG8_SB(1, 0), cB + kstep, voffB); PG8_STAGE(PG8_SA(1, 0), cA + kstep, voffA); PG8_STAGE(PG8_SB(1, 1), cB + hstep + kstep, voffB);
        PG8_WAIT_V(6); PG8_BAR;
    }
    for (;;) {
        const bool has_next = S.next(ui + 1, nxt);
        const char* nA = has_next ? (const char*)g.A + (size_t)nxt.pm * tstep : cA; const char* nB = has_next ? (const char*)g.Bt + (size_t)nxt.e * g.bstride + (size_t)nxt.pn * tstep : cB;
        for (int t = 0; t < nt; t += 2) {
            const bool last = (t == nt - 2);
            const char* a1 = cA + (size_t)(t + 1) * kstep;
            const char* a2 = last ? nA : cA + (size_t)(t + 2) * kstep; const char* b2 = last ? nB : cB + (size_t)(t + 2) * kstep;
            const char* a3 = a2 + kstep; const char* b3 = b2 + kstep;
            if (last && has_next) S.a_ready(nxt);
            if constexpr (SP2) {
            PG8_LDB(B0, 0, 0); PG8_LDB(B1, 0, 1); PG8_SCHED; PG8_LDA(At, 0, 0); PG8_STAGE(PG8_SA(1, 1), a1 + hstep, voffA);
            PG8_WAIT_V(8); PG8_WAIT_L(0); PG8_BAR; PG8_MMA(0, 0, At, B0); PG8_MMA(0, 1, At, B1); PG8_BAR; PG8_SCHED;
            PG8_LDA(At, 0, 1); PG8_STAGE(PG8_SB(0, 0), b2, voffB); PG8_STAGE(PG8_SB(0, 1), b2 + hstep, voffB); PG8_STAGE(PG8_SA(0, 0), a2, voffA);
            PG8_WAIT_V(8); PG8_WAIT_L(0); PG8_BAR; PG8_MMA(1, 0, At, B0); PG8_MMA(1, 1, At, B1); PG8_BAR; PG8_SCHED;
            PG8_LDB(B0, 1, 0); PG8_LDB(B1, 1, 1); PG8_SCHED; PG8_LDA(At, 1, 0); PG8_STAGE(PG8_SA(0, 1), a2 + hstep, voffA);
            PG8_WAIT_V(8); PG8_WAIT_L(0); PG8_BAR; PG8_MMA(0, 0, At, B0); PG8_MMA(0, 1, At, B1); PG8_BAR; PG8_SCHED;
            PG8_LDA(At, 1, 1); PG8_STAGE(PG8_SB(1, 0), b3, voffB); PG8_STAGE(PG8_SB(1, 1), b3 + hstep, voffB); PG8_STAGE(PG8_SA(1, 0), a3, voffA);
            PG8_WAIT_V(8); PG8_WAIT_L(0); PG8_BAR; PG8_MMA(1, 0, At, B0); PG8_MMA(1, 1, At, B1); PG8_BAR; PG8_SCHED;
            } else {
            PG8_LDB(B0, 0, 0); PG8_SCHED; PG8_LDA(At, 0, 0); PG8_STAGE(PG8_SA(1, 1), a1 + hstep, voffA);
            PG8_WAIT_L(8); PG8_BAR; PG8_WAIT_L(0); PG8_MMA(0, 0, At, B0); PG8_BAR; PG8_SCHED;
            PG8_LDB(B1, 0, 1); PG8_STAGE(PG8_SB(0, 0), b2, voffB);
            PG8_BAR; PG8_WAIT_L(0); PG8_MMA(0, 1, At, B1); PG8_BAR;
            PG8_LDA(At, 0, 1); PG8_STAGE(PG8_SA(0, 0), a2, voffA);
            PG8_BAR; PG8_WAIT_L(0); PG8_MMA(1, 0, At, B0); PG8_BAR; PG8_SCHED;
            PG8_STAGE(PG8_SB(0, 1), b2 + hstep, voffB);
            PG8_WAIT_V(6); PG8_BAR; PG8_MMA(1, 1, At, B1); PG8_BAR;
            PG8_LDB(B0, 1, 0); PG8_SCHED; PG8_LDA(At, 1, 0); PG8_STAGE(PG8_SA(0, 1), a2 + hstep, voffA);
            PG8_WAIT_L(8); PG8_BAR; PG8_WAIT_L(0); PG8_MMA(0, 0, At, B0); PG8_BAR; PG8_SCHED;
            PG8_LDB(B1, 1, 1); PG8_STAGE(PG8_SB(1, 0), b3, voffB);
            PG8_BAR; PG8_WAIT_L(0); PG8_MMA(0, 1, At, B1); PG8_BAR;
            PG8_LDA(At, 1, 1); PG8_STAGE(PG8_SA(1, 0), a3, voffA);
            PG8_BAR; PG8_WAIT_L(0); PG8_MMA(1, 0, At, B0); PG8_BAR; PG8_SCHED;
            PG8_STAGE(PG8_SB(1, 1), b3 + hstep, voffB);
            PG8_WAIT_V(6); PG8_BAR; PG8_MMA(1, 1, At, B1); PG8_BAR;
            }
        }
        if constexpr (FP8) asm volatile("s_nop 15\n\ts_nop 15" ::: "memory");
        if constexpr (ALIGN_EPI) { if (wr == 0) PG8_BAR; }
        if constexpr (!Epi::AFTER_DRAIN) { E(acc, cur, wr, wc, fr, fq); S.done(cur); }
        if (!has_next) break;
#pragma unroll
        for (int a = 0; a < 2; ++a)
#pragma unroll
            for (int b = 0; b < 2; ++b)
#pragma unroll
                for (int m = 0; m < 4; ++m)
#pragma unroll
                    for (int n = 0; n < 2; ++n) acc[a][b][m][n] = (f32x4){0.f, 0.f, 0.f, 0.f};
        cur = nxt; cA = nA; cB = nB; ++ui;
        if constexpr (ALIGN_EPI) { if (wr == 1) PG8_BAR; }
    }
    PG8_WAIT_V(0);
    if constexpr (!ALIGN_EPI) { if (wr == 0) PG8_BAR; }
    PG8_BAR;
    if constexpr (Epi::AFTER_DRAIN) { E.fused(acc, cur, wr, wc, fr, fq, lds, wid, lane); S.done(cur); }
#undef PG8_SA
#undef PG8_SB
#undef PG8_STAGE
#undef PG8_LDA
#undef PG8_LDB
#undef PG8_MMA
#undef PG8_WAIT_V
#undef PG8_WAIT_L
#undef PG8_BAR
#undef PG8_SCHED
}
}

constexpr int NWAVES = 8;
constexpr int S = 16384, DM = 2048, NPROJ = 5120, AW = 1024, HD = 128, NH = 8, DFF = 5632, NE = 8, CKW = 31, NBLK = 64;
constexpr float LN_EPS = 1e-5f, ALPHA = 1.41421356237309515f;
constexpr int MOE_ROWS = 2 * S + NE * 256;
constexpr float WSC_GU = 32.f, WSC_D = 128.f, ASC_H = 4.f, ASC_ACT = 8.f;

constexpr size_t MiB = 1u << 20;
constexpr size_t WS_CTL = 0, CTL_ZERO_BYTES = 1 * MiB;
constexpr size_t WS_ROPEC = 1 * MiB, WS_ROPES = 5 * MiB;
constexpr size_t WS_KMEAN = 9 * MiB;
constexpr size_t WS_EIDX = 9 * MiB + 512 * 1024, WS_GATEW = WS_EIDX + 128 * 1024, WS_ROWPOS = WS_GATEW + 128 * 1024;
constexpr size_t WS_WIN = 10 * MiB, WS_WOUT = 50 * MiB, WS_WGU0 = 66 * MiB, WS_WD0 = 110 * MiB, WS_WGUE = 132 * MiB, WS_WDE = 484 * MiB;
constexpr size_t WS_HB = 660 * MiB;
constexpr size_t WS_R2 = 724 * MiB;
constexpr size_t WS_HB8 = 860 * MiB + 72 * MiB;
constexpr size_t WS_HBP = 860 * MiB;
constexpr size_t WS_R1 = 996 * MiB;
constexpr size_t WS_Q = WS_R1, WS_K = WS_R1 + 32 * MiB, WS_V = WS_R1 + 64 * MiB, WS_U = WS_R1 + 96 * MiB, WS_CAT = WS_R1 + 128 * MiB, WS_ACT = WS_R1;
constexpr size_t WS_VT = WS_R1 + 192 * MiB, WS_PO = WS_R1 + 224 * MiB, WS_PML = WS_R1 + 320 * MiB, WS_LIST = WS_R1 + 324 * MiB;
constexpr size_t WS_END = 1370 * MiB;
static_assert(WS_R1 + (size_t)MOE_ROWS * DFF * 2 <= WS_END && WS_HBP + (size_t)MOE_ROWS * DM * 2 <= WS_R1 && WS_R2 + (size_t)MOE_ROWS * DM * 2 <= WS_HBP, "d_ws map");
static_assert(WS_WDE + (size_t)NE * DM * DFF * 2 <= WS_HB && WS_WGUE + (size_t)NE * 2 * DFF * DM * 2 <= WS_WDE, "d_ws weights map");
constexpr int CW_TMO = 0, CW_CODE = 1, CW_BAR = 4096, CW_ECNT = 8192, CW_ECUR = 8192 + 64 * 8, CW_LCNT = 12288;
constexpr int RING_OFF = 0, RING_BYTES = 131072;
constexpr int LDSCTL_OFF = 139264, MISC_OFF = LDSCTL_OFF + 320;
constexpr int LDS_BYTES = 147456;

__device__ const float INV_FREQ[64] = {
1.000000000e+00f, 8.659643531e-01f, 7.498942018e-01f, 6.493816376e-01f, 5.623413324e-01f, 4.869675338e-01f, 4.216965139e-01f, 3.651741147e-01f, 3.162277639e-01f, 2.738419771e-01f, 2.371373773e-01f, 2.053525001e-01f, 1.778279394e-01f, 1.539926529e-01f, 1.333521456e-01f, 1.154781953e-01f, 1.000000015e-01f, 8.659642935e-02f, 7.498942316e-02f, 6.493816525e-02f, 5.623413250e-02f, 4.869675264e-02f, 4.216964915e-02f, 3.651741147e-02f, 3.162277490e-02f, 2.738419548e-02f, 2.371373773e-02f, 2.053525113e-02f, 1.778279431e-02f, 1.539926510e-02f, 1.333521400e-02f, 1.154781971e-02f, 9.999999776e-03f, 8.659643121e-03f, 7.498942316e-03f, 6.493816152e-03f, 5.623413250e-03f, 4.869675264e-03f, 4.216964822e-03f, 3.651741194e-03f, 3.162277630e-03f, 2.738419687e-03f, 2.371373819e-03f, 2.053525066e-03f, 1.778279431e-03f, 1.539926510e-03f, 1.333521446e-03f, 1.154782018e-03f, 1.000000047e-03f, 8.659643354e-04f, 7.498941850e-04f, 6.493816036e-04f, 5.623413017e-04f, 4.869675322e-04f, 4.216965172e-04f, 3.651741135e-04f, 3.162277571e-04f, 2.738419571e-04f, 2.371373703e-04f, 2.053525095e-04f, 1.778279402e-04f, 1.539926598e-04f, 1.333521504e-04f, 1.154782003e-04f
};

#define GAS __attribute__((address_space(1)))
#define LAS __attribute__((address_space(3)))
typedef unsigned short bf16;
typedef unsigned v4u __attribute__((ext_vector_type(4)));
typedef unsigned v2u __attribute__((ext_vector_type(2)));
typedef float f32x4 __attribute__((ext_vector_type(4)));
typedef float f32x2 __attribute__((ext_vector_type(2)));
typedef short bf16x8 __attribute__((ext_vector_type(8)));
typedef GAS unsigned gu32;
typedef GAS unsigned long long gu64;
#define RLX_AGENT __ATOMIC_RELAXED, __HIP_MEMORY_SCOPE_AGENT
#define LDS_WAIT() asm volatile("s_waitcnt lgkmcnt(0)" ::: "memory")
#define VM_WAIT() asm volatile("s_waitcnt vmcnt(0)" ::: "memory")
__device__ __forceinline__ unsigned f2bf(float f) { unsigned u = __builtin_bit_cast(unsigned, f); return (u + 0x7fffu + ((u >> 16) & 1u)) >> 16; }
__device__ __forceinline__ unsigned pk2(float lo, float hi) { return f2bf(lo) | (f2bf(hi) << 16); }
__device__ __forceinline__ float bflo(unsigned w) { return __builtin_bit_cast(float, w << 16); }
__device__ __forceinline__ float bfhi(unsigned w) { return __builtin_bit_cast(float, w & 0xffff0000u); }

#define XB_TMO      128
#define XB_XCNT(j)  (256  + 64 * (j))
#define XB_XSUB(j)  (1280 + 64 * (j))
#define XB_XGEN(j)  (2304 + 64 * (j))
#define XB_TOP      3328
#define XB_TOPGEN   3392
#define XCD_BAR_WORDS 3456
#define XB_SPIN_CAP (1u << 22)

__device__ __forceinline__ unsigned xb_ld(unsigned* p)              { return __hip_atomic_load(p, __ATOMIC_RELAXED, __HIP_MEMORY_SCOPE_AGENT); }
__device__ __forceinline__ unsigned xb_add(unsigned* p, unsigned v) { return __hip_atomic_fetch_add(p, v, __ATOMIC_RELAXED, __HIP_MEMORY_SCOPE_AGENT); }
__device__ __forceinline__ unsigned xb_xcc_id() { return (unsigned)__builtin_amdgcn_s_getreg((3 << 11) | 20) & 0xFu; }
#define XB_SPIN(cond, bar) do { unsigned _sp = 0; while (cond) { __builtin_amdgcn_s_sleep(1); \
    if ((++_sp & 255u) == 0u) { if (xb_ld(&(bar)[XB_TMO])) break; if (_sp > XB_SPIN_CAP) { atomicAdd(&(bar)[XB_TMO], 1u); break; } } } } while (0)

__device__ __forceinline__ int lane_now() { int l; asm volatile("v_mbcnt_lo_u32_b32 %0, -1, 0\n\tv_mbcnt_hi_u32_b32 %0, -1, %0" : "=v"(l)); return l; }
#define XB_T0() (b.w0 == 0 && lane_now() == 0)
struct XcdBarrier {
    unsigned* bar; unsigned x; int w0;
    volatile LAS unsigned* st;
};

__device__ __forceinline__ XcdBarrier xcd_barrier_post(unsigned* bar, volatile LAS unsigned* st, int w0) {
    XcdBarrier b; b.bar = bar; b.x = xb_xcc_id(); b.st = st; b.w0 = w0;
    if (XB_T0()) (void)xb_add(&bar[XB_XCNT(b.x)], 1u);
    return b;
}
__device__ __forceinline__ void xcd_barrier_complete(unsigned* bar, unsigned x, unsigned& nloc, unsigned& nx) {
    const unsigned G = gridDim.x * gridDim.y * gridDim.z;
    unsigned sum, cnt, mine, sp = 0u;
    for (;;) {
        sum = 0u; cnt = 0u; mine = 0u;
#pragma unroll
        for (unsigned j = 0; j < 16; ++j) { const unsigned c = xb_ld(&bar[XB_XCNT(j)]); sum += c; cnt += (c > 0u) ? 1u : 0u; mine = (j == x) ? c : mine; }
        if (sum == G) break;
        __builtin_amdgcn_s_sleep(1);
        if ((++sp & 255u) == 0u) { if (xb_ld(&bar[XB_TMO])) break; if (sp > XB_SPIN_CAP) { atomicAdd(&bar[XB_TMO], 1u); break; } }
    }
    nloc = mine > 0u ? mine : 1u; nx = cnt > 0u ? cnt : 1u;
}

__device__ __forceinline__ void xcd_barrier(const XcdBarrier& b) {
    asm volatile("s_waitcnt vmcnt(0)" ::: "memory");
    __syncthreads();
    if (XB_T0()) {
        unsigned* bar = b.bar;
        __builtin_amdgcn_s_waitcnt(0);
        unsigned nloc = b.st[0], nx = b.st[1];
        if (nloc == 0u) { xcd_barrier_complete(bar, b.x, nloc, nx); b.st[0] = nloc; b.st[1] = nx; }
        const unsigned old = xb_add(&bar[XB_XSUB(b.x)], 1u);
        const unsigned gen = old / nloc;
        if (old + 1u == (gen + 1u) * nloc) {
            __builtin_amdgcn_fence(__ATOMIC_RELEASE, "agent");
            asm volatile("s_waitcnt vmcnt(0)" ::: "memory");
            const unsigned og = xb_add(&bar[XB_TOP], 1u);
            const unsigned tg = og / nx;
            if (og + 1u == (tg + 1u) * nx) xb_add(&bar[XB_TOPGEN], 1u);
            else XB_SPIN(xb_ld(&bar[XB_TOPGEN]) == tg, bar);
            __builtin_amdgcn_fence(__ATOMIC_ACQUIRE, "agent");
            xb_add(&bar[XB_XGEN(b.x)], 1u);
            asm volatile("s_waitcnt vmcnt(0)" ::: "memory");
        } else {
            XB_SPIN(xb_ld(&bar[XB_XGEN(b.x)]) == gen, bar);
            __builtin_amdgcn_fence(__ATOMIC_ACQUIRE, "agent");
            asm volatile("s_waitcnt vmcnt(0)" ::: "memory");
        }
    }
    __syncthreads();
}


struct Frame {
    LAS unsigned char* lds;
    volatile LAS unsigned* MISC;
    gu32* ctl;
    int wave;
    int vcu, G;
    const float* x; float* out;
    const float *w_in, *conv_w, *conv_b, *conv_g, *conv_be, *w_out, *lnm_g, *lnm_b, *lnf_g, *lnf_b, *fg, *fu, *fd, *router, *eg, *eu, *ed;
    unsigned char* ws;
};
__device__ __forceinline__ int shx_i(int v, int m, int lane) { return __builtin_amdgcn_ds_bpermute((lane ^ m) << 2, v); }
__device__ __forceinline__ float shx(float v, int m, int lane) { return __builtin_bit_cast(float, __builtin_amdgcn_ds_bpermute((lane ^ m) << 2, __builtin_bit_cast(int, v))); }
__device__ __forceinline__ int shl_i(int v, int src) { return __builtin_amdgcn_ds_bpermute(src << 2, v); }
__device__ __forceinline__ float wave_sum(float v, int lane) {
#pragma unroll
    for (int o = 1; o < 64; o <<= 1) v += shx(v, o, lane);
    return v;
}
__device__ __forceinline__ int wmap(int kind, int c) {
    if (kind == 0) return c;
    if (kind == 1) {
        if (c < 2048) { const int hh = c >> 7, w = c & 127, n = w >> 6, idx = w & 63; return hh * 128 + 32 * (idx >> 4) + 8 * ((idx >> 2) & 3) + 4 * n + (idx & 3); }
        if (c < 3072) return c;
        if (c < 4096) { const int j = c - 3072; return 3072 + 256 * (j >> 7) + (j & 127); }
        const int j = c - 4096; return 3072 + 256 * (j >> 7) + 128 + (j & 127);
    }
    return 256 * (c >> 7) + (kind == 3 ? 128 : 0) + (c & 127);
}
__device__ __forceinline__ void p0_transpose_item(const float* Wg, int K, int N, bf16* WT, int kind, LAS float* scr, int item, int lane) {
    const GAS float* W = (const GAS float*)Wg;
    const int nblk = N / 32, kb = item / nblk, nb = item % nblk, k0 = 64 * kb, n0 = 32 * nb;
    float wv[32];
#pragma unroll
    for (int i = 0; i < 32; ++i) wv[i] = W[(size_t)(k0 + 2 * i + (lane >> 5)) * N + n0 + (lane & 31)];
#pragma unroll
    for (int i = 0; i < 32; ++i) scr[(2 * i + (lane >> 5)) * 33 + (lane & 31)] = wv[i];
    LDS_WAIT(); asm volatile("" ::: "memory");
    const int c = lane & 7;
#pragma unroll
    for (int j = 0; j < 4; ++j) { const int n = (lane >> 3) + 8 * j; const LAS float* s = scr + (8 * c) * 33 + n;
        v4u o; o.x = pk2(s[0 * 33], s[1 * 33]); o.y = pk2(s[2 * 33], s[3 * 33]); o.z = pk2(s[4 * 33], s[5 * 33]); o.w = pk2(s[6 * 33], s[7 * 33]);
        *(GAS v4u*)(WT + (size_t)wmap(kind, n0 + n) * K + k0 + 8 * c) = o; }
    LDS_WAIT(); asm volatile("" ::: "memory");
}
__device__ __forceinline__ void sincos_acc(float ang, float& sn, float& cs) {
    const double x = (double)ang, k = __builtin_rint(x * 0.63661977236758134308);
    double r = __builtin_fma(-k, 1.57079632679489655800e+00, x); r = __builtin_fma(-k, 6.12323399573676603587e-17, r);
    const int q = ((int)k) & 3; const double r2 = r * r;
    double sp = 1.0 / 6227020800.0; sp = sp * r2 - 1.0 / 39916800.0; sp = sp * r2 + 1.0 / 362880.0; sp = sp * r2 - 1.0 / 5040.0; sp = sp * r2 + 1.0 / 120.0; sp = sp * r2 - 1.0 / 6.0;
    const double s = r + r * r2 * sp;
    double cp = -1.0 / 87178291200.0; cp = cp * r2 + 1.0 / 479001600.0; cp = cp * r2 - 1.0 / 3628800.0; cp = cp * r2 + 1.0 / 40320.0; cp = cp * r2 - 1.0 / 720.0; cp = cp * r2 + 1.0 / 24.0; cp = cp * r2 - 0.5;
    const double c = 1.0 + r2 * cp;
    const double ss = (q & 1) ? c : s, cc = (q & 1) ? s : c;
    sn = (float)((q & 2) ? -ss : ss); cs = (float)(((q + 1) & 2) ? -cc : cc);
}
__device__ __forceinline__ void p0_transpose_item8(const float* Wg, int K, int N, unsigned char* WT, int kind, float wscale, LAS float* scr, int item, int lane) {
    const GAS float* W = (const GAS float*)Wg;
    const int nblk = N / 32, kb = item / nblk, nb = item % nblk, k0 = 64 * kb, n0 = 32 * nb;
    float wv[32];
#pragma unroll
    for (int i = 0; i < 32; ++i) wv[i] = W[(size_t)(k0 + 2 * i + (lane >> 5)) * N + n0 + (lane & 31)];
#pragma unroll
    for (int i = 0; i < 32; ++i) scr[(2 * i + (lane >> 5)) * 33 + (lane & 31)] = wv[i] * wscale;
    LDS_WAIT(); asm volatile("" ::: "memory");
    const int c = lane & 7;
#pragma unroll
    for (int j = 0; j < 4; ++j) { const int n = (lane >> 3) + 8 * j; const LAS float* sp = scr + (8 * c) * 33 + n;
        v2u o; o.x = pg8::pk4_fp8(sp[0 * 33], sp[1 * 33], sp[2 * 33], sp[3 * 33]); o.y = pg8::pk4_fp8(sp[4 * 33], sp[5 * 33], sp[6 * 33], sp[7 * 33]);
        *(GAS v2u*)(WT + (size_t)wmap(kind, n0 + n) * K + k0 + 8 * c) = o; }
    LDS_WAIT(); asm volatile("" ::: "memory");
}
__device__ __forceinline__ void p0_transpose_stack8(Frame& F, const float* src, int K, int N, int nmat, unsigned char* dst, size_t dst_stride, int kind, float wscale) {
    LAS float* scr = (LAS float*)(F.lds + RING_OFF + F.wave * 16384);
    const int gw = F.vcu * NWAVES + F.wave, NGW = F.G * NWAVES, per = (K / 64) * (N / 32), total = per * nmat, lane = lane_now();
#pragma clang loop unroll(disable)
    for (int it = gw; it < total; it += NGW) { const int m = it / per, r = it - m * per;
        p0_transpose_item8(src + (size_t)m * K * N, K, N, dst + (size_t)m * dst_stride, kind, wscale, scr, r, lane); }
}
__device__ __forceinline__ void p0_stack(Frame& F, const float* src, int K, int N, int nmat, unsigned char* dst, size_t dst_stride_bytes, int kind, bool fp8, float wscale) {
    LAS float* t = (LAS float*)(F.lds + RING_OFF);
    const int tid = F.wave * 64 + lane_now(), ntn = N / 256, per = (K / 128) * ntn, total = per * nmat;
    f32x4 raw[16];
    int it = blockIdx.x;
    if (it < total) { const int m = it / per, r = it - m * per, k0 = (r / ntn) * 128, n0 = (r % ntn) * 256; const GAS f32x4* W = (const GAS f32x4*)(src + (size_t)m * K * N + (size_t)k0 * N + n0);
#pragma unroll
        for (int i = 0; i < 16; ++i) { const int p = tid + 512 * i; raw[i] = W[(size_t)(p >> 6) * (N / 4) + (p & 63)]; } }
#pragma clang loop unroll(disable)
    for (; it < total; it += F.G) { const int m = it / per, r = it - m * per, k0 = (r / ntn) * 128, n0 = (r % ntn) * 256;
        const int tid2 = F.wave * 64 + lane_now();
#pragma unroll
        for (int i = 0; i < 16; ++i) { const int p = tid2 + 512 * i; LAS float* d = t + (p >> 6) * 257 + (p & 63) * 4; d[0] = raw[i][0] * wscale; d[1] = raw[i][1] * wscale; d[2] = raw[i][2] * wscale; d[3] = raw[i][3] * wscale; }
        __syncthreads();
        { const int nx = it + F.G; if (nx < total) { const int m2 = nx / per, r2 = nx - m2 * per, k2 = (r2 / ntn) * 128, n2 = (r2 % ntn) * 256; const GAS f32x4* W = (const GAS f32x4*)(src + (size_t)m2 * K * N + (size_t)k2 * N + n2);
#pragma unroll
            for (int i = 0; i < 16; ++i) { const int p = tid2 + 512 * i; raw[i] = W[(size_t)(p >> 6) * (N / 4) + (p & 63)]; } } }
        unsigned char* drow = dst + (size_t)m * dst_stride_bytes;
#pragma unroll
        for (int q = 0; q < 8; ++q) { const int cid = tid2 + 512 * q, nrow = cid >> 4, kc = cid & 15; const LAS float* sp = t + (8 * kc) * 257 + nrow;
            const float e0 = sp[0], e1 = sp[257], e2 = sp[2 * 257], e3 = sp[3 * 257], e4 = sp[4 * 257], e5 = sp[5 * 257], e6 = sp[6 * 257], e7 = sp[7 * 257];
            const size_t drw = (size_t)wmap(kind, n0 + nrow) * K + k0 + 8 * kc;
            if (fp8) { v2u o; o.x = pg8::pk4_fp8(e0, e1, e2, e3); o.y = pg8::pk4_fp8(e4, e5, e6, e7); *(GAS v2u*)(drow + drw) = o; }
            else { v4u o; o.x = pk2(e0, e1); o.y = pk2(e2, e3); o.z = pk2(e4, e5); o.w = pk2(e6, e7); *(GAS v4u*)(drow + drw * 2) = o; } }
        __syncthreads();
    }
}
__device__ __forceinline__ void p0_prologue(Frame& F) {
    p0_stack(F, F.w_in, DM, NPROJ, 2, F.ws + WS_WIN, (size_t)NPROJ * DM * 2, 1, false, 1.f);
    p0_stack(F, F.w_out, DM, DM, 2, F.ws + WS_WOUT, (size_t)DM * DM * 2, 0, false, 1.f);
    p0_stack(F, F.fg, DM, DFF, 1, F.ws + WS_WGU0, 0, 2, false, 1.f);
    p0_stack(F, F.fu, DM, DFF, 1, F.ws + WS_WGU0, 0, 3, false, 1.f);
    p0_stack(F, F.fd, DFF, DM, 1, F.ws + WS_WD0, 0, 0, false, 1.f);
    p0_stack(F, F.eg, DM, DFF, NE, F.ws + WS_WGUE, (size_t)2 * DFF * DM, 2, true, WSC_GU);
    p0_stack(F, F.eu, DM, DFF, NE, F.ws + WS_WGUE, (size_t)2 * DFF * DM, 3, true, WSC_GU);
    p0_stack(F, F.ed, DFF, DM, NE, F.ws + WS_WDE, (size_t)DM * DFF, 0, true, WSC_D);
    { GAS float* rc = (GAS float*)(F.ws + WS_ROPEC); GAS float* rs = (GAS float*)(F.ws + WS_ROPES);
#pragma clang loop unroll(disable)
      for (int i = (F.vcu * NWAVES + F.wave) * 64 + lane_now(); i < S * 64; i += F.G * NWAVES * 64) { const int t = i >> 6, f = i & 63; const float ang = (float)t * INV_FREQ[f]; float sn, cs; sincos_acc(ang, sn, cs); rc[i] = cs; rs[i] = sn; } }
    { const GAS f32x4* xs = (const GAS f32x4*)F.x; GAS v4u* hb = (GAS v4u*)(F.ws + WS_HB);
#pragma clang loop unroll(disable)
      for (int i = (F.vcu * NWAVES + F.wave) * 64 + lane_now(); i < S * DM / 8; i += F.G * NWAVES * 64) { const f32x4 a = xs[2 * i], b = xs[2 * i + 1]; v4u o; o.x = pk2(a[0], a[1]); o.y = pk2(a[2], a[3]); o.z = pk2(b[0], b[1]); o.w = pk2(b[2], b[3]); hb[i] = o; } }
}

__device__ __forceinline__ void kmean_phase(Frame& F) {
    const int lane = lane_now(), c8 = lane & 15, rg = lane >> 4;
    const int unit = F.wave * F.G + (int)blockIdx.x;
    if (unit < NH * NBLK) { const int j = unit & 63, h = unit >> 6;
        const GAS v4u* kp = (const GAS v4u*)(F.ws + WS_K) + ((size_t)(j * 256 + rg) * 1024 + h * 128) / 8 + c8;
        float a[8];
#pragma unroll
        for (int i = 0; i < 8; ++i) a[i] = 0.f;
#pragma unroll 16
        for (int it = 0; it < 64; ++it) { const v4u w = kp[(size_t)it * 4 * 128];
            a[0] += bflo(w.x); a[1] += bfhi(w.x); a[2] += bflo(w.y); a[3] += bfhi(w.y); a[4] += bflo(w.z); a[5] += bfhi(w.z); a[6] += bflo(w.w); a[7] += bfhi(w.w); }
#pragma unroll
        for (int i = 0; i < 8; ++i) { a[i] += shx(a[i], 16, lane); a[i] += shx(a[i], 32, lane); a[i] *= (1.f / 256.f); }
        if (rg == 0) { v4u hi, lo;
            hi.x = pk2(a[0], a[1]); hi.y = pk2(a[2], a[3]); hi.z = pk2(a[4], a[5]); hi.w = pk2(a[6], a[7]);
            lo.x = pk2(a[0] - bflo(hi.x), a[1] - bfhi(hi.x)); lo.y = pk2(a[2] - bflo(hi.y), a[3] - bfhi(hi.y)); lo.z = pk2(a[4] - bflo(hi.z), a[5] - bfhi(hi.z)); lo.w = pk2(a[6] - bflo(hi.w), a[7] - bfhi(hi.w));
            GAS v4u* kh = (GAS v4u*)(F.ws + WS_KMEAN) + ((size_t)(h * 64 + j) * 128) / 8 + c8;
            kh[0] = hi; kh[NH * NBLK * HD / 8] = lo; } }
}
__device__ __forceinline__ void vt_phase(Frame& F) {
    const int gw = F.vcu * NWAVES + F.wave, NGW = F.G * NWAVES, lane = lane_now();
    LAS unsigned char* tile = F.lds + RING_OFF + F.wave * 8704;
    constexpr int NU = (S / 32) * NH;
    v4u raw[2][8];
#pragma unroll
    for (int k = 0; k < 2; ++k) { const int unit = gw + k * NGW; if (unit < NU) { const int h = unit & 7, kb = (unit >> 3) * 32;
            const GAS v4u* src = (const GAS v4u*)(F.ws + WS_V) + ((size_t)kb * 1024 + h * 128) / 8;
#pragma unroll
            for (int i = 0; i < 8; ++i) raw[k][i] = src[(size_t)(i * 4 + (lane >> 4)) * 128 + (lane & 15)]; } }
#pragma unroll
    for (int k = 0; k < 2; ++k) { const int unit = gw + k * NGW; if (unit < NU) { const int h = unit & 7, kb = (unit >> 3) * 32;
#pragma unroll
            for (int i = 0; i < 8; ++i) *(LAS v4u*)(tile + (i * 4 + (lane >> 4)) * 272 + (lane & 15) * 16) = raw[k][i];
            LDS_WAIT(); asm volatile("" ::: "memory");
            const int ch = lane & 3, G = ch >> 1, g = ch & 1;
#pragma unroll
            for (int i = 0; i < 8; ++i) { const int d = i * 16 + (lane >> 2);
                unsigned short e[8];
#pragma unroll
                for (int p = 0; p < 8; ++p) { const int key = 16 * G + 8 * (p >> 2) + 4 * g + (p & 3); e[p] = *(const LAS unsigned short*)(tile + key * 272 + d * 2); }
                v4u o; o.x = (unsigned)e[0] | ((unsigned)e[1] << 16); o.y = (unsigned)e[2] | ((unsigned)e[3] << 16); o.z = (unsigned)e[4] | ((unsigned)e[5] << 16); o.w = (unsigned)e[6] | ((unsigned)e[7] << 16);
                *((GAS v4u*)(F.ws + WS_VT) + ((size_t)(h * 128 + d) * S + kb + 8 * ch) / 8) = o; }
            LDS_WAIT(); asm volatile("" ::: "memory"); } }
}

constexpr int CT = 16, CROWS = CT + 30;
__device__ __forceinline__ void conv_phase(Frame& F, int l) {
    LAS unsigned* ub = (LAS unsigned*)(F.lds + RING_OFF);
    LAS f32x2* part = (LAS f32x2*)(F.lds + RING_OFF + CROWS * 2048);
    const int lane = lane_now(), tid = F.wave * 64 + lane;
    const GAS f32x2* cw = (const GAS f32x2*)(F.conv_w + (size_t)l * CKW * 1024) + tid;
    float w0[CKW], w1[CKW];
#pragma unroll
    for (int k = 0; k < CKW; ++k) { const f32x2 w = cw[k * 512]; w0[k] = w.x; w1[k] = w.y; }
    const f32x2 cb = ((const GAS f32x2*)(F.conv_b + l * 1024))[tid], lg = ((const GAS f32x2*)(F.conv_g + l * 1024))[tid], lb = ((const GAS f32x2*)(F.conv_be + l * 1024))[tid];
    const GAS v4u* U = (const GAS v4u*)(F.ws + WS_U);
    GAS unsigned* CAT = (GAS unsigned*)(F.ws + WS_CAT);
    constexpr int NP = (CROWS * 128 + NWAVES * 64 - 1) / (NWAVES * 64);
    const int tb = (int)blockIdx.x * 64;
#pragma clang loop unroll(disable)
    for (int st = 0; st < 4; ++st) { const int t0 = tb + st * CT;
        { const int lane2 = lane_now(), tid2 = F.wave * 64 + lane2;
          v4u nx[NP];
#pragma unroll
          for (int i = 0; i < NP; ++i) { const int p = tid2 + NWAVES * 64 * i, tok = t0 - 30 + (p >> 7); nx[i] = (v4u){0u, 0u, 0u, 0u}; if (p < CROWS * 128 && tok >= 0) nx[i] = U[(size_t)tok * 128 + (p & 127)]; }
#pragma unroll
          for (int i = 0; i < NP; ++i) { const int p = tid2 + NWAVES * 64 * i; if (p < CROWS * 128) *(LAS v4u*)(ub + (p >> 7) * 512 + (p & 127) * 4) = nx[i]; } }
        __syncthreads();
        float a0[CT], a1[CT];
#pragma unroll
        for (int t = 0; t < CT; ++t) { a0[t] = cb.x; a1[t] = cb.y; }
#pragma unroll
        for (int r = 0; r < CROWS; ++r) { const unsigned w = ub[r * 512 + tid]; const float x0 = bflo(w), x1 = bfhi(w);
#pragma unroll
            for (int t = 0; t < CT; ++t) { if (r - t >= 0 && r - t <= 30) { a0[t] += w0[r - t] * x0; a1[t] += w1[r - t] * x1; } } }
#pragma unroll
        for (int t = 0; t < CT; ++t) { float s1 = a0[t] + a1[t], q = a0[t] * a0[t] + a1[t] * a1[t]; s1 = wave_sum(s1, lane); q = wave_sum(q, lane); if (lane == 0) part[F.wave * CT + t] = (f32x2){s1, q}; }
        __syncthreads();
#pragma unroll
        for (int t = 0; t < CT; ++t) { float s1 = 0.f, q = 0.f;
#pragma unroll
            for (int w = 0; w < 8; ++w) { const f32x2 pp = part[w * CT + t]; s1 += pp.x; q += pp.y; }
            const float mean = s1 * (1.f / 1024.f), var = fmaxf(q * (1.f / 1024.f) - mean * mean, 0.f), rstd = 1.0f / sqrtf(var + LN_EPS);
            const float y0 = (a0[t] - mean) * rstd * lg.x + lb.x, y1 = (a1[t] - mean) * rstd * lg.y + lb.y;
            CAT[((size_t)(t0 + t) * DM + 1024) / 2 + tid] = pk2(y0 * pg8::sigmoidf_fast(y0), y1 * pg8::sigmoidf_fast(y1)); }
        __syncthreads();
    }
}

typedef float f32x16 __attribute__((ext_vector_type(16)));
typedef __bf16 bf16x2_t __attribute__((ext_vector_type(2)));
__device__ __forceinline__ unsigned cvtpk(float lo, float hi) { const f32x2 v = {lo, hi}; const bf16x2_t b = __builtin_convertvector(v, bf16x2_t); return __builtin_bit_cast(unsigned, b); }
#define MFMA32(a, b, c) __builtin_amdgcn_mfma_f32_32x32x16_bf16((a), (b), (c), 0, 0, 0)
constexpr int LIST_PER_HEAD = 256 * 2016;
__device__ __forceinline__ int binoff(int j) { return 256 * (63 * j - (j * (j - 1)) / 2); }
#define TOP3_INSERT(v, j) do { const float v_ = (v); const int j_ = (j); \
    if (v_ > tv2) { if (v_ > tv1) { tv2 = tv1; ti2 = ti1; if (v_ > tv0) { tv1 = tv0; ti1 = ti0; tv0 = v_; ti0 = j_; } else { tv1 = v_; ti1 = j_; } } else { tv2 = v_; ti2 = j_; } } } while (0)
__device__ __forceinline__ void sel_phase(Frame& F, int l) {
    LAS int* cntL = (LAS int*)(F.lds + RING_OFF); LAS int* baseL = cntL + 64;
    const int lane = lane_now(), r = lane & 31, hg = lane >> 5, tid = F.wave * 64 + lane;
    const float NEG = -__builtin_inff();
#pragma clang loop unroll(disable)
    for (int unit = blockIdx.x; unit < 63 * NH; unit += F.G) { const int b = 1 + (unit >> 3), h = unit & 7;
        if (tid < 64) cntL[tid] = 0;
        __syncthreads();
        const int t = b * 256 + F.wave * 32 + r;
        const GAS bf16x8* qp = (const GAS bf16x8*)(F.ws + WS_Q) + ((size_t)t * 1024 + h * 128) / 8 + hg;
        bf16x8 qf[8];
#pragma unroll
        for (int kk = 0; kk < 8; ++kk) qf[kk] = qp[2 * kk];
        const GAS bf16x8* kh = (const GAS bf16x8*)(F.ws + WS_KMEAN) + ((size_t)(h * 64 + r) * 128) / 8 + hg;
        f32x16 G0, G1;
#pragma unroll
        for (int i = 0; i < 16; ++i) { G0[i] = 0.f; G1[i] = 0.f; }
#pragma unroll
        for (int kk = 0; kk < 8; ++kk) { G0 = MFMA32(kh[2 * kk], qf[kk], G0); G0 = MFMA32(kh[2 * kk + NH * NBLK * HD / 8], qf[kk], G0); }
        if (b > 32) {
#pragma unroll
            for (int kk = 0; kk < 8; ++kk) { G1 = MFMA32(kh[2 * kk + 32 * 16], qf[kk], G1); G1 = MFMA32(kh[2 * kk + 32 * 16 + NH * NBLK * HD / 8], qf[kk], G1); } }
        float tv0 = NEG, tv1 = NEG, tv2 = NEG; int ti0 = 0, ti1 = 0, ti2 = 0;
#pragma unroll
        for (int i = 0; i < 16; ++i) { const int j = (i & 3) + 8 * (i >> 2) + 4 * hg; TOP3_INSERT(j < b ? G0[i] : NEG, j); }
        if (b > 32) {
#pragma unroll
            for (int i = 0; i < 16; ++i) { const int j = 32 + (i & 3) + 8 * (i >> 2) + 4 * hg; TOP3_INSERT(j < b ? G1[i] : NEG, j); } }
        { const float p0 = shx(tv0, 32, lane), p1 = shx(tv1, 32, lane), p2 = shx(tv2, 32, lane); const int q0 = shx_i(ti0, 32, lane), q1 = shx_i(ti1, 32, lane), q2 = shx_i(ti2, 32, lane);
          TOP3_INSERT(p0, q0); TOP3_INSERT(p1, q1); TOP3_INSERT(p2, q2); }
        int rk0 = 0, rk1 = 0, rk2 = 0;
        if (hg == 0) {
            if (tv0 > NEG) rk0 = __hip_atomic_fetch_add(cntL + ti0, 1, __ATOMIC_RELAXED, __HIP_MEMORY_SCOPE_WORKGROUP);
            if (tv1 > NEG) rk1 = __hip_atomic_fetch_add(cntL + ti1, 1, __ATOMIC_RELAXED, __HIP_MEMORY_SCOPE_WORKGROUP);
            if (tv2 > NEG) rk2 = __hip_atomic_fetch_add(cntL + ti2, 1, __ATOMIC_RELAXED, __HIP_MEMORY_SCOPE_WORKGROUP); }
        __syncthreads();
        if (tid < 64) { const int c = cntL[tid]; if (c > 0) baseL[tid] = (int)__hip_atomic_fetch_add(F.ctl + CW_LCNT + l * 512 + h * 64 + tid, (unsigned)c, RLX_AGENT); }
        __syncthreads();
        if (hg == 0) { GAS int* L = (GAS int*)(F.ws + WS_LIST) + (size_t)h * LIST_PER_HEAD;
            if (tv0 > NEG) L[binoff(ti0) + baseL[ti0] + rk0] = t * 4 + 0;
            if (tv1 > NEG) L[binoff(ti1) + baseL[ti1] + rk1] = t * 4 + 1;
            if (tv2 > NEG) L[binoff(ti2) + baseL[ti2] + rk2] = t * 4 + 2; }
        __syncthreads();
    }
}
constexpr int KROW = 272, VROW = 528, KBUF_BYTES = 256 * KROW, VBUF_BYTES = 128 * VROW;
#define SCHED_FENCE() __builtin_amdgcn_sched_barrier(0)
template <bool CAUSAL>
__device__ __forceinline__ void moba_tile(const bf16x8 (&qf)[8], const LAS unsigned char* kb, const LAS unsigned char* vb, const int nkt, const int r, const int hg, f32x16 (&O)[4], float& ms, float& lsum) {
    const float NEG = -__builtin_inff(), SC = 0.08838834764831845f * 1.44269504088896341f;
    f32x16 Sx[8];
    bf16x8 kfA[8], kfB[8];
#pragma unroll
    for (int kk = 0; kk < 8; ++kk) kfA[kk] = *(const LAS bf16x8*)(kb + kk * 32);
#pragma unroll
    for (int kt = 0; kt < 8; ++kt) {
        if (kt < nkt) { f32x16 a;
#pragma unroll
            for (int i = 0; i < 16; ++i) a[i] = 0.f;
            if (kt + 1 < 8 && kt + 1 < nkt) {
#pragma unroll
                for (int kk = 0; kk < 8; ++kk) { if (kt & 1) kfA[kk] = *(const LAS bf16x8*)(kb + (kt + 1) * 32 * KROW + kk * 32); else kfB[kk] = *(const LAS bf16x8*)(kb + (kt + 1) * 32 * KROW + kk * 32); } }
            SCHED_FENCE();
#pragma unroll
            for (int kk = 0; kk < 8; ++kk) a = MFMA32((kt & 1) ? kfB[kk] : kfA[kk], qf[kk], a);
            SCHED_FENCE();
            if (CAUSAL && kt == nkt - 1) {
#pragma unroll
                for (int i = 0; i < 16; ++i) a[i] = ((i & 3) + 8 * (i >> 2) + 4 * hg > r) ? NEG : a[i]; }
            Sx[kt] = a;
        } else {
#pragma unroll
            for (int i = 0; i < 16; ++i) Sx[kt][i] = NEG; }
    }
    float mx = NEG;
#pragma unroll
    for (int kt = 0; kt < 8; ++kt)
#pragma unroll
        for (int i = 0; i < 16; ++i) mx = fmaxf(mx, Sx[kt][i]);
    mx = fmaxf(mx, shx(mx, 32, r + 32 * hg));
    ms = mx * SC;
    float ls = 0.f;
    bf16x8 pb[8][2];
#pragma unroll
    for (int kt = 0; kt < 8; ++kt)
#pragma unroll
        for (int s2 = 0; s2 < 2; ++s2) { float p[8];
#pragma unroll
            for (int i = 0; i < 8; ++i) { p[i] = __builtin_amdgcn_exp2f(Sx[kt][8 * s2 + i] * SC - ms); ls += p[i]; }
            v4u pw; pw.x = cvtpk(p[0], p[1]); pw.y = cvtpk(p[2], p[3]); pw.z = cvtpk(p[4], p[5]); pw.w = cvtpk(p[6], p[7]);
            pb[kt][s2] = __builtin_bit_cast(bf16x8, pw); }
    lsum = ls + shx(ls, 32, r + 32 * hg);
#pragma unroll
    for (int dt = 0; dt < 4; ++dt)
#pragma unroll
        for (int i = 0; i < 16; ++i) O[dt][i] = 0.f;
    bf16x8 vfA[4], vfB[4];
#pragma unroll
    for (int dt = 0; dt < 4; ++dt) vfA[dt] = *(const LAS bf16x8*)(vb + dt * 32 * VROW);
#pragma unroll
    for (int st = 0; st < 16; ++st) { const int kt = st >> 1, s2 = st & 1;
        if (kt < nkt) {
            if (st + 1 < 16 && ((st + 1) >> 1) < nkt) {
#pragma unroll
                for (int dt = 0; dt < 4; ++dt) { if (st & 1) vfA[dt] = *(const LAS bf16x8*)(vb + dt * 32 * VROW + (st + 1) * 32); else vfB[dt] = *(const LAS bf16x8*)(vb + dt * 32 * VROW + (st + 1) * 32); } }
            SCHED_FENCE();
#pragma unroll
            for (int dt = 0; dt < 4; ++dt) O[dt] = MFMA32((st & 1) ? vfB[dt] : vfA[dt], pb[kt][s2], O[dt]);
            SCHED_FENCE();
        }
    }
}
__device__ __forceinline__ void stage_kv(Frame& F, int h, int j, int tid) {
    LAS unsigned char* kbuf = F.lds + RING_OFF; LAS unsigned char* vbuf = kbuf + KBUF_BYTES;
    const GAS v4u* kg = (const GAS v4u*)(F.ws + WS_K) + ((size_t)(j * 256) * 1024 + h * 128) / 8;
    const GAS v4u* vg = (const GAS v4u*)(F.ws + WS_VT) + ((size_t)(h * 128) * S + j * 256) / 8;
    v4u kr[8], vr[8];
#pragma unroll
    for (int i = 0; i < 8; ++i) { const int p = tid + 512 * i; kr[i] = kg[(size_t)(p >> 4) * 128 + (p & 15)]; vr[i] = vg[(size_t)(p >> 5) * (S / 8) + (p & 31)]; }
#pragma unroll
    for (int i = 0; i < 8; ++i) { const int p = tid + 512 * i; *(LAS v4u*)(kbuf + (p >> 4) * KROW + (p & 15) * 16) = kr[i]; *(LAS v4u*)(vbuf + (p >> 5) * VROW + (p & 31) * 16) = vr[i]; }
}
__device__ __forceinline__ void partial_phase(Frame& F, int l) {
    gu32* lcnt = F.ctl + CW_LCNT + l * 512;
    LAS int* tab = (LAS int*)(F.lds + RING_OFF + KBUF_BYTES + VBUF_BYTES);
    { const int lane = lane_now(); int tl[8], sum = 0;
#pragma unroll
      for (int i = 0; i < 8; ++i) { const int c = (int)__hip_atomic_load(lcnt + lane * 8 + i, RLX_AGENT); tl[i] = (c + 255) >> 8; sum += tl[i]; }
      int inc = sum;
#pragma unroll
      for (int o = 1; o < 64; o <<= 1) { const int v = __builtin_amdgcn_ds_bpermute((lane - o) << 2, inc); if (lane >= o) inc += v; }
      int run = inc - sum;
      if (F.wave == 0) {
#pragma unroll
          for (int i = 0; i < 8; ++i) { run += tl[i]; tab[lane * 8 + i] = run; } } }
    __syncthreads();
    const int total = __builtin_amdgcn_readfirstlane(tab[511]);
    const int u_lo = (int)(((long)blockIdx.x * total) / F.G), u_hi = (int)(((long)(blockIdx.x + 1) * total) / F.G);
    int staged = -1;
#pragma clang loop unroll(disable)
    for (int u = u_lo; u < u_hi; ++u) {
        const int lane = lane_now(), r = lane & 31, hg = lane >> 5, tid = F.wave * 64 + lane;
        const LAS unsigned char* kb = F.lds + RING_OFF + r * KROW + hg * 16; const LAS unsigned char* vb = F.lds + RING_OFF + KBUF_BYTES + r * VROW + hg * 16;
        int bin = 0, chunk = 0; bool mine = false;
        { const int prev = lane ? tab[lane * 8 - 1] : 0; int lo = prev;
#pragma unroll
          for (int i = 0; i < 8; ++i) { const int hi = tab[lane * 8 + i]; if (u >= lo && u < hi) { mine = true; bin = lane * 8 + i; chunk = u - lo; } lo = hi; } }
        const int src = __builtin_ctzll(__ballot(mine)); bin = __builtin_amdgcn_readlane(bin, src); chunk = __builtin_amdgcn_readlane(chunk, src);
        const int h = bin >> 6, j = bin & 63, n = (int)__builtin_amdgcn_readfirstlane(__hip_atomic_load(lcnt + bin, RLX_AGENT));
        const int base = chunk * 256 + F.wave * 32; const bool active = base < n, valid = base + r < n;
        const int e = ((const GAS int*)(F.ws + WS_LIST))[(size_t)h * LIST_PER_HEAD + binoff(j) + (active ? base + (valid ? r : 0) : 0)];
        const int t = e >> 2, sl = e & 3;
        const GAS bf16x8* qp = (const GAS bf16x8*)(F.ws + WS_Q) + ((size_t)t * 1024 + h * 128) / 8 + hg;
        bf16x8 qf[8];
#pragma unroll
        for (int kk = 0; kk < 8; ++kk) qf[kk] = qp[2 * kk];
        if (bin != staged) {
            __syncthreads();
            stage_kv(F, h, j, tid);
            __syncthreads();
            staged = bin; }
        if (active) {
            f32x16 O[4]; float ms, ls;
            moba_tile<false>(qf, kb, vb, 8, r, hg, O, ms, ls);
            if (valid) { const size_t idx = ((size_t)t * NH + h) * 3 + sl; const float inv = 1.0f / ls;
                GAS v2u* po = (GAS v2u*)(F.ws + WS_PO) + idx * 32 + hg;
#pragma unroll
                for (int dt = 0; dt < 4; ++dt)
#pragma unroll
                    for (int g4 = 0; g4 < 4; ++g4) po[dt * 8 + 2 * g4] = (v2u){cvtpk(O[dt][4 * g4] * inv, O[dt][4 * g4 + 1] * inv), cvtpk(O[dt][4 * g4 + 2] * inv, O[dt][4 * g4 + 3] * inv)};
                if (hg == 0) ((GAS f32x2*)(F.ws + WS_PML))[idx] = (f32x2){ms, ls}; }
        }
    }
}
__device__ __forceinline__ void own_phase(Frame& F) {
#pragma clang loop unroll(disable)
    for (int u = blockIdx.x; u < NBLK * NH; u += F.G) { const int h = u & 7, b = u >> 3, qt = F.wave;
        const int lane = lane_now(), r = lane & 31, hg = lane >> 5, tid = F.wave * 64 + lane;
        const LAS unsigned char* kb = F.lds + RING_OFF + r * KROW + hg * 16; const LAS unsigned char* vb = F.lds + RING_OFF + KBUF_BYTES + r * VROW + hg * 16;
        const int t = b * 256 + qt * 32 + r;
        const GAS bf16x8* qp = (const GAS bf16x8*)(F.ws + WS_Q) + ((size_t)t * 1024 + h * 128) / 8 + hg;
        bf16x8 qf[8];
#pragma unroll
        for (int kk = 0; kk < 8; ++kk) qf[kk] = qp[2 * kk];
        __syncthreads();
        stage_kv(F, h, b, tid);
        __syncthreads();
        f32x16 O[4]; float ms, ls;
        moba_tile<true>(qf, kb, vb, qt + 1, r, hg, O, ms, ls);
        const int nv = b < 3 ? b : 3; const size_t idx0 = ((size_t)t * NH + h) * 3;
        float pm[3], pl[3], M = ms;
#pragma unroll
        for (int s2 = 0; s2 < 3; ++s2) { pm[s2] = -__builtin_inff(); pl[s2] = 0.f; if (s2 < nv) { const f32x2 v = ((const GAS f32x2*)(F.ws + WS_PML))[idx0 + s2]; pm[s2] = v.x; pl[s2] = v.y; M = fmaxf(M, v.x); } }
        const float wo = __builtin_amdgcn_exp2f(ms - M); float W = ls * wo, w[3];
#pragma unroll
        for (int s2 = 0; s2 < 3; ++s2) { w[s2] = pl[s2] * __builtin_amdgcn_exp2f(pm[s2] - M); W += w[s2]; }
        const float invW = 1.0f / W;
#pragma unroll
        for (int dt = 0; dt < 4; ++dt)
#pragma unroll
            for (int i = 0; i < 16; ++i) O[dt][i] *= wo;
#pragma unroll
        for (int s2 = 0; s2 < 3; ++s2) { if (s2 < nv) { const GAS v2u* po = (const GAS v2u*)(F.ws + WS_PO) + (idx0 + s2) * 32 + hg;
#pragma unroll
                for (int dt = 0; dt < 4; ++dt)
#pragma unroll
                    for (int g4 = 0; g4 < 4; ++g4) { const v2u v = po[dt * 8 + 2 * g4]; O[dt][4 * g4] += w[s2] * bflo(v.x); O[dt][4 * g4 + 1] += w[s2] * bfhi(v.x); O[dt][4 * g4 + 2] += w[s2] * bflo(v.y); O[dt][4 * g4 + 3] += w[s2] * bfhi(v.y); } } }
        GAS v2u* co = (GAS v2u*)(F.ws + WS_CAT) + ((size_t)t * DM + h * 128) / 4 + hg;
#pragma unroll
        for (int dt = 0; dt < 4; ++dt)
#pragma unroll
            for (int g4 = 0; g4 < 4; ++g4) co[dt * 8 + 2 * g4] = (v2u){cvtpk(O[dt][4 * g4] * invW, O[dt][4 * g4 + 1] * invW), cvtpk(O[dt][4 * g4 + 2] * invW, O[dt][4 * g4 + 3] * invW)};
    }
}

__device__ __forceinline__ void ln_phase(Frame& F, const float* xres_, const bf16* y_, const float* g_, const float* b_, const float* router) {
    const int gw = F.vcu * NWAVES + F.wave, lane = lane_now();
    const GAS f32x4* gp = (const GAS f32x4*)g_ + lane; const GAS f32x4* bp = (const GAS f32x4*)b_ + lane;
    int ecl[8];
#pragma unroll
    for (int e = 0; e < 8; ++e) ecl[e] = 0;
    f32x4 hraw[8]; v2u hraw16[8], yraw[8];
    { const GAS v2u* yp = (const GAS v2u*)(y_ + (size_t)(gw * 8) * DM) + lane;
      if (xres_) { const GAS f32x4* hp = (const GAS f32x4*)(xres_ + (size_t)(gw * 8) * DM) + lane;
#pragma unroll
          for (int j = 0; j < 8; ++j) hraw[j] = hp[64 * j]; }
      else { const GAS v2u* hp = (const GAS v2u*)(F.ws + WS_HB + (size_t)(gw * 8) * DM * 2) + lane;
#pragma unroll
          for (int j = 0; j < 8; ++j) hraw16[j] = hp[64 * j]; }
#pragma unroll
      for (int j = 0; j < 8; ++j) yraw[j] = yp[64 * j]; }
#pragma clang loop unroll(disable)
    for (int i = 0; i < S / (256 * NWAVES); ++i) { const int row = gw * (S / (256 * NWAVES)) + i;
        f32x4 v[8]; float s = 0.f;
#pragma unroll
        for (int j = 0; j < 8; ++j) { const v2u yv = yraw[j]; const f32x4 hv = xres_ ? hraw[j] : (f32x4){bflo(hraw16[j].x), bfhi(hraw16[j].x), bflo(hraw16[j].y), bfhi(hraw16[j].y)};
            v[j] = hv * ALPHA + (f32x4){bflo(yv.x), bfhi(yv.x), bflo(yv.y), bfhi(yv.y)}; s += (v[j][0] + v[j][1]) + (v[j][2] + v[j][3]); }
        if (i + 1 < S / (256 * NWAVES)) { const GAS v2u* yp = (const GAS v2u*)(y_ + (size_t)(row + 1) * DM) + lane;
            if (xres_) { const GAS f32x4* hp = (const GAS f32x4*)(xres_ + (size_t)(row + 1) * DM) + lane;
#pragma unroll
                for (int j = 0; j < 8; ++j) hraw[j] = hp[64 * j]; }
            else { const GAS v2u* hp = (const GAS v2u*)(F.ws + WS_HB + (size_t)(row + 1) * DM * 2) + lane;
#pragma unroll
                for (int j = 0; j < 8; ++j) hraw16[j] = hp[64 * j]; }
#pragma unroll
            for (int j = 0; j < 8; ++j) yraw[j] = yp[64 * j]; }
        const float mean = wave_sum(s, lane) * (1.f / DM); float s2 = 0.f;
#pragma unroll
        for (int j = 0; j < 8; ++j) { v[j] = v[j] - mean; s2 += (v[j][0] * v[j][0] + v[j][1] * v[j][1]) + (v[j][2] * v[j][2] + v[j][3] * v[j][3]); }
        const float rstd = 1.f / sqrtf(wave_sum(s2, lane) * (1.f / DM) + LN_EPS);
        GAS v2u* hb = (GAS v2u*)(F.ws + WS_HB + (size_t)row * DM * 2) + lane;
#pragma unroll
        for (int j = 0; j < 8; ++j) { v[j] = v[j] * rstd * gp[64 * j] + bp[64 * j]; hb[64 * j] = (v2u){pk2(v[j][0], v[j][1]), pk2(v[j][2], v[j][3])};
            if (router) ((GAS unsigned*)(F.ws + WS_HB8 + (size_t)row * DM))[64 * j + lane] = pg8::pk4_fp8(v[j][0] * ASC_H, v[j][1] * ASC_H, v[j][2] * ASC_H, v[j][3] * ASC_H); }
        if (router) {
            float lg[8];
#pragma unroll
            for (int e = 0; e < 8; ++e) lg[e] = 0.f;
#pragma unroll
            for (int j = 0; j < 8; ++j)
#pragma unroll
                for (int c = 0; c < 4; ++c) { const GAS f32x4* rw = (const GAS f32x4*)(router + (size_t)(256 * j + 4 * lane + c) * 8); const f32x4 r0 = rw[0], r1 = rw[1]; const float xv = v[j][c];
                    lg[0] += xv * r0[0]; lg[1] += xv * r0[1]; lg[2] += xv * r0[2]; lg[3] += xv * r0[3]; lg[4] += xv * r1[0]; lg[5] += xv * r1[1]; lg[6] += xv * r1[2]; lg[7] += xv * r1[3]; }
#pragma unroll
            for (int e = 0; e < 8; ++e) lg[e] = wave_sum(lg[e], lane);
            int i1 = 0; float v1 = lg[0];
#pragma unroll
            for (int e = 1; e < 8; ++e) if (lg[e] > v1) { v1 = lg[e]; i1 = e; }
            int i2 = -1; float v2 = -__builtin_inff();
#pragma unroll
            for (int e = 0; e < 8; ++e) if (e != i1 && lg[e] > v2) { v2 = lg[e]; i2 = e; }
            const float g1 = 1.0f / (1.0f + __expf(v2 - v1)), g2 = 1.0f - g1;
            if (lane == 0) { ((GAS int*)(F.ws + WS_EIDX))[row * 2] = i1; ((GAS int*)(F.ws + WS_EIDX))[row * 2 + 1] = i2; ((GAS float*)(F.ws + WS_GATEW))[row * 2] = g1; ((GAS float*)(F.ws + WS_GATEW))[row * 2 + 1] = g2; }
#pragma unroll
            for (int e = 0; e < 8; ++e) ecl[e] += (i1 == e ? 1 : 0) + (i2 == e ? 1 : 0);
        }
    }
    if (router) { int mine = 0;
#pragma unroll
        for (int e = 0; e < 8; ++e) mine = (lane == e) ? ecl[e] : mine;
        if (lane < 8 && mine) __hip_atomic_fetch_add(F.ctl + CW_ECNT + 64 * lane, (unsigned)mine, RLX_AGENT); }
}
__device__ __forceinline__ void load_expert_layout(Frame& F, int (&off)[8], int (&cum)[8], int& npanels) {
    int o = 0;
#pragma unroll
    for (int e = 0; e < 8; ++e) { const int c = (int)__builtin_amdgcn_readfirstlane(__hip_atomic_load(F.ctl + CW_ECNT + 64 * e, RLX_AGENT)); off[e] = o; cum[e] = o >> 8; o += (c + 255) & ~255; }
    npanels = o >> 8;
}
__device__ __forceinline__ void route_phase(Frame& F) {
    const int gw = F.vcu * NWAVES + F.wave, lane = lane_now();
    int off[8], cum[8], np; load_expert_layout(F, off, cum, np);
    const int row = gw * 8 + (lane >> 1), slot = lane & 1; const bool act = lane < 16;
    const int mye = act ? ((const GAS int*)(F.ws + WS_EIDX))[row * 2 + slot] : -1;
    int pos = 0;
#pragma unroll
    for (int e = 0; e < 8; ++e) { const unsigned long long mask = __ballot(mye == e);
        if (mask) { const int leader = __builtin_ctzll(mask), n = __builtin_popcountll(mask); unsigned b = 0u;
            if (lane == leader) b = __hip_atomic_fetch_add(F.ctl + CW_ECUR + 64 * e, (unsigned)n, RLX_AGENT);
            b = (unsigned)shl_i((int)b, leader);
            if (mye == e) pos = off[e] + (int)b + __builtin_popcountll(mask & ((1ull << lane) - 1ull)); } }
    if (act) ((GAS int*)(F.ws + WS_ROWPOS))[row * 2 + slot] = pos;
#pragma clang loop unroll(disable)
    for (int k0 = 0; k0 < 16; k0 += 8) {
        v4u t[8][2];
#pragma unroll
        for (int k = 0; k < 8; ++k) { const int r = gw * 8 + ((k0 + k) >> 1); const GAS v4u* src = (const GAS v4u*)(F.ws + WS_HB8 + (size_t)r * DM) + lane; t[k][0] = src[0]; t[k][1] = src[64]; }
#pragma unroll
        for (int k = 0; k < 8; ++k) { const int p = __builtin_amdgcn_readfirstlane(shl_i(pos, k0 + k)); GAS v4u* dst = (GAS v4u*)(F.ws + WS_HBP + (size_t)p * DM) + lane; dst[0] = t[k][0]; dst[64] = t[k][1]; }
    }
}
__device__ __forceinline__ void ln_moe_phase(Frame& F, const float* g_, const float* b_) {
    const int gw = F.vcu * NWAVES + F.wave, lane = lane_now();
    const GAS f32x4* gp = (const GAS f32x4*)g_ + lane; const GAS f32x4* bp = (const GAS f32x4*)b_ + lane;
    int mp1 = 0, mp2 = 0; float mg1 = 0.f, mg2 = 0.f;
    if (lane < 8) { const int rr = gw * 8 + lane; mp1 = ((const GAS int*)(F.ws + WS_ROWPOS))[rr * 2]; mp2 = ((const GAS int*)(F.ws + WS_ROWPOS))[rr * 2 + 1]; mg1 = ((const GAS float*)(F.ws + WS_GATEW))[rr * 2]; mg2 = ((const GAS float*)(F.ws + WS_GATEW))[rr * 2 + 1]; }
    v2u hraw[8], araw[8], braw[8];
    { const int p1 = __builtin_amdgcn_readlane(mp1, 0), p2 = __builtin_amdgcn_readlane(mp2, 0);
      const GAS v2u* hp = (const GAS v2u*)(F.ws + WS_HB + (size_t)(gw * 8) * DM * 2) + lane;
      const GAS v2u* y1 = (const GAS v2u*)(F.ws + WS_R2 + (size_t)p1 * DM * 2) + lane; const GAS v2u* y2 = (const GAS v2u*)(F.ws + WS_R2 + (size_t)p2 * DM * 2) + lane;
#pragma unroll
      for (int j = 0; j < 8; ++j) { hraw[j] = hp[64 * j]; araw[j] = y1[64 * j]; braw[j] = y2[64 * j]; } }
#pragma clang loop unroll(disable)
    for (int i = 0; i < 8; ++i) { const int row = gw * 8 + i;
        const float g1 = __builtin_bit_cast(float, shl_i(__builtin_bit_cast(int, mg1), i)), g2 = __builtin_bit_cast(float, shl_i(__builtin_bit_cast(int, mg2), i));
        f32x4 v[8]; float s = 0.f;
#pragma unroll
        for (int j = 0; j < 8; ++j) { const v2u a = araw[j], b = braw[j];
            const f32x4 fa = (f32x4){bflo(a.x), bfhi(a.x), bflo(a.y), bfhi(a.y)}, fb = (f32x4){bflo(b.x), bfhi(b.x), bflo(b.y), bfhi(b.y)};
            v[j] = (f32x4){bflo(hraw[j].x), bfhi(hraw[j].x), bflo(hraw[j].y), bfhi(hraw[j].y)} * ALPHA + fa * g1 + fb * g2; s += (v[j][0] + v[j][1]) + (v[j][2] + v[j][3]); }
        if (i + 1 < 8) { const int p1 = __builtin_amdgcn_readfirstlane(shl_i(mp1, i + 1)), p2 = __builtin_amdgcn_readfirstlane(shl_i(mp2, i + 1));
            const GAS v2u* hp = (const GAS v2u*)(F.ws + WS_HB + (size_t)(row + 1) * DM * 2) + lane;
            const GAS v2u* y1 = (const GAS v2u*)(F.ws + WS_R2 + (size_t)p1 * DM * 2) + lane; const GAS v2u* y2 = (const GAS v2u*)(F.ws + WS_R2 + (size_t)p2 * DM * 2) + lane;
#pragma unroll
            for (int j = 0; j < 8; ++j) { hraw[j] = hp[64 * j]; araw[j] = y1[64 * j]; braw[j] = y2[64 * j]; } }
        const float mean = wave_sum(s, lane) * (1.f / DM); float s2 = 0.f;
#pragma unroll
        for (int j = 0; j < 8; ++j) { v[j] = v[j] - mean; s2 += (v[j][0] * v[j][0] + v[j][1] * v[j][1]) + (v[j][2] * v[j][2] + v[j][3] * v[j][3]); }
        const float rstd = 1.f / sqrtf(wave_sum(s2, lane) * (1.f / DM) + LN_EPS);
        GAS f32x4* op = (GAS f32x4*)(F.out + (size_t)row * DM) + lane;
#pragma unroll
        for (int j = 0; j < 8; ++j) op[64 * j] = v[j] * rstd * gp[64 * j] + bp[64 * j];
    }
}

struct Args { const float* in[18]; float* out; unsigned char* ws; };
__global__ void __launch_bounds__(NWAVES * 64, 2) hymba_fwd(Args args) {
    extern __shared__ __attribute__((aligned(16))) unsigned char lds[];
    Frame F;
    F.lds = (LAS unsigned char*)lds;
    F.MISC = (volatile LAS unsigned*)(F.lds + MISC_OFF);
    F.wave = __builtin_amdgcn_readfirstlane((int)threadIdx.x >> 6);
    F.G = gridDim.x; { const int bx = blockIdx.x; F.vcu = (F.G % 8 == 0) ? (bx % 8) * (F.G / 8) + bx / 8 : bx; }
    F.ws = args.ws; F.ctl = (gu32*)(args.ws + WS_CTL);
    F.x = args.in[0]; F.w_in = args.in[1]; F.conv_w = args.in[2]; F.conv_b = args.in[3]; F.conv_g = args.in[4]; F.conv_be = args.in[5]; F.w_out = args.in[6];
    F.lnm_g = args.in[7]; F.lnm_b = args.in[8]; F.lnf_g = args.in[9]; F.lnf_b = args.in[10]; F.fg = args.in[11]; F.fu = args.in[12]; F.fd = args.in[13];
    F.router = args.in[14]; F.eg = args.in[15]; F.eu = args.in[16]; F.ed = args.in[17]; F.out = args.out;
    for (int u = threadIdx.x; u < (LDS_BYTES - LDSCTL_OFF) / 4; u += NWAVES * 64) ((LAS unsigned*)(F.lds + LDSCTL_OFF))[u] = 0u;
    __syncthreads();
    XcdBarrier bar = xcd_barrier_post((unsigned*)(F.ctl + CW_BAR), F.MISC + 8, F.wave);
#define LAUNDER() asm volatile("" : "+s"(F.ws), "+s"(F.ctl), "+s"(F.out), "+s"(F.x), "+s"(bar.bar), "+s"(F.wave))
#define GRID_BAR() do { LAUNDER(); xcd_barrier(bar); LAUNDER(); } while (0)
#define HB ((bf16*)(F.ws + WS_HB))
#define Y ((bf16*)(F.ws + WS_R2))

    p0_prologue(F);
    GRID_BAR();

#pragma clang loop unroll(disable)
    for (int l = 0; l < 2; ++l) {
#ifndef NO_G_INPROJ
        { pg8::Gemm g{HB, (const bf16*)(F.ws + WS_WIN) + (size_t)l * NPROJ * DM, S, NPROJ, DM, 0}; pg8::StaticOrder So; So.init(S, NPROJ, F.G, (int)blockIdx.x);
          pg8::EpiInProj E{(bf16*)(F.ws + WS_Q), (bf16*)(F.ws + WS_K), (bf16*)(F.ws + WS_V), (bf16*)(F.ws + WS_U), (const float*)(F.ws + WS_ROPEC), (const float*)(F.ws + WS_ROPES)};
          pg8::gemm_phase<pg8::EpiInProj, pg8::StaticOrder, true, true>(F.lds + RING_OFF, g, So, E, F.wave); }
#endif
        GRID_BAR();
        kmean_phase(F);
        vt_phase(F);
        __syncthreads();
        conv_phase(F, l);
        GRID_BAR();
        sel_phase(F, l);
        GRID_BAR();
        partial_phase(F, l);
        GRID_BAR();
        own_phase(F);
        GRID_BAR();
#ifndef NO_G_OUTPROJ
        { pg8::Gemm g{(const bf16*)(F.ws + WS_CAT), (const bf16*)(F.ws + WS_WOUT) + (size_t)l * DM * DM, S, DM, DM, 0}; pg8::StaticOrder So; So.init(S, DM, F.G, (int)blockIdx.x);
          pg8::EpiBf16 E{Y, DM, 1.0f};
          pg8::gemm_phase<pg8::EpiBf16, pg8::StaticOrder, true, true>(F.lds + RING_OFF, g, So, E, F.wave); }
#endif
        GRID_BAR();
        ln_phase(F, l == 0 ? F.x : nullptr, Y, F.lnm_g + l * DM, F.lnm_b + l * DM, l == 1 ? F.router : nullptr);
        GRID_BAR();
        if (l == 0) {
#ifndef NO_G_FFNGU
            { pg8::Gemm g{HB, (const bf16*)(F.ws + WS_WGU0), S, 2 * DFF, DM, 0}; pg8::StaticOrder So; So.init(S, 2 * DFF, F.G, (int)blockIdx.x);
              pg8::EpiSwiGLU E{(bf16*)(F.ws + WS_ACT), DFF};
              pg8::gemm_phase<pg8::EpiSwiGLU, pg8::StaticOrder, true, true>(F.lds + RING_OFF, g, So, E, F.wave); }
#endif
            GRID_BAR();
#ifndef NO_G_FFND
            { pg8::Gemm g{(const bf16*)(F.ws + WS_ACT), (const bf16*)(F.ws + WS_WD0), S, DM, DFF, 0}; pg8::StaticOrder So; So.init(S, DM, F.G, (int)blockIdx.x);
              pg8::EpiBf16 E{Y, DM, 1.0f};
              pg8::gemm_phase<pg8::EpiBf16, pg8::StaticOrder, true, true>(F.lds + RING_OFF, g, So, E, F.wave); }
#endif
            GRID_BAR();
            ln_phase(F, nullptr, Y, F.lnf_g, F.lnf_b, nullptr);
            GRID_BAR();
        } else {
            route_phase(F);
            GRID_BAR();
            int off[8], cum[8], np; load_expert_layout(F, off, cum, np);
#ifndef NO_G_MOEGU
            { pg8::Gemm g{(const bf16*)(F.ws + WS_HBP), (const bf16*)(F.ws + WS_WGUE), np * 256, 2 * DFF, DM / 2, (size_t)2 * DFF * DM}; pg8::GroupedOrder So; So.init(np * 256, 2 * DFF, F.G, (int)blockIdx.x);
#pragma unroll
              for (int e = 0; e < 8; ++e) So.cum[e] = cum[e];
              pg8::EpiSwiGLU8 E{F.ws + WS_ACT, DFF, 1.0f / (WSC_GU * ASC_H), ASC_ACT};
              pg8::gemm_phase<pg8::EpiSwiGLU8, pg8::GroupedOrder, true, true, true>(F.lds + RING_OFF, g, So, E, F.wave); }
#endif
            GRID_BAR();
#ifndef NO_G_MOED
            { pg8::Gemm g{(const bf16*)(F.ws + WS_ACT), (const bf16*)(F.ws + WS_WDE), np * 256, DM, DFF / 2, (size_t)DM * DFF}; pg8::GroupedOrder So; So.init(np * 256, DM, F.G, (int)blockIdx.x);
#pragma unroll
              for (int e = 0; e < 8; ++e) So.cum[e] = cum[e];
              pg8::EpiBf16 E{(bf16*)(F.ws + WS_R2), DM, 1.0f / (WSC_D * ASC_ACT)};
              pg8::gemm_phase<pg8::EpiBf16, pg8::GroupedOrder, true, true, true>(F.lds + RING_OFF, g, So, E, F.wave); }
#endif
            GRID_BAR();
            ln_moe_phase(F, F.lnf_g + DM, F.lnf_b + DM);
        }
    }
#undef GRID_BAR
#undef LAUNDER
#undef HB
#undef Y
}

extern "C" void kernel_launch(void* const* d_in, const int* in_sizes, int n_in, void* d_out, int out_size, void* d_ws, size_t ws_size, hipStream_t stream) {
    static int grid = 0;
    if (grid == 0) {
        if (n_in != 18 || in_sizes[0] != S * DM || out_size != S * DM || ws_size < WS_END) { fprintf(stderr, "kernel_launch: unexpected shapes (n_in %d, in0 %d, out %d, ws %zu < %zu); nothing launched\n", n_in, n_in > 0 ? in_sizes[0] : -1, out_size, ws_size, (size_t)WS_END); grid = -1; return; }
        int dev = 0, cus = 0, per_cu = 0;
        if (hipGetDevice(&dev) != hipSuccess || hipDeviceGetAttribute(&cus, hipDeviceAttributeMultiprocessorCount, dev) != hipSuccess) { grid = -1; return; }
        if (hipFuncSetAttribute((const void*)hymba_fwd, hipFuncAttributeMaxDynamicSharedMemorySize, LDS_BYTES) != hipSuccess) { fprintf(stderr, "kernel_launch: hipFuncSetAttribute failed\n"); grid = -1; return; }
        if (hipOccupancyMaxActiveBlocksPerMultiprocessor(&per_cu, (const void*)hymba_fwd, NWAVES * 64, LDS_BYTES) != hipSuccess || per_cu < 1)
            fprintf(stderr, "kernel_launch: note: occupancy query reports %d workgroups per CU\n", per_cu);
        (void)hipGetLastError();
        grid = cus;
        if (grid != 256) { fprintf(stderr, "kernel_launch: built for 256 CUs, device has %d; nothing launched\n", cus); grid = -1; return; }
    }
    if (grid < 0) return;
    if (hipMemsetAsync((char*)d_ws + WS_CTL, 0, CTL_ZERO_BYTES, stream) != hipSuccess) return;
    Args a{};
    for (int i = 0; i < 18; ++i) a.in[i] = (const float*)d_in[i];
    a.out = (float*)d_out; a.ws = (unsigned char*)d_ws;
    hipLaunchKernelGGL(hymba_fwd, dim3(grid), dim3(NWAVES * 64), LDS_BYTES, stream, a);
}
```

```cpp
#include <hip/hip_runtime.h>
#include <cstdio>
#include <cstdint>
#include <cmath>
namespace pg8 {
#define PG8_LAS __attribute__((address_space(3)))
typedef unsigned short bf16_t;
typedef short bf16x8 __attribute__((ext_vector_type(8)));
typedef float f32x4 __attribute__((ext_vector_type(4)));
typedef unsigned u32x4 __attribute__((ext_vector_type(4)));
typedef unsigned u32x2 __attribute__((ext_vector_type(2)));
typedef int v8i __attribute__((ext_vector_type(8)));
typedef int v4i __attribute__((ext_vector_type(4)));
constexpr int BM = 256, BK = 64, HALF = 128, HTB = HALF * BK * 2  , STAGE_BYTES = 8 * HTB, NXCD = 8, WGM = 8;

__host__ __device__ __forceinline__ int lds_byte(int r, int c) { const int st = (r >> 4) * 2 + (c >> 5), rr = r & 15, cc = c & 31, ob = rr * 64 + cc * 2; return st * 1024 + (ob ^ (((ob >> 9) & 1) << 5)); }
__host__ __device__ __forceinline__ void stage_rc(int b, int& R, int& C) { const int st = b / 1024, sb = b % 1024, swz = sb ^ (((sb >> 9) & 1) << 5); R = (st >> 1) * 16 + swz / 64; C = (st & 1) * 32 + (swz % 64) / 2; }
__host__ __device__ __forceinline__ int perm32(int rho) { const int n = rho >> 4, i = rho & 15; return 8 * (i >> 2) + 4 * n + (i & 3); }

struct Unit { int pm, pn, e; };
struct Gemm { const bf16_t* A; const bf16_t* Bt; int M, N, K; size_t bstride; };

struct StaticOrder {
    int nM, nN, nwg, G, c;
    __host__ __device__ void init(int M, int N, int G_, int c_) { nM = M / BM; nN = N / BM; nwg = nM * nN; G = G_; c = c_; }
    __host__ __device__ bool next(int i, Unit& u) const {
        const long L = (long)i * G + c; if (L >= nwg) return false;
        int wgid = (int)L; { const int q = nwg / NXCD, r = nwg % NXCD, xcd = wgid % NXCD, off = wgid / NXCD; wgid = (xcd < r ? xcd * (q + 1) : r * (q + 1) + (xcd - r) * q) + off; }
        const int nig = WGM * nN, gid = wgid / nig, fm = gid * WGM, gsz = (nM - fm) < WGM ? (nM - fm) : WGM;
        u.pm = fm + ((wgid % nig) % gsz); u.pn = (wgid % nig) / gsz; u.e = 0; return true;
    }
    __device__ __forceinline__ void a_ready(const Unit&) const {}
    __device__ __forceinline__ void done(const Unit&) const {}
};
struct GroupedOrder : StaticOrder {
    int cum[8];
    __device__ bool next(int i, Unit& u) const {
        if (!StaticOrder::next(i, u)) return false;
        int e = 0;
#pragma unroll
        for (int j = 1; j < 8; ++j) e += (u.pm >= cum[j]) ? 1 : 0;
        u.e = e; return true;
    }
};

__device__ __forceinline__ unsigned cvt_pk_bf16(float lo, float hi) { unsigned r; asm volatile("v_cvt_pk_bf16_f32 %0, %1, %2" : "=v"(r) : "v"(lo), "v"(hi)); return r; }
__device__ __forceinline__ float sigmoidf_fast(float g) { return __builtin_amdgcn_rcpf(1.0f + __builtin_amdgcn_exp2f(-1.44269504089f * g)); }

__device__ __forceinline__ unsigned pk4_fp8(float a, float b, float c, float d) {
    unsigned w = 0u; w = __builtin_amdgcn_cvt_pk_fp8_f32(__builtin_amdgcn_fmed3f(a, -448.f, 448.f), __builtin_amdgcn_fmed3f(b, -448.f, 448.f), w, false);
    return __builtin_amdgcn_cvt_pk_fp8_f32(__builtin_amdgcn_fmed3f(c, -448.f, 448.f), __builtin_amdgcn_fmed3f(d, -448.f, 448.f), w, true); }
struct EpiF32 {
    static constexpr bool PERM = false, AFTER_DRAIN = false;
    float* C; int ldc;
    __device__ __forceinline__ void operator()(const f32x4 (&acc)[2][2][4][2], const Unit& u, int wr, int wc, int fr, int fq) const {
        const int row0 = u.pm * BM + wr * 64 + fr, col0 = u.pn * BM + wc * 32 + 4 * fq;
#pragma unroll
        for (int ai = 0; ai < 2; ++ai)
#pragma unroll
            for (int m = 0; m < 4; ++m) { float* rowp = C + (size_t)(row0 + ai * HALF + m * 16) * ldc + col0;
#pragma unroll
                for (int bj = 0; bj < 2; ++bj)
#pragma unroll
                    for (int n = 0; n < 2; ++n) *(f32x4*)(rowp + bj * HALF + n * 16) = acc[ai][bj][m][n]; }
    }
};
struct EpiBf16 {
    static constexpr bool PERM = true, AFTER_DRAIN = false;
    bf16_t* O; int ldc; float sc;
    __device__ __forceinline__ void operator()(const f32x4 (&acc)[2][2][4][2], const Unit& u, int wr, int wc, int fr, int fq) const {
        const int row0 = u.pm * BM + wr * 64 + fr, col0 = u.pn * BM + wc * 32 + 8 * fq;
#pragma unroll
        for (int ai = 0; ai < 2; ++ai)
#pragma unroll
            for (int m = 0; m < 4; ++m) { bf16_t* rowp = O + (size_t)(row0 + ai * HALF + m * 16) * ldc + col0;
#pragma unroll
                for (int bj = 0; bj < 2; ++bj) { const f32x4 v0 = acc[ai][bj][m][0] * sc, v1 = acc[ai][bj][m][1] * sc;
                    u32x4 w; w.x = cvt_pk_bf16(v0[0], v0[1]); w.y = cvt_pk_bf16(v0[2], v0[3]); w.z = cvt_pk_bf16(v1[0], v1[1]); w.w = cvt_pk_bf16(v1[2], v1[3]);
                    *(u32x4*)(rowp + bj * HALF) = w; } }
    }
};
struct EpiSwiGLU {
    static constexpr bool PERM = true, AFTER_DRAIN = false;
    bf16_t* O; int ldc;
    __device__ __forceinline__ void operator()(const f32x4 (&acc)[2][2][4][2], const Unit& u, int wr, int wc, int fr, int fq) const {
        const int row0 = u.pm * BM + wr * 64 + fr, col0 = u.pn * HALF + wc * 32 + 8 * fq;
#pragma unroll
        for (int ai = 0; ai < 2; ++ai)
#pragma unroll
            for (int m = 0; m < 4; ++m) { bf16_t* rowp = O + (size_t)(row0 + ai * HALF + m * 16) * ldc + col0;
                float o[8];
#pragma unroll
                for (int n = 0; n < 2; ++n)
#pragma unroll
                    for (int j = 0; j < 4; ++j) { const float g = acc[ai][0][m][n][j], up = acc[ai][1][m][n][j]; o[n * 4 + j] = g * sigmoidf_fast(g) * up; }
                u32x4 w; w.x = cvt_pk_bf16(o[0], o[1]); w.y = cvt_pk_bf16(o[2], o[3]); w.z = cvt_pk_bf16(o[4], o[5]); w.w = cvt_pk_bf16(o[6], o[7]);
                *(u32x4*)rowp = w; }
    }
};
struct EpiSwiGLU8 {
    static constexpr bool PERM = true, AFTER_DRAIN = false;
    unsigned char* O; int ldc; float sin, sout;
    __device__ __forceinline__ void operator()(const f32x4 (&acc)[2][2][4][2], const Unit& u, int wr, int wc, int fr, int fq) const {
        const int row0 = u.pm * BM + wr * 64 + fr, col0 = u.pn * HALF + wc * 32 + 8 * fq;
#pragma unroll
        for (int ai = 0; ai < 2; ++ai)
#pragma unroll
            for (int m = 0; m < 4; ++m) { unsigned char* rowp = O + (size_t)(row0 + ai * HALF + m * 16) * ldc + col0;
                float o[8];
#pragma unroll
                for (int n = 0; n < 2; ++n)
#pragma unroll
                    for (int j = 0; j < 4; ++j) { const float g = acc[ai][0][m][n][j] * sin, up = acc[ai][1][m][n][j] * sin; o[n * 4 + j] = g * sigmoidf_fast(g) * up * sout; }
                u32x2 w; w.x = pk4_fp8(o[0], o[1], o[2], o[3]); w.y = pk4_fp8(o[4], o[5], o[6], o[7]);
                *(u32x2*)rowp = w; }
    }
};
struct EpiInProj {
    static constexpr bool PERM = true, AFTER_DRAIN = false;
    bf16_t *Q, *Kb, *V, *U; const float *ropeC, *ropeS; float sc; int pn_off;
    __device__ __forceinline__ void operator()(const f32x4 (&acc)[2][2][4][2], const Unit& u, int wr, int wc, int fr, int fq) const {
        const int row0 = u.pm * BM + wr * 64 + fr, pn = u.pn + pn_off;
        if (pn < 8) {
            bf16_t* base = (pn < 4) ? Q : Kb; const int col0 = (pn & 3) * BM + wc * 32 + 8 * fq, idx0 = 16 * wc + 4 * fq;
#pragma unroll
            for (int ai = 0; ai < 2; ++ai)
#pragma unroll
                for (int m = 0; m < 4; ++m) { const int row = row0 + ai * HALF + m * 16;
                    const f32x4 cs = *(const f32x4*)(ropeC + (size_t)row * 64 + idx0), sn = *(const f32x4*)(ropeS + (size_t)row * 64 + idx0);
#pragma unroll
                    for (int bj = 0; bj < 2; ++bj) { const f32x4 x1 = acc[ai][bj][m][0] * sc, x2 = acc[ai][bj][m][1] * sc;
                        const f32x4 o1 = x1 * cs - x2 * sn, o2 = x2 * cs + x1 * sn;
                        u32x4 w; w.x = cvt_pk_bf16(o1[0], o1[1]); w.y = cvt_pk_bf16(o1[2], o1[3]); w.z = cvt_pk_bf16(o2[0], o2[1]); w.w = cvt_pk_bf16(o2[2], o2[3]);
                        *(u32x4*)(base + (size_t)row * 1024 + col0 + bj * HALF) = w; } }
        } else if (pn < 12) {
            const int col0 = (pn - 8) * BM + wc * 32 + 8 * fq;
#pragma unroll
            for (int ai = 0; ai < 2; ++ai)
#pragma unroll
                for (int m = 0; m < 4; ++m) { bf16_t* rowp = V + (size_t)(row0 + ai * HALF + m * 16) * 1024 + col0;
#pragma unroll
                    for (int bj = 0; bj < 2; ++bj) { const f32x4 v0 = acc[ai][bj][m][0] * sc, v1 = acc[ai][bj][m][1] * sc;
                        u32x4 w; w.x = cvt_pk_bf16(v0[0], v0[1]); w.y = cvt_pk_bf16(v0[2], v0[3]); w.z = cvt_pk_bf16(v1[0], v1[1]); w.w = cvt_pk_bf16(v1[2], v1[3]);
                        *(u32x4*)(rowp + bj * HALF) = w; } }
        } else {
            const int col0 = (pn - 12) * HALF + wc * 32 + 8 * fq;
#pragma unroll
            for (int ai = 0; ai < 2; ++ai)
#pragma unroll
                for (int m = 0; m < 4; ++m) { bf16_t* rowp = U + (size_t)(row0 + ai * HALF + m * 16) * 1024 + col0;
                    float o[8];
#pragma unroll
                    for (int n = 0; n < 2; ++n)
#pragma unroll
                        for (int j = 0; j < 4; ++j) o[n * 4 + j] = acc[ai][0][m][n][j] * sc * sigmoidf_fast(acc[ai][1][m][n][j] * sc);
                    u32x4 w; w.x = cvt_pk_bf16(o[0], o[1]); w.y = cvt_pk_bf16(o[2], o[3]); w.z = cvt_pk_bf16(o[4], o[5]); w.w = cvt_pk_bf16(o[6], o[7]);
                    *(u32x4*)rowp = w; }
        }
    }
};

template <class Epi, class Sched, bool ALIGN_EPI = false, bool SP2 = false, bool FP8 = false>
__device__ __forceinline__ void gemm_phase(PG8_LAS unsigned char* lds, const Gemm g, const Sched& S, const Epi& E, const int wave_in) {
    int lane; asm volatile("v_mbcnt_lo_u32_b32 %0, -1, 0\n\tv_mbcnt_hi_u32_b32 %0, -1, %0" : "=v"(lane));
    const int wid = wave_in, tid = wid * 64 + lane, wr = wid >> 2, wc = wid & 3, fr = lane & 15, fq = lane >> 4;
    const int K = g.K, nt = K / BK;
    unsigned voffA[2], voffB[2];
#pragma unroll
    for (int i = 0; i < 2; ++i) { int R, C; stage_rc(tid * 16 + i * 8192, R, C); const int Rb = Epi::PERM ? ((R & ~31) + perm32(R & 31)) : R;
        voffA[i] = (unsigned)(R * K + C) * 2u; voffB[i] = (unsigned)(Rb * K + C) * 2u; }
    const size_t kstep = (size_t)(BK * 2);
    const size_t hstep = (size_t)HALF * K * 2;
    const size_t tstep = 2 * hstep;
    const unsigned ldsw = (unsigned)wid * 1024u;
    const int aoff = lds_byte(wr * 64 + fr, fq * 8), boff = lds_byte(wc * 32 + fr, fq * 8);
#define PG8_SA(b, h) (((b) * 2 + (h)) * HTB)
#define PG8_SB(b, h) ((4 + (b) * 2 + (h)) * HTB)
#define PG8_STAGE(bufoff, gbase, voff) do { _Pragma("unroll") for (int _i = 0; _i < 2; ++_i) \
        __builtin_amdgcn_global_load_lds((const unsigned*)((const char*)(gbase) + (voff)[_i]), (PG8_LAS unsigned*)(lds + (bufoff) + ldsw + _i * 8192), 16, 0, 0); } while (0)
#define PG8_LDA(dst, b, h) do { if constexpr (FP8) { _Pragma("unroll") for (int m = 0; m < 4; ++m) { const v4i lo_ = *(const PG8_LAS v4i*)(lds + PG8_SA(b, h) + aoff + m * 2048), hi_ = *(const PG8_LAS v4i*)(lds + PG8_SA(b, h) + aoff + m * 2048 + 1024); \
            dst##8[m] = __builtin_shufflevector(lo_, hi_, 0, 1, 2, 3, 4, 5, 6, 7); } } \
        else { _Pragma("unroll") for (int m = 0; m < 4; ++m) _Pragma("unroll") for (int k = 0; k < 2; ++k) dst[m][k] = *(const PG8_LAS bf16x8*)(lds + PG8_SA(b, h) + aoff + m * 2048 + k * 1024); } } while (0)
#define PG8_LDB(dst, b, h) do { if constexpr (FP8) { _Pragma("unroll") for (int n = 0; n < 2; ++n) { const v4i lo_ = *(const PG8_LAS v4i*)(lds + PG8_SB(b, h) + boff + n * 2048), hi_ = *(const PG8_LAS v4i*)(lds + PG8_SB(b, h) + boff + n * 2048 + 1024); \
            dst##8[n] = __builtin_shufflevector(lo_, hi_, 0, 1, 2, 3, 4, 5, 6, 7); } } \
        else { _Pragma("unroll") for (int n = 0; n < 2; ++n) _Pragma("unroll") for (int k = 0; k < 2; ++k) dst[n][k] = *(const PG8_LAS bf16x8*)(lds + PG8_SB(b, h) + boff + n * 2048 + k * 1024); } } while (0)
#define PG8_MMA(ai, bj, At, Bt) do { __builtin_amdgcn_s_setprio(1); \
        if constexpr (FP8) {   \
            _Pragma("unroll") for (int m = 0; m < 4; ++m) _Pragma("unroll") for (int n = 0; n < 2; ++n) \
                asm volatile("v_mfma_f32_16x16x128_f8f6f4 %0, %1, %2, %0" : "+v"(acc[ai][bj][m][n]) : "v"(Bt##8[n]), "v"(At##8[m]));   \
        } else { _Pragma("unroll") for (int m = 0; m < 4; ++m) _Pragma("unroll") for (int n = 0; n < 2; ++n) _Pragma("unroll") for (int k = 0; k < 2; ++k) \
            acc[ai][bj][m][n] = __builtin_amdgcn_mfma_f32_16x16x32_bf16(Bt[n][k], At[m][k], acc[ai][bj][m][n], 0, 0, 0); } \
        __builtin_amdgcn_s_setprio(0); } while (0)
#define PG8_WAIT_V(n) asm volatile("s_waitcnt vmcnt(" #n ")" ::: "memory")
#define PG8_WAIT_L(n) asm volatile("s_waitcnt lgkmcnt(" #n ")" ::: "memory")
#define PG8_BAR __builtin_amdgcn_s_barrier()
#define PG8_SCHED __builtin_amdgcn_sched_barrier(0)
    Unit cur, nxt; int ui = 0;
    if (!S.next(0, cur)) return;
    f32x4 acc[2][2][4][2];
#pragma unroll
    for (int a = 0; a < 2; ++a)
#pragma unroll
        for (int b = 0; b < 2; ++b)
#pragma unroll
            for (int m = 0; m < 4; ++m)
#pragma unroll
                for (int n = 0; n < 2; ++n) acc[a][b][m][n] = (f32x4){0.f, 0.f, 0.f, 0.f};
    bf16x8 At[4][2], B0[2][2], B1[2][2]; v8i At8[4], B08[2], B18[2];
    const char* cA = (const char*)g.A + (size_t)cur.pm * tstep; const char* cB = (const char*)g.Bt + (size_t)cur.e * g.bstride + (size_t)cur.pn * tstep;
    S.a_ready(cur);
    if constexpr (SP2) {
        PG8_STAGE(PG8_SB(0, 0), cB, voffB); PG8_STAGE(PG8_SB(0, 1), cB + hstep, voffB); PG8_STAGE(PG8_SA(0, 0), cA, voffA); PG8_STAGE(PG8_SA(0, 1), cA + hstep, voffA);
        if (wr == 1) PG8_BAR;
        PG8_WAIT_V(2); PG8_BAR;
        PG8_STAGE(PG8_SB(1, 0), cB + kstep, voffB); PG8_STAGE(PG8_SA(1, 0), cA + kstep, voffA); PG8_STAGE(PG8_SB(1, 1), cB + hstep + kstep, voffB);
        PG8_WAIT_V(6); PG8_BAR;
    } else {
        PG8_STAGE(PG8_SB(0, 0), cB, voffB); PG8_STAGE(PG8_SA(0, 0), cA, voffA); PG8_STAGE(PG8_SB(0, 1), cB + hstep, voffB); PG8_STAGE(PG8_SA(0, 1), cA + hstep, voffA);
        if (wr == 1) PG8_BAR;
        PG8_WAIT_V(4); PG8_BAR;
        PG8_STAGE(PG8_SB(1, 0), cB + kstep, voffB); PG8_STAGE(PG8_SA(1, 0), cA + kstep, voffA); PG8_STAGE(PG8_SB(1, 1), cB + hstep + kstep, voffB);
        PG8_WAIT_V(6); PG8_BAR;
    }
    for (;;) {
        const bool has_next = S.next(ui + 1, nxt);
        const char* nA = has_next ? (const char*)g.A + (size_t)nxt.pm * tstep : cA; const char* nB = has_next ? (const char*)g.Bt + (size_t)nxt.e * g.bstride + (size_t)nxt.pn * tstep : cB;
        for (int t = 0; t < nt; t += 2) {
            const bool last = (t == nt - 2);
            const char* a1 = cA + (size_t)(t + 1) * kstep;
            const char* a2 = last ? nA : cA + (size_t)(t + 2) * kstep; const char* b2 = last ? nB : cB + (size_t)(t + 2) * kstep;
            const char* a3 = a2 + kstep; const char* b3 = b2 + kstep;
            if (last && has_next) S.a_ready(nxt);
            if constexpr (SP2) {
            PG8_LDB(B0, 0, 0); PG8_LDB(B1, 0, 1); PG8_SCHED; PG8_LDA(At, 0, 0); PG8_STAGE(PG8_SA(1, 1), a1 + hstep, voffA);
            PG8_WAIT_V(8); PG8_WAIT_L(0); PG8_BAR; PG8_MMA(0, 0, At, B0); PG8_MMA(0, 1, At, B1); PG8_BAR; PG8_SCHED;
            PG8_LDA(At, 0, 1); PG8_STAGE(PG8_SB(0, 0), b2, voffB); PG8_STAGE(PG8_SB(0, 1), b2 + hstep, voffB); PG8_STAGE(PG8_SA(0, 0), a2, voffA);
            PG8_WAIT_V(8); PG8_WAIT_L(0); PG8_BAR; PG8_MMA(1, 0, At, B0); PG8_MMA(1, 1, At, B1); PG8_BAR; PG8_SCHED;
            PG8_LDB(B0, 1, 0); PG8_LDB(B1, 1, 1); PG8_SCHED; PG8_LDA(At, 1, 0); PG8_STAGE(PG8_SA(0, 1), a2 + hstep, voffA);
            PG8_WAIT_V(8); PG8_WAIT_L(0); PG8_BAR; PG8_MMA(0, 0, At, B0); PG8_MMA(0, 1, At, B1); PG8_BAR; PG8_SCHED;
            PG8_LDA(At, 1, 1); PG8_STAGE(PG8_SB(1, 0), b3, voffB); PG8_STAGE(PG8_SB(1, 1), b3 + hstep, voffB); PG8_STAGE(PG8_SA(1, 0), a3, voffA);
            PG8_WAIT_V(8); PG8_WAIT_L(0); PG8_BAR; PG8_MMA(1, 0, At, B0); PG8_MMA(1, 1, At, B1); PG8_BAR; PG8_SCHED;
            } else {
            PG8_LDB(B0, 0, 0); PG8_SCHED; PG8_LDA(At, 0, 0); PG8_STAGE(PG8_SA(1, 1), a1 + hstep, voffA);
            PG8_WAIT_L(8); PG8_BAR; PG8_WAIT_L(0); PG8_MMA(0, 0, At, B0); PG8_BAR; PG8_SCHED;
            PG8_LDB(B1, 0, 1); PG8_STAGE(PG8_SB(0, 0), b2, voffB);
            PG8_BAR; PG8_WAIT_L(0); PG8_MMA(0, 1, At, B1); PG8_BAR;
            PG8_LDA(At, 0, 1); PG8_STAGE(PG8_SA(0, 0), a2, voffA);
            PG8_BAR; PG8_WAIT_L(0); PG8_MMA(1, 0, At, B0); PG8_BAR; PG8_SCHED;
            PG8_STAGE(PG8_SB(0, 1), b2 + hstep, voffB);
            PG8_WAIT_V(6); PG8_BAR; PG8_MMA(1, 1, At, B1); PG8_BAR;
            PG8_LDB(B0, 1, 0); PG8_SCHED; PG8_LDA(At, 1, 0); PG8_STAGE(PG8_SA(0, 1), a2 + hstep, voffA);
            PG8_WAIT_L(8); PG8_BAR; PG8_WAIT_L(0); PG8_MMA(0, 0, At, B0); PG8_BAR; PG8_SCHED;
            PG8_LDB(B1, 1, 1); PG8_STAGE(PG8_SB(1, 0), b3, voffB);
            PG8_BAR; PG8_WAIT_L(0); PG8_MMA(0, 1, At, B1); PG8_BAR;
            PG8_LDA(At, 1, 1); PG8_STAGE(PG8_SA(1, 0), a3, voffA);
            PG8_BAR; PG8_WAIT_L(0); PG8_MMA(1, 0, At, B0); PG8_BAR; PG8_SCHED;
            PG8_STAGE(PG8_SB(1, 1), b3 + hstep, voffB);
            PG8_WAIT_V(6); PG8_BAR; PG8_MMA(1, 1, At, B1); PG8_BAR;
            }
        }
        if constexpr (FP8) asm volatile("s_nop 15\n\ts_nop 15" ::: "memory");
        if constexpr (ALIGN_EPI) { if (wr == 0) PG8_BAR; }
        if constexpr (!Epi::AFTER_DRAIN) { E(acc, cur, wr, wc, fr, fq); S.done(cur); }
        if (!has_next) break;
#pragma unroll
        for (int a = 0; a < 2; ++a)
#pragma unroll
            for (int b = 0; b < 2; ++b)
#pragma unroll
                for (int m = 0; m < 4; ++m)
#pragma unroll
                    for (int n = 0; n < 2; ++n) acc[a][b][m][n] = (f32x4){0.f, 0.f, 0.f, 0.f};
        cur = nxt; cA = nA; cB = nB; ++ui;
        if constexpr (ALIGN_EPI) { if (wr == 1) PG8_BAR; }
    }
    PG8_WAIT_V(0);
    if constexpr (!ALIGN_EPI) { if (wr == 0) PG8_BAR; }
    PG8_BAR;
    if constexpr (Epi::AFTER_DRAIN) { E.fused(acc, cur, wr, wc, fr, fq, lds, wid, lane); S.done(cur); }
#undef PG8_SA
#undef PG8_SB
#undef PG8_STAGE
#undef PG8_LDA
#undef PG8_LDB
#undef PG8_MMA
#undef PG8_WAIT_V
#undef PG8_WAIT_L
#undef PG8_BAR
#undef PG8_SCHED
}
}

constexpr int NWAVES = 8;
constexpr int S = 16384, DM = 2048, NPROJ = 5120, AW = 1024, HD = 128, NH = 8, DFF = 5632, NE = 8, CKW = 31, NBLK = 64;
constexpr float LN_EPS = 1e-5f, ALPHA = 1.41421356237309515f;
constexpr int MOE_ROWS = 2 * S + NE * 256;
constexpr float WSC_GU = 32.f, WSC_D = 128.f, ASC_H = 4.f, ASC_ACT = 8.f, WSC_O = 64.f, ASC_CAT = 16.f;

constexpr size_t MiB = 1u << 20;
constexpr size_t WS_CTL = 0, CTL_ZERO_BYTES = 1 * MiB;
constexpr size_t WS_ROPEC = 1 * MiB, WS_ROPES = 5 * MiB;
constexpr size_t WS_KMEAN = 9 * MiB;
constexpr size_t WS_EIDX = 9 * MiB + 512 * 1024, WS_GATEW = WS_EIDX + 128 * 1024, WS_ROWPOS = WS_GATEW + 128 * 1024;
constexpr size_t WS_WIN = 10 * MiB, WS_WOUT = 50 * MiB, WS_WGU0 = 66 * MiB, WS_WD0 = 110 * MiB, WS_WGUE = 132 * MiB, WS_WDE = 484 * MiB;
constexpr size_t WS_HB = 660 * MiB;
constexpr size_t WS_R2 = 724 * MiB;
constexpr size_t WS_HB8 = 860 * MiB + 72 * MiB;
constexpr size_t WS_HBP = 860 * MiB;
constexpr size_t WS_R1 = 996 * MiB;
constexpr size_t WS_Q = WS_R1, WS_K = WS_R1 + 32 * MiB, WS_V = WS_R1 + 64 * MiB, WS_U = WS_R1 + 96 * MiB, WS_CAT = WS_R1 + 128 * MiB, WS_ACT = WS_R1;
constexpr size_t WS_VT = WS_R1 + 192 * MiB, WS_PO = WS_R1 + 224 * MiB, WS_PML = WS_R1 + 320 * MiB, WS_LIST = WS_R1 + 324 * MiB;
constexpr size_t WS_END = 1370 * MiB;
static_assert(WS_R1 + (size_t)MOE_ROWS * DFF * 2 <= WS_END && WS_HBP + (size_t)MOE_ROWS * DM * 2 <= WS_R1 && WS_R2 + (size_t)MOE_ROWS * DM * 2 <= WS_HBP, "d_ws map");
static_assert(WS_WDE + (size_t)NE * DM * DFF * 2 <= WS_HB && WS_WGUE + (size_t)NE * 2 * DFF * DM * 2 <= WS_WDE, "d_ws weights map");
constexpr int CW_TMO = 0, CW_CODE = 1, CW_BAR = 4096, CW_ECNT = 8192, CW_ECUR = 8192 + 64 * 8, CW_LCNT = 12288;
constexpr int RING_OFF = 0, RING_BYTES = 131072;
constexpr int LDSCTL_OFF = 139264, MISC_OFF = LDSCTL_OFF + 320;
constexpr int LDS_BYTES = 147456;

__device__ const float INV_FREQ[64] = {
1.000000000e+00f, 8.659643531e-01f, 7.498942018e-01f, 6.493816376e-01f, 5.623413324e-01f, 4.869675338e-01f, 4.216965139e-01f, 3.651741147e-01f, 3.162277639e-01f, 2.738419771e-01f, 2.371373773e-01f, 2.053525001e-01f, 1.778279394e-01f, 1.539926529e-01f, 1.333521456e-01f, 1.154781953e-01f, 1.000000015e-01f, 8.659642935e-02f, 7.498942316e-02f, 6.493816525e-02f, 5.623413250e-02f, 4.869675264e-02f, 4.216964915e-02f, 3.651741147e-02f, 3.162277490e-02f, 2.738419548e-02f, 2.371373773e-02f, 2.053525113e-02f, 1.778279431e-02f, 1.539926510e-02f, 1.333521400e-02f, 1.154781971e-02f, 9.999999776e-03f, 8.659643121e-03f, 7.498942316e-03f, 6.493816152e-03f, 5.623413250e-03f, 4.869675264e-03f, 4.216964822e-03f, 3.651741194e-03f, 3.162277630e-03f, 2.738419687e-03f, 2.371373819e-03f, 2.053525066e-03f, 1.778279431e-03f, 1.539926510e-03f, 1.333521446e-03f, 1.154782018e-03f, 1.000000047e-03f, 8.659643354e-04f, 7.498941850e-04f, 6.493816036e-04f, 5.623413017e-04f, 4.869675322e-04f, 4.216965172e-04f, 3.651741135e-04f, 3.162277571e-04f, 2.738419571e-04f, 2.371373703e-04f, 2.053525095e-04f, 1.778279402e-04f, 1.539926598e-04f, 1.333521504e-04f, 1.154782003e-04f
};

#define GAS __attribute__((address_space(1)))
#define LAS __attribute__((address_space(3)))
typedef unsigned short bf16;
typedef unsigned v4u __attribute__((ext_vector_type(4)));
typedef unsigned v2u __attribute__((ext_vector_type(2)));
typedef float f32x4 __attribute__((ext_vector_type(4)));
typedef float f32x2 __attribute__((ext_vector_type(2)));
typedef short bf16x8 __attribute__((ext_vector_type(8)));
typedef GAS unsigned gu32;
typedef GAS unsigned long long gu64;
#define RLX_AGENT __ATOMIC_RELAXED, __HIP_MEMORY_SCOPE_AGENT
#define LDS_WAIT() asm volatile("s_waitcnt lgkmcnt(0)" ::: "memory")
#define VM_WAIT() asm volatile("s_waitcnt vmcnt(0)" ::: "memory")
__device__ __forceinline__ unsigned f2bf(float f) { unsigned u = __builtin_bit_cast(unsigned, f); return (u + 0x7fffu + ((u >> 16) & 1u)) >> 16; }
__device__ __forceinline__ unsigned pk2(float lo, float hi) { return f2bf(lo) | (f2bf(hi) << 16); }
__device__ __forceinline__ float bflo(unsigned w) { return __builtin_bit_cast(float, w << 16); }
__device__ __forceinline__ float bfhi(unsigned w) { return __builtin_bit_cast(float, w & 0xffff0000u); }

#define XB_TMO      128
#define XB_XCNT(j)  (256  + 64 * (j))
#define XB_XSUB(j)  (1280 + 64 * (j))
#define XB_XGEN(j)  (2304 + 64 * (j))
#define XB_TOP      3328
#define XB_TOPGEN   3392
#define XCD_BAR_WORDS 3456
#define XB_SPIN_CAP (1u << 22)

__device__ __forceinline__ unsigned xb_ld(unsigned* p)              { return __hip_atomic_load(p, __ATOMIC_RELAXED, __HIP_MEMORY_SCOPE_AGENT); }
__device__ __forceinline__ unsigned xb_add(unsigned* p, unsigned v) { return __hip_atomic_fetch_add(p, v, __ATOMIC_RELAXED, __HIP_MEMORY_SCOPE_AGENT); }
__device__ __forceinline__ unsigned xb_xcc_id() { return (unsigned)__builtin_amdgcn_s_getreg((3 << 11) | 20) & 0xFu; }
#define XB_SPIN(cond, bar) do { unsigned _sp = 0; while (cond) { __builtin_amdgcn_s_sleep(1); \
    if ((++_sp & 255u) == 0u) { if (xb_ld(&(bar)[XB_TMO])) break; if (_sp > XB_SPIN_CAP) { atomicAdd(&(bar)[XB_TMO], 1u); break; } } } } while (0)

__device__ __forceinline__ int lane_now() { int l; asm volatile("v_mbcnt_lo_u32_b32 %0, -1, 0\n\tv_mbcnt_hi_u32_b32 %0, -1, %0" : "=v"(l)); return l; }
#define XB_T0() (b.w0 == 0 && lane_now() == 0)
struct XcdBarrier {
    unsigned* bar; unsigned x; int w0;
    volatile LAS unsigned* st;
};

__device__ __forceinline__ XcdBarrier xcd_barrier_post(unsigned* bar, volatile LAS unsigned* st, int w0) {
    XcdBarrier b; b.bar = bar; b.x = xb_xcc_id(); b.st = st; b.w0 = w0;
    if (XB_T0()) (void)xb_add(&bar[XB_XCNT(b.x)], 1u);
    return b;
}
__device__ __forceinline__ void xcd_barrier_complete(unsigned* bar, unsigned x, unsigned& nloc, unsigned& nx) {
    const unsigned G = gridDim.x * gridDim.y * gridDim.z;
    unsigned sum, cnt, mine, sp = 0u;
    for (;;) {
        sum = 0u; cnt = 0u; mine = 0u;
#pragma unroll
        for (unsigned j = 0; j < 16; ++j) { const unsigned c = xb_ld(&bar[XB_XCNT(j)]); sum += c; cnt += (c > 0u) ? 1u : 0u; mine = (j == x) ? c : mine; }
        if (sum == G) break;
        __builtin_amdgcn_s_sleep(1);
        if ((++sp & 255u) == 0u) { if (xb_ld(&bar[XB_TMO])) break; if (sp > XB_SPIN_CAP) { atomicAdd(&bar[XB_TMO], 1u); break; } }
    }
    nloc = mine > 0u ? mine : 1u; nx = cnt > 0u ? cnt : 1u;
}

__device__ __forceinline__ void xcd_barrier(const XcdBarrier& b) {
    asm volatile("s_waitcnt vmcnt(0)" ::: "memory");
    __syncthreads();
    if (XB_T0()) {
        unsigned* bar = b.bar;
        __builtin_amdgcn_s_waitcnt(0);
        unsigned nloc = b.st[0], nx = b.st[1];
        if (nloc == 0u) { xcd_barrier_complete(bar, b.x, nloc, nx); b.st[0] = nloc; b.st[1] = nx; }
        const unsigned old = xb_add(&bar[XB_XSUB(b.x)], 1u);
        const unsigned gen = old / nloc;
        if (old + 1u == (gen + 1u) * nloc) {
            __builtin_amdgcn_fence(__ATOMIC_RELEASE, "agent");
            asm volatile("s_waitcnt vmcnt(0)" ::: "memory");
            const unsigned og = xb_add(&bar[XB_TOP], 1u);
            const unsigned tg = og / nx;
            if (og + 1u == (tg + 1u) * nx) xb_add(&bar[XB_TOPGEN], 1u);
            else XB_SPIN(xb_ld(&bar[XB_TOPGEN]) == tg, bar);
            __builtin_amdgcn_fence(__ATOMIC_ACQUIRE, "agent");
            xb_add(&bar[XB_XGEN(b.x)], 1u);
            asm volatile("s_waitcnt vmcnt(0)" ::: "memory");
        } else {
            XB_SPIN(xb_ld(&bar[XB_XGEN(b.x)]) == gen, bar);
            __builtin_amdgcn_fence(__ATOMIC_ACQUIRE, "agent");
            asm volatile("s_waitcnt vmcnt(0)" ::: "memory");
        }
    }
    __syncthreads();
}


struct Frame {
    LAS unsigned char* lds;
    volatile LAS unsigned* MISC;
    gu32* ctl;
    int wave;
    int vcu, G;
    const float* x; float* out;
    const float *w_in, *conv_w, *conv_b, *conv_g, *conv_be, *w_out, *lnm_g, *lnm_b, *lnf_g, *lnf_b, *fg, *fu, *fd, *router, *eg, *eu, *ed;
    unsigned char* ws;
};
__device__ __forceinline__ int shx_i(int v, int m, int lane) { return __builtin_amdgcn_ds_bpermute((lane ^ m) << 2, v); }
__device__ __forceinline__ float shx(float v, int m, int lane) { return __builtin_bit_cast(float, __builtin_amdgcn_ds_bpermute((lane ^ m) << 2, __builtin_bit_cast(int, v))); }
__device__ __forceinline__ int shl_i(int v, int src) { return __builtin_amdgcn_ds_bpermute(src << 2, v); }
__device__ __forceinline__ float wave_sum(float v, int lane) {
#pragma unroll
    for (int o = 1; o < 64; o <<= 1) v += shx(v, o, lane);
    return v;
}
__device__ __forceinline__ int wmap(int kind, int c) {
    if (kind == 0) return c;
    if (kind == 1) {
        if (c < 2048) { const int hh = c >> 7, w = c & 127, n = w >> 6, idx = w & 63; return hh * 128 + 32 * (idx >> 4) + 8 * ((idx >> 2) & 3) + 4 * n + (idx & 3); }
        if (c < 3072) return c;
        if (c < 4096) { const int j = c - 3072; return 3072 + 256 * (j >> 7) + (j & 127); }
        const int j = c - 4096; return 3072 + 256 * (j >> 7) + 128 + (j & 127);
    }
    return 256 * (c >> 7) + (kind == 3 ? 128 : 0) + (c & 127);
}
__device__ __forceinline__ void p0_transpose_item(const float* Wg, int K, int N, bf16* WT, int kind, LAS float* scr, int item, int lane) {
    const GAS float* W = (const GAS float*)Wg;
    const int nblk = N / 32, kb = item / nblk, nb = item % nblk, k0 = 64 * kb, n0 = 32 * nb;
    float wv[32];
#pragma unroll
    for (int i = 0; i < 32; ++i) wv[i] = W[(size_t)(k0 + 2 * i + (lane >> 5)) * N + n0 + (lane & 31)];
#pragma unroll
    for (int i = 0; i < 32; ++i) scr[(2 * i + (lane >> 5)) * 33 + (lane & 31)] = wv[i];
    LDS_WAIT(); asm volatile("" ::: "memory");
    const int c = lane & 7;
#pragma unroll
    for (int j = 0; j < 4; ++j) { const int n = (lane >> 3) + 8 * j; const LAS float* s = scr + (8 * c) * 33 + n;
        v4u o; o.x = pk2(s[0 * 33], s[1 * 33]); o.y = pk2(s[2 * 33], s[3 * 33]); o.z = pk2(s[4 * 33], s[5 * 33]); o.w = pk2(s[6 * 33], s[7 * 33]);
        *(GAS v4u*)(WT + (size_t)wmap(kind, n0 + n) * K + k0 + 8 * c) = o; }
    LDS_WAIT(); asm volatile("" ::: "memory");
}
__device__ __forceinline__ void sincos_acc(float ang, float& sn, float& cs) {
    const double x = (double)ang, k = __builtin_rint(x * 0.63661977236758134308);
    double r = __builtin_fma(-k, 1.57079632679489655800e+00, x); r = __builtin_fma(-k, 6.12323399573676603587e-17, r);
    const int q = ((int)k) & 3; const double r2 = r * r;
    double sp = 1.0 / 6227020800.0; sp = sp * r2 - 1.0 / 39916800.0; sp = sp * r2 + 1.0 / 362880.0; sp = sp * r2 - 1.0 / 5040.0; sp = sp * r2 + 1.0 / 120.0; sp = sp * r2 - 1.0 / 6.0;
    const double s = r + r * r2 * sp;
    double cp = -1.0 / 87178291200.0; cp = cp * r2 + 1.0 / 479001600.0; cp = cp * r2 - 1.0 / 3628800.0; cp = cp * r2 + 1.0 / 40320.0; cp = cp * r2 - 1.0 / 720.0; cp = cp * r2 + 1.0 / 24.0; cp = cp * r2 - 0.5;
    const double c = 1.0 + r2 * cp;
    const double ss = (q & 1) ? c : s, cc = (q & 1) ? s : c;
    sn = (float)((q & 2) ? -ss : ss); cs = (float)(((q + 1) & 2) ? -cc : cc);
}
__device__ __forceinline__ void p0_transpose_item8(const float* Wg, int K, int N, unsigned char* WT, int kind, float wscale, LAS float* scr, int item, int lane) {
    const GAS float* W = (const GAS float*)Wg;
    const int nblk = N / 32, kb = item / nblk, nb = item % nblk, k0 = 64 * kb, n0 = 32 * nb;
    float wv[32];
#pragma unroll
    for (int i = 0; i < 32; ++i) wv[i] = W[(size_t)(k0 + 2 * i + (lane >> 5)) * N + n0 + (lane & 31)];
#pragma unroll
    for (int i = 0; i < 32; ++i) scr[(2 * i + (lane >> 5)) * 33 + (lane & 31)] = wv[i] * wscale;
    LDS_WAIT(); asm volatile("" ::: "memory");
    const int c = lane & 7;
#pragma unroll
    for (int j = 0; j < 4; ++j) { const int n = (lane >> 3) + 8 * j; const LAS float* sp = scr + (8 * c) * 33 + n;
        v2u o; o.x = pg8::pk4_fp8(sp[0 * 33], sp[1 * 33], sp[2 * 33], sp[3 * 33]); o.y = pg8::pk4_fp8(sp[4 * 33], sp[5 * 33], sp[6 * 33], sp[7 * 33]);
        *(GAS v2u*)(WT + (size_t)wmap(kind, n0 + n) * K + k0 + 8 * c) = o; }
    LDS_WAIT(); asm volatile("" ::: "memory");
}
__device__ __forceinline__ void p0_transpose_stack8(Frame& F, const float* src, int K, int N, int nmat, unsigned char* dst, size_t dst_stride, int kind, float wscale) {
    LAS float* scr = (LAS float*)(F.lds + RING_OFF + F.wave * 16384);
    const int gw = F.vcu * NWAVES + F.wave, NGW = F.G * NWAVES, per = (K / 64) * (N / 32), total = per * nmat, lane = lane_now();
#pragma clang loop unroll(disable)
    for (int it = gw; it < total; it += NGW) { const int m = it / per, r = it - m * per;
        p0_transpose_item8(src + (size_t)m * K * N, K, N, dst + (size_t)m * dst_stride, kind, wscale, scr, r, lane); }
}
__device__ __forceinline__ void p0_stack(Frame& F, const float* src, int K, int N, int nmat, unsigned char* dst, size_t dst_stride_bytes, int kind, bool fp8, float wscale, int n_lo = 0, int n_cnt = 0, int drow_off = 0) {
    LAS float* t = (LAS float*)(F.lds + RING_OFF);
    const int tid = F.wave * 64 + lane_now(), ntn = (n_cnt ? n_cnt : N) / 256, per = (K / 128) * ntn, total = per * nmat;
    f32x4 raw[16];
    int it = blockIdx.x;
    if (it < total) { const int m = it / per, r = it - m * per, k0 = (r / ntn) * 128, n0 = n_lo + (r % ntn) * 256; const GAS f32x4* W = (const GAS f32x4*)(src + (size_t)m * K * N + (size_t)k0 * N + n0);
#pragma unroll
        for (int i = 0; i < 16; ++i) { const int p = tid + 512 * i; raw[i] = W[(size_t)(p >> 6) * (N / 4) + (p & 63)]; } }
#pragma clang loop unroll(disable)
    for (; it < total; it += F.G) { const int m = it / per, r = it - m * per, k0 = (r / ntn) * 128, n0 = n_lo + (r % ntn) * 256;
        const int tid2 = F.wave * 64 + lane_now();
#pragma unroll
        for (int i = 0; i < 16; ++i) { const int p = tid2 + 512 * i; LAS float* d = t + (p >> 6) * 257 + (p & 63) * 4; d[0] = raw[i][0] * wscale; d[1] = raw[i][1] * wscale; d[2] = raw[i][2] * wscale; d[3] = raw[i][3] * wscale; }
        __syncthreads();
        { const int nx = it + F.G; if (nx < total) { const int m2 = nx / per, r2 = nx - m2 * per, k2 = (r2 / ntn) * 128, n2 = n_lo + (r2 % ntn) * 256; const GAS f32x4* W = (const GAS f32x4*)(src + (size_t)m2 * K * N + (size_t)k2 * N + n2);
#pragma unroll
            for (int i = 0; i < 16; ++i) { const int p = tid2 + 512 * i; raw[i] = W[(size_t)(p >> 6) * (N / 4) + (p & 63)]; } } }
        unsigned char* drow = dst + (size_t)m * dst_stride_bytes;
#pragma unroll
        for (int q = 0; q < 8; ++q) { const int cid = tid2 + 512 * q, nrow = cid >> 4, kc = cid & 15; const LAS float* sp = t + (8 * kc) * 257 + nrow;
            const float e0 = sp[0], e1 = sp[257], e2 = sp[2 * 257], e3 = sp[3 * 257], e4 = sp[4 * 257], e5 = sp[5 * 257], e6 = sp[6 * 257], e7 = sp[7 * 257];
            const size_t drw = (size_t)(wmap(kind, n0 + nrow) - drow_off) * K + k0 + 8 * kc;
            if (fp8) { v2u o; o.x = pg8::pk4_fp8(e0, e1, e2, e3); o.y = pg8::pk4_fp8(e4, e5, e6, e7); *(GAS v2u*)(drow + drw) = o; }
            else { v4u o; o.x = pk2(e0, e1); o.y = pk2(e2, e3); o.z = pk2(e4, e5); o.w = pk2(e6, e7); *(GAS v4u*)(drow + drw * 2) = o; } }
        __syncthreads();
    }
}
__device__ __forceinline__ void p0_prologue(Frame& F) {
    p0_stack(F, F.w_in, DM, NPROJ, 2, F.ws + WS_WIN, (size_t)20 * MiB, 1, true, WSC_GU, 0, 3072, 0);
    p0_stack(F, F.w_in, DM, NPROJ, 2, F.ws + WS_WIN + 8 * MiB, (size_t)20 * MiB, 1, false, 1.f, 3072, 2048, 3072);
    p0_stack(F, F.w_out, DM, DM, 2, F.ws + WS_WOUT, (size_t)DM * DM, 0, true, WSC_O);
    p0_stack(F, F.fg, DM, DFF, 1, F.ws + WS_WGU0, 0, 2, false, 1.f);
    p0_stack(F, F.fu, DM, DFF, 1, F.ws + WS_WGU0, 0, 3, false, 1.f);
    p0_stack(F, F.fd, DFF, DM, 1, F.ws + WS_WD0, 0, 0, false, 1.f);
    p0_stack(F, F.eg, DM, DFF, NE, F.ws + WS_WGUE, (size_t)2 * DFF * DM, 2, true, WSC_GU);
    p0_stack(F, F.eu, DM, DFF, NE, F.ws + WS_WGUE, (size_t)2 * DFF * DM, 3, true, WSC_GU);
    p0_stack(F, F.ed, DFF, DM, NE, F.ws + WS_WDE, (size_t)DM * DFF, 0, true, WSC_D);
    { GAS float* rc = (GAS float*)(F.ws + WS_ROPEC); GAS float* rs = (GAS float*)(F.ws + WS_ROPES);
#pragma clang loop unroll(disable)
      for (int i = (F.vcu * NWAVES + F.wave) * 64 + lane_now(); i < S * 64; i += F.G * NWAVES * 64) { const int t = i >> 6, f = i & 63; const float ang = (float)t * INV_FREQ[f]; float sn, cs; sincos_acc(ang, sn, cs); rc[i] = cs; rs[i] = sn; } }
    { const GAS f32x4* xs = (const GAS f32x4*)F.x; GAS v4u* hb = (GAS v4u*)(F.ws + WS_HB);
#pragma clang loop unroll(disable)
      for (int i = (F.vcu * NWAVES + F.wave) * 64 + lane_now(); i < S * DM / 8; i += F.G * NWAVES * 64) { const f32x4 a = xs[2 * i], b = xs[2 * i + 1]; v4u o; o.x = pk2(a[0], a[1]); o.y = pk2(a[2], a[3]); o.z = pk2(b[0], b[1]); o.w = pk2(b[2], b[3]); hb[i] = o;
          ((GAS v2u*)(F.ws + WS_HB8))[i] = (v2u){pg8::pk4_fp8(a[0] * ASC_H, a[1] * ASC_H, a[2] * ASC_H, a[3] * ASC_H), pg8::pk4_fp8(b[0] * ASC_H, b[1] * ASC_H, b[2] * ASC_H, b[3] * ASC_H)}; } }
}

__device__ __forceinline__ void kmean_phase(Frame& F) {
    const int lane = lane_now(), c8 = lane & 15, rg = lane >> 4;
    const int unit = F.wave * F.G + (int)blockIdx.x;
    if (unit < NH * NBLK) { const int j = unit & 63, h = unit >> 6;
        const GAS v4u* kp = (const GAS v4u*)(F.ws + WS_K) + ((size_t)(j * 256 + rg) * 1024 + h * 128) / 8 + c8;
        float a[8];
#pragma unroll
        for (int i = 0; i < 8; ++i) a[i] = 0.f;
#pragma unroll 16
        for (int it = 0; it < 64; ++it) { const v4u w = kp[(size_t)it * 4 * 128];
            a[0] += bflo(w.x); a[1] += bfhi(w.x); a[2] += bflo(w.y); a[3] += bfhi(w.y); a[4] += bflo(w.z); a[5] += bfhi(w.z); a[6] += bflo(w.w); a[7] += bfhi(w.w); }
#pragma unroll
        for (int i = 0; i < 8; ++i) { a[i] += shx(a[i], 16, lane); a[i] += shx(a[i], 32, lane); a[i] *= (1.f / 256.f); }
        if (rg == 0) { v4u hi, lo;
            hi.x = pk2(a[0], a[1]); hi.y = pk2(a[2], a[3]); hi.z = pk2(a[4], a[5]); hi.w = pk2(a[6], a[7]);
            lo.x = pk2(a[0] - bflo(hi.x), a[1] - bfhi(hi.x)); lo.y = pk2(a[2] - bflo(hi.y), a[3] - bfhi(hi.y)); lo.z = pk2(a[4] - bflo(hi.z), a[5] - bfhi(hi.z)); lo.w = pk2(a[6] - bflo(hi.w), a[7] - bfhi(hi.w));
            GAS v4u* kh = (GAS v4u*)(F.ws + WS_KMEAN) + ((size_t)(h * 64 + j) * 128) / 8 + c8;
            kh[0] = hi; kh[NH * NBLK * HD / 8] = lo; } }
}
__device__ __forceinline__ void vt_phase(Frame& F) {
    const int gw = F.vcu * NWAVES + F.wave, NGW = F.G * NWAVES, lane = lane_now();
    LAS unsigned char* tile = F.lds + RING_OFF + F.wave * 8704;
    constexpr int NU = (S / 32) * NH;
    v4u raw[2][8];
#pragma unroll
    for (int k = 0; k < 2; ++k) { const int unit = gw + k * NGW; if (unit < NU) { const int h = unit & 7, kb = (unit >> 3) * 32;
            const GAS v4u* src = (const GAS v4u*)(F.ws + WS_V) + ((size_t)kb * 1024 + h * 128) / 8;
#pragma unroll
            for (int i = 0; i < 8; ++i) raw[k][i] = src[(size_t)(i * 4 + (lane >> 4)) * 128 + (lane & 15)]; } }
#pragma unroll
    for (int k = 0; k < 2; ++k) { const int unit = gw + k * NGW; if (unit < NU) { const int h = unit & 7, kb = (unit >> 3) * 32;
#pragma unroll
            for (int i = 0; i < 8; ++i) *(LAS v4u*)(tile + (i * 4 + (lane >> 4)) * 272 + (lane & 15) * 16) = raw[k][i];
            LDS_WAIT(); asm volatile("" ::: "memory");
            const int ch = lane & 3, G = ch >> 1, g = ch & 1;
#pragma unroll
            for (int i = 0; i < 8; ++i) { const int d = i * 16 + (lane >> 2);
                unsigned short e[8];
#pragma unroll
                for (int p = 0; p < 8; ++p) { const int key = 16 * G + 8 * (p >> 2) + 4 * g + (p & 3); e[p] = *(const LAS unsigned short*)(tile + key * 272 + d * 2); }
                v4u o; o.x = (unsigned)e[0] | ((unsigned)e[1] << 16); o.y = (unsigned)e[2] | ((unsigned)e[3] << 16); o.z = (unsigned)e[4] | ((unsigned)e[5] << 16); o.w = (unsigned)e[6] | ((unsigned)e[7] << 16);
                *((GAS v4u*)(F.ws + WS_VT) + ((size_t)(h * 128 + d) * S + kb + 8 * ch) / 8) = o; }
            LDS_WAIT(); asm volatile("" ::: "memory"); } }
}

constexpr int CT = 16, CROWS = CT + 30;
__device__ __forceinline__ void conv_phase(Frame& F, int l) {
    LAS unsigned* ub = (LAS unsigned*)(F.lds + RING_OFF);
    LAS f32x2* part = (LAS f32x2*)(F.lds + RING_OFF + CROWS * 2048);
    const int lane = lane_now(), tid = F.wave * 64 + lane;
    const GAS f32x2* cw = (const GAS f32x2*)(F.conv_w + (size_t)l * CKW * 1024) + tid;
    float w0[CKW], w1[CKW];
#pragma unroll
    for (int k = 0; k < CKW; ++k) { const f32x2 w = cw[k * 512]; w0[k] = w.x; w1[k] = w.y; }
    const f32x2 cb = ((const GAS f32x2*)(F.conv_b + l * 1024))[tid], lg = ((const GAS f32x2*)(F.conv_g + l * 1024))[tid], lb = ((const GAS f32x2*)(F.conv_be + l * 1024))[tid];
    const GAS v4u* U = (const GAS v4u*)(F.ws + WS_U);
    GAS unsigned* CAT = (GAS unsigned*)(F.ws + WS_CAT);
    constexpr int NP = (CROWS * 128 + NWAVES * 64 - 1) / (NWAVES * 64);
    const int tb = (int)blockIdx.x * 64;
#pragma clang loop unroll(disable)
    for (int st = 0; st < 4; ++st) { const int t0 = tb + st * CT;
        { const int lane2 = lane_now(), tid2 = F.wave * 64 + lane2;
          v4u nx[NP];
#pragma unroll
          for (int i = 0; i < NP; ++i) { const int p = tid2 + NWAVES * 64 * i, tok = t0 - 30 + (p >> 7); nx[i] = (v4u){0u, 0u, 0u, 0u}; if (p < CROWS * 128 && tok >= 0) nx[i] = U[(size_t)tok * 128 + (p & 127)]; }
#pragma unroll
          for (int i = 0; i < NP; ++i) { const int p = tid2 + NWAVES * 64 * i; if (p < CROWS * 128) *(LAS v4u*)(ub + (p >> 7) * 512 + (p & 127) * 4) = nx[i]; } }
        __syncthreads();
        float a0[CT], a1[CT];
#pragma unroll
        for (int t = 0; t < CT; ++t) { a0[t] = cb.x; a1[t] = cb.y; }
#pragma unroll
        for (int r = 0; r < CROWS; ++r) { const unsigned w = ub[r * 512 + tid]; const float x0 = bflo(w), x1 = bfhi(w);
#pragma unroll
            for (int t = 0; t < CT; ++t) { if (r - t >= 0 && r - t <= 30) { a0[t] += w0[r - t] * x0; a1[t] += w1[r - t] * x1; } } }
#pragma unroll
        for (int t = 0; t < CT; ++t) { float s1 = a0[t] + a1[t], q = a0[t] * a0[t] + a1[t] * a1[t]; s1 = wave_sum(s1, lane); q = wave_sum(q, lane); if (lane == 0) part[F.wave * CT + t] = (f32x2){s1, q}; }
        __syncthreads();
#pragma unroll
        for (int t = 0; t < CT; ++t) { float s1 = 0.f, q = 0.f;
#pragma unroll
            for (int w = 0; w < 8; ++w) { const f32x2 pp = part[w * CT + t]; s1 += pp.x; q += pp.y; }
            const float mean = s1 * (1.f / 1024.f), var = fmaxf(q * (1.f / 1024.f) - mean * mean, 0.f), rstd = 1.0f / sqrtf(var + LN_EPS);
            const float y0 = (a0[t] - mean) * rstd * lg.x + lb.x, y1 = (a1[t] - mean) * rstd * lg.y + lb.y;
            ((GAS unsigned short*)(F.ws + WS_CAT))[((size_t)(t0 + t) * DM + 1024) / 2 + tid] = (unsigned short)pg8::pk4_fp8(y0 * pg8::sigmoidf_fast(y0) * ASC_CAT, y1 * pg8::sigmoidf_fast(y1) * ASC_CAT, 0.f, 0.f); }
        __syncthreads();
    }
}

typedef float f32x16 __attribute__((ext_vector_type(16)));
typedef __bf16 bf16x2_t __attribute__((ext_vector_type(2)));
__device__ __forceinline__ unsigned cvtpk(float lo, float hi) { const f32x2 v = {lo, hi}; const bf16x2_t b = __builtin_convertvector(v, bf16x2_t); return __builtin_bit_cast(unsigned, b); }
#define MFMA32(a, b, c) __builtin_amdgcn_mfma_f32_32x32x16_bf16((a), (b), (c), 0, 0, 0)
constexpr int LIST_PER_HEAD = 256 * 2016;
__device__ __forceinline__ int binoff(int j) { return 256 * (63 * j - (j * (j - 1)) / 2); }
#define TOP3_INSERT(v, j) do { const float v_ = (v); const int j_ = (j); \
    if (v_ > tv2) { if (v_ > tv1) { tv2 = tv1; ti2 = ti1; if (v_ > tv0) { tv1 = tv0; ti1 = ti0; tv0 = v_; ti0 = j_; } else { tv1 = v_; ti1 = j_; } } else { tv2 = v_; ti2 = j_; } } } while (0)
__device__ __forceinline__ void sel_phase(Frame& F, int l) {
    LAS int* cntL = (LAS int*)(F.lds + RING_OFF); LAS int* baseL = cntL + 64;
    const int lane = lane_now(), r = lane & 31, hg = lane >> 5, tid = F.wave * 64 + lane;
    const float NEG = -__builtin_inff();
#pragma clang loop unroll(disable)
    for (int unit = blockIdx.x; unit < 63 * NH; unit += F.G) { const int b = 1 + (unit >> 3), h = unit & 7;
        if (tid < 64) cntL[tid] = 0;
        __syncthreads();
        const int t = b * 256 + F.wave * 32 + r;
        const GAS bf16x8* qp = (const GAS bf16x8*)(F.ws + WS_Q) + ((size_t)t * 1024 + h * 128) / 8 + hg;
        bf16x8 qf[8];
#pragma unroll
        for (int kk = 0; kk < 8; ++kk) qf[kk] = qp[2 * kk];
        const GAS bf16x8* kh = (const GAS bf16x8*)(F.ws + WS_KMEAN) + ((size_t)(h * 64 + r) * 128) / 8 + hg;
        f32x16 G0, G1;
#pragma unroll
        for (int i = 0; i < 16; ++i) { G0[i] = 0.f; G1[i] = 0.f; }
#pragma unroll
        for (int kk = 0; kk < 8; ++kk) { G0 = MFMA32(kh[2 * kk], qf[kk], G0); G0 = MFMA32(kh[2 * kk + NH * NBLK * HD / 8], qf[kk], G0); }
        if (b > 32) {
#pragma unroll
            for (int kk = 0; kk < 8; ++kk) { G1 = MFMA32(kh[2 * kk + 32 * 16], qf[kk], G1); G1 = MFMA32(kh[2 * kk + 32 * 16 + NH * NBLK * HD / 8], qf[kk], G1); } }
        float tv0 = NEG, tv1 = NEG, tv2 = NEG; int ti0 = 0, ti1 = 0, ti2 = 0;
#pragma unroll
        for (int i = 0; i < 16; ++i) { const int j = (i & 3) + 8 * (i >> 2) + 4 * hg; TOP3_INSERT(j < b ? G0[i] : NEG, j); }
        if (b > 32) {
#pragma unroll
            for (int i = 0; i < 16; ++i) { const int j = 32 + (i & 3) + 8 * (i >> 2) + 4 * hg; TOP3_INSERT(j < b ? G1[i] : NEG, j); } }
        { const float p0 = shx(tv0, 32, lane), p1 = shx(tv1, 32, lane), p2 = shx(tv2, 32, lane); const int q0 = shx_i(ti0, 32, lane), q1 = shx_i(ti1, 32, lane), q2 = shx_i(ti2, 32, lane);
          TOP3_INSERT(p0, q0); TOP3_INSERT(p1, q1); TOP3_INSERT(p2, q2); }
        int rk0 = 0, rk1 = 0, rk2 = 0;
        if (hg == 0) {
            if (tv0 > NEG) rk0 = __hip_atomic_fetch_add(cntL + ti0, 1, __ATOMIC_RELAXED, __HIP_MEMORY_SCOPE_WORKGROUP);
            if (tv1 > NEG) rk1 = __hip_atomic_fetch_add(cntL + ti1, 1, __ATOMIC_RELAXED, __HIP_MEMORY_SCOPE_WORKGROUP);
            if (tv2 > NEG) rk2 = __hip_atomic_fetch_add(cntL + ti2, 1, __ATOMIC_RELAXED, __HIP_MEMORY_SCOPE_WORKGROUP); }
        __syncthreads();
        if (tid < 64) { const int c = cntL[tid]; if (c > 0) baseL[tid] = (int)__hip_atomic_fetch_add(F.ctl + CW_LCNT + l * 512 + h * 64 + tid, (unsigned)c, RLX_AGENT); }
        __syncthreads();
        if (hg == 0) { GAS int* L = (GAS int*)(F.ws + WS_LIST) + (size_t)h * LIST_PER_HEAD;
            if (tv0 > NEG) L[binoff(ti0) + baseL[ti0] + rk0] = t * 4 + 0;
            if (tv1 > NEG) L[binoff(ti1) + baseL[ti1] + rk1] = t * 4 + 1;
            if (tv2 > NEG) L[binoff(ti2) + baseL[ti2] + rk2] = t * 4 + 2; }
        __syncthreads();
    }
}
constexpr int KROW = 272, VROW = 528, KBUF_BYTES = 256 * KROW, VBUF_BYTES = 128 * VROW;
#define SCHED_FENCE() __builtin_amdgcn_sched_barrier(0)
template <bool CAUSAL>
__device__ __forceinline__ void moba_tile(const bf16x8 (&qf)[8], const LAS unsigned char* kb, const LAS unsigned char* vb, const int nkt, const int r, const int hg, f32x16 (&O)[4], float& ms, float& lsum) {
    const float NEG = -__builtin_inff(), SC = 0.08838834764831845f * 1.44269504088896341f;
    f32x16 Sx[8];
    bf16x8 kfA[8], kfB[8];
#pragma unroll
    for (int kk = 0; kk < 8; ++kk) kfA[kk] = *(const LAS bf16x8*)(kb + kk * 32);
#pragma unroll
    for (int kt = 0; kt < 8; ++kt) {
        if (kt < nkt) { f32x16 a;
#pragma unroll
            for (int i = 0; i < 16; ++i) a[i] = 0.f;
            if (kt + 1 < 8 && kt + 1 < nkt) {
#pragma unroll
                for (int kk = 0; kk < 8; ++kk) { if (kt & 1) kfA[kk] = *(const LAS bf16x8*)(kb + (kt + 1) * 32 * KROW + kk * 32); else kfB[kk] = *(const LAS bf16x8*)(kb + (kt + 1) * 32 * KROW + kk * 32); } }
            SCHED_FENCE();
#pragma unroll
            for (int kk = 0; kk < 8; ++kk) a = MFMA32((kt & 1) ? kfB[kk] : kfA[kk], qf[kk], a);
            SCHED_FENCE();
            if (CAUSAL && kt == nkt - 1) {
#pragma unroll
                for (int i = 0; i < 16; ++i) a[i] = ((i & 3) + 8 * (i >> 2) + 4 * hg > r) ? NEG : a[i]; }
            Sx[kt] = a;
        } else {
#pragma unroll
            for (int i = 0; i < 16; ++i) Sx[kt][i] = NEG; }
    }
    float mx = NEG;
#pragma unroll
    for (int kt = 0; kt < 8; ++kt)
#pragma unroll
        for (int i = 0; i < 16; ++i) mx = fmaxf(mx, Sx[kt][i]);
    mx = fmaxf(mx, shx(mx, 32, r + 32 * hg));
    ms = mx * SC;
    float ls = 0.f;
    bf16x8 pb[8][2];
#pragma unroll
    for (int kt = 0; kt < 8; ++kt)
#pragma unroll
        for (int s2 = 0; s2 < 2; ++s2) { float p[8];
#pragma unroll
            for (int i = 0; i < 8; ++i) { p[i] = __builtin_amdgcn_exp2f(Sx[kt][8 * s2 + i] * SC - ms); ls += p[i]; }
            v4u pw; pw.x = cvtpk(p[0], p[1]); pw.y = cvtpk(p[2], p[3]); pw.z = cvtpk(p[4], p[5]); pw.w = cvtpk(p[6], p[7]);
            pb[kt][s2] = __builtin_bit_cast(bf16x8, pw); }
    lsum = ls + shx(ls, 32, r + 32 * hg);
#pragma unroll
    for (int dt = 0; dt < 4; ++dt)
#pragma unroll
        for (int i = 0; i < 16; ++i) O[dt][i] = 0.f;
    bf16x8 vfA[4], vfB[4];
#pragma unroll
    for (int dt = 0; dt < 4; ++dt) vfA[dt] = *(const LAS bf16x8*)(vb + dt * 32 * VROW);
#pragma unroll
    for (int st = 0; st < 16; ++st) { const int kt = st >> 1, s2 = st & 1;
        if (kt < nkt) {
            if (st + 1 < 16 && ((st + 1) >> 1) < nkt) {
#pragma unroll
                for (int dt = 0; dt < 4; ++dt) { if (st & 1) vfA[dt] = *(const LAS bf16x8*)(vb + dt * 32 * VROW + (st + 1) * 32); else vfB[dt] = *(const LAS bf16x8*)(vb + dt * 32 * VROW + (st + 1) * 32); } }
            SCHED_FENCE();
#pragma unroll
            for (int dt = 0; dt < 4; ++dt) O[dt] = MFMA32((st & 1) ? vfB[dt] : vfA[dt], pb[kt][s2], O[dt]);
            SCHED_FENCE();
        }
    }
}
__device__ __forceinline__ void stage_kv(Frame& F, int h, int j, int tid) {
    LAS unsigned char* kbuf = F.lds + RING_OFF; LAS unsigned char* vbuf = kbuf + KBUF_BYTES;
    const GAS v4u* kg = (const GAS v4u*)(F.ws + WS_K) + ((size_t)(j * 256) * 1024 + h * 128) / 8;
    const GAS v4u* vg = (const GAS v4u*)(F.ws + WS_VT) + ((size_t)(h * 128) * S + j * 256) / 8;
    v4u kr[8], vr[8];
#pragma unroll
    for (int i = 0; i < 8; ++i) { const int p = tid + 512 * i; kr[i] = kg[(size_t)(p >> 4) * 128 + (p & 15)]; vr[i] = vg[(size_t)(p >> 5) * (S / 8) + (p & 31)]; }
#pragma unroll
    for (int i = 0; i < 8; ++i) { const int p = tid + 512 * i; *(LAS v4u*)(kbuf + (p >> 4) * KROW + (p & 15) * 16) = kr[i]; *(LAS v4u*)(vbuf + (p >> 5) * VROW + (p & 31) * 16) = vr[i]; }
}
__device__ __forceinline__ void partial_phase(Frame& F, int l) {
    gu32* lcnt = F.ctl + CW_LCNT + l * 512;
    LAS int* tab = (LAS int*)(F.lds + RING_OFF + KBUF_BYTES + VBUF_BYTES);
    { const int lane = lane_now(); int tl[8], sum = 0;
#pragma unroll
      for (int i = 0; i < 8; ++i) { const int c = (int)__hip_atomic_load(lcnt + lane * 8 + i, RLX_AGENT); tl[i] = (c + 255) >> 8; sum += tl[i]; }
      int inc = sum;
#pragma unroll
      for (int o = 1; o < 64; o <<= 1) { const int v = __builtin_amdgcn_ds_bpermute((lane - o) << 2, inc); if (lane >= o) inc += v; }
      int run = inc - sum;
      if (F.wave == 0) {
#pragma unroll
          for (int i = 0; i < 8; ++i) { run += tl[i]; tab[lane * 8 + i] = run; } } }
    __syncthreads();
    const int total = __builtin_amdgcn_readfirstlane(tab[511]);
    const int u_lo = (int)(((long)blockIdx.x * total) / F.G), u_hi = (int)(((long)(blockIdx.x + 1) * total) / F.G);
    int staged = -1;
#pragma clang loop unroll(disable)
    for (int u = u_lo; u < u_hi; ++u) {
        const int lane = lane_now(), r = lane & 31, hg = lane >> 5, tid = F.wave * 64 + lane;
        const LAS unsigned char* kb = F.lds + RING_OFF + r * KROW + hg * 16; const LAS unsigned char* vb = F.lds + RING_OFF + KBUF_BYTES + r * VROW + hg * 16;
        int bin = 0, chunk = 0; bool mine = false;
        { const int prev = lane ? tab[lane * 8 - 1] : 0; int lo = prev;
#pragma unroll
          for (int i = 0; i < 8; ++i) { const int hi = tab[lane * 8 + i]; if (u >= lo && u < hi) { mine = true; bin = lane * 8 + i; chunk = u - lo; } lo = hi; } }
        const int src = __builtin_ctzll(__ballot(mine)); bin = __builtin_amdgcn_readlane(bin, src); chunk = __builtin_amdgcn_readlane(chunk, src);
        const int h = bin >> 6, j = bin & 63, n = (int)__builtin_amdgcn_readfirstlane(__hip_atomic_load(lcnt + bin, RLX_AGENT));
        const int base = chunk * 256 + F.wave * 32; const bool active = base < n, valid = base + r < n;
        const int e = ((const GAS int*)(F.ws + WS_LIST))[(size_t)h * LIST_PER_HEAD + binoff(j) + (active ? base + (valid ? r : 0) : 0)];
        const int t = e >> 2, sl = e & 3;
        const GAS bf16x8* qp = (const GAS bf16x8*)(F.ws + WS_Q) + ((size_t)t * 1024 + h * 128) / 8 + hg;
        bf16x8 qf[8];
#pragma unroll
        for (int kk = 0; kk < 8; ++kk) qf[kk] = qp[2 * kk];
        if (bin != staged) {
            __syncthreads();
            stage_kv(F, h, j, tid);
            __syncthreads();
            staged = bin; }
        if (active) {
            f32x16 O[4]; float ms, ls;
            moba_tile<false>(qf, kb, vb, 8, r, hg, O, ms, ls);
            if (valid) { const size_t idx = ((size_t)h * S + t) * 3 + sl; const float inv = 1.0f / ls;
                GAS v2u* po = (GAS v2u*)(F.ws + WS_PO) + idx * 32 + hg;
#pragma unroll
                for (int dt = 0; dt < 4; ++dt)
#pragma unroll
                    for (int g4 = 0; g4 < 4; ++g4) po[dt * 8 + 2 * g4] = (v2u){cvtpk(O[dt][4 * g4] * inv, O[dt][4 * g4 + 1] * inv), cvtpk(O[dt][4 * g4 + 2] * inv, O[dt][4 * g4 + 3] * inv)};
                if (hg == 0) ((GAS f32x2*)(F.ws + WS_PML))[idx] = (f32x2){ms, ls}; }
        }
    }
}
__device__ __forceinline__ void own_phase(Frame& F) {
#pragma clang loop unroll(disable)
    for (int u = blockIdx.x; u < NBLK * NH; u += F.G) { const int h = u & 7, b = u >> 3, qt = F.wave;
        const int lane = lane_now(), r = lane & 31, hg = lane >> 5, tid = F.wave * 64 + lane;
        const LAS unsigned char* kb = F.lds + RING_OFF + r * KROW + hg * 16; const LAS unsigned char* vb = F.lds + RING_OFF + KBUF_BYTES + r * VROW + hg * 16;
        const int t = b * 256 + qt * 32 + r;
        const GAS bf16x8* qp = (const GAS bf16x8*)(F.ws + WS_Q) + ((size_t)t * 1024 + h * 128) / 8 + hg;
        bf16x8 qf[8];
#pragma unroll
        for (int kk = 0; kk < 8; ++kk) qf[kk] = qp[2 * kk];
        __syncthreads();
        stage_kv(F, h, b, tid);
        __syncthreads();
        f32x16 O[4]; float ms, ls;
        moba_tile<true>(qf, kb, vb, qt + 1, r, hg, O, ms, ls);
        __syncthreads();
        { LAS unsigned char* ow = F.lds + RING_OFF + F.wave * 8704;
          LAS f32x2* stq = (LAS f32x2*)(F.lds + RING_OFF + KBUF_BYTES) + F.wave * 32;
#pragma unroll
          for (int dt = 0; dt < 4; ++dt)
#pragma unroll
              for (int g4 = 0; g4 < 4; ++g4) *(LAS v2u*)(ow + r * 272 + (dt * 32 + 8 * g4 + 4 * hg) * 2) = (v2u){cvtpk(O[dt][4 * g4], O[dt][4 * g4 + 1]), cvtpk(O[dt][4 * g4 + 2], O[dt][4 * g4 + 3])};
          if (hg == 0) stq[r] = (f32x2){ms, ls};
          LDS_WAIT(); asm volatile("" ::: "memory");
          const int qq = lane >> 4, c = lane & 15, nv = b < 3 ? b : 3;
#pragma unroll
          for (int half = 0; half < 2; ++half) {
              v4u pv[4][3]; f32x2 pml[4][3];
#pragma unroll
              for (int pp = 0; pp < 4; ++pp) { const int q = 4 * (half * 4 + pp) + qq; const size_t idx0 = ((size_t)h * S + (b * 256 + qt * 32 + q)) * 3;
#pragma unroll
                  for (int s2 = 0; s2 < 3; ++s2) { const int so = s2 < nv ? s2 : 0;
                      pv[pp][s2] = ((const GAS v4u*)(F.ws + WS_PO))[(idx0 + so) * 16 + c]; pml[pp][s2] = ((const GAS f32x2*)(F.ws + WS_PML))[idx0 + so]; } }
#pragma unroll
              for (int pp = 0; pp < 4; ++pp) { const int q = 4 * (half * 4 + pp) + qq, t2 = b * 256 + qt * 32 + q;
                  const f32x2 own = stq[q]; const v4u ov = *(const LAS v4u*)(ow + q * 272 + c * 16);
                  float M = own.x;
#pragma unroll
                  for (int s2 = 0; s2 < 3; ++s2) { const bool have = s2 < nv; pml[pp][s2].x = have ? pml[pp][s2].x : -__builtin_inff(); pml[pp][s2].y = have ? pml[pp][s2].y : 0.f;
                      pv[pp][s2].x = have ? pv[pp][s2].x : 0u; pv[pp][s2].y = have ? pv[pp][s2].y : 0u; pv[pp][s2].z = have ? pv[pp][s2].z : 0u; pv[pp][s2].w = have ? pv[pp][s2].w : 0u;
                      M = fmaxf(M, pml[pp][s2].x); }
                  const float wo = __builtin_amdgcn_exp2f(own.x - M); float W = own.y * wo, w[3];
#pragma unroll
                  for (int s2 = 0; s2 < 3; ++s2) { w[s2] = pml[pp][s2].y * __builtin_amdgcn_exp2f(pml[pp][s2].x - M); W += w[s2]; }
                  float o[8] = {bflo(ov.x) * wo, bfhi(ov.x) * wo, bflo(ov.y) * wo, bfhi(ov.y) * wo, bflo(ov.z) * wo, bfhi(ov.z) * wo, bflo(ov.w) * wo, bfhi(ov.w) * wo};
#pragma unroll
                  for (int s2 = 0; s2 < 3; ++s2) { const v4u v = pv[pp][s2]; o[0] += w[s2] * bflo(v.x); o[1] += w[s2] * bfhi(v.x); o[2] += w[s2] * bflo(v.y); o[3] += w[s2] * bfhi(v.y); o[4] += w[s2] * bflo(v.z); o[5] += w[s2] * bfhi(v.z); o[6] += w[s2] * bflo(v.w); o[7] += w[s2] * bfhi(v.w); }
                  const float osc = ASC_CAT / W;
                  *(GAS v2u*)(F.ws + WS_CAT + (size_t)t2 * DM + h * 128 + 8 * c) = (v2u){pg8::pk4_fp8(o[0] * osc, o[1] * osc, o[2] * osc, o[3] * osc), pg8::pk4_fp8(o[4] * osc, o[5] * osc, o[6] * osc, o[7] * osc)}; }
          } }
    }
}

__device__ __forceinline__ void ln_phase(Frame& F, const float* xres_, const bf16* y_, const float* g_, const float* b_, const float* router, bool write8) {
    const int gw = F.vcu * NWAVES + F.wave, lane = lane_now();
    const GAS f32x4* gp = (const GAS f32x4*)g_ + lane; const GAS f32x4* bp = (const GAS f32x4*)b_ + lane;
    int ecl[8];
#pragma unroll
    for (int e = 0; e < 8; ++e) ecl[e] = 0;
    f32x4 hraw[8]; v2u hraw16[8], yraw[8];
    { const GAS v2u* yp = (const GAS v2u*)(y_ + (size_t)(gw * 8) * DM) + lane;
      if (xres_) { const GAS f32x4* hp = (const GAS f32x4*)(xres_ + (size_t)(gw * 8) * DM) + lane;
#pragma unroll
          for (int j = 0; j < 8; ++j) hraw[j] = hp[64 * j]; }
      else { const GAS v2u* hp = (const GAS v2u*)(F.ws + WS_HB + (size_t)(gw * 8) * DM * 2) + lane;
#pragma unroll
          for (int j = 0; j < 8; ++j) hraw16[j] = hp[64 * j]; }
#pragma unroll
      for (int j = 0; j < 8; ++j) yraw[j] = yp[64 * j]; }
#pragma clang loop unroll(disable)
    for (int i = 0; i < S / (256 * NWAVES); ++i) { const int row = gw * (S / (256 * NWAVES)) + i;
        f32x4 v[8]; float s = 0.f;
#pragma unroll
        for (int j = 0; j < 8; ++j) { const v2u yv = yraw[j]; const f32x4 hv = xres_ ? hraw[j] : (f32x4){bflo(hraw16[j].x), bfhi(hraw16[j].x), bflo(hraw16[j].y), bfhi(hraw16[j].y)};
            v[j] = hv * ALPHA + (f32x4){bflo(yv.x), bfhi(yv.x), bflo(yv.y), bfhi(yv.y)}; s += (v[j][0] + v[j][1]) + (v[j][2] + v[j][3]); }
        if (i + 1 < S / (256 * NWAVES)) { const GAS v2u* yp = (const GAS v2u*)(y_ + (size_t)(row + 1) * DM) + lane;
            if (xres_) { const GAS f32x4* hp = (const GAS f32x4*)(xres_ + (size_t)(row + 1) * DM) + lane;
#pragma unroll
                for (int j = 0; j < 8; ++j) hraw[j] = hp[64 * j]; }
            else { const GAS v2u* hp = (const GAS v2u*)(F.ws + WS_HB + (size_t)(row + 1) * DM * 2) + lane;
#pragma unroll
                for (int j = 0; j < 8; ++j) hraw16[j] = hp[64 * j]; }
#pragma unroll
            for (int j = 0; j < 8; ++j) yraw[j] = yp[64 * j]; }
        const float mean = wave_sum(s, lane) * (1.f / DM); float s2 = 0.f;
#pragma unroll
        for (int j = 0; j < 8; ++j) { v[j] = v[j] - mean; s2 += (v[j][0] * v[j][0] + v[j][1] * v[j][1]) + (v[j][2] * v[j][2] + v[j][3] * v[j][3]); }
        const float rstd = 1.f / sqrtf(wave_sum(s2, lane) * (1.f / DM) + LN_EPS);
        GAS v2u* hb = (GAS v2u*)(F.ws + WS_HB + (size_t)row * DM * 2) + lane;
#pragma unroll
        for (int j = 0; j < 8; ++j) { v[j] = v[j] * rstd * gp[64 * j] + bp[64 * j]; hb[64 * j] = (v2u){pk2(v[j][0], v[j][1]), pk2(v[j][2], v[j][3])};
            if (write8) ((GAS unsigned*)(F.ws + WS_HB8 + (size_t)row * DM))[64 * j + lane] = pg8::pk4_fp8(v[j][0] * ASC_H, v[j][1] * ASC_H, v[j][2] * ASC_H, v[j][3] * ASC_H); }
        if (router) {
            float lg[8];
#pragma unroll
            for (int e = 0; e < 8; ++e) lg[e] = 0.f;
#pragma unroll
            for (int j = 0; j < 8; ++j)
#pragma unroll
                for (int c = 0; c < 4; ++c) { const GAS f32x4* rw = (const GAS f32x4*)(router + (size_t)(256 * j + 4 * lane + c) * 8); const f32x4 r0 = rw[0], r1 = rw[1]; const float xv = v[j][c];
                    lg[0] += xv * r0[0]; lg[1] += xv * r0[1]; lg[2] += xv * r0[2]; lg[3] += xv * r0[3]; lg[4] += xv * r1[0]; lg[5] += xv * r1[1]; lg[6] += xv * r1[2]; lg[7] += xv * r1[3]; }
#pragma unroll
            for (int e = 0; e < 8; ++e) lg[e] = wave_sum(lg[e], lane);
            int i1 = 0; float v1 = lg[0];
#pragma unroll
            for (int e = 1; e < 8; ++e) if (lg[e] > v1) { v1 = lg[e]; i1 = e; }
            int i2 = -1; float v2 = -__builtin_inff();
#pragma unroll
            for (int e = 0; e < 8; ++e) if (e != i1 && lg[e] > v2) { v2 = lg[e]; i2 = e; }
            const float g1 = 1.0f / (1.0f + __expf(v2 - v1)), g2 = 1.0f - g1;
            if (lane == 0) { ((GAS int*)(F.ws + WS_EIDX))[row * 2] = i1; ((GAS int*)(F.ws + WS_EIDX))[row * 2 + 1] = i2; ((GAS float*)(F.ws + WS_GATEW))[row * 2] = g1; ((GAS float*)(F.ws + WS_GATEW))[row * 2 + 1] = g2; }
#pragma unroll
            for (int e = 0; e < 8; ++e) ecl[e] += (i1 == e ? 1 : 0) + (i2 == e ? 1 : 0);
        }
    }
    if (router) { int mine = 0;
#pragma unroll
        for (int e = 0; e < 8; ++e) mine = (lane == e) ? ecl[e] : mine;
        if (lane < 8 && mine) __hip_atomic_fetch_add(F.ctl + CW_ECNT + 64 * lane, (unsigned)mine, RLX_AGENT); }
}
__device__ __forceinline__ void load_expert_layout(Frame& F, int (&off)[8], int (&cum)[8], int& npanels) {
    int o = 0;
#pragma unroll
    for (int e = 0; e < 8; ++e) { const int c = (int)__builtin_amdgcn_readfirstlane(__hip_atomic_load(F.ctl + CW_ECNT + 64 * e, RLX_AGENT)); off[e] = o; cum[e] = o >> 8; o += (c + 255) & ~255; }
    npanels = o >> 8;
}
__device__ __forceinline__ void route_phase(Frame& F) {
    const int gw = F.vcu * NWAVES + F.wave, lane = lane_now();
    int off[8], cum[8], np; load_expert_layout(F, off, cum, np);
    const int row = gw * 8 + (lane >> 1), slot = lane & 1; const bool act = lane < 16;
    const int mye = act ? ((const GAS int*)(F.ws + WS_EIDX))[row * 2 + slot] : -1;
    int pos = 0;
#pragma unroll
    for (int e = 0; e < 8; ++e) { const unsigned long long mask = __ballot(mye == e);
        if (mask) { const int leader = __builtin_ctzll(mask), n = __builtin_popcountll(mask); unsigned b = 0u;
            if (lane == leader) b = __hip_atomic_fetch_add(F.ctl + CW_ECUR + 64 * e, (unsigned)n, RLX_AGENT);
            b = (unsigned)shl_i((int)b, leader);
            if (mye == e) pos = off[e] + (int)b + __builtin_popcountll(mask & ((1ull << lane) - 1ull)); } }
    if (act) ((GAS int*)(F.ws + WS_ROWPOS))[row * 2 + slot] = pos;
#pragma clang loop unroll(disable)
    for (int k0 = 0; k0 < 16; k0 += 8) {
        v4u t[8][2];
#pragma unroll
        for (int k = 0; k < 8; ++k) { const int r = gw * 8 + ((k0 + k) >> 1); const GAS v4u* src = (const GAS v4u*)(F.ws + WS_HB8 + (size_t)r * DM) + lane; t[k][0] = src[0]; t[k][1] = src[64]; }
#pragma unroll
        for (int k = 0; k < 8; ++k) { const int p = __builtin_amdgcn_readfirstlane(shl_i(pos, k0 + k)); GAS v4u* dst = (GAS v4u*)(F.ws + WS_HBP + (size_t)p * DM) + lane; dst[0] = t[k][0]; dst[64] = t[k][1]; }
    }
}
__device__ __forceinline__ void ln_moe_phase(Frame& F, const float* g_, const float* b_) {
    const int gw = F.vcu * NWAVES + F.wave, lane = lane_now();
    const GAS f32x4* gp = (const GAS f32x4*)g_ + lane; const GAS f32x4* bp = (const GAS f32x4*)b_ + lane;
    int mp1 = 0, mp2 = 0; float mg1 = 0.f, mg2 = 0.f;
    if (lane < 8) { const int rr = gw * 8 + lane; mp1 = ((const GAS int*)(F.ws + WS_ROWPOS))[rr * 2]; mp2 = ((const GAS int*)(F.ws + WS_ROWPOS))[rr * 2 + 1]; mg1 = ((const GAS float*)(F.ws + WS_GATEW))[rr * 2]; mg2 = ((const GAS float*)(F.ws + WS_GATEW))[rr * 2 + 1]; }
    v2u hraw[8], araw[8], braw[8];
    { const int p1 = __builtin_amdgcn_readlane(mp1, 0), p2 = __builtin_amdgcn_readlane(mp2, 0);
      const GAS v2u* hp = (const GAS v2u*)(F.ws + WS_HB + (size_t)(gw * 8) * DM * 2) + lane;
      const GAS v2u* y1 = (const GAS v2u*)(F.ws + WS_R2 + (size_t)p1 * DM * 2) + lane; const GAS v2u* y2 = (const GAS v2u*)(F.ws + WS_R2 + (size_t)p2 * DM * 2) + lane;
#pragma unroll
      for (int j = 0; j < 8; ++j) { hraw[j] = hp[64 * j]; araw[j] = y1[64 * j]; braw[j] = y2[64 * j]; } }
#pragma clang loop unroll(disable)
    for (int i = 0; i < 8; ++i) { const int row = gw * 8 + i;
        const float g1 = __builtin_bit_cast(float, shl_i(__builtin_bit_cast(int, mg1), i)), g2 = __builtin_bit_cast(float, shl_i(__builtin_bit_cast(int, mg2), i));
        f32x4 v[8]; float s = 0.f;
#pragma unroll
        for (int j = 0; j < 8; ++j) { const v2u a = araw[j], b = braw[j];
            const f32x4 fa = (f32x4){bflo(a.x), bfhi(a.x), bflo(a.y), bfhi(a.y)}, fb = (f32x4){bflo(b.x), bfhi(b.x), bflo(b.y), bfhi(b.y)};
            v[j] = (f32x4){bflo(hraw[j].x), bfhi(hraw[j].x), bflo(hraw[j].y), bfhi(hraw[j].y)} * ALPHA + fa * g1 + fb * g2; s += (v[j][0] + v[j][1]) + (v[j][2] + v[j][3]); }
        if (i + 1 < 8) { const int p1 = __builtin_amdgcn_readfirstlane(shl_i(mp1, i + 1)), p2 = __builtin_amdgcn_readfirstlane(shl_i(mp2, i + 1));
            const GAS v2u* hp = (const GAS v2u*)(F.ws + WS_HB + (size_t)(row + 1) * DM * 2) + lane;
            const GAS v2u* y1 = (const GAS v2u*)(F.ws + WS_R2 + (size_t)p1 * DM * 2) + lane; const GAS v2u* y2 = (const GAS v2u*)(F.ws + WS_R2 + (size_t)p2 * DM * 2) + lane;
#pragma unroll
            for (int j = 0; j < 8; ++j) { hraw[j] = hp[64 * j]; araw[j] = y1[64 * j]; braw[j] = y2[64 * j]; } }
        const float mean = wave_sum(s, lane) * (1.f / DM); float s2 = 0.f;
#pragma unroll
        for (int j = 0; j < 8; ++j) { v[j] = v[j] - mean; s2 += (v[j][0] * v[j][0] + v[j][1] * v[j][1]) + (v[j][2] * v[j][2] + v[j][3] * v[j][3]); }
        const float rstd = 1.f / sqrtf(wave_sum(s2, lane) * (1.f / DM) + LN_EPS);
        GAS f32x4* op = (GAS f32x4*)(F.out + (size_t)row * DM) + lane;
#pragma unroll
        for (int j = 0; j < 8; ++j) op[64 * j] = v[j] * rstd * gp[64 * j] + bp[64 * j];
    }
}

struct Args { const float* in[18]; float* out; unsigned char* ws; };
__global__ void __launch_bounds__(NWAVES * 64, 2) hymba_fwd(Args args) {
    extern __shared__ __attribute__((aligned(16))) unsigned char lds[];
    Frame F;
    F.lds = (LAS unsigned char*)lds;
    F.MISC = (volatile LAS unsigned*)(F.lds + MISC_OFF);
    F.wave = __builtin_amdgcn_readfirstlane((int)threadIdx.x >> 6);
    F.G = gridDim.x; { const int bx = blockIdx.x; F.vcu = (F.G % 8 == 0) ? (bx % 8) * (F.G / 8) + bx / 8 : bx; }
    F.ws = args.ws; F.ctl = (gu32*)(args.ws + WS_CTL);
    F.x = args.in[0]; F.w_in = args.in[1]; F.conv_w = args.in[2]; F.conv_b = args.in[3]; F.conv_g = args.in[4]; F.conv_be = args.in[5]; F.w_out = args.in[6];
    F.lnm_g = args.in[7]; F.lnm_b = args.in[8]; F.lnf_g = args.in[9]; F.lnf_b = args.in[10]; F.fg = args.in[11]; F.fu = args.in[12]; F.fd = args.in[13];
    F.router = args.in[14]; F.eg = args.in[15]; F.eu = args.in[16]; F.ed = args.in[17]; F.out = args.out;
    for (int u = threadIdx.x; u < (LDS_BYTES - LDSCTL_OFF) / 4; u += NWAVES * 64) ((LAS unsigned*)(F.lds + LDSCTL_OFF))[u] = 0u;
    __syncthreads();
    XcdBarrier bar = xcd_barrier_post((unsigned*)(F.ctl + CW_BAR), F.MISC + 8, F.wave);
#define LAUNDER() asm volatile("" : "+s"(F.ws), "+s"(F.ctl), "+s"(F.out), "+s"(F.x), "+s"(bar.bar), "+s"(F.wave))
#define GRID_BAR() do { LAUNDER(); xcd_barrier(bar); LAUNDER(); } while (0)
#define HB ((bf16*)(F.ws + WS_HB))
#define Y ((bf16*)(F.ws + WS_R2))

    p0_prologue(F);
    GRID_BAR();

#pragma clang loop unroll(disable)
    for (int l = 0; l < 2; ++l) {
#ifndef NO_G_INPROJ
        { pg8::Gemm g{(const bf16*)(F.ws + WS_HB8), (const bf16*)(F.ws + WS_WIN + (size_t)l * 20 * MiB), S, 3072, DM / 2, 0}; pg8::StaticOrder So; So.init(S, 3072, F.G, (int)blockIdx.x);
          pg8::EpiInProj E{(bf16*)(F.ws + WS_Q), (bf16*)(F.ws + WS_K), (bf16*)(F.ws + WS_V), (bf16*)(F.ws + WS_U), (const float*)(F.ws + WS_ROPEC), (const float*)(F.ws + WS_ROPES), 1.0f / (WSC_GU * ASC_H), 0};
          pg8::gemm_phase<pg8::EpiInProj, pg8::StaticOrder, true, true, true>(F.lds + RING_OFF, g, So, E, F.wave); }
        { pg8::Gemm g{HB, (const bf16*)(F.ws + WS_WIN + (size_t)l * 20 * MiB + 8 * MiB), S, 2048, DM, 0}; pg8::StaticOrder So; So.init(S, 2048, F.G, (int)blockIdx.x);
          pg8::EpiInProj E{(bf16*)(F.ws + WS_Q), (bf16*)(F.ws + WS_K), (bf16*)(F.ws + WS_V), (bf16*)(F.ws + WS_U), (const float*)(F.ws + WS_ROPEC), (const float*)(F.ws + WS_ROPES), 1.0f, 12};
          pg8::gemm_phase<pg8::EpiInProj, pg8::StaticOrder, true, true, false>(F.lds + RING_OFF, g, So, E, F.wave); }
#endif
        GRID_BAR();
        kmean_phase(F);
        vt_phase(F);
        __syncthreads();
        conv_phase(F, l);
        GRID_BAR();
        sel_phase(F, l);
        GRID_BAR();
        partial_phase(F, l);
        GRID_BAR();
        own_phase(F);
        GRID_BAR();
#ifndef NO_G_OUTPROJ
        { pg8::Gemm g{(const bf16*)(F.ws + WS_CAT), (const bf16*)(F.ws + WS_WOUT + (size_t)l * DM * DM), S, DM, DM / 2, 0}; pg8::StaticOrder So; So.init(S, DM, F.G, (int)blockIdx.x);
          pg8::EpiBf16 E{Y, DM, 1.0f / (WSC_O * ASC_CAT)};
          pg8::gemm_phase<pg8::EpiBf16, pg8::StaticOrder, true, true, true>(F.lds + RING_OFF, g, So, E, F.wave); }
#endif
        GRID_BAR();
        ln_phase(F, nullptr, Y, F.lnm_g + l * DM, F.lnm_b + l * DM, l == 1 ? F.router : nullptr, l == 1);
        GRID_BAR();
        if (l == 0) {
#ifndef NO_G_FFNGU
            { pg8::Gemm g{HB, (const bf16*)(F.ws + WS_WGU0), S, 2 * DFF, DM, 0}; pg8::StaticOrder So; So.init(S, 2 * DFF, F.G, (int)blockIdx.x);
              pg8::EpiSwiGLU E{(bf16*)(F.ws + WS_ACT), DFF};
              pg8::gemm_phase<pg8::EpiSwiGLU, pg8::StaticOrder, true, true>(F.lds + RING_OFF, g, So, E, F.wave); }
#endif
            GRID_BAR();
#ifndef NO_G_FFND
            { pg8::Gemm g{(const bf16*)(F.ws + WS_ACT), (const bf16*)(F.ws + WS_WD0), S, DM, DFF, 0}; pg8::StaticOrder So; So.init(S, DM, F.G, (int)blockIdx.x);
              pg8::EpiBf16 E{Y, DM, 1.0f};
              pg8::gemm_phase<pg8::EpiBf16, pg8::StaticOrder, true, true>(F.lds + RING_OFF, g, So, E, F.wave); }
#endif
            GRID_BAR();
            ln_phase(F, nullptr, Y, F.lnf_g, F.lnf_b, nullptr, true);
            GRID_BAR();
        } else {
            route_phase(F);
            GRID_BAR();
            int off[8], cum[8], np; load_expert_layout(F, off, cum, np);
#ifndef NO_G_MOEGU
            { pg8::Gemm g{(const bf16*)(F.ws + WS_HBP), (const bf16*)(F.ws + WS_WGUE), np * 256, 2 * DFF, DM / 2, (size_t)2 * DFF * DM}; pg8::GroupedOrder So; So.init(np * 256, 2 * DFF, F.G, (int)blockIdx.x);
#pragma unroll
              for (int e = 0; e < 8; ++e) So.cum[e] = cum[e];
              pg8::EpiSwiGLU8 E{F.ws + WS_ACT, DFF, 1.0f / (WSC_GU * ASC_H), ASC_ACT};
              pg8::gemm_phase<pg8::EpiSwiGLU8, pg8::GroupedOrder, true, true, true>(F.lds + RING_OFF, g, So, E, F.wave); }
#endif
            GRID_BAR();
#ifndef NO_G_MOED
            { pg8::Gemm g{(const bf16*)(F.ws + WS_ACT), (const bf16*)(F.ws + WS_WDE), np * 256, DM, DFF / 2, (size_t)DM * DFF}; pg8::GroupedOrder So; So.init(np * 256, DM, F.G, (int)blockIdx.x);
#pragma unroll
              for (int e = 0; e < 8; ++e) So.cum[e] = cum[e];
              pg8::EpiBf16 E{(bf16*)(F.ws + WS_R2), DM, 1.0f / (WSC_D * ASC_ACT)};
              pg8::gemm_phase<pg8::EpiBf16, pg8::GroupedOrder, true, true, true>(F.lds + RING_OFF, g, So, E, F.wave); }
#endif
            GRID_BAR();
            ln_moe_phase(F, F.lnf_g + DM, F.lnf_b + DM);
        }
    }
#undef GRID_BAR
#undef LAUNDER
#undef HB
#undef Y
}

extern "C" void kernel_launch(void* const* d_in, const int* in_sizes, int n_in, void* d_out, int out_size, void* d_ws, size_t ws_size, hipStream_t stream) {
    static int grid = 0;
    if (grid == 0) {
        if (n_in != 18 || in_sizes[0] != S * DM || out_size != S * DM || ws_size < WS_END) { fprintf(stderr, "kernel_launch: unexpected shapes (n_in %d, in0 %d, out %d, ws %zu < %zu); nothing launched\n", n_in, n_in > 0 ? in_sizes[0] : -1, out_size, ws_size, (size_t)WS_END); grid = -1; return; }
        int dev = 0, cus = 0, per_cu = 0;
        if (hipGetDevice(&dev) != hipSuccess || hipDeviceGetAttribute(&cus, hipDeviceAttributeMultiprocessorCount, dev) != hipSuccess) { grid = -1; return; }
        if (hipFuncSetAttribute((const void*)hymba_fwd, hipFuncAttributeMaxDynamicSharedMemorySize, LDS_BYTES) != hipSuccess) { fprintf(stderr, "kernel_launch: hipFuncSetAttribute failed\n"); grid = -1; return; }
        if (hipOccupancyMaxActiveBlocksPerMultiprocessor(&per_cu, (const void*)hymba_fwd, NWAVES * 64, LDS_BYTES) != hipSuccess || per_cu < 1)
            fprintf(stderr, "kernel_launch: note: occupancy query reports %d workgroups per CU\n", per_cu);
        (void)hipGetLastError();
        grid = cus;
        if (grid != 256) { fprintf(stderr, "kernel_launch: built for 256 CUs, device has %d; nothing launched\n", cus); grid = -1; return; }
    }
    if (grid < 0) return;
    if (hipMemsetAsync((char*)d_ws + WS_CTL, 0, CTL_ZERO_BYTES, stream) != hipSuccess) return;
    Args a{};
    for (int i = 0; i < 18; ++i) a.in[i] = (const float*)d_in[i];
    a.out = (float*)d_out; a.ws = (unsigned char*)d_ws;
    hipLaunchKernelGGL(hymba_fwd, dim3(grid), dim3(NWAVES * 64), LDS_BYTES, stream, a);
}
```

```cpp
#include <hip/hip_runtime.h>
#include <cstdio>
#include <cstdint>
#include <cmath>
namespace pg8 {
#define PG8_LAS __attribute__((address_space(3)))
typedef unsigned short bf16_t;
typedef short bf16x8 __attribute__((ext_vector_type(8)));
typedef float f32x4 __attribute__((ext_vector_type(4)));
typedef unsigned u32x4 __attribute__((ext_vector_type(4)));
typedef unsigned u32x2 __attribute__((ext_vector_type(2)));
typedef int v8i __attribute__((ext_vector_type(8)));
typedef int v4i __attribute__((ext_vector_type(4)));
constexpr int BM = 256, BK = 64, HALF = 128, HTB = HALF * BK * 2  , STAGE_BYTES = 8 * HTB, NXCD = 8, WGM = 8;

__host__ __device__ __forceinline__ int lds_byte(int r, int c) { const int st = (r >> 4) * 2 + (c >> 5), rr = r & 15, cc = c & 31, ob = rr * 64 + cc * 2; return st * 1024 + (ob ^ (((ob >> 9) & 1) << 5)); }
__host__ __device__ __forceinline__ void stage_rc(int b, int& R, int& C) { const int st = b / 1024, sb = b % 1024, swz = sb ^ (((sb >> 9) & 1) << 5); R = (st >> 1) * 16 + swz / 64; C = (st & 1) * 32 + (swz % 64) / 2; }
__host__ __device__ __forceinline__ int perm32(int rho) { const int n = rho >> 4, i = rho & 15; return 8 * (i >> 2) + 4 * n + (i & 3); }

struct Unit { int pm, pn, e; };
struct Gemm { const bf16_t* A; const bf16_t* Bt; int M, N, K; size_t bstride; };

struct StaticOrder {
    int nM, nN, nwg, G, c;
    __host__ __device__ void init(int M, int N, int G_, int c_) { nM = M / BM; nN = N / BM; nwg = nM * nN; G = G_; c = c_; }
    __host__ __device__ bool next(int i, Unit& u) const {
        const long L = (long)i * G + c; if (L >= nwg) return false;
        int wgid = (int)L; { const int q = nwg / NXCD, r = nwg % NXCD, xcd = wgid % NXCD, off = wgid / NXCD; wgid = (xcd < r ? xcd * (q + 1) : r * (q + 1) + (xcd - r) * q) + off; }
        const int nig = WGM * nN, gid = wgid / nig, fm = gid * WGM, gsz = (nM - fm) < WGM ? (nM - fm) : WGM;
        u.pm = fm + ((wgid % nig) % gsz); u.pn = (wgid % nig) / gsz; u.e = 0; return true;
    }
    __device__ __forceinline__ void a_ready(const Unit&) const {}
    __device__ __forceinline__ void done(const Unit&) const {}
};
struct GroupedOrder : StaticOrder {
    int cum[8];
    __device__ bool next(int i, Unit& u) const {
        if (!StaticOrder::next(i, u)) return false;
        int e = 0;
#pragma unroll
        for (int j = 1; j < 8; ++j) e += (u.pm >= cum[j]) ? 1 : 0;
        u.e = e; return true;
    }
};

__device__ __forceinline__ unsigned cvt_pk_bf16(float lo, float hi) { unsigned r; asm volatile("v_cvt_pk_bf16_f32 %0, %1, %2" : "=v"(r) : "v"(lo), "v"(hi)); return r; }
__device__ __forceinline__ float sigmoidf_fast(float g) { return __builtin_amdgcn_rcpf(1.0f + __builtin_amdgcn_exp2f(-1.44269504089f * g)); }

__device__ __forceinline__ unsigned pk4_fp8(float a, float b, float c, float d) {
    unsigned w = 0u; w = __builtin_amdgcn_cvt_pk_fp8_f32(__builtin_amdgcn_fmed3f(a, -448.f, 448.f), __builtin_amdgcn_fmed3f(b, -448.f, 448.f), w, false);
    return __builtin_amdgcn_cvt_pk_fp8_f32(__builtin_amdgcn_fmed3f(c, -448.f, 448.f), __builtin_amdgcn_fmed3f(d, -448.f, 448.f), w, true); }
struct EpiF32 {
    static constexpr bool PERM = false, AFTER_DRAIN = false;
    float* C; int ldc;
    __device__ __forceinline__ void operator()(const f32x4 (&acc)[2][2][4][2], const Unit& u, int wr, int wc, int fr, int fq) const {
        const int row0 = u.pm * BM + wr * 64 + fr, col0 = u.pn * BM + wc * 32 + 4 * fq;
#pragma unroll
        for (int ai = 0; ai < 2; ++ai)
#pragma unroll
            for (int m = 0; m < 4; ++m) { float* rowp = C + (size_t)(row0 + ai * HALF + m * 16) * ldc + col0;
#pragma unroll
                for (int bj = 0; bj < 2; ++bj)
#pragma unroll
                    for (int n = 0; n < 2; ++n) *(f32x4*)(rowp + bj * HALF + n * 16) = acc[ai][bj][m][n]; }
    }
};
struct EpiBf16 {
    static constexpr bool PERM = true, AFTER_DRAIN = false;
    bf16_t* O; int ldc; float sc;
    __device__ __forceinline__ void operator()(const f32x4 (&acc)[2][2][4][2], const Unit& u, int wr, int wc, int fr, int fq) const {
        const int row0 = u.pm * BM + wr * 64 + fr, col0 = u.pn * BM + wc * 32 + 8 * fq;
#pragma unroll
        for (int ai = 0; ai < 2; ++ai)
#pragma unroll
            for (int m = 0; m < 4; ++m) { bf16_t* rowp = O + (size_t)(row0 + ai * HALF + m * 16) * ldc + col0;
#pragma unroll
                for (int bj = 0; bj < 2; ++bj) { const f32x4 v0 = acc[ai][bj][m][0] * sc, v1 = acc[ai][bj][m][1] * sc;
                    u32x4 w; w.x = cvt_pk_bf16(v0[0], v0[1]); w.y = cvt_pk_bf16(v0[2], v0[3]); w.z = cvt_pk_bf16(v1[0], v1[1]); w.w = cvt_pk_bf16(v1[2], v1[3]);
                    *(u32x4*)(rowp + bj * HALF) = w; } }
    }
};
struct EpiSwiGLU {
    static constexpr bool PERM = true, AFTER_DRAIN = false;
    bf16_t* O; int ldc;
    __device__ __forceinline__ void operator()(const f32x4 (&acc)[2][2][4][2], const Unit& u, int wr, int wc, int fr, int fq) const {
        const int row0 = u.pm * BM + wr * 64 + fr, col0 = u.pn * HALF + wc * 32 + 8 * fq;
#pragma unroll
        for (int ai = 0; ai < 2; ++ai)
#pragma unroll
            for (int m = 0; m < 4; ++m) { bf16_t* rowp = O + (size_t)(row0 + ai * HALF + m * 16) * ldc + col0;
                float o[8];
#pragma unroll
                for (int n = 0; n < 2; ++n)
#pragma unroll
                    for (int j = 0; j < 4; ++j) { const float g = acc[ai][0][m][n][j], up = acc[ai][1][m][n][j]; o[n * 4 + j] = g * sigmoidf_fast(g) * up; }
                u32x4 w; w.x = cvt_pk_bf16(o[0], o[1]); w.y = cvt_pk_bf16(o[2], o[3]); w.z = cvt_pk_bf16(o[4], o[5]); w.w = cvt_pk_bf16(o[6], o[7]);
                *(u32x4*)rowp = w; }
    }
};
struct EpiSwiGLU8 {
    static constexpr bool PERM = true, AFTER_DRAIN = false;
    unsigned char* O; int ldc; float sin, sout;
    __device__ __forceinline__ void operator()(const f32x4 (&acc)[2][2][4][2], const Unit& u, int wr, int wc, int fr, int fq) const {
        const int row0 = u.pm * BM + wr * 64 + fr, col0 = u.pn * HALF + wc * 32 + 8 * fq;
#pragma unroll
        for (int ai = 0; ai < 2; ++ai)
#pragma unroll
            for (int m = 0; m < 4; ++m) { unsigned char* rowp = O + (size_t)(row0 + ai * HALF + m * 16) * ldc + col0;
                float o[8];
#pragma unroll
                for (int n = 0; n < 2; ++n)
#pragma unroll
                    for (int j = 0; j < 4; ++j) { const float g = acc[ai][0][m][n][j] * sin, up = acc[ai][1][m][n][j] * sin; o[n * 4 + j] = g * sigmoidf_fast(g) * up * sout; }
                u32x2 w; w.x = pk4_fp8(o[0], o[1], o[2], o[3]); w.y = pk4_fp8(o[4], o[5], o[6], o[7]);
                *(u32x2*)rowp = w; }
    }
};
struct EpiInProj {
    static constexpr bool PERM = true, AFTER_DRAIN = false;
    bf16_t *Q, *Kb, *V, *U; const float *ropeC, *ropeS; float sc; int pn_off;
    __device__ __forceinline__ void operator()(const f32x4 (&acc)[2][2][4][2], const Unit& u, int wr, int wc, int fr, int fq) const {
        const int row0 = u.pm * BM + wr * 64 + fr, pn = u.pn + pn_off;
        if (pn < 8) {
            bf16_t* base = (pn < 4) ? Q : Kb; const int col0 = (pn & 3) * BM + wc * 32 + 8 * fq, idx0 = 16 * wc + 4 * fq;
#pragma unroll
            for (int ai = 0; ai < 2; ++ai)
#pragma unroll
                for (int m = 0; m < 4; ++m) { const int row = row0 + ai * HALF + m * 16;
                    const f32x4 cs = *(const f32x4*)(ropeC + (size_t)row * 64 + idx0), sn = *(const f32x4*)(ropeS + (size_t)row * 64 + idx0);
#pragma unroll
                    for (int bj = 0; bj < 2; ++bj) { const f32x4 x1 = acc[ai][bj][m][0] * sc, x2 = acc[ai][bj][m][1] * sc;
                        const f32x4 o1 = x1 * cs - x2 * sn, o2 = x2 * cs + x1 * sn;
                        u32x4 w; w.x = cvt_pk_bf16(o1[0], o1[1]); w.y = cvt_pk_bf16(o1[2], o1[3]); w.z = cvt_pk_bf16(o2[0], o2[1]); w.w = cvt_pk_bf16(o2[2], o2[3]);
                        *(u32x4*)(base + (size_t)row * 1024 + col0 + bj * HALF) = w; } }
        } else if (pn < 12) {
            const int col0 = (pn - 8) * BM + wc * 32 + 8 * fq;
#pragma unroll
            for (int ai = 0; ai < 2; ++ai)
#pragma unroll
                for (int m = 0; m < 4; ++m) { bf16_t* rowp = V + (size_t)(row0 + ai * HALF + m * 16) * 1024 + col0;
#pragma unroll
                    for (int bj = 0; bj < 2; ++bj) { const f32x4 v0 = acc[ai][bj][m][0] * sc, v1 = acc[ai][bj][m][1] * sc;
                        u32x4 w; w.x = cvt_pk_bf16(v0[0], v0[1]); w.y = cvt_pk_bf16(v0[2], v0[3]); w.z = cvt_pk_bf16(v1[0], v1[1]); w.w = cvt_pk_bf16(v1[2], v1[3]);
                        *(u32x4*)(rowp + bj * HALF) = w; } }
        } else {
            const int col0 = (pn - 12) * HALF + wc * 32 + 8 * fq;
#pragma unroll
            for (int ai = 0; ai < 2; ++ai)
#pragma unroll
                for (int m = 0; m < 4; ++m) { bf16_t* rowp = U + (size_t)(row0 + ai * HALF + m * 16) * 1024 + col0;
                    float o[8];
#pragma unroll
                    for (int n = 0; n < 2; ++n)
#pragma unroll
                        for (int j = 0; j < 4; ++j) o[n * 4 + j] = acc[ai][0][m][n][j] * sc * sigmoidf_fast(acc[ai][1][m][n][j] * sc);
                    u32x4 w; w.x = cvt_pk_bf16(o[0], o[1]); w.y = cvt_pk_bf16(o[2], o[3]); w.z = cvt_pk_bf16(o[4], o[5]); w.w = cvt_pk_bf16(o[6], o[7]);
                    *(u32x4*)rowp = w; }
        }
    }
};

template <class Epi, class Sched, bool ALIGN_EPI = false, bool SP2 = false, bool FP8 = false>
__device__ __forceinline__ void gemm_phase(PG8_LAS unsigned char* lds, const Gemm g, const Sched& S, const Epi& E, const int wave_in) {
    int lane; asm volatile("v_mbcnt_lo_u32_b32 %0, -1, 0\n\tv_mbcnt_hi_u32_b32 %0, -1, %0" : "=v"(lane));
    const int wid = wave_in, tid = wid * 64 + lane, wr = wid >> 2, wc = wid & 3, fr = lane & 15, fq = lane >> 4;
    const int K = g.K, nt = K / BK;
    unsigned voffA[2], voffB[2];
#pragma unroll
    for (int i = 0; i < 2; ++i) { int R, C; stage_rc(tid * 16 + i * 8192, R, C); const int Rb = Epi::PERM ? ((R & ~31) + perm32(R & 31)) : R;
        voffA[i] = (unsigned)(R * K + C) * 2u; voffB[i] = (unsigned)(Rb * K + C) * 2u; }
    const size_t kstep = (size_t)(BK * 2);
    const size_t hstep = (size_t)HALF * K * 2;
    const size_t tstep = 2 * hstep;
    const unsigned ldsw = (unsigned)wid * 1024u;
    const int aoff = lds_byte(wr * 64 + fr, fq * 8), boff = lds_byte(wc * 32 + fr, fq * 8);
#define PG8_SA(b, h) (((b) * 2 + (h)) * HTB)
#define PG8_SB(b, h) ((4 + (b) * 2 + (h)) * HTB)
#define PG8_STAGE(bufoff, gbase, voff) do { _Pragma("unroll") for (int _i = 0; _i < 2; ++_i) \
        __builtin_amdgcn_global_load_lds((const unsigned*)((const char*)(gbase) + (voff)[_i]), (PG8_LAS unsigned*)(lds + (bufoff) + ldsw + _i * 8192), 16, 0, 0); } while (0)
#define PG8_LDA(dst, b, h) do { if constexpr (FP8) { _Pragma("unroll") for (int m = 0; m < 4; ++m) { const v4i lo_ = *(const PG8_LAS v4i*)(lds + PG8_SA(b, h) + aoff + m * 2048), hi_ = *(const PG8_LAS v4i*)(lds + PG8_SA(b, h) + aoff + m * 2048 + 1024); \
            dst##8[m] = __builtin_shufflevector(lo_, hi_, 0, 1, 2, 3, 4, 5, 6, 7); } } \
        else { _Pragma("unroll") for (int m = 0; m < 4; ++m) _Pragma("unroll") for (int k = 0; k < 2; ++k) dst[m][k] = *(const PG8_LAS bf16x8*)(lds + PG8_SA(b, h) + aoff + m * 2048 + k * 1024); } } while (0)
#define PG8_LDB(dst, b, h) do { if constexpr (FP8) { _Pragma("unroll") for (int n = 0; n < 2; ++n) { const v4i lo_ = *(const PG8_LAS v4i*)(lds + PG8_SB(b, h) + boff + n * 2048), hi_ = *(const PG8_LAS v4i*)(lds + PG8_SB(b, h) + boff + n * 2048 + 1024); \
            dst##8[n] = __builtin_shufflevector(lo_, hi_, 0, 1, 2, 3, 4, 5, 6, 7); } } \
        else { _Pragma("unroll") for (int n = 0; n < 2; ++n) _Pragma("unroll") for (int k = 0; k < 2; ++k) dst[n][k] = *(const PG8_LAS bf16x8*)(lds + PG8_SB(b, h) + boff + n * 2048 + k * 1024); } } while (0)
#define PG8_MMA(ai, bj, At, Bt) do { __builtin_amdgcn_s_setprio(1); \
        if constexpr (FP8) {   \
            _Pragma("unroll") for (int m = 0; m < 4; ++m) _Pragma("unroll") for (int n = 0; n < 2; ++n) \
                asm volatile("v_mfma_f32_16x16x128_f8f6f4 %0, %1, %2, %0" : "+v"(acc[ai][bj][m][n]) : "v"(Bt##8[n]), "v"(At##8[m]));   \
        } else { _Pragma("unroll") for (int m = 0; m < 4; ++m) _Pragma("unroll") for (int n = 0; n < 2; ++n) _Pragma("unroll") for (int k = 0; k < 2; ++k) \
            acc[ai][bj][m][n] = __builtin_amdgcn_mfma_f32_16x16x32_bf16(Bt[n][k], At[m][k], acc[ai][bj][m][n], 0, 0, 0); } \
        __builtin_amdgcn_s_setprio(0); } while (0)
#define PG8_WAIT_V(n) asm volatile("s_waitcnt vmcnt(" #n ")" ::: "memory")
#define PG8_WAIT_L(n) asm volatile("s_waitcnt lgkmcnt(" #n ")" ::: "memory")
#define PG8_BAR __builtin_amdgcn_s_barrier()
#define PG8_SCHED __builtin_amdgcn_sched_barrier(0)
    Unit cur, nxt; int ui = 0;
    if (!S.next(0, cur)) return;
    f32x4 acc[2][2][4][2];
#pragma unroll
    for (int a = 0; a < 2; ++a)
#pragma unroll
        for (int b = 0; b < 2; ++b)
#pragma unroll
            for (int m = 0; m < 4; ++m)
#pragma unroll
                for (int n = 0; n < 2; ++n) acc[a][b][m][n] = (f32x4){0.f, 0.f, 0.f, 0.f};
    bf16x8 At[4][2], B0[2][2], B1[2][2]; v8i At8[4], B08[2], B18[2];
    const char* cA = (const char*)g.A + (size_t)cur.pm * tstep; const char* cB = (const char*)g.Bt + (size_t)cur.e * g.bstride + (size_t)cur.pn * tstep;
    S.a_ready(cur);
    if constexpr (SP2) {
        PG8_STAGE(PG8_SB(0, 0), cB, voffB); PG8_STAGE(PG8_SB(0, 1), cB + hstep, voffB); PG8_STAGE(PG8_SA(0, 0), cA, voffA); PG8_STAGE(PG8_SA(0, 1), cA + hstep, voffA);
        if (wr == 1) PG8_BAR;
        PG8_WAIT_V(2); PG8_BAR;
        PG8_STAGE(PG8_SB(1, 0), cB + kstep, voffB); PG8_STAGE(PG8_SA(1, 0), cA + kstep, voffA); PG8_STAGE(PG8_SB(1, 1), cB + hstep + kstep, voffB);
        PG8_WAIT_V(6); PG8_BAR;
    } else {
        PG8_STAGE(PG8_SB(0, 0), cB, voffB); PG8_STAGE(PG8_SA(0, 0), cA, voffA); PG8_STAGE(PG8_SB(0, 1), cB + hstep, voffB); PG8_STAGE(PG8_SA(0, 1), cA + hstep, voffA);
        if (wr == 1) PG8_BAR;
        PG8_WAIT_V(4); PG8_BAR;
        PG8_STAGE(PG8_SB(1, 0), cB + kstep, voffB); PG8_STAGE(PG8_SA(1, 0), cA + kstep, voffA); PG8_STAGE(PG8_SB(1, 1), cB + hstep + kstep, voffB);
        PG8_WAIT_V(6); PG8_BAR;
    }
    for (;;) {
        const bool has_next = S.next(ui + 1, nxt);
        const char* nA = has_next ? (const char*)g.A + (size_t)nxt.pm * tstep : cA; const char* nB = has_next ? (const char*)g.Bt + (size_t)nxt.e * g.bstride + (size_t)nxt.pn * tstep : cB;
        for (int t = 0; t < nt; t += 2) {
            const bool last = (t == nt - 2);
            const char* a1 = cA + (size_t)(t + 1) * kstep;
            const char* a2 = last ? nA : cA + (size_t)(t + 2) * kstep; const char* b2 = last ? nB : cB + (size_t)(t + 2) * kstep;
            const char* a3 = a2 + kstep; const char* b3 = b2 + kstep;
            if (last && has_next) S.a_ready(nxt);
            if constexpr (SP2) {
            PG8_LDB(B0, 0, 0); PG8_LDB(B1, 0, 1); PG8_SCHED; PG8_LDA(At, 0, 0); PG8_STAGE(PG8_SA(1, 1), a1 + hstep, voffA);
            PG8_WAIT_V(8); PG8_WAIT_L(0); PG8_BAR; PG8_MMA(0, 0, At, B0); PG8_MMA(0, 1, At, B1); PG8_BAR; PG8_SCHED;
            PG8_LDA(At, 0, 1); PG8_STAGE(PG8_SB(0, 0), b2, voffB); PG8_STAGE(PG8_SB(0, 1), b2 + hstep, voffB); PG8_STAGE(PG8_SA(0, 0), a2, voffA);
            PG8_WAIT_V(8); PG8_WAIT_L(0); PG8_BAR; PG8_MMA(1, 0, At, B0); PG8_MMA(1, 1, At, B1); PG8_BAR; PG8_SCHED;
            PG8_LDB(B0, 1, 0); PG8_LDB(B1, 1, 1); PG8_SCHED; PG8_LDA(At, 1, 0); PG8_STAGE(PG8_SA(0, 1), a2 + hstep, voffA);
            PG8_WAIT_V(8); PG8_WAIT_L(0); PG8_BAR; PG8_MMA(0, 0, At, B0); PG8_MMA(0, 1, At, B1); PG8_BAR; PG8_SCHED;
            PG8_LDA(At, 1, 1); PG8_STAGE(PG8_SB(1, 0), b3, voffB); PG8_STAGE(PG8_SB(1, 1), b3 + hstep, voffB); PG8_STAGE(PG8_SA(1, 0), a3, voffA);
            PG8_WAIT_V(8); PG8_WAIT_L(0); PG8_BAR; PG8_MMA(1, 0, At, B0); PG8_MMA(1, 1, At, B1); PG8_BAR; PG8_SCHED;
            } else {
            PG8_LDB(B0, 0, 0); PG8_SCHED; PG8_LDA(At, 0, 0); PG8_STAGE(PG8_SA(1, 1), a1 + hstep, voffA);
            PG8_WAIT_L(8); PG8_BAR; PG8_WAIT_L(0); PG8_MMA(0, 0, At, B0); PG8_BAR; PG8_SCHED;
            PG8_LDB(B1, 0, 1); PG8_STAGE(PG8_SB(0, 0), b2, voffB);
            PG8_BAR; PG8_WAIT_L(0); PG8_MMA(0, 1, At, B1); PG8_BAR;
            PG8_LDA(At, 0, 1); PG8_STAGE(PG8_SA(0, 0), a2, voffA);
            PG8_BAR; PG8_WAIT_L(0); PG8_MMA(1, 0, At, B0); PG8_BAR; PG8_SCHED;
            PG8_STAGE(PG8_SB(0, 1), b2 + hstep, voffB);
            PG8_WAIT_V(6); PG8_BAR; PG8_MMA(1, 1, At, B1); PG8_BAR;
            PG8_LDB(B0, 1, 0); PG8_SCHED; PG8_LDA(At, 1, 0); PG8_STAGE(PG8_SA(0, 1), a2 + hstep, voffA);
            PG8_WAIT_L(8); PG8_BAR; PG8_WAIT_L(0); PG8_MMA(0, 0, At, B0); PG8_BAR; PG8_SCHED;
            PG8_LDB(B1, 1, 1); PG8_STAGE(PG8_SB(1, 0), b3, voffB);
            PG8_BAR; PG8_WAIT_L(0); PG8_MMA(0, 1, At, B1); PG8_BAR;
            PG8_LDA(At, 1, 1); PG8_STAGE(PG8_SA(1, 0), a3, voffA);
            PG8_BAR; PG8_WAIT_L(0); PG8_MMA(1, 0, At, B0); PG8_BAR; PG8_SCHED;
            PG8_STAGE(PG8_SB(1, 1), b3 + hstep, voffB);
            PG8_WAIT_V(6); PG8_BAR; PG8_MMA(1, 1, At, B1); PG8_BAR;
            }
        }
        if constexpr (FP8) asm volatile("s_nop 15\n\ts_nop 15" ::: "memory");
        if constexpr (ALIGN_EPI) { if (wr == 0) PG8_BAR; }
        if constexpr (!Epi::AFTER_DRAIN) { E(acc, cur, wr, wc, fr, fq); S.done(cur); }
        if (!has_next) break;
#pragma unroll
        for (int a = 0; a < 2; ++a)
#pragma unroll
            for (int b = 0; b < 2; ++b)
#pragma unroll
                for (int m = 0; m < 4; ++m)
#pragma unroll
                    for (int n = 0; n < 2; ++n) acc[a][b][m][n] = (f32x4){0.f, 0.f, 0.f, 0.f};
        cur = nxt; cA = nA; cB = nB; ++ui;
        if constexpr (ALIGN_EPI) { if (wr == 1) PG8_BAR; }
    }
    PG8_WAIT_V(0);
    if constexpr (!ALIGN_EPI) { if (wr == 0) PG8_BAR; }
    PG8_BAR;
    if constexpr (Epi::AFTER_DRAIN) { E.fused(acc, cur, wr, wc, fr, fq, lds, wid, lane); S.done(cur); }
#undef PG8_SA
#undef PG8_SB
#undef PG8_STAGE
#undef PG8_LDA
#undef PG8_LDB
#undef PG8_MMA
#undef PG8_WAIT_V
#undef PG8_WAIT_L
#undef PG8_BAR
#undef PG8_SCHED
}
}

constexpr int NWAVES = 8;
constexpr int S = 16384, DM = 2048, NPROJ = 5120, AW = 1024, HD = 128, NH = 8, DFF = 5632, NE = 8, CKW = 31, NBLK = 64;
constexpr float LN_EPS = 1e-5f, ALPHA = 1.41421356237309515f;
constexpr int MOE_ROWS = 2 * S + NE * 256;
constexpr float WSC_GU = 32.f, WSC_D = 128.f, ASC_H = 4.f, ASC_ACT = 8.f, WSC_O = 64.f, ASC_CAT = 16.f;

constexpr size_t MiB = 1u << 20;
constexpr size_t WS_CTL = 0, CTL_ZERO_BYTES = 1 * MiB;
constexpr size_t WS_ROPEC = 1 * MiB, WS_ROPES = 5 * MiB;
constexpr size_t WS_KMEAN = 9 * MiB;
constexpr size_t WS_RWT = 9 * MiB + 256 * 1024;
constexpr size_t WS_EIDX = 9 * MiB + 512 * 1024, WS_GATEW = WS_EIDX + 128 * 1024, WS_ROWPOS = WS_GATEW + 128 * 1024;
constexpr size_t WS_WIN = 10 * MiB, WS_WOUT = 50 * MiB, WS_WGU0 = 66 * MiB, WS_WD0 = 110 * MiB, WS_WGUE = 132 * MiB, WS_WDE = 484 * MiB;
constexpr size_t WS_HB = 660 * MiB;
constexpr size_t WS_R2 = 724 * MiB;
constexpr size_t WS_HB8 = 860 * MiB + 72 * MiB;
constexpr size_t WS_HBP = 860 * MiB;
constexpr size_t WS_R1 = 996 * MiB;
constexpr size_t WS_Q = WS_R1, WS_K = WS_R1 + 32 * MiB, WS_V = WS_R1 + 64 * MiB, WS_U = WS_R1 + 96 * MiB, WS_CAT = WS_R1 + 128 * MiB, WS_ACT = WS_R1;
constexpr size_t WS_VT = WS_R1 + 192 * MiB, WS_PO = WS_R1 + 224 * MiB, WS_PML = WS_R1 + 320 * MiB, WS_LIST = WS_R1 + 324 * MiB;
constexpr size_t WS_END = 1370 * MiB;
static_assert(WS_R1 + (size_t)MOE_ROWS * DFF * 2 <= WS_END && WS_HBP + (size_t)MOE_ROWS * DM * 2 <= WS_R1 && WS_R2 + (size_t)MOE_ROWS * DM * 2 <= WS_HBP, "d_ws map");
static_assert(WS_WDE + (size_t)NE * DM * DFF * 2 <= WS_HB && WS_WGUE + (size_t)NE * 2 * DFF * DM * 2 <= WS_WDE, "d_ws weights map");
constexpr int CW_TMO = 0, CW_CODE = 1, CW_BAR = 4096, CW_ECNT = 8192, CW_ECUR = 8192 + 64 * 8, CW_LCNT = 12288, CW_QUEUE = 14336;
constexpr int RING_OFF = 0, RING_BYTES = 131072;
constexpr int LDSCTL_OFF = 143360, MISC_OFF = LDSCTL_OFF + 320;
constexpr int LDS_BYTES = 147456;

__device__ const float INV_FREQ[64] = {
1.000000000e+00f, 8.659643531e-01f, 7.498942018e-01f, 6.493816376e-01f, 5.623413324e-01f, 4.869675338e-01f, 4.216965139e-01f, 3.651741147e-01f, 3.162277639e-01f, 2.738419771e-01f, 2.371373773e-01f, 2.053525001e-01f, 1.778279394e-01f, 1.539926529e-01f, 1.333521456e-01f, 1.154781953e-01f, 1.000000015e-01f, 8.659642935e-02f, 7.498942316e-02f, 6.493816525e-02f, 5.623413250e-02f, 4.869675264e-02f, 4.216964915e-02f, 3.651741147e-02f, 3.162277490e-02f, 2.738419548e-02f, 2.371373773e-02f, 2.053525113e-02f, 1.778279431e-02f, 1.539926510e-02f, 1.333521400e-02f, 1.154781971e-02f, 9.999999776e-03f, 8.659643121e-03f, 7.498942316e-03f, 6.493816152e-03f, 5.623413250e-03f, 4.869675264e-03f, 4.216964822e-03f, 3.651741194e-03f, 3.162277630e-03f, 2.738419687e-03f, 2.371373819e-03f, 2.053525066e-03f, 1.778279431e-03f, 1.539926510e-03f, 1.333521446e-03f, 1.154782018e-03f, 1.000000047e-03f, 8.659643354e-04f, 7.498941850e-04f, 6.493816036e-04f, 5.623413017e-04f, 4.869675322e-04f, 4.216965172e-04f, 3.651741135e-04f, 3.162277571e-04f, 2.738419571e-04f, 2.371373703e-04f, 2.053525095e-04f, 1.778279402e-04f, 1.539926598e-04f, 1.333521504e-04f, 1.154782003e-04f
};

#define GAS __attribute__((address_space(1)))
#define LAS __attribute__((address_space(3)))
typedef unsigned short bf16;
typedef unsigned v4u __attribute__((ext_vector_type(4)));
typedef unsigned v2u __attribute__((ext_vector_type(2)));
typedef float f32x4 __attribute__((ext_vector_type(4)));
typedef float f32x2 __attribute__((ext_vector_type(2)));
typedef short bf16x8 __attribute__((ext_vector_type(8)));
typedef GAS unsigned gu32;
typedef GAS unsigned long long gu64;
#define RLX_AGENT __ATOMIC_RELAXED, __HIP_MEMORY_SCOPE_AGENT
#define LDS_WAIT() asm volatile("s_waitcnt lgkmcnt(0)" ::: "memory")
#define VM_WAIT() asm volatile("s_waitcnt vmcnt(0)" ::: "memory")
__device__ __forceinline__ unsigned f2bf(float f) { unsigned u = __builtin_bit_cast(unsigned, f); return (u + 0x7fffu + ((u >> 16) & 1u)) >> 16; }
__device__ __forceinline__ unsigned pk2(float lo, float hi) { return f2bf(lo) | (f2bf(hi) << 16); }
__device__ __forceinline__ float bflo(unsigned w) { return __builtin_bit_cast(float, w << 16); }
__device__ __forceinline__ float bfhi(unsigned w) { return __builtin_bit_cast(float, w & 0xffff0000u); }

#define XB_TMO      128
#define XB_XCNT(j)  (256  + 64 * (j))
#define XB_XSUB(j)  (1280 + 64 * (j))
#define XB_XGEN(j)  (2304 + 64 * (j))
#define XB_TOP      3328
#define XB_TOPGEN   3392
#define XCD_BAR_WORDS 3456
#define XB_SPIN_CAP (1u << 22)

__device__ __forceinline__ unsigned xb_ld(unsigned* p)              { return __hip_atomic_load(p, __ATOMIC_RELAXED, __HIP_MEMORY_SCOPE_AGENT); }
__device__ __forceinline__ unsigned xb_add(unsigned* p, unsigned v) { return __hip_atomic_fetch_add(p, v, __ATOMIC_RELAXED, __HIP_MEMORY_SCOPE_AGENT); }
__device__ __forceinline__ unsigned xb_xcc_id() { return (unsigned)__builtin_amdgcn_s_getreg((3 << 11) | 20) & 0xFu; }
#define XB_SPIN(cond, bar) do { unsigned _sp = 0; while (cond) { __builtin_amdgcn_s_sleep(1); \
    if ((++_sp & 255u) == 0u) { if (xb_ld(&(bar)[XB_TMO])) break; if (_sp > XB_SPIN_CAP) { atomicAdd(&(bar)[XB_TMO], 1u); break; } } } } while (0)

__device__ __forceinline__ int lane_now() { int l; asm volatile("v_mbcnt_lo_u32_b32 %0, -1, 0\n\tv_mbcnt_hi_u32_b32 %0, -1, %0" : "=v"(l)); return l; }
#define XB_T0() (b.w0 == 0 && lane_now() == 0)
struct XcdBarrier {
    unsigned* bar; unsigned x; int w0;
    volatile LAS unsigned* st;
};

__device__ __forceinline__ XcdBarrier xcd_barrier_post(unsigned* bar, volatile LAS unsigned* st, int w0) {
    XcdBarrier b; b.bar = bar; b.x = xb_xcc_id(); b.st = st; b.w0 = w0;
    if (XB_T0()) (void)xb_add(&bar[XB_XCNT(b.x)], 1u);
    return b;
}
__device__ __forceinline__ void xcd_barrier_complete(unsigned* bar, unsigned x, unsigned& nloc, unsigned& nx) {
    const unsigned G = gridDim.x * gridDim.y * gridDim.z;
    unsigned sum, cnt, mine, sp = 0u;
    for (;;) {
        sum = 0u; cnt = 0u; mine = 0u;
#pragma unroll
        for (unsigned j = 0; j < 16; ++j) { const unsigned c = xb_ld(&bar[XB_XCNT(j)]); sum += c; cnt += (c > 0u) ? 1u : 0u; mine = (j == x) ? c : mine; }
        if (sum == G) break;
        __builtin_amdgcn_s_sleep(1);
        if ((++sp & 255u) == 0u) { if (xb_ld(&bar[XB_TMO])) break; if (sp > XB_SPIN_CAP) { atomicAdd(&bar[XB_TMO], 1u); break; } }
    }
    nloc = mine > 0u ? mine : 1u; nx = cnt > 0u ? cnt : 1u;
}

__device__ __forceinline__ void xcd_barrier(const XcdBarrier& b) {
    asm volatile("s_waitcnt vmcnt(0)" ::: "memory");
    __syncthreads();
    if (XB_T0()) {
        unsigned* bar = b.bar;
        __builtin_amdgcn_s_waitcnt(0);
        unsigned nloc = b.st[0], nx = b.st[1];
        if (nloc == 0u) { xcd_barrier_complete(bar, b.x, nloc, nx); b.st[0] = nloc; b.st[1] = nx; }
        const unsigned old = xb_add(&bar[XB_XSUB(b.x)], 1u);
        const unsigned gen = old / nloc;
        if (old + 1u == (gen + 1u) * nloc) {
            __builtin_amdgcn_fence(__ATOMIC_RELEASE, "agent");
            asm volatile("s_waitcnt vmcnt(0)" ::: "memory");
            const unsigned og = xb_add(&bar[XB_TOP], 1u);
            const unsigned tg = og / nx;
            if (og + 1u == (tg + 1u) * nx) xb_add(&bar[XB_TOPGEN], 1u);
            else XB_SPIN(xb_ld(&bar[XB_TOPGEN]) == tg, bar);
            __builtin_amdgcn_fence(__ATOMIC_ACQUIRE, "agent");
            xb_add(&bar[XB_XGEN(b.x)], 1u);
            asm volatile("s_waitcnt vmcnt(0)" ::: "memory");
        } else {
            XB_SPIN(xb_ld(&bar[XB_XGEN(b.x)]) == gen, bar);
            __builtin_amdgcn_fence(__ATOMIC_ACQUIRE, "agent");
            asm volatile("s_waitcnt vmcnt(0)" ::: "memory");
        }
    }
    __syncthreads();
}


struct Frame {
    LAS unsigned char* lds;
    volatile LAS unsigned* MISC;
    gu32* ctl;
    int wave;
    int vcu, G;
    const float* x; float* out;
    const float *w_in, *conv_w, *conv_b, *conv_g, *conv_be, *w_out, *lnm_g, *lnm_b, *lnf_g, *lnf_b, *fg, *fu, *fd, *router, *eg, *eu, *ed;
    unsigned char* ws;
    unsigned long long tacc, tt0;
};
#ifndef PROBE_ID
#define PROBE_ID 0
#endif
#ifndef PROBE_WG
#define PROBE_WG 0
#endif
#define TSTART(id) do { if (PROBE_ID == (id)) F.tt0 = __builtin_amdgcn_s_memrealtime(); } while (0)
#define TSTOP(id) do { if (PROBE_ID == (id)) F.tacc += __builtin_amdgcn_s_memrealtime() - F.tt0; } while (0)
__device__ __forceinline__ int shx_i(int v, int m, int lane) { return __builtin_amdgcn_ds_bpermute((lane ^ m) << 2, v); }
__device__ __forceinline__ float shx(float v, int m, int lane) { return __builtin_bit_cast(float, __builtin_amdgcn_ds_bpermute((lane ^ m) << 2, __builtin_bit_cast(int, v))); }
__device__ __forceinline__ int shl_i(int v, int src) { return __builtin_amdgcn_ds_bpermute(src << 2, v); }
template <int N> __device__ __forceinline__ void wave_sum_n(float (&v)[N], int lane) {
#pragma unroll
    for (int i = 0; i < N; ++i) { float x = v[i];
        x += __builtin_bit_cast(float, __builtin_amdgcn_update_dpp(0, __builtin_bit_cast(int, x), 0xB1, 0xF, 0xF, false));
        x += __builtin_bit_cast(float, __builtin_amdgcn_update_dpp(0, __builtin_bit_cast(int, x), 0x4E, 0xF, 0xF, false));
        x += __builtin_bit_cast(float, __builtin_amdgcn_update_dpp(0, __builtin_bit_cast(int, x), 0x141, 0xF, 0xF, false));
        x += __builtin_bit_cast(float, __builtin_amdgcn_update_dpp(0, __builtin_bit_cast(int, x), 0x140, 0xF, 0xF, false));
        v[i] = x; }
#pragma unroll
    for (int o = 16; o < 64; o <<= 1) { float t[N];
#pragma unroll
        for (int i = 0; i < N; ++i) t[i] = shx(v[i], o, lane);
#pragma unroll
        for (int i = 0; i < N; ++i) v[i] += t[i]; }
}
__device__ __forceinline__ float wave_sum(float v, int lane) {
    v += __builtin_bit_cast(float, __builtin_amdgcn_update_dpp(0, __builtin_bit_cast(int, v), 0xB1, 0xF, 0xF, false));
    v += __builtin_bit_cast(float, __builtin_amdgcn_update_dpp(0, __builtin_bit_cast(int, v), 0x4E, 0xF, 0xF, false));
    v += __builtin_bit_cast(float, __builtin_amdgcn_update_dpp(0, __builtin_bit_cast(int, v), 0x141, 0xF, 0xF, false));
    v += __builtin_bit_cast(float, __builtin_amdgcn_update_dpp(0, __builtin_bit_cast(int, v), 0x140, 0xF, 0xF, false));
    v += shx(v, 16, lane); v += shx(v, 32, lane);
    return v;
}
__device__ __forceinline__ int wmap(int kind, int c) {
    if (kind == 0) return c;
    if (kind == 1) {
        if (c < 2048) { const int hh = c >> 7, w = c & 127, n = w >> 6, idx = w & 63; return hh * 128 + 32 * (idx >> 4) + 8 * ((idx >> 2) & 3) + 4 * n + (idx & 3); }
        if (c < 3072) return c;
        if (c < 4096) { const int j = c - 3072; return 3072 + 256 * (j >> 7) + (j & 127); }
        const int j = c - 4096; return 3072 + 256 * (j >> 7) + 128 + (j & 127);
    }
    return 256 * (c >> 7) + (kind == 3 ? 128 : 0) + (c & 127);
}
__device__ __forceinline__ void p0_transpose_item(const float* Wg, int K, int N, bf16* WT, int kind, LAS float* scr, int item, int lane) {
    const GAS float* W = (const GAS float*)Wg;
    const int nblk = N / 32, kb = item / nblk, nb = item % nblk, k0 = 64 * kb, n0 = 32 * nb;
    float wv[32];
#pragma unroll
    for (int i = 0; i < 32; ++i) wv[i] = W[(size_t)(k0 + 2 * i + (lane >> 5)) * N + n0 + (lane & 31)];
#pragma unroll
    for (int i = 0; i < 32; ++i) scr[(2 * i + (lane >> 5)) * 33 + (lane & 31)] = wv[i];
    LDS_WAIT(); asm volatile("" ::: "memory");
    const int c = lane & 7;
#pragma unroll
    for (int j = 0; j < 4; ++j) { const int n = (lane >> 3) + 8 * j; const LAS float* s = scr + (8 * c) * 33 + n;
        v4u o; o.x = pk2(s[0 * 33], s[1 * 33]); o.y = pk2(s[2 * 33], s[3 * 33]); o.z = pk2(s[4 * 33], s[5 * 33]); o.w = pk2(s[6 * 33], s[7 * 33]);
        *(GAS v4u*)(WT + (size_t)wmap(kind, n0 + n) * K + k0 + 8 * c) = o; }
    LDS_WAIT(); asm volatile("" ::: "memory");
}
__device__ __forceinline__ void sincos_acc(float ang, float& sn, float& cs) {
    const double x = (double)ang, k = __builtin_rint(x * 0.63661977236758134308);
    double r = __builtin_fma(-k, 1.57079632679489655800e+00, x); r = __builtin_fma(-k, 6.12323399573676603587e-17, r);
    const int q = ((int)k) & 3; const double r2 = r * r;
    double sp = 1.0 / 6227020800.0; sp = sp * r2 - 1.0 / 39916800.0; sp = sp * r2 + 1.0 / 362880.0; sp = sp * r2 - 1.0 / 5040.0; sp = sp * r2 + 1.0 / 120.0; sp = sp * r2 - 1.0 / 6.0;
    const double s = r + r * r2 * sp;
    double cp = -1.0 / 87178291200.0; cp = cp * r2 + 1.0 / 479001600.0; cp = cp * r2 - 1.0 / 3628800.0; cp = cp * r2 + 1.0 / 40320.0; cp = cp * r2 - 1.0 / 720.0; cp = cp * r2 + 1.0 / 24.0; cp = cp * r2 - 0.5;
    const double c = 1.0 + r2 * cp;
    const double ss = (q & 1) ? c : s, cc = (q & 1) ? s : c;
    sn = (float)((q & 2) ? -ss : ss); cs = (float)(((q + 1) & 2) ? -cc : cc);
}
__device__ __forceinline__ void p0_transpose_item8(const float* Wg, int K, int N, unsigned char* WT, int kind, float wscale, LAS float* scr, int item, int lane) {
    const GAS float* W = (const GAS float*)Wg;
    const int nblk = N / 32, kb = item / nblk, nb = item % nblk, k0 = 64 * kb, n0 = 32 * nb;
    float wv[32];
#pragma unroll
    for (int i = 0; i < 32; ++i) wv[i] = W[(size_t)(k0 + 2 * i + (lane >> 5)) * N + n0 + (lane & 31)];
#pragma unroll
    for (int i = 0; i < 32; ++i) scr[(2 * i + (lane >> 5)) * 33 + (lane & 31)] = wv[i] * wscale;
    LDS_WAIT(); asm volatile("" ::: "memory");
    const int c = lane & 7;
#pragma unroll
    for (int j = 0; j < 4; ++j) { const int n = (lane >> 3) + 8 * j; const LAS float* sp = scr + (8 * c) * 33 + n;
        v2u o; o.x = pg8::pk4_fp8(sp[0 * 33], sp[1 * 33], sp[2 * 33], sp[3 * 33]); o.y = pg8::pk4_fp8(sp[4 * 33], sp[5 * 33], sp[6 * 33], sp[7 * 33]);
        *(GAS v2u*)(WT + (size_t)wmap(kind, n0 + n) * K + k0 + 8 * c) = o; }
    LDS_WAIT(); asm volatile("" ::: "memory");
}
__device__ __forceinline__ void p0_transpose_stack8(Frame& F, const float* src, int K, int N, int nmat, unsigned char* dst, size_t dst_stride, int kind, float wscale) {
    LAS float* scr = (LAS float*)(F.lds + RING_OFF + F.wave * 16384);
    const int gw = F.vcu * NWAVES + F.wave, NGW = F.G * NWAVES, per = (K / 64) * (N / 32), total = per * nmat, lane = lane_now();
#pragma clang loop unroll(disable)
    for (int it = gw; it < total; it += NGW) { const int m = it / per, r = it - m * per;
        p0_transpose_item8(src + (size_t)m * K * N, K, N, dst + (size_t)m * dst_stride, kind, wscale, scr, r, lane); }
}
__device__ __forceinline__ void p0_stack(Frame& F, const float* src, int K, int N, int nmat, unsigned char* dst, size_t dst_stride_bytes, int kind, bool fp8, float wscale, int n_lo = 0, int n_cnt = 0, int drow_off = 0) {
    LAS float* t = (LAS float*)(F.lds + RING_OFF);
    const int tid = F.wave * 64 + lane_now(), ntn = (n_cnt ? n_cnt : N) / 256, per = (K / 128) * ntn, total = per * nmat;
    f32x4 raw[16];
    int it = blockIdx.x;
    if (it < total) { const int m = it / per, r = it - m * per, k0 = (r / ntn) * 128, n0 = n_lo + (r % ntn) * 256; const GAS f32x4* W = (const GAS f32x4*)(src + (size_t)m * K * N + (size_t)k0 * N + n0);
#pragma unroll
        for (int i = 0; i < 16; ++i) { const int p = tid + 512 * i; raw[i] = W[(size_t)(p >> 6) * (N / 4) + (p & 63)]; } }
#pragma clang loop unroll(disable)
    for (; it < total; it += F.G) { const int m = it / per, r = it - m * per, k0 = (r / ntn) * 128, n0 = n_lo + (r % ntn) * 256;
        const int tid2 = F.wave * 64 + lane_now();
#pragma unroll
        for (int i = 0; i < 16; ++i) { const int p = tid2 + 512 * i; LAS float* d = t + (p >> 6) * 257 + (p & 63) * 4; d[0] = raw[i][0] * wscale; d[1] = raw[i][1] * wscale; d[2] = raw[i][2] * wscale; d[3] = raw[i][3] * wscale; }
        __syncthreads();
        { const int nx = (it + F.G < total) ? it + F.G : it;
          const int m2 = nx / per, r2 = nx - m2 * per, k2 = (r2 / ntn) * 128, n2 = n_lo + (r2 % ntn) * 256; const GAS f32x4* W = (const GAS f32x4*)(src + (size_t)m2 * K * N + (size_t)k2 * N + n2);
#pragma unroll
            for (int i = 0; i < 16; ++i) { const int p = tid2 + 512 * i; raw[i] = W[(size_t)(p >> 6) * (N / 4) + (p & 63)]; } }
        unsigned char* drow = dst + (size_t)m * dst_stride_bytes;
#pragma unroll
        for (int q = 0; q < 8; ++q) { const int cid = tid2 + 512 * q, nrow = cid >> 4, kc = cid & 15; const LAS float* sp = t + (8 * kc) * 257 + nrow;
            const float e0 = sp[0], e1 = sp[257], e2 = sp[2 * 257], e3 = sp[3 * 257], e4 = sp[4 * 257], e5 = sp[5 * 257], e6 = sp[6 * 257], e7 = sp[7 * 257];
            const size_t drw = (size_t)(wmap(kind, n0 + nrow) - drow_off) * K + k0 + 8 * kc;
            if (fp8) { v2u o; o.x = pg8::pk4_fp8(e0, e1, e2, e3); o.y = pg8::pk4_fp8(e4, e5, e6, e7); *(GAS v2u*)(drow + drw) = o; }
            else { v4u o; o.x = pk2(e0, e1); o.y = pk2(e2, e3); o.z = pk2(e4, e5); o.w = pk2(e6, e7); *(GAS v4u*)(drow + drw * 2) = o; } }
        __syncthreads();
    }
}
__device__ __forceinline__ void p0_prologue(Frame& F) {
    p0_stack(F, F.w_in, DM, NPROJ, 2, F.ws + WS_WIN, (size_t)20 * MiB, 1, true, WSC_GU, 0, 3072, 0);
    p0_stack(F, F.w_in, DM, NPROJ, 2, F.ws + WS_WIN + 8 * MiB, (size_t)20 * MiB, 1, false, 1.f, 3072, 2048, 3072);
    p0_stack(F, F.w_out, DM, DM, 2, F.ws + WS_WOUT, (size_t)DM * DM, 0, true, WSC_O);
    p0_stack(F, F.fg, DM, DFF, 1, F.ws + WS_WGU0, 0, 2, false, 1.f);
    p0_stack(F, F.fu, DM, DFF, 1, F.ws + WS_WGU0, 0, 3, false, 1.f);
    p0_stack(F, F.fd, DFF, DM, 1, F.ws + WS_WD0, 0, 0, false, 1.f);
    p0_stack(F, F.eg, DM, DFF, NE, F.ws + WS_WGUE, (size_t)2 * DFF * DM, 2, true, WSC_GU);
    p0_stack(F, F.eu, DM, DFF, NE, F.ws + WS_WGUE, (size_t)2 * DFF * DM, 3, true, WSC_GU);
    p0_stack(F, F.ed, DFF, DM, NE, F.ws + WS_WDE, (size_t)DM * DFF, 0, true, WSC_D);
    { const int i = ((F.vcu * NWAVES + F.wave) * 64 + lane_now()); if (i < NE * DM) { const int e = i / DM, k = i - e * DM; const float w = ((const GAS float*)F.router)[k * NE + e];
          const unsigned hi = f2bf(w), lo = f2bf(w - __builtin_bit_cast(float, hi << 16)); ((GAS bf16*)(F.ws + WS_RWT))[i] = (bf16)hi; ((GAS bf16*)(F.ws + WS_RWT))[NE * DM + i] = (bf16)lo; } }
    { GAS float* rc = (GAS float*)(F.ws + WS_ROPEC); GAS float* rs = (GAS float*)(F.ws + WS_ROPES);
#pragma clang loop unroll(disable)
      for (int i = (F.vcu * NWAVES + F.wave) * 64 + lane_now(); i < S * 64; i += F.G * NWAVES * 64) { const int t = i >> 6, f = i & 63; const float ang = (float)t * INV_FREQ[f]; float sn, cs; sincos_acc(ang, sn, cs); rc[i] = cs; rs[i] = sn; } }
    { const GAS f32x4* xs = (const GAS f32x4*)F.x; GAS v4u* hb = (GAS v4u*)(F.ws + WS_HB);
#pragma clang loop unroll(disable)
      for (int i = (F.vcu * NWAVES + F.wave) * 64 + lane_now(); i < S * DM / 8; i += F.G * NWAVES * 64) { const f32x4 a = xs[2 * i], b = xs[2 * i + 1]; v4u o; o.x = pk2(a[0], a[1]); o.y = pk2(a[2], a[3]); o.z = pk2(b[0], b[1]); o.w = pk2(b[2], b[3]); hb[i] = o;
          ((GAS v2u*)(F.ws + WS_HB8))[i] = (v2u){pg8::pk4_fp8(a[0] * ASC_H, a[1] * ASC_H, a[2] * ASC_H, a[3] * ASC_H), pg8::pk4_fp8(b[0] * ASC_H, b[1] * ASC_H, b[2] * ASC_H, b[3] * ASC_H)}; } }
}

__device__ __forceinline__ void kmean_phase(Frame& F) {
    const int lane = lane_now(), c8 = lane & 15, rg = lane >> 4, u2 = F.wave >> 2, q = F.wave & 3, tid = F.wave * 64 + lane;
    LAS float* ks = (LAS float*)(F.lds + RING_OFF + 8 * 8704);
    { const int unit = (int)blockIdx.x + u2 * F.G, j = unit & 63, h = unit >> 6;
      const GAS v4u* kp = (const GAS v4u*)(F.ws + WS_K) + ((size_t)(j * 256 + 64 * q + rg) * 1024 + h * 128) / 8 + c8;
      v4u w[16];
#pragma unroll
      for (int it = 0; it < 16; ++it) w[it] = kp[(size_t)it * 4 * 128];
      float a[8];
#pragma unroll
      for (int i = 0; i < 8; ++i) a[i] = 0.f;
#pragma unroll
      for (int it = 0; it < 16; ++it) { a[0] += bflo(w[it].x); a[1] += bfhi(w[it].x); a[2] += bflo(w[it].y); a[3] += bfhi(w[it].y); a[4] += bflo(w[it].z); a[5] += bfhi(w[it].z); a[6] += bflo(w[it].w); a[7] += bfhi(w[it].w); }
#pragma unroll
      for (int i = 0; i < 8; ++i) { a[i] += shx(a[i], 16, lane); a[i] += shx(a[i], 32, lane); }
      if (rg == 0) { *(LAS f32x4*)(ks + (u2 * 4 + q) * 128 + 8 * c8) = (f32x4){a[0], a[1], a[2], a[3]}; *(LAS f32x4*)(ks + (u2 * 4 + q) * 128 + 8 * c8 + 4) = (f32x4){a[4], a[5], a[6], a[7]}; } }
    __syncthreads();
    if (tid < 128) { const int uu = tid >> 6, cp = tid & 63, unit = (int)blockIdx.x + uu * F.G, j = unit & 63, h = unit >> 6;
        float m0 = 0.f, m1 = 0.f;
#pragma unroll
        for (int qq = 0; qq < 4; ++qq) { const f32x2 v = *(const LAS f32x2*)(ks + (uu * 4 + qq) * 128 + 2 * cp); m0 += v.x; m1 += v.y; }
        m0 *= (1.f / 256.f); m1 *= (1.f / 256.f);
        const unsigned hi = pk2(m0, m1), lo = pk2(m0 - bflo(hi), m1 - bfhi(hi));
        GAS unsigned* kh = (GAS unsigned*)(F.ws + WS_KMEAN) + ((size_t)(h * 64 + j) * 128) / 2 + cp;
        kh[0] = hi; kh[NH * NBLK * HD / 2] = lo; }
}
__device__ __forceinline__ void vt_phase(Frame& F) {
    const int gw = F.vcu * NWAVES + F.wave, NGW = F.G * NWAVES, lane = lane_now();
    LAS unsigned char* tile = F.lds + RING_OFF + F.wave * 8704;
    constexpr int NU = (S / 32) * NH;
    v4u raw[2][8];
#pragma unroll
    for (int k = 0; k < 2; ++k) { const int unit = (gw + k * NGW) & (NU - 1); const int h = unit & 7, kb = (unit >> 3) * 32;
            const GAS v4u* src = (const GAS v4u*)(F.ws + WS_V) + ((size_t)kb * 1024 + h * 128) / 8;
#pragma unroll
            for (int i = 0; i < 8; ++i) raw[k][i] = src[(size_t)(i * 4 + (lane >> 4)) * 128 + (lane & 15)]; }
#pragma unroll
    for (int k = 0; k < 2; ++k) { const int unit = gw + k * NGW; if (unit < NU) { const int h = unit & 7, kb = (unit >> 3) * 32;
#pragma unroll
            for (int i = 0; i < 8; ++i) *(LAS v4u*)(tile + (i * 4 + (lane >> 4)) * 272 + (lane & 15) * 16) = raw[k][i];
            LDS_WAIT(); asm volatile("" ::: "memory");
            const int ch = lane & 3, G = ch >> 1, g = ch & 1;
#pragma unroll
            for (int i = 0; i < 8; ++i) { const int d = i * 16 + (lane >> 2);
                unsigned short e[8];
#pragma unroll
                for (int p = 0; p < 8; ++p) { const int key = 16 * G + 8 * (p >> 2) + 4 * g + (p & 3); e[p] = *(const LAS unsigned short*)(tile + key * 272 + d * 2); }
                v4u o; o.x = (unsigned)e[0] | ((unsigned)e[1] << 16); o.y = (unsigned)e[2] | ((unsigned)e[3] << 16); o.z = (unsigned)e[4] | ((unsigned)e[5] << 16); o.w = (unsigned)e[6] | ((unsigned)e[7] << 16);
                *((GAS v4u*)(F.ws + WS_VT) + ((size_t)(h * 128 + d) * S + kb + 8 * ch) / 8) = o; }
            LDS_WAIT(); asm volatile("" ::: "memory"); } }
}

constexpr int CT = 16, CROWS = CT + 30;
__device__ __forceinline__ void conv_phase(Frame& F, int l) {
    LAS unsigned* ub = (LAS unsigned*)(F.lds + RING_OFF);
    LAS f32x2* part = (LAS f32x2*)(F.lds + RING_OFF + CROWS * 2048);
    const int lane = lane_now(), tid = F.wave * 64 + lane;
    const GAS f32x2* cw = (const GAS f32x2*)(F.conv_w + (size_t)l * CKW * 1024) + tid;
    float w0[CKW], w1[CKW];
#pragma unroll
    for (int k = 0; k < CKW; ++k) { const f32x2 w = cw[k * 512]; w0[k] = w.x; w1[k] = w.y; }
    const f32x2 cb = ((const GAS f32x2*)(F.conv_b + l * 1024))[tid], lg = ((const GAS f32x2*)(F.conv_g + l * 1024))[tid], lb = ((const GAS f32x2*)(F.conv_be + l * 1024))[tid];
    const GAS v4u* U = (const GAS v4u*)(F.ws + WS_U);
    GAS unsigned* CAT = (GAS unsigned*)(F.ws + WS_CAT);
    constexpr int NP = (CROWS * 128 + NWAVES * 64 - 1) / (NWAVES * 64);
    const int tb = (int)blockIdx.x * 64;
#pragma clang loop unroll(disable)
    for (int st = 0; st < 4; ++st) { const int t0 = tb + st * CT;
        TSTART(21);
        { const int lane2 = lane_now(), tid2 = F.wave * 64 + lane2;
          v4u nx[NP];
#pragma unroll
          for (int i = 0; i < NP; ++i) { const int p = tid2 + NWAVES * 64 * i, pc = p < CROWS * 128 ? p : CROWS * 128 - 1, tok = t0 - 30 + (pc >> 7);
              const v4u ld = U[(size_t)(tok >= 0 ? tok : 0) * 128 + (pc & 127)]; const bool ok = tok >= 0; nx[i].x = ok ? ld.x : 0u; nx[i].y = ok ? ld.y : 0u; nx[i].z = ok ? ld.z : 0u; nx[i].w = ok ? ld.w : 0u; }
#pragma unroll
          for (int i = 0; i < NP; ++i) { const int p = tid2 + NWAVES * 64 * i; if (p < CROWS * 128) *(LAS v4u*)(ub + (p >> 7) * 512 + (p & 127) * 4) = nx[i]; } }
        __syncthreads();
        TSTOP(21); TSTART(22);
        f32x2 av[CT];
#pragma unroll
        for (int t = 0; t < CT; ++t) av[t] = cb;
#pragma unroll
        for (int r = 0; r < CROWS; ++r) { const unsigned w = ub[r * 512 + tid]; const f32x2 x = {bflo(w), bfhi(w)};
#pragma unroll
            for (int t = 0; t < CT; ++t) { if (r - t >= 0 && r - t <= 30) av[t] += (f32x2){w0[r - t], w1[r - t]} * x; } }
        TSTOP(22); TSTART(23);
        { float red[2 * CT];
#pragma unroll
          for (int t = 0; t < CT; ++t) { red[2 * t] = av[t].x + av[t].y; red[2 * t + 1] = av[t].x * av[t].x + av[t].y * av[t].y; }
          float r16[16], r8[8], r4[4], r2[2], r1;
#define RS_STEP(dst, src, n, bit) { const bool hi = (lane & (bit)) != 0; float snd_[n], kp_[n]; \
            _Pragma("unroll") for (int i = 0; i < (n); ++i) { float lo_ = src[i], up_ = src[i + (n)]; asm volatile("" : "+v"(lo_), "+v"(up_));     \
                snd_[i] = shx(hi ? lo_ : up_, (bit), lane); kp_[i] = hi ? up_ : lo_; } \
            _Pragma("unroll") for (int i = 0; i < (n); ++i) dst[i] = kp_[i] + snd_[i]; }
          RS_STEP(r16, red, 16, 32) RS_STEP(r8, r16, 8, 16) RS_STEP(r4, r8, 4, 8) RS_STEP(r2, r4, 2, 4)
          { const bool hi = (lane & 2) != 0; float lo_ = r2[0], up_ = r2[1]; asm volatile("" : "+v"(lo_), "+v"(up_)); const float snd = shx(hi ? lo_ : up_, 2, lane); r1 = (hi ? up_ : lo_) + snd; }
#undef RS_STEP
          r1 += shx(r1, 1, lane);
          if ((lane & 1) == 0) ((LAS float*)part)[F.wave * (2 * CT) + (lane >> 1)] = r1; }
        __syncthreads();
        LAS f32x2* fin = part + NWAVES * CT;
        if (tid < CT) { float s1 = 0.f, q = 0.f;
#pragma unroll
            for (int w = 0; w < 8; ++w) { const f32x2 pp = part[w * CT + tid]; s1 += pp.x; q += pp.y; }
            const float mean = s1 * (1.f / 1024.f), var = fmaxf(q * (1.f / 1024.f) - mean * mean, 0.f);
            fin[tid] = (f32x2){mean, 1.0f / sqrtf(var + LN_EPS)}; }
        __syncthreads();
        TSTOP(23); TSTART(24);
        { f32x4 fv[CT / 2];
#pragma unroll
          for (int i = 0; i < CT / 2; ++i) fv[i] = ((const LAS f32x4*)fin)[i];
#pragma unroll
          for (int t = 0; t < CT; ++t) { const float mean = fv[t >> 1][2 * (t & 1)], rstd = fv[t >> 1][2 * (t & 1) + 1];
              const float y0 = (av[t].x - mean) * rstd * lg.x + lb.x, y1 = (av[t].y - mean) * rstd * lg.y + lb.y;
              ((GAS unsigned short*)(F.ws + WS_CAT))[((size_t)(t0 + t) * DM + 1024) / 2 + tid] = (unsigned short)pg8::pk4_fp8(y0 * pg8::sigmoidf_fast(y0) * ASC_CAT, y1 * pg8::sigmoidf_fast(y1) * ASC_CAT, 0.f, 0.f); } }
        __syncthreads();
        TSTOP(24);
    }
}

typedef float f32x16 __attribute__((ext_vector_type(16)));
typedef __bf16 bf16x2_t __attribute__((ext_vector_type(2)));
__device__ __forceinline__ unsigned cvtpk(float lo, float hi) { const f32x2 v = {lo, hi}; const bf16x2_t b = __builtin_convertvector(v, bf16x2_t); return __builtin_bit_cast(unsigned, b); }
#define MFMA32(a, b, c) __builtin_amdgcn_mfma_f32_32x32x16_bf16((a), (b), (c), 0, 0, 0)
constexpr int LIST_PER_HEAD = 256 * 2016;
__device__ __forceinline__ int binoff(int j) { return 256 * (63 * j - (j * (j - 1)) / 2); }
#define TOP3_INSERT(v, j) do { const float v_ = (v); const int j_ = (j); \
    if (v_ > tv2) { if (v_ > tv1) { tv2 = tv1; ti2 = ti1; if (v_ > tv0) { tv1 = tv0; ti1 = ti0; tv0 = v_; ti0 = j_; } else { tv1 = v_; ti1 = j_; } } else { tv2 = v_; ti2 = j_; } } } while (0)
__device__ __forceinline__ void sel_phase(Frame& F, int l) {
    LAS int* cntL = (LAS int*)(F.lds + RING_OFF); LAS int* baseL = cntL + 64;
    const int lane = lane_now(), r = lane & 31, hg = lane >> 5, tid = F.wave * 64 + lane;
    const float NEG = -__builtin_inff();
#pragma clang loop unroll(disable)
    for (int unit = blockIdx.x; unit < 63 * NH; unit += F.G) { const int b = 1 + (unit >> 3), h = unit & 7;
        if (tid < 64) cntL[tid] = 0;
        __syncthreads();
        const int t = b * 256 + F.wave * 32 + r;
        const GAS bf16x8* qp = (const GAS bf16x8*)(F.ws + WS_Q) + ((size_t)t * 1024 + h * 128) / 8 + hg;
        bf16x8 qf[8];
#pragma unroll
        for (int kk = 0; kk < 8; ++kk) qf[kk] = qp[2 * kk];
        const GAS bf16x8* kh = (const GAS bf16x8*)(F.ws + WS_KMEAN) + ((size_t)(h * 64 + r) * 128) / 8 + hg;
        f32x16 G0, G1;
#pragma unroll
        for (int i = 0; i < 16; ++i) { G0[i] = 0.f; G1[i] = 0.f; }
#pragma unroll
        for (int kk = 0; kk < 8; ++kk) { G0 = MFMA32(kh[2 * kk], qf[kk], G0); G0 = MFMA32(kh[2 * kk + NH * NBLK * HD / 8], qf[kk], G0); }
        if (b > 32) {
#pragma unroll
            for (int kk = 0; kk < 8; ++kk) { G1 = MFMA32(kh[2 * kk + 32 * 16], qf[kk], G1); G1 = MFMA32(kh[2 * kk + 32 * 16 + NH * NBLK * HD / 8], qf[kk], G1); } }
        float tv0 = NEG, tv1 = NEG, tv2 = NEG; int ti0 = 0, ti1 = 0, ti2 = 0;
#pragma unroll
        for (int i = 0; i < 16; ++i) { const int j = (i & 3) + 8 * (i >> 2) + 4 * hg; TOP3_INSERT(j < b ? G0[i] : NEG, j); }
        if (b > 32) {
#pragma unroll
            for (int i = 0; i < 16; ++i) { const int j = 32 + (i & 3) + 8 * (i >> 2) + 4 * hg; TOP3_INSERT(j < b ? G1[i] : NEG, j); } }
        { const float p0 = shx(tv0, 32, lane), p1 = shx(tv1, 32, lane), p2 = shx(tv2, 32, lane); const int q0 = shx_i(ti0, 32, lane), q1 = shx_i(ti1, 32, lane), q2 = shx_i(ti2, 32, lane);
          TOP3_INSERT(p0, q0); TOP3_INSERT(p1, q1); TOP3_INSERT(p2, q2); }
        int rk0 = 0, rk1 = 0, rk2 = 0;
        if (hg == 0) {
            if (tv0 > NEG) rk0 = __hip_atomic_fetch_add(cntL + ti0, 1, __ATOMIC_RELAXED, __HIP_MEMORY_SCOPE_WORKGROUP);
            if (tv1 > NEG) rk1 = __hip_atomic_fetch_add(cntL + ti1, 1, __ATOMIC_RELAXED, __HIP_MEMORY_SCOPE_WORKGROUP);
            if (tv2 > NEG) rk2 = __hip_atomic_fetch_add(cntL + ti2, 1, __ATOMIC_RELAXED, __HIP_MEMORY_SCOPE_WORKGROUP); }
        __syncthreads();
        if (tid < 64) { const int c = cntL[tid]; if (c > 0) baseL[tid] = (int)__hip_atomic_fetch_add(F.ctl + CW_LCNT + l * 512 + h * 64 + tid, (unsigned)c, RLX_AGENT); }
        __syncthreads();
        if (hg == 0) { GAS int* L = (GAS int*)(F.ws + WS_LIST) + (size_t)h * LIST_PER_HEAD;
            if (tv0 > NEG) L[binoff(ti0) + baseL[ti0] + rk0] = t * 4 + 0;
            if (tv1 > NEG) L[binoff(ti1) + baseL[ti1] + rk1] = t * 4 + 1;
            if (tv2 > NEG) L[binoff(ti2) + baseL[ti2] + rk2] = t * 4 + 2; }
        __syncthreads();
    }
}
constexpr int KROW = 272, VROW = 528, KBUF_BYTES = 256 * KROW, VBUF_BYTES = 128 * VROW;
#define SCHED_FENCE() __builtin_amdgcn_sched_barrier(0)
template <bool CAUSAL>
__device__ __forceinline__ void moba_tile(const bf16x8 (&qf)[8], const LAS unsigned char* kb, const LAS unsigned char* vb, const int nkt, const int r, const int hg, f32x16 (&O)[4], float& ms, float& lsum) {
    const float NEG = -__builtin_inff(), SC = 0.08838834764831845f * 1.44269504088896341f;
    f32x16 Sx[8];
    bf16x8 kfA[8], kfB[8];
#pragma unroll
    for (int kk = 0; kk < 8; ++kk) kfA[kk] = *(const LAS bf16x8*)(kb + kk * 32);
#pragma unroll
    for (int kt = 0; kt < 8; ++kt) {
        if (kt < nkt) { f32x16 a;
#pragma unroll
            for (int i = 0; i < 16; ++i) a[i] = 0.f;
            if (kt + 1 < 8 && kt + 1 < nkt) {
#pragma unroll
                for (int kk = 0; kk < 8; ++kk) { if (kt & 1) kfA[kk] = *(const LAS bf16x8*)(kb + (kt + 1) * 32 * KROW + kk * 32); else kfB[kk] = *(const LAS bf16x8*)(kb + (kt + 1) * 32 * KROW + kk * 32); } }
            SCHED_FENCE();
#pragma unroll
            for (int kk = 0; kk < 8; ++kk) a = MFMA32((kt & 1) ? kfB[kk] : kfA[kk], qf[kk], a);
            SCHED_FENCE();
            if (CAUSAL && kt == nkt - 1) {
#pragma unroll
                for (int i = 0; i < 16; ++i) a[i] = ((i & 3) + 8 * (i >> 2) + 4 * hg > r) ? NEG : a[i]; }
            Sx[kt] = a;
        } else {
#pragma unroll
            for (int i = 0; i < 16; ++i) Sx[kt][i] = NEG; }
    }
    float mx = NEG;
#pragma unroll
    for (int kt = 0; kt < 8; ++kt)
#pragma unroll
        for (int i = 0; i < 16; ++i) mx = fmaxf(mx, Sx[kt][i]);
    mx = fmaxf(mx, shx(mx, 32, r + 32 * hg));
    ms = mx * SC;
    float ls = 0.f;
    bf16x8 pb[8][2];
#pragma unroll
    for (int kt = 0; kt < 8; ++kt)
#pragma unroll
        for (int s2 = 0; s2 < 2; ++s2) { float p[8];
#pragma unroll
            for (int i = 0; i < 8; ++i) { p[i] = __builtin_amdgcn_exp2f(Sx[kt][8 * s2 + i] * SC - ms); ls += p[i]; }
            v4u pw; pw.x = cvtpk(p[0], p[1]); pw.y = cvtpk(p[2], p[3]); pw.z = cvtpk(p[4], p[5]); pw.w = cvtpk(p[6], p[7]);
            pb[kt][s2] = __builtin_bit_cast(bf16x8, pw); }
    lsum = ls + shx(ls, 32, r + 32 * hg);
#pragma unroll
    for (int dt = 0; dt < 4; ++dt)
#pragma unroll
        for (int i = 0; i < 16; ++i) O[dt][i] = 0.f;
    bf16x8 vfA[4], vfB[4];
#pragma unroll
    for (int dt = 0; dt < 4; ++dt) vfA[dt] = *(const LAS bf16x8*)(vb + dt * 32 * VROW);
#pragma unroll
    for (int st = 0; st < 16; ++st) { const int kt = st >> 1, s2 = st & 1;
        if (kt < nkt) {
            if (st + 1 < 16 && ((st + 1) >> 1) < nkt) {
#pragma unroll
                for (int dt = 0; dt < 4; ++dt) { if (st & 1) vfA[dt] = *(const LAS bf16x8*)(vb + dt * 32 * VROW + (st + 1) * 32); else vfB[dt] = *(const LAS bf16x8*)(vb + dt * 32 * VROW + (st + 1) * 32); } }
            SCHED_FENCE();
#pragma unroll
            for (int dt = 0; dt < 4; ++dt) O[dt] = MFMA32((st & 1) ? vfB[dt] : vfA[dt], pb[kt][s2], O[dt]);
            SCHED_FENCE();
        }
    }
}
__device__ __forceinline__ void stage_kv(Frame& F, int h, int j, int tid) {
    LAS unsigned char* kbuf = F.lds + RING_OFF; LAS unsigned char* vbuf = kbuf + KBUF_BYTES;
    const GAS v4u* kg = (const GAS v4u*)(F.ws + WS_K) + ((size_t)(j * 256) * 1024 + h * 128) / 8;
    const GAS v4u* vg = (const GAS v4u*)(F.ws + WS_VT) + ((size_t)(h * 128) * S + j * 256) / 8;
    v4u kr[8], vr[8];
#pragma unroll
    for (int i = 0; i < 8; ++i) { const int p = tid + 512 * i; kr[i] = kg[(size_t)(p >> 4) * 128 + (p & 15)]; vr[i] = vg[(size_t)(p >> 5) * (S / 8) + (p & 31)]; }
#pragma unroll
    for (int i = 0; i < 8; ++i) { const int p = tid + 512 * i; *(LAS v4u*)(kbuf + (p >> 4) * KROW + (p & 15) * 16) = kr[i]; *(LAS v4u*)(vbuf + (p >> 5) * VROW + (p & 31) * 16) = vr[i]; }
}
__device__ __forceinline__ void partial_phase(Frame& F, int l) {
    gu32* lcnt = F.ctl + CW_LCNT + l * 512;
    LAS int* tab = (LAS int*)(F.lds + RING_OFF + KBUF_BYTES + VBUF_BYTES);
    LAS int* tabc = tab + 512;
    LAS int* tabn = tab + 1024;
    { const int lane = lane_now(); int tl[8], cs[8], cn[8], sum = 0, csum = 0;
#pragma unroll
      for (int i = 0; i < 8; ++i) { cn[i] = (int)__hip_atomic_load(lcnt + lane * 8 + i, RLX_AGENT); tl[i] = (cn[i] + 255) >> 8; cs[i] = 14 * tl[i] + (tl[i] ? 11 : 0); sum += tl[i]; csum += cs[i]; }
      int inc = sum, cinc = csum;
#pragma unroll
      for (int o = 1; o < 64; o <<= 1) { const int v = __builtin_amdgcn_ds_bpermute((lane - o) << 2, inc), cv = __builtin_amdgcn_ds_bpermute((lane - o) << 2, cinc); if (lane >= o) { inc += v; cinc += cv; } }
      int run = inc - sum, crun = cinc - csum;
      if (F.wave == 0) {
#pragma unroll
          for (int i = 0; i < 8; ++i) { run += tl[i]; crun += cs[i]; tab[lane * 8 + i] = run; tabc[lane * 8 + i] = crun; tabn[lane * 8 + i] = cn[i]; } } }
    __syncthreads();
    int u_lo, u_hi;
    { const int lane = lane_now(); const long T = tabc[511];
      const int x0 = (int)(((long)blockIdx.x * T) / F.G), x1 = (int)(((long)(blockIdx.x + 1) * T) / F.G);
      int c0 = 0, c1 = 0; int plo = lane ? tabc[lane * 8 - 1] : 0, pu = lane ? tab[lane * 8 - 1] : 0;
#pragma unroll
      for (int i = 0; i < 8; ++i) { const int hi = tabc[lane * 8 + i], uu = tab[lane * 8 + i], nu = uu - pu;
          { const int loc = x0 - plo; c0 += (x0 >= hi) ? nu : (loc <= 0 ? 0 : (loc <= 25 ? 1 : 1 + (loc - 25 + 13) / 14)); }
          { const int loc = x1 - plo; c1 += (x1 >= hi) ? nu : (loc <= 0 ? 0 : (loc <= 25 ? 1 : 1 + (loc - 25 + 13) / 14)); }
          plo = hi; pu = uu; }
#pragma unroll
      for (int o = 1; o < 64; o <<= 1) { c0 += shx_i(c0, o, lane); c1 += shx_i(c1, o, lane); }
      u_lo = __builtin_amdgcn_readfirstlane(c0); u_hi = __builtin_amdgcn_readfirstlane(c1); }
    int staged = -1;
#define PARTIAL_LOCATE(uu, obin, ochunk, oe) { const int lane_ = lane_now(); int b_ = 0, c_ = 0; bool m_ = false; \
        { int lo_ = lane_ ? tab[lane_ * 8 - 1] : 0; \
          _Pragma("unroll") for (int i = 0; i < 8; ++i) { const int hi_ = tab[lane_ * 8 + i]; if ((uu) >= lo_ && (uu) < hi_) { m_ = true; b_ = lane_ * 8 + i; c_ = (uu) - lo_; } lo_ = hi_; } } \
        const int s_ = __builtin_ctzll(__ballot(m_)); obin = __builtin_amdgcn_readlane(b_, s_); ochunk = __builtin_amdgcn_readlane(c_, s_); \
        const int n_ = __builtin_amdgcn_readfirstlane(tabn[obin]), base_ = ochunk * 256 + F.wave * 32, r_ = lane_ & 31; \
        oe = ((const GAS int*)(F.ws + WS_LIST))[(size_t)(obin >> 6) * LIST_PER_HEAD + binoff(obin & 63) + (base_ < n_ ? base_ + (base_ + r_ < n_ ? r_ : 0) : 0)]; }
    int nbin = 0, nchunk = 0, ne = 0;
    if (u_lo < u_hi) PARTIAL_LOCATE(u_lo, nbin, nchunk, ne)
#pragma clang loop unroll(disable)
    for (int u = u_lo; u < u_hi; ++u) {
        const int lane = lane_now(), r = lane & 31, hg = lane >> 5, tid = F.wave * 64 + lane;
        const LAS unsigned char* kb = F.lds + RING_OFF + r * KROW + hg * 16; const LAS unsigned char* vb = F.lds + RING_OFF + KBUF_BYTES + r * VROW + hg * 16;
        TSTART(41);
        const int bin = nbin, chunk = nchunk, e = ne;
        { const int un = (u + 1 < u_hi) ? u + 1 : u; PARTIAL_LOCATE(un, nbin, nchunk, ne) }
        const int h = bin >> 6, j = bin & 63, n = __builtin_amdgcn_readfirstlane(tabn[bin]);
        const int base = chunk * 256 + F.wave * 32; const bool active = base < n, valid = base + r < n;
        const int t = e >> 2, sl = e & 3;
        const GAS bf16x8* qp = (const GAS bf16x8*)(F.ws + WS_Q) + ((size_t)t * 1024 + h * 128) / 8 + hg;
        bf16x8 qf[8];
#pragma unroll
        for (int kk = 0; kk < 8; ++kk) qf[kk] = qp[2 * kk];
        TSTOP(41); TSTART(42);
        if (bin != staged) {
            __syncthreads();
            stage_kv(F, h, j, tid);
            __syncthreads();
            staged = bin; }
        TSTOP(42);
        if (active) {
            f32x16 O[4]; float ms, ls;
            TSTART(43);
            moba_tile<false>(qf, kb, vb, 8, r, hg, O, ms, ls);
            TSTOP(43); TSTART(44);
            if (valid) { const size_t idx = ((size_t)h * S + t) * 3 + sl; const float inv = 1.0f / ls;
                GAS v2u* po = (GAS v2u*)(F.ws + WS_PO) + idx * 32 + hg;
#pragma unroll
                for (int dt = 0; dt < 4; ++dt)
#pragma unroll
                    for (int g4 = 0; g4 < 4; ++g4) po[dt * 8 + 2 * g4] = (v2u){cvtpk(O[dt][4 * g4] * inv, O[dt][4 * g4 + 1] * inv), cvtpk(O[dt][4 * g4 + 2] * inv, O[dt][4 * g4 + 3] * inv)};
                if (hg == 0) ((GAS f32x2*)(F.ws + WS_PML))[idx] = (f32x2){ms, ls}; }
            TSTOP(44);
        }
    }
#undef PARTIAL_LOCATE
}
__device__ __forceinline__ void own_phase(Frame& F) {
#pragma clang loop unroll(disable)
    for (int u = blockIdx.x; u < NBLK * NH; u += F.G) { const int h = u & 7, b = u >> 3, qt = F.wave;
        const int lane = lane_now(), r = lane & 31, hg = lane >> 5, tid = F.wave * 64 + lane;
        const LAS unsigned char* kb = F.lds + RING_OFF + r * KROW + hg * 16; const LAS unsigned char* vb = F.lds + RING_OFF + KBUF_BYTES + r * VROW + hg * 16;
        const int t = b * 256 + qt * 32 + r;
        const GAS bf16x8* qp = (const GAS bf16x8*)(F.ws + WS_Q) + ((size_t)t * 1024 + h * 128) / 8 + hg;
        bf16x8 qf[8];
#pragma unroll
        for (int kk = 0; kk < 8; ++kk) qf[kk] = qp[2 * kk];
        __syncthreads();
        stage_kv(F, h, b, tid);
        __syncthreads();
        f32x16 O[4]; float ms, ls;
        moba_tile<true>(qf, kb, vb, qt + 1, r, hg, O, ms, ls);
        __syncthreads();
        { LAS unsigned char* ow = F.lds + RING_OFF + F.wave * 8704;
          LAS f32x2* stq = (LAS f32x2*)(F.lds + RING_OFF + KBUF_BYTES) + F.wave * 32;
#pragma unroll
          for (int dt = 0; dt < 4; ++dt)
#pragma unroll
              for (int g4 = 0; g4 < 4; ++g4) *(LAS v2u*)(ow + r * 272 + (dt * 32 + 8 * g4 + 4 * hg) * 2) = (v2u){cvtpk(O[dt][4 * g4], O[dt][4 * g4 + 1]), cvtpk(O[dt][4 * g4 + 2], O[dt][4 * g4 + 3])};
          if (hg == 0) stq[r] = (f32x2){ms, ls};
          LDS_WAIT(); asm volatile("" ::: "memory");
          const int qq = lane >> 4, c = lane & 15, nv = b < 3 ? b : 3;
#pragma unroll
          for (int half = 0; half < 2; ++half) {
              v4u pv[4][3]; f32x2 pml[4][3];
#pragma unroll
              for (int pp = 0; pp < 4; ++pp) { const int q = 4 * (half * 4 + pp) + qq; const size_t idx0 = ((size_t)h * S + (b * 256 + qt * 32 + q)) * 3;
#pragma unroll
                  for (int s2 = 0; s2 < 3; ++s2) { const int so = s2 < nv ? s2 : 0;
                      pv[pp][s2] = ((const GAS v4u*)(F.ws + WS_PO))[(idx0 + so) * 16 + c]; pml[pp][s2] = ((const GAS f32x2*)(F.ws + WS_PML))[idx0 + so]; } }
#pragma unroll
              for (int pp = 0; pp < 4; ++pp) { const int q = 4 * (half * 4 + pp) + qq, t2 = b * 256 + qt * 32 + q;
                  const f32x2 own = stq[q]; const v4u ov = *(const LAS v4u*)(ow + q * 272 + c * 16);
                  float M = own.x;
#pragma unroll
                  for (int s2 = 0; s2 < 3; ++s2) { const bool have = s2 < nv; pml[pp][s2].x = have ? pml[pp][s2].x : -__builtin_inff(); pml[pp][s2].y = have ? pml[pp][s2].y : 0.f;
                      pv[pp][s2].x = have ? pv[pp][s2].x : 0u; pv[pp][s2].y = have ? pv[pp][s2].y : 0u; pv[pp][s2].z = have ? pv[pp][s2].z : 0u; pv[pp][s2].w = have ? pv[pp][s2].w : 0u;
                      M = fmaxf(M, pml[pp][s2].x); }
                  const float wo = __builtin_amdgcn_exp2f(own.x - M); float W = own.y * wo, w[3];
#pragma unroll
                  for (int s2 = 0; s2 < 3; ++s2) { w[s2] = pml[pp][s2].y * __builtin_amdgcn_exp2f(pml[pp][s2].x - M); W += w[s2]; }
                  float o[8] = {bflo(ov.x) * wo, bfhi(ov.x) * wo, bflo(ov.y) * wo, bfhi(ov.y) * wo, bflo(ov.z) * wo, bfhi(ov.z) * wo, bflo(ov.w) * wo, bfhi(ov.w) * wo};
#pragma unroll
                  for (int s2 = 0; s2 < 3; ++s2) { const v4u v = pv[pp][s2]; o[0] += w[s2] * bflo(v.x); o[1] += w[s2] * bfhi(v.x); o[2] += w[s2] * bflo(v.y); o[3] += w[s2] * bfhi(v.y); o[4] += w[s2] * bflo(v.z); o[5] += w[s2] * bfhi(v.z); o[6] += w[s2] * bflo(v.w); o[7] += w[s2] * bfhi(v.w); }
                  const float osc = ASC_CAT / W;
                  *(GAS v2u*)(F.ws + WS_CAT + (size_t)t2 * DM + h * 128 + 8 * c) = (v2u){pg8::pk4_fp8(o[0] * osc, o[1] * osc, o[2] * osc, o[3] * osc), pg8::pk4_fp8(o[4] * osc, o[5] * osc, o[6] * osc, o[7] * osc)}; }
          } }
    }
}

__device__ __forceinline__ void ln_phase(Frame& F, const float* xres_, const bf16* y_, const float* g_, const float* b_, const float* router, bool write8) {
    const int gw = F.vcu * NWAVES + F.wave, lane = lane_now();
    f32x4 gv[8], bv[8];
#pragma unroll
    for (int j = 0; j < 8; ++j) { gv[j] = ((const GAS f32x4*)g_)[lane + 64 * j]; bv[j] = ((const GAS f32x4*)b_)[lane + 64 * j]; }
    f32x4 hraw[8]; v2u hraw16[8], yraw[8];
    { const GAS v2u* yp = (const GAS v2u*)(y_ + (size_t)(gw * 8) * DM) + lane;
      if (xres_) { const GAS f32x4* hp = (const GAS f32x4*)(xres_ + (size_t)(gw * 8) * DM) + lane;
#pragma unroll
          for (int j = 0; j < 8; ++j) hraw[j] = hp[64 * j]; }
      else { const GAS v2u* hp = (const GAS v2u*)(F.ws + WS_HB + (size_t)(gw * 8) * DM * 2) + lane;
#pragma unroll
          for (int j = 0; j < 8; ++j) hraw16[j] = hp[64 * j]; }
#pragma unroll
      for (int j = 0; j < 8; ++j) yraw[j] = yp[64 * j]; }
#pragma clang loop unroll(disable)
    for (int i = 0; i < S / (256 * NWAVES); ++i) { const int row = gw * (S / (256 * NWAVES)) + i;
        f32x4 v[8]; float s = 0.f;
#pragma unroll
        for (int j = 0; j < 8; ++j) { const v2u yv = yraw[j]; const f32x4 hv = xres_ ? hraw[j] : (f32x4){bflo(hraw16[j].x), bfhi(hraw16[j].x), bflo(hraw16[j].y), bfhi(hraw16[j].y)};
            v[j] = hv * ALPHA + (f32x4){bflo(yv.x), bfhi(yv.x), bflo(yv.y), bfhi(yv.y)}; s += (v[j][0] + v[j][1]) + (v[j][2] + v[j][3]); }
        { const int rown = (i + 1 < S / (256 * NWAVES)) ? row + 1 : row;
          const GAS v2u* yp = (const GAS v2u*)(y_ + (size_t)rown * DM) + lane;
            if (xres_) { const GAS f32x4* hp = (const GAS f32x4*)(xres_ + (size_t)rown * DM) + lane;
#pragma unroll
                for (int j = 0; j < 8; ++j) hraw[j] = hp[64 * j]; }
            else { const GAS v2u* hp = (const GAS v2u*)(F.ws + WS_HB + (size_t)rown * DM * 2) + lane;
#pragma unroll
                for (int j = 0; j < 8; ++j) hraw16[j] = hp[64 * j]; }
#pragma unroll
            for (int j = 0; j < 8; ++j) yraw[j] = yp[64 * j]; }
        const float mean = wave_sum(s, lane) * (1.f / DM); float s2 = 0.f;
#pragma unroll
        for (int j = 0; j < 8; ++j) { v[j] = v[j] - mean; s2 += (v[j][0] * v[j][0] + v[j][1] * v[j][1]) + (v[j][2] * v[j][2] + v[j][3] * v[j][3]); }
        const float rstd = 1.f / sqrtf(wave_sum(s2, lane) * (1.f / DM) + LN_EPS);
        GAS v2u* hb = (GAS v2u*)(F.ws + WS_HB + (size_t)row * DM * 2) + lane;
#pragma unroll
        for (int j = 0; j < 8; ++j) { v[j] = v[j] * rstd * gv[j] + bv[j]; hb[64 * j] = (v2u){pk2(v[j][0], v[j][1]), pk2(v[j][2], v[j][3])};
            if (write8) ((GAS unsigned*)(F.ws + WS_HB8 + (size_t)row * DM))[64 * j + lane] = pg8::pk4_fp8(v[j][0] * ASC_H, v[j][1] * ASC_H, v[j][2] * ASC_H, v[j][3] * ASC_H); }
    }
}
typedef float f32x4r __attribute__((ext_vector_type(4)));
__device__ __forceinline__ void router_phase(Frame& F) {
    const int lane = lane_now(), rr = lane & 15, kg = lane >> 4, w = F.wave;
    LAS float* lg = (LAS float*)(F.lds + RING_OFF);
    const GAS bf16x8* bp = (const GAS bf16x8*)(F.ws + WS_RWT) + ((size_t)(rr & 7) * DM + 256 * w) / 8 + kg;
    const bool colok = rr < 8;
    bf16x8 bh[8], bl[8], af[4][8];
#pragma unroll
    for (int kk = 0; kk < 8; ++kk) { bh[kk] = bp[4 * kk]; bl[kk] = bp[4 * kk + NE * DM / 8]; }
#pragma unroll
    for (int g = 0; g < 4; ++g) { const int row0 = ((int)blockIdx.x + F.G * g) * 16; const GAS bf16x8* ap = (const GAS bf16x8*)(F.ws + WS_HB) + ((size_t)(row0 + rr) * DM + 256 * w) / 8 + kg;
#pragma unroll
        for (int kk = 0; kk < 8; ++kk) af[g][kk] = ap[4 * kk]; }
    if (!colok) {
#pragma unroll
        for (int kk = 0; kk < 8; ++kk) { bh[kk] = (bf16x8){0, 0, 0, 0, 0, 0, 0, 0}; bl[kk] = bh[kk]; } }
#pragma unroll
    for (int g = 0; g < 4; ++g) { f32x4r acc = {0.f, 0.f, 0.f, 0.f};
#pragma unroll
        for (int kk = 0; kk < 8; ++kk) { acc = __builtin_amdgcn_mfma_f32_16x16x32_bf16(af[g][kk], bh[kk], acc, 0, 0, 0); acc = __builtin_amdgcn_mfma_f32_16x16x32_bf16(af[g][kk], bl[kk], acc, 0, 0, 0); }
        if (colok) {
#pragma unroll
            for (int i = 0; i < 4; ++i) lg[((g * 8 + w) * 16 + 4 * kg + i) * 8 + rr] = acc[i]; } }
    __syncthreads();
    if (w == 0) { const int g = lane >> 4, r = lane & 15; float v[8] = {0.f, 0.f, 0.f, 0.f, 0.f, 0.f, 0.f, 0.f};
#pragma unroll
        for (int ww = 0; ww < 8; ++ww) { const f32x4r l0 = *(const LAS f32x4r*)(lg + ((g * 8 + ww) * 16 + r) * 8), l1 = *(const LAS f32x4r*)(lg + ((g * 8 + ww) * 16 + r) * 8 + 4);
            v[0] += l0[0]; v[1] += l0[1]; v[2] += l0[2]; v[3] += l0[3]; v[4] += l1[0]; v[5] += l1[1]; v[6] += l1[2]; v[7] += l1[3]; }
        float v1 = v[0]; int i1 = 0;
#pragma unroll
        for (int e = 1; e < 8; ++e) if (v[e] > v1) { v1 = v[e]; i1 = e; }
        float v2 = -__builtin_inff(); int i2 = -1;
#pragma unroll
        for (int e = 0; e < 8; ++e) if (e != i1 && v[e] > v2) { v2 = v[e]; i2 = e; }
        const float g1 = 1.0f / (1.0f + __expf(v2 - v1)), g2 = 1.0f - g1; const int row = ((int)blockIdx.x + F.G * g) * 16 + r;
        ((GAS int*)(F.ws + WS_EIDX))[row * 2] = i1; ((GAS int*)(F.ws + WS_EIDX))[row * 2 + 1] = i2; ((GAS float*)(F.ws + WS_GATEW))[row * 2] = g1; ((GAS float*)(F.ws + WS_GATEW))[row * 2 + 1] = g2;
        int mine = 0;
#pragma unroll
        for (int e = 0; e < 8; ++e) { const int c = __builtin_popcountll(__ballot(i1 == e)) + __builtin_popcountll(__ballot(i2 == e)); mine = (lane == e) ? c : mine; }
        if (lane < 8 && mine) __hip_atomic_fetch_add(F.ctl + CW_ECNT + 64 * lane, (unsigned)mine, RLX_AGENT); }
    __syncthreads();
}
__device__ __forceinline__ void load_expert_layout(Frame& F, int (&off)[8], int (&cum)[8], int& npanels) {
    const int lane = lane_now();
    const int cv = (int)__hip_atomic_load(F.ctl + CW_ECNT + 64 * (lane & 7), RLX_AGENT);
    int o = 0;
#pragma unroll
    for (int e = 0; e < 8; ++e) { const int c = __builtin_amdgcn_readlane(cv, e); off[e] = o; cum[e] = o >> 8; o += (c + 255) & ~255; }
    npanels = o >> 8;
}
__device__ __forceinline__ void route_phase(Frame& F) {
    const int gw = F.vcu * NWAVES + F.wave, lane = lane_now();
    int off[8], cum[8], np; load_expert_layout(F, off, cum, np);
    const int row = gw * 8 + (lane >> 1), slot = lane & 1; const bool act = lane < 16;
    const int mye = act ? ((const GAS int*)(F.ws + WS_EIDX))[row * 2 + slot] : -1;
    int pos = 0;
#pragma unroll
    for (int e = 0; e < 8; ++e) { const unsigned long long mask = __ballot(mye == e);
        if (mask) { const int leader = __builtin_ctzll(mask), n = __builtin_popcountll(mask); unsigned b = 0u;
            if (lane == leader) b = __hip_atomic_fetch_add(F.ctl + CW_ECUR + 64 * e, (unsigned)n, RLX_AGENT);
            b = (unsigned)shl_i((int)b, leader);
            if (mye == e) pos = off[e] + (int)b + __builtin_popcountll(mask & ((1ull << lane) - 1ull)); } }
    if (act) ((GAS int*)(F.ws + WS_ROWPOS))[row * 2 + slot] = pos;
#pragma clang loop unroll(disable)
    for (int k0 = 0; k0 < 16; k0 += 8) {
        v4u t[8][2];
#pragma unroll
        for (int k = 0; k < 8; ++k) { const int r = gw * 8 + ((k0 + k) >> 1); const GAS v4u* src = (const GAS v4u*)(F.ws + WS_HB8 + (size_t)r * DM) + lane; t[k][0] = src[0]; t[k][1] = src[64]; }
#pragma unroll
        for (int k = 0; k < 8; ++k) { const int p = __builtin_amdgcn_readfirstlane(shl_i(pos, k0 + k)); GAS v4u* dst = (GAS v4u*)(F.ws + WS_HBP + (size_t)p * DM) + lane; dst[0] = t[k][0]; dst[64] = t[k][1]; }
    }
}
__device__ __forceinline__ void ln_moe_phase(Frame& F, const float* g_, const float* b_) {
    const int gw = F.vcu * NWAVES + F.wave, lane = lane_now();
    f32x4 gv[8], bv[8];
#pragma unroll
    for (int j = 0; j < 8; ++j) { gv[j] = ((const GAS f32x4*)g_)[lane + 64 * j]; bv[j] = ((const GAS f32x4*)b_)[lane + 64 * j]; }
    int mp1 = 0, mp2 = 0; float mg1 = 0.f, mg2 = 0.f;
    if (lane < 8) { const int rr = gw * 8 + lane; mp1 = ((const GAS int*)(F.ws + WS_ROWPOS))[rr * 2]; mp2 = ((const GAS int*)(F.ws + WS_ROWPOS))[rr * 2 + 1]; mg1 = ((const GAS float*)(F.ws + WS_GATEW))[rr * 2]; mg2 = ((const GAS float*)(F.ws + WS_GATEW))[rr * 2 + 1]; }
    v2u hraw[8], araw[8], braw[8];
    { const int p1 = __builtin_amdgcn_readlane(mp1, 0), p2 = __builtin_amdgcn_readlane(mp2, 0);
      const GAS v2u* hp = (const GAS v2u*)(F.ws + WS_HB + (size_t)(gw * 8) * DM * 2) + lane;
      const GAS v2u* y1 = (const GAS v2u*)(F.ws + WS_R2 + (size_t)p1 * DM * 2) + lane; const GAS v2u* y2 = (const GAS v2u*)(F.ws + WS_R2 + (size_t)p2 * DM * 2) + lane;
#pragma unroll
      for (int j = 0; j < 8; ++j) { hraw[j] = hp[64 * j]; araw[j] = y1[64 * j]; braw[j] = y2[64 * j]; } }
#pragma clang loop unroll(disable)
    for (int i = 0; i < 8; ++i) { const int row = gw * 8 + i;
        const float g1 = __builtin_bit_cast(float, shl_i(__builtin_bit_cast(int, mg1), i)), g2 = __builtin_bit_cast(float, shl_i(__builtin_bit_cast(int, mg2), i));
        f32x4 v[8]; float s = 0.f;
#pragma unroll
        for (int j = 0; j < 8; ++j) { const v2u a = araw[j], b = braw[j];
            const f32x4 fa = (f32x4){bflo(a.x), bfhi(a.x), bflo(a.y), bfhi(a.y)}, fb = (f32x4){bflo(b.x), bfhi(b.x), bflo(b.y), bfhi(b.y)};
            v[j] = (f32x4){bflo(hraw[j].x), bfhi(hraw[j].x), bflo(hraw[j].y), bfhi(hraw[j].y)} * ALPHA + fa * g1 + fb * g2; s += (v[j][0] + v[j][1]) + (v[j][2] + v[j][3]); }
        { const int in = (i + 1 < 8) ? i + 1 : i; const int p1 = __builtin_amdgcn_readfirstlane(shl_i(mp1, in)), p2 = __builtin_amdgcn_readfirstlane(shl_i(mp2, in));
            const GAS v2u* hp = (const GAS v2u*)(F.ws + WS_HB + (size_t)(gw * 8 + in) * DM * 2) + lane;
            const GAS v2u* y1 = (const GAS v2u*)(F.ws + WS_R2 + (size_t)p1 * DM * 2) + lane; const GAS v2u* y2 = (const GAS v2u*)(F.ws + WS_R2 + (size_t)p2 * DM * 2) + lane;
#pragma unroll
            for (int j = 0; j < 8; ++j) { hraw[j] = hp[64 * j]; araw[j] = y1[64 * j]; braw[j] = y2[64 * j]; } }
        const float mean = wave_sum(s, lane) * (1.f / DM); float s2 = 0.f;
#pragma unroll
        for (int j = 0; j < 8; ++j) { v[j] = v[j] - mean; s2 += (v[j][0] * v[j][0] + v[j][1] * v[j][1]) + (v[j][2] * v[j][2] + v[j][3] * v[j][3]); }
        const float rstd = 1.f / sqrtf(wave_sum(s2, lane) * (1.f / DM) + LN_EPS);
        GAS f32x4* op = (GAS f32x4*)(F.out + (size_t)row * DM) + lane;
#pragma unroll
        for (int j = 0; j < 8; ++j) op[64 * j] = v[j] * rstd * gv[j] + bv[j];
    }
}

struct Args { const float* in[18]; float* out; unsigned char* ws; };
__global__ void __launch_bounds__(NWAVES * 64, 2) hymba_fwd(Args args) {
    extern __shared__ __attribute__((aligned(16))) unsigned char lds[];
    Frame F;
    F.lds = (LAS unsigned char*)lds;
    F.MISC = (volatile LAS unsigned*)(F.lds + MISC_OFF);
    F.wave = __builtin_amdgcn_readfirstlane((int)threadIdx.x >> 6);
    F.G = gridDim.x; { const int bx = blockIdx.x; F.vcu = (F.G % 8 == 0) ? (bx % 8) * (F.G / 8) + bx / 8 : bx; }
    F.ws = args.ws; F.ctl = (gu32*)(args.ws + WS_CTL);
    F.x = args.in[0]; F.w_in = args.in[1]; F.conv_w = args.in[2]; F.conv_b = args.in[3]; F.conv_g = args.in[4]; F.conv_be = args.in[5]; F.w_out = args.in[6];
    F.lnm_g = args.in[7]; F.lnm_b = args.in[8]; F.lnf_g = args.in[9]; F.lnf_b = args.in[10]; F.fg = args.in[11]; F.fu = args.in[12]; F.fd = args.in[13];
    F.router = args.in[14]; F.eg = args.in[15]; F.eu = args.in[16]; F.ed = args.in[17]; F.out = args.out;
    for (int u = threadIdx.x; u < (LDS_BYTES - LDSCTL_OFF) / 4; u += NWAVES * 64) ((LAS unsigned*)(F.lds + LDSCTL_OFF))[u] = 0u;
    __syncthreads();
    XcdBarrier bar = xcd_barrier_post((unsigned*)(F.ctl + CW_BAR), F.MISC + 8, F.wave);
#define LAUNDER() asm volatile("" : "+s"(F.ws), "+s"(F.ctl), "+s"(F.out), "+s"(F.x), "+s"(bar.bar), "+s"(F.wave))
#define GRID_BAR_N(k) do { LAUNDER(); TSTART(200); TSTART(200 + (k)); xcd_barrier(bar); TSTOP(200); TSTOP(200 + (k)); LAUNDER(); } while (0)
#define GRID_BAR() GRID_BAR_N(99)
#ifndef PROBE_ID
#define PROBE_ID 0
#endif
    F.tacc = 0ull; F.tt0 = 0ull;
#define HB ((bf16*)(F.ws + WS_HB))
#define Y ((bf16*)(F.ws + WS_R2))

    TSTART(10); p0_prologue(F); TSTOP(10);
    GRID_BAR_N(1);

#pragma clang loop unroll(disable)
    for (int l = 0; l < 2; ++l) {
#ifndef NO_G_INPROJ
        TSTART(11);
        { pg8::Gemm g{(const bf16*)(F.ws + WS_HB8), (const bf16*)(F.ws + WS_WIN + (size_t)l * 20 * MiB), S, 3072, DM / 2, 0}; pg8::StaticOrder So; So.init(S, 3072, F.G, (int)blockIdx.x);
          pg8::EpiInProj E{(bf16*)(F.ws + WS_Q), (bf16*)(F.ws + WS_K), (bf16*)(F.ws + WS_V), (bf16*)(F.ws + WS_U), (const float*)(F.ws + WS_ROPEC), (const float*)(F.ws + WS_ROPES), 1.0f / (WSC_GU * ASC_H), 0};
          pg8::gemm_phase<pg8::EpiInProj, pg8::StaticOrder, true, true, true>(F.lds + RING_OFF, g, So, E, F.wave); }
        { pg8::Gemm g{HB, (const bf16*)(F.ws + WS_WIN + (size_t)l * 20 * MiB + 8 * MiB), S, 2048, DM, 0}; pg8::StaticOrder So; So.init(S, 2048, F.G, (int)blockIdx.x);
          pg8::EpiInProj E{(bf16*)(F.ws + WS_Q), (bf16*)(F.ws + WS_K), (bf16*)(F.ws + WS_V), (bf16*)(F.ws + WS_U), (const float*)(F.ws + WS_ROPEC), (const float*)(F.ws + WS_ROPES), 1.0f, 12};
          pg8::gemm_phase<pg8::EpiInProj, pg8::StaticOrder, true, true, false>(F.lds + RING_OFF, g, So, E, F.wave); }
        TSTOP(11);
#endif
        GRID_BAR_N(2);
        TSTART(1); kmean_phase(F); TSTOP(1);
        TSTART(2); vt_phase(F); TSTOP(2);
        __syncthreads();
        TSTART(3); conv_phase(F, l); TSTOP(3);
        GRID_BAR_N(3);
        TSTART(4); sel_phase(F, l); TSTOP(4);
        GRID_BAR_N(4);
        TSTART(51); TSTART(5); partial_phase(F, l); TSTOP(5);
        GRID_BAR_N(5); TSTOP(51);
        TSTART(52); TSTART(6); own_phase(F); TSTOP(6);
        GRID_BAR_N(6); TSTOP(52);
#ifndef NO_G_OUTPROJ
        TSTART(12);
        { pg8::Gemm g{(const bf16*)(F.ws + WS_CAT), (const bf16*)(F.ws + WS_WOUT + (size_t)l * DM * DM), S, DM, DM / 2, 0}; pg8::StaticOrder So; So.init(S, DM, F.G, (int)blockIdx.x);
          pg8::EpiBf16 E{Y, DM, 1.0f / (WSC_O * ASC_CAT)};
          pg8::gemm_phase<pg8::EpiBf16, pg8::StaticOrder, true, true, true>(F.lds + RING_OFF, g, So, E, F.wave); }
        TSTOP(12);
#endif
        GRID_BAR_N(7);
        TSTART(7); ln_phase(F, nullptr, Y, F.lnm_g + l * DM, F.lnm_b + l * DM, l == 1 ? F.router : nullptr, l == 1); TSTOP(7);
        GRID_BAR_N(8);
        if (l == 0) {
#ifndef NO_G_FFNGU
        TSTART(13); unsigned long long ck1 = (PROBE_ID == 313) ? (unsigned long long)clock64() : 0ull;
            { pg8::Gemm g{HB, (const bf16*)(F.ws + WS_WGU0), S, 2 * DFF, DM, 0}; pg8::StaticOrder So; So.init(S, 2 * DFF, F.G, (int)blockIdx.x);
              pg8::EpiSwiGLU E{(bf16*)(F.ws + WS_ACT), DFF};
              pg8::gemm_phase<pg8::EpiSwiGLU, pg8::StaticOrder, true, true>(F.lds + RING_OFF, g, So, E, F.wave); }
        TSTOP(13); if (PROBE_ID == 313) F.tacc += ((unsigned long long)clock64() - ck1) >> 8;
#endif
            GRID_BAR_N(9);
#ifndef NO_G_FFND
        TSTART(14);
            { pg8::Gemm g{(const bf16*)(F.ws + WS_ACT), (const bf16*)(F.ws + WS_WD0), S, DM, DFF, 0}; pg8::StaticOrder So; So.init(S, DM, F.G, (int)blockIdx.x);
              pg8::EpiBf16 E{Y, DM, 1.0f};
              pg8::gemm_phase<pg8::EpiBf16, pg8::StaticOrder, true, true>(F.lds + RING_OFF, g, So, E, F.wave); }
        TSTOP(14);
#endif
            GRID_BAR_N(10);
            TSTART(7); ln_phase(F, nullptr, Y, F.lnf_g, F.lnf_b, nullptr, true); TSTOP(7);
            GRID_BAR_N(11);
        } else {
            TSTART(17); router_phase(F); TSTOP(17);
            GRID_BAR_N(12);
            TSTART(8); route_phase(F); TSTOP(8);
            GRID_BAR_N(13);
            int off[8], cum[8], np; load_expert_layout(F, off, cum, np);
#ifndef NO_G_MOEGU
        TSTART(15); unsigned long long ck0 = (PROBE_ID == 315) ? (unsigned long long)clock64() : 0ull;
            { pg8::Gemm g{(const bf16*)(F.ws + WS_HBP), (const bf16*)(F.ws + WS_WGUE), np * 256, 2 * DFF, DM / 2, (size_t)2 * DFF * DM}; pg8::GroupedOrder So; So.init(np * 256, 2 * DFF, F.G, (int)blockIdx.x);
#pragma unroll
              for (int e = 0; e < 8; ++e) So.cum[e] = cum[e];
              pg8::EpiSwiGLU8 E{F.ws + WS_ACT, DFF, 1.0f / (WSC_GU * ASC_H), ASC_ACT};
              pg8::gemm_phase<pg8::EpiSwiGLU8, pg8::GroupedOrder, true, true, true>(F.lds + RING_OFF, g, So, E, F.wave); }
        TSTOP(15); if (PROBE_ID == 315) F.tacc += ((unsigned long long)clock64() - ck0) >> 8;
#endif
            GRID_BAR_N(14);
#ifndef NO_G_MOED
        TSTART(16);
            { pg8::Gemm g{(const bf16*)(F.ws + WS_ACT), (const bf16*)(F.ws + WS_WDE), np * 256, DM, DFF / 2, (size_t)DM * DFF}; pg8::GroupedOrder So; So.init(np * 256, DM, F.G, (int)blockIdx.x);
#pragma unroll
              for (int e = 0; e < 8; ++e) So.cum[e] = cum[e];
              pg8::EpiBf16 E{(bf16*)(F.ws + WS_R2), DM, 1.0f / (WSC_D * ASC_ACT)};
              pg8::gemm_phase<pg8::EpiBf16, pg8::GroupedOrder, true, true, true>(F.lds + RING_OFF, g, So, E, F.wave); }
        TSTOP(16);
#endif
            GRID_BAR_N(15);
            TSTART(9); ln_moe_phase(F, F.lnf_g + DM, F.lnf_b + DM); TSTOP(9);
        }
    }
    if (PROBE_ID != 0 && blockIdx.x == PROBE_WG && F.wave == 0) { const unsigned long long t1 = __builtin_amdgcn_s_memrealtime(); while (__builtin_amdgcn_s_memrealtime() - t1 < 16ull * F.tacc) __builtin_amdgcn_s_sleep(8); }
#undef GRID_BAR
#undef LAUNDER
#undef HB
#undef Y
}

extern "C" void kernel_launch(void* const* d_in, const int* in_sizes, int n_in, void* d_out, int out_size, void* d_ws, size_t ws_size, hipStream_t stream) {
    static int grid = 0;
    if (grid == 0) {
        if (n_in != 18 || in_sizes[0] != S * DM || out_size != S * DM || ws_size < WS_END) { fprintf(stderr, "kernel_launch: unexpected shapes (n_in %d, in0 %d, out %d, ws %zu < %zu); nothing launched\n", n_in, n_in > 0 ? in_sizes[0] : -1, out_size, ws_size, (size_t)WS_END); grid = -1; return; }
        int dev = 0, cus = 0, per_cu = 0;
        if (hipGetDevice(&dev) != hipSuccess || hipDeviceGetAttribute(&cus, hipDeviceAttributeMultiprocessorCount, dev) != hipSuccess) { grid = -1; return; }
        if (hipFuncSetAttribute((const void*)hymba_fwd, hipFuncAttributeMaxDynamicSharedMemorySize, LDS_BYTES) != hipSuccess) { fprintf(stderr, "kernel_launch: hipFuncSetAttribute failed\n"); grid = -1; return; }
        if (hipOccupancyMaxActiveBlocksPerMultiprocessor(&per_cu, (const void*)hymba_fwd, NWAVES * 64, LDS_BYTES) != hipSuccess || per_cu < 1)
            fprintf(stderr, "kernel_launch: note: occupancy query reports %d workgroups per CU\n", per_cu);
        (void)hipGetLastError();
        grid = cus;
        if (grid != 256) { fprintf(stderr, "kernel_launch: built for 256 CUs, device has %d; nothing launched\n", cus); grid = -1; return; }
    }
    if (grid < 0) return;
    if (hipMemsetAsync((char*)d_ws + WS_CTL, 0, CTL_ZERO_BYTES, stream) != hipSuccess) return;
    Args a{};
    for (int i = 0; i < 18; ++i) a.in[i] = (const float*)d_in[i];
    a.out = (float*)d_out; a.ws = (unsigned char*)d_ws;
    hipLaunchKernelGGL(hymba_fwd, dim3(grid), dim3(NWAVES * 64), LDS_BYTES, stream, a);
}
```

```cpp
#include <hip/hip_runtime.h>
#include <cstdio>
#include <cstdint>
#include <cmath>
namespace pg8 {
#define PG8_LAS __attribute__((address_space(3)))
typedef unsigned short bf16_t;
typedef short bf16x8 __attribute__((ext_vector_type(8)));
typedef float f32x4 __attribute__((ext_vector_type(4)));
typedef unsigned u32x4 __attribute__((ext_vector_type(4)));
typedef unsigned u32x2 __attribute__((ext_vector_type(2)));
typedef int v8i __attribute__((ext_vector_type(8)));
typedef int v4i __attribute__((ext_vector_type(4)));
constexpr int BM = 256, BK = 64, HALF = 128, HTB = HALF * BK * 2  , STAGE_BYTES = 8 * HTB, NXCD = 8, WGM = 8;

__host__ __device__ __forceinline__ int lds_byte(int r, int c) { const int st = (r >> 4) * 2 + (c >> 5), rr = r & 15, cc = c & 31, ob = rr * 64 + cc * 2; return st * 1024 + (ob ^ (((ob >> 9) & 1) << 5)); }
__host__ __device__ __forceinline__ void stage_rc(int b, int& R, int& C) { const int st = b / 1024, sb = b % 1024, swz = sb ^ (((sb >> 9) & 1) << 5); R = (st >> 1) * 16 + swz / 64; C = (st & 1) * 32 + (swz % 64) / 2; }
__host__ __device__ __forceinline__ int perm32(int rho) { const int n = rho >> 4, i = rho & 15; return 8 * (i >> 2) + 4 * n + (i & 3); }

struct Unit { int pm, pn, e; };
struct Gemm { const bf16_t* A; const bf16_t* Bt; int M, N, K; size_t bstride; };

struct StaticOrder {
    int nM, nN, nwg, G, c;
    __host__ __device__ void init(int M, int N, int G_, int c_) { nM = M / BM; nN = N / BM; nwg = nM * nN; G = G_; c = c_; }
    __host__ __device__ bool next(int i, Unit& u) const {
        const long L = (long)i * G + c; if (L >= nwg) return false;
        int wgid = (int)L; { const int q = nwg / NXCD, r = nwg % NXCD, xcd = wgid % NXCD, off = wgid / NXCD; wgid = (xcd < r ? xcd * (q + 1) : r * (q + 1) + (xcd - r) * q) + off; }
        const int nig = WGM * nN, gid = wgid / nig, fm = gid * WGM, gsz = (nM - fm) < WGM ? (nM - fm) : WGM;
        u.pm = fm + ((wgid % nig) % gsz); u.pn = (wgid % nig) / gsz; u.e = 0; return true;
    }
    __device__ __forceinline__ void a_ready(const Unit&) const {}
    __device__ __forceinline__ void done(const Unit&) const {}
};
struct GroupedOrder : StaticOrder {
    int cum[8];
    __device__ bool next(int i, Unit& u) const {
        if (!StaticOrder::next(i, u)) return false;
        int e = 0;
#pragma unroll
        for (int j = 1; j < 8; ++j) e += (u.pm >= cum[j]) ? 1 : 0;
        u.e = e; return true;
    }
};

__device__ __forceinline__ unsigned cvt_pk_bf16(float lo, float hi) { unsigned r; asm volatile("v_cvt_pk_bf16_f32 %0, %1, %2" : "=v"(r) : "v"(lo), "v"(hi)); return r; }
__device__ __forceinline__ float sigmoidf_fast(float g) { return __builtin_amdgcn_rcpf(1.0f + __builtin_amdgcn_exp2f(-1.44269504089f * g)); }

__device__ __forceinline__ unsigned pk4_fp8(float a, float b, float c, float d) {
    unsigned w = 0u; w = __builtin_amdgcn_cvt_pk_fp8_f32(__builtin_amdgcn_fmed3f(a, -448.f, 448.f), __builtin_amdgcn_fmed3f(b, -448.f, 448.f), w, false);
    return __builtin_amdgcn_cvt_pk_fp8_f32(__builtin_amdgcn_fmed3f(c, -448.f, 448.f), __builtin_amdgcn_fmed3f(d, -448.f, 448.f), w, true); }
struct EpiF32 {
    static constexpr bool PERM = false, AFTER_DRAIN = false;
    float* C; int ldc;
    __device__ __forceinline__ void operator()(const f32x4 (&acc)[2][2][4][2], const Unit& u, int wr, int wc, int fr, int fq) const {
        const int row0 = u.pm * BM + wr * 64 + fr, col0 = u.pn * BM + wc * 32 + 4 * fq;
#pragma unroll
        for (int ai = 0; ai < 2; ++ai)
#pragma unroll
            for (int m = 0; m < 4; ++m) { float* rowp = C + (size_t)(row0 + ai * HALF + m * 16) * ldc + col0;
#pragma unroll
                for (int bj = 0; bj < 2; ++bj)
#pragma unroll
                    for (int n = 0; n < 2; ++n) *(f32x4*)(rowp + bj * HALF + n * 16) = acc[ai][bj][m][n]; }
    }
};
struct EpiBf16 {
    static constexpr bool PERM = true, AFTER_DRAIN = false;
    bf16_t* O; int ldc; float sc;
    __device__ __forceinline__ void operator()(const f32x4 (&acc)[2][2][4][2], const Unit& u, int wr, int wc, int fr, int fq) const {
        const int row0 = u.pm * BM + wr * 64 + fr, col0 = u.pn * BM + wc * 32 + 8 * fq;
#pragma unroll
        for (int ai = 0; ai < 2; ++ai)
#pragma unroll
            for (int m = 0; m < 4; ++m) { bf16_t* rowp = O + (size_t)(row0 + ai * HALF + m * 16) * ldc + col0;
#pragma unroll
                for (int bj = 0; bj < 2; ++bj) { const f32x4 v0 = acc[ai][bj][m][0] * sc, v1 = acc[ai][bj][m][1] * sc;
                    u32x4 w; w.x = cvt_pk_bf16(v0[0], v0[1]); w.y = cvt_pk_bf16(v0[2], v0[3]); w.z = cvt_pk_bf16(v1[0], v1[1]); w.w = cvt_pk_bf16(v1[2], v1[3]);
                    *(u32x4*)(rowp + bj * HALF) = w; } }
    }
};
struct EpiSwiGLU {
    static constexpr bool PERM = true, AFTER_DRAIN = false;
    bf16_t* O; int ldc;
    __device__ __forceinline__ void operator()(const f32x4 (&acc)[2][2][4][2], const Unit& u, int wr, int wc, int fr, int fq) const {
        const int row0 = u.pm * BM + wr * 64 + fr, col0 = u.pn * HALF + wc * 32 + 8 * fq;
#pragma unroll
        for (int ai = 0; ai < 2; ++ai)
#pragma unroll
            for (int m = 0; m < 4; ++m) { bf16_t* rowp = O + (size_t)(row0 + ai * HALF + m * 16) * ldc + col0;
                float o[8];
#pragma unroll
                for (int n = 0; n < 2; ++n)
#pragma unroll
                    for (int j = 0; j < 4; ++j) { const float g = acc[ai][0][m][n][j], up = acc[ai][1][m][n][j]; o[n * 4 + j] = g * sigmoidf_fast(g) * up; }
                u32x4 w; w.x = cvt_pk_bf16(o[0], o[1]); w.y = cvt_pk_bf16(o[2], o[3]); w.z = cvt_pk_bf16(o[4], o[5]); w.w = cvt_pk_bf16(o[6], o[7]);
                *(u32x4*)rowp = w; }
    }
};
struct EpiSwiGLU8 {
    static constexpr bool PERM = true, AFTER_DRAIN = false;
    unsigned char* O; int ldc; float sin, sout;
    __device__ __forceinline__ void operator()(const f32x4 (&acc)[2][2][4][2], const Unit& u, int wr, int wc, int fr, int fq) const {
        const int row0 = u.pm * BM + wr * 64 + fr, col0 = u.pn * HALF + wc * 32 + 8 * fq;
#pragma unroll
        for (int ai = 0; ai < 2; ++ai)
#pragma unroll
            for (int m = 0; m < 4; ++m) { unsigned char* rowp = O + (size_t)(row0 + ai * HALF + m * 16) * ldc + col0;
                float o[8];
#pragma unroll
                for (int n = 0; n < 2; ++n)
#pragma unroll
                    for (int j = 0; j < 4; ++j) { const float g = acc[ai][0][m][n][j] * sin, up = acc[ai][1][m][n][j] * sin; o[n * 4 + j] = g * sigmoidf_fast(g) * up * sout; }
                u32x2 w; w.x = pk4_fp8(o[0], o[1], o[2], o[3]); w.y = pk4_fp8(o[4], o[5], o[6], o[7]);
                *(u32x2*)rowp = w; }
    }
};
struct EpiInProj {
    static constexpr bool PERM = true, AFTER_DRAIN = false;
    bf16_t *Q, *Kb, *V, *U; const float *ropeC, *ropeS; float sc; int pn_off;
    __device__ __forceinline__ void operator()(const f32x4 (&acc)[2][2][4][2], const Unit& u, int wr, int wc, int fr, int fq) const {
        const int row0 = u.pm * BM + wr * 64 + fr, pn = u.pn + pn_off;
        if (pn < 8) {
            bf16_t* base = (pn < 4) ? Q : Kb; const int col0 = (pn & 3) * BM + wc * 32 + 8 * fq, idx0 = 16 * wc + 4 * fq;
#pragma unroll
            for (int ai = 0; ai < 2; ++ai)
#pragma unroll
                for (int m = 0; m < 4; ++m) { const int row = row0 + ai * HALF + m * 16;
                    const f32x4 cs = *(const f32x4*)(ropeC + (size_t)row * 64 + idx0), sn = *(const f32x4*)(ropeS + (size_t)row * 64 + idx0);
#pragma unroll
                    for (int bj = 0; bj < 2; ++bj) { const f32x4 x1 = acc[ai][bj][m][0] * sc, x2 = acc[ai][bj][m][1] * sc;
                        const f32x4 o1 = x1 * cs - x2 * sn, o2 = x2 * cs + x1 * sn;
                        u32x4 w; w.x = cvt_pk_bf16(o1[0], o1[1]); w.y = cvt_pk_bf16(o1[2], o1[3]); w.z = cvt_pk_bf16(o2[0], o2[1]); w.w = cvt_pk_bf16(o2[2], o2[3]);
                        *(u32x4*)(base + (size_t)row * 1024 + col0 + bj * HALF) = w; } }
        } else if (pn < 12) {
            const int col0 = (pn - 8) * BM + wc * 32 + 8 * fq;
#pragma unroll
            for (int ai = 0; ai < 2; ++ai)
#pragma unroll
                for (int m = 0; m < 4; ++m) { bf16_t* rowp = V + (size_t)(row0 + ai * HALF + m * 16) * 1024 + col0;
#pragma unroll
                    for (int bj = 0; bj < 2; ++bj) { const f32x4 v0 = acc[ai][bj][m][0] * sc, v1 = acc[ai][bj][m][1] * sc;
                        u32x4 w; w.x = cvt_pk_bf16(v0[0], v0[1]); w.y = cvt_pk_bf16(v0[2], v0[3]); w.z = cvt_pk_bf16(v1[0], v1[1]); w.w = cvt_pk_bf16(v1[2], v1[3]);
                        *(u32x4*)(rowp + bj * HALF) = w; } }
        } else {
            const int col0 = (pn - 12) * HALF + wc * 32 + 8 * fq;
#pragma unroll
            for (int ai = 0; ai < 2; ++ai)
#pragma unroll
                for (int m = 0; m < 4; ++m) { bf16_t* rowp = U + (size_t)(row0 + ai * HALF + m * 16) * 1024 + col0;
                    float o[8];
#pragma unroll
                    for (int n = 0; n < 2; ++n)
#pragma unroll
                        for (int j = 0; j < 4; ++j) o[n * 4 + j] = acc[ai][0][m][n][j] * sc * sigmoidf_fast(acc[ai][1][m][n][j] * sc);
                    u32x4 w; w.x = cvt_pk_bf16(o[0], o[1]); w.y = cvt_pk_bf16(o[2], o[3]); w.z = cvt_pk_bf16(o[4], o[5]); w.w = cvt_pk_bf16(o[6], o[7]);
                    *(u32x4*)rowp = w; }
        }
    }
};

template <class Epi, class Sched, bool ALIGN_EPI = false, bool SP2 = false, bool FP8 = false>
__device__ __forceinline__ void gemm_phase(PG8_LAS unsigned char* lds, const Gemm g, const Sched& S, const Epi& E, const int wave_in) {
    int lane; asm volatile("v_mbcnt_lo_u32_b32 %0, -1, 0\n\tv_mbcnt_hi_u32_b32 %0, -1, %0" : "=v"(lane));
    const int wid = wave_in, tid = wid * 64 + lane, wr = wid >> 2, wc = wid & 3, fr = lane & 15, fq = lane >> 4;
    const int K = g.K, nt = K / BK;
    unsigned voffA[2], voffB[2];
#pragma unroll
    for (int i = 0; i < 2; ++i) { int R, C; stage_rc(tid * 16 + i * 8192, R, C); const int Rb = Epi::PERM ? ((R & ~31) + perm32(R & 31)) : R;
        voffA[i] = (unsigned)(R * K + C) * 2u; voffB[i] = (unsigned)(Rb * K + C) * 2u; }
    const size_t kstep = (size_t)(BK * 2);
    const size_t hstep = (size_t)HALF * K * 2;
    const size_t tstep = 2 * hstep;
    const unsigned ldsw = (unsigned)wid * 1024u;
    const int aoff = lds_byte(wr * 64 + fr, fq * 8), boff = lds_byte(wc * 32 + fr, fq * 8);
#define PG8_SA(b, h) (((b) * 2 + (h)) * HTB)
#define PG8_SB(b, h) ((4 + (b) * 2 + (h)) * HTB)
#define PG8_STAGE(bufoff, gbase, voff) do { _Pragma("unroll") for (int _i = 0; _i < 2; ++_i) \
        __builtin_amdgcn_global_load_lds((const unsigned*)((const char*)(gbase) + (voff)[_i]), (PG8_LAS unsigned*)(lds + (bufoff) + ldsw + _i * 8192), 16, 0, 0); } while (0)
#define PG8_LDA(dst, b, h) do { if constexpr (FP8) { _Pragma("unroll") for (int m = 0; m < 4; ++m) { const v4i lo_ = *(const PG8_LAS v4i*)(lds + PG8_SA(b, h) + aoff + m * 2048), hi_ = *(const PG8_LAS v4i*)(lds + PG8_SA(b, h) + aoff + m * 2048 + 1024); \
            dst##8[m] = __builtin_shufflevector(lo_, hi_, 0, 1, 2, 3, 4, 5, 6, 7); } } \
        else { _Pragma("unroll") for (int m = 0; m < 4; ++m) _Pragma("unroll") for (int k = 0; k < 2; ++k) dst[m][k] = *(const PG8_LAS bf16x8*)(lds + PG8_SA(b, h) + aoff + m * 2048 + k * 1024); } } while (0)
#define PG8_LDB(dst, b, h) do { if constexpr (FP8) { _Pragma("unroll") for (int n = 0; n < 2; ++n) { const v4i lo_ = *(const PG8_LAS v4i*)(lds + PG8_SB(b, h) + boff + n * 2048), hi_ = *(const PG8_LAS v4i*)(lds + PG8_SB(b, h) + boff + n * 2048 + 1024); \
            dst##8[n] = __builtin_shufflevector(lo_, hi_, 0, 1, 2, 3, 4, 5, 6, 7); } } \
        else { _Pragma("unroll") for (int n = 0; n < 2; ++n) _Pragma("unroll") for (int k = 0; k < 2; ++k) dst[n][k] = *(const PG8_LAS bf16x8*)(lds + PG8_SB(b, h) + boff + n * 2048 + k * 1024); } } while (0)
#define PG8_MMA(ai, bj, At, Bt) do { __builtin_amdgcn_s_setprio(1); \
        if constexpr (FP8) {   \
            _Pragma("unroll") for (int m = 0; m < 4; ++m) _Pragma("unroll") for (int n = 0; n < 2; ++n) \
                asm volatile("v_mfma_f32_16x16x128_f8f6f4 %0, %1, %2, %0" : "+v"(acc[ai][bj][m][n]) : "v"(Bt##8[n]), "v"(At##8[m]));   \
        } else { _Pragma("unroll") for (int m = 0; m < 4; ++m) _Pragma("unroll") for (int n = 0; n < 2; ++n) _Pragma("unroll") for (int k = 0; k < 2; ++k) \
            acc[ai][bj][m][n] = __builtin_amdgcn_mfma_f32_16x16x32_bf16(Bt[n][k], At[m][k], acc[ai][bj][m][n], 0, 0, 0); } \
        __builtin_amdgcn_s_setprio(0); } while (0)
#define PG8_WAIT_V(n) asm volatile("s_waitcnt vmcnt(" #n ")" ::: "memory")
#define PG8_WAIT_L(n) asm volatile("s_waitcnt lgkmcnt(" #n ")" ::: "memory")
#define PG8_BAR __builtin_amdgcn_s_barrier()
#define PG8_SCHED __builtin_amdgcn_sched_barrier(0)
    Unit cur, nxt; int ui = 0;
    if (!S.next(0, cur)) return;
    f32x4 acc[2][2][4][2];
#pragma unroll
    for (int a = 0; a < 2; ++a)
#pragma unroll
        for (int b = 0; b < 2; ++b)
#pragma unroll
            for (int m = 0; m < 4; ++m)
#pragma unroll
                for (int n = 0; n < 2; ++n) acc[a][b][m][n] = (f32x4){0.f, 0.f, 0.f, 0.f};
    bf16x8 At[4][2], B0[2][2], B1[2][2]; v8i At8[4], B08[2], B18[2];
    const char* cA = (const char*)g.A + (size_t)cur.pm * tstep; const char* cB = (const char*)g.Bt + (size_t)cur.e * g.bstride + (size_t)cur.pn * tstep;
    S.a_ready(cur);
    if constexpr (SP2) {
        PG8_STAGE(PG8_SB(0, 0), cB, voffB); PG8_STAGE(PG8_SB(0, 1), cB + hstep, voffB); PG8_STAGE(PG8_SA(0, 0), cA, voffA); PG8_STAGE(PG8_SA(0, 1), cA + hstep, voffA);
        if (wr == 1) PG8_BAR;
        PG8_WAIT_V(2); PG8_BAR;
        PG8_STAGE(PG8_SB(1, 0), cB + kstep, voffB); PG8_STAGE(PG8_SA(1, 0), cA + kstep, voffA); PG8_STAGE(PG8_SB(1, 1), cB + hstep + kstep, voffB);
        PG8_WAIT_V(6); PG8_BAR;
    } else {
        PG8_STAGE(PG8_SB(0, 0), cB, voffB); PG8_STAGE(PG8_SA(0, 0), cA, voffA); PG8_STAGE(PG8_SB(0, 1), cB + hstep, voffB); PG8_STAGE(PG8_SA(0, 1), cA + hstep, voffA);
        if (wr == 1) PG8_BAR;
        PG8_WAIT_V(4); PG8_BAR;
        PG8_STAGE(PG8_SB(1, 0), cB + kstep, voffB); PG8_STAGE(PG8_SA(1, 0), cA + kstep, voffA); PG8_STAGE(PG8_SB(1, 1), cB + hstep + kstep, voffB);
        PG8_WAIT_V(6); PG8_BAR;
    }
    for (;;) {
        const bool has_next = S.next(ui + 1, nxt);
        const char* nA = has_next ? (const char*)g.A + (size_t)nxt.pm * tstep : cA; const char* nB = has_next ? (const char*)g.Bt + (size_t)nxt.e * g.bstride + (size_t)nxt.pn * tstep : cB;
        for (int t = 0; t < nt; t += 2) {
            const bool last = (t == nt - 2);
            const char* a1 = cA + (size_t)(t + 1) * kstep;
            const char* a2 = last ? nA : cA + (size_t)(t + 2) * kstep; const char* b2 = last ? nB : cB + (size_t)(t + 2) * kstep;
            const char* a3 = a2 + kstep; const char* b3 = b2 + kstep;
            if (last && has_next) S.a_ready(nxt);
            if constexpr (SP2) {
            PG8_LDB(B0, 0, 0); PG8_LDB(B1, 0, 1); PG8_SCHED; PG8_LDA(At, 0, 0); PG8_STAGE(PG8_SA(1, 1), a1 + hstep, voffA);
            PG8_WAIT_V(8); PG8_WAIT_L(0); PG8_BAR; PG8_MMA(0, 0, At, B0); PG8_MMA(0, 1, At, B1); PG8_BAR; PG8_SCHED;
            PG8_LDA(At, 0, 1); PG8_STAGE(PG8_SB(0, 0), b2, voffB); PG8_STAGE(PG8_SB(0, 1), b2 + hstep, voffB); PG8_STAGE(PG8_SA(0, 0), a2, voffA);
            PG8_WAIT_V(8); PG8_WAIT_L(0); PG8_BAR; PG8_MMA(1, 0, At, B0); PG8_MMA(1, 1, At, B1); PG8_BAR; PG8_SCHED;
            PG8_LDB(B0, 1, 0); PG8_LDB(B1, 1, 1); PG8_SCHED; PG8_LDA(At, 1, 0); PG8_STAGE(PG8_SA(0, 1), a2 + hstep, voffA);
            PG8_WAIT_V(8); PG8_WAIT_L(0); PG8_BAR; PG8_MMA(0, 0, At, B0); PG8_MMA(0, 1, At, B1); PG8_BAR; PG8_SCHED;
            PG8_LDA(At, 1, 1); PG8_STAGE(PG8_SB(1, 0), b3, voffB); PG8_STAGE(PG8_SB(1, 1), b3 + hstep, voffB); PG8_STAGE(PG8_SA(1, 0), a3, voffA);
            PG8_WAIT_V(8); PG8_WAIT_L(0); PG8_BAR; PG8_MMA(1, 0, At, B0); PG8_MMA(1, 1, At, B1); PG8_BAR; PG8_SCHED;
            } else {
            PG8_LDB(B0, 0, 0); PG8_SCHED; PG8_LDA(At, 0, 0); PG8_STAGE(PG8_SA(1, 1), a1 + hstep, voffA);
            PG8_WAIT_L(8); PG8_BAR; PG8_WAIT_L(0); PG8_MMA(0, 0, At, B0); PG8_BAR; PG8_SCHED;
            PG8_LDB(B1, 0, 1); PG8_STAGE(PG8_SB(0, 0), b2, voffB);
            PG8_BAR; PG8_WAIT_L(0); PG8_MMA(0, 1, At, B1); PG8_BAR;
            PG8_LDA(At, 0, 1); PG8_STAGE(PG8_SA(0, 0), a2, voffA);
            PG8_BAR; PG8_WAIT_L(0); PG8_MMA(1, 0, At, B0); PG8_BAR; PG8_SCHED;
            PG8_STAGE(PG8_SB(0, 1), b2 + hstep, voffB);
            PG8_WAIT_V(6); PG8_BAR; PG8_MMA(1, 1, At, B1); PG8_BAR;
            PG8_LDB(B0, 1, 0); PG8_SCHED; PG8_LDA(At, 1, 0); PG8_STAGE(PG8_SA(0, 1), a2 + hstep, voffA);
            PG8_WAIT_L(8); PG8_BAR; PG8_WAIT_L(0); PG8_MMA(0, 0, At, B0); PG8_BAR; PG8_SCHED;
            PG8_LDB(B1, 1, 1); PG8_STAGE(PG8_SB(1, 0), b3, voffB);
            PG8_BAR; PG8_WAIT_L(0); PG8_MMA(0, 1, At, B1); PG8_BAR;
            PG8_LDA(At, 1, 1); PG8_STAGE(PG8_SA(1, 0), a3, voffA);
            PG8_BAR; PG8_WAIT_L(0); PG8_MMA(1, 0, At, B0); PG8_BAR; PG8_SCHED;
            PG8_STAGE(PG8_SB(1, 1), b3 + hstep, voffB);
            PG8_WAIT_V(6); PG8_BAR; PG8_MMA(1, 1, At, B1); PG8_BAR;
            }
        }
        if constexpr (FP8) asm volatile("s_nop 15\n\ts_nop 15" ::: "memory");
        if constexpr (ALIGN_EPI) { if (wr == 0) PG8_BAR; }
        if constexpr (!Epi::AFTER_DRAIN) { E(acc, cur, wr, wc, fr, fq); S.done(cur); }
        if (!has_next) break;
#pragma unroll
        for (int a = 0; a < 2; ++a)
#pragma unroll
            for (int b = 0; b < 2; ++b)
#pragma unroll
                for (int m = 0; m < 4; ++m)
#pragma unroll
                    for (int n = 0; n < 2; ++n) acc[a][b][m][n] = (f32x4){0.f, 0.f, 0.f, 0.f};
        cur = nxt; cA = nA; cB = nB; ++ui;
        if constexpr (ALIGN_EPI) { if (wr == 1) PG8_BAR; }
    }
    PG8_WAIT_V(0);
    if constexpr (!ALIGN_EPI) { if (wr == 0) PG8_BAR; }
    PG8_BAR;
    if constexpr (Epi::AFTER_DRAIN) { E.fused(acc, cur, wr, wc, fr, fq, lds, wid, lane); S.done(cur); }
#undef PG8_SA
#undef PG8_SB
#undef PG8_STAGE
#undef PG8_LDA
#undef PG8_LDB
#undef PG8_MMA
#undef PG8_WAIT_V
#undef PG8_WAIT_L
#undef PG8_BAR
#undef PG8_SCHED
}
}

constexpr int NWAVES = 8;
constexpr int S = 16384, DM = 2048, NPROJ = 5120, AW = 1024, HD = 128, NH = 8, DFF = 5632, NE = 8, CKW = 31, NBLK = 64;
constexpr float LN_EPS = 1e-5f, ALPHA = 1.41421356237309515f;
constexpr int MOE_ROWS = 2 * S + NE * 256;
constexpr float WSC_GU = 32.f, WSC_D = 128.f, ASC_H = 4.f, ASC_ACT = 8.f, WSC_O = 64.f, ASC_CAT = 16.f;

constexpr size_t MiB = 1u << 20;
constexpr size_t WS_CTL = 0, CTL_ZERO_BYTES = 1 * MiB;
constexpr size_t WS_ROPEC = 1 * MiB, WS_ROPES = 5 * MiB;
constexpr size_t WS_KMEAN = 9 * MiB;
constexpr size_t WS_RWT = 9 * MiB + 256 * 1024;
constexpr size_t WS_EIDX = 9 * MiB + 512 * 1024, WS_GATEW = WS_EIDX + 128 * 1024, WS_ROWPOS = WS_GATEW + 128 * 1024;
constexpr size_t WS_WIN = 10 * MiB, WS_WOUT = 50 * MiB, WS_WGU0 = 66 * MiB, WS_WD0 = 110 * MiB, WS_WGUE = 132 * MiB, WS_WDE = 484 * MiB;
constexpr size_t WS_HB = 660 * MiB;
constexpr size_t WS_R2 = 724 * MiB;
constexpr size_t WS_HB8 = 860 * MiB + 72 * MiB;
constexpr size_t WS_HBP = 860 * MiB;
constexpr size_t WS_R1 = 996 * MiB;
constexpr size_t WS_Q = WS_R1, WS_K = WS_R1 + 32 * MiB, WS_V = WS_R1 + 64 * MiB, WS_U = WS_R1 + 96 * MiB, WS_CAT = WS_R1 + 128 * MiB, WS_ACT = WS_R1;
constexpr size_t WS_VT = WS_R1 + 192 * MiB, WS_PO = WS_R1 + 224 * MiB, WS_PML = WS_R1 + 320 * MiB, WS_LIST = WS_R1 + 324 * MiB;
constexpr size_t WS_END = 1370 * MiB;
static_assert(WS_R1 + (size_t)MOE_ROWS * DFF * 2 <= WS_END && WS_HBP + (size_t)MOE_ROWS * DM * 2 <= WS_R1 && WS_R2 + (size_t)MOE_ROWS * DM * 2 <= WS_HBP, "d_ws map");
static_assert(WS_WDE + (size_t)NE * DM * DFF * 2 <= WS_HB && WS_WGUE + (size_t)NE * 2 * DFF * DM * 2 <= WS_WDE, "d_ws weights map");
constexpr int CW_TMO = 0, CW_CODE = 1, CW_BAR = 4096, CW_ECNT = 8192, CW_ECUR = 8192 + 64 * 8, CW_LCNT = 12288, CW_QUEUE = 14336, CW_STEALQ = 14464, CW_ARRIVE = 16384;
constexpr int RING_OFF = 0, RING_BYTES = 131072;
constexpr int LDSCTL_OFF = 143360, MISC_OFF = LDSCTL_OFF + 320;
constexpr int LDS_BYTES = 147456;

__device__ const float INV_FREQ[64] = {
1.000000000e+00f, 8.659643531e-01f, 7.498942018e-01f, 6.493816376e-01f, 5.623413324e-01f, 4.869675338e-01f, 4.216965139e-01f, 3.651741147e-01f, 3.162277639e-01f, 2.738419771e-01f, 2.371373773e-01f, 2.053525001e-01f, 1.778279394e-01f, 1.539926529e-01f, 1.333521456e-01f, 1.154781953e-01f, 1.000000015e-01f, 8.659642935e-02f, 7.498942316e-02f, 6.493816525e-02f, 5.623413250e-02f, 4.869675264e-02f, 4.216964915e-02f, 3.651741147e-02f, 3.162277490e-02f, 2.738419548e-02f, 2.371373773e-02f, 2.053525113e-02f, 1.778279431e-02f, 1.539926510e-02f, 1.333521400e-02f, 1.154781971e-02f, 9.999999776e-03f, 8.659643121e-03f, 7.498942316e-03f, 6.493816152e-03f, 5.623413250e-03f, 4.869675264e-03f, 4.216964822e-03f, 3.651741194e-03f, 3.162277630e-03f, 2.738419687e-03f, 2.371373819e-03f, 2.053525066e-03f, 1.778279431e-03f, 1.539926510e-03f, 1.333521446e-03f, 1.154782018e-03f, 1.000000047e-03f, 8.659643354e-04f, 7.498941850e-04f, 6.493816036e-04f, 5.623413017e-04f, 4.869675322e-04f, 4.216965172e-04f, 3.651741135e-04f, 3.162277571e-04f, 2.738419571e-04f, 2.371373703e-04f, 2.053525095e-04f, 1.778279402e-04f, 1.539926598e-04f, 1.333521504e-04f, 1.154782003e-04f
};

#define GAS __attribute__((address_space(1)))
#define LAS __attribute__((address_space(3)))
typedef unsigned short bf16;
typedef unsigned v4u __attribute__((ext_vector_type(4)));
typedef unsigned v2u __attribute__((ext_vector_type(2)));
typedef float f32x4 __attribute__((ext_vector_type(4)));
typedef float f32x2 __attribute__((ext_vector_type(2)));
typedef short bf16x8 __attribute__((ext_vector_type(8)));
typedef GAS unsigned gu32;
typedef GAS unsigned long long gu64;
#define RLX_AGENT __ATOMIC_RELAXED, __HIP_MEMORY_SCOPE_AGENT
#define LDS_WAIT() asm volatile("s_waitcnt lgkmcnt(0)" ::: "memory")
#define VM_WAIT() asm volatile("s_waitcnt vmcnt(0)" ::: "memory")
__device__ __forceinline__ unsigned f2bf(float f) { unsigned u = __builtin_bit_cast(unsigned, f); return (u + 0x7fffu + ((u >> 16) & 1u)) >> 16; }
__device__ __forceinline__ unsigned pk2(float lo, float hi) { return f2bf(lo) | (f2bf(hi) << 16); }
__device__ __forceinline__ float bflo(unsigned w) { return __builtin_bit_cast(float, w << 16); }
__device__ __forceinline__ float bfhi(unsigned w) { return __builtin_bit_cast(float, w & 0xffff0000u); }

#define XB_TMO      128
#define XB_XCNT(j)  (256  + 64 * (j))
#define XB_XSUB(j)  (1280 + 64 * (j))
#define XB_XGEN(j)  (2304 + 64 * (j))
#define XB_TOP      3328
#define XB_TOPGEN   3392
#define XCD_BAR_WORDS 3456
#define XB_SPIN_CAP (1u << 22)

__device__ __forceinline__ unsigned xb_ld(unsigned* p)              { return __hip_atomic_load(p, __ATOMIC_RELAXED, __HIP_MEMORY_SCOPE_AGENT); }
__device__ __forceinline__ unsigned xb_add(unsigned* p, unsigned v) { return __hip_atomic_fetch_add(p, v, __ATOMIC_RELAXED, __HIP_MEMORY_SCOPE_AGENT); }
__device__ __forceinline__ unsigned xb_xcc_id() { return (unsigned)__builtin_amdgcn_s_getreg((3 << 11) | 20) & 0xFu; }
#define XB_SPIN(cond, bar) do { unsigned _sp = 0; while (cond) { __builtin_amdgcn_s_sleep(1); \
    if ((++_sp & 255u) == 0u) { if (xb_ld(&(bar)[XB_TMO])) break; if (_sp > XB_SPIN_CAP) { atomicAdd(&(bar)[XB_TMO], 1u); break; } } } } while (0)

__device__ __forceinline__ int lane_now() { int l; asm volatile("v_mbcnt_lo_u32_b32 %0, -1, 0\n\tv_mbcnt_hi_u32_b32 %0, -1, %0" : "=v"(l)); return l; }
#define XB_T0() (b.w0 == 0 && lane_now() == 0)
struct XcdBarrier {
    unsigned* bar; unsigned x; int w0;
    volatile LAS unsigned* st;
};

__device__ __forceinline__ XcdBarrier xcd_barrier_post(unsigned* bar, volatile LAS unsigned* st, int w0) {
    XcdBarrier b; b.bar = bar; b.x = xb_xcc_id(); b.st = st; b.w0 = w0;
    if (XB_T0()) (void)xb_add(&bar[XB_XCNT(b.x)], 1u);
    return b;
}
__device__ __forceinline__ void xcd_barrier_complete(unsigned* bar, unsigned x, unsigned& nloc, unsigned& nx) {
    const unsigned G = gridDim.x * gridDim.y * gridDim.z;
    unsigned sum, cnt, mine, sp = 0u;
    for (;;) {
        sum = 0u; cnt = 0u; mine = 0u;
#pragma unroll
        for (unsigned j = 0; j < 16; ++j) { const unsigned c = xb_ld(&bar[XB_XCNT(j)]); sum += c; cnt += (c > 0u) ? 1u : 0u; mine = (j == x) ? c : mine; }
        if (sum == G) break;
        __builtin_amdgcn_s_sleep(1);
        if ((++sp & 255u) == 0u) { if (xb_ld(&bar[XB_TMO])) break; if (sp > XB_SPIN_CAP) { atomicAdd(&bar[XB_TMO], 1u); break; } }
    }
    nloc = mine > 0u ? mine : 1u; nx = cnt > 0u ? cnt : 1u;
}

__device__ __forceinline__ void xcd_barrier(const XcdBarrier& b) {
    asm volatile("s_waitcnt vmcnt(0)" ::: "memory");
    __syncthreads();
    if (XB_T0()) {
        unsigned* bar = b.bar;
        __builtin_amdgcn_s_waitcnt(0);
        unsigned nloc = b.st[0], nx = b.st[1];
        if (nloc == 0u) { xcd_barrier_complete(bar, b.x, nloc, nx); b.st[0] = nloc; b.st[1] = nx; }
        const unsigned old = xb_add(&bar[XB_XSUB(b.x)], 1u);
        const unsigned gen = old / nloc;
        if (old + 1u == (gen + 1u) * nloc) {
            __builtin_amdgcn_fence(__ATOMIC_RELEASE, "agent");
            asm volatile("s_waitcnt vmcnt(0)" ::: "memory");
            const unsigned og = xb_add(&bar[XB_TOP], 1u);
            const unsigned tg = og / nx;
            if (og + 1u == (tg + 1u) * nx) xb_add(&bar[XB_TOPGEN], 1u);
            else XB_SPIN(xb_ld(&bar[XB_TOPGEN]) == tg, bar);
            __builtin_amdgcn_fence(__ATOMIC_ACQUIRE, "agent");
            xb_add(&bar[XB_XGEN(b.x)], 1u);
            asm volatile("s_waitcnt vmcnt(0)" ::: "memory");
        } else {
            XB_SPIN(xb_ld(&bar[XB_XGEN(b.x)]) == gen, bar);
            __builtin_amdgcn_fence(__ATOMIC_ACQUIRE, "agent");
            asm volatile("s_waitcnt vmcnt(0)" ::: "memory");
        }
    }
    __syncthreads();
}


struct Frame {
    LAS unsigned char* lds;
    volatile LAS unsigned* MISC;
    gu32* ctl;
    int wave;
    int vcu, G;
    const float* x; float* out;
    const float *w_in, *conv_w, *conv_b, *conv_g, *conv_be, *w_out, *lnm_g, *lnm_b, *lnf_g, *lnf_b, *fg, *fu, *fd, *router, *eg, *eu, *ed;
    unsigned char* ws;
    unsigned long long tacc, tt0;
};
#ifndef PROBE_ID
#define PROBE_ID 0
#endif
#ifndef PROBE_WG
#define PROBE_WG 0
#endif
#define TSTART(id) do { if (PROBE_ID == (id)) F.tt0 = __builtin_amdgcn_s_memrealtime(); } while (0)
#define TSTOP(id) do { if (PROBE_ID == (id)) F.tacc += __builtin_amdgcn_s_memrealtime() - F.tt0; } while (0)
__device__ __forceinline__ int shx_i(int v, int m, int lane) { return __builtin_amdgcn_ds_bpermute((lane ^ m) << 2, v); }
__device__ __forceinline__ float shx(float v, int m, int lane) { return __builtin_bit_cast(float, __builtin_amdgcn_ds_bpermute((lane ^ m) << 2, __builtin_bit_cast(int, v))); }
__device__ __forceinline__ int shl_i(int v, int src) { return __builtin_amdgcn_ds_bpermute(src << 2, v); }
template <int N> __device__ __forceinline__ void wave_sum_n(float (&v)[N], int lane) {
#pragma unroll
    for (int i = 0; i < N; ++i) { float x = v[i];
        x += __builtin_bit_cast(float, __builtin_amdgcn_update_dpp(0, __builtin_bit_cast(int, x), 0xB1, 0xF, 0xF, false));
        x += __builtin_bit_cast(float, __builtin_amdgcn_update_dpp(0, __builtin_bit_cast(int, x), 0x4E, 0xF, 0xF, false));
        x += __builtin_bit_cast(float, __builtin_amdgcn_update_dpp(0, __builtin_bit_cast(int, x), 0x141, 0xF, 0xF, false));
        x += __builtin_bit_cast(float, __builtin_amdgcn_update_dpp(0, __builtin_bit_cast(int, x), 0x140, 0xF, 0xF, false));
        v[i] = x; }
#pragma unroll
    for (int o = 16; o < 64; o <<= 1) { float t[N];
#pragma unroll
        for (int i = 0; i < N; ++i) t[i] = shx(v[i], o, lane);
#pragma unroll
        for (int i = 0; i < N; ++i) v[i] += t[i]; }
}
__device__ __forceinline__ float wave_sum(float v, int lane) {
    v += __builtin_bit_cast(float, __builtin_amdgcn_update_dpp(0, __builtin_bit_cast(int, v), 0xB1, 0xF, 0xF, false));
    v += __builtin_bit_cast(float, __builtin_amdgcn_update_dpp(0, __builtin_bit_cast(int, v), 0x4E, 0xF, 0xF, false));
    v += __builtin_bit_cast(float, __builtin_amdgcn_update_dpp(0, __builtin_bit_cast(int, v), 0x141, 0xF, 0xF, false));
    v += __builtin_bit_cast(float, __builtin_amdgcn_update_dpp(0, __builtin_bit_cast(int, v), 0x140, 0xF, 0xF, false));
    v += shx(v, 16, lane); v += shx(v, 32, lane);
    return v;
}
__device__ __forceinline__ int wmap(int kind, int c) {
    if (kind == 0) return c;
    if (kind == 1) {
        if (c < 2048) { const int hh = c >> 7, w = c & 127, n = w >> 6, idx = w & 63; return hh * 128 + 32 * (idx >> 4) + 8 * ((idx >> 2) & 3) + 4 * n + (idx & 3); }
        if (c < 3072) return c;
        if (c < 4096) { const int j = c - 3072; return 3072 + 256 * (j >> 7) + (j & 127); }
        const int j = c - 4096; return 3072 + 256 * (j >> 7) + 128 + (j & 127);
    }
    return 256 * (c >> 7) + (kind == 3 ? 128 : 0) + (c & 127);
}
__device__ __forceinline__ void p0_transpose_item(const float* Wg, int K, int N, bf16* WT, int kind, LAS float* scr, int item, int lane) {
    const GAS float* W = (const GAS float*)Wg;
    const int nblk = N / 32, kb = item / nblk, nb = item % nblk, k0 = 64 * kb, n0 = 32 * nb;
    float wv[32];
#pragma unroll
    for (int i = 0; i < 32; ++i) wv[i] = W[(size_t)(k0 + 2 * i + (lane >> 5)) * N + n0 + (lane & 31)];
#pragma unroll
    for (int i = 0; i < 32; ++i) scr[(2 * i + (lane >> 5)) * 33 + (lane & 31)] = wv[i];
    LDS_WAIT(); asm volatile("" ::: "memory");
    const int c = lane & 7;
#pragma unroll
    for (int j = 0; j < 4; ++j) { const int n = (lane >> 3) + 8 * j; const LAS float* s = scr + (8 * c) * 33 + n;
        v4u o; o.x = pk2(s[0 * 33], s[1 * 33]); o.y = pk2(s[2 * 33], s[3 * 33]); o.z = pk2(s[4 * 33], s[5 * 33]); o.w = pk2(s[6 * 33], s[7 * 33]);
        *(GAS v4u*)(WT + (size_t)wmap(kind, n0 + n) * K + k0 + 8 * c) = o; }
    LDS_WAIT(); asm volatile("" ::: "memory");
}
__device__ __forceinline__ void sincos_acc(float ang, float& sn, float& cs) {
    const double x = (double)ang, k = __builtin_rint(x * 0.63661977236758134308);
    double r = __builtin_fma(-k, 1.57079632679489655800e+00, x); r = __builtin_fma(-k, 6.12323399573676603587e-17, r);
    const int q = ((int)k) & 3; const double r2 = r * r;
    double sp = 1.0 / 6227020800.0; sp = sp * r2 - 1.0 / 39916800.0; sp = sp * r2 + 1.0 / 362880.0; sp = sp * r2 - 1.0 / 5040.0; sp = sp * r2 + 1.0 / 120.0; sp = sp * r2 - 1.0 / 6.0;
    const double s = r + r * r2 * sp;
    double cp = -1.0 / 87178291200.0; cp = cp * r2 + 1.0 / 479001600.0; cp = cp * r2 - 1.0 / 3628800.0; cp = cp * r2 + 1.0 / 40320.0; cp = cp * r2 - 1.0 / 720.0; cp = cp * r2 + 1.0 / 24.0; cp = cp * r2 - 0.5;
    const double c = 1.0 + r2 * cp;
    const double ss = (q & 1) ? c : s, cc = (q & 1) ? s : c;
    sn = (float)((q & 2) ? -ss : ss); cs = (float)(((q + 1) & 2) ? -cc : cc);
}
__device__ __forceinline__ void p0_transpose_item8(const float* Wg, int K, int N, unsigned char* WT, int kind, float wscale, LAS float* scr, int item, int lane) {
    const GAS float* W = (const GAS float*)Wg;
    const int nblk = N / 32, kb = item / nblk, nb = item % nblk, k0 = 64 * kb, n0 = 32 * nb;
    float wv[32];
#pragma unroll
    for (int i = 0; i < 32; ++i) wv[i] = W[(size_t)(k0 + 2 * i + (lane >> 5)) * N + n0 + (lane & 31)];
#pragma unroll
    for (int i = 0; i < 32; ++i) scr[(2 * i + (lane >> 5)) * 33 + (lane & 31)] = wv[i] * wscale;
    LDS_WAIT(); asm volatile("" ::: "memory");
    const int c = lane & 7;
#pragma unroll
    for (int j = 0; j < 4; ++j) { const int n = (lane >> 3) + 8 * j; const LAS float* sp = scr + (8 * c) * 33 + n;
        v2u o; o.x = pg8::pk4_fp8(sp[0 * 33], sp[1 * 33], sp[2 * 33], sp[3 * 33]); o.y = pg8::pk4_fp8(sp[4 * 33], sp[5 * 33], sp[6 * 33], sp[7 * 33]);
        *(GAS v2u*)(WT + (size_t)wmap(kind, n0 + n) * K + k0 + 8 * c) = o; }
    LDS_WAIT(); asm volatile("" ::: "memory");
}
__device__ __forceinline__ void p0_transpose_stack8(Frame& F, const float* src, int K, int N, int nmat, unsigned char* dst, size_t dst_stride, int kind, float wscale) {
    LAS float* scr = (LAS float*)(F.lds + RING_OFF + F.wave * 16384);
    const int gw = F.vcu * NWAVES + F.wave, NGW = F.G * NWAVES, per = (K / 64) * (N / 32), total = per * nmat, lane = lane_now();
#pragma clang loop unroll(disable)
    for (int it = gw; it < total; it += NGW) { const int m = it / per, r = it - m * per;
        p0_transpose_item8(src + (size_t)m * K * N, K, N, dst + (size_t)m * dst_stride, kind, wscale, scr, r, lane); }
}
__device__ __forceinline__ void p0_stack(Frame& F, const float* src, int K, int N, int nmat, unsigned char* dst, size_t dst_stride_bytes, int kind, bool fp8, float wscale, int n_lo = 0, int n_cnt = 0, int drow_off = 0) {
    LAS float* t = (LAS float*)(F.lds + RING_OFF);
    const int tid = F.wave * 64 + lane_now(), ntn = (n_cnt ? n_cnt : N) / 256, per = (K / 128) * ntn, total = per * nmat;
    f32x4 raw[16];
    int it = blockIdx.x;
    if (it < total) { const int m = it / per, r = it - m * per, k0 = (r / ntn) * 128, n0 = n_lo + (r % ntn) * 256; const GAS f32x4* W = (const GAS f32x4*)(src + (size_t)m * K * N + (size_t)k0 * N + n0);
#pragma unroll
        for (int i = 0; i < 16; ++i) { const int p = tid + 512 * i; raw[i] = W[(size_t)(p >> 6) * (N / 4) + (p & 63)]; } }
#pragma clang loop unroll(disable)
    for (; it < total; it += F.G) { const int m = it / per, r = it - m * per, k0 = (r / ntn) * 128, n0 = n_lo + (r % ntn) * 256;
        const int tid2 = F.wave * 64 + lane_now();
#pragma unroll
        for (int i = 0; i < 16; ++i) { const int p = tid2 + 512 * i; LAS float* d = t + (p >> 6) * 257 + (p & 63) * 4; d[0] = raw[i][0] * wscale; d[1] = raw[i][1] * wscale; d[2] = raw[i][2] * wscale; d[3] = raw[i][3] * wscale; }
        __syncthreads();
        { const int nx = (it + F.G < total) ? it + F.G : it;
          const int m2 = nx / per, r2 = nx - m2 * per, k2 = (r2 / ntn) * 128, n2 = n_lo + (r2 % ntn) * 256; const GAS f32x4* W = (const GAS f32x4*)(src + (size_t)m2 * K * N + (size_t)k2 * N + n2);
#pragma unroll
            for (int i = 0; i < 16; ++i) { const int p = tid2 + 512 * i; raw[i] = W[(size_t)(p >> 6) * (N / 4) + (p & 63)]; } }
        unsigned char* drow = dst + (size_t)m * dst_stride_bytes;
#pragma unroll
        for (int q = 0; q < 8; ++q) { const int cid = tid2 + 512 * q, nrow = cid >> 4, kc = cid & 15; const LAS float* sp = t + (8 * kc) * 257 + nrow;
            const float e0 = sp[0], e1 = sp[257], e2 = sp[2 * 257], e3 = sp[3 * 257], e4 = sp[4 * 257], e5 = sp[5 * 257], e6 = sp[6 * 257], e7 = sp[7 * 257];
            const size_t drw = (size_t)(wmap(kind, n0 + nrow) - drow_off) * K + k0 + 8 * kc;
            if (fp8) { v2u o; o.x = pg8::pk4_fp8(e0, e1, e2, e3); o.y = pg8::pk4_fp8(e4, e5, e6, e7); *(GAS v2u*)(drow + drw) = o; }
            else { v4u o; o.x = pk2(e0, e1); o.y = pk2(e2, e3); o.z = pk2(e4, e5); o.w = pk2(e6, e7); *(GAS v4u*)(drow + drw * 2) = o; } }
        __syncthreads();
    }
}
constexpr int XT_PER = 352, XT_TOTAL = 24 * XT_PER;
static_assert((DM / 128) * (DFF / 256) == XT_PER && (DFF / 128) * (DM / 256) == XT_PER, "expert tile counts");
__device__ __forceinline__ void convert_expert_tile(Frame& F, int t) {
    LAS float* tl = (LAS float*)(F.lds + RING_OFF);
    const int tid = F.wave * 64 + lane_now();
    const int mat = t / XT_PER, r = t - mat * XT_PER, kidx = mat >> 3, e = mat & 7;
    const float* pg = F.eg; const float* pu = F.eu; const float* pd = F.ed;
    asm volatile("" : "+s"(pg), "+s"(pu), "+s"(pd));
    const bool down = kidx == 2;
    const int K = down ? DFF : DM, N = down ? DM : DFF, ntn = N / 256, k0 = (r / ntn) * 128, n0 = (r % ntn) * 256;
    const float* src = (kidx == 0 ? pg : (kidx == 1 ? pu : pd)) + (size_t)e * DM * DFF;
    unsigned char* dst = down ? (F.ws + WS_WDE + (size_t)e * DM * DFF) : (F.ws + WS_WGUE + (size_t)e * 2 * DFF * DM);
    const int kind = down ? 0 : (kidx == 0 ? 2 : 3); const float wscale = down ? WSC_D : WSC_GU;
    const GAS f32x4* W = (const GAS f32x4*)(src + (size_t)k0 * N + n0);
    f32x4 raw[16];
#pragma unroll
    for (int i = 0; i < 16; ++i) { const int p = tid + 512 * i; raw[i] = W[(size_t)(p >> 6) * (N / 4) + (p & 63)]; }
#pragma unroll
    for (int i = 0; i < 16; ++i) { const int p = tid + 512 * i; LAS float* d = tl + (p >> 6) * 257 + (p & 63) * 4; d[0] = raw[i][0] * wscale; d[1] = raw[i][1] * wscale; d[2] = raw[i][2] * wscale; d[3] = raw[i][3] * wscale; }
    __syncthreads();
#pragma unroll
    for (int q = 0; q < 8; ++q) { const int cid = tid + 512 * q, nrow = cid >> 4, kc = cid & 15; const LAS float* sp = tl + (8 * kc) * 257 + nrow;
        const float e0 = sp[0], e1 = sp[257], e2 = sp[2 * 257], e3 = sp[3 * 257], e4 = sp[4 * 257], e5 = sp[5 * 257], e6 = sp[6 * 257], e7 = sp[7 * 257];
        v2u o; o.x = pg8::pk4_fp8(e0, e1, e2, e3); o.y = pg8::pk4_fp8(e4, e5, e6, e7);
        *(GAS v2u*)(dst + (size_t)wmap(kind, n0 + nrow) * K + k0 + 8 * kc) = o; }
    __syncthreads();
}
constexpr unsigned STEAL_THRESH = 200u;
__device__ __forceinline__ void steal_point(Frame& F, int idx) {
    __syncthreads();
    const bool t0 = (F.wave == 0) && (lane_now() == 0);
    if (t0) __hip_atomic_fetch_add(F.ctl + CW_ARRIVE + 64 * idx, 1u, RLX_AGENT);
#pragma clang loop unroll(disable)
    for (int it = 0; it < XT_TOTAL; ++it) {
        if (t0) { int tt = -1;
            if (__hip_atomic_load(F.ctl + CW_ARRIVE + 64 * idx, RLX_AGENT) < STEAL_THRESH) { const unsigned q = __hip_atomic_fetch_add(F.ctl + CW_STEALQ, 1u, RLX_AGENT); if (q < (unsigned)XT_TOTAL) tt = (int)q; }
            F.MISC[17] = (unsigned)tt; }
        __syncthreads();
        const int tt = (int)__builtin_amdgcn_readfirstlane(F.MISC[17]);
        if (tt < 0) break;
        convert_expert_tile(F, tt);
    }
}
__device__ __forceinline__ void steal_drain(Frame& F) {
    __syncthreads();
    const bool t0 = (F.wave == 0) && (lane_now() == 0);
#pragma clang loop unroll(disable)
    for (int it = 0; it < XT_TOTAL; ++it) {
        if (t0) { const unsigned q = __hip_atomic_fetch_add(F.ctl + CW_STEALQ, 1u, RLX_AGENT); F.MISC[17] = q < (unsigned)XT_TOTAL ? q : 0xffffffffu; }
        __syncthreads();
        const int tt = (int)__builtin_amdgcn_readfirstlane(F.MISC[17]);
        if (tt < 0) break;
        convert_expert_tile(F, tt);
    }
}
__device__ __forceinline__ void p0_prologue(Frame& F) {
    p0_stack(F, F.w_in, DM, NPROJ, 2, F.ws + WS_WIN, (size_t)20 * MiB, 1, true, WSC_GU, 0, 3072, 0);
    p0_stack(F, F.w_in, DM, NPROJ, 2, F.ws + WS_WIN + 8 * MiB, (size_t)20 * MiB, 1, false, 1.f, 3072, 2048, 3072);
    p0_stack(F, F.w_out, DM, DM, 2, F.ws + WS_WOUT, (size_t)DM * DM, 0, true, WSC_O);
    p0_stack(F, F.fg, DM, DFF, 1, F.ws + WS_WGU0, 0, 2, false, 1.f);
    p0_stack(F, F.fu, DM, DFF, 1, F.ws + WS_WGU0, 0, 3, false, 1.f);
    p0_stack(F, F.fd, DFF, DM, 1, F.ws + WS_WD0, 0, 0, false, 1.f);
    { const int i = ((F.vcu * NWAVES + F.wave) * 64 + lane_now()); if (i < NE * DM) { const int e = i / DM, k = i - e * DM; const float w = ((const GAS float*)F.router)[k * NE + e];
          const unsigned hi = f2bf(w), lo = f2bf(w - __builtin_bit_cast(float, hi << 16)); ((GAS bf16*)(F.ws + WS_RWT))[i] = (bf16)hi; ((GAS bf16*)(F.ws + WS_RWT))[NE * DM + i] = (bf16)lo; } }
    { GAS float* rc = (GAS float*)(F.ws + WS_ROPEC); GAS float* rs = (GAS float*)(F.ws + WS_ROPES);
#pragma clang loop unroll(disable)
      for (int i = (F.vcu * NWAVES + F.wave) * 64 + lane_now(); i < S * 64; i += F.G * NWAVES * 64) { const int t = i >> 6, f = i & 63; const float ang = (float)t * INV_FREQ[f]; float sn, cs; sincos_acc(ang, sn, cs); rc[i] = cs; rs[i] = sn; } }
    { const GAS f32x4* xs = (const GAS f32x4*)F.x; GAS v4u* hb = (GAS v4u*)(F.ws + WS_HB);
#pragma clang loop unroll(disable)
      for (int i = (F.vcu * NWAVES + F.wave) * 64 + lane_now(); i < S * DM / 8; i += F.G * NWAVES * 64) { const f32x4 a = xs[2 * i], b = xs[2 * i + 1]; v4u o; o.x = pk2(a[0], a[1]); o.y = pk2(a[2], a[3]); o.z = pk2(b[0], b[1]); o.w = pk2(b[2], b[3]); hb[i] = o;
          ((GAS v2u*)(F.ws + WS_HB8))[i] = (v2u){pg8::pk4_fp8(a[0] * ASC_H, a[1] * ASC_H, a[2] * ASC_H, a[3] * ASC_H), pg8::pk4_fp8(b[0] * ASC_H, b[1] * ASC_H, b[2] * ASC_H, b[3] * ASC_H)}; } }
}

__device__ __forceinline__ void kmean_phase(Frame& F) {
    const int lane = lane_now(), c8 = lane & 15, rg = lane >> 4, u2 = F.wave >> 2, q = F.wave & 3, tid = F.wave * 64 + lane;
    LAS float* ks = (LAS float*)(F.lds + RING_OFF + 8 * 8704);
    { const int unit = (int)blockIdx.x + u2 * F.G, j = unit & 63, h = unit >> 6;
      const GAS v4u* kp = (const GAS v4u*)(F.ws + WS_K) + ((size_t)(j * 256 + 64 * q + rg) * 1024 + h * 128) / 8 + c8;
      v4u w[16];
#pragma unroll
      for (int it = 0; it < 16; ++it) w[it] = kp[(size_t)it * 4 * 128];
      float a[8];
#pragma unroll
      for (int i = 0; i < 8; ++i) a[i] = 0.f;
#pragma unroll
      for (int it = 0; it < 16; ++it) { a[0] += bflo(w[it].x); a[1] += bfhi(w[it].x); a[2] += bflo(w[it].y); a[3] += bfhi(w[it].y); a[4] += bflo(w[it].z); a[5] += bfhi(w[it].z); a[6] += bflo(w[it].w); a[7] += bfhi(w[it].w); }
#pragma unroll
      for (int i = 0; i < 8; ++i) { a[i] += shx(a[i], 16, lane); a[i] += shx(a[i], 32, lane); }
      if (rg == 0) { *(LAS f32x4*)(ks + (u2 * 4 + q) * 128 + 8 * c8) = (f32x4){a[0], a[1], a[2], a[3]}; *(LAS f32x4*)(ks + (u2 * 4 + q) * 128 + 8 * c8 + 4) = (f32x4){a[4], a[5], a[6], a[7]}; } }
    __syncthreads();
    if (tid < 128) { const int uu = tid >> 6, cp = tid & 63, unit = (int)blockIdx.x + uu * F.G, j = unit & 63, h = unit >> 6;
        float m0 = 0.f, m1 = 0.f;
#pragma unroll
        for (int qq = 0; qq < 4; ++qq) { const f32x2 v = *(const LAS f32x2*)(ks + (uu * 4 + qq) * 128 + 2 * cp); m0 += v.x; m1 += v.y; }
        m0 *= (1.f / 256.f); m1 *= (1.f / 256.f);
        const unsigned hi = pk2(m0, m1), lo = pk2(m0 - bflo(hi), m1 - bfhi(hi));
        GAS unsigned* kh = (GAS unsigned*)(F.ws + WS_KMEAN) + ((size_t)(h * 64 + j) * 128) / 2 + cp;
        kh[0] = hi; kh[NH * NBLK * HD / 2] = lo; }
}
__device__ __forceinline__ void vt_phase(Frame& F) {
    const int gw = F.vcu * NWAVES + F.wave, NGW = F.G * NWAVES, lane = lane_now();
    LAS unsigned char* tile = F.lds + RING_OFF + F.wave * 8704;
    constexpr int NU = (S / 32) * NH;
    v4u raw[2][8];
#pragma unroll
    for (int k = 0; k < 2; ++k) { const int unit = (gw + k * NGW) & (NU - 1); const int h = unit & 7, kb = (unit >> 3) * 32;
            const GAS v4u* src = (const GAS v4u*)(F.ws + WS_V) + ((size_t)kb * 1024 + h * 128) / 8;
#pragma unroll
            for (int i = 0; i < 8; ++i) raw[k][i] = src[(size_t)(i * 4 + (lane >> 4)) * 128 + (lane & 15)]; }
#pragma unroll
    for (int k = 0; k < 2; ++k) { const int unit = gw + k * NGW; if (unit < NU) { const int h = unit & 7, kb = (unit >> 3) * 32;
#pragma unroll
            for (int i = 0; i < 8; ++i) *(LAS v4u*)(tile + (i * 4 + (lane >> 4)) * 272 + (lane & 15) * 16) = raw[k][i];
            LDS_WAIT(); asm volatile("" ::: "memory");
            const int ch = lane & 3, G = ch >> 1, g = ch & 1;
#pragma unroll
            for (int i = 0; i < 8; ++i) { const int d = i * 16 + (lane >> 2);
                unsigned short e[8];
#pragma unroll
                for (int p = 0; p < 8; ++p) { const int key = 16 * G + 8 * (p >> 2) + 4 * g + (p & 3); e[p] = *(const LAS unsigned short*)(tile + key * 272 + d * 2); }
                v4u o; o.x = (unsigned)e[0] | ((unsigned)e[1] << 16); o.y = (unsigned)e[2] | ((unsigned)e[3] << 16); o.z = (unsigned)e[4] | ((unsigned)e[5] << 16); o.w = (unsigned)e[6] | ((unsigned)e[7] << 16);
                *((GAS v4u*)(F.ws + WS_VT) + ((size_t)(h * 128 + d) * S + kb + 8 * ch) / 8) = o; }
            LDS_WAIT(); asm volatile("" ::: "memory"); } }
}

constexpr int CT = 16, CROWS = CT + 30;
__device__ __forceinline__ void conv_phase(Frame& F, int l) {
    LAS unsigned* ub = (LAS unsigned*)(F.lds + RING_OFF);
    LAS f32x2* part = (LAS f32x2*)(F.lds + RING_OFF + CROWS * 2048);
    const int lane = lane_now(), tid = F.wave * 64 + lane;
    const GAS f32x2* cw = (const GAS f32x2*)(F.conv_w + (size_t)l * CKW * 1024) + tid;
    float w0[CKW], w1[CKW];
#pragma unroll
    for (int k = 0; k < CKW; ++k) { const f32x2 w = cw[k * 512]; w0[k] = w.x; w1[k] = w.y; }
    const f32x2 cb = ((const GAS f32x2*)(F.conv_b + l * 1024))[tid], lg = ((const GAS f32x2*)(F.conv_g + l * 1024))[tid], lb = ((const GAS f32x2*)(F.conv_be + l * 1024))[tid];
    const GAS v4u* U = (const GAS v4u*)(F.ws + WS_U);
    GAS unsigned* CAT = (GAS unsigned*)(F.ws + WS_CAT);
    constexpr int NP = (CROWS * 128 + NWAVES * 64 - 1) / (NWAVES * 64);
    const int tb = (int)blockIdx.x * 64;
#pragma clang loop unroll(disable)
    for (int st = 0; st < 4; ++st) { const int t0 = tb + st * CT;
        TSTART(21);
        { const int lane2 = lane_now(), tid2 = F.wave * 64 + lane2;
          v4u nx[NP];
#pragma unroll
          for (int i = 0; i < NP; ++i) { const int p = tid2 + NWAVES * 64 * i, pc = p < CROWS * 128 ? p : CROWS * 128 - 1, tok = t0 - 30 + (pc >> 7);
              const v4u ld = U[(size_t)(tok >= 0 ? tok : 0) * 128 + (pc & 127)]; const bool ok = tok >= 0; nx[i].x = ok ? ld.x : 0u; nx[i].y = ok ? ld.y : 0u; nx[i].z = ok ? ld.z : 0u; nx[i].w = ok ? ld.w : 0u; }
#pragma unroll
          for (int i = 0; i < NP; ++i) { const int p = tid2 + NWAVES * 64 * i; if (p < CROWS * 128) *(LAS v4u*)(ub + (p >> 7) * 512 + (p & 127) * 4) = nx[i]; } }
        __syncthreads();
        TSTOP(21); TSTART(22);
        f32x2 av[CT];
#pragma unroll
        for (int t = 0; t < CT; ++t) av[t] = cb;
#pragma unroll
        for (int r = 0; r < CROWS; ++r) { const unsigned w = ub[r * 512 + tid]; const f32x2 x = {bflo(w), bfhi(w)};
#pragma unroll
            for (int t = 0; t < CT; ++t) { if (r - t >= 0 && r - t <= 30) av[t] += (f32x2){w0[r - t], w1[r - t]} * x; } }
        TSTOP(22); TSTART(23);
        { float red[2 * CT];
#pragma unroll
          for (int t = 0; t < CT; ++t) { red[2 * t] = av[t].x + av[t].y; red[2 * t + 1] = av[t].x * av[t].x + av[t].y * av[t].y; }
          float r16[16], r8[8], r4[4], r2[2], r1;
#define RS_STEP(dst, src, n, bit) { const bool hi = (lane & (bit)) != 0; float snd_[n], kp_[n]; \
            _Pragma("unroll") for (int i = 0; i < (n); ++i) { float lo_ = src[i], up_ = src[i + (n)]; asm volatile("" : "+v"(lo_), "+v"(up_));     \
                snd_[i] = shx(hi ? lo_ : up_, (bit), lane); kp_[i] = hi ? up_ : lo_; } \
            _Pragma("unroll") for (int i = 0; i < (n); ++i) dst[i] = kp_[i] + snd_[i]; }
          RS_STEP(r16, red, 16, 32) RS_STEP(r8, r16, 8, 16) RS_STEP(r4, r8, 4, 8) RS_STEP(r2, r4, 2, 4)
          { const bool hi = (lane & 2) != 0; float lo_ = r2[0], up_ = r2[1]; asm volatile("" : "+v"(lo_), "+v"(up_)); const float snd = shx(hi ? lo_ : up_, 2, lane); r1 = (hi ? up_ : lo_) + snd; }
#undef RS_STEP
          r1 += shx(r1, 1, lane);
          if ((lane & 1) == 0) ((LAS float*)part)[F.wave * (2 * CT) + (lane >> 1)] = r1; }
        __syncthreads();
        LAS f32x2* fin = part + NWAVES * CT;
        if (tid < CT) { float s1 = 0.f, q = 0.f;
#pragma unroll
            for (int w = 0; w < 8; ++w) { const f32x2 pp = part[w * CT + tid]; s1 += pp.x; q += pp.y; }
            const float mean = s1 * (1.f / 1024.f), var = fmaxf(q * (1.f / 1024.f) - mean * mean, 0.f);
            fin[tid] = (f32x2){mean, 1.0f / sqrtf(var + LN_EPS)}; }
        __syncthreads();
        TSTOP(23); TSTART(24);
        { f32x4 fv[CT / 2];
#pragma unroll
          for (int i = 0; i < CT / 2; ++i) fv[i] = ((const LAS f32x4*)fin)[i];
#pragma unroll
          for (int t = 0; t < CT; ++t) { const float mean = fv[t >> 1][2 * (t & 1)], rstd = fv[t >> 1][2 * (t & 1) + 1];
              const float y0 = (av[t].x - mean) * rstd * lg.x + lb.x, y1 = (av[t].y - mean) * rstd * lg.y + lb.y;
              ((GAS unsigned short*)(F.ws + WS_CAT))[((size_t)(t0 + t) * DM + 1024) / 2 + tid] = (unsigned short)pg8::pk4_fp8(y0 * pg8::sigmoidf_fast(y0) * ASC_CAT, y1 * pg8::sigmoidf_fast(y1) * ASC_CAT, 0.f, 0.f); } }
        __syncthreads();
        TSTOP(24);
    }
}

typedef float f32x16 __attribute__((ext_vector_type(16)));
typedef __bf16 bf16x2_t __attribute__((ext_vector_type(2)));
__device__ __forceinline__ unsigned cvtpk(float lo, float hi) { const f32x2 v = {lo, hi}; const bf16x2_t b = __builtin_convertvector(v, bf16x2_t); return __builtin_bit_cast(unsigned, b); }
#define MFMA32(a, b, c) __builtin_amdgcn_mfma_f32_32x32x16_bf16((a), (b), (c), 0, 0, 0)
constexpr int LIST_PER_HEAD = 256 * 2016;
__device__ __forceinline__ int binoff(int j) { return 256 * (63 * j - (j * (j - 1)) / 2); }
#define TOP3_INSERT(v, j) do { const float v_ = (v); const int j_ = (j); \
    if (v_ > tv2) { if (v_ > tv1) { tv2 = tv1; ti2 = ti1; if (v_ > tv0) { tv1 = tv0; ti1 = ti0; tv0 = v_; ti0 = j_; } else { tv1 = v_; ti1 = j_; } } else { tv2 = v_; ti2 = j_; } } } while (0)
__device__ __forceinline__ void sel_phase(Frame& F, int l) {
    LAS int* cntL = (LAS int*)(F.lds + RING_OFF); LAS int* baseL = cntL + 64;
    const int lane = lane_now(), r = lane & 31, hg = lane >> 5, tid = F.wave * 64 + lane;
    const float NEG = -__builtin_inff();
#pragma clang loop unroll(disable)
    for (int unit = blockIdx.x; unit < 63 * NH; unit += F.G) { const int b = 1 + (unit >> 3), h = unit & 7;
        if (tid < 64) cntL[tid] = 0;
        __syncthreads();
        const int t = b * 256 + F.wave * 32 + r;
        const GAS bf16x8* qp = (const GAS bf16x8*)(F.ws + WS_Q) + ((size_t)t * 1024 + h * 128) / 8 + hg;
        bf16x8 qf[8];
#pragma unroll
        for (int kk = 0; kk < 8; ++kk) qf[kk] = qp[2 * kk];
        const GAS bf16x8* kh = (const GAS bf16x8*)(F.ws + WS_KMEAN) + ((size_t)(h * 64 + r) * 128) / 8 + hg;
        f32x16 G0, G1;
#pragma unroll
        for (int i = 0; i < 16; ++i) { G0[i] = 0.f; G1[i] = 0.f; }
#pragma unroll
        for (int kk = 0; kk < 8; ++kk) { G0 = MFMA32(kh[2 * kk], qf[kk], G0); G0 = MFMA32(kh[2 * kk + NH * NBLK * HD / 8], qf[kk], G0); }
        if (b > 32) {
#pragma unroll
            for (int kk = 0; kk < 8; ++kk) { G1 = MFMA32(kh[2 * kk + 32 * 16], qf[kk], G1); G1 = MFMA32(kh[2 * kk + 32 * 16 + NH * NBLK * HD / 8], qf[kk], G1); } }
        float tv0 = NEG, tv1 = NEG, tv2 = NEG; int ti0 = 0, ti1 = 0, ti2 = 0;
#pragma unroll
        for (int i = 0; i < 16; ++i) { const int j = (i & 3) + 8 * (i >> 2) + 4 * hg; TOP3_INSERT(j < b ? G0[i] : NEG, j); }
        if (b > 32) {
#pragma unroll
            for (int i = 0; i < 16; ++i) { const int j = 32 + (i & 3) + 8 * (i >> 2) + 4 * hg; TOP3_INSERT(j < b ? G1[i] : NEG, j); } }
        { const float p0 = shx(tv0, 32, lane), p1 = shx(tv1, 32, lane), p2 = shx(tv2, 32, lane); const int q0 = shx_i(ti0, 32, lane), q1 = shx_i(ti1, 32, lane), q2 = shx_i(ti2, 32, lane);
          TOP3_INSERT(p0, q0); TOP3_INSERT(p1, q1); TOP3_INSERT(p2, q2); }
        int rk0 = 0, rk1 = 0, rk2 = 0;
        if (hg == 0) {
            if (tv0 > NEG) rk0 = __hip_atomic_fetch_add(cntL + ti0, 1, __ATOMIC_RELAXED, __HIP_MEMORY_SCOPE_WORKGROUP);
            if (tv1 > NEG) rk1 = __hip_atomic_fetch_add(cntL + ti1, 1, __ATOMIC_RELAXED, __HIP_MEMORY_SCOPE_WORKGROUP);
            if (tv2 > NEG) rk2 = __hip_atomic_fetch_add(cntL + ti2, 1, __ATOMIC_RELAXED, __HIP_MEMORY_SCOPE_WORKGROUP); }
        __syncthreads();
        if (tid < 64) { const int c = cntL[tid]; if (c > 0) baseL[tid] = (int)__hip_atomic_fetch_add(F.ctl + CW_LCNT + l * 512 + h * 64 + tid, (unsigned)c, RLX_AGENT); }
        __syncthreads();
        if (hg == 0) { GAS int* L = (GAS int*)(F.ws + WS_LIST) + (size_t)h * LIST_PER_HEAD;
            if (tv0 > NEG) L[binoff(ti0) + baseL[ti0] + rk0] = t * 4 + 0;
            if (tv1 > NEG) L[binoff(ti1) + baseL[ti1] + rk1] = t * 4 + 1;
            if (tv2 > NEG) L[binoff(ti2) + baseL[ti2] + rk2] = t * 4 + 2; }
        __syncthreads();
    }
}
constexpr int KROW = 272, VROW = 528, KBUF_BYTES = 256 * KROW, VBUF_BYTES = 128 * VROW;
#define SCHED_FENCE() __builtin_amdgcn_sched_barrier(0)
template <bool CAUSAL>
__device__ __forceinline__ void moba_tile(const bf16x8 (&qf)[8], const LAS unsigned char* kb, const LAS unsigned char* vb, const int nkt, const int r, const int hg, f32x16 (&O)[4], float& ms, float& lsum) {
    const float NEG = -__builtin_inff(), SC = 0.08838834764831845f * 1.44269504088896341f;
    f32x16 Sx[8];
    bf16x8 kfA[8], kfB[8];
#pragma unroll
    for (int kk = 0; kk < 8; ++kk) kfA[kk] = *(const LAS bf16x8*)(kb + kk * 32);
#pragma unroll
    for (int kt = 0; kt < 8; ++kt) {
        if (kt < nkt) { f32x16 a;
#pragma unroll
            for (int i = 0; i < 16; ++i) a[i] = 0.f;
            if (kt + 1 < 8 && kt + 1 < nkt) {
#pragma unroll
                for (int kk = 0; kk < 8; ++kk) { if (kt & 1) kfA[kk] = *(const LAS bf16x8*)(kb + (kt + 1) * 32 * KROW + kk * 32); else kfB[kk] = *(const LAS bf16x8*)(kb + (kt + 1) * 32 * KROW + kk * 32); } }
            SCHED_FENCE();
#pragma unroll
            for (int kk = 0; kk < 8; ++kk) a = MFMA32((kt & 1) ? kfB[kk] : kfA[kk], qf[kk], a);
            SCHED_FENCE();
            if (CAUSAL && kt == nkt - 1) {
#pragma unroll
                for (int i = 0; i < 16; ++i) a[i] = ((i & 3) + 8 * (i >> 2) + 4 * hg > r) ? NEG : a[i]; }
            Sx[kt] = a;
        } else {
#pragma unroll
            for (int i = 0; i < 16; ++i) Sx[kt][i] = NEG; }
    }
    float mx = NEG;
#pragma unroll
    for (int kt = 0; kt < 8; ++kt)
#pragma unroll
        for (int i = 0; i < 16; ++i) mx = fmaxf(mx, Sx[kt][i]);
    mx = fmaxf(mx, shx(mx, 32, r + 32 * hg));
    ms = mx * SC;
    float ls = 0.f;
    bf16x8 pb[8][2];
#pragma unroll
    for (int kt = 0; kt < 8; ++kt)
#pragma unroll
        for (int s2 = 0; s2 < 2; ++s2) { float p[8];
#pragma unroll
            for (int i = 0; i < 8; ++i) { p[i] = __builtin_amdgcn_exp2f(Sx[kt][8 * s2 + i] * SC - ms); ls += p[i]; }
            v4u pw; pw.x = cvtpk(p[0], p[1]); pw.y = cvtpk(p[2], p[3]); pw.z = cvtpk(p[4], p[5]); pw.w = cvtpk(p[6], p[7]);
            pb[kt][s2] = __builtin_bit_cast(bf16x8, pw); }
    lsum = ls + shx(ls, 32, r + 32 * hg);
#pragma unroll
    for (int dt = 0; dt < 4; ++dt)
#pragma unroll
        for (int i = 0; i < 16; ++i) O[dt][i] = 0.f;
    bf16x8 vfA[4], vfB[4];
#pragma unroll
    for (int dt = 0; dt < 4; ++dt) vfA[dt] = *(const LAS bf16x8*)(vb + dt * 32 * VROW);
#pragma unroll
    for (int st = 0; st < 16; ++st) { const int kt = st >> 1, s2 = st & 1;
        if (kt < nkt) {
            if (st + 1 < 16 && ((st + 1) >> 1) < nkt) {
#pragma unroll
                for (int dt = 0; dt < 4; ++dt) { if (st & 1) vfA[dt] = *(const LAS bf16x8*)(vb + dt * 32 * VROW + (st + 1) * 32); else vfB[dt] = *(const LAS bf16x8*)(vb + dt * 32 * VROW + (st + 1) * 32); } }
            SCHED_FENCE();
#pragma unroll
            for (int dt = 0; dt < 4; ++dt) O[dt] = MFMA32((st & 1) ? vfB[dt] : vfA[dt], pb[kt][s2], O[dt]);
            SCHED_FENCE();
        }
    }
}
__device__ __forceinline__ void stage_kv(Frame& F, int h, int j, int tid) {
    LAS unsigned char* kbuf = F.lds + RING_OFF; LAS unsigned char* vbuf = kbuf + KBUF_BYTES;
    const GAS v4u* kg = (const GAS v4u*)(F.ws + WS_K) + ((size_t)(j * 256) * 1024 + h * 128) / 8;
    const GAS v4u* vg = (const GAS v4u*)(F.ws + WS_VT) + ((size_t)(h * 128) * S + j * 256) / 8;
    v4u kr[8], vr[8];
#pragma unroll
    for (int i = 0; i < 8; ++i) { const int p = tid + 512 * i; kr[i] = kg[(size_t)(p >> 4) * 128 + (p & 15)]; vr[i] = vg[(size_t)(p >> 5) * (S / 8) + (p & 31)]; }
#pragma unroll
    for (int i = 0; i < 8; ++i) { const int p = tid + 512 * i; *(LAS v4u*)(kbuf + (p >> 4) * KROW + (p & 15) * 16) = kr[i]; *(LAS v4u*)(vbuf + (p >> 5) * VROW + (p & 31) * 16) = vr[i]; }
}
__device__ __forceinline__ void partial_phase(Frame& F, int l) {
    gu32* lcnt = F.ctl + CW_LCNT + l * 512;
    LAS int* tab = (LAS int*)(F.lds + RING_OFF + KBUF_BYTES + VBUF_BYTES);
    LAS int* tabc = tab + 512;
    LAS int* tabn = tab + 1024;
    { const int lane = lane_now(); int tl[8], cs[8], cn[8], sum = 0, csum = 0;
#pragma unroll
      for (int i = 0; i < 8; ++i) { cn[i] = (int)__hip_atomic_load(lcnt + lane * 8 + i, RLX_AGENT); tl[i] = (cn[i] + 255) >> 8; cs[i] = 14 * tl[i] + (tl[i] ? 11 : 0); sum += tl[i]; csum += cs[i]; }
      int inc = sum, cinc = csum;
#pragma unroll
      for (int o = 1; o < 64; o <<= 1) { const int v = __builtin_amdgcn_ds_bpermute((lane - o) << 2, inc), cv = __builtin_amdgcn_ds_bpermute((lane - o) << 2, cinc); if (lane >= o) { inc += v; cinc += cv; } }
      int run = inc - sum, crun = cinc - csum;
      if (F.wave == 0) {
#pragma unroll
          for (int i = 0; i < 8; ++i) { run += tl[i]; crun += cs[i]; tab[lane * 8 + i] = run; tabc[lane * 8 + i] = crun; tabn[lane * 8 + i] = cn[i]; } } }
    __syncthreads();
    int u_lo, u_hi;
    { const int lane = lane_now(); const long T = tabc[511];
      const int x0 = (int)(((long)blockIdx.x * T) / F.G), x1 = (int)(((long)(blockIdx.x + 1) * T) / F.G);
      int c0 = 0, c1 = 0; int plo = lane ? tabc[lane * 8 - 1] : 0, pu = lane ? tab[lane * 8 - 1] : 0;
#pragma unroll
      for (int i = 0; i < 8; ++i) { const int hi = tabc[lane * 8 + i], uu = tab[lane * 8 + i], nu = uu - pu;
          { const int loc = x0 - plo; c0 += (x0 >= hi) ? nu : (loc <= 0 ? 0 : (loc <= 25 ? 1 : 1 + (loc - 25 + 13) / 14)); }
          { const int loc = x1 - plo; c1 += (x1 >= hi) ? nu : (loc <= 0 ? 0 : (loc <= 25 ? 1 : 1 + (loc - 25 + 13) / 14)); }
          plo = hi; pu = uu; }
#pragma unroll
      for (int o = 1; o < 64; o <<= 1) { c0 += shx_i(c0, o, lane); c1 += shx_i(c1, o, lane); }
      u_lo = __builtin_amdgcn_readfirstlane(c0); u_hi = __builtin_amdgcn_readfirstlane(c1); }
    int staged = -1;
#define PARTIAL_LOCATE(uu, obin, ochunk, oe) { const int lane_ = lane_now(); int b_ = 0, c_ = 0; bool m_ = false; \
        { int lo_ = lane_ ? tab[lane_ * 8 - 1] : 0; \
          _Pragma("unroll") for (int i = 0; i < 8; ++i) { const int hi_ = tab[lane_ * 8 + i]; if ((uu) >= lo_ && (uu) < hi_) { m_ = true; b_ = lane_ * 8 + i; c_ = (uu) - lo_; } lo_ = hi_; } } \
        const int s_ = __builtin_ctzll(__ballot(m_)); obin = __builtin_amdgcn_readlane(b_, s_); ochunk = __builtin_amdgcn_readlane(c_, s_); \
        const int n_ = __builtin_amdgcn_readfirstlane(tabn[obin]), base_ = ochunk * 256 + F.wave * 32, r_ = lane_ & 31; \
        oe = ((const GAS int*)(F.ws + WS_LIST))[(size_t)(obin >> 6) * LIST_PER_HEAD + binoff(obin & 63) + (base_ < n_ ? base_ + (base_ + r_ < n_ ? r_ : 0) : 0)]; }
    int nbin = 0, nchunk = 0, ne = 0;
    if (u_lo < u_hi) PARTIAL_LOCATE(u_lo, nbin, nchunk, ne)
#pragma clang loop unroll(disable)
    for (int u = u_lo; u < u_hi; ++u) {
        const int lane = lane_now(), r = lane & 31, hg = lane >> 5, tid = F.wave * 64 + lane;
        const LAS unsigned char* kb = F.lds + RING_OFF + r * KROW + hg * 16; const LAS unsigned char* vb = F.lds + RING_OFF + KBUF_BYTES + r * VROW + hg * 16;
        TSTART(41);
        const int bin = nbin, chunk = nchunk, e = ne;
        { const int un = (u + 1 < u_hi) ? u + 1 : u; PARTIAL_LOCATE(un, nbin, nchunk, ne) }
        const int h = bin >> 6, j = bin & 63, n = __builtin_amdgcn_readfirstlane(tabn[bin]);
        const int base = chunk * 256 + F.wave * 32; const bool active = base < n, valid = base + r < n;
        const int t = e >> 2, sl = e & 3;
        const GAS bf16x8* qp = (const GAS bf16x8*)(F.ws + WS_Q) + ((size_t)t * 1024 + h * 128) / 8 + hg;
        bf16x8 qf[8];
#pragma unroll
        for (int kk = 0; kk < 8; ++kk) qf[kk] = qp[2 * kk];
        TSTOP(41); TSTART(42);
        if (bin != staged) {
            __syncthreads();
            stage_kv(F, h, j, tid);
            __syncthreads();
            staged = bin; }
        TSTOP(42);
        if (active) {
            f32x16 O[4]; float ms, ls;
            TSTART(43);
            moba_tile<false>(qf, kb, vb, 8, r, hg, O, ms, ls);
            TSTOP(43); TSTART(44);
            if (valid) { const size_t idx = ((size_t)h * S + t) * 3 + sl; const float inv = 1.0f / ls;
                GAS v2u* po = (GAS v2u*)(F.ws + WS_PO) + idx * 32 + hg;
#pragma unroll
                for (int dt = 0; dt < 4; ++dt)
#pragma unroll
                    for (int g4 = 0; g4 < 4; ++g4) po[dt * 8 + 2 * g4] = (v2u){cvtpk(O[dt][4 * g4] * inv, O[dt][4 * g4 + 1] * inv), cvtpk(O[dt][4 * g4 + 2] * inv, O[dt][4 * g4 + 3] * inv)};
                if (hg == 0) ((GAS f32x2*)(F.ws + WS_PML))[idx] = (f32x2){ms, ls}; }
            TSTOP(44);
        }
    }
#undef PARTIAL_LOCATE
}
__device__ __forceinline__ void own_phase(Frame& F) {
#pragma clang loop unroll(disable)
    for (int u = blockIdx.x; u < NBLK * NH; u += F.G) { const int h = u & 7, b = u >> 3, qt = F.wave;
        const int lane = lane_now(), r = lane & 31, hg = lane >> 5, tid = F.wave * 64 + lane;
        const LAS unsigned char* kb = F.lds + RING_OFF + r * KROW + hg * 16; const LAS unsigned char* vb = F.lds + RING_OFF + KBUF_BYTES + r * VROW + hg * 16;
        const int t = b * 256 + qt * 32 + r;
        const GAS bf16x8* qp = (const GAS bf16x8*)(F.ws + WS_Q) + ((size_t)t * 1024 + h * 128) / 8 + hg;
        bf16x8 qf[8];
#pragma unroll
        for (int kk = 0; kk < 8; ++kk) qf[kk] = qp[2 * kk];
        __syncthreads();
        stage_kv(F, h, b, tid);
        __syncthreads();
        f32x16 O[4]; float ms, ls;
        moba_tile<true>(qf, kb, vb, qt + 1, r, hg, O, ms, ls);
        __syncthreads();
        { LAS unsigned char* ow = F.lds + RING_OFF + F.wave * 8704;
          LAS f32x2* stq = (LAS f32x2*)(F.lds + RING_OFF + KBUF_BYTES) + F.wave * 32;
#pragma unroll
          for (int dt = 0; dt < 4; ++dt)
#pragma unroll
              for (int g4 = 0; g4 < 4; ++g4) *(LAS v2u*)(ow + r * 272 + (dt * 32 + 8 * g4 + 4 * hg) * 2) = (v2u){cvtpk(O[dt][4 * g4], O[dt][4 * g4 + 1]), cvtpk(O[dt][4 * g4 + 2], O[dt][4 * g4 + 3])};
          if (hg == 0) stq[r] = (f32x2){ms, ls};
          LDS_WAIT(); asm volatile("" ::: "memory");
          const int qq = lane >> 4, c = lane & 15, nv = b < 3 ? b : 3;
#pragma unroll
          for (int half = 0; half < 2; ++half) {
              v4u pv[4][3]; f32x2 pml[4][3];
#pragma unroll
              for (int pp = 0; pp < 4; ++pp) { const int q = 4 * (half * 4 + pp) + qq; const size_t idx0 = ((size_t)h * S + (b * 256 + qt * 32 + q)) * 3;
#pragma unroll
                  for (int s2 = 0; s2 < 3; ++s2) { const int so = s2 < nv ? s2 : 0;
                      pv[pp][s2] = ((const GAS v4u*)(F.ws + WS_PO))[(idx0 + so) * 16 + c]; pml[pp][s2] = ((const GAS f32x2*)(F.ws + WS_PML))[idx0 + so]; } }
#pragma unroll
              for (int pp = 0; pp < 4; ++pp) { const int q = 4 * (half * 4 + pp) + qq, t2 = b * 256 + qt * 32 + q;
                  const f32x2 own = stq[q]; const v4u ov = *(const LAS v4u*)(ow + q * 272 + c * 16);
                  float M = own.x;
#pragma unroll
                  for (int s2 = 0; s2 < 3; ++s2) { const bool have = s2 < nv; pml[pp][s2].x = have ? pml[pp][s2].x : -__builtin_inff(); pml[pp][s2].y = have ? pml[pp][s2].y : 0.f;
                      pv[pp][s2].x = have ? pv[pp][s2].x : 0u; pv[pp][s2].y = have ? pv[pp][s2].y : 0u; pv[pp][s2].z = have ? pv[pp][s2].z : 0u; pv[pp][s2].w = have ? pv[pp][s2].w : 0u;
                      M = fmaxf(M, pml[pp][s2].x); }
                  const float wo = __builtin_amdgcn_exp2f(own.x - M); float W = own.y * wo, w[3];
#pragma unroll
                  for (int s2 = 0; s2 < 3; ++s2) { w[s2] = pml[pp][s2].y * __builtin_amdgcn_exp2f(pml[pp][s2].x - M); W += w[s2]; }
                  float o[8] = {bflo(ov.x) * wo, bfhi(ov.x) * wo, bflo(ov.y) * wo, bfhi(ov.y) * wo, bflo(ov.z) * wo, bfhi(ov.z) * wo, bflo(ov.w) * wo, bfhi(ov.w) * wo};
#pragma unroll
                  for (int s2 = 0; s2 < 3; ++s2) { const v4u v = pv[pp][s2]; o[0] += w[s2] * bflo(v.x); o[1] += w[s2] * bfhi(v.x); o[2] += w[s2] * bflo(v.y); o[3] += w[s2] * bfhi(v.y); o[4] += w[s2] * bflo(v.z); o[5] += w[s2] * bfhi(v.z); o[6] += w[s2] * bflo(v.w); o[7] += w[s2] * bfhi(v.w); }
                  const float osc = ASC_CAT / W;
                  *(GAS v2u*)(F.ws + WS_CAT + (size_t)t2 * DM + h * 128 + 8 * c) = (v2u){pg8::pk4_fp8(o[0] * osc, o[1] * osc, o[2] * osc, o[3] * osc), pg8::pk4_fp8(o[4] * osc, o[5] * osc, o[6] * osc, o[7] * osc)}; }
          } }
    }
}

__device__ __forceinline__ void ln_phase(Frame& F, const float* xres_, const bf16* y_, const float* g_, const float* b_, const float* router, bool write8) {
    const int gw = F.vcu * NWAVES + F.wave, lane = lane_now();
    f32x4 gv[8], bv[8];
#pragma unroll
    for (int j = 0; j < 8; ++j) { gv[j] = ((const GAS f32x4*)g_)[lane + 64 * j]; bv[j] = ((const GAS f32x4*)b_)[lane + 64 * j]; }
    f32x4 hraw[8]; v2u hraw16[8], yraw[8];
    { const GAS v2u* yp = (const GAS v2u*)(y_ + (size_t)(gw * 8) * DM) + lane;
      if (xres_) { const GAS f32x4* hp = (const GAS f32x4*)(xres_ + (size_t)(gw * 8) * DM) + lane;
#pragma unroll
          for (int j = 0; j < 8; ++j) hraw[j] = hp[64 * j]; }
      else { const GAS v2u* hp = (const GAS v2u*)(F.ws + WS_HB + (size_t)(gw * 8) * DM * 2) + lane;
#pragma unroll
          for (int j = 0; j < 8; ++j) hraw16[j] = hp[64 * j]; }
#pragma unroll
      for (int j = 0; j < 8; ++j) yraw[j] = yp[64 * j]; }
#pragma clang loop unroll(disable)
    for (int i = 0; i < S / (256 * NWAVES); ++i) { const int row = gw * (S / (256 * NWAVES)) + i;
        f32x4 v[8]; float s = 0.f;
#pragma unroll
        for (int j = 0; j < 8; ++j) { const v2u yv = yraw[j]; const f32x4 hv = xres_ ? hraw[j] : (f32x4){bflo(hraw16[j].x), bfhi(hraw16[j].x), bflo(hraw16[j].y), bfhi(hraw16[j].y)};
            v[j] = hv * ALPHA + (f32x4){bflo(yv.x), bfhi(yv.x), bflo(yv.y), bfhi(yv.y)}; s += (v[j][0] + v[j][1]) + (v[j][2] + v[j][3]); }
        { const int rown = (i + 1 < S / (256 * NWAVES)) ? row + 1 : row;
          const GAS v2u* yp = (const GAS v2u*)(y_ + (size_t)rown * DM) + lane;
            if (xres_) { const GAS f32x4* hp = (const GAS f32x4*)(xres_ + (size_t)rown * DM) + lane;
#pragma unroll
                for (int j = 0; j < 8; ++j) hraw[j] = hp[64 * j]; }
            else { const GAS v2u* hp = (const GAS v2u*)(F.ws + WS_HB + (size_t)rown * DM * 2) + lane;
#pragma unroll
                for (int j = 0; j < 8; ++j) hraw16[j] = hp[64 * j]; }
#pragma unroll
            for (int j = 0; j < 8; ++j) yraw[j] = yp[64 * j]; }
        const float mean = wave_sum(s, lane) * (1.f / DM); float s2 = 0.f;
#pragma unroll
        for (int j = 0; j < 8; ++j) { v[j] = v[j] - mean; s2 += (v[j][0] * v[j][0] + v[j][1] * v[j][1]) + (v[j][2] * v[j][2] + v[j][3] * v[j][3]); }
        const float rstd = 1.f / sqrtf(wave_sum(s2, lane) * (1.f / DM) + LN_EPS);
        GAS v2u* hb = (GAS v2u*)(F.ws + WS_HB + (size_t)row * DM * 2) + lane;
#pragma unroll
        for (int j = 0; j < 8; ++j) { v[j] = v[j] * rstd * gv[j] + bv[j]; hb[64 * j] = (v2u){pk2(v[j][0], v[j][1]), pk2(v[j][2], v[j][3])};
            if (write8) ((GAS unsigned*)(F.ws + WS_HB8 + (size_t)row * DM))[64 * j + lane] = pg8::pk4_fp8(v[j][0] * ASC_H, v[j][1] * ASC_H, v[j][2] * ASC_H, v[j][3] * ASC_H); }
    }
}
typedef float f32x4r __attribute__((ext_vector_type(4)));
__device__ __forceinline__ void router_phase(Frame& F) {
    const int lane = lane_now(), rr = lane & 15, kg = lane >> 4, w = F.wave;
    LAS float* lg = (LAS float*)(F.lds + RING_OFF);
    const GAS bf16x8* bp = (const GAS bf16x8*)(F.ws + WS_RWT) + ((size_t)(rr & 7) * DM + 256 * w) / 8 + kg;
    const bool colok = rr < 8;
    bf16x8 bh[8], bl[8], af[4][8];
#pragma unroll
    for (int kk = 0; kk < 8; ++kk) { bh[kk] = bp[4 * kk]; bl[kk] = bp[4 * kk + NE * DM / 8]; }
#pragma unroll
    for (int g = 0; g < 4; ++g) { const int row0 = ((int)blockIdx.x + F.G * g) * 16; const GAS bf16x8* ap = (const GAS bf16x8*)(F.ws + WS_HB) + ((size_t)(row0 + rr) * DM + 256 * w) / 8 + kg;
#pragma unroll
        for (int kk = 0; kk < 8; ++kk) af[g][kk] = ap[4 * kk]; }
    if (!colok) {
#pragma unroll
        for (int kk = 0; kk < 8; ++kk) { bh[kk] = (bf16x8){0, 0, 0, 0, 0, 0, 0, 0}; bl[kk] = bh[kk]; } }
#pragma unroll
    for (int g = 0; g < 4; ++g) { f32x4r acc = {0.f, 0.f, 0.f, 0.f};
#pragma unroll
        for (int kk = 0; kk < 8; ++kk) { acc = __builtin_amdgcn_mfma_f32_16x16x32_bf16(af[g][kk], bh[kk], acc, 0, 0, 0); acc = __builtin_amdgcn_mfma_f32_16x16x32_bf16(af[g][kk], bl[kk], acc, 0, 0, 0); }
        if (colok) {
#pragma unroll
            for (int i = 0; i < 4; ++i) lg[((g * 8 + w) * 16 + 4 * kg + i) * 8 + rr] = acc[i]; } }
    __syncthreads();
    if (w == 0) { const int g = lane >> 4, r = lane & 15; float v[8] = {0.f, 0.f, 0.f, 0.f, 0.f, 0.f, 0.f, 0.f};
#pragma unroll
        for (int ww = 0; ww < 8; ++ww) { const f32x4r l0 = *(const LAS f32x4r*)(lg + ((g * 8 + ww) * 16 + r) * 8), l1 = *(const LAS f32x4r*)(lg + ((g * 8 + ww) * 16 + r) * 8 + 4);
            v[0] += l0[0]; v[1] += l0[1]; v[2] += l0[2]; v[3] += l0[3]; v[4] += l1[0]; v[5] += l1[1]; v[6] += l1[2]; v[7] += l1[3]; }
        float v1 = v[0]; int i1 = 0;
#pragma unroll
        for (int e = 1; e < 8; ++e) if (v[e] > v1) { v1 = v[e]; i1 = e; }
        float v2 = -__builtin_inff(); int i2 = -1;
#pragma unroll
        for (int e = 0; e < 8; ++e) if (e != i1 && v[e] > v2) { v2 = v[e]; i2 = e; }
        const float g1 = 1.0f / (1.0f + __expf(v2 - v1)), g2 = 1.0f - g1; const int row = ((int)blockIdx.x + F.G * g) * 16 + r;
        ((GAS int*)(F.ws + WS_EIDX))[row * 2] = i1; ((GAS int*)(F.ws + WS_EIDX))[row * 2 + 1] = i2; ((GAS float*)(F.ws + WS_GATEW))[row * 2] = g1; ((GAS float*)(F.ws + WS_GATEW))[row * 2 + 1] = g2;
        int mine = 0;
#pragma unroll
        for (int e = 0; e < 8; ++e) { const int c = __builtin_popcountll(__ballot(i1 == e)) + __builtin_popcountll(__ballot(i2 == e)); mine = (lane == e) ? c : mine; }
        if (lane < 8 && mine) __hip_atomic_fetch_add(F.ctl + CW_ECNT + 64 * lane, (unsigned)mine, RLX_AGENT); }
    __syncthreads();
}
__device__ __forceinline__ void load_expert_layout(Frame& F, int (&off)[8], int (&cum)[8], int& npanels) {
    const int lane = lane_now();
    const int cv = (int)__hip_atomic_load(F.ctl + CW_ECNT + 64 * (lane & 7), RLX_AGENT);
    int o = 0;
#pragma unroll
    for (int e = 0; e < 8; ++e) { const int c = __builtin_amdgcn_readlane(cv, e); off[e] = o; cum[e] = o >> 8; o += (c + 255) & ~255; }
    npanels = o >> 8;
}
__device__ __forceinline__ void route_phase(Frame& F) {
    const int gw = F.vcu * NWAVES + F.wave, lane = lane_now();
    int off[8], cum[8], np; load_expert_layout(F, off, cum, np);
    const int row = gw * 8 + (lane >> 1), slot = lane & 1; const bool act = lane < 16;
    const int mye = act ? ((const GAS int*)(F.ws + WS_EIDX))[row * 2 + slot] : -1;
    int pos = 0;
#pragma unroll
    for (int e = 0; e < 8; ++e) { const unsigned long long mask = __ballot(mye == e);
        if (mask) { const int leader = __builtin_ctzll(mask), n = __builtin_popcountll(mask); unsigned b = 0u;
            if (lane == leader) b = __hip_atomic_fetch_add(F.ctl + CW_ECUR + 64 * e, (unsigned)n, RLX_AGENT);
            b = (unsigned)shl_i((int)b, leader);
            if (mye == e) pos = off[e] + (int)b + __builtin_popcountll(mask & ((1ull << lane) - 1ull)); } }
    if (act) ((GAS int*)(F.ws + WS_ROWPOS))[row * 2 + slot] = pos;
#pragma clang loop unroll(disable)
    for (int k0 = 0; k0 < 16; k0 += 8) {
        v4u t[8][2];
#pragma unroll
        for (int k = 0; k < 8; ++k) { const int r = gw * 8 + ((k0 + k) >> 1); const GAS v4u* src = (const GAS v4u*)(F.ws + WS_HB8 + (size_t)r * DM) + lane; t[k][0] = src[0]; t[k][1] = src[64]; }
#pragma unroll
        for (int k = 0; k < 8; ++k) { const int p = __builtin_amdgcn_readfirstlane(shl_i(pos, k0 + k)); GAS v4u* dst = (GAS v4u*)(F.ws + WS_HBP + (size_t)p * DM) + lane; dst[0] = t[k][0]; dst[64] = t[k][1]; }
    }
}
__device__ __forceinline__ void ln_moe_phase(Frame& F, const float* g_, const float* b_) {
    const int gw = F.vcu * NWAVES + F.wave, lane = lane_now();
    f32x4 gv[8], bv[8];
#pragma unroll
    for (int j = 0; j < 8; ++j) { gv[j] = ((const GAS f32x4*)g_)[lane + 64 * j]; bv[j] = ((const GAS f32x4*)b_)[lane + 64 * j]; }
    int mp1 = 0, mp2 = 0; float mg1 = 0.f, mg2 = 0.f;
    if (lane < 8) { const int rr = gw * 8 + lane; mp1 = ((const GAS int*)(F.ws + WS_ROWPOS))[rr * 2]; mp2 = ((const GAS int*)(F.ws + WS_ROWPOS))[rr * 2 + 1]; mg1 = ((const GAS float*)(F.ws + WS_GATEW))[rr * 2]; mg2 = ((const GAS float*)(F.ws + WS_GATEW))[rr * 2 + 1]; }
    v2u hraw[8], araw[8], braw[8];
    { const int p1 = __builtin_amdgcn_readlane(mp1, 0), p2 = __builtin_amdgcn_readlane(mp2, 0);
      const GAS v2u* hp = (const GAS v2u*)(F.ws + WS_HB + (size_t)(gw * 8) * DM * 2) + lane;
      const GAS v2u* y1 = (const GAS v2u*)(F.ws + WS_R2 + (size_t)p1 * DM * 2) + lane; const GAS v2u* y2 = (const GAS v2u*)(F.ws + WS_R2 + (size_t)p2 * DM * 2) + lane;
#pragma unroll
      for (int j = 0; j < 8; ++j) { hraw[j] = hp[64 * j]; araw[j] = y1[64 * j]; braw[j] = y2[64 * j]; } }
#pragma clang loop unroll(disable)
    for (int i = 0; i < 8; ++i) { const int row = gw * 8 + i;
        const float g1 = __builtin_bit_cast(float, shl_i(__builtin_bit_cast(int, mg1), i)), g2 = __builtin_bit_cast(float, shl_i(__builtin_bit_cast(int, mg2), i));
        f32x4 v[8]; float s = 0.f;
#pragma unroll
        for (int j = 0; j < 8; ++j) { const v2u a = araw[j], b = braw[j];
            const f32x4 fa = (f32x4){bflo(a.x), bfhi(a.x), bflo(a.y), bfhi(a.y)}, fb = (f32x4){bflo(b.x), bfhi(b.x), bflo(b.y), bfhi(b.y)};
            v[j] = (f32x4){bflo(hraw[j].x), bfhi(hraw[j].x), bflo(hraw[j].y), bfhi(hraw[j].y)} * ALPHA + fa * g1 + fb * g2; s += (v[j][0] + v[j][1]) + (v[j][2] + v[j][3]); }
        { const int in = (i + 1 < 8) ? i + 1 : i; const int p1 = __builtin_amdgcn_readfirstlane(shl_i(mp1, in)), p2 = __builtin_amdgcn_readfirstlane(shl_i(mp2, in));
            const GAS v2u* hp = (const GAS v2u*)(F.ws + WS_HB + (size_t)(gw * 8 + in) * DM * 2) + lane;
            const GAS v2u* y1 = (const GAS v2u*)(F.ws + WS_R2 + (size_t)p1 * DM * 2) + lane; const GAS v2u* y2 = (const GAS v2u*)(F.ws + WS_R2 + (size_t)p2 * DM * 2) + lane;
#pragma unroll
            for (int j = 0; j < 8; ++j) { hraw[j] = hp[64 * j]; araw[j] = y1[64 * j]; braw[j] = y2[64 * j]; } }
        const float mean = wave_sum(s, lane) * (1.f / DM); float s2 = 0.f;
#pragma unroll
        for (int j = 0; j < 8; ++j) { v[j] = v[j] - mean; s2 += (v[j][0] * v[j][0] + v[j][1] * v[j][1]) + (v[j][2] * v[j][2] + v[j][3] * v[j][3]); }
        const float rstd = 1.f / sqrtf(wave_sum(s2, lane) * (1.f / DM) + LN_EPS);
        GAS f32x4* op = (GAS f32x4*)(F.out + (size_t)row * DM) + lane;
#pragma unroll
        for (int j = 0; j < 8; ++j) op[64 * j] = v[j] * rstd * gv[j] + bv[j];
    }
}

struct Args { const float* in[18]; float* out; unsigned char* ws; };
__global__ void __launch_bounds__(NWAVES * 64, 2) hymba_fwd(Args args) {
    extern __shared__ __attribute__((aligned(16))) unsigned char lds[];
    Frame F;
    F.lds = (LAS unsigned char*)lds;
    F.MISC = (volatile LAS unsigned*)(F.lds + MISC_OFF);
    F.wave = __builtin_amdgcn_readfirstlane((int)threadIdx.x >> 6);
    F.G = gridDim.x; { const int bx = blockIdx.x; F.vcu = (F.G % 8 == 0) ? (bx % 8) * (F.G / 8) + bx / 8 : bx; }
    F.ws = args.ws; F.ctl = (gu32*)(args.ws + WS_CTL);
    F.x = args.in[0]; F.w_in = args.in[1]; F.conv_w = args.in[2]; F.conv_b = args.in[3]; F.conv_g = args.in[4]; F.conv_be = args.in[5]; F.w_out = args.in[6];
    F.lnm_g = args.in[7]; F.lnm_b = args.in[8]; F.lnf_g = args.in[9]; F.lnf_b = args.in[10]; F.fg = args.in[11]; F.fu = args.in[12]; F.fd = args.in[13];
    F.router = args.in[14]; F.eg = args.in[15]; F.eu = args.in[16]; F.ed = args.in[17]; F.out = args.out;
    for (int u = threadIdx.x; u < (LDS_BYTES - LDSCTL_OFF) / 4; u += NWAVES * 64) ((LAS unsigned*)(F.lds + LDSCTL_OFF))[u] = 0u;
    __syncthreads();
    XcdBarrier bar = xcd_barrier_post((unsigned*)(F.ctl + CW_BAR), F.MISC + 8, F.wave);
#define LAUNDER() asm volatile("" : "+s"(F.ws), "+s"(F.ctl), "+s"(F.out), "+s"(F.x), "+s"(bar.bar), "+s"(F.wave))
#define GRID_BAR_N(k) do { LAUNDER(); TSTART(200); TSTART(200 + (k)); xcd_barrier(bar); TSTOP(200); TSTOP(200 + (k)); LAUNDER(); } while (0)
#define GRID_BAR() GRID_BAR_N(99)
#ifndef PROBE_ID
#define PROBE_ID 0
#endif
    F.tacc = 0ull; F.tt0 = 0ull;
#define HB ((bf16*)(F.ws + WS_HB))
#define Y ((bf16*)(F.ws + WS_R2))

    TSTART(10); p0_prologue(F); TSTOP(10);
    GRID_BAR_N(1);

#pragma clang loop unroll(disable)
    for (int l = 0; l < 2; ++l) {
#ifndef NO_G_INPROJ
        TSTART(11);
        { pg8::Gemm g{(const bf16*)(F.ws + WS_HB8), (const bf16*)(F.ws + WS_WIN + (size_t)l * 20 * MiB), S, 3072, DM / 2, 0}; pg8::StaticOrder So; So.init(S, 3072, F.G, (int)blockIdx.x);
          pg8::EpiInProj E{(bf16*)(F.ws + WS_Q), (bf16*)(F.ws + WS_K), (bf16*)(F.ws + WS_V), (bf16*)(F.ws + WS_U), (const float*)(F.ws + WS_ROPEC), (const float*)(F.ws + WS_ROPES), 1.0f / (WSC_GU * ASC_H), 0};
          pg8::gemm_phase<pg8::EpiInProj, pg8::StaticOrder, true, true, true>(F.lds + RING_OFF, g, So, E, F.wave); }
        { pg8::Gemm g{HB, (const bf16*)(F.ws + WS_WIN + (size_t)l * 20 * MiB + 8 * MiB), S, 2048, DM, 0}; pg8::StaticOrder So; So.init(S, 2048, F.G, (int)blockIdx.x);
          pg8::EpiInProj E{(bf16*)(F.ws + WS_Q), (bf16*)(F.ws + WS_K), (bf16*)(F.ws + WS_V), (bf16*)(F.ws + WS_U), (const float*)(F.ws + WS_ROPEC), (const float*)(F.ws + WS_ROPES), 1.0f, 12};
          pg8::gemm_phase<pg8::EpiInProj, pg8::StaticOrder, true, true, false>(F.lds + RING_OFF, g, So, E, F.wave); }
        TSTOP(11);
#endif
        GRID_BAR_N(2);
        TSTART(1); kmean_phase(F); TSTOP(1);
        TSTART(2); vt_phase(F); TSTOP(2);
        __syncthreads();
        TSTART(3); conv_phase(F, l); TSTOP(3);
        GRID_BAR_N(3);
        TSTART(4); sel_phase(F, l); TSTOP(4);
        GRID_BAR_N(4);
        TSTART(51); TSTART(5); partial_phase(F, l); TSTOP(5);
        steal_point(F, 5 * 2 + l); GRID_BAR_N(5); TSTOP(51);
        TSTART(52); TSTART(6); own_phase(F); TSTOP(6);
        GRID_BAR_N(6); TSTOP(52);
#ifndef NO_G_OUTPROJ
        TSTART(12);
        { pg8::Gemm g{(const bf16*)(F.ws + WS_CAT), (const bf16*)(F.ws + WS_WOUT + (size_t)l * DM * DM), S, DM, DM / 2, 0}; pg8::StaticOrder So; So.init(S, DM, F.G, (int)blockIdx.x);
          pg8::EpiBf16 E{Y, DM, 1.0f / (WSC_O * ASC_CAT)};
          pg8::gemm_phase<pg8::EpiBf16, pg8::StaticOrder, true, true, true>(F.lds + RING_OFF, g, So, E, F.wave); }
        TSTOP(12);
#endif
        GRID_BAR_N(7);
        TSTART(7); ln_phase(F, nullptr, Y, F.lnm_g + l * DM, F.lnm_b + l * DM, l == 1 ? F.router : nullptr, l == 1); TSTOP(7);
        GRID_BAR_N(8);
        if (l == 0) {
#ifndef NO_G_FFNGU
        TSTART(13); unsigned long long ck1 = (PROBE_ID == 313) ? (unsigned long long)clock64() : 0ull;
            { pg8::Gemm g{HB, (const bf16*)(F.ws + WS_WGU0), S, 2 * DFF, DM, 0}; pg8::StaticOrder So; So.init(S, 2 * DFF, F.G, (int)blockIdx.x);
              pg8::EpiSwiGLU E{(bf16*)(F.ws + WS_ACT), DFF};
              pg8::gemm_phase<pg8::EpiSwiGLU, pg8::StaticOrder, true, true>(F.lds + RING_OFF, g, So, E, F.wave); }
        TSTOP(13); if (PROBE_ID == 313) F.tacc += ((unsigned long long)clock64() - ck1) >> 8;
#endif
            GRID_BAR_N(9);
#ifndef NO_G_FFND
        TSTART(14);
            { pg8::Gemm g{(const bf16*)(F.ws + WS_ACT), (const bf16*)(F.ws + WS_WD0), S, DM, DFF, 0}; pg8::StaticOrder So; So.init(S, DM, F.G, (int)blockIdx.x);
              pg8::EpiBf16 E{Y, DM, 1.0f};
              pg8::gemm_phase<pg8::EpiBf16, pg8::StaticOrder, true, true>(F.lds + RING_OFF, g, So, E, F.wave); }
        TSTOP(14);
#endif
            GRID_BAR_N(10);
            TSTART(7); ln_phase(F, nullptr, Y, F.lnf_g, F.lnf_b, nullptr, true); TSTOP(7);
            GRID_BAR_N(11);
        } else {
            TSTART(17); router_phase(F); TSTOP(17);
            GRID_BAR_N(12);
            TSTART(8); route_phase(F); TSTOP(8);
            steal_drain(F); GRID_BAR_N(13);
            int off[8], cum[8], np; load_expert_layout(F, off, cum, np);
#ifndef NO_G_MOEGU
        TSTART(15); unsigned long long ck0 = (PROBE_ID == 315) ? (unsigned long long)clock64() : 0ull;
            { pg8::Gemm g{(const bf16*)(F.ws + WS_HBP), (const bf16*)(F.ws + WS_WGUE), np * 256, 2 * DFF, DM / 2, (size_t)2 * DFF * DM}; pg8::GroupedOrder So; So.init(np * 256, 2 * DFF, F.G, (int)blockIdx.x);
#pragma unroll
              for (int e = 0; e < 8; ++e) So.cum[e] = cum[e];
              pg8::EpiSwiGLU8 E{F.ws + WS_ACT, DFF, 1.0f / (WSC_GU * ASC_H), ASC_ACT};
              pg8::gemm_phase<pg8::EpiSwiGLU8, pg8::GroupedOrder, true, true, true>(F.lds + RING_OFF, g, So, E, F.wave); }
        TSTOP(15); if (PROBE_ID == 315) F.tacc += ((unsigned long long)clock64() - ck0) >> 8;
#endif
            GRID_BAR_N(14);
#ifndef NO_G_MOED
        TSTART(16);
            { pg8::Gemm g{(const bf16*)(F.ws + WS_ACT), (const bf16*)(F.ws + WS_WDE), np * 256, DM, DFF / 2, (size_t)DM * DFF}; pg8::GroupedOrder So; So.init(np * 256, DM, F.G, (int)blockIdx.x);
#pragma unroll
              for (int e = 0; e < 8; ++e) So.cum[e] = cum[e];
              pg8::EpiBf16 E{(bf16*)(F.ws + WS_R2), DM, 1.0f / (WSC_D * ASC_ACT)};
              pg8::gemm_phase<pg8::EpiBf16, pg8::GroupedOrder, true, true, true>(F.lds + RING_OFF, g, So, E, F.wave); }
        TSTOP(16);
#endif
            GRID_BAR_N(15);
            TSTART(9); ln_moe_phase(F, F.lnf_g + DM, F.lnf_b + DM); TSTOP(9);
        }
    }
    if (PROBE_ID != 0 && blockIdx.x == PROBE_WG && F.wave == 0) { const unsigned long long t1 = __builtin_amdgcn_s_memrealtime(); while (__builtin_amdgcn_s_memrealtime() - t1 < 16ull * F.tacc) __builtin_amdgcn_s_sleep(8); }
#undef GRID_BAR
#undef LAUNDER
#undef HB
#undef Y
}

extern "C" void kernel_launch(void* const* d_in, const int* in_sizes, int n_in, void* d_out, int out_size, void* d_ws, size_t ws_size, hipStream_t stream) {
    static int grid = 0;
    if (grid == 0) {
        if (n_in != 18 || in_sizes[0] != S * DM || out_size != S * DM || ws_size < WS_END) { fprintf(stderr, "kernel_launch: unexpected shapes (n_in %d, in0 %d, out %d, ws %zu < %zu); nothing launched\n", n_in, n_in > 0 ? in_sizes[0] : -1, out_size, ws_size, (size_t)WS_END); grid = -1; return; }
        int dev = 0, cus = 0, per_cu = 0;
        if (hipGetDevice(&dev) != hipSuccess || hipDeviceGetAttribute(&cus, hipDeviceAttributeMultiprocessorCount, dev) != hipSuccess) { grid = -1; return; }
        if (hipFuncSetAttribute((const void*)hymba_fwd, hipFuncAttributeMaxDynamicSharedMemorySize, LDS_BYTES) != hipSuccess) { fprintf(stderr, "kernel_launch: hipFuncSetAttribute failed\n"); grid = -1; return; }
        if (hipOccupancyMaxActiveBlocksPerMultiprocessor(&per_cu, (const void*)hymba_fwd, NWAVES * 64, LDS_BYTES) != hipSuccess || per_cu < 1)
            fprintf(stderr, "kernel_launch: note: occupancy query reports %d workgroups per CU\n", per_cu);
        (void)hipGetLastError();
        grid = cus;
        if (grid != 256) { fprintf(stderr, "kernel_launch: built for 256 CUs, device has %d; nothing launched\n", cus); grid = -1; return; }
    }
    if (grid < 0) return;
    if (hipMemsetAsync((char*)d_ws + WS_CTL, 0, CTL_ZERO_BYTES, stream) != hipSuccess) return;
    Args a{};
    for (int i = 0; i < 18; ++i) a.in[i] = (const float*)d_in[i];
    a.out = (float*)d_out; a.ws = (unsigned char*)d_ws;
    hipLaunchKernelGGL(hymba_fwd, dim3(grid), dim3(NWAVES * 64), LDS_BYTES, stream, a);
}
```

```cpp
#include <hip/hip_runtime.h>
#include <cstdio>
#include <cstdint>
#include <cmath>
namespace pg8 {
#define PG8_LAS __attribute__((address_space(3)))
typedef unsigned short bf16_t;
typedef short bf16x8 __attribute__((ext_vector_type(8)));
typedef float f32x4 __attribute__((ext_vector_type(4)));
typedef unsigned u32x4 __attribute__((ext_vector_type(4)));
typedef unsigned u32x2 __attribute__((ext_vector_type(2)));
typedef int v8i __attribute__((ext_vector_type(8)));
typedef int v4i __attribute__((ext_vector_type(4)));
constexpr int BM = 256, BK = 64, HALF = 128, HTB = HALF * BK * 2  , STAGE_BYTES = 8 * HTB, NXCD = 8, WGM = 8;

__host__ __device__ __forceinline__ int lds_byte(int r, int c) { const int st = (r >> 4) * 2 + (c >> 5), rr = r & 15, cc = c & 31, ob = rr * 64 + cc * 2; return st * 1024 + (ob ^ (((ob >> 9) & 1) << 5)); }
__host__ __device__ __forceinline__ void stage_rc(int b, int& R, int& C) { const int st = b / 1024, sb = b % 1024, swz = sb ^ (((sb >> 9) & 1) << 5); R = (st >> 1) * 16 + swz / 64; C = (st & 1) * 32 + (swz % 64) / 2; }
__host__ __device__ __forceinline__ int perm32(int rho) { const int n = rho >> 4, i = rho & 15; return 8 * (i >> 2) + 4 * n + (i & 3); }

struct Unit { int pm, pn, e; };
struct Gemm { const bf16_t* A; const bf16_t* Bt; int M, N, K; size_t bstride; };

struct StaticOrder {
    int nM, nN, nwg, G, c;
    __host__ __device__ void init(int M, int N, int G_, int c_) { nM = M / BM; nN = N / BM; nwg = nM * nN; G = G_; c = c_; }
    __host__ __device__ bool next(int i, Unit& u) const {
        const long L = (long)i * G + c; if (L >= nwg) return false;
        int wgid = (int)L; { const int q = nwg / NXCD, r = nwg % NXCD, xcd = wgid % NXCD, off = wgid / NXCD; wgid = (xcd < r ? xcd * (q + 1) : r * (q + 1) + (xcd - r) * q) + off; }
        const int nig = WGM * nN, gid = wgid / nig, fm = gid * WGM, gsz = (nM - fm) < WGM ? (nM - fm) : WGM;
        u.pm = fm + ((wgid % nig) % gsz); u.pn = (wgid % nig) / gsz; u.e = 0; return true;
    }
    __device__ __forceinline__ void a_ready(const Unit&) const {}
    __device__ __forceinline__ void done(const Unit&) const {}
};
struct GroupedOrder : StaticOrder {
    int cum[8];
    __device__ bool next(int i, Unit& u) const {
        if (!StaticOrder::next(i, u)) return false;
        int e = 0;
#pragma unroll
        for (int j = 1; j < 8; ++j) e += (u.pm >= cum[j]) ? 1 : 0;
        u.e = e; return true;
    }
};

__device__ __forceinline__ unsigned cvt_pk_bf16(float lo, float hi) { unsigned r; asm volatile("v_cvt_pk_bf16_f32 %0, %1, %2" : "=v"(r) : "v"(lo), "v"(hi)); return r; }
__device__ __forceinline__ float sigmoidf_fast(float g) { return __builtin_amdgcn_rcpf(1.0f + __builtin_amdgcn_exp2f(-1.44269504089f * g)); }

__device__ __forceinline__ unsigned pk4_fp8(float a, float b, float c, float d) {
    unsigned w = 0u; w = __builtin_amdgcn_cvt_pk_fp8_f32(__builtin_amdgcn_fmed3f(a, -448.f, 448.f), __builtin_amdgcn_fmed3f(b, -448.f, 448.f), w, false);
    return __builtin_amdgcn_cvt_pk_fp8_f32(__builtin_amdgcn_fmed3f(c, -448.f, 448.f), __builtin_amdgcn_fmed3f(d, -448.f, 448.f), w, true); }
__device__ __forceinline__ unsigned pk4_i8(float a, float b, float c, float d) {
    const int ia = (int)__builtin_rintf(__builtin_amdgcn_fmed3f(a, -127.f, 127.f)), ib = (int)__builtin_rintf(__builtin_amdgcn_fmed3f(b, -127.f, 127.f));
    const int ic = (int)__builtin_rintf(__builtin_amdgcn_fmed3f(c, -127.f, 127.f)), id = (int)__builtin_rintf(__builtin_amdgcn_fmed3f(d, -127.f, 127.f));
    return (unsigned)(ia & 255) | ((unsigned)(ib & 255) << 8) | ((unsigned)(ic & 255) << 16) | ((unsigned)id << 24); }
struct EpiF32 {
    static constexpr bool PERM = false, AFTER_DRAIN = false;
    float* C; int ldc;
    __device__ __forceinline__ void operator()(const f32x4 (&acc)[2][2][4][2], const Unit& u, int wr, int wc, int fr, int fq) const {
        const int row0 = u.pm * BM + wr * 64 + fr, col0 = u.pn * BM + wc * 32 + 4 * fq;
#pragma unroll
        for (int ai = 0; ai < 2; ++ai)
#pragma unroll
            for (int m = 0; m < 4; ++m) { float* rowp = C + (size_t)(row0 + ai * HALF + m * 16) * ldc + col0;
#pragma unroll
                for (int bj = 0; bj < 2; ++bj)
#pragma unroll
                    for (int n = 0; n < 2; ++n) *(f32x4*)(rowp + bj * HALF + n * 16) = acc[ai][bj][m][n]; }
    }
};
struct EpiBf16 {
    static constexpr bool PERM = true, AFTER_DRAIN = false;
    bf16_t* O; int ldc; float sc;
    __device__ __forceinline__ void operator()(const f32x4 (&acc)[2][2][4][2], const Unit& u, int wr, int wc, int fr, int fq) const {
        const int row0 = u.pm * BM + wr * 64 + fr, col0 = u.pn * BM + wc * 32 + 8 * fq;
#pragma unroll
        for (int ai = 0; ai < 2; ++ai)
#pragma unroll
            for (int m = 0; m < 4; ++m) { bf16_t* rowp = O + (size_t)(row0 + ai * HALF + m * 16) * ldc + col0;
#pragma unroll
                for (int bj = 0; bj < 2; ++bj) { const f32x4 v0 = acc[ai][bj][m][0] * sc, v1 = acc[ai][bj][m][1] * sc;
                    u32x4 w; w.x = cvt_pk_bf16(v0[0], v0[1]); w.y = cvt_pk_bf16(v0[2], v0[3]); w.z = cvt_pk_bf16(v1[0], v1[1]); w.w = cvt_pk_bf16(v1[2], v1[3]);
                    *(u32x4*)(rowp + bj * HALF) = w; } }
    }
};
struct EpiSwiGLU {
    static constexpr bool PERM = true, AFTER_DRAIN = false;
    bf16_t* O; int ldc;
    __device__ __forceinline__ void operator()(const f32x4 (&acc)[2][2][4][2], const Unit& u, int wr, int wc, int fr, int fq) const {
        const int row0 = u.pm * BM + wr * 64 + fr, col0 = u.pn * HALF + wc * 32 + 8 * fq;
#pragma unroll
        for (int ai = 0; ai < 2; ++ai)
#pragma unroll
            for (int m = 0; m < 4; ++m) { bf16_t* rowp = O + (size_t)(row0 + ai * HALF + m * 16) * ldc + col0;
                float o[8];
#pragma unroll
                for (int n = 0; n < 2; ++n)
#pragma unroll
                    for (int j = 0; j < 4; ++j) { const float g = acc[ai][0][m][n][j], up = acc[ai][1][m][n][j]; o[n * 4 + j] = g * sigmoidf_fast(g) * up; }
                u32x4 w; w.x = cvt_pk_bf16(o[0], o[1]); w.y = cvt_pk_bf16(o[2], o[3]); w.z = cvt_pk_bf16(o[4], o[5]); w.w = cvt_pk_bf16(o[6], o[7]);
                *(u32x4*)rowp = w; }
    }
};
struct EpiSwiGLUq {
    static constexpr bool PERM = true, AFTER_DRAIN = false;
    bf16_t* O; int ldc; const float* rs; float ws;
    __device__ __forceinline__ void operator()(const f32x4 (&acc)[2][2][4][2], const Unit& u, int wr, int wc, int fr, int fq) const {
        const int row0 = u.pm * BM + wr * 64 + fr, col0 = u.pn * HALF + wc * 32 + 8 * fq;
#pragma unroll
        for (int ai = 0; ai < 2; ++ai)
#pragma unroll
            for (int m = 0; m < 4; ++m) { const int row = row0 + ai * HALF + m * 16; bf16_t* rowp = O + (size_t)row * ldc + col0; const float sc = rs[row] * ws;
                float o[8];
#pragma unroll
                for (int n = 0; n < 2; ++n)
#pragma unroll
                    for (int j = 0; j < 4; ++j) { const float g = acc[ai][0][m][n][j] * sc, up = acc[ai][1][m][n][j] * sc; o[n * 4 + j] = g * sigmoidf_fast(g) * up; }
                u32x4 w; w.x = cvt_pk_bf16(o[0], o[1]); w.y = cvt_pk_bf16(o[2], o[3]); w.z = cvt_pk_bf16(o[4], o[5]); w.w = cvt_pk_bf16(o[6], o[7]);
                *(u32x4*)rowp = w; }
    }
};
struct EpiSwiGLU8 {
    static constexpr bool PERM = true, AFTER_DRAIN = false;
    unsigned char* O; int ldc; float sin, sout;
    __device__ __forceinline__ void operator()(const f32x4 (&acc)[2][2][4][2], const Unit& u, int wr, int wc, int fr, int fq) const {
        const int row0 = u.pm * BM + wr * 64 + fr, col0 = u.pn * HALF + wc * 32 + 8 * fq;
#pragma unroll
        for (int ai = 0; ai < 2; ++ai)
#pragma unroll
            for (int m = 0; m < 4; ++m) { unsigned char* rowp = O + (size_t)(row0 + ai * HALF + m * 16) * ldc + col0;
                float o[8];
#pragma unroll
                for (int n = 0; n < 2; ++n)
#pragma unroll
                    for (int j = 0; j < 4; ++j) { const float g = acc[ai][0][m][n][j] * sin, up = acc[ai][1][m][n][j] * sin; o[n * 4 + j] = g * sigmoidf_fast(g) * up * sout; }
                u32x2 w; w.x = pk4_fp8(o[0], o[1], o[2], o[3]); w.y = pk4_fp8(o[4], o[5], o[6], o[7]);
                *(u32x2*)rowp = w; }
    }
};
struct EpiInProj {
    static constexpr bool PERM = true, AFTER_DRAIN = false;
    bf16_t *Q, *Kb, *V, *U; const float *ropeC, *ropeS; float sc; int pn_off;
    __device__ __forceinline__ void operator()(const f32x4 (&acc)[2][2][4][2], const Unit& u, int wr, int wc, int fr, int fq) const {
        const int row0 = u.pm * BM + wr * 64 + fr, pn = u.pn + pn_off;
        if (pn < 8) {
            bf16_t* base = (pn < 4) ? Q : Kb; const int col0 = (pn & 3) * BM + wc * 32 + 8 * fq, idx0 = 16 * wc + 4 * fq;
#pragma unroll
            for (int ai = 0; ai < 2; ++ai)
#pragma unroll
                for (int m = 0; m < 4; ++m) { const int row = row0 + ai * HALF + m * 16;
                    const f32x4 cs = *(const f32x4*)(ropeC + (size_t)row * 64 + idx0), sn = *(const f32x4*)(ropeS + (size_t)row * 64 + idx0);
#pragma unroll
                    for (int bj = 0; bj < 2; ++bj) { const f32x4 x1 = acc[ai][bj][m][0] * sc, x2 = acc[ai][bj][m][1] * sc;
                        const f32x4 o1 = x1 * cs - x2 * sn, o2 = x2 * cs + x1 * sn;
                        u32x4 w; w.x = cvt_pk_bf16(o1[0], o1[1]); w.y = cvt_pk_bf16(o1[2], o1[3]); w.z = cvt_pk_bf16(o2[0], o2[1]); w.w = cvt_pk_bf16(o2[2], o2[3]);
                        *(u32x4*)(base + (size_t)row * 1024 + col0 + bj * HALF) = w; } }
        } else if (pn < 12) {
            const int col0 = (pn - 8) * BM + wc * 32 + 8 * fq;
#pragma unroll
            for (int ai = 0; ai < 2; ++ai)
#pragma unroll
                for (int m = 0; m < 4; ++m) { bf16_t* rowp = V + (size_t)(row0 + ai * HALF + m * 16) * 1024 + col0;
#pragma unroll
                    for (int bj = 0; bj < 2; ++bj) { const f32x4 v0 = acc[ai][bj][m][0] * sc, v1 = acc[ai][bj][m][1] * sc;
                        u32x4 w; w.x = cvt_pk_bf16(v0[0], v0[1]); w.y = cvt_pk_bf16(v0[2], v0[3]); w.z = cvt_pk_bf16(v1[0], v1[1]); w.w = cvt_pk_bf16(v1[2], v1[3]);
                        *(u32x4*)(rowp + bj * HALF) = w; } }
        } else {
            const int col0 = (pn - 12) * HALF + wc * 32 + 8 * fq;
#pragma unroll
            for (int ai = 0; ai < 2; ++ai)
#pragma unroll
                for (int m = 0; m < 4; ++m) { bf16_t* rowp = U + (size_t)(row0 + ai * HALF + m * 16) * 1024 + col0;
                    float o[8];
#pragma unroll
                    for (int n = 0; n < 2; ++n)
#pragma unroll
                        for (int j = 0; j < 4; ++j) o[n * 4 + j] = acc[ai][0][m][n][j] * sc * sigmoidf_fast(acc[ai][1][m][n][j] * sc);
                    u32x4 w; w.x = cvt_pk_bf16(o[0], o[1]); w.y = cvt_pk_bf16(o[2], o[3]); w.z = cvt_pk_bf16(o[4], o[5]); w.w = cvt_pk_bf16(o[6], o[7]);
                    *(u32x4*)rowp = w; }
        }
    }
};

template <class Epi, class Sched, bool ALIGN_EPI = false, bool SP2 = false, bool FP8 = false, bool I8 = false>
__device__ __forceinline__ void gemm_phase(PG8_LAS unsigned char* lds, const Gemm g, const Sched& S, const Epi& E, const int wave_in) {
    int lane; asm volatile("v_mbcnt_lo_u32_b32 %0, -1, 0\n\tv_mbcnt_hi_u32_b32 %0, -1, %0" : "=v"(lane));
    const int wid = wave_in, tid = wid * 64 + lane, wr = wid >> 2, wc = wid & 3, fr = lane & 15, fq = lane >> 4;
    const int K = g.K, nt = K / BK;
    unsigned voffA[2], voffB[2];
#pragma unroll
    for (int i = 0; i < 2; ++i) { int R, C; stage_rc(tid * 16 + i * 8192, R, C); const int Rb = Epi::PERM ? ((R & ~31) + perm32(R & 31)) : R;
        voffA[i] = (unsigned)(R * K + C) * 2u; voffB[i] = (unsigned)(Rb * K + C) * 2u; }
    const size_t kstep = (size_t)(BK * 2);
    const size_t hstep = (size_t)HALF * K * 2;
    const size_t tstep = 2 * hstep;
    const unsigned ldsw = (unsigned)wid * 1024u;
    const int aoff = lds_byte(wr * 64 + fr, fq * 8), boff = lds_byte(wc * 32 + fr, fq * 8);
#define PG8_SA(b, h) (((b) * 2 + (h)) * HTB)
#define PG8_SB(b, h) ((4 + (b) * 2 + (h)) * HTB)
#define PG8_STAGE(bufoff, gbase, voff) do { _Pragma("unroll") for (int _i = 0; _i < 2; ++_i) \
        __builtin_amdgcn_global_load_lds((const unsigned*)((const char*)(gbase) + (voff)[_i]), (PG8_LAS unsigned*)(lds + (bufoff) + ldsw + _i * 8192), 16, 0, 0); } while (0)
#define PG8_LDA(dst, b, h) do { if constexpr (FP8) { _Pragma("unroll") for (int m = 0; m < 4; ++m) { const v4i lo_ = *(const PG8_LAS v4i*)(lds + PG8_SA(b, h) + aoff + m * 2048), hi_ = *(const PG8_LAS v4i*)(lds + PG8_SA(b, h) + aoff + m * 2048 + 1024); \
            dst##8[m] = __builtin_shufflevector(lo_, hi_, 0, 1, 2, 3, 4, 5, 6, 7); } } \
        else { _Pragma("unroll") for (int m = 0; m < 4; ++m) _Pragma("unroll") for (int k = 0; k < 2; ++k) dst[m][k] = *(const PG8_LAS bf16x8*)(lds + PG8_SA(b, h) + aoff + m * 2048 + k * 1024); } } while (0)
#define PG8_LDB(dst, b, h) do { if constexpr (FP8) { _Pragma("unroll") for (int n = 0; n < 2; ++n) { const v4i lo_ = *(const PG8_LAS v4i*)(lds + PG8_SB(b, h) + boff + n * 2048), hi_ = *(const PG8_LAS v4i*)(lds + PG8_SB(b, h) + boff + n * 2048 + 1024); \
            dst##8[n] = __builtin_shufflevector(lo_, hi_, 0, 1, 2, 3, 4, 5, 6, 7); } } \
        else { _Pragma("unroll") for (int n = 0; n < 2; ++n) _Pragma("unroll") for (int k = 0; k < 2; ++k) dst[n][k] = *(const PG8_LAS bf16x8*)(lds + PG8_SB(b, h) + boff + n * 2048 + k * 1024); } } while (0)
#define PG8_MMA(ai, bj, At, Bt) do { __builtin_amdgcn_s_setprio(1); \
        if constexpr (FP8) {   \
            _Pragma("unroll") for (int m = 0; m < 4; ++m) _Pragma("unroll") for (int n = 0; n < 2; ++n) \
                asm volatile("v_mfma_f32_16x16x128_f8f6f4 %0, %1, %2, %0" : "+v"(acc[ai][bj][m][n]) : "v"(Bt##8[n]), "v"(At##8[m]));   \
        } else if constexpr (I8) {   \
            _Pragma("unroll") for (int m = 0; m < 4; ++m) _Pragma("unroll") for (int n = 0; n < 2; ++n) _Pragma("unroll") for (int k = 0; k < 2; ++k) \
                asm volatile("v_mfma_i32_16x16x64_i8 %0, %1, %2, %0" : "+v"(acc[ai][bj][m][n]) : "v"(Bt[n][k]), "v"(At[m][k])); \
        } else { _Pragma("unroll") for (int m = 0; m < 4; ++m) _Pragma("unroll") for (int n = 0; n < 2; ++n) _Pragma("unroll") for (int k = 0; k < 2; ++k) \
            acc[ai][bj][m][n] = __builtin_amdgcn_mfma_f32_16x16x32_bf16(Bt[n][k], At[m][k], acc[ai][bj][m][n], 0, 0, 0); } \
        __builtin_amdgcn_s_setprio(0); } while (0)
#define PG8_WAIT_V(n) asm volatile("s_waitcnt vmcnt(" #n ")" ::: "memory")
#define PG8_WAIT_L(n) asm volatile("s_waitcnt lgkmcnt(" #n ")" ::: "memory")
#define PG8_BAR __builtin_amdgcn_s_barrier()
#define PG8_SCHED __builtin_amdgcn_sched_barrier(0)
    Unit cur, nxt; int ui = 0;
    if (!S.next(0, cur)) return;
    f32x4 acc[2][2][4][2];
#pragma unroll
    for (int a = 0; a < 2; ++a)
#pragma unroll
        for (int b = 0; b < 2; ++b)
#pragma unroll
            for (int m = 0; m < 4; ++m)
#pragma unroll
                for (int n = 0; n < 2; ++n) acc[a][b][m][n] = (f32x4){0.f, 0.f, 0.f, 0.f};
    bf16x8 At[4][2], B0[2][2], B1[2][2]; v8i At8[4], B08[2], B18[2];
    const char* cA = (const char*)g.A + (size_t)cur.pm * tstep; const char* cB = (const char*)g.Bt + (size_t)cur.e * g.bstride + (size_t)cur.pn * tstep;
    S.a_ready(cur);
    if constexpr (SP2) {
        PG8_STAGE(PG8_SB(0, 0), cB, voffB); PG8_STAGE(PG8_SB(0, 1), cB + hstep, voffB); PG8_STAGE(PG8_SA(0, 0), cA, voffA); PG8_STAGE(PG8_SA(0, 1), cA + hstep, voffA);
        if (wr == 1) PG8_BAR;
        PG8_WAIT_V(2); PG8_BAR;
        PG8_STAGE(PG8_SB(1, 0), cB + kstep, voffB); PG8_STAGE(PG8_SA(1, 0), cA + kstep, voffA); PG8_STAGE(PG8_SB(1, 1), cB + hstep + kstep, voffB);
        PG8_WAIT_V(6); PG8_BAR;
    } else {
        PG8_STAGE(PG8_SB(0, 0), cB, voffB); PG8_STAGE(PG8_SA(0, 0), cA, voffA); PG8_STAGE(PG8_SB(0, 1), cB + hstep, voffB); PG8_STAGE(PG8_SA(0, 1), cA + hstep, voffA);
        if (wr == 1) PG8_BAR;
        PG8_WAIT_V(4); PG8_BAR;
        PG8_STAGE(PG8_SB(1, 0), cB + kstep, voffB); PG8_STAGE(PG8_SA(1, 0), cA + kstep, voffA); PG8_STAGE(PG8_SB(1, 1), cB + hstep + kstep, voffB);
        PG8_WAIT_V(6); PG8_BAR;
    }
    for (;;) {
        const bool has_next = S.next(ui + 1, nxt);
        const char* nA = has_next ? (const char*)g.A + (size_t)nxt.pm * tstep : cA; const char* nB = has_next ? (const char*)g.Bt + (size_t)nxt.e * g.bstride + (size_t)nxt.pn * tstep : cB;
        for (int t = 0; t < nt; t += 2) {
            const bool last = (t == nt - 2);
            const char* a1 = cA + (size_t)(t + 1) * kstep;
            const char* a2 = last ? nA : cA + (size_t)(t + 2) * kstep; const char* b2 = last ? nB : cB + (size_t)(t + 2) * kstep;
            const char* a3 = a2 + kstep; const char* b3 = b2 + kstep;
            if (last && has_next) S.a_ready(nxt);
            if constexpr (SP2) {
            PG8_LDB(B0, 0, 0); PG8_LDB(B1, 0, 1); PG8_SCHED; PG8_LDA(At, 0, 0); PG8_STAGE(PG8_SA(1, 1), a1 + hstep, voffA);
            PG8_WAIT_V(8); PG8_WAIT_L(0); PG8_BAR; PG8_MMA(0, 0, At, B0); PG8_MMA(0, 1, At, B1); PG8_BAR; PG8_SCHED;
            PG8_LDA(At, 0, 1); PG8_STAGE(PG8_SB(0, 0), b2, voffB); PG8_STAGE(PG8_SB(0, 1), b2 + hstep, voffB); PG8_STAGE(PG8_SA(0, 0), a2, voffA);
            PG8_WAIT_V(8); PG8_WAIT_L(0); PG8_BAR; PG8_MMA(1, 0, At, B0); PG8_MMA(1, 1, At, B1); PG8_BAR; PG8_SCHED;
            PG8_LDB(B0, 1, 0); PG8_LDB(B1, 1, 1); PG8_SCHED; PG8_LDA(At, 1, 0); PG8_STAGE(PG8_SA(0, 1), a2 + hstep, voffA);
            PG8_WAIT_V(8); PG8_WAIT_L(0); PG8_BAR; PG8_MMA(0, 0, At, B0); PG8_MMA(0, 1, At, B1); PG8_BAR; PG8_SCHED;
            PG8_LDA(At, 1, 1); PG8_STAGE(PG8_SB(1, 0), b3, voffB); PG8_STAGE(PG8_SB(1, 1), b3 + hstep, voffB); PG8_STAGE(PG8_SA(1, 0), a3, voffA);
            PG8_WAIT_V(8); PG8_WAIT_L(0); PG8_BAR; PG8_MMA(1, 0, At, B0); PG8_MMA(1, 1, At, B1); PG8_BAR; PG8_SCHED;
            } else {
            PG8_LDB(B0, 0, 0); PG8_SCHED; PG8_LDA(At, 0, 0); PG8_STAGE(PG8_SA(1, 1), a1 + hstep, voffA);
            PG8_WAIT_L(8); PG8_BAR; PG8_WAIT_L(0); PG8_MMA(0, 0, At, B0); PG8_BAR; PG8_SCHED;
            PG8_LDB(B1, 0, 1); PG8_STAGE(PG8_SB(0, 0), b2, voffB);
            PG8_BAR; PG8_WAIT_L(0); PG8_MMA(0, 1, At, B1); PG8_BAR;
            PG8_LDA(At, 0, 1); PG8_STAGE(PG8_SA(0, 0), a2, voffA);
            PG8_BAR; PG8_WAIT_L(0); PG8_MMA(1, 0, At, B0); PG8_BAR; PG8_SCHED;
            PG8_STAGE(PG8_SB(0, 1), b2 + hstep, voffB);
            PG8_WAIT_V(6); PG8_BAR; PG8_MMA(1, 1, At, B1); PG8_BAR;
            PG8_LDB(B0, 1, 0); PG8_SCHED; PG8_LDA(At, 1, 0); PG8_STAGE(PG8_SA(0, 1), a2 + hstep, voffA);
            PG8_WAIT_L(8); PG8_BAR; PG8_WAIT_L(0); PG8_MMA(0, 0, At, B0); PG8_BAR; PG8_SCHED;
            PG8_LDB(B1, 1, 1); PG8_STAGE(PG8_SB(1, 0), b3, voffB);
            PG8_BAR; PG8_WAIT_L(0); PG8_MMA(0, 1, At, B1); PG8_BAR;
            PG8_LDA(At, 1, 1); PG8_STAGE(PG8_SA(1, 0), a3, voffA);
            PG8_BAR; PG8_WAIT_L(0); PG8_MMA(1, 0, At, B0); PG8_BAR; PG8_SCHED;
            PG8_STAGE(PG8_SB(1, 1), b3 + hstep, voffB);
            PG8_WAIT_V(6); PG8_BAR; PG8_MMA(1, 1, At, B1); PG8_BAR;
            }
        }
        if constexpr (FP8) asm volatile("s_nop 15\n\ts_nop 15" ::: "memory");
        if constexpr (I8) { asm volatile("s_nop 15\n\ts_nop 15" ::: "memory");
#pragma unroll
            for (int a = 0; a < 2; ++a)
#pragma unroll
                for (int b = 0; b < 2; ++b)
#pragma unroll
                    for (int m = 0; m < 4; ++m)
#pragma unroll
                        for (int n = 0; n < 2; ++n)
                            asm volatile("v_cvt_f32_i32_e32 %0, %0\n\tv_cvt_f32_i32_e32 %1, %1\n\tv_cvt_f32_i32_e32 %2, %2\n\tv_cvt_f32_i32_e32 %3, %3" : "+v"(acc[a][b][m][n][0]), "+v"(acc[a][b][m][n][1]), "+v"(acc[a][b][m][n][2]), "+v"(acc[a][b][m][n][3])); }
        if constexpr (ALIGN_EPI) { if (wr == 0) PG8_BAR; }
        if constexpr (!Epi::AFTER_DRAIN) { E(acc, cur, wr, wc, fr, fq); S.done(cur); }
        if (!has_next) break;
#pragma unroll
        for (int a = 0; a < 2; ++a)
#pragma unroll
            for (int b = 0; b < 2; ++b)
#pragma unroll
                for (int m = 0; m < 4; ++m)
#pragma unroll
                    for (int n = 0; n < 2; ++n) acc[a][b][m][n] = (f32x4){0.f, 0.f, 0.f, 0.f};
        cur = nxt; cA = nA; cB = nB; ++ui;
        if constexpr (ALIGN_EPI) { if (wr == 1) PG8_BAR; }
    }
    PG8_WAIT_V(0);
    if constexpr (!ALIGN_EPI) { if (wr == 0) PG8_BAR; }
    PG8_BAR;
    if constexpr (Epi::AFTER_DRAIN) { E.fused(acc, cur, wr, wc, fr, fq, lds, wid, lane); S.done(cur); }
#undef PG8_SA
#undef PG8_SB
#undef PG8_STAGE
#undef PG8_LDA
#undef PG8_LDB
#undef PG8_MMA
#undef PG8_WAIT_V
#undef PG8_WAIT_L
#undef PG8_BAR
#undef PG8_SCHED
}
}

constexpr int NWAVES = 8;
constexpr int S = 16384, DM = 2048, NPROJ = 5120, AW = 1024, HD = 128, NH = 8, DFF = 5632, NE = 8, CKW = 31, NBLK = 64;
constexpr float LN_EPS = 1e-5f, ALPHA = 1.41421356237309515f;
constexpr int MOE_ROWS = 2 * S + NE * 256;
constexpr float WSC_GU = 32.f, WSC_D = 128.f, ASC_H = 4.f, ASC_ACT = 8.f, WSC_O = 64.f, ASC_CAT = 16.f;
constexpr float WQ_GU = 1024.f;

constexpr size_t MiB = 1u << 20;
constexpr size_t WS_CTL = 0, CTL_ZERO_BYTES = 1 * MiB;
constexpr size_t WS_ROPEC = 1 * MiB, WS_ROPES = 5 * MiB;
constexpr size_t WS_KMEAN = 9 * MiB;
constexpr size_t WS_RWT = 9 * MiB + 256 * 1024;
constexpr size_t WS_RSC = 9 * MiB + 896 * 1024;
constexpr size_t WS_EIDX = 9 * MiB + 512 * 1024, WS_GATEW = WS_EIDX + 128 * 1024, WS_ROWPOS = WS_GATEW + 128 * 1024;
constexpr size_t WS_WIN = 10 * MiB, WS_WOUT = 50 * MiB, WS_WGU0 = 66 * MiB, WS_WD0 = 110 * MiB, WS_WGUE = 132 * MiB, WS_WDE = 484 * MiB;
constexpr size_t WS_HB = 660 * MiB;
constexpr size_t WS_R2 = 724 * MiB;
constexpr size_t WS_HB8 = 860 * MiB + 72 * MiB;
constexpr size_t WS_HBP = 860 * MiB;
constexpr size_t WS_R1 = 996 * MiB;
constexpr size_t WS_Q = WS_R1, WS_K = WS_R1 + 32 * MiB, WS_V = WS_R1 + 64 * MiB, WS_U = WS_R1 + 96 * MiB, WS_CAT = WS_R1 + 128 * MiB, WS_ACT = WS_R1;
constexpr size_t WS_VT = WS_R1 + 192 * MiB, WS_PO = WS_R1 + 224 * MiB, WS_PML = WS_R1 + 320 * MiB, WS_LIST = WS_R1 + 324 * MiB;
constexpr size_t WS_END = 1370 * MiB;
static_assert(WS_R1 + (size_t)MOE_ROWS * DFF * 2 <= WS_END && WS_HBP + (size_t)MOE_ROWS * DM * 2 <= WS_R1 && WS_R2 + (size_t)MOE_ROWS * DM * 2 <= WS_HBP, "d_ws map");
static_assert(WS_WDE + (size_t)NE * DM * DFF * 2 <= WS_HB && WS_WGUE + (size_t)NE * 2 * DFF * DM * 2 <= WS_WDE, "d_ws weights map");
constexpr int CW_TMO = 0, CW_CODE = 1, CW_BAR = 4096, CW_ECNT = 8192, CW_ECUR = 8192 + 64 * 8, CW_LCNT = 12288, CW_QUEUE = 14336, CW_STEALQ = 14464, CW_ARRIVE = 16384;
constexpr int RING_OFF = 0, RING_BYTES = 131072;
constexpr int LDSCTL_OFF = 143360, MISC_OFF = LDSCTL_OFF + 320;
constexpr int LDS_BYTES = 147456;

__device__ const float INV_FREQ[64] = {
1.000000000e+00f, 8.659643531e-01f, 7.498942018e-01f, 6.493816376e-01f, 5.623413324e-01f, 4.869675338e-01f, 4.216965139e-01f, 3.651741147e-01f, 3.162277639e-01f, 2.738419771e-01f, 2.371373773e-01f, 2.053525001e-01f, 1.778279394e-01f, 1.539926529e-01f, 1.333521456e-01f, 1.154781953e-01f, 1.000000015e-01f, 8.659642935e-02f, 7.498942316e-02f, 6.493816525e-02f, 5.623413250e-02f, 4.869675264e-02f, 4.216964915e-02f, 3.651741147e-02f, 3.162277490e-02f, 2.738419548e-02f, 2.371373773e-02f, 2.053525113e-02f, 1.778279431e-02f, 1.539926510e-02f, 1.333521400e-02f, 1.154781971e-02f, 9.999999776e-03f, 8.659643121e-03f, 7.498942316e-03f, 6.493816152e-03f, 5.623413250e-03f, 4.869675264e-03f, 4.216964822e-03f, 3.651741194e-03f, 3.162277630e-03f, 2.738419687e-03f, 2.371373819e-03f, 2.053525066e-03f, 1.778279431e-03f, 1.539926510e-03f, 1.333521446e-03f, 1.154782018e-03f, 1.000000047e-03f, 8.659643354e-04f, 7.498941850e-04f, 6.493816036e-04f, 5.623413017e-04f, 4.869675322e-04f, 4.216965172e-04f, 3.651741135e-04f, 3.162277571e-04f, 2.738419571e-04f, 2.371373703e-04f, 2.053525095e-04f, 1.778279402e-04f, 1.539926598e-04f, 1.333521504e-04f, 1.154782003e-04f
};

#define GAS __attribute__((address_space(1)))
#define LAS __attribute__((address_space(3)))
typedef unsigned short bf16;
typedef unsigned v4u __attribute__((ext_vector_type(4)));
typedef unsigned v2u __attribute__((ext_vector_type(2)));
typedef float f32x4 __attribute__((ext_vector_type(4)));
typedef float f32x2 __attribute__((ext_vector_type(2)));
typedef short bf16x8 __attribute__((ext_vector_type(8)));
typedef GAS unsigned gu32;
typedef GAS unsigned long long gu64;
#define RLX_AGENT __ATOMIC_RELAXED, __HIP_MEMORY_SCOPE_AGENT
#define LDS_WAIT() asm volatile("s_waitcnt lgkmcnt(0)" ::: "memory")
#define VM_WAIT() asm volatile("s_waitcnt vmcnt(0)" ::: "memory")
__device__ __forceinline__ unsigned f2bf(float f) { unsigned u = __builtin_bit_cast(unsigned, f); return (u + 0x7fffu + ((u >> 16) & 1u)) >> 16; }
__device__ __forceinline__ unsigned pk2(float lo, float hi) { return f2bf(lo) | (f2bf(hi) << 16); }
__device__ __forceinline__ float bflo(unsigned w) { return __builtin_bit_cast(float, w << 16); }
__device__ __forceinline__ float bfhi(unsigned w) { return __builtin_bit_cast(float, w & 0xffff0000u); }

#define XB_TMO      128
#define XB_XCNT(j)  (256  + 64 * (j))
#define XB_XSUB(j)  (1280 + 64 * (j))
#define XB_XGEN(j)  (2304 + 64 * (j))
#define XB_TOP      3328
#define XB_TOPGEN   3392
#define XCD_BAR_WORDS 3456
#define XB_SPIN_CAP (1u << 22)

__device__ __forceinline__ unsigned xb_ld(unsigned* p)              { return __hip_atomic_load(p, __ATOMIC_RELAXED, __HIP_MEMORY_SCOPE_AGENT); }
__device__ __forceinline__ unsigned xb_add(unsigned* p, unsigned v) { return __hip_atomic_fetch_add(p, v, __ATOMIC_RELAXED, __HIP_MEMORY_SCOPE_AGENT); }
__device__ __forceinline__ unsigned xb_xcc_id() { return (unsigned)__builtin_amdgcn_s_getreg((3 << 11) | 20) & 0xFu; }
#define XB_SPIN(cond, bar) do { unsigned _sp = 0; while (cond) { __builtin_amdgcn_s_sleep(1); \
    if ((++_sp & 255u) == 0u) { if (xb_ld(&(bar)[XB_TMO])) break; if (_sp > XB_SPIN_CAP) { atomicAdd(&(bar)[XB_TMO], 1u); break; } } } } while (0)

__device__ __forceinline__ int lane_now() { int l; asm volatile("v_mbcnt_lo_u32_b32 %0, -1, 0\n\tv_mbcnt_hi_u32_b32 %0, -1, %0" : "=v"(l)); return l; }
#define XB_T0() (b.w0 == 0 && lane_now() == 0)
struct XcdBarrier {
    unsigned* bar; unsigned x; int w0;
    volatile LAS unsigned* st;
};

__device__ __forceinline__ XcdBarrier xcd_barrier_post(unsigned* bar, volatile LAS unsigned* st, int w0) {
    XcdBarrier b; b.bar = bar; b.x = xb_xcc_id(); b.st = st; b.w0 = w0;
    if (XB_T0()) (void)xb_add(&bar[XB_XCNT(b.x)], 1u);
    return b;
}
__device__ __forceinline__ void xcd_barrier_complete(unsigned* bar, unsigned x, unsigned& nloc, unsigned& nx) {
    const unsigned G = gridDim.x * gridDim.y * gridDim.z;
    unsigned sum, cnt, mine, sp = 0u;
    for (;;) {
        sum = 0u; cnt = 0u; mine = 0u;
#pragma unroll
        for (unsigned j = 0; j < 16; ++j) { const unsigned c = xb_ld(&bar[XB_XCNT(j)]); sum += c; cnt += (c > 0u) ? 1u : 0u; mine = (j == x) ? c : mine; }
        if (sum == G) break;
        __builtin_amdgcn_s_sleep(1);
        if ((++sp & 255u) == 0u) { if (xb_ld(&bar[XB_TMO])) break; if (sp > XB_SPIN_CAP) { atomicAdd(&bar[XB_TMO], 1u); break; } }
    }
    nloc = mine > 0u ? mine : 1u; nx = cnt > 0u ? cnt : 1u;
}

__device__ __forceinline__ void xcd_barrier(const XcdBarrier& b) {
    asm volatile("s_waitcnt vmcnt(0)" ::: "memory");
    __syncthreads();
    if (XB_T0()) {
        unsigned* bar = b.bar;
        __builtin_amdgcn_s_waitcnt(0);
        unsigned nloc = b.st[0], nx = b.st[1];
        if (nloc == 0u) { xcd_barrier_complete(bar, b.x, nloc, nx); b.st[0] = nloc; b.st[1] = nx; }
        const unsigned old = xb_add(&bar[XB_XSUB(b.x)], 1u);
        const unsigned gen = old / nloc;
        if (old + 1u == (gen + 1u) * nloc) {
            __builtin_amdgcn_fence(__ATOMIC_RELEASE, "agent");
            asm volatile("s_waitcnt vmcnt(0)" ::: "memory");
            const unsigned og = xb_add(&bar[XB_TOP], 1u);
            const unsigned tg = og / nx;
            if (og + 1u == (tg + 1u) * nx) xb_add(&bar[XB_TOPGEN], 1u);
            else XB_SPIN(xb_ld(&bar[XB_TOPGEN]) == tg, bar);
            __builtin_amdgcn_fence(__ATOMIC_ACQUIRE, "agent");
            xb_add(&bar[XB_XGEN(b.x)], 1u);
            asm volatile("s_waitcnt vmcnt(0)" ::: "memory");
        } else {
            XB_SPIN(xb_ld(&bar[XB_XGEN(b.x)]) == gen, bar);
            __builtin_amdgcn_fence(__ATOMIC_ACQUIRE, "agent");
            asm volatile("s_waitcnt vmcnt(0)" ::: "memory");
        }
    }
    __syncthreads();
}


struct Frame {
    LAS unsigned char* lds;
    volatile LAS unsigned* MISC;
    gu32* ctl;
    int wave;
    int vcu, G;
    const float* x; float* out;
    const float *w_in, *conv_w, *conv_b, *conv_g, *conv_be, *w_out, *lnm_g, *lnm_b, *lnf_g, *lnf_b, *fg, *fu, *fd, *router, *eg, *eu, *ed;
    unsigned char* ws;
    unsigned long long tacc, tt0;
};
#ifndef PROBE_ID
#define PROBE_ID 0
#endif
#ifndef PROBE_WG
#define PROBE_WG 0
#endif
#define TSTART(id) do { if (PROBE_ID == (id)) F.tt0 = __builtin_amdgcn_s_memrealtime(); } while (0)
#define TSTOP(id) do { if (PROBE_ID == (id)) F.tacc += __builtin_amdgcn_s_memrealtime() - F.tt0; } while (0)
__device__ __forceinline__ int shx_i(int v, int m, int lane) { return __builtin_amdgcn_ds_bpermute((lane ^ m) << 2, v); }
__device__ __forceinline__ float shx(float v, int m, int lane) { return __builtin_bit_cast(float, __builtin_amdgcn_ds_bpermute((lane ^ m) << 2, __builtin_bit_cast(int, v))); }
__device__ __forceinline__ int shl_i(int v, int src) { return __builtin_amdgcn_ds_bpermute(src << 2, v); }
template <int N> __device__ __forceinline__ void wave_sum_n(float (&v)[N], int lane) {
#pragma unroll
    for (int i = 0; i < N; ++i) { float x = v[i];
        x += __builtin_bit_cast(float, __builtin_amdgcn_update_dpp(0, __builtin_bit_cast(int, x), 0xB1, 0xF, 0xF, false));
        x += __builtin_bit_cast(float, __builtin_amdgcn_update_dpp(0, __builtin_bit_cast(int, x), 0x4E, 0xF, 0xF, false));
        x += __builtin_bit_cast(float, __builtin_amdgcn_update_dpp(0, __builtin_bit_cast(int, x), 0x141, 0xF, 0xF, false));
        x += __builtin_bit_cast(float, __builtin_amdgcn_update_dpp(0, __builtin_bit_cast(int, x), 0x140, 0xF, 0xF, false));
        v[i] = x; }
#pragma unroll
    for (int o = 16; o < 64; o <<= 1) { float t[N];
#pragma unroll
        for (int i = 0; i < N; ++i) t[i] = shx(v[i], o, lane);
#pragma unroll
        for (int i = 0; i < N; ++i) v[i] += t[i]; }
}
__device__ __forceinline__ float wave_max(float v, int lane) {
    v = fmaxf(v, __builtin_bit_cast(float, __builtin_amdgcn_update_dpp(0, __builtin_bit_cast(int, v), 0xB1, 0xF, 0xF, false)));
    v = fmaxf(v, __builtin_bit_cast(float, __builtin_amdgcn_update_dpp(0, __builtin_bit_cast(int, v), 0x4E, 0xF, 0xF, false)));
    v = fmaxf(v, __builtin_bit_cast(float, __builtin_amdgcn_update_dpp(0, __builtin_bit_cast(int, v), 0x141, 0xF, 0xF, false)));
    v = fmaxf(v, __builtin_bit_cast(float, __builtin_amdgcn_update_dpp(0, __builtin_bit_cast(int, v), 0x140, 0xF, 0xF, false)));
    v = fmaxf(v, shx(v, 16, lane)); v = fmaxf(v, shx(v, 32, lane));
    return v;
}
__device__ __forceinline__ float wave_sum(float v, int lane) {
    v += __builtin_bit_cast(float, __builtin_amdgcn_update_dpp(0, __builtin_bit_cast(int, v), 0xB1, 0xF, 0xF, false));
    v += __builtin_bit_cast(float, __builtin_amdgcn_update_dpp(0, __builtin_bit_cast(int, v), 0x4E, 0xF, 0xF, false));
    v += __builtin_bit_cast(float, __builtin_amdgcn_update_dpp(0, __builtin_bit_cast(int, v), 0x141, 0xF, 0xF, false));
    v += __builtin_bit_cast(float, __builtin_amdgcn_update_dpp(0, __builtin_bit_cast(int, v), 0x140, 0xF, 0xF, false));
    v += shx(v, 16, lane); v += shx(v, 32, lane);
    return v;
}
__device__ __forceinline__ int wmap(int kind, int c) {
    if (kind == 0) return c;
    if (kind == 1) {
        if (c < 2048) { const int hh = c >> 7, w = c & 127, n = w >> 6, idx = w & 63; return hh * 128 + 32 * (idx >> 4) + 8 * ((idx >> 2) & 3) + 4 * n + (idx & 3); }
        if (c < 3072) return c;
        if (c < 4096) { const int j = c - 3072; return 3072 + 256 * (j >> 7) + (j & 127); }
        const int j = c - 4096; return 3072 + 256 * (j >> 7) + 128 + (j & 127);
    }
    return 256 * (c >> 7) + (kind == 3 ? 128 : 0) + (c & 127);
}
__device__ __forceinline__ void p0_transpose_item(const float* Wg, int K, int N, bf16* WT, int kind, LAS float* scr, int item, int lane) {
    const GAS float* W = (const GAS float*)Wg;
    const int nblk = N / 32, kb = item / nblk, nb = item % nblk, k0 = 64 * kb, n0 = 32 * nb;
    float wv[32];
#pragma unroll
    for (int i = 0; i < 32; ++i) wv[i] = W[(size_t)(k0 + 2 * i + (lane >> 5)) * N + n0 + (lane & 31)];
#pragma unroll
    for (int i = 0; i < 32; ++i) scr[(2 * i + (lane >> 5)) * 33 + (lane & 31)] = wv[i];
    LDS_WAIT(); asm volatile("" ::: "memory");
    const int c = lane & 7;
#pragma unroll
    for (int j = 0; j < 4; ++j) { const int n = (lane >> 3) + 8 * j; const LAS float* s = scr + (8 * c) * 33 + n;
        v4u o; o.x = pk2(s[0 * 33], s[1 * 33]); o.y = pk2(s[2 * 33], s[3 * 33]); o.z = pk2(s[4 * 33], s[5 * 33]); o.w = pk2(s[6 * 33], s[7 * 33]);
        *(GAS v4u*)(WT + (size_t)wmap(kind, n0 + n) * K + k0 + 8 * c) = o; }
    LDS_WAIT(); asm volatile("" ::: "memory");
}
__device__ __forceinline__ void sincos_acc(float ang, float& sn, float& cs) {
    const double x = (double)ang, k = __builtin_rint(x * 0.63661977236758134308);
    double r = __builtin_fma(-k, 1.57079632679489655800e+00, x); r = __builtin_fma(-k, 6.12323399573676603587e-17, r);
    const int q = ((int)k) & 3; const double r2 = r * r;
    double sp = 1.0 / 6227020800.0; sp = sp * r2 - 1.0 / 39916800.0; sp = sp * r2 + 1.0 / 362880.0; sp = sp * r2 - 1.0 / 5040.0; sp = sp * r2 + 1.0 / 120.0; sp = sp * r2 - 1.0 / 6.0;
    const double s = r + r * r2 * sp;
    double cp = -1.0 / 87178291200.0; cp = cp * r2 + 1.0 / 479001600.0; cp = cp * r2 - 1.0 / 3628800.0; cp = cp * r2 + 1.0 / 40320.0; cp = cp * r2 - 1.0 / 720.0; cp = cp * r2 + 1.0 / 24.0; cp = cp * r2 - 0.5;
    const double c = 1.0 + r2 * cp;
    const double ss = (q & 1) ? c : s, cc = (q & 1) ? s : c;
    sn = (float)((q & 2) ? -ss : ss); cs = (float)(((q + 1) & 2) ? -cc : cc);
}
__device__ __forceinline__ void p0_transpose_item8(const float* Wg, int K, int N, unsigned char* WT, int kind, float wscale, LAS float* scr, int item, int lane) {
    const GAS float* W = (const GAS float*)Wg;
    const int nblk = N / 32, kb = item / nblk, nb = item % nblk, k0 = 64 * kb, n0 = 32 * nb;
    float wv[32];
#pragma unroll
    for (int i = 0; i < 32; ++i) wv[i] = W[(size_t)(k0 + 2 * i + (lane >> 5)) * N + n0 + (lane & 31)];
#pragma unroll
    for (int i = 0; i < 32; ++i) scr[(2 * i + (lane >> 5)) * 33 + (lane & 31)] = wv[i] * wscale;
    LDS_WAIT(); asm volatile("" ::: "memory");
    const int c = lane & 7;
#pragma unroll
    for (int j = 0; j < 4; ++j) { const int n = (lane >> 3) + 8 * j; const LAS float* sp = scr + (8 * c) * 33 + n;
        v2u o; o.x = pg8::pk4_fp8(sp[0 * 33], sp[1 * 33], sp[2 * 33], sp[3 * 33]); o.y = pg8::pk4_fp8(sp[4 * 33], sp[5 * 33], sp[6 * 33], sp[7 * 33]);
        *(GAS v2u*)(WT + (size_t)wmap(kind, n0 + n) * K + k0 + 8 * c) = o; }
    LDS_WAIT(); asm volatile("" ::: "memory");
}
__device__ __forceinline__ void p0_transpose_stack8(Frame& F, const float* src, int K, int N, int nmat, unsigned char* dst, size_t dst_stride, int kind, float wscale) {
    LAS float* scr = (LAS float*)(F.lds + RING_OFF + F.wave * 16384);
    const int gw = F.vcu * NWAVES + F.wave, NGW = F.G * NWAVES, per = (K / 64) * (N / 32), total = per * nmat, lane = lane_now();
#pragma clang loop unroll(disable)
    for (int it = gw; it < total; it += NGW) { const int m = it / per, r = it - m * per;
        p0_transpose_item8(src + (size_t)m * K * N, K, N, dst + (size_t)m * dst_stride, kind, wscale, scr, r, lane); }
}
__device__ __forceinline__ void p0_stack(Frame& F, const float* src, int K, int N, int nmat, unsigned char* dst, size_t dst_stride_bytes, int kind, int qmode  , float wscale, int n_lo = 0, int n_cnt = 0, int drow_off = 0) {
    LAS float* t = (LAS float*)(F.lds + RING_OFF);
    const int tid = F.wave * 64 + lane_now(), ntn = (n_cnt ? n_cnt : N) / 256, per = (K / 128) * ntn, total = per * nmat;
    f32x4 raw[16];
    int it = blockIdx.x;
    if (it < total) { const int m = it / per, r = it - m * per, k0 = (r / ntn) * 128, n0 = n_lo + (r % ntn) * 256; const GAS f32x4* W = (const GAS f32x4*)(src + (size_t)m * K * N + (size_t)k0 * N + n0);
#pragma unroll
        for (int i = 0; i < 16; ++i) { const int p = tid + 512 * i; raw[i] = W[(size_t)(p >> 6) * (N / 4) + (p & 63)]; } }
#pragma clang loop unroll(disable)
    for (; it < total; it += F.G) { const int m = it / per, r = it - m * per, k0 = (r / ntn) * 128, n0 = n_lo + (r % ntn) * 256;
        const int tid2 = F.wave * 64 + lane_now();
#pragma unroll
        for (int i = 0; i < 16; ++i) { const int p = tid2 + 512 * i; LAS float* d = t + (p >> 6) * 257 + (p & 63) * 4; d[0] = raw[i][0] * wscale; d[1] = raw[i][1] * wscale; d[2] = raw[i][2] * wscale; d[3] = raw[i][3] * wscale; }
        __syncthreads();
        { const int nx = (it + F.G < total) ? it + F.G : it;
          const int m2 = nx / per, r2 = nx - m2 * per, k2 = (r2 / ntn) * 128, n2 = n_lo + (r2 % ntn) * 256; const GAS f32x4* W = (const GAS f32x4*)(src + (size_t)m2 * K * N + (size_t)k2 * N + n2);
#pragma unroll
            for (int i = 0; i < 16; ++i) { const int p = tid2 + 512 * i; raw[i] = W[(size_t)(p >> 6) * (N / 4) + (p & 63)]; } }
        unsigned char* drow = dst + (size_t)m * dst_stride_bytes;
#pragma unroll
        for (int q = 0; q < 8; ++q) { const int cid = tid2 + 512 * q, nrow = cid >> 4, kc = cid & 15; const LAS float* sp = t + (8 * kc) * 257 + nrow;
            const float e0 = sp[0], e1 = sp[257], e2 = sp[2 * 257], e3 = sp[3 * 257], e4 = sp[4 * 257], e5 = sp[5 * 257], e6 = sp[6 * 257], e7 = sp[7 * 257];
            const size_t drw = (size_t)(wmap(kind, n0 + nrow) - drow_off) * K + k0 + 8 * kc;
            if (qmode == 1) { v2u o; o.x = pg8::pk4_fp8(e0, e1, e2, e3); o.y = pg8::pk4_fp8(e4, e5, e6, e7); *(GAS v2u*)(drow + drw) = o; }
            else if (qmode == 2) { v2u o; o.x = pg8::pk4_i8(e0, e1, e2, e3); o.y = pg8::pk4_i8(e4, e5, e6, e7); *(GAS v2u*)(drow + drw) = o; }
            else { v4u o; o.x = pk2(e0, e1); o.y = pk2(e2, e3); o.z = pk2(e4, e5); o.w = pk2(e6, e7); *(GAS v4u*)(drow + drw * 2) = o; } }
        __syncthreads();
    }
}
constexpr int XT_PER = 352, XT_TOTAL = 24 * XT_PER;
static_assert((DM / 128) * (DFF / 256) == XT_PER && (DFF / 128) * (DM / 256) == XT_PER, "expert tile counts");
__device__ __forceinline__ void convert_expert_tile(Frame& F, int t) {
    LAS float* tl = (LAS float*)(F.lds + RING_OFF);
    const int tid = F.wave * 64 + lane_now();
    const int mat = t / XT_PER, r = t - mat * XT_PER, kidx = mat >> 3, e = mat & 7;
    const float* pg = F.eg; const float* pu = F.eu; const float* pd = F.ed;
    asm volatile("" : "+s"(pg), "+s"(pu), "+s"(pd));
    const bool down = kidx == 2;
    const int K = down ? DFF : DM, N = down ? DM : DFF, ntn = N / 256, k0 = (r / ntn) * 128, n0 = (r % ntn) * 256;
    const float* src = (kidx == 0 ? pg : (kidx == 1 ? pu : pd)) + (size_t)e * DM * DFF;
    unsigned char* dst = down ? (F.ws + WS_WDE + (size_t)e * DM * DFF) : (F.ws + WS_WGUE + (size_t)e * 2 * DFF * DM);
    const int kind = down ? 0 : (kidx == 0 ? 2 : 3); const float wscale = down ? WSC_D : WSC_GU;
    const GAS f32x4* W = (const GAS f32x4*)(src + (size_t)k0 * N + n0);
    f32x4 raw[16];
#pragma unroll
    for (int i = 0; i < 16; ++i) { const int p = tid + 512 * i; raw[i] = W[(size_t)(p >> 6) * (N / 4) + (p & 63)]; }
#pragma unroll
    for (int i = 0; i < 16; ++i) { const int p = tid + 512 * i; LAS float* d = tl + (p >> 6) * 257 + (p & 63) * 4; d[0] = raw[i][0] * wscale; d[1] = raw[i][1] * wscale; d[2] = raw[i][2] * wscale; d[3] = raw[i][3] * wscale; }
    __syncthreads();
#pragma unroll
    for (int q = 0; q < 8; ++q) { const int cid = tid + 512 * q, nrow = cid >> 4, kc = cid & 15; const LAS float* sp = tl + (8 * kc) * 257 + nrow;
        const float e0 = sp[0], e1 = sp[257], e2 = sp[2 * 257], e3 = sp[3 * 257], e4 = sp[4 * 257], e5 = sp[5 * 257], e6 = sp[6 * 257], e7 = sp[7 * 257];
        v2u o; o.x = pg8::pk4_fp8(e0, e1, e2, e3); o.y = pg8::pk4_fp8(e4, e5, e6, e7);
        *(GAS v2u*)(dst + (size_t)wmap(kind, n0 + nrow) * K + k0 + 8 * kc) = o; }
    __syncthreads();
}
constexpr unsigned STEAL_THRESH = 200u;
__device__ __forceinline__ void steal_point(Frame& F, int idx) {
    __syncthreads();
    const bool t0 = (F.wave == 0) && (lane_now() == 0);
    if (t0) __hip_atomic_fetch_add(F.ctl + CW_ARRIVE + 64 * idx, 1u, RLX_AGENT);
#pragma clang loop unroll(disable)
    for (int it = 0; it < XT_TOTAL; ++it) {
        if (t0) { int tt = -1;
            if (__hip_atomic_load(F.ctl + CW_ARRIVE + 64 * idx, RLX_AGENT) < STEAL_THRESH) { const unsigned q = __hip_atomic_fetch_add(F.ctl + CW_STEALQ, 1u, RLX_AGENT); if (q < (unsigned)XT_TOTAL) tt = (int)q; }
            F.MISC[17] = (unsigned)tt; }
        __syncthreads();
        const int tt = (int)__builtin_amdgcn_readfirstlane(F.MISC[17]);
        if (tt < 0) break;
        convert_expert_tile(F, tt);
    }
}
__device__ __forceinline__ void steal_drain(Frame& F) {
    __syncthreads();
    const bool t0 = (F.wave == 0) && (lane_now() == 0);
#pragma clang loop unroll(disable)
    for (int it = 0; it < XT_TOTAL; ++it) {
        if (t0) { const unsigned q = __hip_atomic_fetch_add(F.ctl + CW_STEALQ, 1u, RLX_AGENT); F.MISC[17] = q < (unsigned)XT_TOTAL ? q : 0xffffffffu; }
        __syncthreads();
        const int tt = (int)__builtin_amdgcn_readfirstlane(F.MISC[17]);
        if (tt < 0) break;
        convert_expert_tile(F, tt);
    }
}
__device__ __forceinline__ void p0_prologue(Frame& F) {
    p0_stack(F, F.w_in, DM, NPROJ, 2, F.ws + WS_WIN, (size_t)20 * MiB, 1, 1, WSC_GU, 0, 3072, 0);
    p0_stack(F, F.w_in, DM, NPROJ, 2, F.ws + WS_WIN + 8 * MiB, (size_t)20 * MiB, 1, 0, 1.f, 3072, 2048, 3072);
    p0_stack(F, F.w_out, DM, DM, 2, F.ws + WS_WOUT, (size_t)DM * DM, 0, 1, WSC_O);
    p0_stack(F, F.fg, DM, DFF, 1, F.ws + WS_WGU0, 0, 2, 2, WQ_GU);
    p0_stack(F, F.fu, DM, DFF, 1, F.ws + WS_WGU0, 0, 3, 2, WQ_GU);
    p0_stack(F, F.fd, DFF, DM, 1, F.ws + WS_WD0, 0, 0, 0, 1.f);
    { const int i = ((F.vcu * NWAVES + F.wave) * 64 + lane_now()); if (i < NE * DM) { const int e = i / DM, k = i - e * DM; const float w = ((const GAS float*)F.router)[k * NE + e];
          const unsigned hi = f2bf(w), lo = f2bf(w - __builtin_bit_cast(float, hi << 16)); ((GAS bf16*)(F.ws + WS_RWT))[i] = (bf16)hi; ((GAS bf16*)(F.ws + WS_RWT))[NE * DM + i] = (bf16)lo; } }
    { GAS float* rc = (GAS float*)(F.ws + WS_ROPEC); GAS float* rs = (GAS float*)(F.ws + WS_ROPES);
#pragma clang loop unroll(disable)
      for (int i = (F.vcu * NWAVES + F.wave) * 64 + lane_now(); i < S * 64; i += F.G * NWAVES * 64) { const int t = i >> 6, f = i & 63; const float ang = (float)t * INV_FREQ[f]; float sn, cs; sincos_acc(ang, sn, cs); rc[i] = cs; rs[i] = sn; } }
    { const GAS f32x4* xs = (const GAS f32x4*)F.x; GAS v4u* hb = (GAS v4u*)(F.ws + WS_HB);
#pragma clang loop unroll(disable)
      for (int i = (F.vcu * NWAVES + F.wave) * 64 + lane_now(); i < S * DM / 8; i += F.G * NWAVES * 64) { const f32x4 a = xs[2 * i], b = xs[2 * i + 1]; v4u o; o.x = pk2(a[0], a[1]); o.y = pk2(a[2], a[3]); o.z = pk2(b[0], b[1]); o.w = pk2(b[2], b[3]); hb[i] = o;
          ((GAS v2u*)(F.ws + WS_HB8))[i] = (v2u){pg8::pk4_fp8(a[0] * ASC_H, a[1] * ASC_H, a[2] * ASC_H, a[3] * ASC_H), pg8::pk4_fp8(b[0] * ASC_H, b[1] * ASC_H, b[2] * ASC_H, b[3] * ASC_H)}; } }
}

__device__ __forceinline__ void kmean_phase(Frame& F) {
    const int lane = lane_now(), c8 = lane & 15, rg = lane >> 4, u2 = F.wave >> 2, q = F.wave & 3, tid = F.wave * 64 + lane;
    LAS float* ks = (LAS float*)(F.lds + RING_OFF + 8 * 8704);
    { const int unit = (int)blockIdx.x + u2 * F.G, j = unit & 63, h = unit >> 6;
      const GAS v4u* kp = (const GAS v4u*)(F.ws + WS_K) + ((size_t)(j * 256 + 64 * q + rg) * 1024 + h * 128) / 8 + c8;
      v4u w[16];
#pragma unroll
      for (int it = 0; it < 16; ++it) w[it] = kp[(size_t)it * 4 * 128];
      float a[8];
#pragma unroll
      for (int i = 0; i < 8; ++i) a[i] = 0.f;
#pragma unroll
      for (int it = 0; it < 16; ++it) { a[0] += bflo(w[it].x); a[1] += bfhi(w[it].x); a[2] += bflo(w[it].y); a[3] += bfhi(w[it].y); a[4] += bflo(w[it].z); a[5] += bfhi(w[it].z); a[6] += bflo(w[it].w); a[7] += bfhi(w[it].w); }
#pragma unroll
      for (int i = 0; i < 8; ++i) { a[i] += shx(a[i], 16, lane); a[i] += shx(a[i], 32, lane); }
      if (rg == 0) { *(LAS f32x4*)(ks + (u2 * 4 + q) * 128 + 8 * c8) = (f32x4){a[0], a[1], a[2], a[3]}; *(LAS f32x4*)(ks + (u2 * 4 + q) * 128 + 8 * c8 + 4) = (f32x4){a[4], a[5], a[6], a[7]}; } }
    __syncthreads();
    if (tid < 128) { const int uu = tid >> 6, cp = tid & 63, unit = (int)blockIdx.x + uu * F.G, j = unit & 63, h = unit >> 6;
        float m0 = 0.f, m1 = 0.f;
#pragma unroll
        for (int qq = 0; qq < 4; ++qq) { const f32x2 v = *(const LAS f32x2*)(ks + (uu * 4 + qq) * 128 + 2 * cp); m0 += v.x; m1 += v.y; }
        m0 *= (1.f / 256.f); m1 *= (1.f / 256.f);
        const unsigned hi = pk2(m0, m1), lo = pk2(m0 - bflo(hi), m1 - bfhi(hi));
        GAS unsigned* kh = (GAS unsigned*)(F.ws + WS_KMEAN) + ((size_t)(h * 64 + j) * 128) / 2 + cp;
        kh[0] = hi; kh[NH * NBLK * HD / 2] = lo; }
}
__device__ __forceinline__ void vt_phase(Frame& F) {
    const int gw = F.vcu * NWAVES + F.wave, NGW = F.G * NWAVES, lane = lane_now();
    LAS unsigned char* tile = F.lds + RING_OFF + F.wave * 8704;
    constexpr int NU = (S / 32) * NH;
    v4u raw[2][8];
#pragma unroll
    for (int k = 0; k < 2; ++k) { const int unit = (gw + k * NGW) & (NU - 1); const int h = unit & 7, kb = (unit >> 3) * 32;
            const GAS v4u* src = (const GAS v4u*)(F.ws + WS_V) + ((size_t)kb * 1024 + h * 128) / 8;
#pragma unroll
            for (int i = 0; i < 8; ++i) raw[k][i] = src[(size_t)(i * 4 + (lane >> 4)) * 128 + (lane & 15)]; }
#pragma unroll
    for (int k = 0; k < 2; ++k) { const int unit = gw + k * NGW; if (unit < NU) { const int h = unit & 7, kb = (unit >> 3) * 32;
#pragma unroll
            for (int i = 0; i < 8; ++i) *(LAS v4u*)(tile + (i * 4 + (lane >> 4)) * 272 + (lane & 15) * 16) = raw[k][i];
            LDS_WAIT(); asm volatile("" ::: "memory");
            const int ch = lane & 3, G = ch >> 1, g = ch & 1;
#pragma unroll
            for (int i = 0; i < 8; ++i) { const int d = i * 16 + (lane >> 2);
                unsigned short e[8];
#pragma unroll
                for (int p = 0; p < 8; ++p) { const int key = 16 * G + 8 * (p >> 2) + 4 * g + (p & 3); e[p] = *(const LAS unsigned short*)(tile + key * 272 + d * 2); }
                v4u o; o.x = (unsigned)e[0] | ((unsigned)e[1] << 16); o.y = (unsigned)e[2] | ((unsigned)e[3] << 16); o.z = (unsigned)e[4] | ((unsigned)e[5] << 16); o.w = (unsigned)e[6] | ((unsigned)e[7] << 16);
                *((GAS v4u*)(F.ws + WS_VT) + ((size_t)(h * 128 + d) * S + kb + 8 * ch) / 8) = o; }
            LDS_WAIT(); asm volatile("" ::: "memory"); } }
}

constexpr int CT = 16, CROWS = CT + 30;
__device__ __forceinline__ void conv_phase(Frame& F, int l) {
    LAS unsigned* ub = (LAS unsigned*)(F.lds + RING_OFF);
    LAS f32x2* part = (LAS f32x2*)(F.lds + RING_OFF + CROWS * 2048);
    const int lane = lane_now(), tid = F.wave * 64 + lane;
    const GAS f32x2* cw = (const GAS f32x2*)(F.conv_w + (size_t)l * CKW * 1024) + tid;
    float w0[CKW], w1[CKW];
#pragma unroll
    for (int k = 0; k < CKW; ++k) { const f32x2 w = cw[k * 512]; w0[k] = w.x; w1[k] = w.y; }
    const f32x2 cb = ((const GAS f32x2*)(F.conv_b + l * 1024))[tid], lg = ((const GAS f32x2*)(F.conv_g + l * 1024))[tid], lb = ((const GAS f32x2*)(F.conv_be + l * 1024))[tid];
    const GAS v4u* U = (const GAS v4u*)(F.ws + WS_U);
    GAS unsigned* CAT = (GAS unsigned*)(F.ws + WS_CAT);
    constexpr int NP = (CROWS * 128 + NWAVES * 64 - 1) / (NWAVES * 64);
    const int tb = (int)blockIdx.x * 64;
#pragma clang loop unroll(disable)
    for (int st = 0; st < 4; ++st) { const int t0 = tb + st * CT;
        TSTART(21);
        { const int lane2 = lane_now(), tid2 = F.wave * 64 + lane2;
          v4u nx[NP];
#pragma unroll
          for (int i = 0; i < NP; ++i) { const int p = tid2 + NWAVES * 64 * i, pc = p < CROWS * 128 ? p : CROWS * 128 - 1, tok = t0 - 30 + (pc >> 7);
              const v4u ld = U[(size_t)(tok >= 0 ? tok : 0) * 128 + (pc & 127)]; const bool ok = tok >= 0; nx[i].x = ok ? ld.x : 0u; nx[i].y = ok ? ld.y : 0u; nx[i].z = ok ? ld.z : 0u; nx[i].w = ok ? ld.w : 0u; }
#pragma unroll
          for (int i = 0; i < NP; ++i) { const int p = tid2 + NWAVES * 64 * i; if (p < CROWS * 128) *(LAS v4u*)(ub + (p >> 7) * 512 + (p & 127) * 4) = nx[i]; } }
        __syncthreads();
        TSTOP(21); TSTART(22);
        f32x2 av[CT];
#pragma unroll
        for (int t = 0; t < CT; ++t) av[t] = cb;
#pragma unroll
        for (int r = 0; r < CROWS; ++r) { const unsigned w = ub[r * 512 + tid]; const f32x2 x = {bflo(w), bfhi(w)};
#pragma unroll
            for (int t = 0; t < CT; ++t) { if (r - t >= 0 && r - t <= 30) av[t] += (f32x2){w0[r - t], w1[r - t]} * x; } }
        TSTOP(22); TSTART(23);
        { float red[2 * CT];
#pragma unroll
          for (int t = 0; t < CT; ++t) { red[2 * t] = av[t].x + av[t].y; red[2 * t + 1] = av[t].x * av[t].x + av[t].y * av[t].y; }
          float r16[16], r8[8], r4[4], r2[2], r1;
#define RS_STEP(dst, src, n, bit) { const bool hi = (lane & (bit)) != 0; float snd_[n], kp_[n]; \
            _Pragma("unroll") for (int i = 0; i < (n); ++i) { float lo_ = src[i], up_ = src[i + (n)]; asm volatile("" : "+v"(lo_), "+v"(up_));     \
                snd_[i] = shx(hi ? lo_ : up_, (bit), lane); kp_[i] = hi ? up_ : lo_; } \
            _Pragma("unroll") for (int i = 0; i < (n); ++i) dst[i] = kp_[i] + snd_[i]; }
          RS_STEP(r16, red, 16, 32) RS_STEP(r8, r16, 8, 16) RS_STEP(r4, r8, 4, 8) RS_STEP(r2, r4, 2, 4)
          { const bool hi = (lane & 2) != 0; float lo_ = r2[0], up_ = r2[1]; asm volatile("" : "+v"(lo_), "+v"(up_)); const float snd = shx(hi ? lo_ : up_, 2, lane); r1 = (hi ? up_ : lo_) + snd; }
#undef RS_STEP
          r1 += shx(r1, 1, lane);
          if ((lane & 1) == 0) ((LAS float*)part)[F.wave * (2 * CT) + (lane >> 1)] = r1; }
        __syncthreads();
        LAS f32x2* fin = part + NWAVES * CT;
        if (tid < CT) { float s1 = 0.f, q = 0.f;
#pragma unroll
            for (int w = 0; w < 8; ++w) { const f32x2 pp = part[w * CT + tid]; s1 += pp.x; q += pp.y; }
            const float mean = s1 * (1.f / 1024.f), var = fmaxf(q * (1.f / 1024.f) - mean * mean, 0.f);
            fin[tid] = (f32x2){mean, 1.0f / sqrtf(var + LN_EPS)}; }
        __syncthreads();
        TSTOP(23); TSTART(24);
        { f32x4 fv[CT / 2];
#pragma unroll
          for (int i = 0; i < CT / 2; ++i) fv[i] = ((const LAS f32x4*)fin)[i];
#pragma unroll
          for (int t = 0; t < CT; ++t) { const float mean = fv[t >> 1][2 * (t & 1)], rstd = fv[t >> 1][2 * (t & 1) + 1];
              const float y0 = (av[t].x - mean) * rstd * lg.x + lb.x, y1 = (av[t].y - mean) * rstd * lg.y + lb.y;
              ((GAS unsigned short*)(F.ws + WS_CAT))[((size_t)(t0 + t) * DM + 1024) / 2 + tid] = (unsigned short)pg8::pk4_fp8(y0 * pg8::sigmoidf_fast(y0) * ASC_CAT, y1 * pg8::sigmoidf_fast(y1) * ASC_CAT, 0.f, 0.f); } }
        __syncthreads();
        TSTOP(24);
    }
}

typedef float f32x16 __attribute__((ext_vector_type(16)));
typedef __bf16 bf16x2_t __attribute__((ext_vector_type(2)));
__device__ __forceinline__ unsigned cvtpk(float lo, float hi) { const f32x2 v = {lo, hi}; const bf16x2_t b = __builtin_convertvector(v, bf16x2_t); return __builtin_bit_cast(unsigned, b); }
#define MFMA32(a, b, c) __builtin_amdgcn_mfma_f32_32x32x16_bf16((a), (b), (c), 0, 0, 0)
constexpr int LIST_PER_HEAD = 256 * 2016;
__device__ __forceinline__ int binoff(int j) { return 256 * (63 * j - (j * (j - 1)) / 2); }
#define TOP3_INSERT(v, j) do { const float v_ = (v); const int j_ = (j); \
    if (v_ > tv2) { if (v_ > tv1) { tv2 = tv1; ti2 = ti1; if (v_ > tv0) { tv1 = tv0; ti1 = ti0; tv0 = v_; ti0 = j_; } else { tv1 = v_; ti1 = j_; } } else { tv2 = v_; ti2 = j_; } } } while (0)
__device__ __forceinline__ void sel_phase(Frame& F, int l) {
    LAS int* cntL = (LAS int*)(F.lds + RING_OFF); LAS int* baseL = cntL + 64;
    const int lane = lane_now(), r = lane & 31, hg = lane >> 5, tid = F.wave * 64 + lane;
    const float NEG = -__builtin_inff();
#pragma clang loop unroll(disable)
    for (int unit = blockIdx.x; unit < 63 * NH; unit += F.G) { const int b = 1 + (unit >> 3), h = unit & 7;
        if (tid < 64) cntL[tid] = 0;
        __syncthreads();
        const int t = b * 256 + F.wave * 32 + r;
        const GAS bf16x8* qp = (const GAS bf16x8*)(F.ws + WS_Q) + ((size_t)t * 1024 + h * 128) / 8 + hg;
        bf16x8 qf[8];
#pragma unroll
        for (int kk = 0; kk < 8; ++kk) qf[kk] = qp[2 * kk];
        const GAS bf16x8* kh = (const GAS bf16x8*)(F.ws + WS_KMEAN) + ((size_t)(h * 64 + r) * 128) / 8 + hg;
        f32x16 G0, G1;
#pragma unroll
        for (int i = 0; i < 16; ++i) { G0[i] = 0.f; G1[i] = 0.f; }
#pragma unroll
        for (int kk = 0; kk < 8; ++kk) { G0 = MFMA32(kh[2 * kk], qf[kk], G0); G0 = MFMA32(kh[2 * kk + NH * NBLK * HD / 8], qf[kk], G0); }
        if (b > 32) {
#pragma unroll
            for (int kk = 0; kk < 8; ++kk) { G1 = MFMA32(kh[2 * kk + 32 * 16], qf[kk], G1); G1 = MFMA32(kh[2 * kk + 32 * 16 + NH * NBLK * HD / 8], qf[kk], G1); } }
        float tv0 = NEG, tv1 = NEG, tv2 = NEG; int ti0 = 0, ti1 = 0, ti2 = 0;
#pragma unroll
        for (int i = 0; i < 16; ++i) { const int j = (i & 3) + 8 * (i >> 2) + 4 * hg; TOP3_INSERT(j < b ? G0[i] : NEG, j); }
        if (b > 32) {
#pragma unroll
            for (int i = 0; i < 16; ++i) { const int j = 32 + (i & 3) + 8 * (i >> 2) + 4 * hg; TOP3_INSERT(j < b ? G1[i] : NEG, j); } }
        { const float p0 = shx(tv0, 32, lane), p1 = shx(tv1, 32, lane), p2 = shx(tv2, 32, lane); const int q0 = shx_i(ti0, 32, lane), q1 = shx_i(ti1, 32, lane), q2 = shx_i(ti2, 32, lane);
          TOP3_INSERT(p0, q0); TOP3_INSERT(p1, q1); TOP3_INSERT(p2, q2); }
        int rk0 = 0, rk1 = 0, rk2 = 0;
        if (hg == 0) {
            if (tv0 > NEG) rk0 = __hip_atomic_fetch_add(cntL + ti0, 1, __ATOMIC_RELAXED, __HIP_MEMORY_SCOPE_WORKGROUP);
            if (tv1 > NEG) rk1 = __hip_atomic_fetch_add(cntL + ti1, 1, __ATOMIC_RELAXED, __HIP_MEMORY_SCOPE_WORKGROUP);
            if (tv2 > NEG) rk2 = __hip_atomic_fetch_add(cntL + ti2, 1, __ATOMIC_RELAXED, __HIP_MEMORY_SCOPE_WORKGROUP); }
        __syncthreads();
        if (tid < 64) { const int c = cntL[tid]; if (c > 0) baseL[tid] = (int)__hip_atomic_fetch_add(F.ctl + CW_LCNT + l * 512 + h * 64 + tid, (unsigned)c, RLX_AGENT); }
        __syncthreads();
        if (hg == 0) { GAS int* L = (GAS int*)(F.ws + WS_LIST) + (size_t)h * LIST_PER_HEAD;
            if (tv0 > NEG) L[binoff(ti0) + baseL[ti0] + rk0] = t * 4 + 0;
            if (tv1 > NEG) L[binoff(ti1) + baseL[ti1] + rk1] = t * 4 + 1;
            if (tv2 > NEG) L[binoff(ti2) + baseL[ti2] + rk2] = t * 4 + 2; }
        __syncthreads();
    }
}
constexpr int KROW = 272, VROW = 528, KBUF_BYTES = 256 * KROW, VBUF_BYTES = 128 * VROW;
#define SCHED_FENCE() __builtin_amdgcn_sched_barrier(0)
template <bool CAUSAL>
__device__ __forceinline__ void moba_tile(const bf16x8 (&qf)[8], const LAS unsigned char* kb, const LAS unsigned char* vb, const int nkt, const int r, const int hg, f32x16 (&O)[4], float& ms, float& lsum) {
    const float NEG = -__builtin_inff(), SC = 0.08838834764831845f * 1.44269504088896341f;
    f32x16 Sx[8];
    bf16x8 kfA[8], kfB[8];
#pragma unroll
    for (int kk = 0; kk < 8; ++kk) kfA[kk] = *(const LAS bf16x8*)(kb + kk * 32);
#pragma unroll
    for (int kt = 0; kt < 8; ++kt) {
        if (kt < nkt) { f32x16 a;
#pragma unroll
            for (int i = 0; i < 16; ++i) a[i] = 0.f;
            if (kt + 1 < 8 && kt + 1 < nkt) {
#pragma unroll
                for (int kk = 0; kk < 8; ++kk) { if (kt & 1) kfA[kk] = *(const LAS bf16x8*)(kb + (kt + 1) * 32 * KROW + kk * 32); else kfB[kk] = *(const LAS bf16x8*)(kb + (kt + 1) * 32 * KROW + kk * 32); } }
            SCHED_FENCE();
#pragma unroll
            for (int kk = 0; kk < 8; ++kk) a = MFMA32((kt & 1) ? kfB[kk] : kfA[kk], qf[kk], a);
            SCHED_FENCE();
            if (CAUSAL && kt == nkt - 1) {
#pragma unroll
                for (int i = 0; i < 16; ++i) a[i] = ((i & 3) + 8 * (i >> 2) + 4 * hg > r) ? NEG : a[i]; }
            Sx[kt] = a;
        } else {
#pragma unroll
            for (int i = 0; i < 16; ++i) Sx[kt][i] = NEG; }
    }
    float mx = NEG;
#pragma unroll
    for (int kt = 0; kt < 8; ++kt)
#pragma unroll
        for (int i = 0; i < 16; ++i) mx = fmaxf(mx, Sx[kt][i]);
    mx = fmaxf(mx, shx(mx, 32, r + 32 * hg));
    ms = mx * SC;
    float ls = 0.f;
    bf16x8 pb[8][2];
#pragma unroll
    for (int kt = 0; kt < 8; ++kt)
#pragma unroll
        for (int s2 = 0; s2 < 2; ++s2) { float p[8];
#pragma unroll
            for (int i = 0; i < 8; ++i) { p[i] = __builtin_amdgcn_exp2f(Sx[kt][8 * s2 + i] * SC - ms); ls += p[i]; }
            v4u pw; pw.x = cvtpk(p[0], p[1]); pw.y = cvtpk(p[2], p[3]); pw.z = cvtpk(p[4], p[5]); pw.w = cvtpk(p[6], p[7]);
            pb[kt][s2] = __builtin_bit_cast(bf16x8, pw); }
    lsum = ls + shx(ls, 32, r + 32 * hg);
#pragma unroll
    for (int dt = 0; dt < 4; ++dt)
#pragma unroll
        for (int i = 0; i < 16; ++i) O[dt][i] = 0.f;
    bf16x8 vfA[4], vfB[4];
#pragma unroll
    for (int dt = 0; dt < 4; ++dt) vfA[dt] = *(const LAS bf16x8*)(vb + dt * 32 * VROW);
#pragma unroll
    for (int st = 0; st < 16; ++st) { const int kt = st >> 1, s2 = st & 1;
        if (kt < nkt) {
            if (st + 1 < 16 && ((st + 1) >> 1) < nkt) {
#pragma unroll
                for (int dt = 0; dt < 4; ++dt) { if (st & 1) vfA[dt] = *(const LAS bf16x8*)(vb + dt * 32 * VROW + (st + 1) * 32); else vfB[dt] = *(const LAS bf16x8*)(vb + dt * 32 * VROW + (st + 1) * 32); } }
            SCHED_FENCE();
#pragma unroll
            for (int dt = 0; dt < 4; ++dt) O[dt] = MFMA32((st & 1) ? vfB[dt] : vfA[dt], pb[kt][s2], O[dt]);
            SCHED_FENCE();
        }
    }
}
__device__ __forceinline__ void stage_kv(Frame& F, int h, int j, int tid) {
    LAS unsigned char* kbuf = F.lds + RING_OFF; LAS unsigned char* vbuf = kbuf + KBUF_BYTES;
    const GAS v4u* kg = (const GAS v4u*)(F.ws + WS_K) + ((size_t)(j * 256) * 1024 + h * 128) / 8;
    const GAS v4u* vg = (const GAS v4u*)(F.ws + WS_VT) + ((size_t)(h * 128) * S + j * 256) / 8;
    v4u kr[8], vr[8];
#pragma unroll
    for (int i = 0; i < 8; ++i) { const int p = tid + 512 * i; kr[i] = kg[(size_t)(p >> 4) * 128 + (p & 15)]; vr[i] = vg[(size_t)(p >> 5) * (S / 8) + (p & 31)]; }
#pragma unroll
    for (int i = 0; i < 8; ++i) { const int p = tid + 512 * i; *(LAS v4u*)(kbuf + (p >> 4) * KROW + (p & 15) * 16) = kr[i]; *(LAS v4u*)(vbuf + (p >> 5) * VROW + (p & 31) * 16) = vr[i]; }
}
__device__ __forceinline__ void partial_phase(Frame& F, int l) {
    gu32* lcnt = F.ctl + CW_LCNT + l * 512;
    LAS int* tab = (LAS int*)(F.lds + RING_OFF + KBUF_BYTES + VBUF_BYTES);
    LAS int* tabc = tab + 512;
    LAS int* tabn = tab + 1024;
    { const int lane = lane_now(); int tl[8], cs[8], cn[8], sum = 0, csum = 0;
#pragma unroll
      for (int i = 0; i < 8; ++i) { cn[i] = (int)__hip_atomic_load(lcnt + lane * 8 + i, RLX_AGENT); tl[i] = (cn[i] + 255) >> 8; cs[i] = 14 * tl[i] + (tl[i] ? 11 : 0); sum += tl[i]; csum += cs[i]; }
      int inc = sum, cinc = csum;
#pragma unroll
      for (int o = 1; o < 64; o <<= 1) { const int v = __builtin_amdgcn_ds_bpermute((lane - o) << 2, inc), cv = __builtin_amdgcn_ds_bpermute((lane - o) << 2, cinc); if (lane >= o) { inc += v; cinc += cv; } }
      int run = inc - sum, crun = cinc - csum;
      if (F.wave == 0) {
#pragma unroll
          for (int i = 0; i < 8; ++i) { run += tl[i]; crun += cs[i]; tab[lane * 8 + i] = run; tabc[lane * 8 + i] = crun; tabn[lane * 8 + i] = cn[i]; } } }
    __syncthreads();
    int u_lo, u_hi;
    { const int lane = lane_now(); const long T = tabc[511];
      const int x0 = (int)(((long)blockIdx.x * T) / F.G), x1 = (int)(((long)(blockIdx.x + 1) * T) / F.G);
      int c0 = 0, c1 = 0; int plo = lane ? tabc[lane * 8 - 1] : 0, pu = lane ? tab[lane * 8 - 1] : 0;
#pragma unroll
      for (int i = 0; i < 8; ++i) { const int hi = tabc[lane * 8 + i], uu = tab[lane * 8 + i], nu = uu - pu;
          { const int loc = x0 - plo; c0 += (x0 >= hi) ? nu : (loc <= 0 ? 0 : (loc <= 25 ? 1 : 1 + (loc - 25 + 13) / 14)); }
          { const int loc = x1 - plo; c1 += (x1 >= hi) ? nu : (loc <= 0 ? 0 : (loc <= 25 ? 1 : 1 + (loc - 25 + 13) / 14)); }
          plo = hi; pu = uu; }
#pragma unroll
      for (int o = 1; o < 64; o <<= 1) { c0 += shx_i(c0, o, lane); c1 += shx_i(c1, o, lane); }
      u_lo = __builtin_amdgcn_readfirstlane(c0); u_hi = __builtin_amdgcn_readfirstlane(c1); }
    int staged = -1;
#define PARTIAL_LOCATE(uu, obin, ochunk, oe) { const int lane_ = lane_now(); int b_ = 0, c_ = 0; bool m_ = false; \
        { int lo_ = lane_ ? tab[lane_ * 8 - 1] : 0; \
          _Pragma("unroll") for (int i = 0; i < 8; ++i) { const int hi_ = tab[lane_ * 8 + i]; if ((uu) >= lo_ && (uu) < hi_) { m_ = true; b_ = lane_ * 8 + i; c_ = (uu) - lo_; } lo_ = hi_; } } \
        const int s_ = __builtin_ctzll(__ballot(m_)); obin = __builtin_amdgcn_readlane(b_, s_); ochunk = __builtin_amdgcn_readlane(c_, s_); \
        const int n_ = __builtin_amdgcn_readfirstlane(tabn[obin]), base_ = ochunk * 256 + F.wave * 32, r_ = lane_ & 31; \
        oe = ((const GAS int*)(F.ws + WS_LIST))[(size_t)(obin >> 6) * LIST_PER_HEAD + binoff(obin & 63) + (base_ < n_ ? base_ + (base_ + r_ < n_ ? r_ : 0) : 0)]; }
    int nbin = 0, nchunk = 0, ne = 0;
    if (u_lo < u_hi) PARTIAL_LOCATE(u_lo, nbin, nchunk, ne)
#pragma clang loop unroll(disable)
    for (int u = u_lo; u < u_hi; ++u) {
        const int lane = lane_now(), r = lane & 31, hg = lane >> 5, tid = F.wave * 64 + lane;
        const LAS unsigned char* kb = F.lds + RING_OFF + r * KROW + hg * 16; const LAS unsigned char* vb = F.lds + RING_OFF + KBUF_BYTES + r * VROW + hg * 16;
        TSTART(41);
        const int bin = nbin, chunk = nchunk, e = ne;
        { const int un = (u + 1 < u_hi) ? u + 1 : u; PARTIAL_LOCATE(un, nbin, nchunk, ne) }
        const int h = bin >> 6, j = bin & 63, n = __builtin_amdgcn_readfirstlane(tabn[bin]);
        const int base = chunk * 256 + F.wave * 32; const bool active = base < n, valid = base + r < n;
        const int t = e >> 2, sl = e & 3;
        const GAS bf16x8* qp = (const GAS bf16x8*)(F.ws + WS_Q) + ((size_t)t * 1024 + h * 128) / 8 + hg;
        bf16x8 qf[8];
#pragma unroll
        for (int kk = 0; kk < 8; ++kk) qf[kk] = qp[2 * kk];
        TSTOP(41); TSTART(42);
        if (bin != staged) {
            __syncthreads();
            stage_kv(F, h, j, tid);
            __syncthreads();
            staged = bin; }
        TSTOP(42);
        if (active) {
            f32x16 O[4]; float ms, ls;
            TSTART(43);
            moba_tile<false>(qf, kb, vb, 8, r, hg, O, ms, ls);
            TSTOP(43); TSTART(44);
            if (valid) { const size_t idx = ((size_t)h * S + t) * 3 + sl; const float inv = 1.0f / ls;
                GAS v2u* po = (GAS v2u*)(F.ws + WS_PO) + idx * 32 + hg;
#pragma unroll
                for (int dt = 0; dt < 4; ++dt)
#pragma unroll
                    for (int g4 = 0; g4 < 4; ++g4) po[dt * 8 + 2 * g4] = (v2u){cvtpk(O[dt][4 * g4] * inv, O[dt][4 * g4 + 1] * inv), cvtpk(O[dt][4 * g4 + 2] * inv, O[dt][4 * g4 + 3] * inv)};
                if (hg == 0) ((GAS f32x2*)(F.ws + WS_PML))[idx] = (f32x2){ms, ls}; }
            TSTOP(44);
        }
    }
#undef PARTIAL_LOCATE
}
__device__ __forceinline__ void own_phase(Frame& F) {
#pragma clang loop unroll(disable)
    for (int u = blockIdx.x; u < NBLK * NH; u += F.G) { const int h = u & 7, b = u >> 3, qt = F.wave;
        const int lane = lane_now(), r = lane & 31, hg = lane >> 5, tid = F.wave * 64 + lane;
        const LAS unsigned char* kb = F.lds + RING_OFF + r * KROW + hg * 16; const LAS unsigned char* vb = F.lds + RING_OFF + KBUF_BYTES + r * VROW + hg * 16;
        const int t = b * 256 + qt * 32 + r;
        const GAS bf16x8* qp = (const GAS bf16x8*)(F.ws + WS_Q) + ((size_t)t * 1024 + h * 128) / 8 + hg;
        bf16x8 qf[8];
#pragma unroll
        for (int kk = 0; kk < 8; ++kk) qf[kk] = qp[2 * kk];
        __syncthreads();
        stage_kv(F, h, b, tid);
        __syncthreads();
        f32x16 O[4]; float ms, ls;
        moba_tile<true>(qf, kb, vb, qt + 1, r, hg, O, ms, ls);
        __syncthreads();
        { LAS unsigned char* ow = F.lds + RING_OFF + F.wave * 8704;
          LAS f32x2* stq = (LAS f32x2*)(F.lds + RING_OFF + KBUF_BYTES) + F.wave * 32;
#pragma unroll
          for (int dt = 0; dt < 4; ++dt)
#pragma unroll
              for (int g4 = 0; g4 < 4; ++g4) *(LAS v2u*)(ow + r * 272 + (dt * 32 + 8 * g4 + 4 * hg) * 2) = (v2u){cvtpk(O[dt][4 * g4], O[dt][4 * g4 + 1]), cvtpk(O[dt][4 * g4 + 2], O[dt][4 * g4 + 3])};
          if (hg == 0) stq[r] = (f32x2){ms, ls};
          LDS_WAIT(); asm volatile("" ::: "memory");
          const int qq = lane >> 4, c = lane & 15, nv = b < 3 ? b : 3;
#pragma unroll
          for (int half = 0; half < 2; ++half) {
              v4u pv[4][3]; f32x2 pml[4][3];
#pragma unroll
              for (int pp = 0; pp < 4; ++pp) { const int q = 4 * (half * 4 + pp) + qq; const size_t idx0 = ((size_t)h * S + (b * 256 + qt * 32 + q)) * 3;
#pragma unroll
                  for (int s2 = 0; s2 < 3; ++s2) { const int so = s2 < nv ? s2 : 0;
                      pv[pp][s2] = ((const GAS v4u*)(F.ws + WS_PO))[(idx0 + so) * 16 + c]; pml[pp][s2] = ((const GAS f32x2*)(F.ws + WS_PML))[idx0 + so]; } }
#pragma unroll
              for (int pp = 0; pp < 4; ++pp) { const int q = 4 * (half * 4 + pp) + qq, t2 = b * 256 + qt * 32 + q;
                  const f32x2 own = stq[q]; const v4u ov = *(const LAS v4u*)(ow + q * 272 + c * 16);
                  float M = own.x;
#pragma unroll
                  for (int s2 = 0; s2 < 3; ++s2) { const bool have = s2 < nv; pml[pp][s2].x = have ? pml[pp][s2].x : -__builtin_inff(); pml[pp][s2].y = have ? pml[pp][s2].y : 0.f;
                      pv[pp][s2].x = have ? pv[pp][s2].x : 0u; pv[pp][s2].y = have ? pv[pp][s2].y : 0u; pv[pp][s2].z = have ? pv[pp][s2].z : 0u; pv[pp][s2].w = have ? pv[pp][s2].w : 0u;
                      M = fmaxf(M, pml[pp][s2].x); }
                  const float wo = __builtin_amdgcn_exp2f(own.x - M); float W = own.y * wo, w[3];
#pragma unroll
                  for (int s2 = 0; s2 < 3; ++s2) { w[s2] = pml[pp][s2].y * __builtin_amdgcn_exp2f(pml[pp][s2].x - M); W += w[s2]; }
                  float o[8] = {bflo(ov.x) * wo, bfhi(ov.x) * wo, bflo(ov.y) * wo, bfhi(ov.y) * wo, bflo(ov.z) * wo, bfhi(ov.z) * wo, bflo(ov.w) * wo, bfhi(ov.w) * wo};
#pragma unroll
                  for (int s2 = 0; s2 < 3; ++s2) { const v4u v = pv[pp][s2]; o[0] += w[s2] * bflo(v.x); o[1] += w[s2] * bfhi(v.x); o[2] += w[s2] * bflo(v.y); o[3] += w[s2] * bfhi(v.y); o[4] += w[s2] * bflo(v.z); o[5] += w[s2] * bfhi(v.z); o[6] += w[s2] * bflo(v.w); o[7] += w[s2] * bfhi(v.w); }
                  const float osc = ASC_CAT / W;
                  *(GAS v2u*)(F.ws + WS_CAT + (size_t)t2 * DM + h * 128 + 8 * c) = (v2u){pg8::pk4_fp8(o[0] * osc, o[1] * osc, o[2] * osc, o[3] * osc), pg8::pk4_fp8(o[4] * osc, o[5] * osc, o[6] * osc, o[7] * osc)}; }
          } }
    }
}

__device__ __forceinline__ void ln_phase(Frame& F, const float* xres_, const bf16* y_, const float* g_, const float* b_, const float* router, int q8  ) {
    const int gw = F.vcu * NWAVES + F.wave, lane = lane_now();
    f32x4 gv[8], bv[8];
#pragma unroll
    for (int j = 0; j < 8; ++j) { gv[j] = ((const GAS f32x4*)g_)[lane + 64 * j]; bv[j] = ((const GAS f32x4*)b_)[lane + 64 * j]; }
    f32x4 hraw[8]; v2u hraw16[8], yraw[8];
    { const GAS v2u* yp = (const GAS v2u*)(y_ + (size_t)(gw * 8) * DM) + lane;
      if (xres_) { const GAS f32x4* hp = (const GAS f32x4*)(xres_ + (size_t)(gw * 8) * DM) + lane;
#pragma unroll
          for (int j = 0; j < 8; ++j) hraw[j] = hp[64 * j]; }
      else { const GAS v2u* hp = (const GAS v2u*)(F.ws + WS_HB + (size_t)(gw * 8) * DM * 2) + lane;
#pragma unroll
          for (int j = 0; j < 8; ++j) hraw16[j] = hp[64 * j]; }
#pragma unroll
      for (int j = 0; j < 8; ++j) yraw[j] = yp[64 * j]; }
#pragma clang loop unroll(disable)
    for (int i = 0; i < S / (256 * NWAVES); ++i) { const int row = gw * (S / (256 * NWAVES)) + i;
        f32x4 v[8]; float s = 0.f;
#pragma unroll
        for (int j = 0; j < 8; ++j) { const v2u yv = yraw[j]; const f32x4 hv = xres_ ? hraw[j] : (f32x4){bflo(hraw16[j].x), bfhi(hraw16[j].x), bflo(hraw16[j].y), bfhi(hraw16[j].y)};
            v[j] = hv * ALPHA + (f32x4){bflo(yv.x), bfhi(yv.x), bflo(yv.y), bfhi(yv.y)}; s += (v[j][0] + v[j][1]) + (v[j][2] + v[j][3]); }
        { const int rown = (i + 1 < S / (256 * NWAVES)) ? row + 1 : row;
          const GAS v2u* yp = (const GAS v2u*)(y_ + (size_t)rown * DM) + lane;
            if (xres_) { const GAS f32x4* hp = (const GAS f32x4*)(xres_ + (size_t)rown * DM) + lane;
#pragma unroll
                for (int j = 0; j < 8; ++j) hraw[j] = hp[64 * j]; }
            else { const GAS v2u* hp = (const GAS v2u*)(F.ws + WS_HB + (size_t)rown * DM * 2) + lane;
#pragma unroll
                for (int j = 0; j < 8; ++j) hraw16[j] = hp[64 * j]; }
#pragma unroll
            for (int j = 0; j < 8; ++j) yraw[j] = yp[64 * j]; }
        const float mean = wave_sum(s, lane) * (1.f / DM); float s2 = 0.f;
#pragma unroll
        for (int j = 0; j < 8; ++j) { v[j] = v[j] - mean; s2 += (v[j][0] * v[j][0] + v[j][1] * v[j][1]) + (v[j][2] * v[j][2] + v[j][3] * v[j][3]); }
        const float rstd = 1.f / sqrtf(wave_sum(s2, lane) * (1.f / DM) + LN_EPS);
        GAS v2u* hb = (GAS v2u*)(F.ws + WS_HB + (size_t)row * DM * 2) + lane;
        float amax = 0.f;
#pragma unroll
        for (int j = 0; j < 8; ++j) { v[j] = v[j] * rstd * gv[j] + bv[j]; hb[64 * j] = (v2u){pk2(v[j][0], v[j][1]), pk2(v[j][2], v[j][3])};
            amax = fmaxf(fmaxf(amax, fmaxf(fabsf(v[j][0]), fabsf(v[j][1]))), fmaxf(fabsf(v[j][2]), fabsf(v[j][3])));
            if (q8 == 1) ((GAS unsigned*)(F.ws + WS_HB8 + (size_t)row * DM))[64 * j + lane] = pg8::pk4_fp8(v[j][0] * ASC_H, v[j][1] * ASC_H, v[j][2] * ASC_H, v[j][3] * ASC_H); }
        if (q8 == 2) { amax = fmaxf(wave_max(amax, lane), 1e-20f); const float qs = 127.f / amax;
#pragma unroll
            for (int j = 0; j < 8; ++j) ((GAS unsigned*)(F.ws + WS_HB8 + (size_t)row * DM))[64 * j + lane] = pg8::pk4_i8(v[j][0] * qs, v[j][1] * qs, v[j][2] * qs, v[j][3] * qs);
            if (lane == 0) ((GAS float*)(F.ws + WS_RSC))[row] = amax * (1.f / 127.f); }
    }
}
typedef float f32x4r __attribute__((ext_vector_type(4)));
__device__ __forceinline__ void router_phase(Frame& F) {
    const int lane = lane_now(), rr = lane & 15, kg = lane >> 4, w = F.wave;
    LAS float* lg = (LAS float*)(F.lds + RING_OFF);
    const GAS bf16x8* bp = (const GAS bf16x8*)(F.ws + WS_RWT) + ((size_t)(rr & 7) * DM + 256 * w) / 8 + kg;
    const bool colok = rr < 8;
    bf16x8 bh[8], bl[8], af[4][8];
#pragma unroll
    for (int kk = 0; kk < 8; ++kk) { bh[kk] = bp[4 * kk]; bl[kk] = bp[4 * kk + NE * DM / 8]; }
#pragma unroll
    for (int g = 0; g < 4; ++g) { const int row0 = ((int)blockIdx.x + F.G * g) * 16; const GAS bf16x8* ap = (const GAS bf16x8*)(F.ws + WS_HB) + ((size_t)(row0 + rr) * DM + 256 * w) / 8 + kg;
#pragma unroll
        for (int kk = 0; kk < 8; ++kk) af[g][kk] = ap[4 * kk]; }
    if (!colok) {
#pragma unroll
        for (int kk = 0; kk < 8; ++kk) { bh[kk] = (bf16x8){0, 0, 0, 0, 0, 0, 0, 0}; bl[kk] = bh[kk]; } }
#pragma unroll
    for (int g = 0; g < 4; ++g) { f32x4r acc = {0.f, 0.f, 0.f, 0.f};
#pragma unroll
        for (int kk = 0; kk < 8; ++kk) { acc = __builtin_amdgcn_mfma_f32_16x16x32_bf16(af[g][kk], bh[kk], acc, 0, 0, 0); acc = __builtin_amdgcn_mfma_f32_16x16x32_bf16(af[g][kk], bl[kk], acc, 0, 0, 0); }
        if (colok) {
#pragma unroll
            for (int i = 0; i < 4; ++i) lg[((g * 8 + w) * 16 + 4 * kg + i) * 8 + rr] = acc[i]; } }
    __syncthreads();
    if (w == 0) { const int g = lane >> 4, r = lane & 15; float v[8] = {0.f, 0.f, 0.f, 0.f, 0.f, 0.f, 0.f, 0.f};
#pragma unroll
        for (int ww = 0; ww < 8; ++ww) { const f32x4r l0 = *(const LAS f32x4r*)(lg + ((g * 8 + ww) * 16 + r) * 8), l1 = *(const LAS f32x4r*)(lg + ((g * 8 + ww) * 16 + r) * 8 + 4);
            v[0] += l0[0]; v[1] += l0[1]; v[2] += l0[2]; v[3] += l0[3]; v[4] += l1[0]; v[5] += l1[1]; v[6] += l1[2]; v[7] += l1[3]; }
        float v1 = v[0]; int i1 = 0;
#pragma unroll
        for (int e = 1; e < 8; ++e) if (v[e] > v1) { v1 = v[e]; i1 = e; }
        float v2 = -__builtin_inff(); int i2 = -1;
#pragma unroll
        for (int e = 0; e < 8; ++e) if (e != i1 && v[e] > v2) { v2 = v[e]; i2 = e; }
        const float g1 = 1.0f / (1.0f + __expf(v2 - v1)), g2 = 1.0f - g1; const int row = ((int)blockIdx.x + F.G * g) * 16 + r;
        ((GAS int*)(F.ws + WS_EIDX))[row * 2] = i1; ((GAS int*)(F.ws + WS_EIDX))[row * 2 + 1] = i2; ((GAS float*)(F.ws + WS_GATEW))[row * 2] = g1; ((GAS float*)(F.ws + WS_GATEW))[row * 2 + 1] = g2;
        int mine = 0;
#pragma unroll
        for (int e = 0; e < 8; ++e) { const int c = __builtin_popcountll(__ballot(i1 == e)) + __builtin_popcountll(__ballot(i2 == e)); mine = (lane == e) ? c : mine; }
        if (lane < 8 && mine) __hip_atomic_fetch_add(F.ctl + CW_ECNT + 64 * lane, (unsigned)mine, RLX_AGENT); }
    __syncthreads();
}
__device__ __forceinline__ void load_expert_layout(Frame& F, int (&off)[8], int (&cum)[8], int& npanels) {
    const int lane = lane_now();
    const int cv = (int)__hip_atomic_load(F.ctl + CW_ECNT + 64 * (lane & 7), RLX_AGENT);
    int o = 0;
#pragma unroll
    for (int e = 0; e < 8; ++e) { const int c = __builtin_amdgcn_readlane(cv, e); off[e] = o; cum[e] = o >> 8; o += (c + 255) & ~255; }
    npanels = o >> 8;
}
__device__ __forceinline__ void route_phase(Frame& F) {
    const int gw = F.vcu * NWAVES + F.wave, lane = lane_now();
    int off[8], cum[8], np; load_expert_layout(F, off, cum, np);
    const int row = gw * 8 + (lane >> 1), slot = lane & 1; const bool act = lane < 16;
    const int mye = act ? ((const GAS int*)(F.ws + WS_EIDX))[row * 2 + slot] : -1;
    int pos = 0;
#pragma unroll
    for (int e = 0; e < 8; ++e) { const unsigned long long mask = __ballot(mye == e);
        if (mask) { const int leader = __builtin_ctzll(mask), n = __builtin_popcountll(mask); unsigned b = 0u;
            if (lane == leader) b = __hip_atomic_fetch_add(F.ctl + CW_ECUR + 64 * e, (unsigned)n, RLX_AGENT);
            b = (unsigned)shl_i((int)b, leader);
            if (mye == e) pos = off[e] + (int)b + __builtin_popcountll(mask & ((1ull << lane) - 1ull)); } }
    if (act) ((GAS int*)(F.ws + WS_ROWPOS))[row * 2 + slot] = pos;
#pragma clang loop unroll(disable)
    for (int k0 = 0; k0 < 16; k0 += 8) {
        v4u t[8][2];
#pragma unroll
        for (int k = 0; k < 8; ++k) { const int r = gw * 8 + ((k0 + k) >> 1); const GAS v4u* src = (const GAS v4u*)(F.ws + WS_HB8 + (size_t)r * DM) + lane; t[k][0] = src[0]; t[k][1] = src[64]; }
#pragma unroll
        for (int k = 0; k < 8; ++k) { const int p = __builtin_amdgcn_readfirstlane(shl_i(pos, k0 + k)); GAS v4u* dst = (GAS v4u*)(F.ws + WS_HBP + (size_t)p * DM) + lane; dst[0] = t[k][0]; dst[64] = t[k][1]; }
    }
}
__device__ __forceinline__ void ln_moe_phase(Frame& F, const float* g_, const float* b_) {
    const int gw = F.vcu * NWAVES + F.wave, lane = lane_now();
    f32x4 gv[8], bv[8];
#pragma unroll
    for (int j = 0; j < 8; ++j) { gv[j] = ((const GAS f32x4*)g_)[lane + 64 * j]; bv[j] = ((const GAS f32x4*)b_)[lane + 64 * j]; }
    int mp1 = 0, mp2 = 0; float mg1 = 0.f, mg2 = 0.f;
    if (lane < 8) { const int rr = gw * 8 + lane; mp1 = ((const GAS int*)(F.ws + WS_ROWPOS))[rr * 2]; mp2 = ((const GAS int*)(F.ws + WS_ROWPOS))[rr * 2 + 1]; mg1 = ((const GAS float*)(F.ws + WS_GATEW))[rr * 2]; mg2 = ((const GAS float*)(F.ws + WS_GATEW))[rr * 2 + 1]; }
    v2u hraw[8], araw[8], braw[8];
    { const int p1 = __builtin_amdgcn_readlane(mp1, 0), p2 = __builtin_amdgcn_readlane(mp2, 0);
      const GAS v2u* hp = (const GAS v2u*)(F.ws + WS_HB + (size_t)(gw * 8) * DM * 2) + lane;
      const GAS v2u* y1 = (const GAS v2u*)(F.ws + WS_R2 + (size_t)p1 * DM * 2) + lane; const GAS v2u* y2 = (const GAS v2u*)(F.ws + WS_R2 + (size_t)p2 * DM * 2) + lane;
#pragma unroll
      for (int j = 0; j < 8; ++j) { hraw[j] = hp[64 * j]; araw[j] = y1[64 * j]; braw[j] = y2[64 * j]; } }
#pragma clang loop unroll(disable)
    for (int i = 0; i < 8; ++i) { const int row = gw * 8 + i;
        const float g1 = __builtin_bit_cast(float, shl_i(__builtin_bit_cast(int, mg1), i)), g2 = __builtin_bit_cast(float, shl_i(__builtin_bit_cast(int, mg2), i));
        f32x4 v[8]; float s = 0.f;
#pragma unroll
        for (int j = 0; j < 8; ++j) { const v2u a = araw[j], b = braw[j];
            const f32x4 fa = (f32x4){bflo(a.x), bfhi(a.x), bflo(a.y), bfhi(a.y)}, fb = (f32x4){bflo(b.x), bfhi(b.x), bflo(b.y), bfhi(b.y)};
            v[j] = (f32x4){bflo(hraw[j].x), bfhi(hraw[j].x), bflo(hraw[j].y), bfhi(hraw[j].y)} * ALPHA + fa * g1 + fb * g2; s += (v[j][0] + v[j][1]) + (v[j][2] + v[j][3]); }
        { const int in = (i + 1 < 8) ? i + 1 : i; const int p1 = __builtin_amdgcn_readfirstlane(shl_i(mp1, in)), p2 = __builtin_amdgcn_readfirstlane(shl_i(mp2, in));
            const GAS v2u* hp = (const GAS v2u*)(F.ws + WS_HB + (size_t)(gw * 8 + in) * DM * 2) + lane;
            const GAS v2u* y1 = (const GAS v2u*)(F.ws + WS_R2 + (size_t)p1 * DM * 2) + lane; const GAS v2u* y2 = (const GAS v2u*)(F.ws + WS_R2 + (size_t)p2 * DM * 2) + lane;
#pragma unroll
            for (int j = 0; j < 8; ++j) { hraw[j] = hp[64 * j]; araw[j] = y1[64 * j]; braw[j] = y2[64 * j]; } }
        const float mean = wave_sum(s, lane) * (1.f / DM); float s2 = 0.f;
#pragma unroll
        for (int j = 0; j < 8; ++j) { v[j] = v[j] - mean; s2 += (v[j][0] * v[j][0] + v[j][1] * v[j][1]) + (v[j][2] * v[j][2] + v[j][3] * v[j][3]); }
        const float rstd = 1.f / sqrtf(wave_sum(s2, lane) * (1.f / DM) + LN_EPS);
        GAS f32x4* op = (GAS f32x4*)(F.out + (size_t)row * DM) + lane;
#pragma unroll
        for (int j = 0; j < 8; ++j) op[64 * j] = v[j] * rstd * gv[j] + bv[j];
    }
}

struct Args { const float* in[18]; float* out; unsigned char* ws; };
__global__ void __launch_bounds__(NWAVES * 64, 2) hymba_fwd(Args args) {
    extern __shared__ __attribute__((aligned(16))) unsigned char lds[];
    Frame F;
    F.lds = (LAS unsigned char*)lds;
    F.MISC = (volatile LAS unsigned*)(F.lds + MISC_OFF);
    F.wave = __builtin_amdgcn_readfirstlane((int)threadIdx.x >> 6);
    F.G = gridDim.x; { const int bx = blockIdx.x; F.vcu = (F.G % 8 == 0) ? (bx % 8) * (F.G / 8) + bx / 8 : bx; }
    F.ws = args.ws; F.ctl = (gu32*)(args.ws + WS_CTL);
    F.x = args.in[0]; F.w_in = args.in[1]; F.conv_w = args.in[2]; F.conv_b = args.in[3]; F.conv_g = args.in[4]; F.conv_be = args.in[5]; F.w_out = args.in[6];
    F.lnm_g = args.in[7]; F.lnm_b = args.in[8]; F.lnf_g = args.in[9]; F.lnf_b = args.in[10]; F.fg = args.in[11]; F.fu = args.in[12]; F.fd = args.in[13];
    F.router = args.in[14]; F.eg = args.in[15]; F.eu = args.in[16]; F.ed = args.in[17]; F.out = args.out;
    for (int u = threadIdx.x; u < (LDS_BYTES - LDSCTL_OFF) / 4; u += NWAVES * 64) ((LAS unsigned*)(F.lds + LDSCTL_OFF))[u] = 0u;
    __syncthreads();
    XcdBarrier bar = xcd_barrier_post((unsigned*)(F.ctl + CW_BAR), F.MISC + 8, F.wave);
#define LAUNDER() asm volatile("" : "+s"(F.ws), "+s"(F.ctl), "+s"(F.out), "+s"(F.x), "+s"(bar.bar), "+s"(F.wave))
#define GRID_BAR_N(k) do { LAUNDER(); TSTART(200); TSTART(200 + (k)); xcd_barrier(bar); TSTOP(200); TSTOP(200 + (k)); LAUNDER(); } while (0)
#define GRID_BAR() GRID_BAR_N(99)
#ifndef PROBE_ID
#define PROBE_ID 0
#endif
    F.tacc = 0ull; F.tt0 = 0ull;
#define HB ((bf16*)(F.ws + WS_HB))
#define Y ((bf16*)(F.ws + WS_R2))

    TSTART(10); p0_prologue(F); TSTOP(10);
    GRID_BAR_N(1);

#pragma clang loop unroll(disable)
    for (int l = 0; l < 2; ++l) {
#ifndef NO_G_INPROJ
        TSTART(11);
        { pg8::Gemm g{(const bf16*)(F.ws + WS_HB8), (const bf16*)(F.ws + WS_WIN + (size_t)l * 20 * MiB), S, 3072, DM / 2, 0}; pg8::StaticOrder So; So.init(S, 3072, F.G, (int)blockIdx.x);
          pg8::EpiInProj E{(bf16*)(F.ws + WS_Q), (bf16*)(F.ws + WS_K), (bf16*)(F.ws + WS_V), (bf16*)(F.ws + WS_U), (const float*)(F.ws + WS_ROPEC), (const float*)(F.ws + WS_ROPES), 1.0f / (WSC_GU * ASC_H), 0};
          pg8::gemm_phase<pg8::EpiInProj, pg8::StaticOrder, true, true, true>(F.lds + RING_OFF, g, So, E, F.wave); }
        { pg8::Gemm g{HB, (const bf16*)(F.ws + WS_WIN + (size_t)l * 20 * MiB + 8 * MiB), S, 2048, DM, 0}; pg8::StaticOrder So; So.init(S, 2048, F.G, (int)blockIdx.x);
          pg8::EpiInProj E{(bf16*)(F.ws + WS_Q), (bf16*)(F.ws + WS_K), (bf16*)(F.ws + WS_V), (bf16*)(F.ws + WS_U), (const float*)(F.ws + WS_ROPEC), (const float*)(F.ws + WS_ROPES), 1.0f, 12};
          pg8::gemm_phase<pg8::EpiInProj, pg8::StaticOrder, true, true, false>(F.lds + RING_OFF, g, So, E, F.wave); }
        TSTOP(11);
#endif
        GRID_BAR_N(2);
        TSTART(1); kmean_phase(F); TSTOP(1);
        TSTART(2); vt_phase(F); TSTOP(2);
        __syncthreads();
        TSTART(3); conv_phase(F, l); TSTOP(3);
        GRID_BAR_N(3);
        TSTART(4); sel_phase(F, l); TSTOP(4);
        GRID_BAR_N(4);
        TSTART(51); TSTART(5); partial_phase(F, l); TSTOP(5);
        steal_point(F, 5 * 2 + l); GRID_BAR_N(5); TSTOP(51);
        TSTART(52); TSTART(6); own_phase(F); TSTOP(6);
        GRID_BAR_N(6); TSTOP(52);
#ifndef NO_G_OUTPROJ
        TSTART(12);
        { pg8::Gemm g{(const bf16*)(F.ws + WS_CAT), (const bf16*)(F.ws + WS_WOUT + (size_t)l * DM * DM), S, DM, DM / 2, 0}; pg8::StaticOrder So; So.init(S, DM, F.G, (int)blockIdx.x);
          pg8::EpiBf16 E{Y, DM, 1.0f / (WSC_O * ASC_CAT)};
          pg8::gemm_phase<pg8::EpiBf16, pg8::StaticOrder, true, true, true>(F.lds + RING_OFF, g, So, E, F.wave); }
        TSTOP(12);
#endif
        GRID_BAR_N(7);
        TSTART(7); ln_phase(F, nullptr, Y, F.lnm_g + l * DM, F.lnm_b + l * DM, l == 1 ? F.router : nullptr, l == 1 ? 1 : 2); TSTOP(7);
        GRID_BAR_N(8);
        if (l == 0) {
#ifndef NO_G_FFNGU
        TSTART(13); unsigned long long ck1 = (PROBE_ID == 313) ? (unsigned long long)clock64() : 0ull;
            { pg8::Gemm g{(const bf16*)(F.ws + WS_HB8), (const bf16*)(F.ws + WS_WGU0), S, 2 * DFF, DM / 2, 0}; pg8::StaticOrder So; So.init(S, 2 * DFF, F.G, (int)blockIdx.x);
              pg8::EpiSwiGLUq E{(bf16*)(F.ws + WS_ACT), DFF, (const float*)(F.ws + WS_RSC), 1.0f / WQ_GU};
              pg8::gemm_phase<pg8::EpiSwiGLUq, pg8::StaticOrder, true, true, false, true>(F.lds + RING_OFF, g, So, E, F.wave); }
        TSTOP(13); if (PROBE_ID == 313) F.tacc += ((unsigned long long)clock64() - ck1) >> 8;
#endif
            GRID_BAR_N(9);
#ifndef NO_G_FFND
        TSTART(14);
            { pg8::Gemm g{(const bf16*)(F.ws + WS_ACT), (const bf16*)(F.ws + WS_WD0), S, DM, DFF, 0}; pg8::StaticOrder So; So.init(S, DM, F.G, (int)blockIdx.x);
              pg8::EpiBf16 E{Y, DM, 1.0f};
              pg8::gemm_phase<pg8::EpiBf16, pg8::StaticOrder, true, true>(F.lds + RING_OFF, g, So, E, F.wave); }
        TSTOP(14);
#endif
            GRID_BAR_N(10);
            TSTART(7); ln_phase(F, nullptr, Y, F.lnf_g, F.lnf_b, nullptr, 1); TSTOP(7);
            GRID_BAR_N(11);
        } else {
            TSTART(17); router_phase(F); TSTOP(17);
            GRID_BAR_N(12);
            TSTART(8); route_phase(F); TSTOP(8);
            steal_drain(F); GRID_BAR_N(13);
            int off[8], cum[8], np; load_expert_layout(F, off, cum, np);
#ifndef NO_G_MOEGU
        TSTART(15); unsigned long long ck0 = (PROBE_ID == 315) ? (unsigned long long)clock64() : 0ull;
            { pg8::Gemm g{(const bf16*)(F.ws + WS_HBP), (const bf16*)(F.ws + WS_WGUE), np * 256, 2 * DFF, DM / 2, (size_t)2 * DFF * DM}; pg8::GroupedOrder So; So.init(np * 256, 2 * DFF, F.G, (int)blockIdx.x);
#pragma unroll
              for (int e = 0; e < 8; ++e) So.cum[e] = cum[e];
              pg8::EpiSwiGLU8 E{F.ws + WS_ACT, DFF, 1.0f / (WSC_GU * ASC_H), ASC_ACT};
              pg8::gemm_phase<pg8::EpiSwiGLU8, pg8::GroupedOrder, true, true, true>(F.lds + RING_OFF, g, So, E, F.wave); }
        TSTOP(15); if (PROBE_ID == 315) F.tacc += ((unsigned long long)clock64() - ck0) >> 8;
#endif
            GRID_BAR_N(14);
#ifndef NO_G_MOED
        TSTART(16);
            { pg8::Gemm g{(const bf16*)(F.ws + WS_ACT), (const bf16*)(F.ws + WS_WDE), np * 256, DM, DFF / 2, (size_t)DM * DFF}; pg8::GroupedOrder So; So.init(np * 256, DM, F.G, (int)blockIdx.x);
#pragma unroll
              for (int e = 0; e < 8; ++e) So.cum[e] = cum[e];
              pg8::EpiBf16 E{(bf16*)(F.ws + WS_R2), DM, 1.0f / (WSC_D * ASC_ACT)};
              pg8::gemm_phase<pg8::EpiBf16, pg8::GroupedOrder, true, true, true>(F.lds + RING_OFF, g, So, E, F.wave); }
        TSTOP(16);
#endif
            GRID_BAR_N(15);
            TSTART(9); ln_moe_phase(F, F.lnf_g + DM, F.lnf_b + DM); TSTOP(9);
        }
    }
    if (PROBE_ID != 0 && blockIdx.x == PROBE_WG && F.wave == 0) { const unsigned long long t1 = __builtin_amdgcn_s_memrealtime(); while (__builtin_amdgcn_s_memrealtime() - t1 < 16ull * F.tacc) __builtin_amdgcn_s_sleep(8); }
#undef GRID_BAR
#undef LAUNDER
#undef HB
#undef Y
}

extern "C" void kernel_launch(void* const* d_in, const int* in_sizes, int n_in, void* d_out, int out_size, void* d_ws, size_t ws_size, hipStream_t stream) {
    static int grid = 0;
    if (grid == 0) {
        if (n_in != 18 || in_sizes[0] != S * DM || out_size != S * DM || ws_size < WS_END) { fprintf(stderr, "kernel_launch: unexpected shapes (n_in %d, in0 %d, out %d, ws %zu < %zu); nothing launched\n", n_in, n_in > 0 ? in_sizes[0] : -1, out_size, ws_size, (size_t)WS_END); grid = -1; return; }
        int dev = 0, cus = 0, per_cu = 0;
        if (hipGetDevice(&dev) != hipSuccess || hipDeviceGetAttribute(&cus, hipDeviceAttributeMultiprocessorCount, dev) != hipSuccess) { grid = -1; return; }
        if (hipFuncSetAttribute((const void*)hymba_fwd, hipFuncAttributeMaxDynamicSharedMemorySize, LDS_BYTES) != hipSuccess) { fprintf(stderr, "kernel_launch: hipFuncSetAttribute failed\n"); grid = -1; return; }
        if (hipOccupancyMaxActiveBlocksPerMultiprocessor(&per_cu, (const void*)hymba_fwd, NWAVES * 64, LDS_BYTES) != hipSuccess || per_cu < 1)
            fprintf(stderr, "kernel_launch: note: occupancy query reports %d workgroups per CU\n", per_cu);
        (void)hipGetLastError();
        grid = cus;
        if (grid != 256) { fprintf(stderr, "kernel_launch: built for 256 CUs, device has %d; nothing launched\n", cus); grid = -1; return; }
    }
    if (grid < 0) return;
    if (hipMemsetAsync((char*)d_ws + WS_CTL, 0, CTL_ZERO_BYTES, stream) != hipSuccess) return;
    Args a{};
    for (int i = 0; i < 18; ++i) a.in[i] = (const float*)d_in[i];
    a.out = (float*)d_out; a.ws = (unsigned char*)d_ws;
    hipLaunchKernelGGL(hymba_fwd, dim3(grid), dim3(NWAVES * 64), LDS_BYTES, stream, a);
}
```

```cpp
#include <hip/hip_runtime.h>
#include <cstdio>
#include <cstdint>
#include <cmath>
namespace pg8 {
#define PG8_LAS __attribute__((address_space(3)))
typedef unsigned short bf16_t;
typedef short bf16x8 __attribute__((ext_vector_type(8)));
typedef float f32x4 __attribute__((ext_vector_type(4)));
typedef unsigned u32x4 __attribute__((ext_vector_type(4)));
typedef unsigned u32x2 __attribute__((ext_vector_type(2)));
typedef int v8i __attribute__((ext_vector_type(8)));
typedef int v4i __attribute__((ext_vector_type(4)));
constexpr int BM = 256, BK = 64, HALF = 128, HTB = HALF * BK * 2  , STAGE_BYTES = 8 * HTB, NXCD = 8, WGM = 8;

__host__ __device__ __forceinline__ int lds_byte(int r, int c) { const int st = (r >> 4) * 2 + (c >> 5), rr = r & 15, cc = c & 31, ob = rr * 64 + cc * 2; return st * 1024 + (ob ^ (((ob >> 9) & 1) << 5)); }
__host__ __device__ __forceinline__ void stage_rc(int b, int& R, int& C) { const int st = b / 1024, sb = b % 1024, swz = sb ^ (((sb >> 9) & 1) << 5); R = (st >> 1) * 16 + swz / 64; C = (st & 1) * 32 + (swz % 64) / 2; }
__host__ __device__ __forceinline__ int perm32(int rho) { const int n = rho >> 4, i = rho & 15; return 8 * (i >> 2) + 4 * n + (i & 3); }

struct Unit { int pm, pn, e; };
struct Gemm { const bf16_t* A; const bf16_t* Bt; int M, N, K; size_t bstride; };

struct StaticOrder {
    int nM, nN, nwg, G, c;
    __host__ __device__ void init(int M, int N, int G_, int c_) { nM = M / BM; nN = N / BM; nwg = nM * nN; G = G_; c = c_; }
    __host__ __device__ bool next(int i, Unit& u) const {
        const long L = (long)i * G + c; if (L >= nwg) return false;
        int wgid = (int)L; { const int q = nwg / NXCD, r = nwg % NXCD, xcd = wgid % NXCD, off = wgid / NXCD; wgid = (xcd < r ? xcd * (q + 1) : r * (q + 1) + (xcd - r) * q) + off; }
        const int nig = WGM * nN, gid = wgid / nig, fm = gid * WGM, gsz = (nM - fm) < WGM ? (nM - fm) : WGM;
        u.pm = fm + ((wgid % nig) % gsz); u.pn = (wgid % nig) / gsz; u.e = 0; return true;
    }
    __device__ __forceinline__ void a_ready(const Unit&) const {}
    __device__ __forceinline__ void done(const Unit&) const {}
};
struct GroupedOrder : StaticOrder {
    int cum[8];
    __device__ bool next(int i, Unit& u) const {
        if (!StaticOrder::next(i, u)) return false;
        int e = 0;
#pragma unroll
        for (int j = 1; j < 8; ++j) e += (u.pm >= cum[j]) ? 1 : 0;
        u.e = e; return true;
    }
};

__device__ __forceinline__ unsigned cvt_pk_bf16(float lo, float hi) { unsigned r; asm volatile("v_cvt_pk_bf16_f32 %0, %1, %2" : "=v"(r) : "v"(lo), "v"(hi)); return r; }
__device__ __forceinline__ float sigmoidf_fast(float g) { return __builtin_amdgcn_rcpf(1.0f + __builtin_amdgcn_exp2f(-1.44269504089f * g)); }

__device__ __forceinline__ unsigned pk4_fp8(float a, float b, float c, float d) {
    unsigned w = 0u; w = __builtin_amdgcn_cvt_pk_fp8_f32(__builtin_amdgcn_fmed3f(a, -448.f, 448.f), __builtin_amdgcn_fmed3f(b, -448.f, 448.f), w, false);
    return __builtin_amdgcn_cvt_pk_fp8_f32(__builtin_amdgcn_fmed3f(c, -448.f, 448.f), __builtin_amdgcn_fmed3f(d, -448.f, 448.f), w, true); }
__device__ __forceinline__ unsigned pk4_i8(float a, float b, float c, float d) {
    const int ia = (int)__builtin_rintf(__builtin_amdgcn_fmed3f(a, -127.f, 127.f)), ib = (int)__builtin_rintf(__builtin_amdgcn_fmed3f(b, -127.f, 127.f));
    const int ic = (int)__builtin_rintf(__builtin_amdgcn_fmed3f(c, -127.f, 127.f)), id = (int)__builtin_rintf(__builtin_amdgcn_fmed3f(d, -127.f, 127.f));
    return (unsigned)(ia & 255) | ((unsigned)(ib & 255) << 8) | ((unsigned)(ic & 255) << 16) | ((unsigned)id << 24); }
struct EpiF32 {
    static constexpr bool PERM = false, AFTER_DRAIN = false;
    float* C; int ldc;
    __device__ __forceinline__ void operator()(const f32x4 (&acc)[2][2][4][2], const Unit& u, int wr, int wc, int fr, int fq) const {
        const int row0 = u.pm * BM + wr * 64 + fr, col0 = u.pn * BM + wc * 32 + 4 * fq;
#pragma unroll
        for (int ai = 0; ai < 2; ++ai)
#pragma unroll
            for (int m = 0; m < 4; ++m) { float* rowp = C + (size_t)(row0 + ai * HALF + m * 16) * ldc + col0;
#pragma unroll
                for (int bj = 0; bj < 2; ++bj)
#pragma unroll
                    for (int n = 0; n < 2; ++n) *(f32x4*)(rowp + bj * HALF + n * 16) = acc[ai][bj][m][n]; }
    }
};
struct EpiBf16 {
    static constexpr bool PERM = true, AFTER_DRAIN = false;
    bf16_t* O; int ldc; float sc;
    __device__ __forceinline__ void operator()(const f32x4 (&acc)[2][2][4][2], const Unit& u, int wr, int wc, int fr, int fq) const {
        const int row0 = u.pm * BM + wr * 64 + fr, col0 = u.pn * BM + wc * 32 + 8 * fq;
#pragma unroll
        for (int ai = 0; ai < 2; ++ai)
#pragma unroll
            for (int m = 0; m < 4; ++m) { bf16_t* rowp = O + (size_t)(row0 + ai * HALF + m * 16) * ldc + col0;
#pragma unroll
                for (int bj = 0; bj < 2; ++bj) { const f32x4 v0 = acc[ai][bj][m][0] * sc, v1 = acc[ai][bj][m][1] * sc;
                    u32x4 w; w.x = cvt_pk_bf16(v0[0], v0[1]); w.y = cvt_pk_bf16(v0[2], v0[3]); w.z = cvt_pk_bf16(v1[0], v1[1]); w.w = cvt_pk_bf16(v1[2], v1[3]);
                    *(u32x4*)(rowp + bj * HALF) = w; } }
    }
};
struct EpiSwiGLU {
    static constexpr bool PERM = true, AFTER_DRAIN = false;
    bf16_t* O; int ldc;
    __device__ __forceinline__ void operator()(const f32x4 (&acc)[2][2][4][2], const Unit& u, int wr, int wc, int fr, int fq) const {
        const int row0 = u.pm * BM + wr * 64 + fr, col0 = u.pn * HALF + wc * 32 + 8 * fq;
#pragma unroll
        for (int ai = 0; ai < 2; ++ai)
#pragma unroll
            for (int m = 0; m < 4; ++m) { bf16_t* rowp = O + (size_t)(row0 + ai * HALF + m * 16) * ldc + col0;
                float o[8];
#pragma unroll
                for (int n = 0; n < 2; ++n)
#pragma unroll
                    for (int j = 0; j < 4; ++j) { const float g = acc[ai][0][m][n][j], up = acc[ai][1][m][n][j]; o[n * 4 + j] = g * sigmoidf_fast(g) * up; }
                u32x4 w; w.x = cvt_pk_bf16(o[0], o[1]); w.y = cvt_pk_bf16(o[2], o[3]); w.z = cvt_pk_bf16(o[4], o[5]); w.w = cvt_pk_bf16(o[6], o[7]);
                *(u32x4*)rowp = w; }
    }
};
struct EpiSwiGLUq {
    static constexpr bool PERM = true, AFTER_DRAIN = false;
    bf16_t* O; int ldc; const float* rs; float ws;
    __device__ __forceinline__ void operator()(const f32x4 (&acc)[2][2][4][2], const Unit& u, int wr, int wc, int fr, int fq) const {
        const int row0 = u.pm * BM + wr * 64 + fr, col0 = u.pn * HALF + wc * 32 + 8 * fq;
#pragma unroll
        for (int ai = 0; ai < 2; ++ai)
#pragma unroll
            for (int m = 0; m < 4; ++m) { const int row = row0 + ai * HALF + m * 16; bf16_t* rowp = O + (size_t)row * ldc + col0; const float sc = rs[row] * ws;
                float o[8];
#pragma unroll
                for (int n = 0; n < 2; ++n)
#pragma unroll
                    for (int j = 0; j < 4; ++j) { const float g = acc[ai][0][m][n][j] * sc, up = acc[ai][1][m][n][j] * sc; o[n * 4 + j] = g * sigmoidf_fast(g) * up; }
                u32x4 w; w.x = cvt_pk_bf16(o[0], o[1]); w.y = cvt_pk_bf16(o[2], o[3]); w.z = cvt_pk_bf16(o[4], o[5]); w.w = cvt_pk_bf16(o[6], o[7]);
                *(u32x4*)rowp = w; }
    }
};
struct EpiSwiGLU8 {
    static constexpr bool PERM = true, AFTER_DRAIN = false;
    unsigned char* O; int ldc; float sin, sout; const float* rs;
    __device__ __forceinline__ void operator()(const f32x4 (&acc)[2][2][4][2], const Unit& u, int wr, int wc, int fr, int fq) const {
        const int row0 = u.pm * BM + wr * 64 + fr, col0 = u.pn * HALF + wc * 32 + 8 * fq;
#pragma unroll
        for (int ai = 0; ai < 2; ++ai)
#pragma unroll
            for (int m = 0; m < 4; ++m) { unsigned char* rowp = O + (size_t)(row0 + ai * HALF + m * 16) * ldc + col0; const float si = rs ? rs[row0 + ai * HALF + m * 16] * sin : sin;
                float o[8];
#pragma unroll
                for (int n = 0; n < 2; ++n)
#pragma unroll
                    for (int j = 0; j < 4; ++j) { const float g = acc[ai][0][m][n][j] * si, up = acc[ai][1][m][n][j] * si; o[n * 4 + j] = g * sigmoidf_fast(g) * up * sout; }
                u32x2 w; w.x = pk4_fp8(o[0], o[1], o[2], o[3]); w.y = pk4_fp8(o[4], o[5], o[6], o[7]);
                *(u32x2*)rowp = w; }
    }
};
struct EpiInProj {
    static constexpr bool PERM = true, AFTER_DRAIN = false;
    bf16_t *Q, *Kb, *V, *U; const float *ropeC, *ropeS; const float* rs; float wsq, wsv; int pn_off;
    __device__ __forceinline__ void operator()(const f32x4 (&acc)[2][2][4][2], const Unit& u, int wr, int wc, int fr, int fq) const {
        const int row0 = u.pm * BM + wr * 64 + fr, pn = u.pn + pn_off;
        if (pn < 8) {
            bf16_t* base = (pn < 4) ? Q : Kb; const int col0 = (pn & 3) * BM + wc * 32 + 8 * fq, idx0 = 16 * wc + 4 * fq;
#pragma unroll
            for (int ai = 0; ai < 2; ++ai)
#pragma unroll
                for (int m = 0; m < 4; ++m) { const int row = row0 + ai * HALF + m * 16; const float sc = rs[row] * wsq;
                    const f32x4 cs = *(const f32x4*)(ropeC + (size_t)row * 64 + idx0), sn = *(const f32x4*)(ropeS + (size_t)row * 64 + idx0);
#pragma unroll
                    for (int bj = 0; bj < 2; ++bj) { const f32x4 x1 = acc[ai][bj][m][0] * sc, x2 = acc[ai][bj][m][1] * sc;
                        const f32x4 o1 = x1 * cs - x2 * sn, o2 = x2 * cs + x1 * sn;
                        u32x4 w; w.x = cvt_pk_bf16(o1[0], o1[1]); w.y = cvt_pk_bf16(o1[2], o1[3]); w.z = cvt_pk_bf16(o2[0], o2[1]); w.w = cvt_pk_bf16(o2[2], o2[3]);
                        *(u32x4*)(base + (size_t)row * 1024 + col0 + bj * HALF) = w; } }
        } else if (pn < 12) {
            const int col0 = (pn - 8) * BM + wc * 32 + 8 * fq;
#pragma unroll
            for (int ai = 0; ai < 2; ++ai)
#pragma unroll
                for (int m = 0; m < 4; ++m) { bf16_t* rowp = V + (size_t)(row0 + ai * HALF + m * 16) * 1024 + col0; const float sc = rs[row0 + ai * HALF + m * 16] * wsv;
#pragma unroll
                    for (int bj = 0; bj < 2; ++bj) { const f32x4 v0 = acc[ai][bj][m][0] * sc, v1 = acc[ai][bj][m][1] * sc;
                        u32x4 w; w.x = cvt_pk_bf16(v0[0], v0[1]); w.y = cvt_pk_bf16(v0[2], v0[3]); w.z = cvt_pk_bf16(v1[0], v1[1]); w.w = cvt_pk_bf16(v1[2], v1[3]);
                        *(u32x4*)(rowp + bj * HALF) = w; } }
        } else {
            const int col0 = (pn - 12) * HALF + wc * 32 + 8 * fq;
#pragma unroll
            for (int ai = 0; ai < 2; ++ai)
#pragma unroll
                for (int m = 0; m < 4; ++m) { bf16_t* rowp = U + (size_t)(row0 + ai * HALF + m * 16) * 1024 + col0; const float sc = rs[row0 + ai * HALF + m * 16] * wsq;
                    float o[8];
#pragma unroll
                    for (int n = 0; n < 2; ++n)
#pragma unroll
                        for (int j = 0; j < 4; ++j) o[n * 4 + j] = acc[ai][0][m][n][j] * sc * sigmoidf_fast(acc[ai][1][m][n][j] * sc);
                    u32x4 w; w.x = cvt_pk_bf16(o[0], o[1]); w.y = cvt_pk_bf16(o[2], o[3]); w.z = cvt_pk_bf16(o[4], o[5]); w.w = cvt_pk_bf16(o[6], o[7]);
                    *(u32x4*)rowp = w; }
        }
    }
};

template <class Epi, class Sched, bool ALIGN_EPI = false, bool SP2 = false, bool FP8 = false, bool I8 = false>
__device__ __forceinline__ void gemm_phase(PG8_LAS unsigned char* lds, const Gemm g, const Sched& S, const Epi& E, const int wave_in) {
    int lane; asm volatile("v_mbcnt_lo_u32_b32 %0, -1, 0\n\tv_mbcnt_hi_u32_b32 %0, -1, %0" : "=v"(lane));
    const int wid = wave_in, tid = wid * 64 + lane, wr = wid >> 2, wc = wid & 3, fr = lane & 15, fq = lane >> 4;
    const int K = g.K, nt = K / BK;
    unsigned voffA[2], voffB[2];
#pragma unroll
    for (int i = 0; i < 2; ++i) { int R, C; stage_rc(tid * 16 + i * 8192, R, C); const int Rb = Epi::PERM ? ((R & ~31) + perm32(R & 31)) : R;
        voffA[i] = (unsigned)(R * K + C) * 2u; voffB[i] = (unsigned)(Rb * K + C) * 2u; }
    const size_t kstep = (size_t)(BK * 2);
    const size_t hstep = (size_t)HALF * K * 2;
    const size_t tstep = 2 * hstep;
    const unsigned ldsw = (unsigned)wid * 1024u;
    const int aoff = lds_byte(wr * 64 + fr, fq * 8), boff = lds_byte(wc * 32 + fr, fq * 8);
#define PG8_SA(b, h) (((b) * 2 + (h)) * HTB)
#define PG8_SB(b, h) ((4 + (b) * 2 + (h)) * HTB)
#define PG8_STAGE(bufoff, gbase, voff) do { _Pragma("unroll") for (int _i = 0; _i < 2; ++_i) \
        __builtin_amdgcn_global_load_lds((const unsigned*)((const char*)(gbase) + (voff)[_i]), (PG8_LAS unsigned*)(lds + (bufoff) + ldsw + _i * 8192), 16, 0, 0); } while (0)
#define PG8_LDA(dst, b, h) do { if constexpr (FP8) { _Pragma("unroll") for (int m = 0; m < 4; ++m) { const v4i lo_ = *(const PG8_LAS v4i*)(lds + PG8_SA(b, h) + aoff + m * 2048), hi_ = *(const PG8_LAS v4i*)(lds + PG8_SA(b, h) + aoff + m * 2048 + 1024); \
            dst##8[m] = __builtin_shufflevector(lo_, hi_, 0, 1, 2, 3, 4, 5, 6, 7); } } \
        else { _Pragma("unroll") for (int m = 0; m < 4; ++m) _Pragma("unroll") for (int k = 0; k < 2; ++k) dst[m][k] = *(const PG8_LAS bf16x8*)(lds + PG8_SA(b, h) + aoff + m * 2048 + k * 1024); } } while (0)
#define PG8_LDB(dst, b, h) do { if constexpr (FP8) { _Pragma("unroll") for (int n = 0; n < 2; ++n) { const v4i lo_ = *(const PG8_LAS v4i*)(lds + PG8_SB(b, h) + boff + n * 2048), hi_ = *(const PG8_LAS v4i*)(lds + PG8_SB(b, h) + boff + n * 2048 + 1024); \
            dst##8[n] = __builtin_shufflevector(lo_, hi_, 0, 1, 2, 3, 4, 5, 6, 7); } } \
        else { _Pragma("unroll") for (int n = 0; n < 2; ++n) _Pragma("unroll") for (int k = 0; k < 2; ++k) dst[n][k] = *(const PG8_LAS bf16x8*)(lds + PG8_SB(b, h) + boff + n * 2048 + k * 1024); } } while (0)
#define PG8_MMA(ai, bj, At, Bt) do { __builtin_amdgcn_s_setprio(1); \
        if constexpr (FP8) {   \
            _Pragma("unroll") for (int m = 0; m < 4; ++m) _Pragma("unroll") for (int n = 0; n < 2; ++n) \
                asm volatile("v_mfma_f32_16x16x128_f8f6f4 %0, %1, %2, %0" : "+v"(acc[ai][bj][m][n]) : "v"(Bt##8[n]), "v"(At##8[m]));   \
        } else if constexpr (I8) {   \
            _Pragma("unroll") for (int m = 0; m < 4; ++m) _Pragma("unroll") for (int n = 0; n < 2; ++n) _Pragma("unroll") for (int k = 0; k < 2; ++k) \
                asm volatile("v_mfma_i32_16x16x64_i8 %0, %1, %2, %0" : "+v"(acc[ai][bj][m][n]) : "v"(Bt[n][k]), "v"(At[m][k])); \
        } else { _Pragma("unroll") for (int m = 0; m < 4; ++m) _Pragma("unroll") for (int n = 0; n < 2; ++n) _Pragma("unroll") for (int k = 0; k < 2; ++k) \
            acc[ai][bj][m][n] = __builtin_amdgcn_mfma_f32_16x16x32_bf16(Bt[n][k], At[m][k], acc[ai][bj][m][n], 0, 0, 0); } \
        __builtin_amdgcn_s_setprio(0); } while (0)
#define PG8_WAIT_V(n) asm volatile("s_waitcnt vmcnt(" #n ")" ::: "memory")
#define PG8_WAIT_L(n) asm volatile("s_waitcnt lgkmcnt(" #n ")" ::: "memory")
#define PG8_BAR __builtin_amdgcn_s_barrier()
#define PG8_SCHED __builtin_amdgcn_sched_barrier(0)
    Unit cur, nxt; int ui = 0;
    if (!S.next(0, cur)) return;
    f32x4 acc[2][2][4][2];
#pragma unroll
    for (int a = 0; a < 2; ++a)
#pragma unroll
        for (int b = 0; b < 2; ++b)
#pragma unroll
            for (int m = 0; m < 4; ++m)
#pragma unroll
                for (int n = 0; n < 2; ++n) acc[a][b][m][n] = (f32x4){0.f, 0.f, 0.f, 0.f};
    bf16x8 At[4][2], B0[2][2], B1[2][2]; v8i At8[4], B08[2], B18[2];
    const char* cA = (const char*)g.A + (size_t)cur.pm * tstep; const char* cB = (const char*)g.Bt + (size_t)cur.e * g.bstride + (size_t)cur.pn * tstep;
    S.a_ready(cur);
    if constexpr (SP2) {
        PG8_STAGE(PG8_SB(0, 0), cB, voffB); PG8_STAGE(PG8_SB(0, 1), cB + hstep, voffB); PG8_STAGE(PG8_SA(0, 0), cA, voffA); PG8_STAGE(PG8_SA(0, 1), cA + hstep, voffA);
        if (wr == 1) PG8_BAR;
        PG8_WAIT_V(2); PG8_BAR;
        PG8_STAGE(PG8_SB(1, 0), cB + kstep, voffB); PG8_STAGE(PG8_SA(1, 0), cA + kstep, voffA); PG8_STAGE(PG8_SB(1, 1), cB + hstep + kstep, voffB);
        PG8_WAIT_V(6); PG8_BAR;
    } else {
        PG8_STAGE(PG8_SB(0, 0), cB, voffB); PG8_STAGE(PG8_SA(0, 0), cA, voffA); PG8_STAGE(PG8_SB(0, 1), cB + hstep, voffB); PG8_STAGE(PG8_SA(0, 1), cA + hstep, voffA);
        if (wr == 1) PG8_BAR;
        PG8_WAIT_V(4); PG8_BAR;
        PG8_STAGE(PG8_SB(1, 0), cB + kstep, voffB); PG8_STAGE(PG8_SA(1, 0), cA + kstep, voffA); PG8_STAGE(PG8_SB(1, 1), cB + hstep + kstep, voffB);
        PG8_WAIT_V(6); PG8_BAR;
    }
    for (;;) {
        const bool has_next = S.next(ui + 1, nxt);
        const char* nA = has_next ? (const char*)g.A + (size_t)nxt.pm * tstep : cA; const char* nB = has_next ? (const char*)g.Bt + (size_t)nxt.e * g.bstride + (size_t)nxt.pn * tstep : cB;
        for (int t = 0; t < nt; t += 2) {
            const bool last = (t == nt - 2);
            const char* a1 = cA + (size_t)(t + 1) * kstep;
            const char* a2 = last ? nA : cA + (size_t)(t + 2) * kstep; const char* b2 = last ? nB : cB + (size_t)(t + 2) * kstep;
            const char* a3 = a2 + kstep; const char* b3 = b2 + kstep;
            if (last && has_next) S.a_ready(nxt);
            if constexpr (SP2) {
            PG8_LDB(B0, 0, 0); PG8_LDB(B1, 0, 1); PG8_SCHED; PG8_LDA(At, 0, 0); PG8_STAGE(PG8_SA(1, 1), a1 + hstep, voffA);
            PG8_WAIT_V(8); PG8_WAIT_L(0); PG8_BAR; PG8_MMA(0, 0, At, B0); PG8_MMA(0, 1, At, B1); PG8_BAR; PG8_SCHED;
            PG8_LDA(At, 0, 1); PG8_STAGE(PG8_SB(0, 0), b2, voffB); PG8_STAGE(PG8_SB(0, 1), b2 + hstep, voffB); PG8_STAGE(PG8_SA(0, 0), a2, voffA);
            PG8_WAIT_V(8); PG8_WAIT_L(0); PG8_BAR; PG8_MMA(1, 0, At, B0); PG8_MMA(1, 1, At, B1); PG8_BAR; PG8_SCHED;
            PG8_LDB(B0, 1, 0); PG8_LDB(B1, 1, 1); PG8_SCHED; PG8_LDA(At, 1, 0); PG8_STAGE(PG8_SA(0, 1), a2 + hstep, voffA);
            PG8_WAIT_V(8); PG8_WAIT_L(0); PG8_BAR; PG8_MMA(0, 0, At, B0); PG8_MMA(0, 1, At, B1); PG8_BAR; PG8_SCHED;
            PG8_LDA(At, 1, 1); PG8_STAGE(PG8_SB(1, 0), b3, voffB); PG8_STAGE(PG8_SB(1, 1), b3 + hstep, voffB); PG8_STAGE(PG8_SA(1, 0), a3, voffA);
            PG8_WAIT_V(8); PG8_WAIT_L(0); PG8_BAR; PG8_MMA(1, 0, At, B0); PG8_MMA(1, 1, At, B1); PG8_BAR; PG8_SCHED;
            } else {
            PG8_LDB(B0, 0, 0); PG8_SCHED; PG8_LDA(At, 0, 0); PG8_STAGE(PG8_SA(1, 1), a1 + hstep, voffA);
            PG8_WAIT_L(8); PG8_BAR; PG8_WAIT_L(0); PG8_MMA(0, 0, At, B0); PG8_BAR; PG8_SCHED;
            PG8_LDB(B1, 0, 1); PG8_STAGE(PG8_SB(0, 0), b2, voffB);
            PG8_BAR; PG8_WAIT_L(0); PG8_MMA(0, 1, At, B1); PG8_BAR;
            PG8_LDA(At, 0, 1); PG8_STAGE(PG8_SA(0, 0), a2, voffA);
            PG8_BAR; PG8_WAIT_L(0); PG8_MMA(1, 0, At, B0); PG8_BAR; PG8_SCHED;
            PG8_STAGE(PG8_SB(0, 1), b2 + hstep, voffB);
            PG8_WAIT_V(6); PG8_BAR; PG8_MMA(1, 1, At, B1); PG8_BAR;
            PG8_LDB(B0, 1, 0); PG8_SCHED; PG8_LDA(At, 1, 0); PG8_STAGE(PG8_SA(0, 1), a2 + hstep, voffA);
            PG8_WAIT_L(8); PG8_BAR; PG8_WAIT_L(0); PG8_MMA(0, 0, At, B0); PG8_BAR; PG8_SCHED;
            PG8_LDB(B1, 1, 1); PG8_STAGE(PG8_SB(1, 0), b3, voffB);
            PG8_BAR; PG8_WAIT_L(0); PG8_MMA(0, 1, At, B1); PG8_BAR;
            PG8_LDA(At, 1, 1); PG8_STAGE(PG8_SA(1, 0), a3, voffA);
            PG8_BAR; PG8_WAIT_L(0); PG8_MMA(1, 0, At, B0); PG8_BAR; PG8_SCHED;
            PG8_STAGE(PG8_SB(1, 1), b3 + hstep, voffB);
            PG8_WAIT_V(6); PG8_BAR; PG8_MMA(1, 1, At, B1); PG8_BAR;
            }
        }
        if constexpr (FP8) asm volatile("s_nop 15\n\ts_nop 15" ::: "memory");
        if constexpr (I8) { asm volatile("s_nop 15\n\ts_nop 15" ::: "memory");
#pragma unroll
            for (int a = 0; a < 2; ++a)
#pragma unroll
                for (int b = 0; b < 2; ++b)
#pragma unroll
                    for (int m = 0; m < 4; ++m)
#pragma unroll
                        for (int n = 0; n < 2; ++n)
                            asm volatile("v_cvt_f32_i32_e32 %0, %0\n\tv_cvt_f32_i32_e32 %1, %1\n\tv_cvt_f32_i32_e32 %2, %2\n\tv_cvt_f32_i32_e32 %3, %3" : "+v"(acc[a][b][m][n][0]), "+v"(acc[a][b][m][n][1]), "+v"(acc[a][b][m][n][2]), "+v"(acc[a][b][m][n][3])); }
        if constexpr (ALIGN_EPI) { if (wr == 0) PG8_BAR; }
        if constexpr (!Epi::AFTER_DRAIN) { E(acc, cur, wr, wc, fr, fq); S.done(cur); }
        if (!has_next) break;
#pragma unroll
        for (int a = 0; a < 2; ++a)
#pragma unroll
            for (int b = 0; b < 2; ++b)
#pragma unroll
                for (int m = 0; m < 4; ++m)
#pragma unroll
                    for (int n = 0; n < 2; ++n) acc[a][b][m][n] = (f32x4){0.f, 0.f, 0.f, 0.f};
        cur = nxt; cA = nA; cB = nB; ++ui;
        if constexpr (ALIGN_EPI) { if (wr == 1) PG8_BAR; }
    }
    PG8_WAIT_V(0);
    if constexpr (!ALIGN_EPI) { if (wr == 0) PG8_BAR; }
    PG8_BAR;
    if constexpr (Epi::AFTER_DRAIN) { E.fused(acc, cur, wr, wc, fr, fq, lds, wid, lane); S.done(cur); }
#undef PG8_SA
#undef PG8_SB
#undef PG8_STAGE
#undef PG8_LDA
#undef PG8_LDB
#undef PG8_MMA
#undef PG8_WAIT_V
#undef PG8_WAIT_L
#undef PG8_BAR
#undef PG8_SCHED
}
}

constexpr int NWAVES = 8;
constexpr int S = 16384, DM = 2048, NPROJ = 5120, AW = 1024, HD = 128, NH = 8, DFF = 5632, NE = 8, CKW = 31, NBLK = 64;
constexpr float LN_EPS = 1e-5f, ALPHA = 1.41421356237309515f;
constexpr int MOE_ROWS = 2 * S + NE * 256;
constexpr float WSC_GU = 32.f, WSC_D = 128.f, ASC_H = 4.f, ASC_ACT = 8.f, WSC_O = 64.f, ASC_CAT = 16.f;
constexpr float WQ_GU = 1024.f;

constexpr size_t MiB = 1u << 20;
constexpr size_t WS_CTL = 0, CTL_ZERO_BYTES = 1 * MiB;
constexpr size_t WS_ROPEC = 1 * MiB, WS_ROPES = 5 * MiB;
constexpr size_t WS_KMEAN = 9 * MiB;
constexpr size_t WS_RWT = 9 * MiB + 256 * 1024;
constexpr size_t WS_RSC = 9 * MiB + 896 * 1024;
constexpr size_t WS_EIDX = 9 * MiB + 512 * 1024, WS_GATEW = WS_EIDX + 128 * 1024, WS_ROWPOS = WS_GATEW + 128 * 1024;
constexpr size_t WS_WIN = 10 * MiB, WS_WOUT = 50 * MiB, WS_WGU0 = 66 * MiB, WS_WD0 = 110 * MiB, WS_WGUE = 132 * MiB, WS_WDE = 484 * MiB;
constexpr size_t WS_HB = 660 * MiB;
constexpr size_t WS_R2 = 724 * MiB;
constexpr size_t WS_HB8 = 860 * MiB + 72 * MiB;
constexpr size_t WS_RSP = 860 * MiB + 112 * MiB;
constexpr size_t WS_HBP = 860 * MiB;
constexpr size_t WS_R1 = 996 * MiB;
constexpr size_t WS_Q = WS_R1, WS_K = WS_R1 + 32 * MiB, WS_V = WS_R1 + 64 * MiB, WS_U = WS_R1 + 96 * MiB, WS_CAT = WS_R1 + 128 * MiB, WS_ACT = WS_R1;
constexpr size_t WS_VT = WS_R1 + 192 * MiB, WS_PO = WS_R1 + 224 * MiB, WS_PML = WS_R1 + 320 * MiB, WS_LIST = WS_R1 + 324 * MiB;
constexpr size_t WS_END = 1370 * MiB;
static_assert(WS_R1 + (size_t)MOE_ROWS * DFF * 2 <= WS_END && WS_HBP + (size_t)MOE_ROWS * DM * 2 <= WS_R1 && WS_R2 + (size_t)MOE_ROWS * DM * 2 <= WS_HBP, "d_ws map");
static_assert(WS_WDE + (size_t)NE * DM * DFF * 2 <= WS_HB && WS_WGUE + (size_t)NE * 2 * DFF * DM * 2 <= WS_WDE, "d_ws weights map");
constexpr int CW_TMO = 0, CW_CODE = 1, CW_BAR = 4096, CW_ECNT = 8192, CW_ECUR = 8192 + 64 * 8, CW_LCNT = 12288, CW_QUEUE = 14336, CW_STEALQ = 14464, CW_ARRIVE = 16384;
constexpr int RING_OFF = 0, RING_BYTES = 131072;
constexpr int LDSCTL_OFF = 143360, MISC_OFF = LDSCTL_OFF + 320;
constexpr int LDS_BYTES = 147456;

__device__ const float INV_FREQ[64] = {
1.000000000e+00f, 8.659643531e-01f, 7.498942018e-01f, 6.493816376e-01f, 5.623413324e-01f, 4.869675338e-01f, 4.216965139e-01f, 3.651741147e-01f, 3.162277639e-01f, 2.738419771e-01f, 2.371373773e-01f, 2.053525001e-01f, 1.778279394e-01f, 1.539926529e-01f, 1.333521456e-01f, 1.154781953e-01f, 1.000000015e-01f, 8.659642935e-02f, 7.498942316e-02f, 6.493816525e-02f, 5.623413250e-02f, 4.869675264e-02f, 4.216964915e-02f, 3.651741147e-02f, 3.162277490e-02f, 2.738419548e-02f, 2.371373773e-02f, 2.053525113e-02f, 1.778279431e-02f, 1.539926510e-02f, 1.333521400e-02f, 1.154781971e-02f, 9.999999776e-03f, 8.659643121e-03f, 7.498942316e-03f, 6.493816152e-03f, 5.623413250e-03f, 4.869675264e-03f, 4.216964822e-03f, 3.651741194e-03f, 3.162277630e-03f, 2.738419687e-03f, 2.371373819e-03f, 2.053525066e-03f, 1.778279431e-03f, 1.539926510e-03f, 1.333521446e-03f, 1.154782018e-03f, 1.000000047e-03f, 8.659643354e-04f, 7.498941850e-04f, 6.493816036e-04f, 5.623413017e-04f, 4.869675322e-04f, 4.216965172e-04f, 3.651741135e-04f, 3.162277571e-04f, 2.738419571e-04f, 2.371373703e-04f, 2.053525095e-04f, 1.778279402e-04f, 1.539926598e-04f, 1.333521504e-04f, 1.154782003e-04f
};

#define GAS __attribute__((address_space(1)))
#define LAS __attribute__((address_space(3)))
typedef unsigned short bf16;
typedef unsigned v4u __attribute__((ext_vector_type(4)));
typedef unsigned v2u __attribute__((ext_vector_type(2)));
typedef float f32x4 __attribute__((ext_vector_type(4)));
typedef float f32x2 __attribute__((ext_vector_type(2)));
typedef short bf16x8 __attribute__((ext_vector_type(8)));
typedef GAS unsigned gu32;
typedef GAS unsigned long long gu64;
#define RLX_AGENT __ATOMIC_RELAXED, __HIP_MEMORY_SCOPE_AGENT
#define LDS_WAIT() asm volatile("s_waitcnt lgkmcnt(0)" ::: "memory")
#define VM_WAIT() asm volatile("s_waitcnt vmcnt(0)" ::: "memory")
__device__ __forceinline__ unsigned f2bf(float f) { unsigned u = __builtin_bit_cast(unsigned, f); return (u + 0x7fffu + ((u >> 16) & 1u)) >> 16; }
__device__ __forceinline__ unsigned pk2(float lo, float hi) { return f2bf(lo) | (f2bf(hi) << 16); }
__device__ __forceinline__ float bflo(unsigned w) { return __builtin_bit_cast(float, w << 16); }
__device__ __forceinline__ float bfhi(unsigned w) { return __builtin_bit_cast(float, w & 0xffff0000u); }

#define XB_TMO      128
#define XB_XCNT(j)  (256  + 64 * (j))
#define XB_XSUB(j)  (1280 + 64 * (j))
#define XB_XGEN(j)  (2304 + 64 * (j))
#define XB_TOP      3328
#define XB_TOPGEN   3392
#define XCD_BAR_WORDS 3456
#define XB_SPIN_CAP (1u << 22)

__device__ __forceinline__ unsigned xb_ld(unsigned* p)              { return __hip_atomic_load(p, __ATOMIC_RELAXED, __HIP_MEMORY_SCOPE_AGENT); }
__device__ __forceinline__ unsigned xb_add(unsigned* p, unsigned v) { return __hip_atomic_fetch_add(p, v, __ATOMIC_RELAXED, __HIP_MEMORY_SCOPE_AGENT); }
__device__ __forceinline__ unsigned xb_xcc_id() { return (unsigned)__builtin_amdgcn_s_getreg((3 << 11) | 20) & 0xFu; }
#define XB_SPIN(cond, bar) do { unsigned _sp = 0; while (cond) { __builtin_amdgcn_s_sleep(1); \
    if ((++_sp & 255u) == 0u) { if (xb_ld(&(bar)[XB_TMO])) break; if (_sp > XB_SPIN_CAP) { atomicAdd(&(bar)[XB_TMO], 1u); break; } } } } while (0)

__device__ __forceinline__ int lane_now() { int l; asm volatile("v_mbcnt_lo_u32_b32 %0, -1, 0\n\tv_mbcnt_hi_u32_b32 %0, -1, %0" : "=v"(l)); return l; }
#define XB_T0() (b.w0 == 0 && lane_now() == 0)
struct XcdBarrier {
    unsigned* bar; unsigned x; int w0;
    volatile LAS unsigned* st;
};

__device__ __forceinline__ XcdBarrier xcd_barrier_post(unsigned* bar, volatile LAS unsigned* st, int w0) {
    XcdBarrier b; b.bar = bar; b.x = xb_xcc_id(); b.st = st; b.w0 = w0;
    if (XB_T0()) (void)xb_add(&bar[XB_XCNT(b.x)], 1u);
    return b;
}
__device__ __forceinline__ void xcd_barrier_complete(unsigned* bar, unsigned x, unsigned& nloc, unsigned& nx) {
    const unsigned G = gridDim.x * gridDim.y * gridDim.z;
    unsigned sum, cnt, mine, sp = 0u;
    for (;;) {
        sum = 0u; cnt = 0u; mine = 0u;
#pragma unroll
        for (unsigned j = 0; j < 16; ++j) { const unsigned c = xb_ld(&bar[XB_XCNT(j)]); sum += c; cnt += (c > 0u) ? 1u : 0u; mine = (j == x) ? c : mine; }
        if (sum == G) break;
        __builtin_amdgcn_s_sleep(1);
        if ((++sp & 255u) == 0u) { if (xb_ld(&bar[XB_TMO])) break; if (sp > XB_SPIN_CAP) { atomicAdd(&bar[XB_TMO], 1u); break; } }
    }
    nloc = mine > 0u ? mine : 1u; nx = cnt > 0u ? cnt : 1u;
}

__device__ __forceinline__ void xcd_barrier(const XcdBarrier& b) {
    asm volatile("s_waitcnt vmcnt(0)" ::: "memory");
    __syncthreads();
    if (XB_T0()) {
        unsigned* bar = b.bar;
        __builtin_amdgcn_s_waitcnt(0);
        unsigned nloc = b.st[0], nx = b.st[1];
        if (nloc == 0u) { xcd_barrier_complete(bar, b.x, nloc, nx); b.st[0] = nloc; b.st[1] = nx; }
        const unsigned old = xb_add(&bar[XB_XSUB(b.x)], 1u);
        const unsigned gen = old / nloc;
        if (old + 1u == (gen + 1u) * nloc) {
            __builtin_amdgcn_fence(__ATOMIC_RELEASE, "agent");
            asm volatile("s_waitcnt vmcnt(0)" ::: "memory");
            const unsigned og = xb_add(&bar[XB_TOP], 1u);
            const unsigned tg = og / nx;
            if (og + 1u == (tg + 1u) * nx) xb_add(&bar[XB_TOPGEN], 1u);
            else XB_SPIN(xb_ld(&bar[XB_TOPGEN]) == tg, bar);
            __builtin_amdgcn_fence(__ATOMIC_ACQUIRE, "agent");
            xb_add(&bar[XB_XGEN(b.x)], 1u);
            asm volatile("s_waitcnt vmcnt(0)" ::: "memory");
        } else {
            XB_SPIN(xb_ld(&bar[XB_XGEN(b.x)]) == gen, bar);
            __builtin_amdgcn_fence(__ATOMIC_ACQUIRE, "agent");
            asm volatile("s_waitcnt vmcnt(0)" ::: "memory");
        }
    }
    __syncthreads();
}


struct Frame {
    LAS unsigned char* lds;
    volatile LAS unsigned* MISC;
    gu32* ctl;
    int wave;
    int vcu, G;
    const float* x; float* out;
    const float *w_in, *conv_w, *conv_b, *conv_g, *conv_be, *w_out, *lnm_g, *lnm_b, *lnf_g, *lnf_b, *fg, *fu, *fd, *router, *eg, *eu, *ed;
    unsigned char* ws;
    unsigned long long tacc, tt0;
};
#ifndef PROBE_ID
#define PROBE_ID 0
#endif
#ifndef PROBE_WG
#define PROBE_WG 0
#endif
#define TSTART(id) do { if (PROBE_ID == (id)) F.tt0 = __builtin_amdgcn_s_memrealtime(); } while (0)
#define TSTOP(id) do { if (PROBE_ID == (id)) F.tacc += __builtin_amdgcn_s_memrealtime() - F.tt0; } while (0)
__device__ __forceinline__ int shx_i(int v, int m, int lane) { return __builtin_amdgcn_ds_bpermute((lane ^ m) << 2, v); }
__device__ __forceinline__ float shx(float v, int m, int lane) { return __builtin_bit_cast(float, __builtin_amdgcn_ds_bpermute((lane ^ m) << 2, __builtin_bit_cast(int, v))); }
__device__ __forceinline__ int shl_i(int v, int src) { return __builtin_amdgcn_ds_bpermute(src << 2, v); }
template <int N> __device__ __forceinline__ void wave_sum_n(float (&v)[N], int lane) {
#pragma unroll
    for (int i = 0; i < N; ++i) { float x = v[i];
        x += __builtin_bit_cast(float, __builtin_amdgcn_update_dpp(0, __builtin_bit_cast(int, x), 0xB1, 0xF, 0xF, false));
        x += __builtin_bit_cast(float, __builtin_amdgcn_update_dpp(0, __builtin_bit_cast(int, x), 0x4E, 0xF, 0xF, false));
        x += __builtin_bit_cast(float, __builtin_amdgcn_update_dpp(0, __builtin_bit_cast(int, x), 0x141, 0xF, 0xF, false));
        x += __builtin_bit_cast(float, __builtin_amdgcn_update_dpp(0, __builtin_bit_cast(int, x), 0x140, 0xF, 0xF, false));
        v[i] = x; }
#pragma unroll
    for (int o = 16; o < 64; o <<= 1) { float t[N];
#pragma unroll
        for (int i = 0; i < N; ++i) t[i] = shx(v[i], o, lane);
#pragma unroll
        for (int i = 0; i < N; ++i) v[i] += t[i]; }
}
__device__ __forceinline__ float wave_max(float v, int lane) {
    v = fmaxf(v, __builtin_bit_cast(float, __builtin_amdgcn_update_dpp(0, __builtin_bit_cast(int, v), 0xB1, 0xF, 0xF, false)));
    v = fmaxf(v, __builtin_bit_cast(float, __builtin_amdgcn_update_dpp(0, __builtin_bit_cast(int, v), 0x4E, 0xF, 0xF, false)));
    v = fmaxf(v, __builtin_bit_cast(float, __builtin_amdgcn_update_dpp(0, __builtin_bit_cast(int, v), 0x141, 0xF, 0xF, false)));
    v = fmaxf(v, __builtin_bit_cast(float, __builtin_amdgcn_update_dpp(0, __builtin_bit_cast(int, v), 0x140, 0xF, 0xF, false)));
    v = fmaxf(v, shx(v, 16, lane)); v = fmaxf(v, shx(v, 32, lane));
    return v;
}
__device__ __forceinline__ float wave_sum(float v, int lane) {
    v += __builtin_bit_cast(float, __builtin_amdgcn_update_dpp(0, __builtin_bit_cast(int, v), 0xB1, 0xF, 0xF, false));
    v += __builtin_bit_cast(float, __builtin_amdgcn_update_dpp(0, __builtin_bit_cast(int, v), 0x4E, 0xF, 0xF, false));
    v += __builtin_bit_cast(float, __builtin_amdgcn_update_dpp(0, __builtin_bit_cast(int, v), 0x141, 0xF, 0xF, false));
    v += __builtin_bit_cast(float, __builtin_amdgcn_update_dpp(0, __builtin_bit_cast(int, v), 0x140, 0xF, 0xF, false));
    v += shx(v, 16, lane); v += shx(v, 32, lane);
    return v;
}
__device__ __forceinline__ int wmap(int kind, int c) {
    if (kind == 0) return c;
    if (kind == 1) {
        if (c < 2048) { const int hh = c >> 7, w = c & 127, n = w >> 6, idx = w & 63; return hh * 128 + 32 * (idx >> 4) + 8 * ((idx >> 2) & 3) + 4 * n + (idx & 3); }
        if (c < 3072) return c;
        if (c < 4096) { const int j = c - 3072; return 3072 + 256 * (j >> 7) + (j & 127); }
        const int j = c - 4096; return 3072 + 256 * (j >> 7) + 128 + (j & 127);
    }
    return 256 * (c >> 7) + (kind == 3 ? 128 : 0) + (c & 127);
}
__device__ __forceinline__ void p0_transpose_item(const float* Wg, int K, int N, bf16* WT, int kind, LAS float* scr, int item, int lane) {
    const GAS float* W = (const GAS float*)Wg;
    const int nblk = N / 32, kb = item / nblk, nb = item % nblk, k0 = 64 * kb, n0 = 32 * nb;
    float wv[32];
#pragma unroll
    for (int i = 0; i < 32; ++i) wv[i] = W[(size_t)(k0 + 2 * i + (lane >> 5)) * N + n0 + (lane & 31)];
#pragma unroll
    for (int i = 0; i < 32; ++i) scr[(2 * i + (lane >> 5)) * 33 + (lane & 31)] = wv[i];
    LDS_WAIT(); asm volatile("" ::: "memory");
    const int c = lane & 7;
#pragma unroll
    for (int j = 0; j < 4; ++j) { const int n = (lane >> 3) + 8 * j; const LAS float* s = scr + (8 * c) * 33 + n;
        v4u o; o.x = pk2(s[0 * 33], s[1 * 33]); o.y = pk2(s[2 * 33], s[3 * 33]); o.z = pk2(s[4 * 33], s[5 * 33]); o.w = pk2(s[6 * 33], s[7 * 33]);
        *(GAS v4u*)(WT + (size_t)wmap(kind, n0 + n) * K + k0 + 8 * c) = o; }
    LDS_WAIT(); asm volatile("" ::: "memory");
}
__device__ __forceinline__ void sincos_acc(float ang, float& sn, float& cs) {
    const double x = (double)ang, k = __builtin_rint(x * 0.63661977236758134308);
    double r = __builtin_fma(-k, 1.57079632679489655800e+00, x); r = __builtin_fma(-k, 6.12323399573676603587e-17, r);
    const int q = ((int)k) & 3; const double r2 = r * r;
    double sp = 1.0 / 6227020800.0; sp = sp * r2 - 1.0 / 39916800.0; sp = sp * r2 + 1.0 / 362880.0; sp = sp * r2 - 1.0 / 5040.0; sp = sp * r2 + 1.0 / 120.0; sp = sp * r2 - 1.0 / 6.0;
    const double s = r + r * r2 * sp;
    double cp = -1.0 / 87178291200.0; cp = cp * r2 + 1.0 / 479001600.0; cp = cp * r2 - 1.0 / 3628800.0; cp = cp * r2 + 1.0 / 40320.0; cp = cp * r2 - 1.0 / 720.0; cp = cp * r2 + 1.0 / 24.0; cp = cp * r2 - 0.5;
    const double c = 1.0 + r2 * cp;
    const double ss = (q & 1) ? c : s, cc = (q & 1) ? s : c;
    sn = (float)((q & 2) ? -ss : ss); cs = (float)(((q + 1) & 2) ? -cc : cc);
}
__device__ __forceinline__ void p0_transpose_item8(const float* Wg, int K, int N, unsigned char* WT, int kind, float wscale, LAS float* scr, int item, int lane) {
    const GAS float* W = (const GAS float*)Wg;
    const int nblk = N / 32, kb = item / nblk, nb = item % nblk, k0 = 64 * kb, n0 = 32 * nb;
    float wv[32];
#pragma unroll
    for (int i = 0; i < 32; ++i) wv[i] = W[(size_t)(k0 + 2 * i + (lane >> 5)) * N + n0 + (lane & 31)];
#pragma unroll
    for (int i = 0; i < 32; ++i) scr[(2 * i + (lane >> 5)) * 33 + (lane & 31)] = wv[i] * wscale;
    LDS_WAIT(); asm volatile("" ::: "memory");
    const int c = lane & 7;
#pragma unroll
    for (int j = 0; j < 4; ++j) { const int n = (lane >> 3) + 8 * j; const LAS float* sp = scr + (8 * c) * 33 + n;
        v2u o; o.x = pg8::pk4_fp8(sp[0 * 33], sp[1 * 33], sp[2 * 33], sp[3 * 33]); o.y = pg8::pk4_fp8(sp[4 * 33], sp[5 * 33], sp[6 * 33], sp[7 * 33]);
        *(GAS v2u*)(WT + (size_t)wmap(kind, n0 + n) * K + k0 + 8 * c) = o; }
    LDS_WAIT(); asm volatile("" ::: "memory");
}
__device__ __forceinline__ void p0_transpose_stack8(Frame& F, const float* src, int K, int N, int nmat, unsigned char* dst, size_t dst_stride, int kind, float wscale) {
    LAS float* scr = (LAS float*)(F.lds + RING_OFF + F.wave * 16384);
    const int gw = F.vcu * NWAVES + F.wave, NGW = F.G * NWAVES, per = (K / 64) * (N / 32), total = per * nmat, lane = lane_now();
#pragma clang loop unroll(disable)
    for (int it = gw; it < total; it += NGW) { const int m = it / per, r = it - m * per;
        p0_transpose_item8(src + (size_t)m * K * N, K, N, dst + (size_t)m * dst_stride, kind, wscale, scr, r, lane); }
}
__device__ __forceinline__ void p0_stack(Frame& F, const float* src, int K, int N, int nmat, unsigned char* dst, size_t dst_stride_bytes, int kind, int qmode  , float wscale, int n_lo = 0, int n_cnt = 0, int drow_off = 0) {
    LAS float* t = (LAS float*)(F.lds + RING_OFF);
    const int tid = F.wave * 64 + lane_now(), ntn = (n_cnt ? n_cnt : N) / 256, per = (K / 128) * ntn, total = per * nmat;
    f32x4 raw[16];
    int it = blockIdx.x;
    if (it < total) { const int m = it / per, r = it - m * per, k0 = (r / ntn) * 128, n0 = n_lo + (r % ntn) * 256; const GAS f32x4* W = (const GAS f32x4*)(src + (size_t)m * K * N + (size_t)k0 * N + n0);
#pragma unroll
        for (int i = 0; i < 16; ++i) { const int p = tid + 512 * i; raw[i] = W[(size_t)(p >> 6) * (N / 4) + (p & 63)]; } }
#pragma clang loop unroll(disable)
    for (; it < total; it += F.G) { const int m = it / per, r = it - m * per, k0 = (r / ntn) * 128, n0 = n_lo + (r % ntn) * 256;
        const int tid2 = F.wave * 64 + lane_now();
#pragma unroll
        for (int i = 0; i < 16; ++i) { const int p = tid2 + 512 * i; LAS float* d = t + (p >> 6) * 257 + (p & 63) * 4; d[0] = raw[i][0] * wscale; d[1] = raw[i][1] * wscale; d[2] = raw[i][2] * wscale; d[3] = raw[i][3] * wscale; }
        __syncthreads();
        { const int nx = (it + F.G < total) ? it + F.G : it;
          const int m2 = nx / per, r2 = nx - m2 * per, k2 = (r2 / ntn) * 128, n2 = n_lo + (r2 % ntn) * 256; const GAS f32x4* W = (const GAS f32x4*)(src + (size_t)m2 * K * N + (size_t)k2 * N + n2);
#pragma unroll
            for (int i = 0; i < 16; ++i) { const int p = tid2 + 512 * i; raw[i] = W[(size_t)(p >> 6) * (N / 4) + (p & 63)]; } }
        unsigned char* drow = dst + (size_t)m * dst_stride_bytes;
#pragma unroll
        for (int q = 0; q < 8; ++q) { const int cid = tid2 + 512 * q, nrow = cid >> 4, kc = cid & 15; const LAS float* sp = t + (8 * kc) * 257 + nrow;
            const float e0 = sp[0], e1 = sp[257], e2 = sp[2 * 257], e3 = sp[3 * 257], e4 = sp[4 * 257], e5 = sp[5 * 257], e6 = sp[6 * 257], e7 = sp[7 * 257];
            const size_t drw = (size_t)(wmap(kind, n0 + nrow) - drow_off) * K + k0 + 8 * kc;
            if (qmode == 1) { v2u o; o.x = pg8::pk4_fp8(e0, e1, e2, e3); o.y = pg8::pk4_fp8(e4, e5, e6, e7); *(GAS v2u*)(drow + drw) = o; }
            else if (qmode == 2) { v2u o; o.x = pg8::pk4_i8(e0, e1, e2, e3); o.y = pg8::pk4_i8(e4, e5, e6, e7); *(GAS v2u*)(drow + drw) = o; }
            else { v4u o; o.x = pk2(e0, e1); o.y = pk2(e2, e3); o.z = pk2(e4, e5); o.w = pk2(e6, e7); *(GAS v4u*)(drow + drw * 2) = o; } }
        __syncthreads();
    }
}
constexpr int XT_PER = 352, XT_TOTAL = 24 * XT_PER;
static_assert((DM / 128) * (DFF / 256) == XT_PER && (DFF / 128) * (DM / 256) == XT_PER, "expert tile counts");
__device__ __forceinline__ void convert_expert_tile(Frame& F, int t) {
    LAS float* tl = (LAS float*)(F.lds + RING_OFF);
    const int tid = F.wave * 64 + lane_now();
    const int mat = t / XT_PER, r = t - mat * XT_PER, kidx = mat >> 3, e = mat & 7;
    const float* pg = F.eg; const float* pu = F.eu; const float* pd = F.ed;
    asm volatile("" : "+s"(pg), "+s"(pu), "+s"(pd));
    const bool down = kidx == 2;
    const int K = down ? DFF : DM, N = down ? DM : DFF, ntn = N / 256, k0 = (r / ntn) * 128, n0 = (r % ntn) * 256;
    const float* src = (kidx == 0 ? pg : (kidx == 1 ? pu : pd)) + (size_t)e * DM * DFF;
    unsigned char* dst = down ? (F.ws + WS_WDE + (size_t)e * DM * DFF) : (F.ws + WS_WGUE + (size_t)e * 2 * DFF * DM);
    const int kind = down ? 0 : (kidx == 0 ? 2 : 3); const float wscale = down ? WSC_D : WQ_GU;
    const GAS f32x4* W = (const GAS f32x4*)(src + (size_t)k0 * N + n0);
    f32x4 raw[16];
#pragma unroll
    for (int i = 0; i < 16; ++i) { const int p = tid + 512 * i; raw[i] = W[(size_t)(p >> 6) * (N / 4) + (p & 63)]; }
#pragma unroll
    for (int i = 0; i < 16; ++i) { const int p = tid + 512 * i; LAS float* d = tl + (p >> 6) * 257 + (p & 63) * 4; d[0] = raw[i][0] * wscale; d[1] = raw[i][1] * wscale; d[2] = raw[i][2] * wscale; d[3] = raw[i][3] * wscale; }
    __syncthreads();
#pragma unroll
    for (int q = 0; q < 8; ++q) { const int cid = tid + 512 * q, nrow = cid >> 4, kc = cid & 15; const LAS float* sp = tl + (8 * kc) * 257 + nrow;
        const float e0 = sp[0], e1 = sp[257], e2 = sp[2 * 257], e3 = sp[3 * 257], e4 = sp[4 * 257], e5 = sp[5 * 257], e6 = sp[6 * 257], e7 = sp[7 * 257];
        v2u o; if (down) { o.x = pg8::pk4_fp8(e0, e1, e2, e3); o.y = pg8::pk4_fp8(e4, e5, e6, e7); } else { o.x = pg8::pk4_i8(e0, e1, e2, e3); o.y = pg8::pk4_i8(e4, e5, e6, e7); }
        *(GAS v2u*)(dst + (size_t)wmap(kind, n0 + nrow) * K + k0 + 8 * kc) = o; }
    __syncthreads();
}
constexpr unsigned STEAL_THRESH = 200u;
__device__ __forceinline__ void steal_point(Frame& F, int idx) {
    __syncthreads();
    const bool t0 = (F.wave == 0) && (lane_now() == 0);
    if (t0) __hip_atomic_fetch_add(F.ctl + CW_ARRIVE + 64 * idx, 1u, RLX_AGENT);
#pragma clang loop unroll(disable)
    for (int it = 0; it < XT_TOTAL; ++it) {
        if (t0) { int tt = -1;
            if (__hip_atomic_load(F.ctl + CW_ARRIVE + 64 * idx, RLX_AGENT) < STEAL_THRESH) { const unsigned q = __hip_atomic_fetch_add(F.ctl + CW_STEALQ, 1u, RLX_AGENT); if (q < (unsigned)XT_TOTAL) tt = (int)q; }
            F.MISC[17] = (unsigned)tt; }
        __syncthreads();
        const int tt = (int)__builtin_amdgcn_readfirstlane(F.MISC[17]);
        if (tt < 0) break;
        convert_expert_tile(F, tt);
    }
}
__device__ __forceinline__ void steal_drain(Frame& F) {
    __syncthreads();
    const bool t0 = (F.wave == 0) && (lane_now() == 0);
#pragma clang loop unroll(disable)
    for (int it = 0; it < XT_TOTAL; ++it) {
        if (t0) { const unsigned q = __hip_atomic_fetch_add(F.ctl + CW_STEALQ, 1u, RLX_AGENT); F.MISC[17] = q < (unsigned)XT_TOTAL ? q : 0xffffffffu; }
        __syncthreads();
        const int tt = (int)__builtin_amdgcn_readfirstlane(F.MISC[17]);
        if (tt < 0) break;
        convert_expert_tile(F, tt);
    }
}
__device__ __forceinline__ void p0_prologue(Frame& F) {
    p0_stack(F, F.w_in, DM, NPROJ, 2, F.ws + WS_WIN, (size_t)20 * MiB, 1, 2, WQ_GU, 0, 2048, 0);
    p0_stack(F, F.w_in, DM, NPROJ, 2, F.ws + WS_WIN, (size_t)20 * MiB, 1, 2, 2.f * WQ_GU, 2048, 1024, 0);
    p0_stack(F, F.w_in, DM, NPROJ, 2, F.ws + WS_WIN, (size_t)20 * MiB, 1, 2, WQ_GU, 3072, 2048, 0);
    p0_stack(F, F.w_out, DM, DM, 2, F.ws + WS_WOUT, (size_t)DM * DM, 0, 1, WSC_O);
    p0_stack(F, F.fg, DM, DFF, 1, F.ws + WS_WGU0, 0, 2, 2, WQ_GU);
    p0_stack(F, F.fu, DM, DFF, 1, F.ws + WS_WGU0, 0, 3, 2, WQ_GU);
    p0_stack(F, F.fd, DFF, DM, 1, F.ws + WS_WD0, 0, 0, 0, 1.f);
    { const int i = ((F.vcu * NWAVES + F.wave) * 64 + lane_now()); if (i < NE * DM) { const int e = i / DM, k = i - e * DM; const float w = ((const GAS float*)F.router)[k * NE + e];
          const unsigned hi = f2bf(w), lo = f2bf(w - __builtin_bit_cast(float, hi << 16)); ((GAS bf16*)(F.ws + WS_RWT))[i] = (bf16)hi; ((GAS bf16*)(F.ws + WS_RWT))[NE * DM + i] = (bf16)lo; } }
    { GAS float* rc = (GAS float*)(F.ws + WS_ROPEC); GAS float* rs = (GAS float*)(F.ws + WS_ROPES);
#pragma clang loop unroll(disable)
      for (int i = (F.vcu * NWAVES + F.wave) * 64 + lane_now(); i < S * 64; i += F.G * NWAVES * 64) { const int t = i >> 6, f = i & 63; const float ang = (float)t * INV_FREQ[f]; float sn, cs; sincos_acc(ang, sn, cs); rc[i] = cs; rs[i] = sn; } }
    { const int gw = F.vcu * NWAVES + F.wave, lane = lane_now();
#pragma clang loop unroll(disable)
      for (int i = 0; i < 8; ++i) { const int row = gw * 8 + i; const GAS f32x4* xp = (const GAS f32x4*)(F.x + (size_t)row * DM) + lane;
          f32x4 v[8]; float amax = 0.f;
#pragma unroll
          for (int j = 0; j < 8; ++j) { v[j] = xp[64 * j]; amax = fmaxf(fmaxf(amax, fmaxf(fabsf(v[j][0]), fabsf(v[j][1]))), fmaxf(fabsf(v[j][2]), fabsf(v[j][3]))); }
          amax = fmaxf(wave_max(amax, lane), 1e-20f); const float qs = 127.f / amax;
          GAS v2u* hb = (GAS v2u*)(F.ws + WS_HB + (size_t)row * DM * 2) + lane;
#pragma unroll
          for (int j = 0; j < 8; ++j) { hb[64 * j] = (v2u){pk2(v[j][0], v[j][1]), pk2(v[j][2], v[j][3])};
              ((GAS unsigned*)(F.ws + WS_HB8 + (size_t)row * DM))[64 * j + lane] = pg8::pk4_i8(v[j][0] * qs, v[j][1] * qs, v[j][2] * qs, v[j][3] * qs); }
          if (lane == 0) ((GAS float*)(F.ws + WS_RSC))[row] = amax * (1.f / 127.f); } }
}

__device__ __forceinline__ void kmean_phase(Frame& F) {
    const int lane = lane_now(), c8 = lane & 15, rg = lane >> 4, u2 = F.wave >> 2, q = F.wave & 3, tid = F.wave * 64 + lane;
    LAS float* ks = (LAS float*)(F.lds + RING_OFF + 8 * 8704);
    { const int unit = (int)blockIdx.x + u2 * F.G, j = unit & 63, h = unit >> 6;
      const GAS v4u* kp = (const GAS v4u*)(F.ws + WS_K) + ((size_t)(j * 256 + 64 * q + rg) * 1024 + h * 128) / 8 + c8;
      v4u w[16];
#pragma unroll
      for (int it = 0; it < 16; ++it) w[it] = kp[(size_t)it * 4 * 128];
      float a[8];
#pragma unroll
      for (int i = 0; i < 8; ++i) a[i] = 0.f;
#pragma unroll
      for (int it = 0; it < 16; ++it) { a[0] += bflo(w[it].x); a[1] += bfhi(w[it].x); a[2] += bflo(w[it].y); a[3] += bfhi(w[it].y); a[4] += bflo(w[it].z); a[5] += bfhi(w[it].z); a[6] += bflo(w[it].w); a[7] += bfhi(w[it].w); }
#pragma unroll
      for (int i = 0; i < 8; ++i) { a[i] += shx(a[i], 16, lane); a[i] += shx(a[i], 32, lane); }
      if (rg == 0) { *(LAS f32x4*)(ks + (u2 * 4 + q) * 128 + 8 * c8) = (f32x4){a[0], a[1], a[2], a[3]}; *(LAS f32x4*)(ks + (u2 * 4 + q) * 128 + 8 * c8 + 4) = (f32x4){a[4], a[5], a[6], a[7]}; } }
    __syncthreads();
    if (tid < 128) { const int uu = tid >> 6, cp = tid & 63, unit = (int)blockIdx.x + uu * F.G, j = unit & 63, h = unit >> 6;
        float m0 = 0.f, m1 = 0.f;
#pragma unroll
        for (int qq = 0; qq < 4; ++qq) { const f32x2 v = *(const LAS f32x2*)(ks + (uu * 4 + qq) * 128 + 2 * cp); m0 += v.x; m1 += v.y; }
        m0 *= (1.f / 256.f); m1 *= (1.f / 256.f);
        const unsigned hi = pk2(m0, m1), lo = pk2(m0 - bflo(hi), m1 - bfhi(hi));
        GAS unsigned* kh = (GAS unsigned*)(F.ws + WS_KMEAN) + ((size_t)(h * 64 + j) * 128) / 2 + cp;
        kh[0] = hi; kh[NH * NBLK * HD / 2] = lo; }
}
__device__ __forceinline__ void vt_phase(Frame& F) {
    const int gw = F.vcu * NWAVES + F.wave, NGW = F.G * NWAVES, lane = lane_now();
    LAS unsigned char* tile = F.lds + RING_OFF + F.wave * 8704;
    constexpr int NU = (S / 32) * NH;
    v4u raw[2][8];
#pragma unroll
    for (int k = 0; k < 2; ++k) { const int unit = (gw + k * NGW) & (NU - 1); const int h = unit & 7, kb = (unit >> 3) * 32;
            const GAS v4u* src = (const GAS v4u*)(F.ws + WS_V) + ((size_t)kb * 1024 + h * 128) / 8;
#pragma unroll
            for (int i = 0; i < 8; ++i) raw[k][i] = src[(size_t)(i * 4 + (lane >> 4)) * 128 + (lane & 15)]; }
#pragma unroll
    for (int k = 0; k < 2; ++k) { const int unit = gw + k * NGW; if (unit < NU) { const int h = unit & 7, kb = (unit >> 3) * 32;
#pragma unroll
            for (int i = 0; i < 8; ++i) *(LAS v4u*)(tile + (i * 4 + (lane >> 4)) * 272 + (lane & 15) * 16) = raw[k][i];
            LDS_WAIT(); asm volatile("" ::: "memory");
            const int ch = lane & 3, G = ch >> 1, g = ch & 1;
#pragma unroll
            for (int i = 0; i < 8; ++i) { const int d = i * 16 + (lane >> 2);
                unsigned short e[8];
#pragma unroll
                for (int p = 0; p < 8; ++p) { const int key = 16 * G + 8 * (p >> 2) + 4 * g + (p & 3); e[p] = *(const LAS unsigned short*)(tile + key * 272 + d * 2); }
                v4u o; o.x = (unsigned)e[0] | ((unsigned)e[1] << 16); o.y = (unsigned)e[2] | ((unsigned)e[3] << 16); o.z = (unsigned)e[4] | ((unsigned)e[5] << 16); o.w = (unsigned)e[6] | ((unsigned)e[7] << 16);
                *((GAS v4u*)(F.ws + WS_VT) + ((size_t)(h * 128 + d) * S + kb + 8 * ch) / 8) = o; }
            LDS_WAIT(); asm volatile("" ::: "memory"); } }
}

constexpr int CT = 16, CROWS = CT + 30;
__device__ __forceinline__ void conv_phase(Frame& F, int l) {
    LAS unsigned* ub = (LAS unsigned*)(F.lds + RING_OFF);
    LAS f32x2* part = (LAS f32x2*)(F.lds + RING_OFF + CROWS * 2048);
    const int lane = lane_now(), tid = F.wave * 64 + lane;
    const GAS f32x2* cw = (const GAS f32x2*)(F.conv_w + (size_t)l * CKW * 1024) + tid;
    float w0[CKW], w1[CKW];
#pragma unroll
    for (int k = 0; k < CKW; ++k) { const f32x2 w = cw[k * 512]; w0[k] = w.x; w1[k] = w.y; }
    const f32x2 cb = ((const GAS f32x2*)(F.conv_b + l * 1024))[tid], lg = ((const GAS f32x2*)(F.conv_g + l * 1024))[tid], lb = ((const GAS f32x2*)(F.conv_be + l * 1024))[tid];
    const GAS v4u* U = (const GAS v4u*)(F.ws + WS_U);
    GAS unsigned* CAT = (GAS unsigned*)(F.ws + WS_CAT);
    constexpr int NP = (CROWS * 128 + NWAVES * 64 - 1) / (NWAVES * 64);
    const int tb = (int)blockIdx.x * 64;
#pragma clang loop unroll(disable)
    for (int st = 0; st < 4; ++st) { const int t0 = tb + st * CT;
        TSTART(21);
        { const int lane2 = lane_now(), tid2 = F.wave * 64 + lane2;
          v4u nx[NP];
#pragma unroll
          for (int i = 0; i < NP; ++i) { const int p = tid2 + NWAVES * 64 * i, pc = p < CROWS * 128 ? p : CROWS * 128 - 1, tok = t0 - 30 + (pc >> 7);
              const v4u ld = U[(size_t)(tok >= 0 ? tok : 0) * 128 + (pc & 127)]; const bool ok = tok >= 0; nx[i].x = ok ? ld.x : 0u; nx[i].y = ok ? ld.y : 0u; nx[i].z = ok ? ld.z : 0u; nx[i].w = ok ? ld.w : 0u; }
#pragma unroll
          for (int i = 0; i < NP; ++i) { const int p = tid2 + NWAVES * 64 * i; if (p < CROWS * 128) *(LAS v4u*)(ub + (p >> 7) * 512 + (p & 127) * 4) = nx[i]; } }
        __syncthreads();
        TSTOP(21); TSTART(22);
        f32x2 av[CT];
#pragma unroll
        for (int t = 0; t < CT; ++t) av[t] = cb;
#pragma unroll
        for (int r = 0; r < CROWS; ++r) { const unsigned w = ub[r * 512 + tid]; const f32x2 x = {bflo(w), bfhi(w)};
#pragma unroll
            for (int t = 0; t < CT; ++t) { if (r - t >= 0 && r - t <= 30) av[t] += (f32x2){w0[r - t], w1[r - t]} * x; } }
        TSTOP(22); TSTART(23);
        { float red[2 * CT];
#pragma unroll
          for (int t = 0; t < CT; ++t) { red[2 * t] = av[t].x + av[t].y; red[2 * t + 1] = av[t].x * av[t].x + av[t].y * av[t].y; }
          float r16[16], r8[8], r4[4], r2[2], r1;
#define RS_STEP(dst, src, n, bit) { const bool hi = (lane & (bit)) != 0; float snd_[n], kp_[n]; \
            _Pragma("unroll") for (int i = 0; i < (n); ++i) { float lo_ = src[i], up_ = src[i + (n)]; asm volatile("" : "+v"(lo_), "+v"(up_));     \
                snd_[i] = shx(hi ? lo_ : up_, (bit), lane); kp_[i] = hi ? up_ : lo_; } \
            _Pragma("unroll") for (int i = 0; i < (n); ++i) dst[i] = kp_[i] + snd_[i]; }
          RS_STEP(r16, red, 16, 32) RS_STEP(r8, r16, 8, 16) RS_STEP(r4, r8, 4, 8) RS_STEP(r2, r4, 2, 4)
          { const bool hi = (lane & 2) != 0; float lo_ = r2[0], up_ = r2[1]; asm volatile("" : "+v"(lo_), "+v"(up_)); const float snd = shx(hi ? lo_ : up_, 2, lane); r1 = (hi ? up_ : lo_) + snd; }
#undef RS_STEP
          r1 += shx(r1, 1, lane);
          if ((lane & 1) == 0) ((LAS float*)part)[F.wave * (2 * CT) + (lane >> 1)] = r1; }
        __syncthreads();
        LAS f32x2* fin = part + NWAVES * CT;
        if (tid < CT) { float s1 = 0.f, q = 0.f;
#pragma unroll
            for (int w = 0; w < 8; ++w) { const f32x2 pp = part[w * CT + tid]; s1 += pp.x; q += pp.y; }
            const float mean = s1 * (1.f / 1024.f), var = fmaxf(q * (1.f / 1024.f) - mean * mean, 0.f);
            fin[tid] = (f32x2){mean, 1.0f / sqrtf(var + LN_EPS)}; }
        __syncthreads();
        TSTOP(23); TSTART(24);
        { f32x4 fv[CT / 2];
#pragma unroll
          for (int i = 0; i < CT / 2; ++i) fv[i] = ((const LAS f32x4*)fin)[i];
#pragma unroll
          for (int t = 0; t < CT; ++t) { const float mean = fv[t >> 1][2 * (t & 1)], rstd = fv[t >> 1][2 * (t & 1) + 1];
              const float y0 = (av[t].x - mean) * rstd * lg.x + lb.x, y1 = (av[t].y - mean) * rstd * lg.y + lb.y;
              ((GAS unsigned short*)(F.ws + WS_CAT))[((size_t)(t0 + t) * DM + 1024) / 2 + tid] = (unsigned short)pg8::pk4_fp8(y0 * pg8::sigmoidf_fast(y0) * ASC_CAT, y1 * pg8::sigmoidf_fast(y1) * ASC_CAT, 0.f, 0.f); } }
        __syncthreads();
        TSTOP(24);
    }
}

typedef float f32x16 __attribute__((ext_vector_type(16)));
typedef __bf16 bf16x2_t __attribute__((ext_vector_type(2)));
__device__ __forceinline__ unsigned cvtpk(float lo, float hi) { const f32x2 v = {lo, hi}; const bf16x2_t b = __builtin_convertvector(v, bf16x2_t); return __builtin_bit_cast(unsigned, b); }
#define MFMA32(a, b, c) __builtin_amdgcn_mfma_f32_32x32x16_bf16((a), (b), (c), 0, 0, 0)
constexpr int LIST_PER_HEAD = 256 * 2016;
__device__ __forceinline__ int binoff(int j) { return 256 * (63 * j - (j * (j - 1)) / 2); }
#define TOP3_INSERT(v, j) do { const float v_ = (v); const int j_ = (j); \
    if (v_ > tv2) { if (v_ > tv1) { tv2 = tv1; ti2 = ti1; if (v_ > tv0) { tv1 = tv0; ti1 = ti0; tv0 = v_; ti0 = j_; } else { tv1 = v_; ti1 = j_; } } else { tv2 = v_; ti2 = j_; } } } while (0)
__device__ __forceinline__ void sel_phase(Frame& F, int l) {
    LAS int* cntL = (LAS int*)(F.lds + RING_OFF); LAS int* baseL = cntL + 64;
    const int lane = lane_now(), r = lane & 31, hg = lane >> 5, tid = F.wave * 64 + lane;
    const float NEG = -__builtin_inff();
#pragma clang loop unroll(disable)
    for (int unit = blockIdx.x; unit < 63 * NH; unit += F.G) { const int b = 1 + (unit >> 3), h = unit & 7;
        if (tid < 64) cntL[tid] = 0;
        __syncthreads();
        const int t = b * 256 + F.wave * 32 + r;
        const GAS bf16x8* qp = (const GAS bf16x8*)(F.ws + WS_Q) + ((size_t)t * 1024 + h * 128) / 8 + hg;
        bf16x8 qf[8];
#pragma unroll
        for (int kk = 0; kk < 8; ++kk) qf[kk] = qp[2 * kk];
        const GAS bf16x8* kh = (const GAS bf16x8*)(F.ws + WS_KMEAN) + ((size_t)(h * 64 + r) * 128) / 8 + hg;
        f32x16 G0, G1;
#pragma unroll
        for (int i = 0; i < 16; ++i) { G0[i] = 0.f; G1[i] = 0.f; }
#pragma unroll
        for (int kk = 0; kk < 8; ++kk) { G0 = MFMA32(kh[2 * kk], qf[kk], G0); G0 = MFMA32(kh[2 * kk + NH * NBLK * HD / 8], qf[kk], G0); }
        if (b > 32) {
#pragma unroll
            for (int kk = 0; kk < 8; ++kk) { G1 = MFMA32(kh[2 * kk + 32 * 16], qf[kk], G1); G1 = MFMA32(kh[2 * kk + 32 * 16 + NH * NBLK * HD / 8], qf[kk], G1); } }
        float tv0 = NEG, tv1 = NEG, tv2 = NEG; int ti0 = 0, ti1 = 0, ti2 = 0;
#pragma unroll
        for (int i = 0; i < 16; ++i) { const int j = (i & 3) + 8 * (i >> 2) + 4 * hg; TOP3_INSERT(j < b ? G0[i] : NEG, j); }
        if (b > 32) {
#pragma unroll
            for (int i = 0; i < 16; ++i) { const int j = 32 + (i & 3) + 8 * (i >> 2) + 4 * hg; TOP3_INSERT(j < b ? G1[i] : NEG, j); } }
        { const float p0 = shx(tv0, 32, lane), p1 = shx(tv1, 32, lane), p2 = shx(tv2, 32, lane); const int q0 = shx_i(ti0, 32, lane), q1 = shx_i(ti1, 32, lane), q2 = shx_i(ti2, 32, lane);
          TOP3_INSERT(p0, q0); TOP3_INSERT(p1, q1); TOP3_INSERT(p2, q2); }
        int rk0 = 0, rk1 = 0, rk2 = 0;
        if (hg == 0) {
            if (tv0 > NEG) rk0 = __hip_atomic_fetch_add(cntL + ti0, 1, __ATOMIC_RELAXED, __HIP_MEMORY_SCOPE_WORKGROUP);
            if (tv1 > NEG) rk1 = __hip_atomic_fetch_add(cntL + ti1, 1, __ATOMIC_RELAXED, __HIP_MEMORY_SCOPE_WORKGROUP);
            if (tv2 > NEG) rk2 = __hip_atomic_fetch_add(cntL + ti2, 1, __ATOMIC_RELAXED, __HIP_MEMORY_SCOPE_WORKGROUP); }
        __syncthreads();
        if (tid < 64) { const int c = cntL[tid]; if (c > 0) baseL[tid] = (int)__hip_atomic_fetch_add(F.ctl + CW_LCNT + l * 512 + h * 64 + tid, (unsigned)c, RLX_AGENT); }
        __syncthreads();
        if (hg == 0) { GAS int* L = (GAS int*)(F.ws + WS_LIST) + (size_t)h * LIST_PER_HEAD;
            if (tv0 > NEG) L[binoff(ti0) + baseL[ti0] + rk0] = t * 4 + 0;
            if (tv1 > NEG) L[binoff(ti1) + baseL[ti1] + rk1] = t * 4 + 1;
            if (tv2 > NEG) L[binoff(ti2) + baseL[ti2] + rk2] = t * 4 + 2; }
        __syncthreads();
    }
}
constexpr int KROW = 272, VROW = 528, KBUF_BYTES = 256 * KROW, VBUF_BYTES = 128 * VROW;
#define SCHED_FENCE() __builtin_amdgcn_sched_barrier(0)
template <bool CAUSAL>
__device__ __forceinline__ void moba_tile(const bf16x8 (&qf)[8], const LAS unsigned char* kb, const LAS unsigned char* vb, const int nkt, const int r, const int hg, f32x16 (&O)[4], float& ms, float& lsum) {
    const float NEG = -__builtin_inff(), SC = 0.08838834764831845f * 1.44269504088896341f;
    f32x16 Sx[8];
    bf16x8 kfA[8], kfB[8];
#pragma unroll
    for (int kk = 0; kk < 8; ++kk) kfA[kk] = *(const LAS bf16x8*)(kb + kk * 32);
#pragma unroll
    for (int kt = 0; kt < 8; ++kt) {
        if (kt < nkt) { f32x16 a;
#pragma unroll
            for (int i = 0; i < 16; ++i) a[i] = 0.f;
            if (kt + 1 < 8 && kt + 1 < nkt) {
#pragma unroll
                for (int kk = 0; kk < 8; ++kk) { if (kt & 1) kfA[kk] = *(const LAS bf16x8*)(kb + (kt + 1) * 32 * KROW + kk * 32); else kfB[kk] = *(const LAS bf16x8*)(kb + (kt + 1) * 32 * KROW + kk * 32); } }
            SCHED_FENCE();
#pragma unroll
            for (int kk = 0; kk < 8; ++kk) a = MFMA32((kt & 1) ? kfB[kk] : kfA[kk], qf[kk], a);
            SCHED_FENCE();
            if (CAUSAL && kt == nkt - 1) {
#pragma unroll
                for (int i = 0; i < 16; ++i) a[i] = ((i & 3) + 8 * (i >> 2) + 4 * hg > r) ? NEG : a[i]; }
            Sx[kt] = a;
        } else {
#pragma unroll
            for (int i = 0; i < 16; ++i) Sx[kt][i] = NEG; }
    }
    float mx = NEG;
#pragma unroll
    for (int kt = 0; kt < 8; ++kt)
#pragma unroll
        for (int i = 0; i < 16; ++i) mx = fmaxf(mx, Sx[kt][i]);
    mx = fmaxf(mx, shx(mx, 32, r + 32 * hg));
    ms = mx * SC;
    float ls = 0.f;
    bf16x8 pb[8][2];
#pragma unroll
    for (int kt = 0; kt < 8; ++kt)
#pragma unroll
        for (int s2 = 0; s2 < 2; ++s2) { float p[8];
#pragma unroll
            for (int i = 0; i < 8; ++i) { p[i] = __builtin_amdgcn_exp2f(Sx[kt][8 * s2 + i] * SC - ms); ls += p[i]; }
            v4u pw; pw.x = cvtpk(p[0], p[1]); pw.y = cvtpk(p[2], p[3]); pw.z = cvtpk(p[4], p[5]); pw.w = cvtpk(p[6], p[7]);
            pb[kt][s2] = __builtin_bit_cast(bf16x8, pw); }
    lsum = ls + shx(ls, 32, r + 32 * hg);
#pragma unroll
    for (int dt = 0; dt < 4; ++dt)
#pragma unroll
        for (int i = 0; i < 16; ++i) O[dt][i] = 0.f;
    bf16x8 vfA[4], vfB[4];
#pragma unroll
    for (int dt = 0; dt < 4; ++dt) vfA[dt] = *(const LAS bf16x8*)(vb + dt * 32 * VROW);
#pragma unroll
    for (int st = 0; st < 16; ++st) { const int kt = st >> 1, s2 = st & 1;
        if (kt < nkt) {
            if (st + 1 < 16 && ((st + 1) >> 1) < nkt) {
#pragma unroll
                for (int dt = 0; dt < 4; ++dt) { if (st & 1) vfA[dt] = *(const LAS bf16x8*)(vb + dt * 32 * VROW + (st + 1) * 32); else vfB[dt] = *(const LAS bf16x8*)(vb + dt * 32 * VROW + (st + 1) * 32); } }
            SCHED_FENCE();
#pragma unroll
            for (int dt = 0; dt < 4; ++dt) O[dt] = MFMA32((st & 1) ? vfB[dt] : vfA[dt], pb[kt][s2], O[dt]);
            SCHED_FENCE();
        }
    }
}
__device__ __forceinline__ void stage_kv(Frame& F, int h, int j, int tid) {
    LAS unsigned char* kbuf = F.lds + RING_OFF; LAS unsigned char* vbuf = kbuf + KBUF_BYTES;
    const GAS v4u* kg = (const GAS v4u*)(F.ws + WS_K) + ((size_t)(j * 256) * 1024 + h * 128) / 8;
    const GAS v4u* vg = (const GAS v4u*)(F.ws + WS_VT) + ((size_t)(h * 128) * S + j * 256) / 8;
    v4u kr[8], vr[8];
#pragma unroll
    for (int i = 0; i < 8; ++i) { const int p = tid + 512 * i; kr[i] = kg[(size_t)(p >> 4) * 128 + (p & 15)]; vr[i] = vg[(size_t)(p >> 5) * (S / 8) + (p & 31)]; }
#pragma unroll
    for (int i = 0; i < 8; ++i) { const int p = tid + 512 * i; *(LAS v4u*)(kbuf + (p >> 4) * KROW + (p & 15) * 16) = kr[i]; *(LAS v4u*)(vbuf + (p >> 5) * VROW + (p & 31) * 16) = vr[i]; }
}
__device__ __forceinline__ void partial_phase(Frame& F, int l) {
    gu32* lcnt = F.ctl + CW_LCNT + l * 512;
    LAS int* tab = (LAS int*)(F.lds + RING_OFF + KBUF_BYTES + VBUF_BYTES);
    LAS int* tabc = tab + 512;
    LAS int* tabn = tab + 1024;
    { const int lane = lane_now(); int tl[8], cs[8], cn[8], sum = 0, csum = 0;
#pragma unroll
      for (int i = 0; i < 8; ++i) { cn[i] = (int)__hip_atomic_load(lcnt + lane * 8 + i, RLX_AGENT); tl[i] = (cn[i] + 255) >> 8; cs[i] = 14 * tl[i] + (tl[i] ? 11 : 0); sum += tl[i]; csum += cs[i]; }
      int inc = sum, cinc = csum;
#pragma unroll
      for (int o = 1; o < 64; o <<= 1) { const int v = __builtin_amdgcn_ds_bpermute((lane - o) << 2, inc), cv = __builtin_amdgcn_ds_bpermute((lane - o) << 2, cinc); if (lane >= o) { inc += v; cinc += cv; } }
      int run = inc - sum, crun = cinc - csum;
      if (F.wave == 0) {
#pragma unroll
          for (int i = 0; i < 8; ++i) { run += tl[i]; crun += cs[i]; tab[lane * 8 + i] = run; tabc[lane * 8 + i] = crun; tabn[lane * 8 + i] = cn[i]; } } }
    __syncthreads();
    int u_lo, u_hi;
    { const int lane = lane_now(); const long T = tabc[511];
      const int x0 = (int)(((long)blockIdx.x * T) / F.G), x1 = (int)(((long)(blockIdx.x + 1) * T) / F.G);
      int c0 = 0, c1 = 0; int plo = lane ? tabc[lane * 8 - 1] : 0, pu = lane ? tab[lane * 8 - 1] : 0;
#pragma unroll
      for (int i = 0; i < 8; ++i) { const int hi = tabc[lane * 8 + i], uu = tab[lane * 8 + i], nu = uu - pu;
          { const int loc = x0 - plo; c0 += (x0 >= hi) ? nu : (loc <= 0 ? 0 : (loc <= 25 ? 1 : 1 + (loc - 25 + 13) / 14)); }
          { const int loc = x1 - plo; c1 += (x1 >= hi) ? nu : (loc <= 0 ? 0 : (loc <= 25 ? 1 : 1 + (loc - 25 + 13) / 14)); }
          plo = hi; pu = uu; }
#pragma unroll
      for (int o = 1; o < 64; o <<= 1) { c0 += shx_i(c0, o, lane); c1 += shx_i(c1, o, lane); }
      u_lo = __builtin_amdgcn_readfirstlane(c0); u_hi = __builtin_amdgcn_readfirstlane(c1); }
    int staged = -1;
#define PARTIAL_LOCATE(uu, obin, ochunk, oe) { const int lane_ = lane_now(); int b_ = 0, c_ = 0; bool m_ = false; \
        { int lo_ = lane_ ? tab[lane_ * 8 - 1] : 0; \
          _Pragma("unroll") for (int i = 0; i < 8; ++i) { const int hi_ = tab[lane_ * 8 + i]; if ((uu) >= lo_ && (uu) < hi_) { m_ = true; b_ = lane_ * 8 + i; c_ = (uu) - lo_; } lo_ = hi_; } } \
        const int s_ = __builtin_ctzll(__ballot(m_)); obin = __builtin_amdgcn_readlane(b_, s_); ochunk = __builtin_amdgcn_readlane(c_, s_); \
        const int n_ = __builtin_amdgcn_readfirstlane(tabn[obin]), base_ = ochunk * 256 + F.wave * 32, r_ = lane_ & 31; \
        oe = ((const GAS int*)(F.ws + WS_LIST))[(size_t)(obin >> 6) * LIST_PER_HEAD + binoff(obin & 63) + (base_ < n_ ? base_ + (base_ + r_ < n_ ? r_ : 0) : 0)]; }
    int nbin = 0, nchunk = 0, ne = 0;
    if (u_lo < u_hi) PARTIAL_LOCATE(u_lo, nbin, nchunk, ne)
#pragma clang loop unroll(disable)
    for (int u = u_lo; u < u_hi; ++u) {
        const int lane = lane_now(), r = lane & 31, hg = lane >> 5, tid = F.wave * 64 + lane;
        const LAS unsigned char* kb = F.lds + RING_OFF + r * KROW + hg * 16; const LAS unsigned char* vb = F.lds + RING_OFF + KBUF_BYTES + r * VROW + hg * 16;
        TSTART(41);
        const int bin = nbin, chunk = nchunk, e = ne;
        { const int un = (u + 1 < u_hi) ? u + 1 : u; PARTIAL_LOCATE(un, nbin, nchunk, ne) }
        const int h = bin >> 6, j = bin & 63, n = __builtin_amdgcn_readfirstlane(tabn[bin]);
        const int base = chunk * 256 + F.wave * 32; const bool active = base < n, valid = base + r < n;
        const int t = e >> 2, sl = e & 3;
        const GAS bf16x8* qp = (const GAS bf16x8*)(F.ws + WS_Q) + ((size_t)t * 1024 + h * 128) / 8 + hg;
        bf16x8 qf[8];
#pragma unroll
        for (int kk = 0; kk < 8; ++kk) qf[kk] = qp[2 * kk];
        TSTOP(41); TSTART(42);
        if (bin != staged) {
            __syncthreads();
            stage_kv(F, h, j, tid);
            __syncthreads();
            staged = bin; }
        TSTOP(42);
        if (active) {
            f32x16 O[4]; float ms, ls;
            TSTART(43);
            moba_tile<false>(qf, kb, vb, 8, r, hg, O, ms, ls);
            TSTOP(43); TSTART(44);
            if (valid) { const size_t idx = ((size_t)h * S + t) * 3 + sl; const float inv = 1.0f / ls;
                GAS v2u* po = (GAS v2u*)(F.ws + WS_PO) + idx * 32 + hg;
#pragma unroll
                for (int dt = 0; dt < 4; ++dt)
#pragma unroll
                    for (int g4 = 0; g4 < 4; ++g4) po[dt * 8 + 2 * g4] = (v2u){cvtpk(O[dt][4 * g4] * inv, O[dt][4 * g4 + 1] * inv), cvtpk(O[dt][4 * g4 + 2] * inv, O[dt][4 * g4 + 3] * inv)};
                if (hg == 0) ((GAS f32x2*)(F.ws + WS_PML))[idx] = (f32x2){ms, ls}; }
            TSTOP(44);
        }
    }
#undef PARTIAL_LOCATE
}
__device__ __forceinline__ void own_phase(Frame& F) {
#pragma clang loop unroll(disable)
    for (int u = blockIdx.x; u < NBLK * NH; u += F.G) { const int h = u & 7, b = u >> 3, qt = F.wave;
        const int lane = lane_now(), r = lane & 31, hg = lane >> 5, tid = F.wave * 64 + lane;
        const LAS unsigned char* kb = F.lds + RING_OFF + r * KROW + hg * 16; const LAS unsigned char* vb = F.lds + RING_OFF + KBUF_BYTES + r * VROW + hg * 16;
        const int t = b * 256 + qt * 32 + r;
        const GAS bf16x8* qp = (const GAS bf16x8*)(F.ws + WS_Q) + ((size_t)t * 1024 + h * 128) / 8 + hg;
        bf16x8 qf[8];
#pragma unroll
        for (int kk = 0; kk < 8; ++kk) qf[kk] = qp[2 * kk];
        __syncthreads();
        stage_kv(F, h, b, tid);
        __syncthreads();
        f32x16 O[4]; float ms, ls;
        moba_tile<true>(qf, kb, vb, qt + 1, r, hg, O, ms, ls);
        __syncthreads();
        { LAS unsigned char* ow = F.lds + RING_OFF + F.wave * 8704;
          LAS f32x2* stq = (LAS f32x2*)(F.lds + RING_OFF + KBUF_BYTES) + F.wave * 32;
#pragma unroll
          for (int dt = 0; dt < 4; ++dt)
#pragma unroll
              for (int g4 = 0; g4 < 4; ++g4) *(LAS v2u*)(ow + r * 272 + (dt * 32 + 8 * g4 + 4 * hg) * 2) = (v2u){cvtpk(O[dt][4 * g4], O[dt][4 * g4 + 1]), cvtpk(O[dt][4 * g4 + 2], O[dt][4 * g4 + 3])};
          if (hg == 0) stq[r] = (f32x2){ms, ls};
          LDS_WAIT(); asm volatile("" ::: "memory");
          const int qq = lane >> 4, c = lane & 15, nv = b < 3 ? b : 3;
#pragma unroll
          for (int half = 0; half < 2; ++half) {
              v4u pv[4][3]; f32x2 pml[4][3];
#pragma unroll
              for (int pp = 0; pp < 4; ++pp) { const int q = 4 * (half * 4 + pp) + qq; const size_t idx0 = ((size_t)h * S + (b * 256 + qt * 32 + q)) * 3;
#pragma unroll
                  for (int s2 = 0; s2 < 3; ++s2) { const int so = s2 < nv ? s2 : 0;
                      pv[pp][s2] = ((const GAS v4u*)(F.ws + WS_PO))[(idx0 + so) * 16 + c]; pml[pp][s2] = ((const GAS f32x2*)(F.ws + WS_PML))[idx0 + so]; } }
#pragma unroll
              for (int pp = 0; pp < 4; ++pp) { const int q = 4 * (half * 4 + pp) + qq, t2 = b * 256 + qt * 32 + q;
                  const f32x2 own = stq[q]; const v4u ov = *(const LAS v4u*)(ow + q * 272 + c * 16);
                  float M = own.x;
#pragma unroll
                  for (int s2 = 0; s2 < 3; ++s2) { const bool have = s2 < nv; pml[pp][s2].x = have ? pml[pp][s2].x : -__builtin_inff(); pml[pp][s2].y = have ? pml[pp][s2].y : 0.f;
                      pv[pp][s2].x = have ? pv[pp][s2].x : 0u; pv[pp][s2].y = have ? pv[pp][s2].y : 0u; pv[pp][s2].z = have ? pv[pp][s2].z : 0u; pv[pp][s2].w = have ? pv[pp][s2].w : 0u;
                      M = fmaxf(M, pml[pp][s2].x); }
                  const float wo = __builtin_amdgcn_exp2f(own.x - M); float W = own.y * wo, w[3];
#pragma unroll
                  for (int s2 = 0; s2 < 3; ++s2) { w[s2] = pml[pp][s2].y * __builtin_amdgcn_exp2f(pml[pp][s2].x - M); W += w[s2]; }
                  float o[8] = {bflo(ov.x) * wo, bfhi(ov.x) * wo, bflo(ov.y) * wo, bfhi(ov.y) * wo, bflo(ov.z) * wo, bfhi(ov.z) * wo, bflo(ov.w) * wo, bfhi(ov.w) * wo};
#pragma unroll
                  for (int s2 = 0; s2 < 3; ++s2) { const v4u v = pv[pp][s2]; o[0] += w[s2] * bflo(v.x); o[1] += w[s2] * bfhi(v.x); o[2] += w[s2] * bflo(v.y); o[3] += w[s2] * bfhi(v.y); o[4] += w[s2] * bflo(v.z); o[5] += w[s2] * bfhi(v.z); o[6] += w[s2] * bflo(v.w); o[7] += w[s2] * bfhi(v.w); }
                  const float osc = ASC_CAT / W;
                  *(GAS v2u*)(F.ws + WS_CAT + (size_t)t2 * DM + h * 128 + 8 * c) = (v2u){pg8::pk4_fp8(o[0] * osc, o[1] * osc, o[2] * osc, o[3] * osc), pg8::pk4_fp8(o[4] * osc, o[5] * osc, o[6] * osc, o[7] * osc)}; }
          } }
    }
}

__device__ __forceinline__ void ln_phase(Frame& F, const float* xres_, const bf16* y_, const float* g_, const float* b_, const float* router, int q8  ) {
    const int gw = F.vcu * NWAVES + F.wave, lane = lane_now();
    f32x4 gv[8], bv[8];
#pragma unroll
    for (int j = 0; j < 8; ++j) { gv[j] = ((const GAS f32x4*)g_)[lane + 64 * j]; bv[j] = ((const GAS f32x4*)b_)[lane + 64 * j]; }
    f32x4 hraw[8]; v2u hraw16[8], yraw[8];
    { const GAS v2u* yp = (const GAS v2u*)(y_ + (size_t)(gw * 8) * DM) + lane;
      if (xres_) { const GAS f32x4* hp = (const GAS f32x4*)(xres_ + (size_t)(gw * 8) * DM) + lane;
#pragma unroll
          for (int j = 0; j < 8; ++j) hraw[j] = hp[64 * j]; }
      else { const GAS v2u* hp = (const GAS v2u*)(F.ws + WS_HB + (size_t)(gw * 8) * DM * 2) + lane;
#pragma unroll
          for (int j = 0; j < 8; ++j) hraw16[j] = hp[64 * j]; }
#pragma unroll
      for (int j = 0; j < 8; ++j) yraw[j] = yp[64 * j]; }
#pragma clang loop unroll(disable)
    for (int i = 0; i < S / (256 * NWAVES); ++i) { const int row = gw * (S / (256 * NWAVES)) + i;
        f32x4 v[8]; float s = 0.f;
#pragma unroll
        for (int j = 0; j < 8; ++j) { const v2u yv = yraw[j]; const f32x4 hv = xres_ ? hraw[j] : (f32x4){bflo(hraw16[j].x), bfhi(hraw16[j].x), bflo(hraw16[j].y), bfhi(hraw16[j].y)};
            v[j] = hv * ALPHA + (f32x4){bflo(yv.x), bfhi(yv.x), bflo(yv.y), bfhi(yv.y)}; s += (v[j][0] + v[j][1]) + (v[j][2] + v[j][3]); }
        { const int rown = (i + 1 < S / (256 * NWAVES)) ? row + 1 : row;
          const GAS v2u* yp = (const GAS v2u*)(y_ + (size_t)rown * DM) + lane;
            if (xres_) { const GAS f32x4* hp = (const GAS f32x4*)(xres_ + (size_t)rown * DM) + lane;
#pragma unroll
                for (int j = 0; j < 8; ++j) hraw[j] = hp[64 * j]; }
            else { const GAS v2u* hp = (const GAS v2u*)(F.ws + WS_HB + (size_t)rown * DM * 2) + lane;
#pragma unroll
                for (int j = 0; j < 8; ++j) hraw16[j] = hp[64 * j]; }
#pragma unroll
            for (int j = 0; j < 8; ++j) yraw[j] = yp[64 * j]; }
        const float mean = wave_sum(s, lane) * (1.f / DM); float s2 = 0.f;
#pragma unroll
        for (int j = 0; j < 8; ++j) { v[j] = v[j] - mean; s2 += (v[j][0] * v[j][0] + v[j][1] * v[j][1]) + (v[j][2] * v[j][2] + v[j][3] * v[j][3]); }
        const float rstd = 1.f / sqrtf(wave_sum(s2, lane) * (1.f / DM) + LN_EPS);
        GAS v2u* hb = (GAS v2u*)(F.ws + WS_HB + (size_t)row * DM * 2) + lane;
        float amax = 0.f;
#pragma unroll
        for (int j = 0; j < 8; ++j) { v[j] = v[j] * rstd * gv[j] + bv[j]; hb[64 * j] = (v2u){pk2(v[j][0], v[j][1]), pk2(v[j][2], v[j][3])};
            amax = fmaxf(fmaxf(amax, fmaxf(fabsf(v[j][0]), fabsf(v[j][1]))), fmaxf(fabsf(v[j][2]), fabsf(v[j][3])));
            if (q8 == 1) ((GAS unsigned*)(F.ws + WS_HB8 + (size_t)row * DM))[64 * j + lane] = pg8::pk4_fp8(v[j][0] * ASC_H, v[j][1] * ASC_H, v[j][2] * ASC_H, v[j][3] * ASC_H); }
        if (q8 == 2) { amax = fmaxf(wave_max(amax, lane), 1e-20f); const float qs = 127.f / amax;
#pragma unroll
            for (int j = 0; j < 8; ++j) ((GAS unsigned*)(F.ws + WS_HB8 + (size_t)row * DM))[64 * j + lane] = pg8::pk4_i8(v[j][0] * qs, v[j][1] * qs, v[j][2] * qs, v[j][3] * qs);
            if (lane == 0) ((GAS float*)(F.ws + WS_RSC))[row] = amax * (1.f / 127.f); }
    }
}
typedef float f32x4r __attribute__((ext_vector_type(4)));
__device__ __forceinline__ void router_phase(Frame& F) {
    const int lane = lane_now(), rr = lane & 15, kg = lane >> 4, w = F.wave;
    LAS float* lg = (LAS float*)(F.lds + RING_OFF);
    const GAS bf16x8* bp = (const GAS bf16x8*)(F.ws + WS_RWT) + ((size_t)(rr & 7) * DM + 256 * w) / 8 + kg;
    const bool colok = rr < 8;
    bf16x8 bh[8], bl[8], af[4][8];
#pragma unroll
    for (int kk = 0; kk < 8; ++kk) { bh[kk] = bp[4 * kk]; bl[kk] = bp[4 * kk + NE * DM / 8]; }
#pragma unroll
    for (int g = 0; g < 4; ++g) { const int row0 = ((int)blockIdx.x + F.G * g) * 16; const GAS bf16x8* ap = (const GAS bf16x8*)(F.ws + WS_HB) + ((size_t)(row0 + rr) * DM + 256 * w) / 8 + kg;
#pragma unroll
        for (int kk = 0; kk < 8; ++kk) af[g][kk] = ap[4 * kk]; }
    if (!colok) {
#pragma unroll
        for (int kk = 0; kk < 8; ++kk) { bh[kk] = (bf16x8){0, 0, 0, 0, 0, 0, 0, 0}; bl[kk] = bh[kk]; } }
#pragma unroll
    for (int g = 0; g < 4; ++g) { f32x4r acc = {0.f, 0.f, 0.f, 0.f};
#pragma unroll
        for (int kk = 0; kk < 8; ++kk) { acc = __builtin_amdgcn_mfma_f32_16x16x32_bf16(af[g][kk], bh[kk], acc, 0, 0, 0); acc = __builtin_amdgcn_mfma_f32_16x16x32_bf16(af[g][kk], bl[kk], acc, 0, 0, 0); }
        if (colok) {
#pragma unroll
            for (int i = 0; i < 4; ++i) lg[((g * 8 + w) * 16 + 4 * kg + i) * 8 + rr] = acc[i]; } }
    __syncthreads();
    if (w == 0) { const int g = lane >> 4, r = lane & 15; float v[8] = {0.f, 0.f, 0.f, 0.f, 0.f, 0.f, 0.f, 0.f};
#pragma unroll
        for (int ww = 0; ww < 8; ++ww) { const f32x4r l0 = *(const LAS f32x4r*)(lg + ((g * 8 + ww) * 16 + r) * 8), l1 = *(const LAS f32x4r*)(lg + ((g * 8 + ww) * 16 + r) * 8 + 4);
            v[0] += l0[0]; v[1] += l0[1]; v[2] += l0[2]; v[3] += l0[3]; v[4] += l1[0]; v[5] += l1[1]; v[6] += l1[2]; v[7] += l1[3]; }
        float v1 = v[0]; int i1 = 0;
#pragma unroll
        for (int e = 1; e < 8; ++e) if (v[e] > v1) { v1 = v[e]; i1 = e; }
        float v2 = -__builtin_inff(); int i2 = -1;
#pragma unroll
        for (int e = 0; e < 8; ++e) if (e != i1 && v[e] > v2) { v2 = v[e]; i2 = e; }
        const float g1 = 1.0f / (1.0f + __expf(v2 - v1)), g2 = 1.0f - g1; const int row = ((int)blockIdx.x + F.G * g) * 16 + r;
        ((GAS int*)(F.ws + WS_EIDX))[row * 2] = i1; ((GAS int*)(F.ws + WS_EIDX))[row * 2 + 1] = i2; ((GAS float*)(F.ws + WS_GATEW))[row * 2] = g1; ((GAS float*)(F.ws + WS_GATEW))[row * 2 + 1] = g2;
        int mine = 0;
#pragma unroll
        for (int e = 0; e < 8; ++e) { const int c = __builtin_popcountll(__ballot(i1 == e)) + __builtin_popcountll(__ballot(i2 == e)); mine = (lane == e) ? c : mine; }
        if (lane < 8 && mine) __hip_atomic_fetch_add(F.ctl + CW_ECNT + 64 * lane, (unsigned)mine, RLX_AGENT); }
    __syncthreads();
}
__device__ __forceinline__ void load_expert_layout(Frame& F, int (&off)[8], int (&cum)[8], int& npanels) {
    const int lane = lane_now();
    const int cv = (int)__hip_atomic_load(F.ctl + CW_ECNT + 64 * (lane & 7), RLX_AGENT);
    int o = 0;
#pragma unroll
    for (int e = 0; e < 8; ++e) { const int c = __builtin_amdgcn_readlane(cv, e); off[e] = o; cum[e] = o >> 8; o += (c + 255) & ~255; }
    npanels = o >> 8;
}
__device__ __forceinline__ void route_phase(Frame& F) {
    const int gw = F.vcu * NWAVES + F.wave, lane = lane_now();
    int off[8], cum[8], np; load_expert_layout(F, off, cum, np);
    const int row = gw * 8 + (lane >> 1), slot = lane & 1; const bool act = lane < 16;
    const int mye = act ? ((const GAS int*)(F.ws + WS_EIDX))[row * 2 + slot] : -1;
    int pos = 0;
#pragma unroll
    for (int e = 0; e < 8; ++e) { const unsigned long long mask = __ballot(mye == e);
        if (mask) { const int leader = __builtin_ctzll(mask), n = __builtin_popcountll(mask); unsigned b = 0u;
            if (lane == leader) b = __hip_atomic_fetch_add(F.ctl + CW_ECUR + 64 * e, (unsigned)n, RLX_AGENT);
            b = (unsigned)shl_i((int)b, leader);
            if (mye == e) pos = off[e] + (int)b + __builtin_popcountll(mask & ((1ull << lane) - 1ull)); } }
    if (act) { ((GAS int*)(F.ws + WS_ROWPOS))[row * 2 + slot] = pos; ((GAS float*)(F.ws + WS_RSP))[pos] = ((const GAS float*)(F.ws + WS_RSC))[row]; }
#pragma clang loop unroll(disable)
    for (int k0 = 0; k0 < 16; k0 += 8) {
        v4u t[8][2];
#pragma unroll
        for (int k = 0; k < 8; ++k) { const int r = gw * 8 + ((k0 + k) >> 1); const GAS v4u* src = (const GAS v4u*)(F.ws + WS_HB8 + (size_t)r * DM) + lane; t[k][0] = src[0]; t[k][1] = src[64]; }
#pragma unroll
        for (int k = 0; k < 8; ++k) { const int p = __builtin_amdgcn_readfirstlane(shl_i(pos, k0 + k)); GAS v4u* dst = (GAS v4u*)(F.ws + WS_HBP + (size_t)p * DM) + lane; dst[0] = t[k][0]; dst[64] = t[k][1]; }
    }
}
__device__ __forceinline__ void ln_moe_phase(Frame& F, const float* g_, const float* b_) {
    const int gw = F.vcu * NWAVES + F.wave, lane = lane_now();
    f32x4 gv[8], bv[8];
#pragma unroll
    for (int j = 0; j < 8; ++j) { gv[j] = ((const GAS f32x4*)g_)[lane + 64 * j]; bv[j] = ((const GAS f32x4*)b_)[lane + 64 * j]; }
    int mp1 = 0, mp2 = 0; float mg1 = 0.f, mg2 = 0.f;
    if (lane < 8) { const int rr = gw * 8 + lane; mp1 = ((const GAS int*)(F.ws + WS_ROWPOS))[rr * 2]; mp2 = ((const GAS int*)(F.ws + WS_ROWPOS))[rr * 2 + 1]; mg1 = ((const GAS float*)(F.ws + WS_GATEW))[rr * 2]; mg2 = ((const GAS float*)(F.ws + WS_GATEW))[rr * 2 + 1]; }
    v2u hraw[8], araw[8], braw[8];
    { const int p1 = __builtin_amdgcn_readlane(mp1, 0), p2 = __builtin_amdgcn_readlane(mp2, 0);
      const GAS v2u* hp = (const GAS v2u*)(F.ws + WS_HB + (size_t)(gw * 8) * DM * 2) + lane;
      const GAS v2u* y1 = (const GAS v2u*)(F.ws + WS_R2 + (size_t)p1 * DM * 2) + lane; const GAS v2u* y2 = (const GAS v2u*)(F.ws + WS_R2 + (size_t)p2 * DM * 2) + lane;
#pragma unroll
      for (int j = 0; j < 8; ++j) { hraw[j] = hp[64 * j]; araw[j] = y1[64 * j]; braw[j] = y2[64 * j]; } }
#pragma clang loop unroll(disable)
    for (int i = 0; i < 8; ++i) { const int row = gw * 8 + i;
        const float g1 = __builtin_bit_cast(float, shl_i(__builtin_bit_cast(int, mg1), i)), g2 = __builtin_bit_cast(float, shl_i(__builtin_bit_cast(int, mg2), i));
        f32x4 v[8]; float s = 0.f;
#pragma unroll
        for (int j = 0; j < 8; ++j) { const v2u a = araw[j], b = braw[j];
            const f32x4 fa = (f32x4){bflo(a.x), bfhi(a.x), bflo(a.y), bfhi(a.y)}, fb = (f32x4){bflo(b.x), bfhi(b.x), bflo(b.y), bfhi(b.y)};
            v[j] = (f32x4){bflo(hraw[j].x), bfhi(hraw[j].x), bflo(hraw[j].y), bfhi(hraw[j].y)} * ALPHA + fa * g1 + fb * g2; s += (v[j][0] + v[j][1]) + (v[j][2] + v[j][3]); }
        { const int in = (i + 1 < 8) ? i + 1 : i; const int p1 = __builtin_amdgcn_readfirstlane(shl_i(mp1, in)), p2 = __builtin_amdgcn_readfirstlane(shl_i(mp2, in));
            const GAS v2u* hp = (const GAS v2u*)(F.ws + WS_HB + (size_t)(gw * 8 + in) * DM * 2) + lane;
            const GAS v2u* y1 = (const GAS v2u*)(F.ws + WS_R2 + (size_t)p1 * DM * 2) + lane; const GAS v2u* y2 = (const GAS v2u*)(F.ws + WS_R2 + (size_t)p2 * DM * 2) + lane;
#pragma unroll
            for (int j = 0; j < 8; ++j) { hraw[j] = hp[64 * j]; araw[j] = y1[64 * j]; braw[j] = y2[64 * j]; } }
        const float mean = wave_sum(s, lane) * (1.f / DM); float s2 = 0.f;
#pragma unroll
        for (int j = 0; j < 8; ++j) { v[j] = v[j] - mean; s2 += (v[j][0] * v[j][0] + v[j][1] * v[j][1]) + (v[j][2] * v[j][2] + v[j][3] * v[j][3]); }
        const float rstd = 1.f / sqrtf(wave_sum(s2, lane) * (1.f / DM) + LN_EPS);
        GAS f32x4* op = (GAS f32x4*)(F.out + (size_t)row * DM) + lane;
#pragma unroll
        for (int j = 0; j < 8; ++j) op[64 * j] = v[j] * rstd * gv[j] + bv[j];
    }
}

struct Args { const float* in[18]; float* out; unsigned char* ws; };
__global__ void __launch_bounds__(NWAVES * 64, 2) hymba_fwd(Args args) {
    extern __shared__ __attribute__((aligned(16))) unsigned char lds[];
    Frame F;
    F.lds = (LAS unsigned char*)lds;
    F.MISC = (volatile LAS unsigned*)(F.lds + MISC_OFF);
    F.wave = __builtin_amdgcn_readfirstlane((int)threadIdx.x >> 6);
    F.G = gridDim.x; { const int bx = blockIdx.x; F.vcu = (F.G % 8 == 0) ? (bx % 8) * (F.G / 8) + bx / 8 : bx; }
    F.ws = args.ws; F.ctl = (gu32*)(args.ws + WS_CTL);
    F.x = args.in[0]; F.w_in = args.in[1]; F.conv_w = args.in[2]; F.conv_b = args.in[3]; F.conv_g = args.in[4]; F.conv_be = args.in[5]; F.w_out = args.in[6];
    F.lnm_g = args.in[7]; F.lnm_b = args.in[8]; F.lnf_g = args.in[9]; F.lnf_b = args.in[10]; F.fg = args.in[11]; F.fu = args.in[12]; F.fd = args.in[13];
    F.router = args.in[14]; F.eg = args.in[15]; F.eu = args.in[16]; F.ed = args.in[17]; F.out = args.out;
    for (int u = threadIdx.x; u < (LDS_BYTES - LDSCTL_OFF) / 4; u += NWAVES * 64) ((LAS unsigned*)(F.lds + LDSCTL_OFF))[u] = 0u;
    __syncthreads();
    XcdBarrier bar = xcd_barrier_post((unsigned*)(F.ctl + CW_BAR), F.MISC + 8, F.wave);
#define LAUNDER() asm volatile("" : "+s"(F.ws), "+s"(F.ctl), "+s"(F.out), "+s"(F.x), "+s"(bar.bar), "+s"(F.wave))
#define GRID_BAR_N(k) do { LAUNDER(); TSTART(200); TSTART(200 + (k)); xcd_barrier(bar); TSTOP(200); TSTOP(200 + (k)); LAUNDER(); } while (0)
#define GRID_BAR() GRID_BAR_N(99)
#ifndef PROBE_ID
#define PROBE_ID 0
#endif
    F.tacc = 0ull; F.tt0 = 0ull;
#define HB ((bf16*)(F.ws + WS_HB))
#define Y ((bf16*)(F.ws + WS_R2))

    TSTART(10); p0_prologue(F); TSTOP(10);
    GRID_BAR_N(1);

#pragma clang loop unroll(disable)
    for (int l = 0; l < 2; ++l) {
#ifndef NO_G_INPROJ
        TSTART(11);
        { pg8::Gemm g{(const bf16*)(F.ws + WS_HB8), (const bf16*)(F.ws + WS_WIN + (size_t)l * 20 * MiB), S, NPROJ, DM / 2, 0}; pg8::StaticOrder So; So.init(S, NPROJ, F.G, (int)blockIdx.x);
          pg8::EpiInProj E{(bf16*)(F.ws + WS_Q), (bf16*)(F.ws + WS_K), (bf16*)(F.ws + WS_V), (bf16*)(F.ws + WS_U), (const float*)(F.ws + WS_ROPEC), (const float*)(F.ws + WS_ROPES), (const float*)(F.ws + WS_RSC), 1.0f / WQ_GU, 0.5f / WQ_GU, 0};
          pg8::gemm_phase<pg8::EpiInProj, pg8::StaticOrder, true, true, false, true>(F.lds + RING_OFF, g, So, E, F.wave); }
        TSTOP(11);
#endif
        GRID_BAR_N(2);
        TSTART(1); kmean_phase(F); TSTOP(1);
        TSTART(2); vt_phase(F); TSTOP(2);
        __syncthreads();
        TSTART(3); conv_phase(F, l); TSTOP(3);
        GRID_BAR_N(3);
        TSTART(4); sel_phase(F, l); TSTOP(4);
        GRID_BAR_N(4);
        TSTART(51); TSTART(5); partial_phase(F, l); TSTOP(5);
        steal_point(F, 5 * 2 + l); GRID_BAR_N(5); TSTOP(51);
        TSTART(52); TSTART(6); own_phase(F); TSTOP(6);
        GRID_BAR_N(6); TSTOP(52);
#ifndef NO_G_OUTPROJ
        TSTART(12);
        { pg8::Gemm g{(const bf16*)(F.ws + WS_CAT), (const bf16*)(F.ws + WS_WOUT + (size_t)l * DM * DM), S, DM, DM / 2, 0}; pg8::StaticOrder So; So.init(S, DM, F.G, (int)blockIdx.x);
          pg8::EpiBf16 E{Y, DM, 1.0f / (WSC_O * ASC_CAT)};
          pg8::gemm_phase<pg8::EpiBf16, pg8::StaticOrder, true, true, true>(F.lds + RING_OFF, g, So, E, F.wave); }
        TSTOP(12);
#endif
        GRID_BAR_N(7);
        TSTART(7); ln_phase(F, nullptr, Y, F.lnm_g + l * DM, F.lnm_b + l * DM, l == 1 ? F.router : nullptr, 2); TSTOP(7);
        GRID_BAR_N(8);
        if (l == 0) {
#ifndef NO_G_FFNGU
        TSTART(13); unsigned long long ck1 = (PROBE_ID == 313) ? (unsigned long long)clock64() : 0ull;
            { pg8::Gemm g{(const bf16*)(F.ws + WS_HB8), (const bf16*)(F.ws + WS_WGU0), S, 2 * DFF, DM / 2, 0}; pg8::StaticOrder So; So.init(S, 2 * DFF, F.G, (int)blockIdx.x);
              pg8::EpiSwiGLUq E{(bf16*)(F.ws + WS_ACT), DFF, (const float*)(F.ws + WS_RSC), 1.0f / WQ_GU};
              pg8::gemm_phase<pg8::EpiSwiGLUq, pg8::StaticOrder, true, true, false, true>(F.lds + RING_OFF, g, So, E, F.wave); }
        TSTOP(13); if (PROBE_ID == 313) F.tacc += ((unsigned long long)clock64() - ck1) >> 8;
#endif
            GRID_BAR_N(9);
#ifndef NO_G_FFND
        TSTART(14);
            { pg8::Gemm g{(const bf16*)(F.ws + WS_ACT), (const bf16*)(F.ws + WS_WD0), S, DM, DFF, 0}; pg8::StaticOrder So; So.init(S, DM, F.G, (int)blockIdx.x);
              pg8::EpiBf16 E{Y, DM, 1.0f};
              pg8::gemm_phase<pg8::EpiBf16, pg8::StaticOrder, true, true>(F.lds + RING_OFF, g, So, E, F.wave); }
        TSTOP(14);
#endif
            GRID_BAR_N(10);
            TSTART(7); ln_phase(F, nullptr, Y, F.lnf_g, F.lnf_b, nullptr, 2); TSTOP(7);
            GRID_BAR_N(11);
        } else {
            TSTART(17); router_phase(F); TSTOP(17);
            GRID_BAR_N(12);
            TSTART(8); route_phase(F); TSTOP(8);
            steal_drain(F); GRID_BAR_N(13);
            int off[8], cum[8], np; load_expert_layout(F, off, cum, np);
#ifndef NO_G_MOEGU
        TSTART(15); unsigned long long ck0 = (PROBE_ID == 315) ? (unsigned long long)clock64() : 0ull;
            { pg8::Gemm g{(const bf16*)(F.ws + WS_HBP), (const bf16*)(F.ws + WS_WGUE), np * 256, 2 * DFF, DM / 2, (size_t)2 * DFF * DM}; pg8::GroupedOrder So; So.init(np * 256, 2 * DFF, F.G, (int)blockIdx.x);
#pragma unroll
              for (int e = 0; e < 8; ++e) So.cum[e] = cum[e];
              pg8::EpiSwiGLU8 E{F.ws + WS_ACT, DFF, 1.0f / WQ_GU, ASC_ACT, (const float*)(F.ws + WS_RSP)};
              pg8::gemm_phase<pg8::EpiSwiGLU8, pg8::GroupedOrder, true, true, false, true>(F.lds + RING_OFF, g, So, E, F.wave); }
        TSTOP(15); if (PROBE_ID == 315) F.tacc += ((unsigned long long)clock64() - ck0) >> 8;
#endif
            GRID_BAR_N(14);
#ifndef NO_G_MOED
        TSTART(16);
            { pg8::Gemm g{(const bf16*)(F.ws + WS_ACT), (const bf16*)(F.ws + WS_WDE), np * 256, DM, DFF / 2, (size_t)DM * DFF}; pg8::GroupedOrder So; So.init(np * 256, DM, F.G, (int)blockIdx.x);
#pragma unroll
              for (int e = 0; e < 8; ++e) So.cum[e] = cum[e];
              pg8::EpiBf16 E{(bf16*)(F.ws + WS_R2), DM, 1.0f / (WSC_D * ASC_ACT)};
              pg8::gemm_phase<pg8::EpiBf16, pg8::GroupedOrder, true, true, true>(F.lds + RING_OFF, g, So, E, F.wave); }
        TSTOP(16);
#endif
            GRID_BAR_N(15);
            TSTART(9); ln_moe_phase(F, F.lnf_g + DM, F.lnf_b + DM); TSTOP(9);
        }
    }
    if (PROBE_ID != 0 && blockIdx.x == PROBE_WG && F.wave == 0) { const unsigned long long t1 = __builtin_amdgcn_s_memrealtime(); while (__builtin_amdgcn_s_memrealtime() - t1 < 16ull * F.tacc) __builtin_amdgcn_s_sleep(8); }
#undef GRID_BAR
#undef LAUNDER
#undef HB
#undef Y
}

extern "C" void kernel_launch(void* const* d_in, const int* in_sizes, int n_in, void* d_out, int out_size, void* d_ws, size_t ws_size, hipStream_t stream) {
    static int grid = 0;
    if (grid == 0) {
        if (n_in != 18 || in_sizes[0] != S * DM || out_size != S * DM || ws_size < WS_END) { fprintf(stderr, "kernel_launch: unexpected shapes (n_in %d, in0 %d, out %d, ws %zu < %zu); nothing launched\n", n_in, n_in > 0 ? in_sizes[0] : -1, out_size, ws_size, (size_t)WS_END); grid = -1; return; }
        int dev = 0, cus = 0, per_cu = 0;
        if (hipGetDevice(&dev) != hipSuccess || hipDeviceGetAttribute(&cus, hipDeviceAttributeMultiprocessorCount, dev) != hipSuccess) { grid = -1; return; }
        if (hipFuncSetAttribute((const void*)hymba_fwd, hipFuncAttributeMaxDynamicSharedMemorySize, LDS_BYTES) != hipSuccess) { fprintf(stderr, "kernel_launch: hipFuncSetAttribute failed\n"); grid = -1; return; }
        if (hipOccupancyMaxActiveBlocksPerMultiprocessor(&per_cu, (const void*)hymba_fwd, NWAVES * 64, LDS_BYTES) != hipSuccess || per_cu < 1)
            fprintf(stderr, "kernel_launch: note: occupancy query reports %d workgroups per CU\n", per_cu);
        (void)hipGetLastError();
        grid = cus;
        if (grid != 256) { fprintf(stderr, "kernel_launch: built for 256 CUs, device has %d; nothing launched\n", cus); grid = -1; return; }
    }
    if (grid < 0) return;
    if (hipMemsetAsync((char*)d_ws + WS_CTL, 0, CTL_ZERO_BYTES, stream) != hipSuccess) return;
    Args a{};
    for (int i = 0; i < 18; ++i) a.in[i] = (const float*)d_in[i];
    a.out = (float*)d_out; a.ws = (unsigned char*)d_ws;
    hipLaunchKernelGGL(hymba_fwd, dim3(grid), dim3(NWAVES * 64), LDS_BYTES, stream, a);
}
```

```cpp
#include <hip/hip_runtime.h>
#include <cstdio>
#include <cstdint>
#include <cmath>
namespace pg8 {
#define PG8_LAS __attribute__((address_space(3)))
typedef unsigned short bf16_t;
typedef short bf16x8 __attribute__((ext_vector_type(8)));
typedef float f32x4 __attribute__((ext_vector_type(4)));
typedef unsigned u32x4 __attribute__((ext_vector_type(4)));
typedef unsigned u32x2 __attribute__((ext_vector_type(2)));
typedef int v8i __attribute__((ext_vector_type(8)));
typedef int v4i __attribute__((ext_vector_type(4)));
constexpr int BM = 256, BK = 64, HALF = 128, HTB = HALF * BK * 2  , STAGE_BYTES = 8 * HTB, NXCD = 8, WGM = 8;

__host__ __device__ __forceinline__ int lds_byte(int r, int c) { const int st = (r >> 4) * 2 + (c >> 5), rr = r & 15, cc = c & 31, ob = rr * 64 + cc * 2; return st * 1024 + (ob ^ (((ob >> 9) & 1) << 5)); }
__host__ __device__ __forceinline__ void stage_rc(int b, int& R, int& C) { const int st = b / 1024, sb = b % 1024, swz = sb ^ (((sb >> 9) & 1) << 5); R = (st >> 1) * 16 + swz / 64; C = (st & 1) * 32 + (swz % 64) / 2; }
__host__ __device__ __forceinline__ int perm32(int rho) { const int n = rho >> 4, i = rho & 15; return 8 * (i >> 2) + 4 * n + (i & 3); }

struct Unit { int pm, pn, e; };
struct Gemm { const bf16_t* A; const bf16_t* Bt; int M, N, K; size_t bstride; int ntk; };

struct StaticOrder {
    int nM, nN, nwg, G, c, lim;
    __host__ __device__ void init(int M, int N, int G_, int c_) { nM = M / BM; nN = N / BM; nwg = nM * nN; G = G_; c = c_; lim = nwg; }
    __host__ __device__ __forceinline__ bool next(int i, Unit& u) const { const long L = (long)i * G + c; if (L >= lim) return false; at((int)L, u); return true; }
    __host__ __device__ __forceinline__ bool at(int L, Unit& u) const {
        int wgid = L; { const int q = nwg / NXCD, r = nwg % NXCD, xcd = wgid % NXCD, off = wgid / NXCD; wgid = (xcd < r ? xcd * (q + 1) : r * (q + 1) + (xcd - r) * q) + off; }
        const int nig = WGM * nN, gid = wgid / nig, fm = gid * WGM, gsz = (nM - fm) < WGM ? (nM - fm) : WGM;
        u.pm = fm + ((wgid % nig) % gsz); u.pn = (wgid % nig) / gsz; u.e = 0; return true;
    }
    __device__ __forceinline__ void a_ready(const Unit&) const {}
    __device__ __forceinline__ void done(const Unit&) const {}
};
struct GroupedOrder : StaticOrder {
    int cum[8];
    __device__ __forceinline__ void expert_of(Unit& u) const { int e = 0;
#pragma unroll
        for (int j = 1; j < 8; ++j) e += (u.pm >= cum[j]) ? 1 : 0;
        u.e = e; }
    __device__ __forceinline__ bool next(int i, Unit& u) const { if (!StaticOrder::next(i, u)) return false; expert_of(u); return true; }
};
struct OneUnit {
    Unit u; bool has;
    __device__ __forceinline__ bool next(int i, Unit& o) const { if (i != 0 || !has) return false; o = u; return true; }
    __device__ __forceinline__ void a_ready(const Unit&) const {}
    __device__ __forceinline__ void done(const Unit&) const {}
};

__device__ __forceinline__ unsigned cvt_pk_bf16(float lo, float hi) { unsigned r; asm volatile("v_cvt_pk_bf16_f32 %0, %1, %2" : "=v"(r) : "v"(lo), "v"(hi)); return r; }
__device__ __forceinline__ float sigmoidf_fast(float g) { return __builtin_amdgcn_rcpf(1.0f + __builtin_amdgcn_exp2f(-1.44269504089f * g)); }

__device__ __forceinline__ unsigned pk4_fp8(float a, float b, float c, float d) {
    unsigned w = 0u; w = __builtin_amdgcn_cvt_pk_fp8_f32(__builtin_amdgcn_fmed3f(a, -448.f, 448.f), __builtin_amdgcn_fmed3f(b, -448.f, 448.f), w, false);
    return __builtin_amdgcn_cvt_pk_fp8_f32(__builtin_amdgcn_fmed3f(c, -448.f, 448.f), __builtin_amdgcn_fmed3f(d, -448.f, 448.f), w, true); }
__device__ __forceinline__ unsigned pk4_i8(float a, float b, float c, float d) {
    const int ia = (int)__builtin_rintf(__builtin_amdgcn_fmed3f(a, -127.f, 127.f)), ib = (int)__builtin_rintf(__builtin_amdgcn_fmed3f(b, -127.f, 127.f));
    const int ic = (int)__builtin_rintf(__builtin_amdgcn_fmed3f(c, -127.f, 127.f)), id = (int)__builtin_rintf(__builtin_amdgcn_fmed3f(d, -127.f, 127.f));
    return (unsigned)(ia & 255) | ((unsigned)(ib & 255) << 8) | ((unsigned)(ic & 255) << 16) | ((unsigned)id << 24); }
struct EpiF32 {
    static constexpr bool PERM = false, AFTER_DRAIN = false, ROWSCALE = false;
    float* C; int ldc;
    __device__ __forceinline__ void operator()(const f32x4 (&acc)[2][2][4][2], const Unit& u, int wr, int wc, int fr, int fq) const {
        const int row0 = u.pm * BM + wr * 64 + fr, col0 = u.pn * BM + wc * 32 + 4 * fq;
#pragma unroll
        for (int ai = 0; ai < 2; ++ai)
#pragma unroll
            for (int m = 0; m < 4; ++m) { float* rowp = C + (size_t)(row0 + ai * HALF + m * 16) * ldc + col0;
#pragma unroll
                for (int bj = 0; bj < 2; ++bj)
#pragma unroll
                    for (int n = 0; n < 2; ++n) *(f32x4*)(rowp + bj * HALF + n * 16) = acc[ai][bj][m][n]; }
    }
};
struct EpiPartF32 {
    static constexpr bool PERM = true, AFTER_DRAIN = false, ROWSCALE = false;
    float* T;
    __device__ __forceinline__ void operator()(const f32x4 (&acc)[2][2][4][2], const Unit&, int wr, int wc, int fr, int fq) const {
        const int row0 = wr * 64 + fr, col0 = wc * 32 + 8 * fq;
#pragma unroll
        for (int ai = 0; ai < 2; ++ai)
#pragma unroll
            for (int m = 0; m < 4; ++m) { float* rowp = T + (size_t)(row0 + ai * HALF + m * 16) * BM + col0;
#pragma unroll
                for (int bj = 0; bj < 2; ++bj) { *(f32x4*)(rowp + bj * HALF) = acc[ai][bj][m][0]; *(f32x4*)(rowp + bj * HALF + 4) = acc[ai][bj][m][1]; } }
    }
};
struct EpiBf16r {
    static constexpr bool PERM = true, AFTER_DRAIN = false, ROWSCALE = true;
    bf16_t* O; int ldc; const float* rs; float ws;
    __device__ __forceinline__ void operator()(const f32x4 (&acc)[2][2][4][2], const Unit& u, int wr, int wc, int fr, int fq, const PG8_LAS float* rsl) const {
        const int row0 = u.pm * BM + wr * 64 + fr, col0 = u.pn * BM + wc * 32 + 8 * fq;
        float rsv[2][4];
#pragma unroll
        for (int ai = 0; ai < 2; ++ai)
#pragma unroll
            for (int m = 0; m < 4; ++m) rsv[ai][m] = rsl[wr * 64 + ai * HALF + m * 16 + fr];
#pragma unroll
        for (int ai = 0; ai < 2; ++ai)
#pragma unroll
            for (int m = 0; m < 4; ++m) { const int row = row0 + ai * HALF + m * 16; bf16_t* rowp = O + (size_t)row * ldc + col0; const float sc = rsv[ai][m] * ws;
#pragma unroll
                for (int bj = 0; bj < 2; ++bj) { const f32x4 v0 = acc[ai][bj][m][0] * sc, v1 = acc[ai][bj][m][1] * sc;
                    u32x4 w; w.x = cvt_pk_bf16(v0[0], v0[1]); w.y = cvt_pk_bf16(v0[2], v0[3]); w.z = cvt_pk_bf16(v1[0], v1[1]); w.w = cvt_pk_bf16(v1[2], v1[3]);
                    *(u32x4*)(rowp + bj * HALF) = w; } }
    }
};
struct EpiBf16 {
    static constexpr bool PERM = true, AFTER_DRAIN = false, ROWSCALE = false;
    bf16_t* O; int ldc; float sc;
    __device__ __forceinline__ void operator()(const f32x4 (&acc)[2][2][4][2], const Unit& u, int wr, int wc, int fr, int fq) const {
        const int row0 = u.pm * BM + wr * 64 + fr, col0 = u.pn * BM + wc * 32 + 8 * fq;
#pragma unroll
        for (int ai = 0; ai < 2; ++ai)
#pragma unroll
            for (int m = 0; m < 4; ++m) { bf16_t* rowp = O + (size_t)(row0 + ai * HALF + m * 16) * ldc + col0;
#pragma unroll
                for (int bj = 0; bj < 2; ++bj) { const f32x4 v0 = acc[ai][bj][m][0] * sc, v1 = acc[ai][bj][m][1] * sc;
                    u32x4 w; w.x = cvt_pk_bf16(v0[0], v0[1]); w.y = cvt_pk_bf16(v0[2], v0[3]); w.z = cvt_pk_bf16(v1[0], v1[1]); w.w = cvt_pk_bf16(v1[2], v1[3]);
                    *(u32x4*)(rowp + bj * HALF) = w; } }
    }
};
struct EpiSwiGLU {
    static constexpr bool PERM = true, AFTER_DRAIN = false, ROWSCALE = false;
    bf16_t* O; int ldc;
    __device__ __forceinline__ void operator()(const f32x4 (&acc)[2][2][4][2], const Unit& u, int wr, int wc, int fr, int fq) const {
        const int row0 = u.pm * BM + wr * 64 + fr, col0 = u.pn * HALF + wc * 32 + 8 * fq;
#pragma unroll
        for (int ai = 0; ai < 2; ++ai)
#pragma unroll
            for (int m = 0; m < 4; ++m) { bf16_t* rowp = O + (size_t)(row0 + ai * HALF + m * 16) * ldc + col0;
                float o[8];
#pragma unroll
                for (int n = 0; n < 2; ++n)
#pragma unroll
                    for (int j = 0; j < 4; ++j) { const float g = acc[ai][0][m][n][j], up = acc[ai][1][m][n][j]; o[n * 4 + j] = g * sigmoidf_fast(g) * up; }
                u32x4 w; w.x = cvt_pk_bf16(o[0], o[1]); w.y = cvt_pk_bf16(o[2], o[3]); w.z = cvt_pk_bf16(o[4], o[5]); w.w = cvt_pk_bf16(o[6], o[7]);
                *(u32x4*)rowp = w; }
    }
};
struct EpiSwiGLUq {
    static constexpr bool PERM = true, AFTER_DRAIN = false, ROWSCALE = true;
    bf16_t* O; int ldc; const float* rs; float ws;
    __device__ __forceinline__ void operator()(const f32x4 (&acc)[2][2][4][2], const Unit& u, int wr, int wc, int fr, int fq, const PG8_LAS float* rsl) const {
        const int row0 = u.pm * BM + wr * 64 + fr, col0 = u.pn * HALF + wc * 32 + 8 * fq;
#pragma unroll
        for (int ai = 0; ai < 2; ++ai)
#pragma unroll
            for (int m = 0; m < 4; ++m) { const int row = row0 + ai * HALF + m * 16; bf16_t* rowp = O + (size_t)row * ldc + col0; const float sc = rsl[wr * 64 + ai * HALF + m * 16 + fr] * ws;
                float o[8];
#pragma unroll
                for (int n = 0; n < 2; ++n)
#pragma unroll
                    for (int j = 0; j < 4; ++j) { const float g = acc[ai][0][m][n][j] * sc, up = acc[ai][1][m][n][j] * sc; o[n * 4 + j] = g * sigmoidf_fast(g) * up; }
                u32x4 w; w.x = cvt_pk_bf16(o[0], o[1]); w.y = cvt_pk_bf16(o[2], o[3]); w.z = cvt_pk_bf16(o[4], o[5]); w.w = cvt_pk_bf16(o[6], o[7]);
                *(u32x4*)rowp = w; }
    }
};
struct EpiSwiGLU8 {
    static constexpr bool PERM = true, AFTER_DRAIN = false, ROWSCALE = true;
    unsigned char* O; int ldc; float sin, sout; const float* rs;
    __device__ __forceinline__ void operator()(const f32x4 (&acc)[2][2][4][2], const Unit& u, int wr, int wc, int fr, int fq, const PG8_LAS float* rsl) const {
        const int row0 = u.pm * BM + wr * 64 + fr, col0 = u.pn * HALF + wc * 32 + 8 * fq;
        float rsv[2][4];
#pragma unroll
        for (int ai = 0; ai < 2; ++ai)
#pragma unroll
            for (int m = 0; m < 4; ++m) rsv[ai][m] = rsl[wr * 64 + ai * HALF + m * 16 + fr];
#pragma unroll
        for (int ai = 0; ai < 2; ++ai)
#pragma unroll
            for (int m = 0; m < 4; ++m) { unsigned char* rowp = O + (size_t)(row0 + ai * HALF + m * 16) * ldc + col0; const float si = rsv[ai][m] * sin;
                float o[8];
#pragma unroll
                for (int n = 0; n < 2; ++n)
#pragma unroll
                    for (int j = 0; j < 4; ++j) { const float g = acc[ai][0][m][n][j] * si, up = acc[ai][1][m][n][j] * si; o[n * 4 + j] = g * sigmoidf_fast(g) * up * sout; }
                u32x2 w; w.x = pk4_fp8(o[0], o[1], o[2], o[3]); w.y = pk4_fp8(o[4], o[5], o[6], o[7]);
                *(u32x2*)rowp = w; }
    }
};
struct EpiInProj {
    static constexpr bool PERM = true, AFTER_DRAIN = false, ROWSCALE = true;
    bf16_t *Q, *Kb, *V, *U; const float *ropeC, *ropeS; const float* rs; float wsq, wsv; int pn_off;
    __device__ __forceinline__ void operator()(const f32x4 (&acc)[2][2][4][2], const Unit& u, int wr, int wc, int fr, int fq, const PG8_LAS float* rsl) const {
        const int row0 = u.pm * BM + wr * 64 + fr, pn = u.pn + pn_off;
        float rsv[2][4];
#pragma unroll
        for (int ai = 0; ai < 2; ++ai)
#pragma unroll
            for (int m = 0; m < 4; ++m) rsv[ai][m] = rsl[wr * 64 + ai * HALF + m * 16 + fr];
        if (pn < 8) {
            bf16_t* base = (pn < 4) ? Q : Kb; const int col0 = (pn & 3) * BM + wc * 32 + 8 * fq, idx0 = 16 * wc + 4 * fq;
#pragma unroll
            for (int ai = 0; ai < 2; ++ai) {
                f32x4 csv[4], snv[4];
#pragma unroll
                for (int m = 0; m < 4; ++m) { const int row = row0 + ai * HALF + m * 16; csv[m] = *(const f32x4*)(ropeC + (size_t)row * 64 + idx0); snv[m] = *(const f32x4*)(ropeS + (size_t)row * 64 + idx0); }
                asm volatile("" : "+v"(csv[0]), "+v"(csv[1]), "+v"(csv[2]), "+v"(csv[3]), "+v"(snv[0]), "+v"(snv[1]), "+v"(snv[2]), "+v"(snv[3]));
#pragma unroll
                for (int m = 0; m < 4; ++m) { const int row = row0 + ai * HALF + m * 16; const float sc = rsv[ai][m] * wsq;
                    const f32x4 cs = csv[m], sn = snv[m];
#pragma unroll
                    for (int bj = 0; bj < 2; ++bj) { const f32x4 x1 = acc[ai][bj][m][0] * sc, x2 = acc[ai][bj][m][1] * sc;
                        const f32x4 o1 = x1 * cs - x2 * sn, o2 = x2 * cs + x1 * sn;
                        u32x4 w; w.x = cvt_pk_bf16(o1[0], o1[1]); w.y = cvt_pk_bf16(o1[2], o1[3]); w.z = cvt_pk_bf16(o2[0], o2[1]); w.w = cvt_pk_bf16(o2[2], o2[3]);
                        *(u32x4*)(base + (size_t)row * 1024 + col0 + bj * HALF) = w; } } }
        } else if (pn < 12) {
            const int col0 = (pn - 8) * BM + wc * 32 + 8 * fq;
#pragma unroll
            for (int ai = 0; ai < 2; ++ai)
#pragma unroll
                for (int m = 0; m < 4; ++m) { bf16_t* rowp = V + (size_t)(row0 + ai * HALF + m * 16) * 1024 + col0; const float sc = rsv[ai][m] * wsv;
#pragma unroll
                    for (int bj = 0; bj < 2; ++bj) { const f32x4 v0 = acc[ai][bj][m][0] * sc, v1 = acc[ai][bj][m][1] * sc;
                        u32x4 w; w.x = cvt_pk_bf16(v0[0], v0[1]); w.y = cvt_pk_bf16(v0[2], v0[3]); w.z = cvt_pk_bf16(v1[0], v1[1]); w.w = cvt_pk_bf16(v1[2], v1[3]);
                        *(u32x4*)(rowp + bj * HALF) = w; } }
        } else {
            const int col0 = (pn - 12) * HALF + wc * 32 + 8 * fq;
#pragma unroll
            for (int ai = 0; ai < 2; ++ai)
#pragma unroll
                for (int m = 0; m < 4; ++m) { bf16_t* rowp = U + (size_t)(row0 + ai * HALF + m * 16) * 1024 + col0; const float sc = rsv[ai][m] * wsq;
                    float o[8];
#pragma unroll
                    for (int n = 0; n < 2; ++n)
#pragma unroll
                        for (int j = 0; j < 4; ++j) o[n * 4 + j] = acc[ai][0][m][n][j] * sc * sigmoidf_fast(acc[ai][1][m][n][j] * sc);
                    u32x4 w; w.x = cvt_pk_bf16(o[0], o[1]); w.y = cvt_pk_bf16(o[2], o[3]); w.z = cvt_pk_bf16(o[4], o[5]); w.w = cvt_pk_bf16(o[6], o[7]);
                    *(u32x4*)rowp = w; }
        }
    }
};

template <class Epi, class Sched, bool ALIGN_EPI = false, bool SP2 = false, bool FP8 = false, bool I8 = false>
__device__ __forceinline__ void gemm_phase(PG8_LAS unsigned char* lds, const Gemm g, const Sched& S, const Epi& E, const int wave_in) {
    int lane; asm volatile("v_mbcnt_lo_u32_b32 %0, -1, 0\n\tv_mbcnt_hi_u32_b32 %0, -1, %0" : "=v"(lane));
    const int wid = wave_in, tid = wid * 64 + lane, wr = wid >> 2, wc = wid & 3, fr = lane & 15, fq = lane >> 4;
    const int K = g.K, nt = g.ntk ? g.ntk : K / BK;
    unsigned voffA[2], voffB[2];
#pragma unroll
    for (int i = 0; i < 2; ++i) { int R, C; stage_rc(tid * 16 + i * 8192, R, C); const int Rb = Epi::PERM ? ((R & ~31) + perm32(R & 31)) : R;
        voffA[i] = (unsigned)(R * K + C) * 2u; voffB[i] = (unsigned)(Rb * K + C) * 2u; }
    const size_t kstep = (size_t)(BK * 2);
    const size_t hstep = (size_t)HALF * K * 2;
    const size_t tstep = 2 * hstep;
    const unsigned ldsw = (unsigned)wid * 1024u;
    const int aoff = lds_byte(wr * 64 + fr, fq * 8), boff = lds_byte(wc * 32 + fr, fq * 8);
#define PG8_SA(b, h) (((b) * 2 + (h)) * HTB)
#define PG8_SB(b, h) ((4 + (b) * 2 + (h)) * HTB)
#define PG8_STAGE(bufoff, gbase, voff) do { _Pragma("unroll") for (int _i = 0; _i < 2; ++_i) \
        __builtin_amdgcn_global_load_lds((const unsigned*)((const char*)(gbase) + (voff)[_i]), (PG8_LAS unsigned*)(lds + (bufoff) + ldsw + _i * 8192), 16, 0, 0); } while (0)
#define PG8_LDA(dst, b, h) do { if constexpr (FP8) { _Pragma("unroll") for (int m = 0; m < 4; ++m) { const v4i lo_ = *(const PG8_LAS v4i*)(lds + PG8_SA(b, h) + aoff + m * 2048), hi_ = *(const PG8_LAS v4i*)(lds + PG8_SA(b, h) + aoff + m * 2048 + 1024); \
            dst##8[m] = __builtin_shufflevector(lo_, hi_, 0, 1, 2, 3, 4, 5, 6, 7); } } \
        else { _Pragma("unroll") for (int m = 0; m < 4; ++m) _Pragma("unroll") for (int k = 0; k < 2; ++k) dst[m][k] = *(const PG8_LAS bf16x8*)(lds + PG8_SA(b, h) + aoff + m * 2048 + k * 1024); } } while (0)
#define PG8_LDB(dst, b, h) do { if constexpr (FP8) { _Pragma("unroll") for (int n = 0; n < 2; ++n) { const v4i lo_ = *(const PG8_LAS v4i*)(lds + PG8_SB(b, h) + boff + n * 2048), hi_ = *(const PG8_LAS v4i*)(lds + PG8_SB(b, h) + boff + n * 2048 + 1024); \
            dst##8[n] = __builtin_shufflevector(lo_, hi_, 0, 1, 2, 3, 4, 5, 6, 7); } } \
        else { _Pragma("unroll") for (int n = 0; n < 2; ++n) _Pragma("unroll") for (int k = 0; k < 2; ++k) dst[n][k] = *(const PG8_LAS bf16x8*)(lds + PG8_SB(b, h) + boff + n * 2048 + k * 1024); } } while (0)
#define PG8_MMA(ai, bj, At, Bt) do { __builtin_amdgcn_s_setprio(1); \
        if constexpr (FP8) {   \
            _Pragma("unroll") for (int m = 0; m < 4; ++m) _Pragma("unroll") for (int n = 0; n < 2; ++n) \
                asm volatile("v_mfma_f32_16x16x128_f8f6f4 %0, %1, %2, %0" : "+v"(acc[ai][bj][m][n]) : "v"(Bt##8[n]), "v"(At##8[m]));   \
        } else if constexpr (I8) {   \
            _Pragma("unroll") for (int m = 0; m < 4; ++m) _Pragma("unroll") for (int n = 0; n < 2; ++n) _Pragma("unroll") for (int k = 0; k < 2; ++k) \
                asm volatile("v_mfma_i32_16x16x64_i8 %0, %1, %2, %0" : "+v"(acc[ai][bj][m][n]) : "v"(Bt[n][k]), "v"(At[m][k])); \
        } else { _Pragma("unroll") for (int m = 0; m < 4; ++m) _Pragma("unroll") for (int n = 0; n < 2; ++n) _Pragma("unroll") for (int k = 0; k < 2; ++k) \
            acc[ai][bj][m][n] = __builtin_amdgcn_mfma_f32_16x16x32_bf16(Bt[n][k], At[m][k], acc[ai][bj][m][n], 0, 0, 0); } \
        __builtin_amdgcn_s_setprio(0); } while (0)
#define PG8_WAIT_V(n) asm volatile("s_waitcnt vmcnt(" #n ")" ::: "memory")
#define PG8_WAIT_L(n) asm volatile("s_waitcnt lgkmcnt(" #n ")" ::: "memory")
#define PG8_BAR __builtin_amdgcn_s_barrier()
#define PG8_SCHED __builtin_amdgcn_sched_barrier(0)
    Unit cur, nxt; int ui = 0;
    if (!S.next(0, cur)) return;
    f32x4 acc[2][2][4][2];
#pragma unroll
    for (int a = 0; a < 2; ++a)
#pragma unroll
        for (int b = 0; b < 2; ++b)
#pragma unroll
            for (int m = 0; m < 4; ++m)
#pragma unroll
                for (int n = 0; n < 2; ++n) acc[a][b][m][n] = (f32x4){0.f, 0.f, 0.f, 0.f};
    bf16x8 At[4][2], B0[2][2], B1[2][2]; v8i At8[4], B08[2], B18[2];
    const char* cA = (const char*)g.A + (size_t)cur.pm * tstep; const char* cB = (const char*)g.Bt + (size_t)cur.e * g.bstride + (size_t)cur.pn * tstep;
    S.a_ready(cur);
    if constexpr (SP2) {
        PG8_STAGE(PG8_SB(0, 0), cB, voffB); PG8_STAGE(PG8_SB(0, 1), cB + hstep, voffB); PG8_STAGE(PG8_SA(0, 0), cA, voffA); PG8_STAGE(PG8_SA(0, 1), cA + hstep, voffA);
        if (wr == 1) PG8_BAR;
        PG8_WAIT_V(2); PG8_BAR;
        PG8_STAGE(PG8_SB(1, 0), cB + kstep, voffB); PG8_STAGE(PG8_SA(1, 0), cA + kstep, voffA); PG8_STAGE(PG8_SB(1, 1), cB + hstep + kstep, voffB);
        PG8_WAIT_V(6); PG8_BAR;
    } else {
        PG8_STAGE(PG8_SB(0, 0), cB, voffB); PG8_STAGE(PG8_SA(0, 0), cA, voffA); PG8_STAGE(PG8_SB(0, 1), cB + hstep, voffB); PG8_STAGE(PG8_SA(0, 1), cA + hstep, voffA);
        if (wr == 1) PG8_BAR;
        PG8_WAIT_V(4); PG8_BAR;
        PG8_STAGE(PG8_SB(1, 0), cB + kstep, voffB); PG8_STAGE(PG8_SA(1, 0), cA + kstep, voffA); PG8_STAGE(PG8_SB(1, 1), cB + hstep + kstep, voffB);
        PG8_WAIT_V(6); PG8_BAR;
    }
    for (;;) {
        const bool has_next = S.next(ui + 1, nxt);
        if constexpr (Epi::ROWSCALE) { if (wid < 4) __builtin_amdgcn_global_load_lds((const unsigned*)(E.rs + (size_t)cur.pm * BM + wid * 64 + lane), (PG8_LAS unsigned*)(lds + 131072 + (ui & 1) * 1024 + wid * 256), 4, 0, 0); }
        const char* nA = has_next ? (const char*)g.A + (size_t)nxt.pm * tstep : cA; const char* nB = has_next ? (const char*)g.Bt + (size_t)nxt.e * g.bstride + (size_t)nxt.pn * tstep : cB;
        for (int t = 0; t < nt; t += 2) {
            const bool last = (t == nt - 2);
            const char* a1 = cA + (size_t)(t + 1) * kstep;
            const char* a2 = last ? nA : cA + (size_t)(t + 2) * kstep; const char* b2 = last ? nB : cB + (size_t)(t + 2) * kstep;
            const char* a3 = a2 + kstep; const char* b3 = b2 + kstep;
            if (last && has_next) S.a_ready(nxt);
            if constexpr (SP2) {
            PG8_LDB(B0, 0, 0); PG8_LDB(B1, 0, 1); PG8_SCHED; PG8_LDA(At, 0, 0); PG8_STAGE(PG8_SA(1, 1), a1 + hstep, voffA);
            PG8_WAIT_V(8); PG8_WAIT_L(0); PG8_BAR; PG8_MMA(0, 0, At, B0); PG8_MMA(0, 1, At, B1); PG8_BAR; PG8_SCHED;
            PG8_LDA(At, 0, 1); PG8_STAGE(PG8_SB(0, 0), b2, voffB); PG8_STAGE(PG8_SB(0, 1), b2 + hstep, voffB); PG8_STAGE(PG8_SA(0, 0), a2, voffA);
            PG8_WAIT_V(8); PG8_WAIT_L(0); PG8_BAR; PG8_MMA(1, 0, At, B0); PG8_MMA(1, 1, At, B1); PG8_BAR; PG8_SCHED;
            PG8_LDB(B0, 1, 0); PG8_LDB(B1, 1, 1); PG8_SCHED; PG8_LDA(At, 1, 0); PG8_STAGE(PG8_SA(0, 1), a2 + hstep, voffA);
            PG8_WAIT_V(8); PG8_WAIT_L(0); PG8_BAR; PG8_MMA(0, 0, At, B0); PG8_MMA(0, 1, At, B1); PG8_BAR; PG8_SCHED;
            PG8_LDA(At, 1, 1); PG8_STAGE(PG8_SB(1, 0), b3, voffB); PG8_STAGE(PG8_SB(1, 1), b3 + hstep, voffB); PG8_STAGE(PG8_SA(1, 0), a3, voffA);
            PG8_WAIT_V(8); PG8_WAIT_L(0); PG8_BAR; PG8_MMA(1, 0, At, B0); PG8_MMA(1, 1, At, B1); PG8_BAR; PG8_SCHED;
            } else {
            PG8_LDB(B0, 0, 0); PG8_SCHED; PG8_LDA(At, 0, 0); PG8_STAGE(PG8_SA(1, 1), a1 + hstep, voffA);
            PG8_WAIT_L(8); PG8_BAR; PG8_WAIT_L(0); PG8_MMA(0, 0, At, B0); PG8_BAR; PG8_SCHED;
            PG8_LDB(B1, 0, 1); PG8_STAGE(PG8_SB(0, 0), b2, voffB);
            PG8_BAR; PG8_WAIT_L(0); PG8_MMA(0, 1, At, B1); PG8_BAR;
            PG8_LDA(At, 0, 1); PG8_STAGE(PG8_SA(0, 0), a2, voffA);
            PG8_BAR; PG8_WAIT_L(0); PG8_MMA(1, 0, At, B0); PG8_BAR; PG8_SCHED;
            PG8_STAGE(PG8_SB(0, 1), b2 + hstep, voffB);
            PG8_WAIT_V(6); PG8_BAR; PG8_MMA(1, 1, At, B1); PG8_BAR;
            PG8_LDB(B0, 1, 0); PG8_SCHED; PG8_LDA(At, 1, 0); PG8_STAGE(PG8_SA(0, 1), a2 + hstep, voffA);
            PG8_WAIT_L(8); PG8_BAR; PG8_WAIT_L(0); PG8_MMA(0, 0, At, B0); PG8_BAR; PG8_SCHED;
            PG8_LDB(B1, 1, 1); PG8_STAGE(PG8_SB(1, 0), b3, voffB);
            PG8_BAR; PG8_WAIT_L(0); PG8_MMA(0, 1, At, B1); PG8_BAR;
            PG8_LDA(At, 1, 1); PG8_STAGE(PG8_SA(1, 0), a3, voffA);
            PG8_BAR; PG8_WAIT_L(0); PG8_MMA(1, 0, At, B0); PG8_BAR; PG8_SCHED;
            PG8_STAGE(PG8_SB(1, 1), b3 + hstep, voffB);
            PG8_WAIT_V(6); PG8_BAR; PG8_MMA(1, 1, At, B1); PG8_BAR;
            }
        }
        if constexpr (FP8) asm volatile("s_nop 15\n\ts_nop 15" ::: "memory");
        if constexpr (I8) { asm volatile("s_nop 15\n\ts_nop 15" ::: "memory");
#pragma unroll
            for (int a = 0; a < 2; ++a)
#pragma unroll
                for (int b = 0; b < 2; ++b)
#pragma unroll
                    for (int m = 0; m < 4; ++m)
#pragma unroll
                        for (int n = 0; n < 2; ++n)
                            asm volatile("v_cvt_f32_i32_e32 %0, %0\n\tv_cvt_f32_i32_e32 %1, %1\n\tv_cvt_f32_i32_e32 %2, %2\n\tv_cvt_f32_i32_e32 %3, %3" : "+v"(acc[a][b][m][n][0]), "+v"(acc[a][b][m][n][1]), "+v"(acc[a][b][m][n][2]), "+v"(acc[a][b][m][n][3])); }
        if constexpr (ALIGN_EPI) { if (wr == 0) PG8_BAR; }
        if constexpr (!Epi::AFTER_DRAIN) { if constexpr (Epi::ROWSCALE) E(acc, cur, wr, wc, fr, fq, (const PG8_LAS float*)(lds + 131072 + (ui & 1) * 1024)); else E(acc, cur, wr, wc, fr, fq); S.done(cur); }
        if (!has_next) break;
#pragma unroll
        for (int a = 0; a < 2; ++a)
#pragma unroll
            for (int b = 0; b < 2; ++b)
#pragma unroll
                for (int m = 0; m < 4; ++m)
#pragma unroll
                    for (int n = 0; n < 2; ++n) acc[a][b][m][n] = (f32x4){0.f, 0.f, 0.f, 0.f};
        cur = nxt; cA = nA; cB = nB; ++ui;
        if constexpr (ALIGN_EPI) { if (wr == 1) PG8_BAR; }
    }
    PG8_WAIT_V(0);
    if constexpr (!ALIGN_EPI) { if (wr == 0) PG8_BAR; }
    PG8_BAR;
    if constexpr (Epi::AFTER_DRAIN) { E.fused(acc, cur, wr, wc, fr, fq, lds, wid, lane); S.done(cur); }
#undef PG8_SA
#undef PG8_SB
#undef PG8_STAGE
#undef PG8_LDA
#undef PG8_LDB
#undef PG8_MMA
#undef PG8_WAIT_V
#undef PG8_WAIT_L
#undef PG8_BAR
#undef PG8_SCHED
}
}

constexpr int NWAVES = 8;
constexpr int S = 16384, DM = 2048, NPROJ = 5120, AW = 1024, HD = 128, NH = 8, DFF = 5632, NE = 8, CKW = 31, NBLK = 64;
constexpr float LN_EPS = 1e-5f, ALPHA = 1.41421356237309515f;
constexpr int MOE_ROWS = 2 * S + NE * 256;
constexpr float WSC_GU = 32.f, WSC_D = 128.f, ASC_H = 4.f, ASC_ACT = 8.f, WSC_O = 64.f, ASC_CAT = 16.f, WQ_O = 2048.f;
constexpr float WQ_GU = 1024.f;

constexpr size_t MiB = 1u << 20;
constexpr size_t WS_CTL = 0, CTL_ZERO_BYTES = 1 * MiB;
constexpr size_t WS_ROPEC = 1 * MiB, WS_ROPES = 5 * MiB;
constexpr size_t WS_KMEAN = 9 * MiB;
constexpr size_t WS_RWT = 9 * MiB + 256 * 1024;
constexpr size_t WS_RSC = 9 * MiB + 896 * 1024;
constexpr size_t WS_CSC = 9 * MiB + 960 * 1024;
constexpr size_t WS_EIDX = 9 * MiB + 512 * 1024, WS_GATEW = WS_EIDX + 128 * 1024, WS_ROWPOS = WS_GATEW + 128 * 1024;
constexpr size_t WS_WIN = 10 * MiB, WS_WOUT = 50 * MiB, WS_WGU0 = 66 * MiB, WS_WD0 = 110 * MiB, WS_WGUE = 132 * MiB, WS_WDE = 484 * MiB;
constexpr size_t WS_HB = 660 * MiB;
constexpr size_t WS_R2 = 724 * MiB;
constexpr size_t WS_HB8 = 860 * MiB + 72 * MiB;
constexpr size_t WS_RSP = 860 * MiB + 112 * MiB;
constexpr size_t WS_HBP = 860 * MiB;
constexpr size_t WS_R1 = 996 * MiB;
constexpr size_t WS_Q = WS_R1, WS_K = WS_R1 + 32 * MiB, WS_V = WS_R1 + 64 * MiB, WS_U = WS_R1 + 96 * MiB, WS_CAT = WS_R1 + 128 * MiB, WS_ACT = WS_R1;
constexpr size_t WS_VT = WS_R1 + 192 * MiB, WS_PO = WS_R1 + 224 * MiB, WS_PML = WS_R1 + 320 * MiB, WS_LIST = WS_R1 + 324 * MiB;
constexpr size_t WS_END = 1370 * MiB;
static_assert(WS_R1 + (size_t)MOE_ROWS * DFF * 2 <= WS_END && WS_HBP + (size_t)MOE_ROWS * DM * 2 <= WS_R1 && WS_R2 + (size_t)MOE_ROWS * DM * 2 <= WS_HBP, "d_ws map");
static_assert(WS_WDE + (size_t)NE * DM * DFF * 2 <= WS_HB && WS_WGUE + (size_t)NE * 2 * DFF * DM * 2 <= WS_WDE, "d_ws weights map");
constexpr int CW_TMO = 0, CW_CODE = 1, CW_BAR = 4096, CW_ECNT = 8192, CW_ECUR = 8192 + 64 * 8, CW_LCNT = 12288, CW_QUEUE = 14336, CW_STEALQ = 14464, CW_ARRIVE = 16384;
constexpr int RING_OFF = 0, RING_BYTES = 131072;
constexpr int LDSCTL_OFF = 143360, MISC_OFF = LDSCTL_OFF + 320;
constexpr int LDS_BYTES = 147456;

__device__ const float INV_FREQ[64] = {
1.000000000e+00f, 8.659643531e-01f, 7.498942018e-01f, 6.493816376e-01f, 5.623413324e-01f, 4.869675338e-01f, 4.216965139e-01f, 3.651741147e-01f, 3.162277639e-01f, 2.738419771e-01f, 2.371373773e-01f, 2.053525001e-01f, 1.778279394e-01f, 1.539926529e-01f, 1.333521456e-01f, 1.154781953e-01f, 1.000000015e-01f, 8.659642935e-02f, 7.498942316e-02f, 6.493816525e-02f, 5.623413250e-02f, 4.869675264e-02f, 4.216964915e-02f, 3.651741147e-02f, 3.162277490e-02f, 2.738419548e-02f, 2.371373773e-02f, 2.053525113e-02f, 1.778279431e-02f, 1.539926510e-02f, 1.333521400e-02f, 1.154781971e-02f, 9.999999776e-03f, 8.659643121e-03f, 7.498942316e-03f, 6.493816152e-03f, 5.623413250e-03f, 4.869675264e-03f, 4.216964822e-03f, 3.651741194e-03f, 3.162277630e-03f, 2.738419687e-03f, 2.371373819e-03f, 2.053525066e-03f, 1.778279431e-03f, 1.539926510e-03f, 1.333521446e-03f, 1.154782018e-03f, 1.000000047e-03f, 8.659643354e-04f, 7.498941850e-04f, 6.493816036e-04f, 5.623413017e-04f, 4.869675322e-04f, 4.216965172e-04f, 3.651741135e-04f, 3.162277571e-04f, 2.738419571e-04f, 2.371373703e-04f, 2.053525095e-04f, 1.778279402e-04f, 1.539926598e-04f, 1.333521504e-04f, 1.154782003e-04f
};

#define GAS __attribute__((address_space(1)))
#define LAS __attribute__((address_space(3)))
typedef unsigned short bf16;
typedef unsigned v4u __attribute__((ext_vector_type(4)));
typedef unsigned v2u __attribute__((ext_vector_type(2)));
typedef float f32x4 __attribute__((ext_vector_type(4)));
typedef float f32x2 __attribute__((ext_vector_type(2)));
typedef short bf16x8 __attribute__((ext_vector_type(8)));
typedef GAS unsigned gu32;
typedef GAS unsigned long long gu64;
#define RLX_AGENT __ATOMIC_RELAXED, __HIP_MEMORY_SCOPE_AGENT
#define LDS_WAIT() asm volatile("s_waitcnt lgkmcnt(0)" ::: "memory")
#define VM_WAIT() asm volatile("s_waitcnt vmcnt(0)" ::: "memory")
__device__ __forceinline__ unsigned f2bf(float f) { unsigned u = __builtin_bit_cast(unsigned, f); return (u + 0x7fffu + ((u >> 16) & 1u)) >> 16; }
__device__ __forceinline__ unsigned pk2(float lo, float hi) { return f2bf(lo) | (f2bf(hi) << 16); }
__device__ __forceinline__ float bflo(unsigned w) { return __builtin_bit_cast(float, w << 16); }
__device__ __forceinline__ float bfhi(unsigned w) { return __builtin_bit_cast(float, w & 0xffff0000u); }

#define XB_TMO      128
#define XB_XCNT(j)  (256  + 64 * (j))
#define XB_XSUB(j)  (1280 + 64 * (j))
#define XB_XGEN(j)  (2304 + 64 * (j))
#define XB_TOP      3328
#define XB_TOPGEN   3392
#define XCD_BAR_WORDS 3456
#define XB_SPIN_CAP (1u << 22)

__device__ __forceinline__ unsigned xb_ld(unsigned* p)              { return __hip_atomic_load(p, __ATOMIC_RELAXED, __HIP_MEMORY_SCOPE_AGENT); }
__device__ __forceinline__ unsigned xb_add(unsigned* p, unsigned v) { return __hip_atomic_fetch_add(p, v, __ATOMIC_RELAXED, __HIP_MEMORY_SCOPE_AGENT); }
__device__ __forceinline__ unsigned xb_xcc_id() { return (unsigned)__builtin_amdgcn_s_getreg((3 << 11) | 20) & 0xFu; }
#define XB_SPIN(cond, bar) do { unsigned _sp = 0; while (cond) { __builtin_amdgcn_s_sleep(1); \
    if ((++_sp & 255u) == 0u) { if (xb_ld(&(bar)[XB_TMO])) break; if (_sp > XB_SPIN_CAP) { atomicAdd(&(bar)[XB_TMO], 1u); break; } } } } while (0)

__device__ __forceinline__ int lane_now() { int l; asm volatile("v_mbcnt_lo_u32_b32 %0, -1, 0\n\tv_mbcnt_hi_u32_b32 %0, -1, %0" : "=v"(l)); return l; }
#define XB_T0() (b.w0 == 0 && lane_now() == 0)
struct XcdBarrier {
    unsigned* bar; unsigned x; int w0;
    volatile LAS unsigned* st;
};

__device__ __forceinline__ XcdBarrier xcd_barrier_post(unsigned* bar, volatile LAS unsigned* st, int w0) {
    XcdBarrier b; b.bar = bar; b.x = xb_xcc_id(); b.st = st; b.w0 = w0;
    if (XB_T0()) (void)xb_add(&bar[XB_XCNT(b.x)], 1u);
    return b;
}
__device__ __forceinline__ void xcd_barrier_complete(unsigned* bar, unsigned x, unsigned& nloc, unsigned& nx) {
    const unsigned G = gridDim.x * gridDim.y * gridDim.z;
    unsigned sum, cnt, mine, sp = 0u;
    for (;;) {
        sum = 0u; cnt = 0u; mine = 0u;
#pragma unroll
        for (unsigned j = 0; j < 16; ++j) { const unsigned c = xb_ld(&bar[XB_XCNT(j)]); sum += c; cnt += (c > 0u) ? 1u : 0u; mine = (j == x) ? c : mine; }
        if (sum == G) break;
        __builtin_amdgcn_s_sleep(1);
        if ((++sp & 255u) == 0u) { if (xb_ld(&bar[XB_TMO])) break; if (sp > XB_SPIN_CAP) { atomicAdd(&bar[XB_TMO], 1u); break; } }
    }
    nloc = mine > 0u ? mine : 1u; nx = cnt > 0u ? cnt : 1u;
}

__device__ __forceinline__ void xcd_barrier(const XcdBarrier& b) {
    asm volatile("s_waitcnt vmcnt(0)" ::: "memory");
    __syncthreads();
    if (XB_T0()) {
        unsigned* bar = b.bar;
        __builtin_amdgcn_s_waitcnt(0);
        unsigned nloc = b.st[0], nx = b.st[1];
        if (nloc == 0u) { xcd_barrier_complete(bar, b.x, nloc, nx); b.st[0] = nloc; b.st[1] = nx; }
        const unsigned old = xb_add(&bar[XB_XSUB(b.x)], 1u);
        const unsigned gen = old / nloc;
        if (old + 1u == (gen + 1u) * nloc) {
            __builtin_amdgcn_fence(__ATOMIC_RELEASE, "agent");
            asm volatile("s_waitcnt vmcnt(0)" ::: "memory");
            const unsigned og = xb_add(&bar[XB_TOP], 1u);
            const unsigned tg = og / nx;
            if (og + 1u == (tg + 1u) * nx) xb_add(&bar[XB_TOPGEN], 1u);
            else XB_SPIN(xb_ld(&bar[XB_TOPGEN]) == tg, bar);
            __builtin_amdgcn_fence(__ATOMIC_ACQUIRE, "agent");
            asm volatile("s_waitcnt vmcnt(0)" ::: "memory");
        } else {
            XB_SPIN(xb_ld(&bar[XB_TOPGEN]) == gen, bar);
            __builtin_amdgcn_fence(__ATOMIC_ACQUIRE, "agent");
            asm volatile("s_waitcnt vmcnt(0)" ::: "memory");
        }
    }
    __syncthreads();
}


struct Frame {
    LAS unsigned char* lds;
    volatile LAS unsigned* MISC;
    gu32* ctl;
    int wave;
    int vcu, G;
    const float* x; float* out;
    const float *w_in, *conv_w, *conv_b, *conv_g, *conv_be, *w_out, *lnm_g, *lnm_b, *lnf_g, *lnf_b, *fg, *fu, *fd, *router, *eg, *eu, *ed;
    unsigned char* ws;
    unsigned long long tacc, tt0;
};
#ifndef PROBE_ID
#define PROBE_ID 0
#endif
#ifndef PROBE_WG
#define PROBE_WG 0
#endif
#define TSTART(id) do { if (PROBE_ID == (id)) F.tt0 = __builtin_amdgcn_s_memrealtime(); } while (0)
#define TSTOP(id) do { if (PROBE_ID == (id)) F.tacc += __builtin_amdgcn_s_memrealtime() - F.tt0; } while (0)
__device__ __forceinline__ int shx_i(int v, int m, int lane) { return __builtin_amdgcn_ds_bpermute((lane ^ m) << 2, v); }
__device__ __forceinline__ float shx(float v, int m, int lane) { return __builtin_bit_cast(float, __builtin_amdgcn_ds_bpermute((lane ^ m) << 2, __builtin_bit_cast(int, v))); }
__device__ __forceinline__ int shl_i(int v, int src) { return __builtin_amdgcn_ds_bpermute(src << 2, v); }
template <int N> __device__ __forceinline__ void wave_sum_n(float (&v)[N], int lane) {
#pragma unroll
    for (int i = 0; i < N; ++i) { float x = v[i];
        x += __builtin_bit_cast(float, __builtin_amdgcn_update_dpp(0, __builtin_bit_cast(int, x), 0xB1, 0xF, 0xF, false));
        x += __builtin_bit_cast(float, __builtin_amdgcn_update_dpp(0, __builtin_bit_cast(int, x), 0x4E, 0xF, 0xF, false));
        x += __builtin_bit_cast(float, __builtin_amdgcn_update_dpp(0, __builtin_bit_cast(int, x), 0x141, 0xF, 0xF, false));
        x += __builtin_bit_cast(float, __builtin_amdgcn_update_dpp(0, __builtin_bit_cast(int, x), 0x140, 0xF, 0xF, false));
        v[i] = x; }
#pragma unroll
    for (int o = 16; o < 64; o <<= 1) { float t[N];
#pragma unroll
        for (int i = 0; i < N; ++i) t[i] = shx(v[i], o, lane);
#pragma unroll
        for (int i = 0; i < N; ++i) v[i] += t[i]; }
}
__device__ __forceinline__ float wave_max(float v, int lane) {
    v = fmaxf(v, __builtin_bit_cast(float, __builtin_amdgcn_update_dpp(0, __builtin_bit_cast(int, v), 0xB1, 0xF, 0xF, false)));
    v = fmaxf(v, __builtin_bit_cast(float, __builtin_amdgcn_update_dpp(0, __builtin_bit_cast(int, v), 0x4E, 0xF, 0xF, false)));
    v = fmaxf(v, __builtin_bit_cast(float, __builtin_amdgcn_update_dpp(0, __builtin_bit_cast(int, v), 0x141, 0xF, 0xF, false)));
    v = fmaxf(v, __builtin_bit_cast(float, __builtin_amdgcn_update_dpp(0, __builtin_bit_cast(int, v), 0x140, 0xF, 0xF, false)));
    v = fmaxf(v, shx(v, 16, lane)); v = fmaxf(v, shx(v, 32, lane));
    return v;
}
__device__ __forceinline__ float wave_sum(float v, int lane) {
    v += __builtin_bit_cast(float, __builtin_amdgcn_update_dpp(0, __builtin_bit_cast(int, v), 0xB1, 0xF, 0xF, false));
    v += __builtin_bit_cast(float, __builtin_amdgcn_update_dpp(0, __builtin_bit_cast(int, v), 0x4E, 0xF, 0xF, false));
    v += __builtin_bit_cast(float, __builtin_amdgcn_update_dpp(0, __builtin_bit_cast(int, v), 0x141, 0xF, 0xF, false));
    v += __builtin_bit_cast(float, __builtin_amdgcn_update_dpp(0, __builtin_bit_cast(int, v), 0x140, 0xF, 0xF, false));
    v += shx(v, 16, lane); v += shx(v, 32, lane);
    return v;
}
__device__ __forceinline__ int wmap(int kind, int c) {
    if (kind == 0) return c;
    if (kind == 1) {
        if (c < 2048) { const int hh = c >> 7, w = c & 127, n = w >> 6, idx = w & 63; return hh * 128 + 32 * (idx >> 4) + 8 * ((idx >> 2) & 3) + 4 * n + (idx & 3); }
        if (c < 3072) return c;
        if (c < 4096) { const int j = c - 3072; return 3072 + 256 * (j >> 7) + (j & 127); }
        const int j = c - 4096; return 3072 + 256 * (j >> 7) + 128 + (j & 127);
    }
    return 256 * (c >> 7) + (kind == 3 ? 128 : 0) + (c & 127);
}
__device__ __forceinline__ void p0_transpose_item(const float* Wg, int K, int N, bf16* WT, int kind, LAS float* scr, int item, int lane) {
    const GAS float* W = (const GAS float*)Wg;
    const int nblk = N / 32, kb = item / nblk, nb = item % nblk, k0 = 64 * kb, n0 = 32 * nb;
    float wv[32];
#pragma unroll
    for (int i = 0; i < 32; ++i) wv[i] = W[(size_t)(k0 + 2 * i + (lane >> 5)) * N + n0 + (lane & 31)];
#pragma unroll
    for (int i = 0; i < 32; ++i) scr[(2 * i + (lane >> 5)) * 33 + (lane & 31)] = wv[i];
    LDS_WAIT(); asm volatile("" ::: "memory");
    const int c = lane & 7;
#pragma unroll
    for (int j = 0; j < 4; ++j) { const int n = (lane >> 3) + 8 * j; const LAS float* s = scr + (8 * c) * 33 + n;
        v4u o; o.x = pk2(s[0 * 33], s[1 * 33]); o.y = pk2(s[2 * 33], s[3 * 33]); o.z = pk2(s[4 * 33], s[5 * 33]); o.w = pk2(s[6 * 33], s[7 * 33]);
        *(GAS v4u*)(WT + (size_t)wmap(kind, n0 + n) * K + k0 + 8 * c) = o; }
    LDS_WAIT(); asm volatile("" ::: "memory");
}
__device__ __forceinline__ void sincos_acc(float ang, float& sn, float& cs) {
    const double x = (double)ang, k = __builtin_rint(x * 0.63661977236758134308);
    double r = __builtin_fma(-k, 1.57079632679489655800e+00, x); r = __builtin_fma(-k, 6.12323399573676603587e-17, r);
    const int q = ((int)k) & 3; const double r2 = r * r;
    double sp = 1.0 / 6227020800.0; sp = sp * r2 - 1.0 / 39916800.0; sp = sp * r2 + 1.0 / 362880.0; sp = sp * r2 - 1.0 / 5040.0; sp = sp * r2 + 1.0 / 120.0; sp = sp * r2 - 1.0 / 6.0;
    const double s = r + r * r2 * sp;
    double cp = -1.0 / 87178291200.0; cp = cp * r2 + 1.0 / 479001600.0; cp = cp * r2 - 1.0 / 3628800.0; cp = cp * r2 + 1.0 / 40320.0; cp = cp * r2 - 1.0 / 720.0; cp = cp * r2 + 1.0 / 24.0; cp = cp * r2 - 0.5;
    const double c = 1.0 + r2 * cp;
    const double ss = (q & 1) ? c : s, cc = (q & 1) ? s : c;
    sn = (float)((q & 2) ? -ss : ss); cs = (float)(((q + 1) & 2) ? -cc : cc);
}
__device__ __forceinline__ void p0_transpose_item8(const float* Wg, int K, int N, unsigned char* WT, int kind, float wscale, LAS float* scr, int item, int lane) {
    const GAS float* W = (const GAS float*)Wg;
    const int nblk = N / 32, kb = item / nblk, nb = item % nblk, k0 = 64 * kb, n0 = 32 * nb;
    float wv[32];
#pragma unroll
    for (int i = 0; i < 32; ++i) wv[i] = W[(size_t)(k0 + 2 * i + (lane >> 5)) * N + n0 + (lane & 31)];
#pragma unroll
    for (int i = 0; i < 32; ++i) scr[(2 * i + (lane >> 5)) * 33 + (lane & 31)] = wv[i] * wscale;
    LDS_WAIT(); asm volatile("" ::: "memory");
    const int c = lane & 7;
#pragma unroll
    for (int j = 0; j < 4; ++j) { const int n = (lane >> 3) + 8 * j; const LAS float* sp = scr + (8 * c) * 33 + n;
        v2u o; o.x = pg8::pk4_fp8(sp[0 * 33], sp[1 * 33], sp[2 * 33], sp[3 * 33]); o.y = pg8::pk4_fp8(sp[4 * 33], sp[5 * 33], sp[6 * 33], sp[7 * 33]);
        *(GAS v2u*)(WT + (size_t)wmap(kind, n0 + n) * K + k0 + 8 * c) = o; }
    LDS_WAIT(); asm volatile("" ::: "memory");
}
__device__ __forceinline__ void p0_transpose_stack8(Frame& F, const float* src, int K, int N, int nmat, unsigned char* dst, size_t dst_stride, int kind, float wscale) {
    LAS float* scr = (LAS float*)(F.lds + RING_OFF + F.wave * 16384);
    const int gw = F.vcu * NWAVES + F.wave, NGW = F.G * NWAVES, per = (K / 64) * (N / 32), total = per * nmat, lane = lane_now();
#pragma clang loop unroll(disable)
    for (int it = gw; it < total; it += NGW) { const int m = it / per, r = it - m * per;
        p0_transpose_item8(src + (size_t)m * K * N, K, N, dst + (size_t)m * dst_stride, kind, wscale, scr, r, lane); }
}
__device__ __forceinline__ void p0_stack(Frame& F, const float* src, int K, int N, int nmat, unsigned char* dst, size_t dst_stride_bytes, int kind, int qmode  , float wscale, int n_lo = 0, int n_cnt = 0, int drow_off = 0, int rot = 0) {
    LAS float* t = (LAS float*)(F.lds + RING_OFF);
    const int tid = F.wave * 64 + lane_now(), ntn = (n_cnt ? n_cnt : N) / 256, per = (K / 128) * ntn, total = per * nmat;
    f32x4 raw[16];
    int it = ((int)blockIdx.x + F.G - rot) % F.G;
    if (it < total) { const int m = it / per, r = it - m * per, k0 = (r / ntn) * 128, n0 = n_lo + (r % ntn) * 256; const GAS f32x4* W = (const GAS f32x4*)(src + (size_t)m * K * N + (size_t)k0 * N + n0);
#pragma unroll
        for (int i = 0; i < 16; ++i) { const int p = tid + 512 * i; raw[i] = W[(size_t)(p >> 6) * (N / 4) + (p & 63)]; } }
#pragma clang loop unroll(disable)
    for (; it < total; it += F.G) { const int m = it / per, r = it - m * per, k0 = (r / ntn) * 128, n0 = n_lo + (r % ntn) * 256;
        const int tid2 = F.wave * 64 + lane_now();
#pragma unroll
        for (int i = 0; i < 16; ++i) { const int p = tid2 + 512 * i; LAS float* d = t + (p >> 6) * 257 + (p & 63) * 4; d[0] = raw[i][0] * wscale; d[1] = raw[i][1] * wscale; d[2] = raw[i][2] * wscale; d[3] = raw[i][3] * wscale; }
        __syncthreads();
        { const int nx = (it + F.G < total) ? it + F.G : it;
          const int m2 = nx / per, r2 = nx - m2 * per, k2 = (r2 / ntn) * 128, n2 = n_lo + (r2 % ntn) * 256; const GAS f32x4* W = (const GAS f32x4*)(src + (size_t)m2 * K * N + (size_t)k2 * N + n2);
#pragma unroll
            for (int i = 0; i < 16; ++i) { const int p = tid2 + 512 * i; raw[i] = W[(size_t)(p >> 6) * (N / 4) + (p & 63)]; } }
        unsigned char* drow = dst + (size_t)m * dst_stride_bytes;
#pragma unroll
        for (int q = 0; q < 8; ++q) { const int cid = tid2 + 512 * q, nrow = cid >> 4, kc = cid & 15; const LAS float* sp = t + (8 * kc) * 257 + nrow;
            const float e0 = sp[0], e1 = sp[257], e2 = sp[2 * 257], e3 = sp[3 * 257], e4 = sp[4 * 257], e5 = sp[5 * 257], e6 = sp[6 * 257], e7 = sp[7 * 257];
            const size_t drw = (size_t)(wmap(kind, n0 + nrow) - drow_off) * K + k0 + 8 * kc;
            if (qmode == 1) { v2u o; o.x = pg8::pk4_fp8(e0, e1, e2, e3); o.y = pg8::pk4_fp8(e4, e5, e6, e7); *(GAS v2u*)(drow + drw) = o; }
            else if (qmode == 2) { v2u o; o.x = pg8::pk4_i8(e0, e1, e2, e3); o.y = pg8::pk4_i8(e4, e5, e6, e7); *(GAS v2u*)(drow + drw) = o; }
            else { v4u o; o.x = pk2(e0, e1); o.y = pk2(e2, e3); o.z = pk2(e4, e5); o.w = pk2(e6, e7); *(GAS v4u*)(drow + drw * 2) = o; } }
        __syncthreads();
    }
}
constexpr int XT_PER = 352, XT_TOTAL = 24 * XT_PER;
static_assert((DM / 128) * (DFF / 256) == XT_PER && (DFF / 128) * (DM / 256) == XT_PER, "expert tile counts");
__device__ __forceinline__ void convert_expert_tile(Frame& F, int t) {
    LAS float* tl = (LAS float*)(F.lds + RING_OFF);
    const int tid = F.wave * 64 + lane_now();
    const int mat = t / XT_PER, r = t - mat * XT_PER, kidx = mat >> 3, e = mat & 7;
    const float* pg = F.eg; const float* pu = F.eu; const float* pd = F.ed;
    asm volatile("" : "+s"(pg), "+s"(pu), "+s"(pd));
    const bool down = kidx == 2;
    const int K = down ? DFF : DM, N = down ? DM : DFF, ntn = N / 256, k0 = (r / ntn) * 128, n0 = (r % ntn) * 256;
    const float* src = (kidx == 0 ? pg : (kidx == 1 ? pu : pd)) + (size_t)e * DM * DFF;
    unsigned char* dst = down ? (F.ws + WS_WDE + (size_t)e * DM * DFF) : (F.ws + WS_WGUE + (size_t)e * 2 * DFF * DM);
    const int kind = down ? 0 : (kidx == 0 ? 2 : 3); const float wscale = down ? WSC_D : WQ_GU;
    const GAS f32x4* W = (const GAS f32x4*)(src + (size_t)k0 * N + n0);
    f32x4 raw[16];
#pragma unroll
    for (int i = 0; i < 16; ++i) { const int p = tid + 512 * i; raw[i] = W[(size_t)(p >> 6) * (N / 4) + (p & 63)]; }
#pragma unroll
    for (int i = 0; i < 16; ++i) { const int p = tid + 512 * i; LAS float* d = tl + (p >> 6) * 257 + (p & 63) * 4; d[0] = raw[i][0] * wscale; d[1] = raw[i][1] * wscale; d[2] = raw[i][2] * wscale; d[3] = raw[i][3] * wscale; }
    __syncthreads();
#pragma unroll
    for (int q = 0; q < 8; ++q) { const int cid = tid + 512 * q, nrow = cid >> 4, kc = cid & 15; const LAS float* sp = tl + (8 * kc) * 257 + nrow;
        const float e0 = sp[0], e1 = sp[257], e2 = sp[2 * 257], e3 = sp[3 * 257], e4 = sp[4 * 257], e5 = sp[5 * 257], e6 = sp[6 * 257], e7 = sp[7 * 257];
        v2u o; if (down) { o.x = pg8::pk4_fp8(e0, e1, e2, e3); o.y = pg8::pk4_fp8(e4, e5, e6, e7); } else { o.x = pg8::pk4_i8(e0, e1, e2, e3); o.y = pg8::pk4_i8(e4, e5, e6, e7); }
        *(GAS v2u*)(dst + (size_t)wmap(kind, n0 + nrow) * K + k0 + 8 * kc) = o; }
    __syncthreads();
}
__device__ __forceinline__ void xt_load(Frame& F, int t, f32x4 (&raw)[16], int tid) {
    const int mat = t / XT_PER, r = t - mat * XT_PER, kidx = mat >> 3, e = mat & 7;
    const float* pg = F.eg; const float* pu = F.eu; const float* pd = F.ed;
    asm volatile("" : "+s"(pg), "+s"(pu), "+s"(pd));
    const bool down = kidx == 2;
    const int N = down ? DM : DFF, ntn = N / 256, k0 = (r / ntn) * 128, n0 = (r % ntn) * 256;
    const float* src = (kidx == 0 ? pg : (kidx == 1 ? pu : pd)) + (size_t)e * DM * DFF;
    const GAS f32x4* W = (const GAS f32x4*)(src + (size_t)k0 * N + n0);
#pragma unroll
    for (int i = 0; i < 16; ++i) { const int p = tid + 512 * i; raw[i] = W[(size_t)(p >> 6) * (N / 4) + (p & 63)]; }
}
__device__ __forceinline__ void xt_store(Frame& F, int t, int tid) {
    const LAS float* tl = (const LAS float*)(F.lds + RING_OFF);
    const int mat = t / XT_PER, r = t - mat * XT_PER, kidx = mat >> 3, e = mat & 7;
    const bool down = kidx == 2;
    const int K = down ? DFF : DM, N = down ? DM : DFF, ntn = N / 256, k0 = (r / ntn) * 128, n0 = (r % ntn) * 256;
    unsigned char* dst = down ? (F.ws + WS_WDE + (size_t)e * DM * DFF) : (F.ws + WS_WGUE + (size_t)e * 2 * DFF * DM);
    const int kind = down ? 0 : (kidx == 0 ? 2 : 3);
#pragma unroll
    for (int q = 0; q < 8; ++q) { const int cid = tid + 512 * q, nrow = cid >> 4, kc = cid & 15; const LAS float* sp = tl + (8 * kc) * 257 + nrow;
        const float e0 = sp[0], e1 = sp[257], e2 = sp[2 * 257], e3 = sp[3 * 257], e4 = sp[4 * 257], e5 = sp[5 * 257], e6 = sp[6 * 257], e7 = sp[7 * 257];
        v2u o; if (down) { o.x = pg8::pk4_fp8(e0, e1, e2, e3); o.y = pg8::pk4_fp8(e4, e5, e6, e7); } else { o.x = pg8::pk4_i8(e0, e1, e2, e3); o.y = pg8::pk4_i8(e4, e5, e6, e7); }
        *(GAS v2u*)(dst + (size_t)wmap(kind, n0 + nrow) * K + k0 + 8 * kc) = o; }
}
constexpr unsigned STEAL_THRESH = 200u;
__device__ __forceinline__ void convert_stream(Frame& F, int idx) {
    LAS float* tl = (LAS float*)(F.lds + RING_OFF);
    __syncthreads();
    const bool t0 = (F.wave == 0) && (lane_now() == 0);
    const bool steal = idx >= 0; const int aidx = steal ? idx : 0;
    unsigned arr = 0u;
    if (t0) { if (steal) arr = __hip_atomic_fetch_add(F.ctl + CW_ARRIVE + 64 * aidx, 1u, RLX_AGENT) + 1u;
        unsigned q = 0xffffffffu; if (!steal || arr < STEAL_THRESH) { q = __hip_atomic_fetch_add(F.ctl + CW_STEALQ, 1u, RLX_AGENT); if (q >= (unsigned)XT_TOTAL) q = 0xffffffffu; }
        F.MISC[17] = q; }
    __syncthreads();
    int tt = (int)__builtin_amdgcn_readfirstlane(F.MISC[17]);
    if (tt < 0) return;
    f32x4 raw[16];
    xt_load(F, tt, raw, F.wave * 64 + lane_now());
#pragma clang loop unroll(disable)
    for (int it = 0; it < XT_TOTAL; ++it) {
        const int tid = F.wave * 64 + lane_now();
        unsigned qn = 0xffffffffu, arrn = 0u;
        if (t0) { if (steal) arrn = __hip_atomic_load(F.ctl + CW_ARRIVE + 64 * aidx, RLX_AGENT);
            if (!steal || arr < STEAL_THRESH) qn = __hip_atomic_fetch_add(F.ctl + CW_STEALQ, 1u, RLX_AGENT); }
        { const float wscale = (tt / XT_PER) >= 16 ? WSC_D : WQ_GU;
#pragma unroll
          for (int i = 0; i < 16; ++i) { const int p = tid + 512 * i; LAS float* d = tl + (p >> 6) * 257 + (p & 63) * 4; d[0] = raw[i][0] * wscale; d[1] = raw[i][1] * wscale; d[2] = raw[i][2] * wscale; d[3] = raw[i][3] * wscale; } }
        if (t0) { F.MISC[17] = qn < (unsigned)XT_TOTAL ? qn : 0xffffffffu; arr = arrn; }
        __syncthreads();
        const int nt = (int)__builtin_amdgcn_readfirstlane(F.MISC[17]);
        xt_load(F, nt >= 0 ? nt : tt, raw, tid);
        xt_store(F, tt, tid);
        __syncthreads();
        if (nt < 0) break;
        tt = nt;
    }
}
__device__ __forceinline__ void steal_point(Frame& F, int idx) { convert_stream(F, idx); }
__device__ __forceinline__ void steal_drain(Frame& F) { convert_stream(F, -1); }
__device__ __forceinline__ void p0_prologue(Frame& F) {
    p0_stack(F, F.w_in, DM, NPROJ, 2, F.ws + WS_WIN, (size_t)20 * MiB, 1, 2, WQ_GU, 0, 2048, 0);
    p0_stack(F, F.w_in, DM, NPROJ, 2, F.ws + WS_WIN, (size_t)20 * MiB, 1, 2, 2.f * WQ_GU, 2048, 1024, 0);
    p0_stack(F, F.w_in, DM, NPROJ, 2, F.ws + WS_WIN, (size_t)20 * MiB, 1, 2, WQ_GU, 3072, 2048, 0);
    p0_stack(F, F.w_out, DM, DM, 2, F.ws + WS_WOUT, (size_t)DM * DM, 0, 2, WQ_O);
    p0_stack(F, F.fg, DM, DFF, 1, F.ws + WS_WGU0, 0, 2, 2, WQ_GU, 0, 0, 0, 128);
    p0_stack(F, F.fu, DM, DFF, 1, F.ws + WS_WGU0, 0, 3, 2, WQ_GU, 0, 0, 0, 224);
    p0_stack(F, F.fd, DFF, DM, 1, F.ws + WS_WD0, 0, 0, 1, WSC_D, 0, 0, 0, 64);
    { const int i = ((F.vcu * NWAVES + F.wave) * 64 + lane_now()); if (i < NE * DM) { const int e = i / DM, k = i - e * DM; const float w = ((const GAS float*)F.router)[k * NE + e];
          const unsigned hi = f2bf(w), lo = f2bf(w - __builtin_bit_cast(float, hi << 16)); ((GAS bf16*)(F.ws + WS_RWT))[i] = (bf16)hi; ((GAS bf16*)(F.ws + WS_RWT))[NE * DM + i] = (bf16)lo; } }
    { GAS float* rc = (GAS float*)(F.ws + WS_ROPEC); GAS float* rs = (GAS float*)(F.ws + WS_ROPES);
      const float ifq = INV_FREQ[lane_now() & 63];
#pragma clang loop unroll(disable)
      for (int i = (F.vcu * NWAVES + F.wave) * 64 + lane_now(); i < S * 64; i += F.G * NWAVES * 64) { const int t = i >> 6; const float ang = (float)t * ifq; float sn, cs; sincos_acc(ang, sn, cs); rc[i] = cs; rs[i] = sn; } }
    { const int gw = F.vcu * NWAVES + F.wave, lane = lane_now();
      f32x4 nv[8];
      { const GAS f32x4* xp0 = (const GAS f32x4*)(F.x + (size_t)(gw * 8) * DM) + lane;
#pragma unroll
        for (int j = 0; j < 8; ++j) nv[j] = xp0[64 * j]; }
#pragma clang loop unroll(disable)
      for (int i = 0; i < 8; ++i) { const int row = gw * 8 + i; const GAS f32x4* xp = (const GAS f32x4*)(F.x + (size_t)(gw * 8 + (i < 7 ? i + 1 : 7)) * DM) + lane;
          f32x4 v[8]; float amax = 0.f;
#pragma unroll
          for (int j = 0; j < 8; ++j) v[j] = nv[j];
#pragma unroll
          for (int j = 0; j < 8; ++j) nv[j] = xp[64 * j];
#pragma unroll
          for (int j = 0; j < 8; ++j) amax = fmaxf(fmaxf(amax, fmaxf(fabsf(v[j][0]), fabsf(v[j][1]))), fmaxf(fabsf(v[j][2]), fabsf(v[j][3])));
          amax = fmaxf(wave_max(amax, lane), 1e-20f); const float qs = 127.f / amax;
          GAS v2u* hb = (GAS v2u*)(F.ws + WS_HB + (size_t)row * DM * 2) + lane;
#pragma unroll
          for (int j = 0; j < 8; ++j) { hb[64 * j] = (v2u){pk2(v[j][0], v[j][1]), pk2(v[j][2], v[j][3])};
              ((GAS unsigned*)(F.ws + WS_HB8 + (size_t)row * DM))[64 * j + lane] = pg8::pk4_i8(v[j][0] * qs, v[j][1] * qs, v[j][2] * qs, v[j][3] * qs); }
          if (lane == 0) ((GAS float*)(F.ws + WS_RSC))[row] = amax * (1.f / 127.f); } }
}

__device__ __forceinline__ void kmean_phase(Frame& F) {
    const int lane = lane_now(), c8 = lane & 15, rg = lane >> 4, u2 = F.wave >> 2, q = F.wave & 3, tid = F.wave * 64 + lane;
    LAS float* ks = (LAS float*)(F.lds + RING_OFF + 8 * 8704);
    { const int unit = (int)blockIdx.x + u2 * F.G, j = unit & 63, h = unit >> 6;
      const GAS v4u* kp = (const GAS v4u*)(F.ws + WS_K) + ((size_t)(j * 256 + 64 * q + rg) * 1024 + h * 128) / 8 + c8;
      v4u w[16];
#pragma unroll
      for (int it = 0; it < 16; ++it) w[it] = kp[(size_t)it * 4 * 128];
      float a[8];
#pragma unroll
      for (int i = 0; i < 8; ++i) a[i] = 0.f;
#pragma unroll
      for (int it = 0; it < 16; ++it) { a[0] += bflo(w[it].x); a[1] += bfhi(w[it].x); a[2] += bflo(w[it].y); a[3] += bfhi(w[it].y); a[4] += bflo(w[it].z); a[5] += bfhi(w[it].z); a[6] += bflo(w[it].w); a[7] += bfhi(w[it].w); }
#pragma unroll
      for (int i = 0; i < 8; ++i) { a[i] += shx(a[i], 16, lane); a[i] += shx(a[i], 32, lane); }
      if (rg == 0) { *(LAS f32x4*)(ks + (u2 * 4 + q) * 128 + 8 * c8) = (f32x4){a[0], a[1], a[2], a[3]}; *(LAS f32x4*)(ks + (u2 * 4 + q) * 128 + 8 * c8 + 4) = (f32x4){a[4], a[5], a[6], a[7]}; } }
    __syncthreads();
    if (tid < 128) { const int uu = tid >> 6, cp = tid & 63, unit = (int)blockIdx.x + uu * F.G, j = unit & 63, h = unit >> 6;
        float m0 = 0.f, m1 = 0.f;
#pragma unroll
        for (int qq = 0; qq < 4; ++qq) { const f32x2 v = *(const LAS f32x2*)(ks + (uu * 4 + qq) * 128 + 2 * cp); m0 += v.x; m1 += v.y; }
        m0 *= (1.f / 256.f); m1 *= (1.f / 256.f);
        const unsigned hi = pk2(m0, m1), lo = pk2(m0 - bflo(hi), m1 - bfhi(hi));
        GAS unsigned* kh = (GAS unsigned*)(F.ws + WS_KMEAN) + ((size_t)(h * 64 + j) * 128) / 2 + cp;
        kh[0] = hi; kh[NH * NBLK * HD / 2] = lo; }
}
__device__ __forceinline__ void vt_phase(Frame& F) {
    const int gw = F.vcu * NWAVES + F.wave, NGW = F.G * NWAVES, lane = lane_now();
    LAS unsigned char* tile = F.lds + RING_OFF + F.wave * 8704;
    constexpr int NU = (S / 32) * NH;
    v4u raw[2][8];
#pragma unroll
    for (int k = 0; k < 2; ++k) { const int unit = (gw + k * NGW) & (NU - 1); const int h = unit & 7, kb = (unit >> 3) * 32;
            const GAS v4u* src = (const GAS v4u*)(F.ws + WS_V) + ((size_t)kb * 1024 + h * 128) / 8;
#pragma unroll
            for (int i = 0; i < 8; ++i) raw[k][i] = src[(size_t)(i * 4 + (lane >> 4)) * 128 + (lane & 15)]; }
#pragma unroll
    for (int k = 0; k < 2; ++k) { const int unit = gw + k * NGW; if (unit < NU) { const int h = unit & 7, kb = (unit >> 3) * 32;
#pragma unroll
            for (int i = 0; i < 8; ++i) *(LAS v4u*)(tile + (i * 4 + (lane >> 4)) * 272 + (lane & 15) * 16) = raw[k][i];
            LDS_WAIT(); asm volatile("" ::: "memory");
            const int ch = lane & 3, G = ch >> 1, g = ch & 1;
#pragma unroll
            for (int i = 0; i < 8; ++i) { const int d = i * 16 + (lane >> 2);
                unsigned short e[8];
#pragma unroll
                for (int p = 0; p < 8; ++p) { const int key = 16 * G + 8 * (p >> 2) + 4 * g + (p & 3); e[p] = *(const LAS unsigned short*)(tile + key * 272 + d * 2); }
                v4u o; o.x = (unsigned)e[0] | ((unsigned)e[1] << 16); o.y = (unsigned)e[2] | ((unsigned)e[3] << 16); o.z = (unsigned)e[4] | ((unsigned)e[5] << 16); o.w = (unsigned)e[6] | ((unsigned)e[7] << 16);
                *((GAS v4u*)(F.ws + WS_VT) + ((size_t)(h * 128 + d) * S + kb + 8 * ch) / 8) = o; }
            LDS_WAIT(); asm volatile("" ::: "memory"); } }
}

constexpr int CT = 16, CROWS = CT + 30;
__device__ __forceinline__ void conv_phase(Frame& F, int l) {
    LAS unsigned* ub = (LAS unsigned*)(F.lds + RING_OFF);
    constexpr int IROWS = 2 * CT + 30;
    LAS f32x2* part = (LAS f32x2*)(F.lds + RING_OFF + IROWS * 2048);
    const int lane = lane_now(), tid = F.wave * 64 + lane;
    const GAS f32x2* cw = (const GAS f32x2*)(F.conv_w + (size_t)l * CKW * 1024) + tid;
    float w0[CKW], w1[CKW];
#pragma unroll
    for (int k = 0; k < CKW; ++k) { const f32x2 w = cw[k * 512]; w0[k] = w.x; w1[k] = w.y; }
    const f32x2 cb = ((const GAS f32x2*)(F.conv_b + l * 1024))[tid], lg = ((const GAS f32x2*)(F.conv_g + l * 1024))[tid], lb = ((const GAS f32x2*)(F.conv_be + l * 1024))[tid];
    const GAS v4u* U = (const GAS v4u*)(F.ws + WS_U);
    GAS unsigned* CAT = (GAS unsigned*)(F.ws + WS_CAT);
    constexpr int NP = (IROWS * 128 + NWAVES * 64 - 1) / (NWAVES * 64);
    const int tb = (int)blockIdx.x * 64;
#pragma clang loop unroll(disable)
    for (int hs = 0; hs < 2; ++hs) { const int tb2 = tb + hs * 2 * CT;
        TSTART(21);
        { const int lane2 = lane_now(), tid2 = F.wave * 64 + lane2;
          v4u nx[NP];
#pragma unroll
          for (int i = 0; i < NP; ++i) { const int p = tid2 + NWAVES * 64 * i, pc = p < IROWS * 128 ? p : IROWS * 128 - 1, tok = tb2 - 30 + (pc >> 7);
              const v4u ld = U[(size_t)(tok >= 0 ? tok : 0) * 128 + (pc & 127)]; const bool ok = tok >= 0; nx[i].x = ok ? ld.x : 0u; nx[i].y = ok ? ld.y : 0u; nx[i].z = ok ? ld.z : 0u; nx[i].w = ok ? ld.w : 0u; }
#pragma unroll
          for (int i = 0; i < NP; ++i) { const int p = tid2 + NWAVES * 64 * i; if (p < IROWS * 128) *(LAS v4u*)(ub + (p >> 7) * 512 + (p & 127) * 4) = nx[i]; } }
        __syncthreads();
        TSTOP(21);
#pragma clang loop unroll(disable)
      for (int sb = 0; sb < 2; ++sb) { const int t0 = tb2 + sb * CT; const LAS unsigned* ubs = ub + sb * CT * 512;
        TSTART(22);
        f32x2 av[CT];
#pragma unroll
        for (int t = 0; t < CT; ++t) av[t] = cb;
#pragma unroll
        for (int r = 0; r < CROWS; ++r) { const unsigned w = ubs[r * 512 + tid]; const f32x2 x = {bflo(w), bfhi(w)};
#pragma unroll
            for (int t = 0; t < CT; ++t) { if (r - t >= 0 && r - t <= 30) av[t] += (f32x2){w0[r - t], w1[r - t]} * x; } }
        TSTOP(22); TSTART(23);
        { float red[2 * CT];
#pragma unroll
          for (int t = 0; t < CT; ++t) { red[2 * t] = av[t].x + av[t].y; red[2 * t + 1] = av[t].x * av[t].x + av[t].y * av[t].y; }
          float r16[16], r8[8], r4[4], r2[2], r1;
#define RS_STEP(dst, src, n, bit) { const bool hi = (lane & (bit)) != 0; float snd_[n], kp_[n]; \
            _Pragma("unroll") for (int i = 0; i < (n); ++i) { float lo_ = src[i], up_ = src[i + (n)]; asm volatile("" : "+v"(lo_), "+v"(up_));     \
                snd_[i] = shx(hi ? lo_ : up_, (bit), lane); kp_[i] = hi ? up_ : lo_; } \
            _Pragma("unroll") for (int i = 0; i < (n); ++i) dst[i] = kp_[i] + snd_[i]; }
          RS_STEP(r16, red, 16, 32) RS_STEP(r8, r16, 8, 16) RS_STEP(r4, r8, 4, 8) RS_STEP(r2, r4, 2, 4)
          { const bool hi = (lane & 2) != 0; float lo_ = r2[0], up_ = r2[1]; asm volatile("" : "+v"(lo_), "+v"(up_)); const float snd = shx(hi ? lo_ : up_, 2, lane); r1 = (hi ? up_ : lo_) + snd; }
#undef RS_STEP
          r1 += shx(r1, 1, lane);
          if ((lane & 1) == 0) ((LAS float*)part)[F.wave * (2 * CT) + (lane >> 1)] = r1; }
        __syncthreads();
        LAS f32x2* fin = part + NWAVES * CT;
        if (tid < CT) { float s1 = 0.f, q = 0.f;
#pragma unroll
            for (int w = 0; w < 8; ++w) { const f32x2 pp = part[w * CT + tid]; s1 += pp.x; q += pp.y; }
            const float mean = s1 * (1.f / 1024.f), var = fmaxf(q * (1.f / 1024.f) - mean * mean, 0.f);
            fin[tid] = (f32x2){mean, 1.0f / sqrtf(var + LN_EPS)}; }
        __syncthreads();
        TSTOP(23); TSTART(24);
        LAS float* pmax = (LAS float*)(fin + CT);
        LAS float* fmx = pmax + NWAVES * CT;
        { f32x4 fv[CT / 2];
#pragma unroll
          for (int i = 0; i < CT / 2; ++i) fv[i] = ((const LAS f32x4*)fin)[i];
          float mx[CT];
#pragma unroll
          for (int t = 0; t < CT; ++t) { const float mean = fv[t >> 1][2 * (t & 1)], rstd = fv[t >> 1][2 * (t & 1) + 1];
              const float y0 = (av[t].x - mean) * rstd * lg.x + lb.x, y1 = (av[t].y - mean) * rstd * lg.y + lb.y;
              av[t].x = y0 * pg8::sigmoidf_fast(y0); av[t].y = y1 * pg8::sigmoidf_fast(y1); mx[t] = fmaxf(fabsf(av[t].x), fabsf(av[t].y)); }
          float m8[8], m4[4], m2[2], m1;
#define RM_STEP(dst, src, n, bit) { const bool hi = (lane & (bit)) != 0; float snd_[n], kp_[n]; \
            _Pragma("unroll") for (int i = 0; i < (n); ++i) { float lo_ = src[i], up_ = src[i + (n)]; asm volatile("" : "+v"(lo_), "+v"(up_)); \
                snd_[i] = shx(hi ? lo_ : up_, (bit), lane); kp_[i] = hi ? up_ : lo_; } \
            _Pragma("unroll") for (int i = 0; i < (n); ++i) dst[i] = fmaxf(kp_[i], snd_[i]); }
          RM_STEP(m8, mx, 8, 32) RM_STEP(m4, m8, 4, 16) RM_STEP(m2, m4, 2, 8)
          { const bool hi = (lane & 4) != 0; float lo_ = m2[0], up_ = m2[1]; asm volatile("" : "+v"(lo_), "+v"(up_)); const float snd = shx(hi ? lo_ : up_, 4, lane); m1 = fmaxf(hi ? up_ : lo_, snd); }
#undef RM_STEP
          m1 = fmaxf(m1, shx(m1, 2, lane)); m1 = fmaxf(m1, shx(m1, 1, lane));
          if ((lane & 3) == 0) pmax[F.wave * CT + (lane >> 2)] = m1; }
        __syncthreads();
        if (tid < CT) { float m = 1e-20f;
#pragma unroll
            for (int w = 0; w < 8; ++w) m = fmaxf(m, pmax[w * CT + tid]);
            fmx[tid] = 127.f / m; ((GAS float*)(F.ws + WS_CSC))[t0 + tid] = m * (1.f / 127.f); }
        __syncthreads();
        { f32x4 qv[CT / 4];
#pragma unroll
          for (int i = 0; i < CT / 4; ++i) qv[i] = ((const LAS f32x4*)fmx)[i];
#pragma unroll
          for (int t = 0; t < CT; ++t) { const float qs = qv[t >> 2][t & 3];
              ((GAS unsigned short*)(F.ws + WS_CAT))[((size_t)(t0 + t) * DM + 1024) / 2 + tid] = (unsigned short)pg8::pk4_i8(av[t].x * qs, av[t].y * qs, 0.f, 0.f); } }
        __syncthreads();
        TSTOP(24);
      }
    }
}

typedef float f32x16 __attribute__((ext_vector_type(16)));
typedef __bf16 bf16x2_t __attribute__((ext_vector_type(2)));
__device__ __forceinline__ unsigned cvtpk(float lo, float hi) { const f32x2 v = {lo, hi}; const bf16x2_t b = __builtin_convertvector(v, bf16x2_t); return __builtin_bit_cast(unsigned, b); }
#define MFMA32(a, b, c) __builtin_amdgcn_mfma_f32_32x32x16_bf16((a), (b), (c), 0, 0, 0)
constexpr int LIST_PER_HEAD = 256 * 2016;
__device__ __forceinline__ int binoff(int j) { return 256 * (63 * j - (j * (j - 1)) / 2); }
#define TOP3_INSERT(v, j) do { const float v_ = (v); const int j_ = (j); \
    if (v_ > tv2) { if (v_ > tv1) { tv2 = tv1; ti2 = ti1; if (v_ > tv0) { tv1 = tv0; ti1 = ti0; tv0 = v_; ti0 = j_; } else { tv1 = v_; ti1 = j_; } } else { tv2 = v_; ti2 = j_; } } } while (0)
__device__ __forceinline__ void sel_phase(Frame& F, int l) {
    LAS int* cntL = (LAS int*)(F.lds + RING_OFF); LAS int* baseL = cntL + 64;
    const int lane = lane_now(), r = lane & 31, hg = lane >> 5, tid = F.wave * 64 + lane;
    const float NEG = -__builtin_inff();
#pragma clang loop unroll(disable)
    for (int unit = blockIdx.x; unit < 63 * NH; unit += F.G) { const int b = 1 + (unit >> 3), h = unit & 7;
        if (tid < 64) cntL[tid] = 0;
        __syncthreads();
        const int t = b * 256 + F.wave * 32 + r;
        const GAS bf16x8* qp = (const GAS bf16x8*)(F.ws + WS_Q) + ((size_t)t * 1024 + h * 128) / 8 + hg;
        bf16x8 qf[8];
#pragma unroll
        for (int kk = 0; kk < 8; ++kk) qf[kk] = qp[2 * kk];
        const GAS bf16x8* kh = (const GAS bf16x8*)(F.ws + WS_KMEAN) + ((size_t)(h * 64 + r) * 128) / 8 + hg;
        f32x16 G0, G1;
#pragma unroll
        for (int i = 0; i < 16; ++i) { G0[i] = 0.f; G1[i] = 0.f; }
        { bf16x8 ka[8], kc[8];
#pragma unroll
          for (int kk = 0; kk < 8; ++kk) ka[kk] = kh[2 * kk];
#pragma unroll
          for (int kk = 0; kk < 8; ++kk) kc[kk] = kh[2 * kk + 32 * 16];
          asm volatile("" : "+v"(ka[0]), "+v"(ka[1]), "+v"(ka[2]), "+v"(ka[3]), "+v"(ka[4]), "+v"(ka[5]), "+v"(ka[6]), "+v"(ka[7]));
#pragma unroll
          for (int kk = 0; kk < 8; ++kk) G0 = MFMA32(ka[kk], qf[kk], G0);
          asm volatile("" : "+v"(kc[0]), "+v"(kc[1]), "+v"(kc[2]), "+v"(kc[3]), "+v"(kc[4]), "+v"(kc[5]), "+v"(kc[6]), "+v"(kc[7]));
          if (b > 32) {
#pragma unroll
              for (int kk = 0; kk < 8; ++kk) G1 = MFMA32(kc[kk], qf[kk], G1); } }
        float tv0 = NEG, tv1 = NEG, tv2 = NEG; int ti0 = 0, ti1 = 0, ti2 = 0;
#pragma unroll
        for (int i = 0; i < 16; ++i) { const int j = (i & 3) + 8 * (i >> 2) + 4 * hg; TOP3_INSERT(j < b ? G0[i] : NEG, j); }
        if (b > 32) {
#pragma unroll
            for (int i = 0; i < 16; ++i) { const int j = 32 + (i & 3) + 8 * (i >> 2) + 4 * hg; TOP3_INSERT(j < b ? G1[i] : NEG, j); } }
        { const float p0 = shx(tv0, 32, lane), p1 = shx(tv1, 32, lane), p2 = shx(tv2, 32, lane); const int q0 = shx_i(ti0, 32, lane), q1 = shx_i(ti1, 32, lane), q2 = shx_i(ti2, 32, lane);
          TOP3_INSERT(p0, q0); TOP3_INSERT(p1, q1); TOP3_INSERT(p2, q2); }
        int rk0 = 0, rk1 = 0, rk2 = 0;
        if (hg == 0) {
            if (tv0 > NEG) rk0 = __hip_atomic_fetch_add(cntL + ti0, 1, __ATOMIC_RELAXED, __HIP_MEMORY_SCOPE_WORKGROUP);
            if (tv1 > NEG) rk1 = __hip_atomic_fetch_add(cntL + ti1, 1, __ATOMIC_RELAXED, __HIP_MEMORY_SCOPE_WORKGROUP);
            if (tv2 > NEG) rk2 = __hip_atomic_fetch_add(cntL + ti2, 1, __ATOMIC_RELAXED, __HIP_MEMORY_SCOPE_WORKGROUP); }
        __syncthreads();
        if (tid < 64) { const int c = cntL[tid]; if (c > 0) baseL[tid] = (int)__hip_atomic_fetch_add(F.ctl + CW_LCNT + l * 512 + h * 64 + tid, (unsigned)c, RLX_AGENT); }
        __syncthreads();
        if (hg == 0) { GAS int* L = (GAS int*)(F.ws + WS_LIST) + (size_t)h * LIST_PER_HEAD;
            if (tv0 > NEG) L[binoff(ti0) + baseL[ti0] + rk0] = t * 4 + 0;
            if (tv1 > NEG) L[binoff(ti1) + baseL[ti1] + rk1] = t * 4 + 1;
            if (tv2 > NEG) L[binoff(ti2) + baseL[ti2] + rk2] = t * 4 + 2; }
        __syncthreads();
    }
}
constexpr int KROW = 272, VROW = 528, KBUF_BYTES = 256 * KROW, VBUF_BYTES = 128 * VROW;
#define SCHED_FENCE() __builtin_amdgcn_sched_barrier(0)
template <bool CAUSAL>
__device__ __forceinline__ void moba_tile(bf16x8 (&qf)[8], const LAS unsigned char* kb, const LAS unsigned char* vb, const int nkt, const int r, const int hg, f32x16 (&O)[4], float& ms, float& lsum, const GAS bf16x8* qpn = nullptr) {
    const float NEG = -__builtin_inff(), SC = 0.08838834764831845f * 1.44269504088896341f;
    f32x16 Sx[8];
    bf16x8 kfA[8], kfB[8];
#pragma unroll
    for (int kk = 0; kk < 8; ++kk) kfA[kk] = *(const LAS bf16x8*)(kb + kk * 32);
#pragma unroll
    for (int kt = 0; kt < 8; ++kt) {
        if (kt < nkt) { f32x16 a;
#pragma unroll
            for (int i = 0; i < 16; ++i) a[i] = 0.f;
            if (kt + 1 < 8 && kt + 1 < nkt) {
#pragma unroll
                for (int kk = 0; kk < 8; ++kk) { if (kt & 1) kfA[kk] = *(const LAS bf16x8*)(kb + (kt + 1) * 32 * KROW + kk * 32); else kfB[kk] = *(const LAS bf16x8*)(kb + (kt + 1) * 32 * KROW + kk * 32); } }
            SCHED_FENCE();
#pragma unroll
            for (int kk = 0; kk < 8; ++kk) a = MFMA32((kt & 1) ? kfB[kk] : kfA[kk], qf[kk], a);
            SCHED_FENCE();
            if (CAUSAL && kt == nkt - 1) {
#pragma unroll
                for (int i = 0; i < 16; ++i) a[i] = ((i & 3) + 8 * (i >> 2) + 4 * hg > r) ? NEG : a[i]; }
            Sx[kt] = a;
        } else {
#pragma unroll
            for (int i = 0; i < 16; ++i) Sx[kt][i] = NEG; }
    }
    if constexpr (!CAUSAL) {
#pragma unroll
        for (int kk = 0; kk < 8; ++kk) qf[kk] = qpn[2 * kk];
        SCHED_FENCE(); }
    float mx = NEG;
#pragma unroll
    for (int kt = 0; kt < 8; ++kt)
#pragma unroll
        for (int i = 0; i < 16; ++i) mx = fmaxf(mx, Sx[kt][i]);
    mx = fmaxf(mx, shx(mx, 32, r + 32 * hg));
    ms = mx * SC;
    float ls = 0.f;
    bf16x8 pb[8][2];
#pragma unroll
    for (int kt = 0; kt < 8; ++kt)
#pragma unroll
        for (int s2 = 0; s2 < 2; ++s2) { float p[8];
#pragma unroll
            for (int i = 0; i < 8; ++i) { p[i] = __builtin_amdgcn_exp2f(Sx[kt][8 * s2 + i] * SC - ms); ls += p[i]; }
            v4u pw; pw.x = cvtpk(p[0], p[1]); pw.y = cvtpk(p[2], p[3]); pw.z = cvtpk(p[4], p[5]); pw.w = cvtpk(p[6], p[7]);
            pb[kt][s2] = __builtin_bit_cast(bf16x8, pw); }
    lsum = ls + shx(ls, 32, r + 32 * hg);
#pragma unroll
    for (int dt = 0; dt < 4; ++dt)
#pragma unroll
        for (int i = 0; i < 16; ++i) O[dt][i] = 0.f;
    bf16x8 vfA[4], vfB[4];
#pragma unroll
    for (int dt = 0; dt < 4; ++dt) vfA[dt] = *(const LAS bf16x8*)(vb + dt * 32 * VROW);
#pragma unroll
    for (int st = 0; st < 16; ++st) { const int kt = st >> 1, s2 = st & 1;
        if (kt < nkt) {
            if (st + 1 < 16 && ((st + 1) >> 1) < nkt) {
#pragma unroll
                for (int dt = 0; dt < 4; ++dt) { if (st & 1) vfA[dt] = *(const LAS bf16x8*)(vb + dt * 32 * VROW + (st + 1) * 32); else vfB[dt] = *(const LAS bf16x8*)(vb + dt * 32 * VROW + (st + 1) * 32); } }
            SCHED_FENCE();
#pragma unroll
            for (int dt = 0; dt < 4; ++dt) O[dt] = MFMA32((st & 1) ? vfB[dt] : vfA[dt], pb[kt][s2], O[dt]);
            SCHED_FENCE();
        }
    }
}
__device__ __forceinline__ void stage_kv(Frame& F, int h, int j, int tid) {
    LAS unsigned char* kbuf = F.lds + RING_OFF; LAS unsigned char* vbuf = kbuf + KBUF_BYTES;
    const GAS v4u* kg = (const GAS v4u*)(F.ws + WS_K) + ((size_t)(j * 256) * 1024 + h * 128) / 8;
    const GAS v4u* vg = (const GAS v4u*)(F.ws + WS_VT) + ((size_t)(h * 128) * S + j * 256) / 8;
    v4u kr[8], vr[8];
#pragma unroll
    for (int i = 0; i < 8; ++i) { const int p = tid + 512 * i; kr[i] = kg[(size_t)(p >> 4) * 128 + (p & 15)]; vr[i] = vg[(size_t)(p >> 5) * (S / 8) + (p & 31)]; }
#pragma unroll
    for (int i = 0; i < 8; ++i) { const int p = tid + 512 * i; *(LAS v4u*)(kbuf + (p >> 4) * KROW + (p & 15) * 16) = kr[i]; *(LAS v4u*)(vbuf + (p >> 5) * VROW + (p & 31) * 16) = vr[i]; }
}
__device__ __forceinline__ void partial_phase(Frame& F, int l) {
    gu32* lcnt = F.ctl + CW_LCNT + l * 512;
    LAS int* tab = (LAS int*)(F.lds + RING_OFF + KBUF_BYTES + VBUF_BYTES);
    LAS int* tabc = tab + 512;
    LAS int* tabn = tab + 1024;
    { const int lane = lane_now(); int tl[8], cs[8], cn[8], sum = 0, csum = 0;
      { v4u c0, c1; asm volatile("global_load_dwordx4 %0, %2, off sc1\n\tglobal_load_dwordx4 %1, %2, off offset:16 sc1\n\ts_waitcnt vmcnt(0)" : "=&v"(c0), "=&v"(c1) : "v"((const GAS unsigned*)(lcnt + lane * 8)) : "memory");
        cn[0] = (int)c0.x; cn[1] = (int)c0.y; cn[2] = (int)c0.z; cn[3] = (int)c0.w; cn[4] = (int)c1.x; cn[5] = (int)c1.y; cn[6] = (int)c1.z; cn[7] = (int)c1.w; }
#pragma unroll
      for (int i = 0; i < 8; ++i) { tl[i] = (cn[i] + 255) >> 8; cs[i] = 14 * tl[i] + (tl[i] ? 11 : 0); sum += tl[i]; csum += cs[i]; }
      int inc = sum, cinc = csum;
#pragma unroll
      for (int o = 1; o < 64; o <<= 1) { const int v = __builtin_amdgcn_ds_bpermute((lane - o) << 2, inc), cv = __builtin_amdgcn_ds_bpermute((lane - o) << 2, cinc); if (lane >= o) { inc += v; cinc += cv; } }
      int run = inc - sum, crun = cinc - csum;
      if (F.wave == 0) {
#pragma unroll
          for (int i = 0; i < 8; ++i) { run += tl[i]; crun += cs[i]; tab[lane * 8 + i] = run; tabc[lane * 8 + i] = crun; tabn[lane * 8 + i] = cn[i]; } } }
    __syncthreads();
    int u_lo, u_hi;
    { const int lane = lane_now(); const long T = tabc[511];
      const int x0 = (int)(((long)blockIdx.x * T) / F.G), x1 = (int)(((long)(blockIdx.x + 1) * T) / F.G);
      int c0 = 0, c1 = 0; int plo = lane ? tabc[lane * 8 - 1] : 0, pu = lane ? tab[lane * 8 - 1] : 0;
#pragma unroll
      for (int i = 0; i < 8; ++i) { const int hi = tabc[lane * 8 + i], uu = tab[lane * 8 + i], nu = uu - pu;
          { const int loc = x0 - plo; c0 += (x0 >= hi) ? nu : (loc <= 0 ? 0 : (loc <= 25 ? 1 : 1 + (loc - 25 + 13) / 14)); }
          { const int loc = x1 - plo; c1 += (x1 >= hi) ? nu : (loc <= 0 ? 0 : (loc <= 25 ? 1 : 1 + (loc - 25 + 13) / 14)); }
          plo = hi; pu = uu; }
#pragma unroll
      for (int o = 1; o < 64; o <<= 1) { c0 += shx_i(c0, o, lane); c1 += shx_i(c1, o, lane); }
      u_lo = __builtin_amdgcn_readfirstlane(c0); u_hi = __builtin_amdgcn_readfirstlane(c1); }
    int staged = -1;
#define PARTIAL_LOCATE(uu, obin, ochunk, oe) { const int lane_ = lane_now(); int b_ = 0, c_ = 0; bool m_ = false; \
        { int lo_ = lane_ ? tab[lane_ * 8 - 1] : 0; \
          _Pragma("unroll") for (int i = 0; i < 8; ++i) { const int hi_ = tab[lane_ * 8 + i]; if ((uu) >= lo_ && (uu) < hi_) { m_ = true; b_ = lane_ * 8 + i; c_ = (uu) - lo_; } lo_ = hi_; } } \
        const int s_ = __builtin_ctzll(__ballot(m_)); obin = __builtin_amdgcn_readlane(b_, s_); ochunk = __builtin_amdgcn_readlane(c_, s_); \
        const int n_ = __builtin_amdgcn_readfirstlane(tabn[obin]), base_ = ochunk * 256 + F.wave * 32, r_ = lane_ & 31; \
        oe = ((const GAS int*)(F.ws + WS_LIST))[(size_t)(obin >> 6) * LIST_PER_HEAD + binoff(obin & 63) + (base_ < n_ ? base_ + (base_ + r_ < n_ ? r_ : 0) : 0)]; }
    int nbin = 0, nchunk = 0, ne = 0;
    bf16x8 qf[8];
    if (u_lo < u_hi) PARTIAL_LOCATE(u_lo, nbin, nchunk, ne)
    { const GAS bf16x8* qp0 = (const GAS bf16x8*)(F.ws + WS_Q) + ((size_t)(ne >> 2) * 1024 + (nbin >> 6) * 128) / 8 + (lane_now() >> 5);
#pragma unroll
      for (int kk = 0; kk < 8; ++kk) qf[kk] = qp0[2 * kk]; }
#pragma clang loop unroll(disable)
    for (int u = u_lo; u < u_hi; ++u) {
        const int lane = lane_now(), r = lane & 31, hg = lane >> 5, tid = F.wave * 64 + lane;
        const LAS unsigned char* kb = F.lds + RING_OFF + r * KROW + hg * 16; const LAS unsigned char* vb = F.lds + RING_OFF + KBUF_BYTES + r * VROW + hg * 16;
        TSTART(41);
        const int bin = nbin, chunk = nchunk, e = ne;
        { const int un = (u + 1 < u_hi) ? u + 1 : u; PARTIAL_LOCATE(un, nbin, nchunk, ne) }
        const int h = bin >> 6, j = bin & 63, n = __builtin_amdgcn_readfirstlane(tabn[bin]);
        const int base = chunk * 256 + F.wave * 32; const bool active = base < n, valid = base + r < n;
        const int t = e >> 2, sl = e & 3;
        const GAS bf16x8* qpn = (const GAS bf16x8*)(F.ws + WS_Q) + ((size_t)(ne >> 2) * 1024 + (nbin >> 6) * 128) / 8 + hg;
        TSTOP(41); TSTART(42);
        if (bin != staged) {
            __syncthreads();
            stage_kv(F, h, j, tid);
            __syncthreads();
            staged = bin; }
        TSTOP(42);
        if (active) {
            f32x16 O[4]; float ms, ls;
            TSTART(43);
            moba_tile<false>(qf, kb, vb, 8, r, hg, O, ms, ls, qpn);
            TSTOP(43); TSTART(44);
            if (valid) { const size_t idx = ((size_t)h * S + t) * 3 + sl; const float inv = 1.0f / ls;
                GAS v2u* po = (GAS v2u*)(F.ws + WS_PO) + idx * 32 + hg;
#pragma unroll
                for (int dt = 0; dt < 4; ++dt)
#pragma unroll
                    for (int g4 = 0; g4 < 4; ++g4) po[dt * 8 + 2 * g4] = (v2u){cvtpk(O[dt][4 * g4] * inv, O[dt][4 * g4 + 1] * inv), cvtpk(O[dt][4 * g4 + 2] * inv, O[dt][4 * g4 + 3] * inv)};
                if (hg == 0) ((GAS f32x2*)(F.ws + WS_PML))[idx] = (f32x2){ms, ls}; }
            TSTOP(44);
        } else {
#pragma unroll
            for (int kk = 0; kk < 8; ++kk) qf[kk] = qpn[2 * kk]; }
    }
#undef PARTIAL_LOCATE
}
__device__ __forceinline__ void own_phase(Frame& F) {
#pragma clang loop unroll(disable)
    for (int u = blockIdx.x; u < NBLK * NH; u += F.G) { const int h = u & 7, b = u >> 3, qt = F.wave;
        const int lane = lane_now(), r = lane & 31, hg = lane >> 5, tid = F.wave * 64 + lane;
        const LAS unsigned char* kb = F.lds + RING_OFF + r * KROW + hg * 16; const LAS unsigned char* vb = F.lds + RING_OFF + KBUF_BYTES + r * VROW + hg * 16;
        const int t = b * 256 + qt * 32 + r;
        const GAS bf16x8* qp = (const GAS bf16x8*)(F.ws + WS_Q) + ((size_t)t * 1024 + h * 128) / 8 + hg;
        bf16x8 qf[8];
#pragma unroll
        for (int kk = 0; kk < 8; ++kk) qf[kk] = qp[2 * kk];
        __syncthreads();
        stage_kv(F, h, b, tid);
        __syncthreads();
        f32x16 O[4]; float ms, ls;
        moba_tile<true>(qf, kb, vb, qt + 1, r, hg, O, ms, ls);
        __syncthreads();
        { LAS unsigned char* ow = F.lds + RING_OFF + F.wave * 8704;
          LAS f32x2* stq = (LAS f32x2*)(F.lds + RING_OFF + KBUF_BYTES) + F.wave * 32;
#pragma unroll
          for (int dt = 0; dt < 4; ++dt)
#pragma unroll
              for (int g4 = 0; g4 < 4; ++g4) *(LAS v2u*)(ow + r * 272 + (dt * 32 + 8 * g4 + 4 * hg) * 2) = (v2u){cvtpk(O[dt][4 * g4], O[dt][4 * g4 + 1]), cvtpk(O[dt][4 * g4 + 2], O[dt][4 * g4 + 3])};
          if (hg == 0) stq[r] = (f32x2){ms, ls};
          LDS_WAIT(); asm volatile("" ::: "memory");
          const int qq = lane >> 4, c = lane & 15, nv = b < 3 ? b : 3;
#pragma unroll
          for (int half = 0; half < 2; ++half) {
              v4u pv[4][3]; f32x2 pml[4][3]; float cscv[4];
#pragma unroll
              for (int pp = 0; pp < 4; ++pp) { const int q = 4 * (half * 4 + pp) + qq; const size_t idx0 = ((size_t)h * S + (b * 256 + qt * 32 + q)) * 3;
                  cscv[pp] = ((const GAS float*)(F.ws + WS_CSC))[b * 256 + qt * 32 + q];
#pragma unroll
                  for (int s2 = 0; s2 < 3; ++s2) { const int so = s2 < nv ? s2 : 0;
                      pv[pp][s2] = ((const GAS v4u*)(F.ws + WS_PO))[(idx0 + so) * 16 + c]; pml[pp][s2] = ((const GAS f32x2*)(F.ws + WS_PML))[idx0 + so]; } }
#pragma unroll
              for (int pp = 0; pp < 4; ++pp) { const int q = 4 * (half * 4 + pp) + qq, t2 = b * 256 + qt * 32 + q;
                  const f32x2 own = stq[q]; const v4u ov = *(const LAS v4u*)(ow + q * 272 + c * 16);
                  float M = own.x;
#pragma unroll
                  for (int s2 = 0; s2 < 3; ++s2) { const bool have = s2 < nv; pml[pp][s2].x = have ? pml[pp][s2].x : -__builtin_inff(); pml[pp][s2].y = have ? pml[pp][s2].y : 0.f;
                      pv[pp][s2].x = have ? pv[pp][s2].x : 0u; pv[pp][s2].y = have ? pv[pp][s2].y : 0u; pv[pp][s2].z = have ? pv[pp][s2].z : 0u; pv[pp][s2].w = have ? pv[pp][s2].w : 0u;
                      M = fmaxf(M, pml[pp][s2].x); }
                  const float wo = __builtin_amdgcn_exp2f(own.x - M); float W = own.y * wo, w[3];
#pragma unroll
                  for (int s2 = 0; s2 < 3; ++s2) { w[s2] = pml[pp][s2].y * __builtin_amdgcn_exp2f(pml[pp][s2].x - M); W += w[s2]; }
                  float o[8] = {bflo(ov.x) * wo, bfhi(ov.x) * wo, bflo(ov.y) * wo, bfhi(ov.y) * wo, bflo(ov.z) * wo, bfhi(ov.z) * wo, bflo(ov.w) * wo, bfhi(ov.w) * wo};
#pragma unroll
                  for (int s2 = 0; s2 < 3; ++s2) { const v4u v = pv[pp][s2]; o[0] += w[s2] * bflo(v.x); o[1] += w[s2] * bfhi(v.x); o[2] += w[s2] * bflo(v.y); o[3] += w[s2] * bfhi(v.y); o[4] += w[s2] * bflo(v.z); o[5] += w[s2] * bfhi(v.z); o[6] += w[s2] * bflo(v.w); o[7] += w[s2] * bfhi(v.w); }
                  const float osc = 1.0f / (W * cscv[pp]);
                  *(GAS v2u*)(F.ws + WS_CAT + (size_t)t2 * DM + h * 128 + 8 * c) = (v2u){pg8::pk4_i8(o[0] * osc, o[1] * osc, o[2] * osc, o[3] * osc), pg8::pk4_i8(o[4] * osc, o[5] * osc, o[6] * osc, o[7] * osc)}; }
          } }
    }
}

__device__ __forceinline__ void ln_phase(Frame& F, const float* xres_, const bf16* y_, const float* g_, const float* b_, const float* router, int q8  ) {
    const int gw = F.vcu * NWAVES + F.wave, lane = lane_now();
    f32x4 gv[8], bv[8];
#pragma unroll
    for (int j = 0; j < 8; ++j) { gv[j] = ((const GAS f32x4*)g_)[lane + 64 * j]; bv[j] = ((const GAS f32x4*)b_)[lane + 64 * j]; }
    f32x4 hraw[8]; v2u hraw16[8], yraw[8];
    { const GAS v2u* yp = (const GAS v2u*)(y_ + (size_t)(gw * 8) * DM) + lane;
      if (xres_) { const GAS f32x4* hp = (const GAS f32x4*)(xres_ + (size_t)(gw * 8) * DM) + lane;
#pragma unroll
          for (int j = 0; j < 8; ++j) hraw[j] = hp[64 * j]; }
      else { const GAS v2u* hp = (const GAS v2u*)(F.ws + WS_HB + (size_t)(gw * 8) * DM * 2) + lane;
#pragma unroll
          for (int j = 0; j < 8; ++j) hraw16[j] = hp[64 * j]; }
#pragma unroll
      for (int j = 0; j < 8; ++j) yraw[j] = yp[64 * j]; }
#pragma clang loop unroll(disable)
    for (int i = 0; i < S / (256 * NWAVES); ++i) { const int row = gw * (S / (256 * NWAVES)) + i;
        f32x4 v[8]; float s = 0.f;
#pragma unroll
        for (int j = 0; j < 8; ++j) { const v2u yv = yraw[j]; const f32x4 hv = xres_ ? hraw[j] : (f32x4){bflo(hraw16[j].x), bfhi(hraw16[j].x), bflo(hraw16[j].y), bfhi(hraw16[j].y)};
            v[j] = hv * ALPHA + (f32x4){bflo(yv.x), bfhi(yv.x), bflo(yv.y), bfhi(yv.y)}; s += (v[j][0] + v[j][1]) + (v[j][2] + v[j][3]); }
        { const int rown = (i + 1 < S / (256 * NWAVES)) ? row + 1 : row;
          const GAS v2u* yp = (const GAS v2u*)(y_ + (size_t)rown * DM) + lane;
            if (xres_) { const GAS f32x4* hp = (const GAS f32x4*)(xres_ + (size_t)rown * DM) + lane;
#pragma unroll
                for (int j = 0; j < 8; ++j) hraw[j] = hp[64 * j]; }
            else { const GAS v2u* hp = (const GAS v2u*)(F.ws + WS_HB + (size_t)rown * DM * 2) + lane;
#pragma unroll
                for (int j = 0; j < 8; ++j) hraw16[j] = hp[64 * j]; }
#pragma unroll
            for (int j = 0; j < 8; ++j) yraw[j] = yp[64 * j]; }
        const float mean = wave_sum(s, lane) * (1.f / DM); float s2 = 0.f;
#pragma unroll
        for (int j = 0; j < 8; ++j) { v[j] = v[j] - mean; s2 += (v[j][0] * v[j][0] + v[j][1] * v[j][1]) + (v[j][2] * v[j][2] + v[j][3] * v[j][3]); }
        const float rstd = 1.f / sqrtf(wave_sum(s2, lane) * (1.f / DM) + LN_EPS);
        GAS v2u* hb = (GAS v2u*)(F.ws + WS_HB + (size_t)row * DM * 2) + lane;
        float amax = 0.f;
#pragma unroll
        for (int j = 0; j < 8; ++j) { v[j] = v[j] * rstd * gv[j] + bv[j]; hb[64 * j] = (v2u){pk2(v[j][0], v[j][1]), pk2(v[j][2], v[j][3])};
            amax = fmaxf(fmaxf(amax, fmaxf(fabsf(v[j][0]), fabsf(v[j][1]))), fmaxf(fabsf(v[j][2]), fabsf(v[j][3])));
            if (q8 == 1) ((GAS unsigned*)(F.ws + WS_HB8 + (size_t)row * DM))[64 * j + lane] = pg8::pk4_fp8(v[j][0] * ASC_H, v[j][1] * ASC_H, v[j][2] * ASC_H, v[j][3] * ASC_H); }
        if (q8 == 2) { amax = fmaxf(wave_max(amax, lane), 1e-20f); const float qs = 127.f / amax;
#pragma unroll
            for (int j = 0; j < 8; ++j) ((GAS unsigned*)(F.ws + WS_HB8 + (size_t)row * DM))[64 * j + lane] = pg8::pk4_i8(v[j][0] * qs, v[j][1] * qs, v[j][2] * qs, v[j][3] * qs);
            if (lane == 0) ((GAS float*)(F.ws + WS_RSC))[row] = amax * (1.f / 127.f); }
    }
}
typedef float f32x4r __attribute__((ext_vector_type(4)));
__device__ __forceinline__ void router_phase(Frame& F) {
    const int lane = lane_now(), rr = lane & 15, kg = lane >> 4, w = F.wave;
    LAS float* lg = (LAS float*)(F.lds + RING_OFF);
    const GAS bf16x8* bp = (const GAS bf16x8*)(F.ws + WS_RWT) + ((size_t)(rr & 7) * DM + 256 * w) / 8 + kg;
    const bool colok = rr < 8;
    bf16x8 bh[8], bl[8], af[4][8];
#pragma unroll
    for (int kk = 0; kk < 8; ++kk) { bh[kk] = bp[4 * kk]; bl[kk] = bp[4 * kk + NE * DM / 8]; }
#pragma unroll
    for (int g = 0; g < 4; ++g) { const int row0 = F.vcu * 64 + g * 16; const GAS bf16x8* ap = (const GAS bf16x8*)(F.ws + WS_HB) + ((size_t)(row0 + rr) * DM + 256 * w) / 8 + kg;
#pragma unroll
        for (int kk = 0; kk < 8; ++kk) af[g][kk] = ap[4 * kk]; }
    if (!colok) {
#pragma unroll
        for (int kk = 0; kk < 8; ++kk) { bh[kk] = (bf16x8){0, 0, 0, 0, 0, 0, 0, 0}; bl[kk] = bh[kk]; } }
#pragma unroll
    for (int g = 0; g < 4; ++g) { f32x4r acc = {0.f, 0.f, 0.f, 0.f};
#pragma unroll
        for (int kk = 0; kk < 8; ++kk) { acc = __builtin_amdgcn_mfma_f32_16x16x32_bf16(af[g][kk], bh[kk], acc, 0, 0, 0); acc = __builtin_amdgcn_mfma_f32_16x16x32_bf16(af[g][kk], bl[kk], acc, 0, 0, 0); }
        if (colok) {
#pragma unroll
            for (int i = 0; i < 4; ++i) lg[((g * 8 + w) * 16 + 4 * kg + i) * 8 + rr] = acc[i]; } }
    __syncthreads();
    if (w == 0) { const int g = lane >> 4, r = lane & 15; float v[8] = {0.f, 0.f, 0.f, 0.f, 0.f, 0.f, 0.f, 0.f};
#pragma unroll
        for (int ww = 0; ww < 8; ++ww) { const f32x4r l0 = *(const LAS f32x4r*)(lg + ((g * 8 + ww) * 16 + r) * 8), l1 = *(const LAS f32x4r*)(lg + ((g * 8 + ww) * 16 + r) * 8 + 4);
            v[0] += l0[0]; v[1] += l0[1]; v[2] += l0[2]; v[3] += l0[3]; v[4] += l1[0]; v[5] += l1[1]; v[6] += l1[2]; v[7] += l1[3]; }
        float v1 = v[0]; int i1 = 0;
#pragma unroll
        for (int e = 1; e < 8; ++e) if (v[e] > v1) { v1 = v[e]; i1 = e; }
        float v2 = -__builtin_inff(); int i2 = -1;
#pragma unroll
        for (int e = 0; e < 8; ++e) if (e != i1 && v[e] > v2) { v2 = v[e]; i2 = e; }
        const float g1 = 1.0f / (1.0f + __expf(v2 - v1)), g2 = 1.0f - g1; const int row = F.vcu * 64 + g * 16 + r;
        ((GAS int*)(F.ws + WS_EIDX))[row * 2] = i1; ((GAS int*)(F.ws + WS_EIDX))[row * 2 + 1] = i2; ((GAS float*)(F.ws + WS_GATEW))[row * 2] = g1; ((GAS float*)(F.ws + WS_GATEW))[row * 2 + 1] = g2;
        int mine = 0;
#pragma unroll
        for (int e = 0; e < 8; ++e) { const int c = __builtin_popcountll(__ballot(i1 == e)) + __builtin_popcountll(__ballot(i2 == e)); mine = (lane == e) ? c : mine; }
        if (lane < 8 && mine) __hip_atomic_fetch_add(F.ctl + CW_ECNT + 64 * lane, (unsigned)mine, RLX_AGENT); }
    __syncthreads();
}
__device__ __forceinline__ void load_expert_layout(Frame& F, int (&off)[8], int (&cum)[8], int& npanels) {
    const int lane = lane_now();
    const int cv = (int)__hip_atomic_load(F.ctl + CW_ECNT + 64 * (lane & 7), RLX_AGENT);
    int o = 0;
#pragma unroll
    for (int e = 0; e < 8; ++e) { const int c = __builtin_amdgcn_readlane(cv, e); off[e] = o; cum[e] = o >> 8; o += (c + 255) & ~255; }
    npanels = o >> 8;
}
__device__ __forceinline__ void route_phase(Frame& F) {
    const int gw = F.vcu * NWAVES + F.wave, lane = lane_now();
    int off[8], cum[8], np; load_expert_layout(F, off, cum, np);
    const int row = gw * 8 + (lane >> 1), slot = lane & 1; const bool act = lane < 16;
    const int mye = act ? ((const GAS int*)(F.ws + WS_EIDX))[row * 2 + slot] : -1;
    int pos = 0, rank = 0, myn = 0;
#pragma unroll
    for (int e = 0; e < 8; ++e) { const unsigned long long mask = __ballot(mye == e);
        myn = (lane == e) ? __builtin_popcountll(mask) : myn; if (mye == e) rank = __builtin_popcountll(mask & ((1ull << lane) - 1ull)); }
    unsigned rb = 0u;
    if (lane < 8 && myn) rb = __hip_atomic_fetch_add(F.ctl + CW_ECUR + 64 * lane, (unsigned)myn, RLX_AGENT);
#pragma unroll
    for (int e = 0; e < 8; ++e) { const int be = __builtin_amdgcn_readlane((int)rb, e); if (mye == e) pos = off[e] + be + rank; }
    if (act) { ((GAS int*)(F.ws + WS_ROWPOS))[row * 2 + slot] = pos; ((GAS float*)(F.ws + WS_RSP))[pos] = ((const GAS float*)(F.ws + WS_RSC))[row]; }
#pragma clang loop unroll(disable)
    for (int k0 = 0; k0 < 16; k0 += 8) {
        v4u t[8][2];
#pragma unroll
        for (int k = 0; k < 8; ++k) { const int r = gw * 8 + ((k0 + k) >> 1); const GAS v4u* src = (const GAS v4u*)(F.ws + WS_HB8 + (size_t)r * DM) + lane; t[k][0] = src[0]; t[k][1] = src[64]; }
#pragma unroll
        for (int k = 0; k < 8; ++k) { const int p = __builtin_amdgcn_readfirstlane(shl_i(pos, k0 + k)); GAS v4u* dst = (GAS v4u*)(F.ws + WS_HBP + (size_t)p * DM) + lane; dst[0] = t[k][0]; dst[64] = t[k][1]; }
    }
}
__device__ __forceinline__ void ln_moe_phase(Frame& F, const float* g_, const float* b_) {
    const int gw = F.vcu * NWAVES + F.wave, lane = lane_now();
    f32x4 gv[8], bv[8];
#pragma unroll
    for (int j = 0; j < 8; ++j) { gv[j] = ((const GAS f32x4*)g_)[lane + 64 * j]; bv[j] = ((const GAS f32x4*)b_)[lane + 64 * j]; }
    int mp1 = 0, mp2 = 0; float mg1 = 0.f, mg2 = 0.f;
    if (lane < 8) { const int rr = gw * 8 + lane; mp1 = ((const GAS int*)(F.ws + WS_ROWPOS))[rr * 2]; mp2 = ((const GAS int*)(F.ws + WS_ROWPOS))[rr * 2 + 1]; mg1 = ((const GAS float*)(F.ws + WS_GATEW))[rr * 2]; mg2 = ((const GAS float*)(F.ws + WS_GATEW))[rr * 2 + 1]; }
    v2u hraw[8], araw[8], braw[8];
    { const int p1 = __builtin_amdgcn_readlane(mp1, 0), p2 = __builtin_amdgcn_readlane(mp2, 0);
      const GAS v2u* hp = (const GAS v2u*)(F.ws + WS_HB + (size_t)(gw * 8) * DM * 2) + lane;
      const GAS v2u* y1 = (const GAS v2u*)(F.ws + WS_R2 + (size_t)p1 * DM * 2) + lane; const GAS v2u* y2 = (const GAS v2u*)(F.ws + WS_R2 + (size_t)p2 * DM * 2) + lane;
#pragma unroll
      for (int j = 0; j < 8; ++j) { hraw[j] = hp[64 * j]; araw[j] = y1[64 * j]; braw[j] = y2[64 * j]; } }
#pragma clang loop unroll(disable)
    for (int i = 0; i < 8; ++i) { const int row = gw * 8 + i;
        const float g1 = __builtin_bit_cast(float, shl_i(__builtin_bit_cast(int, mg1), i)), g2 = __builtin_bit_cast(float, shl_i(__builtin_bit_cast(int, mg2), i));
        f32x4 v[8]; float s = 0.f;
#pragma unroll
        for (int j = 0; j < 8; ++j) { const v2u a = araw[j], b = braw[j];
            const f32x4 fa = (f32x4){bflo(a.x), bfhi(a.x), bflo(a.y), bfhi(a.y)}, fb = (f32x4){bflo(b.x), bfhi(b.x), bflo(b.y), bfhi(b.y)};
            v[j] = (f32x4){bflo(hraw[j].x), bfhi(hraw[j].x), bflo(hraw[j].y), bfhi(hraw[j].y)} * ALPHA + fa * g1 + fb * g2; s += (v[j][0] + v[j][1]) + (v[j][2] + v[j][3]); }
        { const int in = (i + 1 < 8) ? i + 1 : i; const int p1 = __builtin_amdgcn_readfirstlane(shl_i(mp1, in)), p2 = __builtin_amdgcn_readfirstlane(shl_i(mp2, in));
            const GAS v2u* hp = (const GAS v2u*)(F.ws + WS_HB + (size_t)(gw * 8 + in) * DM * 2) + lane;
            const GAS v2u* y1 = (const GAS v2u*)(F.ws + WS_R2 + (size_t)p1 * DM * 2) + lane; const GAS v2u* y2 = (const GAS v2u*)(F.ws + WS_R2 + (size_t)p2 * DM * 2) + lane;
#pragma unroll
            for (int j = 0; j < 8; ++j) { hraw[j] = hp[64 * j]; araw[j] = y1[64 * j]; braw[j] = y2[64 * j]; } }
        const float mean = wave_sum(s, lane) * (1.f / DM); float s2 = 0.f;
#pragma unroll
        for (int j = 0; j < 8; ++j) { v[j] = v[j] - mean; s2 += (v[j][0] * v[j][0] + v[j][1] * v[j][1]) + (v[j][2] * v[j][2] + v[j][3] * v[j][3]); }
        const float rstd = 1.f / sqrtf(wave_sum(s2, lane) * (1.f / DM) + LN_EPS);
        GAS f32x4* op = (GAS f32x4*)(F.out + (size_t)row * DM) + lane;
#pragma unroll
        for (int j = 0; j < 8; ++j) op[64 * j] = v[j] * rstd * gv[j] + bv[j];
    }
}

struct Args { const float* in[18]; float* out; unsigned char* ws; };
__global__ void __launch_bounds__(NWAVES * 64, 2) hymba_fwd(Args args) {
    extern __shared__ __attribute__((aligned(16))) unsigned char lds[];
    Frame F;
    F.lds = (LAS unsigned char*)lds;
    F.MISC = (volatile LAS unsigned*)(F.lds + MISC_OFF);
    F.wave = __builtin_amdgcn_readfirstlane((int)threadIdx.x >> 6);
    F.G = gridDim.x; { const int bx = blockIdx.x; F.vcu = (F.G % 8 == 0) ? (bx % 8) * (F.G / 8) + bx / 8 : bx; }
    F.ws = args.ws; F.ctl = (gu32*)(args.ws + WS_CTL);
    F.x = args.in[0]; F.w_in = args.in[1]; F.conv_w = args.in[2]; F.conv_b = args.in[3]; F.conv_g = args.in[4]; F.conv_be = args.in[5]; F.w_out = args.in[6];
    F.lnm_g = args.in[7]; F.lnm_b = args.in[8]; F.lnf_g = args.in[9]; F.lnf_b = args.in[10]; F.fg = args.in[11]; F.fu = args.in[12]; F.fd = args.in[13];
    F.router = args.in[14]; F.eg = args.in[15]; F.eu = args.in[16]; F.ed = args.in[17]; F.out = args.out;
    for (int u = threadIdx.x; u < (LDS_BYTES - LDSCTL_OFF) / 4; u += NWAVES * 64) ((LAS unsigned*)(F.lds + LDSCTL_OFF))[u] = 0u;
    __syncthreads();
    XcdBarrier bar = xcd_barrier_post((unsigned*)(F.ctl + CW_BAR), F.MISC + 8, F.wave);
#define LAUNDER() asm volatile("" : "+s"(F.ws), "+s"(F.ctl), "+s"(F.out), "+s"(F.x), "+s"(bar.bar), "+s"(F.wave))
#define GRID_BAR_N(k) do { LAUNDER(); TSTART(200); TSTART(200 + (k)); xcd_barrier(bar); TSTOP(200); TSTOP(200 + (k)); LAUNDER(); } while (0)
#define GRID_BAR() GRID_BAR_N(99)
#ifndef PROBE_ID
#define PROBE_ID 0
#endif
    F.tacc = 0ull; F.tt0 = 0ull;
#define HB ((bf16*)(F.ws + WS_HB))
#define Y ((bf16*)(F.ws + WS_R2))

    TSTART(10); p0_prologue(F); TSTOP(10);
    GRID_BAR_N(1);

#pragma clang loop unroll(disable)
    for (int l = 0; l < 2; ++l) {
#ifndef NO_G_INPROJ
        TSTART(11);
        { pg8::Gemm g{(const bf16*)(F.ws + WS_HB8), (const bf16*)(F.ws + WS_WIN + (size_t)l * 20 * MiB), S, NPROJ, DM / 2, 0}; pg8::StaticOrder So; So.init(S, NPROJ, F.G, (int)blockIdx.x);
          pg8::EpiInProj E{(bf16*)(F.ws + WS_Q), (bf16*)(F.ws + WS_K), (bf16*)(F.ws + WS_V), (bf16*)(F.ws + WS_U), (const float*)(F.ws + WS_ROPEC), (const float*)(F.ws + WS_ROPES), (const float*)(F.ws + WS_RSC), 1.0f / WQ_GU, 0.5f / WQ_GU, 0};
          pg8::gemm_phase<pg8::EpiInProj, pg8::StaticOrder, true, true, false, true>(F.lds + RING_OFF, g, So, E, F.wave); }
        TSTOP(11);
#endif
        GRID_BAR_N(2);
        TSTART(1); kmean_phase(F); TSTOP(1);
        TSTART(2); vt_phase(F); TSTOP(2);
        __syncthreads();
        TSTART(3); conv_phase(F, l); TSTOP(3);
        GRID_BAR_N(3);
        TSTART(4); sel_phase(F, l); TSTOP(4);
        GRID_BAR_N(4);
        TSTART(51); TSTART(5); partial_phase(F, l); TSTOP(5);
        steal_point(F, 5 * 2 + l); GRID_BAR_N(5); TSTOP(51);
        TSTART(52); TSTART(6); own_phase(F); TSTOP(6);
        GRID_BAR_N(6); TSTOP(52);
#ifndef NO_G_OUTPROJ
        TSTART(12);
        { pg8::Gemm g{(const bf16*)(F.ws + WS_CAT), (const bf16*)(F.ws + WS_WOUT + (size_t)l * DM * DM), S, DM, DM / 2, 0}; pg8::StaticOrder So; So.init(S, DM, F.G, (int)blockIdx.x);
          pg8::EpiBf16r E{Y, DM, (const float*)(F.ws + WS_CSC), 1.0f / WQ_O};
          pg8::gemm_phase<pg8::EpiBf16r, pg8::StaticOrder, true, true, false, true>(F.lds + RING_OFF, g, So, E, F.wave); }
        TSTOP(12);
#endif
        GRID_BAR_N(7);
        TSTART(7); ln_phase(F, nullptr, Y, F.lnm_g + l * DM, F.lnm_b + l * DM, l == 1 ? F.router : nullptr, 2); TSTOP(7);
        if (l == 0) GRID_BAR_N(8);
        else { LAUNDER(); asm volatile("s_waitcnt vmcnt(0)" ::: "memory"); __syncthreads(); LAUNDER(); }
        if (l == 0) {
#ifndef NO_G_FFNGU
        TSTART(13); unsigned long long ck1 = (PROBE_ID == 313) ? (unsigned long long)clock64() : 0ull;
            { pg8::Gemm g{(const bf16*)(F.ws + WS_HB8), (const bf16*)(F.ws + WS_WGU0), S, 2 * DFF, DM / 2, 0}; pg8::StaticOrder So; So.init(S, 2 * DFF, F.G, (int)blockIdx.x);
              pg8::EpiSwiGLU8 E{F.ws + WS_ACT, DFF, 1.0f / WQ_GU, ASC_ACT, (const float*)(F.ws + WS_RSC)};
              pg8::gemm_phase<pg8::EpiSwiGLU8, pg8::StaticOrder, true, true, false, true>(F.lds + RING_OFF, g, So, E, F.wave); }
        TSTOP(13); if (PROBE_ID == 313) F.tacc += ((unsigned long long)clock64() - ck1) >> 8;
#endif
            GRID_BAR_N(9);
#ifndef NO_G_FFND
        TSTART(14);
            { pg8::Gemm g{(const bf16*)(F.ws + WS_ACT), (const bf16*)(F.ws + WS_WD0), S, DM, DFF / 2, 0}; pg8::StaticOrder So; So.init(S, DM, F.G, (int)blockIdx.x);
              pg8::EpiBf16 E{Y, DM, 1.0f / (WSC_D * ASC_ACT)};
              pg8::gemm_phase<pg8::EpiBf16, pg8::StaticOrder, true, true, true>(F.lds + RING_OFF, g, So, E, F.wave); }
        TSTOP(14);
#endif
            GRID_BAR_N(10);
            TSTART(7); ln_phase(F, nullptr, Y, F.lnf_g, F.lnf_b, nullptr, 2); TSTOP(7);
            GRID_BAR_N(11);
        } else {
            TSTART(17); router_phase(F); TSTOP(17);
            GRID_BAR_N(12);
            TSTART(8); route_phase(F); TSTOP(8);
            steal_drain(F); GRID_BAR_N(13);
            int off[8], cum[8], np; load_expert_layout(F, off, cum, np);
#ifndef NO_G_MOEGU
        TSTART(15); unsigned long long ck0 = (PROBE_ID == 315) ? (unsigned long long)clock64() : 0ull;
            { pg8::Gemm g{(const bf16*)(F.ws + WS_HBP), (const bf16*)(F.ws + WS_WGUE), np * 256, 2 * DFF, DM / 2, (size_t)2 * DFF * DM}; pg8::GroupedOrder So; So.init(np * 256, 2 * DFF, F.G, (int)blockIdx.x);
#pragma unroll
              for (int e = 0; e < 8; ++e) So.cum[e] = cum[e];
              pg8::EpiSwiGLU8 E{F.ws + WS_ACT, DFF, 1.0f / WQ_GU, ASC_ACT, (const float*)(F.ws + WS_RSP)};
              const int full = (So.nwg / F.G) * F.G, T = So.nwg - full, KS = (T == 0 || T > F.G / 2) ? 1 : (T > F.G / 4 ? 2 : 4);
              if (KS > 1) So.lim = full;
              pg8::gemm_phase<pg8::EpiSwiGLU8, pg8::GroupedOrder, true, true, false, true>(F.lds + RING_OFF, g, So, E, F.wave);
              if (KS > 1) {
                  const int s = (int)blockIdx.x, j = s / KS, kc = s - j * KS, NT = DM / 128;
                  const int k0 = ((NT * kc / KS) + 1) & ~1, k1 = kc + 1 == KS ? NT : (((NT * (kc + 1) / KS) + 1) & ~1);
                  pg8::OneUnit S1; S1.has = s < T * KS; S1.u.pm = 0; S1.u.pn = 0; S1.u.e = 0;
                  if (S1.has) { So.at(full + j, S1.u); So.expert_of(S1.u); }
                  pg8::Gemm g2{(const bf16*)(F.ws + WS_HBP) + k0 * pg8::BK, (const bf16*)(F.ws + WS_WGUE) + k0 * pg8::BK, np * 256, 2 * DFF, DM / 2, (size_t)2 * DFF * DM, k1 - k0};
                  pg8::EpiPartF32 E2{(float*)(F.ws + WS_PO) + (size_t)s * 65536};
                  pg8::gemm_phase<pg8::EpiPartF32, pg8::OneUnit, true, true, false, true>(F.lds + RING_OFF, g2, S1, E2, F.wave);
                  GRID_BAR_N(17);
                  { const int tid = F.wave * 64 + lane_now();
#pragma clang loop unroll(disable)
                    for (int idx = (int)blockIdx.x * 512 + tid; idx < T * 4096; idx += F.G * 512) { const int jj = idx >> 12, w = idx & 4095, r = w >> 4, c8 = (w & 15) * 8;
                        pg8::Unit u; So.at(full + jj, u);
                        const GAS f32x4* pp = (const GAS f32x4*)(F.ws + WS_PO) + ((size_t)jj * KS * 65536 + r * 256 + c8) / 4;
                        const float si = ((const GAS float*)(F.ws + WS_RSP))[u.pm * 256 + r] * (1.0f / WQ_GU);
                        f32x4 pv[4][4];
#pragma unroll
                        for (int k = 0; k < 4; ++k) { const GAS f32x4* pk = pp + (size_t)(k < KS ? k : 0) * 16384; pv[k][0] = pk[0]; pv[k][1] = pk[1]; pv[k][2] = pk[32]; pv[k][3] = pk[33]; }
#pragma unroll
                        for (int k = 0; k < 4; ++k) asm volatile("" : "+v"(pv[k][0]), "+v"(pv[k][1]), "+v"(pv[k][2]), "+v"(pv[k][3]));
                        f32x4 g0 = pv[0][0], g1 = pv[0][1], u0 = pv[0][2], u1 = pv[0][3];
#pragma unroll
                        for (int k = 1; k < 4; ++k) { const float m = k < KS ? 1.f : 0.f; g0 += pv[k][0] * m; g1 += pv[k][1] * m; u0 += pv[k][2] * m; u1 += pv[k][3] * m; }
                        float o[8];
#pragma unroll
                        for (int q = 0; q < 4; ++q) { const float ga = g0[q] * si, gb = g1[q] * si; o[q] = ga * pg8::sigmoidf_fast(ga) * (u0[q] * si) * ASC_ACT; o[4 + q] = gb * pg8::sigmoidf_fast(gb) * (u1[q] * si) * ASC_ACT; }
                        *(GAS v2u*)(F.ws + WS_ACT + (size_t)(u.pm * 256 + r) * DFF + u.pn * 128 + c8) = (v2u){pg8::pk4_fp8(o[0], o[1], o[2], o[3]), pg8::pk4_fp8(o[4], o[5], o[6], o[7])}; } }
              } }
        TSTOP(15); if (PROBE_ID == 315) F.tacc += ((unsigned long long)clock64() - ck0) >> 8;
#endif
            GRID_BAR_N(14);
#ifndef NO_G_MOED
        TSTART(16);
            { pg8::Gemm g{(const bf16*)(F.ws + WS_ACT), (const bf16*)(F.ws + WS_WDE), np * 256, DM, DFF / 2, (size_t)DM * DFF}; pg8::GroupedOrder So; So.init(np * 256, DM, F.G, (int)blockIdx.x);
#pragma unroll
              for (int e = 0; e < 8; ++e) So.cum[e] = cum[e];
              pg8::EpiBf16 E{(bf16*)(F.ws + WS_R2), DM, 1.0f / (WSC_D * ASC_ACT)};
              const int full = (So.nwg / F.G) * F.G, T = So.nwg - full, KS = (T == 0 || T > F.G / 2) ? 1 : (T > F.G / 4 ? 2 : 4);
              if (KS > 1) So.lim = full;
              pg8::gemm_phase<pg8::EpiBf16, pg8::GroupedOrder, true, true, true>(F.lds + RING_OFF, g, So, E, F.wave);
              if (KS > 1) {
                  const int s = (int)blockIdx.x, j = s / KS, kc = s - j * KS, NT = DFF / 128;
                  const int k0 = ((NT * kc / KS) + 1) & ~1, k1 = kc + 1 == KS ? NT : (((NT * (kc + 1) / KS) + 1) & ~1);
                  pg8::OneUnit S1; S1.has = s < T * KS; S1.u.pm = 0; S1.u.pn = 0; S1.u.e = 0;
                  if (S1.has) { So.at(full + j, S1.u); So.expert_of(S1.u); }
                  pg8::Gemm g2{(const bf16*)(F.ws + WS_ACT) + k0 * pg8::BK, (const bf16*)(F.ws + WS_WDE) + k0 * pg8::BK, np * 256, DM, DFF / 2, (size_t)DM * DFF, k1 - k0};
                  pg8::EpiPartF32 E2{(float*)(F.ws + WS_PO) + (size_t)s * 65536};
                  pg8::gemm_phase<pg8::EpiPartF32, pg8::OneUnit, true, true, true>(F.lds + RING_OFF, g2, S1, E2, F.wave);
                  GRID_BAR_N(16);
                  { const int tid = F.wave * 64 + lane_now(); const float sc = 1.0f / (WSC_D * ASC_ACT);
#pragma clang loop unroll(disable)
                    for (int idx = (int)blockIdx.x * 512 + tid; idx < T * 8192; idx += F.G * 512) { const int jj = idx >> 13, w = idx & 8191, r = w >> 5, c8 = (w & 31) * 8;
                        pg8::Unit u; So.at(full + jj, u);
                        const GAS f32x4* pp = (const GAS f32x4*)(F.ws + WS_PO) + ((size_t)jj * KS * 65536 + r * 256 + c8) / 4;
                        f32x4 pv[4][2];
#pragma unroll
                        for (int k = 0; k < 4; ++k) { const GAS f32x4* pk = pp + (size_t)(k < KS ? k : 0) * 16384; pv[k][0] = pk[0]; pv[k][1] = pk[1]; }
                        asm volatile("" : "+v"(pv[0][0]), "+v"(pv[0][1]), "+v"(pv[1][0]), "+v"(pv[1][1]), "+v"(pv[2][0]), "+v"(pv[2][1]), "+v"(pv[3][0]), "+v"(pv[3][1]));
                        f32x4 a0 = pv[0][0], a1 = pv[0][1];
#pragma unroll
                        for (int k = 1; k < 4; ++k) { const float m = k < KS ? 1.f : 0.f; a0 += pv[k][0] * m; a1 += pv[k][1] * m; }
                        a0 *= sc; a1 *= sc;
                        *(GAS v4u*)(F.ws + WS_R2 + ((size_t)(u.pm * 256 + r) * DM + u.pn * 256 + c8) * 2) = (v4u){pg8::cvt_pk_bf16(a0[0], a0[1]), pg8::cvt_pk_bf16(a0[2], a0[3]), pg8::cvt_pk_bf16(a1[0], a1[1]), pg8::cvt_pk_bf16(a1[2], a1[3])}; } }
              } }
        TSTOP(16);
#endif
            GRID_BAR_N(15);
            TSTART(9); ln_moe_phase(F, F.lnf_g + DM, F.lnf_b + DM); TSTOP(9);
        }
    }
    if (PROBE_ID != 0 && blockIdx.x == PROBE_WG && F.wave == 0) { const unsigned long long t1 = __builtin_amdgcn_s_memrealtime(); while (__builtin_amdgcn_s_memrealtime() - t1 < 16ull * F.tacc) __builtin_amdgcn_s_sleep(8); }
#undef GRID_BAR
#undef LAUNDER
#undef HB
#undef Y
}

extern "C" void kernel_launch(void* const* d_in, const int* in_sizes, int n_in, void* d_out, int out_size, void* d_ws, size_t ws_size, hipStream_t stream) {
    static int grid = 0;
    if (grid == 0) {
        if (n_in != 18 || in_sizes[0] != S * DM || out_size != S * DM || ws_size < WS_END) { fprintf(stderr, "kernel_launch: unexpected shapes (n_in %d, in0 %d, out %d, ws %zu < %zu); nothing launched\n", n_in, n_in > 0 ? in_sizes[0] : -1, out_size, ws_size, (size_t)WS_END); grid = -1; return; }
        int dev = 0, cus = 0, per_cu = 0;
        if (hipGetDevice(&dev) != hipSuccess || hipDeviceGetAttribute(&cus, hipDeviceAttributeMultiprocessorCount, dev) != hipSuccess) { grid = -1; return; }
        if (hipFuncSetAttribute((const void*)hymba_fwd, hipFuncAttributeMaxDynamicSharedMemorySize, LDS_BYTES) != hipSuccess) { fprintf(stderr, "kernel_launch: hipFuncSetAttribute failed\n"); grid = -1; return; }
        if (hipOccupancyMaxActiveBlocksPerMultiprocessor(&per_cu, (const void*)hymba_fwd, NWAVES * 64, LDS_BYTES) != hipSuccess || per_cu < 1)
            fprintf(stderr, "kernel_launch: note: occupancy query reports %d workgroups per CU\n", per_cu);
        (void)hipGetLastError();
        grid = cus;
        if (grid != 256) { fprintf(stderr, "kernel_launch: built for 256 CUs, device has %d; nothing launched\n", cus); grid = -1; return; }
    }
    if (grid < 0) return;
    if (hipMemsetAsync((char*)d_ws + WS_CTL, 0, CTL_ZERO_BYTES, stream) != hipSuccess) return;
    Args a{};
    for (int i = 0; i < 18; ++i) a.in[i] = (const float*)d_in[i];
    a.out = (float*)d_out; a.ws = (unsigned char*)d_ws;
    hipLaunchKernelGGL(hymba_fwd, dim3(grid), dim3(NWAVES * 64), LDS_BYTES, stream, a);
}
```
